# Optimizing an MI355X kernel written in HIP

```python
import math
import jax, jax.numpy as jnp
from jax import lax
import numpy as np

D_MODEL = 1024
BATCH = 4
SEQ = 8192
DEPTH = 4
DEC_BATCH = 32
DEC_SEQ = 64
PAST_LEN = 4096

CHUNK = 64
A_HEADS = 6
A_HEAD_DIM = 64
A_WIDTH = A_HEADS * A_HEAD_DIM
A_PAST_CHUNKS = 8
A_PAST_ROWS = A_PAST_CHUNKS * CHUNK
A_BAND = A_PAST_ROWS + CHUNK
A_REL_MIN = -(CHUNK - 1)
A_REL_MAX = 128
A_REL_SIZE = A_REL_MAX - A_REL_MIN + 1
ATT_SCALE = A_HEAD_DIM ** -0.5
B_HEADS = 6
B_HEAD_DIM = 64
B_WIDTH = B_HEADS * B_HEAD_DIM
B_GROUPS = 2
B_HPG = B_HEADS // B_GROUPS
B_STATE = 128
B_CONV = 4
B_CONV_DIM = B_WIDTH + 2 * B_GROUPS * B_STATE
SSD_CHUNK = 128
C_GROUPS = 4
C_GROUP_DIM = 64
C_WIDTH = C_GROUPS * C_GROUP_DIM
C_CHUNK = 128
D_MIX = A_WIDTH + B_WIDTH + C_WIDTH
IN_SIZES = (A_WIDTH, A_WIDTH, A_WIDTH, B_WIDTH, B_CONV_DIM, B_HEADS, C_WIDTH, C_WIDTH)
N_IN = 3 * A_WIDTH + B_WIDTH + B_CONV_DIM + B_HEADS + 2 * C_WIDTH
D_FF = 2816
FFN_CONV = 3
DN_ALPHA = (2 * DEPTH) ** 0.25
DN_BETA = (8 * DEPTH) ** -0.25
LN_EPS = 1e-5
RMS_EPS = 1e-5

kernel_name = 'hybrid_streaming_encoder_step'


def layer_norm(x, g, b):
    xf = x.astype(jnp.float32)
    mu = jnp.mean(xf, axis=-1, keepdims=True)
    var = jnp.mean(jnp.square(xf - mu), axis=-1, keepdims=True)
    return ((xf - mu) * lax.rsqrt(var + LN_EPS) * g.astype(jnp.float32) + b.astype(jnp.float32)).astype(x.dtype)


def rms_norm(x, g):
    xf = x.astype(jnp.float32)
    return (xf * lax.rsqrt(jnp.mean(jnp.square(xf), axis=-1, keepdims=True) + RMS_EPS) * g.astype(jnp.float32)).astype(x.dtype)


def split_cols(t, sizes):
    return jnp.split(t, np.cumsum(sizes)[:-1].tolist(), axis=-1)


def causal_dwconv(x, prev, w, b):
    k_width = w.shape[0]
    L = x.shape[1]
    xp = jnp.concatenate([prev.astype(x.dtype), x], axis=1)
    y = b.astype(x.dtype) + w[0] * xp[:, 0:L]
    for j in range(1, k_width):
        y = y + w[j] * xp[:, j:j + L]
    return y, xp[:, L:]


def rel_bias_lookup(table, rel):
    idx = jnp.clip(rel, A_REL_MIN, A_REL_MAX) - A_REL_MIN
    return table[:, idx].astype(jnp.float32)


def band_attention_prompt(q, k, v, table):
    n, L, H, dh = q.shape
    nc = L // CHUNK
    qc = q.reshape(n, nc, CHUNK, H, dh)
    kidx = jnp.arange(nc)[:, None] * CHUNK - A_PAST_ROWS + jnp.arange(A_BAND)[None, :]
    valid = kidx >= 0
    kidx = jnp.maximum(kidx, 0)
    kb = jnp.take(k, kidx, axis=1)
    vb = jnp.take(v, kidx, axis=1)
    s = jnp.einsum('bcqhd,bckhd->bchqk', qc, kb).astype(jnp.float32) * ATT_SCALE
    rel = jnp.arange(CHUNK)[:, None] + A_PAST_ROWS - jnp.arange(A_BAND)[None, :]
    s = s + rel_bias_lookup(table, rel)[None, None]
    s = jnp.where(valid[None, :, None, None, :], s, -jnp.inf)
    p = jax.nn.softmax(s, axis=-1).astype(vb.dtype)
    o = jnp.einsum('bchqk,bckhd->bcqhd', p, vb)
    return o.reshape(n, L, H * dh)


def band_attention_sample(q, k_new, v_new, k_cache, v_cache, table):
    n, T = q.shape[0], q.shape[1]
    n_past = k_cache.shape[1]
    kk = jnp.concatenate([k_cache.astype(k_new.dtype), k_new], axis=1)
    vv = jnp.concatenate([v_cache.astype(v_new.dtype), v_new], axis=1)
    s = jnp.einsum('bqhd,bkhd->bhqk', q, kk).astype(jnp.float32) * ATT_SCALE
    rel = jnp.arange(T)[:, None] + n_past - jnp.arange(n_past + T)[None, :]
    s = s + rel_bias_lookup(table, rel)[None]
    p = jax.nn.softmax(s, axis=-1).astype(vv.dtype)
    o = jnp.einsum('bhqk,bkhd->bqhd', p, vv)
    return o.reshape(n, T, A_WIDTH)


def ssd_scan(x, dt, a, bm, cm, h0):
    n, L = x.shape[0], x.shape[1]
    q = SSD_CHUNK if L % SSD_CHUNK == 0 else L
    nc = L // q
    f32 = jnp.float32
    xg = x.astype(f32).reshape(n, nc, q, B_GROUPS, B_HPG, B_HEAD_DIM)
    dtg = dt.reshape(n, nc, q, B_GROUPS, B_HPG)
    bc = bm.astype(f32).reshape(n, nc, q, B_GROUPS, B_STATE)
    cc = cm.astype(f32).reshape(n, nc, q, B_GROUPS, B_STATE)
    acum = jnp.cumsum(dtg * a.reshape(B_GROUPS, B_HPG), axis=2)
    xdt = xg * dtg[..., None]
    seg = acum[:, :, :, None] - acum[:, :, None, :]
    causal = jnp.tril(jnp.ones((q, q), dtype=bool))
    decay = jnp.exp(jnp.where(causal[:, :, None, None], seg, -jnp.inf))
    cb = jnp.einsum('bclgn,bcsgn->bclsg', cc, bc)
    y_diag = jnp.einsum('bclsgr,bcsgrp->bclgrp', cb[..., None] * decay, xdt)
    decay_s = jnp.exp(acum[:, :, -1:] - acum)
    st = jnp.einsum('bclgn,bclgrp->bcgrpn', bc, xdt * decay_s[..., None])
    chunk_decay = jnp.exp(acum[:, :, -1])

    def step(h, inp):
        s_c, d_c = inp
        return h * d_c[..., None, None] + s_c, h

    h_init = h0.astype(f32).reshape(n, B_GROUPS, B_HPG, B_HEAD_DIM, B_STATE)
    h_last, h_prev = lax.scan(step, h_init, (jnp.moveaxis(st, 1, 0), jnp.moveaxis(chunk_decay, 1, 0)))
    h_prev = jnp.moveaxis(h_prev, 0, 1)
    y_off = jnp.einsum('bclgn,bcgrpn->bclgrp', cc, h_prev) * jnp.exp(acum)[..., None]
    y = (y_diag + y_off).reshape(n, L, B_HEADS, B_HEAD_DIM)
    return y, h_last.reshape(n, B_HEADS, B_HEAD_DIM, B_STATE)


def mamba_mixer(z, xbc, dt_raw, conv_prev, h0, conv_w, conv_b, dt_bias, a_log, d_skip):
    n, L = z.shape[0], z.shape[1]
    f32 = jnp.float32
    xbc, conv_state = causal_dwconv(xbc, conv_prev, conv_w, conv_b)
    xbc = jax.nn.silu(xbc)
    xs, bm, cm = split_cols(xbc, (B_WIDTH, B_GROUPS * B_STATE, B_GROUPS * B_STATE))
    xs = xs.reshape(n, L, B_HEADS, B_HEAD_DIM)
    dt = jax.nn.softplus(dt_raw.astype(f32) + dt_bias.astype(f32))
    a = -jnp.exp(a_log.astype(f32))
    y, h = ssd_scan(xs, dt, a, bm.reshape(n, L, B_GROUPS, B_STATE), cm.reshape(n, L, B_GROUPS, B_STATE), h0)
    y = y + d_skip.astype(f32)[:, None] * xs.astype(f32)
    y = y.reshape(n, L, B_WIDTH).astype(z.dtype) * jax.nn.silu(z)
    return y, conv_state, h


def chunk_mlp(u, v, w_s, b_s):
    n, L = v.shape[0], v.shape[1]
    q = min(L, C_CHUNK)
    nc = L // q
    w = jnp.tril(w_s[:, :q, :q])
    vg = v.reshape(n, nc, q, C_GROUPS, C_GROUP_DIM)
    mixed = jnp.einsum('gij,bcjgd->bcigd', w, vg) + jnp.transpose(b_s[:, :q])[None, None, :, :, None]
    return u * mixed.reshape(n, L, C_WIDTH)


def trunk_layer(x, k_cache, v_cache, ssm_conv_prev, ssm_h0, ffn_conv_prev,
                w_in, attn_rel_bias, ssm_conv_w, ssm_conv_b, ssm_dt_bias, ssm_a_log, ssm_d,
                gmlp_w, gmlp_b, mix_norm_g, w_out, ln1_g, ln1_b,
                ffn_w_in, ffn_conv_w, ffn_conv_b, ffn_w_out, ln2_g, ln2_b):
    n, L = x.shape[0], x.shape[1]
    q, k, v, z, xbc, dt_raw, u, vc = split_cols(x @ w_in, IN_SIZES)
    q = q.reshape(n, L, A_HEADS, A_HEAD_DIM)
    k = k.reshape(n, L, A_HEADS, A_HEAD_DIM)
    v = v.reshape(n, L, A_HEADS, A_HEAD_DIM)
    if k_cache is None:
        o_a = band_attention_prompt(q, k, v, attn_rel_bias)
        keep = min(A_PAST_ROWS, L)
        k_rows, v_rows = k[:, L - keep:], v[:, L - keep:]
    else:
        o_a = band_attention_sample(q, k, v, k_cache, v_cache, attn_rel_bias)
        k_rows, v_rows = k, v
    o_b, ssm_conv_state, ssm_h = mamba_mixer(z, xbc, dt_raw, ssm_conv_prev, ssm_h0, ssm_conv_w, ssm_conv_b,
                                             ssm_dt_bias, ssm_a_log, ssm_d)
    u = jax.nn.gelu(u)
    vc = jax.nn.gelu(vc)
    o_c = chunk_mlp(u, vc, gmlp_w, gmlp_b)
    g_a, g_b, g_c = split_cols(mix_norm_g, (A_WIDTH, B_WIDTH, C_WIDTH))
    mixed = jnp.concatenate([rms_norm(o_a, g_a), rms_norm(o_b, g_b), rms_norm(o_c, g_c)], axis=-1)
    x = layer_norm(DN_ALPHA * x + mixed @ w_out, ln1_g, ln1_b)
    up, ffn_conv_state = causal_dwconv(x @ ffn_w_in, ffn_conv_prev, ffn_conv_w, ffn_conv_b)
    gate, val = split_cols(up, (D_FF, D_FF))
    x = layer_norm(DN_ALPHA * x + (jax.nn.silu(gate) * val) @ ffn_w_out, ln2_g, ln2_b)
    return x, k_rows, v_rows, ssm_h, ssm_conv_state, vc, ffn_conv_state


def setup_inputs(seed: int = 0) -> dict:
    key = jax.random.key(seed)
    ks = jax.random.split(key, 28)
    f32 = jnp.float32

    def nrm(k, shape, scale):
        return jax.random.normal(k, shape, f32) * scale

    keep = min(A_PAST_ROWS, PAST_LEN)
    dt0 = jnp.exp(jax.random.uniform(ks[12], (DEPTH, B_HEADS), f32, math.log(1e-3), math.log(1e-1)))
    return {
        'x_prompt': nrm(ks[0], (BATCH, SEQ, D_MODEL), 1.0),
        'x_sample': nrm(ks[1], (DEC_BATCH, DEC_SEQ, D_MODEL), 1.0),
        'cache_attn_k': nrm(ks[2], (DEPTH, DEC_BATCH, keep, A_HEADS, A_HEAD_DIM), 1.0),
        'cache_attn_v': nrm(ks[3], (DEPTH, DEC_BATCH, keep, A_HEADS, A_HEAD_DIM), 1.0),
        'state_ssm': nrm(ks[4], (DEPTH, DEC_BATCH, B_HEADS, B_HEAD_DIM, B_STATE), 0.1),
        'state_ssm_conv': nrm(ks[5], (DEPTH, DEC_BATCH, B_CONV - 1, B_CONV_DIM), 1.0),
        'state_ffn_conv': nrm(ks[6], (DEPTH, DEC_BATCH, FFN_CONV - 1, 2 * D_FF), 1.0),
        'ln_in_g': 1.0 + nrm(ks[7], (D_MODEL,), 0.05),
        'ln_in_b': nrm(ks[8], (D_MODEL,), 0.02),
        'w_in': nrm(ks[9], (DEPTH, D_MODEL, N_IN), D_MODEL ** -0.5),
        'attn_rel_bias': nrm(ks[10], (DEPTH, A_HEADS, A_REL_SIZE), 0.5),
        'ssm_conv_w': nrm(ks[11], (DEPTH, B_CONV, B_CONV_DIM), B_CONV ** -0.5),
        'ssm_conv_b': nrm(ks[13], (DEPTH, B_CONV_DIM), 0.02),
        'ssm_dt_bias': dt0 + jnp.log(-jnp.expm1(-dt0)),
        'ssm_a_log': jnp.log(jax.random.uniform(ks[14], (DEPTH, B_HEADS), f32, 1.0, 16.0)),
        'ssm_d': 1.0 + nrm(ks[15], (DEPTH, B_HEADS), 0.1),
        'gmlp_w': nrm(ks[16], (DEPTH, C_GROUPS, C_CHUNK, C_CHUNK), C_CHUNK ** -0.5),
        'gmlp_b': 1.0 + nrm(ks[17], (DEPTH, C_GROUPS, C_CHUNK), 0.1),
        'mix_norm_g': 1.0 + nrm(ks[18], (DEPTH, D_MIX), 0.05),
        'w_out': nrm(ks[19], (DEPTH, D_MIX, D_MODEL), D_MIX ** -0.5 * DN_BETA),
        'ln1_g': 1.0 + nrm(ks[20], (DEPTH, D_MODEL), 0.05),
        'ln1_b': nrm(ks[21], (DEPTH, D_MODEL), 0.02),
        'ffn_w_in': nrm(ks[22], (DEPTH, D_MODEL, 2 * D_FF), D_MODEL ** -0.5),
        'ffn_conv_w': nrm(ks[23], (DEPTH, FFN_CONV, 2 * D_FF), FFN_CONV ** -0.5),
        'ffn_conv_b': nrm(ks[24], (DEPTH, 2 * D_FF), 0.02),
        'ffn_w_out': nrm(ks[25], (DEPTH, D_FF, D_MODEL), D_FF ** -0.5 * DN_BETA),
        'ln2_g': 1.0 + nrm(ks[26], (DEPTH, D_MODEL), 0.05),
        'ln2_b': nrm(ks[27], (DEPTH, D_MODEL), 0.02),
    }


def reference(x_prompt, x_sample, cache_attn_k, cache_attn_v, state_ssm, state_ssm_conv, state_ffn_conv,
              ln_in_g, ln_in_b, w_in, attn_rel_bias, ssm_conv_w, ssm_conv_b, ssm_dt_bias, ssm_a_log, ssm_d,
              gmlp_w, gmlp_b, mix_norm_g, w_out, ln1_g, ln1_b,
              ffn_w_in, ffn_conv_w, ffn_conv_b, ffn_w_out, ln2_g, ln2_b):
    xp = layer_norm(x_prompt, ln_in_g, ln_in_b)
    xs = layer_norm(x_sample, ln_in_g, ln_in_b)
    n_p = x_prompt.shape[0]
    zero_ssm_conv = jnp.zeros((n_p, B_CONV - 1, B_CONV_DIM), xp.dtype)
    zero_ssm = jnp.zeros((n_p, B_HEADS, B_HEAD_DIM, B_STATE), jnp.float32)
    zero_ffn_conv = jnp.zeros((n_p, FFN_CONV - 1, 2 * D_FF), xp.dtype)
    p_k, p_v, p_h, p_c, p_f = [], [], [], [], []
    s_k, s_v, s_h, s_c, s_g, s_f = [], [], [], [], [], []
    for l in range(DEPTH):
        lp = (w_in[l], attn_rel_bias[l], ssm_conv_w[l], ssm_conv_b[l], ssm_dt_bias[l], ssm_a_log[l], ssm_d[l],
              gmlp_w[l], gmlp_b[l], mix_norm_g[l], w_out[l], ln1_g[l], ln1_b[l],
              ffn_w_in[l], ffn_conv_w[l], ffn_conv_b[l], ffn_w_out[l], ln2_g[l], ln2_b[l])
        xp, kr, vr, hh, cs, _, fs = trunk_layer(xp, None, None, zero_ssm_conv, zero_ssm, zero_ffn_conv, *lp)
        p_k.append(kr); p_v.append(vr); p_h.append(hh); p_c.append(cs); p_f.append(fs)
        xs, kr, vr, hh, cs, gv, fs = trunk_layer(xs, cache_attn_k[l], cache_attn_v[l], state_ssm_conv[l],
                                                 state_ssm[l], state_ffn_conv[l], *lp)
        s_k.append(kr); s_v.append(vr); s_h.append(hh); s_c.append(cs); s_g.append(gv); s_f.append(fs)
    return (xp, xs,
            jnp.stack(p_k), jnp.stack(p_v), jnp.stack(p_h), jnp.stack(p_c), jnp.stack(p_f),
            jnp.stack(s_k), jnp.stack(s_v), jnp.stack(s_h), jnp.stack(s_c), jnp.stack(s_g), jnp.stack(s_f))
```

```cpp
#define M1_MASK 3
#include <hip/hip_runtime.h>
#include <hip/hip_cooperative_groups.h>
#include <cstdio>
namespace cg = cooperative_groups;

#define LAS __attribute__((address_space(3)))
typedef unsigned short bf16_t;
typedef short bf16x8 __attribute__((ext_vector_type(8)));
typedef float f32x4 __attribute__((ext_vector_type(4)));
typedef float f32x2 __attribute__((ext_vector_type(2)));
typedef unsigned u32x4 __attribute__((ext_vector_type(4)));
typedef unsigned u32x2 __attribute__((ext_vector_type(2)));

constexpr int T_ALL = 34816, T_P = 32768, DM = 1024, NPROJ = 3072, DFF = 2816, DFF2 = 5632, DEPTH = 4;
constexpr int NU64 = 544;
constexpr float ALPHA = 1.6817928305074290f;
constexpr float LN_EPS = 1e-5f, RMS_EPS = 1e-5f;
constexpr int C_K = 384, C_V = 768, C_Z = 1152, C_XBC = 1536, C_U = 2432, C_VC = 2688, C_DT = 2944;
constexpr size_t O_YP = 0, O_YS = 33554432, O_PK = 35651584, O_PV = O_PK + 3145728, O_PH = O_PV + 3145728, O_PC = O_PH + 786432,
                 O_PF = O_PC + 43008, O_SK = O_PF + 180224, O_SV = O_SK + 3145728, O_SH = O_SV + 3145728, O_SC = O_SH + 6291456,
                 O_SG = O_SC + 344064, O_SF = O_SG + 2097152;
constexpr size_t W_IN = 0, W_IN_L = (size_t)NPROJ * DM * 2;
constexpr size_t W_OUT = W_IN + 4 * W_IN_L, W_OUT_L = (size_t)DM * DM * 2;
constexpr size_t W_UP = W_OUT + 4 * W_OUT_L, W_UP_L = (size_t)DFF2 * DM * 2;
constexpr size_t W_DN = W_UP + 4 * W_UP_L, W_DN_L = (size_t)DM * DFF * 2;
constexpr size_t W_GW = W_DN + 4 * W_DN_L, W_GW_L = (size_t)4 * 128 * 128 * 2;
constexpr size_t W_XB = W_GW + 4 * W_GW_L;
constexpr size_t W_PROJ = W_XB + (size_t)T_ALL * DM * 2;
constexpr size_t W_MIX = W_PROJ + (size_t)T_ALL * NPROJ * 2;
constexpr size_t W_ST = W_MIX + (size_t)T_ALL * DM * 2;
constexpr size_t W_CD = W_ST + (size_t)NU64 * 6 * 8192 * 2;
constexpr size_t W_DTB = W_CD + (size_t)NU64 * 8 * 4;
constexpr size_t W_END = W_DTB + (size_t)T_ALL * 8 * 4;
constexpr int LDS_BYTES = 136 * 1024;

struct Params { const float* in[28]; float* out; unsigned char* ws; int ph_lo, ph_hi, coop, pad; };
typedef const __attribute__((address_space(4))) Params KP;

__device__ __forceinline__ float bf2f(unsigned b) { return __uint_as_float(b << 16); }
typedef __bf16 bf16v2 __attribute__((ext_vector_type(2)));
__device__ __forceinline__ unsigned cvt_pk_bf16(float lo, float hi) { const f32x2 v = {lo, hi}; const bf16v2 b = __builtin_convertvector(v, bf16v2); return __builtin_bit_cast(unsigned, b); }
__device__ __forceinline__ u32x2 pack4(f32x4 v) { u32x2 w; w.x = cvt_pk_bf16(v[0], v[1]); w.y = cvt_pk_bf16(v[2], v[3]); return w; }
__device__ __forceinline__ f32x4 unpack4(u32x2 w) { f32x4 v; v[0] = bf2f(w.x & 0xffffu); v[1] = bf2f(w.x >> 16); v[2] = bf2f(w.y & 0xffffu); v[3] = bf2f(w.y >> 16); return v; }
__device__ __forceinline__ float silu_f(float x) { return x / (1.0f + __expf(-x)); }
__device__ __forceinline__ float gelu_tanh(float x) { const float y = 0.7978845608028654f * (x + 0.044715f * x * x * x); const float e = __expf(2.0f * y); return 0.5f * x * (2.0f - 2.0f / (1.0f + e)); }
__device__ __forceinline__ float softplus_f(float x) { const float e = __expf(x); return x > 15.0f ? x : (e < 1e-3f ? e * (1.0f - 0.5f * e + 0.33333333f * e * e) : __logf(1.0f + e)); }
#define MFMA16(colfrag, rowfrag, acc) __builtin_amdgcn_mfma_f32_16x16x32_bf16((colfrag), (rowfrag), (acc), 0, 0, 0)
__device__ __forceinline__ bf16x8 ldsfrag(LAS const unsigned char* p) { return *(LAS const bf16x8*)p; }
__device__ __forceinline__ bf16x8 glbfrag(const bf16_t* p) { return *(const bf16x8*)p; }
#define LDS_WAVE_SYNC() asm volatile("s_waitcnt lgkmcnt(0)" ::: "memory")

namespace pg8 {
constexpr int BM = 256, BK = 64, HALF = 128, HTB = HALF * BK * 2, STAGE_BYTES = 8 * HTB, NXCD = 8, WGM = 8;
__device__ __forceinline__ int lds_byte(int r, int c) { const int st = (r >> 4) * 2 + (c >> 5), rr = r & 15, cc = c & 31, ob = rr * 64 + cc * 2; return st * 1024 + (ob ^ (((ob >> 9) & 1) << 5)); }
__device__ __forceinline__ void stage_rc(int b, int& R, int& C) { const int st = b / 1024, sb = b % 1024, swz = sb ^ (((sb >> 9) & 1) << 5); R = (st >> 1) * 16 + swz / 64; C = (st & 1) * 32 + (swz % 64) / 2; }
struct Unit { int pm, pn; };
struct Gemm { const bf16_t* A; const bf16_t* Bt; int M, N, K; };
struct StaticOrder {
    int nM, nN, nwg, G, c;
    __device__ __forceinline__ void init(int M, int N, int G_, int c_) { nM = M / BM; nN = N / BM; nwg = nM * nN; G = G_; c = c_; }
    __device__ __forceinline__ bool next(int i, Unit& u) const {
        const long L = (long)i * G + c; if (L >= nwg) return false;
        int wgid = (int)L; { const int q = nwg / NXCD, r = nwg % NXCD, xcd = wgid % NXCD, off = wgid / NXCD; wgid = (xcd < r ? xcd * (q + 1) : r * (q + 1) + (xcd - r) * q) + off; }
        const int nig = WGM * nN, gid = wgid / nig, fm = gid * WGM, gsz = (nM - fm) < WGM ? (nM - fm) : WGM;
        u.pm = fm + ((wgid % nig) % gsz); u.pn = (wgid % nig) / gsz; return true;
    }
    __device__ __forceinline__ void a_ready(const Unit&) const {}
    __device__ __forceinline__ void done(const Unit&) const {}
};
struct OneUnit {
    Unit u;
    __device__ __forceinline__ bool next(int i, Unit& o) const { if (i) return false; o = u; return true; }
    __device__ __forceinline__ void a_ready(const Unit&) const {}
    __device__ __forceinline__ void done(const Unit&) const {}
};

template <class Epi, class Sched>
__device__ __forceinline__ void gemm_phase(LAS unsigned char* lds, const Gemm g, const Sched& S, const Epi& E) {
    int tid_ = threadIdx.x; asm volatile("" : "+v"(tid_));
    const int tid = tid_, wid = __builtin_amdgcn_readfirstlane(tid >> 6), lane = tid & 63, wr = wid >> 2, wc = wid & 3, fr = lane & 15, fq = lane >> 4;
    const int K = g.K, nt = K / BK;
    unsigned voffA[2];
#pragma unroll
    for (int i = 0; i < 2; ++i) { int R, C; stage_rc(tid * 16 + i * 8192, R, C); voffA[i] = (unsigned)(R * K + C) * 2u; }
    const size_t kstep = (size_t)(BK * 2);
    const size_t hstep = (size_t)HALF * K * 2;
    const size_t tstep = 2 * hstep;
    const unsigned ldsw = (unsigned)wid * 1024u;
    const int aoff = lds_byte(wr * 64 + fr, fq * 8), boff = lds_byte(wc * 32 + fr, fq * 8);
#define PG8_SA(b, h) (((b) * 2 + (h)) * HTB)
#define PG8_SB(b, h) ((4 + (b) * 2 + (h)) * HTB)
#define PG8_STAGE(bufoff, gbase, voff) do { _Pragma("unroll") for (int _i = 0; _i < 2; ++_i) \
        __builtin_amdgcn_global_load_lds((const unsigned*)((const char*)(gbase) + (voff)[_i]), (LAS unsigned*)(lds + (bufoff) + ldsw + _i * 8192), 16, 0, 0); } while (0)
#define PG8_LDA(dst, b, h) do { _Pragma("unroll") for (int m = 0; m < 4; ++m) _Pragma("unroll") for (int k = 0; k < 2; ++k) dst[m][k] = *(const LAS bf16x8*)(lds + PG8_SA(b, h) + aoff + m * 2048 + k * 1024); } while (0)
#define PG8_LDB(dst, b, h) do { _Pragma("unroll") for (int n = 0; n < 2; ++n) _Pragma("unroll") for (int k = 0; k < 2; ++k) dst[n][k] = *(const LAS bf16x8*)(lds + PG8_SB(b, h) + boff + n * 2048 + k * 1024); } while (0)
#define PG8_MMA(ai, bj, At, Bt) do { __builtin_amdgcn_s_setprio(1); _Pragma("unroll") for (int m = 0; m < 4; ++m) _Pragma("unroll") for (int n = 0; n < 2; ++n) _Pragma("unroll") for (int k = 0; k < 2; ++k) \
        acc[ai][bj][m][n] = __builtin_amdgcn_mfma_f32_16x16x32_bf16(Bt[n][k], At[m][k], acc[ai][bj][m][n], 0, 0, 0); __builtin_amdgcn_s_setprio(0); } while (0)
#define PG8_WAIT_V(n) asm volatile("s_waitcnt vmcnt(" #n ")" ::: "memory")
#define PG8_WAIT_L(n) asm volatile("s_waitcnt lgkmcnt(" #n ")" ::: "memory")
#define PG8_BAR __builtin_amdgcn_s_barrier()
#define PG8_SCHED __builtin_amdgcn_sched_barrier(0)
    Unit cur, nxt; int ui = 0;
    if (!S.next(0, cur)) return;
    f32x4 acc[2][2][4][2];
#pragma unroll
    for (int a = 0; a < 2; ++a)
#pragma unroll
        for (int b = 0; b < 2; ++b)
#pragma unroll
            for (int m = 0; m < 4; ++m)
#pragma unroll
                for (int n = 0; n < 2; ++n) acc[a][b][m][n] = (f32x4){0.f, 0.f, 0.f, 0.f};
    bf16x8 At[4][2], B0[2][2], B1[2][2];
    const char* cA = (const char*)g.A + (size_t)cur.pm * tstep; const char* cB = (const char*)g.Bt + (size_t)cur.pn * tstep;
    S.a_ready(cur);
    PG8_STAGE(PG8_SB(0, 0), cB, voffA); PG8_STAGE(PG8_SA(0, 0), cA, voffA); PG8_STAGE(PG8_SB(0, 1), cB + hstep, voffA); PG8_STAGE(PG8_SA(0, 1), cA + hstep, voffA);
    if (wr == 1) PG8_BAR;
    PG8_WAIT_V(4); PG8_BAR;
    PG8_STAGE(PG8_SB(1, 0), cB + kstep, voffA); PG8_STAGE(PG8_SA(1, 0), cA + kstep, voffA); PG8_STAGE(PG8_SB(1, 1), cB + hstep + kstep, voffA);
    PG8_WAIT_V(6); PG8_BAR;
    for (;;) {
        const bool has_next = S.next(ui + 1, nxt);
        const char* nA = has_next ? (const char*)g.A + (size_t)nxt.pm * tstep : cA; const char* nB = has_next ? (const char*)g.Bt + (size_t)nxt.pn * tstep : cB;
        for (int t = 0; t < nt; t += 2) {
            const bool last = (t == nt - 2);
            const char* a1 = cA + (size_t)(t + 1) * kstep;
            const char* a2 = last ? nA : cA + (size_t)(t + 2) * kstep; const char* b2 = last ? nB : cB + (size_t)(t + 2) * kstep;
            const char* a3 = a2 + kstep; const char* b3 = b2 + kstep;
            if (last && has_next) S.a_ready(nxt);
            PG8_LDB(B0, 0, 0); PG8_SCHED; PG8_LDA(At, 0, 0); PG8_STAGE(PG8_SA(1, 1), a1 + hstep, voffA);
            PG8_WAIT_L(8); PG8_BAR; PG8_WAIT_L(0); PG8_MMA(0, 0, At, B0); PG8_BAR; PG8_SCHED;
            PG8_LDB(B1, 0, 1); PG8_STAGE(PG8_SB(0, 0), b2, voffA);
            PG8_BAR; PG8_WAIT_L(0); PG8_MMA(0, 1, At, B1); PG8_BAR;
            PG8_LDA(At, 0, 1); PG8_STAGE(PG8_SA(0, 0), a2, voffA);
            PG8_BAR; PG8_WAIT_L(0); PG8_MMA(1, 0, At, B0); PG8_BAR; PG8_SCHED;
            PG8_STAGE(PG8_SB(0, 1), b2 + hstep, voffA);
            PG8_WAIT_V(6); PG8_BAR; PG8_MMA(1, 1, At, B1); PG8_BAR;
            PG8_LDB(B0, 1, 0); PG8_SCHED; PG8_LDA(At, 1, 0); PG8_STAGE(PG8_SA(0, 1), a2 + hstep, voffA);
            PG8_WAIT_L(8); PG8_BAR; PG8_WAIT_L(0); PG8_MMA(0, 0, At, B0); PG8_BAR; PG8_SCHED;
            PG8_LDB(B1, 1, 1); PG8_STAGE(PG8_SB(1, 0), b3, voffA);
            PG8_BAR; PG8_WAIT_L(0); PG8_MMA(0, 1, At, B1); PG8_BAR;
            PG8_LDA(At, 1, 1); PG8_STAGE(PG8_SA(1, 0), a3, voffA);
            PG8_BAR; PG8_WAIT_L(0); PG8_MMA(1, 0, At, B0); PG8_BAR; PG8_SCHED;
            PG8_STAGE(PG8_SB(1, 1), b3 + hstep, voffA);
            PG8_WAIT_V(6); PG8_BAR; PG8_MMA(1, 1, At, B1); PG8_BAR;
        }
        if constexpr (!Epi::AFTER_DRAIN) { E(acc, cur, wr, wc, fr, fq); S.done(cur); }
        if (!has_next) break;
#pragma unroll
        for (int a = 0; a < 2; ++a)
#pragma unroll
            for (int b = 0; b < 2; ++b)
#pragma unroll
                for (int m = 0; m < 4; ++m)
#pragma unroll
                    for (int n = 0; n < 2; ++n) acc[a][b][m][n] = (f32x4){0.f, 0.f, 0.f, 0.f};
        cur = nxt; cA = nA; cB = nB; ++ui;
    }
    PG8_WAIT_V(0);
    if (wr == 0) PG8_BAR;
    PG8_BAR;
    if constexpr (Epi::AFTER_DRAIN) { E.fused(acc, cur, wr, wc, fr, fq, lds, wid, lane); S.done(cur); }
#undef PG8_SA
#undef PG8_SB
#undef PG8_STAGE
#undef PG8_LDA
#undef PG8_LDB
#undef PG8_MMA
#undef PG8_WAIT_V
#undef PG8_WAIT_L
#undef PG8_BAR
#undef PG8_SCHED
}
}
using pg8::Unit;

struct EpiIn {
    static constexpr bool AFTER_DRAIN = false;
    bf16_t* proj; float* out; float* dtb; const float* dt_bias; int l;
    __device__ __forceinline__ void operator()(const f32x4 (&acc)[2][2][4][2], const Unit& u, int wr, int wc, int fr, int fq) const {
#pragma unroll
        for (int ai = 0; ai < 2; ++ai)
#pragma unroll
            for (int m = 0; m < 4; ++m) {
                const int row = u.pm * 256 + ai * 128 + wr * 64 + m * 16 + fr;
                const bool isP = row < T_P; int b, t;
                if (isP) { b = row >> 13; t = row & 8191; } else { b = (row - T_P) >> 6; t = row & 63; }
#pragma unroll
                for (int bj = 0; bj < 2; ++bj)
#pragma unroll
                    for (int n = 0; n < 2; ++n) {
                        const int col = u.pn * 256 + bj * 128 + wc * 32 + n * 16 + fq * 4;
                        f32x4 v = acc[ai][bj][m][n];
                        if (col < C_U) {
                            *(u32x2*)(proj + (size_t)row * NPROJ + col) = pack4(v);
                            if (col >= C_K && col < C_Z) {
                                const int isv = col >= C_V; const int cc = col - (isv ? C_V : C_K);
                                if (isP) { if (t >= 7680) *(f32x4*)(out + (isv ? O_PV : O_PK) + ((size_t)(l * 4 + b) * 512 + (t - 7680)) * 384 + cc) = v; }
                                else *(f32x4*)(out + (isv ? O_SV : O_SK) + ((size_t)(l * 32 + b) * 64 + t) * 384 + cc) = v;
                            } else if (col >= C_XBC) {
                                const int cc = col - C_XBC;
                                if (isP) { if (t >= 8189) *(f32x4*)(out + O_PC + ((size_t)(l * 4 + b) * 3 + (t - 8189)) * 896 + cc) = v; }
                                else if (t >= 61) *(f32x4*)(out + O_SC + ((size_t)(l * 32 + b) * 3 + (t - 61)) * 896 + cc) = v;
                            }
                        } else if (col < C_DT) {
#pragma unroll
                            for (int j = 0; j < 4; ++j) v[j] = gelu_tanh(v[j]);
                            *(u32x2*)(proj + (size_t)row * NPROJ + col) = pack4(v);
                            if (col >= C_VC && !isP) *(f32x4*)(out + O_SG + ((size_t)(l * 32 + b) * 64 + t) * 256 + (col - C_VC)) = v;
                        } else if (col < C_DT + 8) {
#pragma unroll
                            for (int j = 0; j < 4; ++j) { const int hh = col + j - C_DT; if (hh < 6) dtb[(size_t)row * 8 + hh] = softplus_f(v[j] + dt_bias[l * 6 + hh]); }
                        }
                    }
            }
    }
};
struct EpiRes {
    static constexpr bool AFTER_DRAIN = false;
    float* x;
    __device__ __forceinline__ void operator()(const f32x4 (&acc)[2][2][4][2], const Unit& u, int wr, int wc, int fr, int fq) const {
#pragma unroll
        for (int ai = 0; ai < 2; ++ai)
#pragma unroll
            for (int m = 0; m < 4; ++m) {
                float* rowp = x + (size_t)(u.pm * 256 + ai * 128 + wr * 64 + m * 16 + fr) * DM + u.pn * 256 + wc * 32 + fq * 4;
#pragma unroll
                for (int bj = 0; bj < 2; ++bj)
#pragma unroll
                    for (int n = 0; n < 2; ++n) { float* q = rowp + bj * 128 + n * 16; const f32x4 o = *(const f32x4*)q; *(f32x4*)q = o * ALPHA + acc[ai][bj][m][n]; }
            }
    }
};
struct EpiUp {
    static constexpr bool AFTER_DRAIN = true;
    bf16_t* H; float* halo; float* out; const float* cw; const float* cb; const float* fstate; int l;
    __device__ __forceinline__ void operator()(const f32x4 (&)[2][2][4][2], const Unit&, int, int, int, int) const {}
    __device__ __forceinline__ void fused(f32x4 (&acc)[2][2][4][2], const Unit& u, int wr, int wc, int fr, int fq, LAS unsigned char* lds, int wid, int lane) const {
        constexpr int LS = 260;
#pragma unroll
        for (int ai = 0; ai < 2; ++ai)
#pragma unroll
            for (int m = 0; m < 4; ++m)
#pragma unroll
                for (int bj = 0; bj < 2; ++bj)
#pragma unroll
                    for (int n = 0; n < 2; ++n) {
                        const int rl = ai * 128 + wr * 64 + m * 16 + fr, cl = bj * 128 + wc * 32 + n * 16 + fq * 4;
                        *(LAS u32x2*)(lds + (rl * LS + cl) * 2) = pack4(acc[ai][bj][m][n]);
                    }
        __syncthreads();
        const int tid = wid * 64 + lane, j = tid & 127, seg = tid >> 7;
        const int hcol = u.pn * 128 + j;
        const float* w = cw + (size_t)l * 3 * DFF2; const float* bb = cb + (size_t)l * DFF2;
        const float wg0 = w[hcol], wg1 = w[DFF2 + hcol], wg2 = w[2 * DFF2 + hcol], bg = bb[hcol];
        const float wv0 = w[DFF + hcol], wv1 = w[DFF2 + DFF + hcol], wv2 = w[2 * DFF2 + DFF + hcol], bv = bb[DFF + hcol];
        const int R = u.pm * 256 + seg * 64;
        const bool isP = R < T_P;
        float g2 = 0.f, g1 = 0.f, v2 = 0.f, v1 = 0.f; int skip = 0;
        const LAS bf16_t* U = (const LAS bf16_t*)lds;
        if (isP) {
            if (seg > 0) { g2 = bf2f(U[(seg * 64 - 2) * LS + j]); g1 = bf2f(U[(seg * 64 - 1) * LS + j]); v2 = bf2f(U[(seg * 64 - 2) * LS + 128 + j]); v1 = bf2f(U[(seg * 64 - 1) * LS + 128 + j]); }
            else if ((R & 8191) != 0) skip = 2;
        } else {
            const int sb = (R - T_P) >> 6; const float* fs = fstate + (size_t)(l * 32 + sb) * 2 * DFF2;
            g2 = fs[hcol]; g1 = fs[DFF2 + hcol]; v2 = fs[DFF + hcol]; v1 = fs[DFF2 + DFF + hcol];
        }
        bf16_t* hp = H + (size_t)R * DFF + hcol;
        for (int i = 0; i < 64; ++i) {
            const float gq = bf2f(U[(seg * 64 + i) * LS + j]), vq = bf2f(U[(seg * 64 + i) * LS + 128 + j]);
            if (i >= skip) {
                const float cgv = bg + wg0 * g2 + wg1 * g1 + wg2 * gq, cvv = bv + wv0 * v2 + wv1 * v1 + wv2 * vq;
                const float hv = silu_f(cgv) * cvv;
                hp[(size_t)i * DFF] = (bf16_t)(cvt_pk_bf16(hv, 0.f) & 0xffffu);
            }
            g2 = g1; g1 = gq; v2 = v1; v1 = vq;
            if (isP) {
                if (seg == 0 && i < 2) { float* hl = halo + ((size_t)u.pm * 4 + i) * DFF2; hl[hcol] = gq; hl[DFF + hcol] = vq; }
                if (seg == 3 && i >= 62) { float* hl = halo + ((size_t)u.pm * 4 + 2 + (i - 62)) * DFF2; hl[hcol] = gq; hl[DFF + hcol] = vq;
                    if ((u.pm & 31) == 31) { float* o = out + O_PF + ((size_t)(l * 4 + (u.pm >> 5)) * 2 + (i - 62)) * DFF2; o[hcol] = gq; o[DFF + hcol] = vq; } }
            } else if (i >= 62) {
                const int sb = (R - T_P) >> 6; float* o = out + O_SF + ((size_t)(l * 32 + sb) * 2 + (i - 62)) * DFF2; o[hcol] = gq; o[DFF + hcol] = vq;
            }
        }
    }
};

__device__ __forceinline__ void ln_row(const float* src, float* x32, bf16_t* xb, const float* g, const float* b, int lane) {
    f32x4 v[4]; float s = 0.f;
#pragma unroll
    for (int i = 0; i < 4; ++i) { v[i] = *(const f32x4*)(src + i * 256 + lane * 4); s += (v[i][0] + v[i][1]) + (v[i][2] + v[i][3]); }
#pragma unroll
    for (int o = 32; o >= 1; o >>= 1) s += __shfl_xor(s, o);
    const float mu = s * (1.0f / 1024.0f); float q = 0.f;
#pragma unroll
    for (int i = 0; i < 4; ++i) { const f32x4 d = v[i] - mu; q += (d[0] * d[0] + d[1] * d[1]) + (d[2] * d[2] + d[3] * d[3]); }
#pragma unroll
    for (int o = 32; o >= 1; o >>= 1) q += __shfl_xor(q, o);
    const float rstd = 1.0f / sqrtf(q * (1.0f / 1024.0f) + LN_EPS);
#pragma unroll
    for (int i = 0; i < 4; ++i) {
        const f32x4 gg = *(const f32x4*)(g + i * 256 + lane * 4), bb = *(const f32x4*)(b + i * 256 + lane * 4);
        const f32x4 o = (v[i] - mu) * rstd * gg + bb;
        *(f32x4*)(x32 + i * 256 + lane * 4) = o; *(u32x2*)(xb + i * 256 + lane * 4) = pack4(o);
    }
}

__device__ __forceinline__ void tr_tile(LAS float* tile, const float* src, int Nsrc, bf16_t* dst, int K, int n0, int k0, int mode, int tid) {
    const int nn = tid & 63, np = n0 + nn; int sc;
    if (mode == 0) sc = np < C_U ? np : (np < C_DT ? np + 6 : (np < C_DT + 6 ? np - 512 : -1));
    else if (mode == 1) sc = np;
    else { const int pn = np >> 8, jj = np & 255; sc = jj < 128 ? pn * 128 + jj : DFF + pn * 128 + (jj - 128); }
#pragma unroll
    for (int i = 0; i < 8; ++i) { const int kk = (tid >> 6) + 8 * i; tile[kk * 65 + nn] = sc >= 0 ? src[(size_t)(k0 + kk) * Nsrc + sc] : 0.f; }
    __syncthreads();
    const int kk2 = (tid & 31) * 2;
#pragma unroll
    for (int i = 0; i < 4; ++i) { const int nn2 = (tid >> 5) + 16 * i; *(unsigned*)(dst + (size_t)(n0 + nn2) * K + k0 + kk2) = cvt_pk_bf16(tile[kk2 * 65 + nn2], tile[(kk2 + 1) * 65 + nn2]); }
    __syncthreads();
}

__device__ __forceinline__ void phase_prep(KP& p, LAS unsigned char* lds) {
    int tid_ = threadIdx.x; asm volatile("" : "+v"(tid_));
    const int tid = tid_, wid = tid >> 6, lane = tid & 63;
    for (int row = blockIdx.x * 8 + wid; row < T_ALL; row += gridDim.x * 8) {
        const float* src = row < T_P ? p.in[0] + (size_t)row * DM : p.in[1] + (size_t)(row - T_P) * DM;
        ln_row(src, p.out + (size_t)row * DM, (bf16_t*)(p.ws + W_XB) + (size_t)row * DM, p.in[7], p.in[8], lane);
    }
    constexpr int T_IN = 48 * 16, T_OUT = 16 * 16, T_UPT = 88 * 16, T_DNT = 16 * 44, T_L = T_IN + T_OUT + T_UPT + T_DNT;
    for (int it = blockIdx.x; it < 4 * T_L; it += gridDim.x) {
        const int l = it / T_L; int r = it % T_L;
        if (r < T_IN) tr_tile((LAS float*)lds, p.in[9] + (size_t)l * DM * 2950, 2950, (bf16_t*)(p.ws + W_IN + l * W_IN_L), DM, (r >> 4) * 64, (r & 15) * 64, 0, tid);
        else if ((r -= T_IN) < T_OUT) tr_tile((LAS float*)lds, p.in[19] + (size_t)l * DM * DM, DM, (bf16_t*)(p.ws + W_OUT + l * W_OUT_L), DM, (r >> 4) * 64, (r & 15) * 64, 1, tid);
        else if ((r -= T_OUT) < T_UPT) tr_tile((LAS float*)lds, p.in[22] + (size_t)l * DM * DFF2, DFF2, (bf16_t*)(p.ws + W_UP + l * W_UP_L), DM, (r >> 4) * 64, (r & 15) * 64, 2, tid);
        else { r -= T_UPT; tr_tile((LAS float*)lds, p.in[25] + (size_t)l * DFF * DM, DM, (bf16_t*)(p.ws + W_DN + l * W_DN_L), DFF, (r / 44) * 64, (r % 44) * 64, 1, tid); }
    }
    for (int i = blockIdx.x * 512 + tid; i < 4 * 4 * 128 * 128; i += gridDim.x * 512) {
        const int jj = i & 127, ii = (i >> 7) & 127;
        ((bf16_t*)(p.ws + W_GW))[i] = (bf16_t)(cvt_pk_bf16(jj <= ii ? p.in[16][i] : 0.f, 0.f) & 0xffffu);
    }
}

__device__ __forceinline__ void phase_ln(KP& p, const float* g, const float* b) {
    int tid_ = threadIdx.x; asm volatile("" : "+v"(tid_));
    const int wid = tid_ >> 6, lane = tid_ & 63;
    for (int row = blockIdx.x * 8 + wid; row < T_ALL; row += gridDim.x * 8)
        ln_row(p.out + (size_t)row * DM, p.out + (size_t)row * DM, (bf16_t*)(p.ws + W_XB) + (size_t)row * DM, g, b, lane);
}

__device__ __forceinline__ f32x4 conv4(KP& p, int l, int u, int i, int ch) {
    const bf16_t* proj = (const bf16_t*)(p.ws + W_PROJ);
    const int R0 = u * 64; const bool isP = u < 512; const bool hasprev = isP && (u & 127) != 0;
    const float* cw = p.in[11] + (size_t)l * 4 * 896 + ch;
    f32x4 y = *(const f32x4*)(p.in[12] + (size_t)l * 896 + ch);
#pragma unroll
    for (int j = 0; j < 4; ++j) {
        const int s = i - 3 + j; f32x4 xv;
        if (s >= 0 || hasprev) xv = unpack4(*(const u32x2*)(proj + (size_t)(R0 + s) * NPROJ + C_XBC + ch));
        else if (!isP) xv = *(const f32x4*)(p.in[5] + ((size_t)(l * 32 + (u - 512)) * 3 + (3 + s)) * 896 + ch);
        else xv = (f32x4){0.f, 0.f, 0.f, 0.f};
        y += *(const f32x4*)(cw + j * 896) * xv;
    }
#pragma unroll
    for (int j = 0; j < 4; ++j) y[j] = silu_f(y[j]);
    return y;
}
__device__ __forceinline__ void dt_scan(KP& p, int l, int u, int g, int wid, int lane, float& dt, float& ac, float& last) {
    const int h = g * 3 + wid;
    dt = ((const float*)(p.ws + W_DTB))[(size_t)(u * 64 + lane) * 8 + h];
    const float a = -__expf(p.in[14][l * 6 + h]);
    float v = dt * a;
#pragma unroll
    for (int o = 1; o < 64; o <<= 1) { const float t = __shfl_up(v, o); if (lane >= o) v += t; }
    ac = v; last = __shfl(v, 63);
}

__device__ __forceinline__ void ssd_states(KP& p, LAS unsigned char* lds, int l, int u, int g) {
    int tid_ = threadIdx.x; asm volatile("" : "+v"(tid_));
    const int tid = tid_, wid = tid >> 6, lane = tid & 63, fr = lane & 15, fq = lane >> 4;
    LAS bf16_t* xT = (LAS bf16_t*)lds;
    LAS bf16_t* BT = (LAS bf16_t*)(lds + 27648);
    LAS float* wgt = (LAS float*)(lds + 46080);
    __syncthreads();
    if (wid < 3) {
        float dt, ac, last; dt_scan(p, l, u, g, wid, lane, dt, ac, last);
        wgt[wid * 64 + lane] = dt * __expf(last - ac);
        if (lane == 0) ((float*)(p.ws + W_CD))[u * 8 + g * 3 + wid] = __expf(last);
    }
    __syncthreads();
#pragma unroll 1
    for (int it = 0; it < 10; ++it) {
        const int idx = it * 512 + tid, i = idx / 80, cgp = idx % 80;
        const int chl = cgp * 4;
        const int ch = chl < 192 ? g * 192 + chl : 384 + g * 128 + (chl - 192);
        const f32x4 y = conv4(p, l, u, i, ch);
        if (chl < 192) { const float w = wgt[(chl >> 6) * 64 + i];
#pragma unroll
            for (int e = 0; e < 4; ++e) xT[(chl + e) * 72 + i] = (bf16_t)(cvt_pk_bf16(y[e] * w, 0.f) & 0xffffu); }
        else {
#pragma unroll
            for (int e = 0; e < 4; ++e) BT[(chl - 192 + e) * 72 + i] = (bf16_t)(cvt_pk_bf16(y[e], 0.f) & 0xffffu); }
    }
    __syncthreads();
    bf16_t* ST = (bf16_t*)(p.ws + W_ST);
#pragma unroll 1
    for (int k = 0; k < 12; ++k) {
        const int tt = wid * 12 + k, hh = tt >> 5, pt = (tt & 31) >> 3, nt = tt & 7;
        f32x4 acc = (f32x4){0.f, 0.f, 0.f, 0.f};
#pragma unroll
        for (int ks = 0; ks < 2; ++ks) {
            const bf16x8 rf = ldsfrag((LAS const unsigned char*)(xT + (hh * 64 + pt * 16 + fr) * 72 + ks * 32 + fq * 8));
            const bf16x8 cf = ldsfrag((LAS const unsigned char*)(BT + (nt * 16 + fr) * 72 + ks * 32 + fq * 8));
            acc = MFMA16(cf, rf, acc);
        }
        *(u32x2*)(ST + ((size_t)(u * 6 + g * 3 + hh) * 64 + pt * 16 + fr) * 128 + nt * 16 + fq * 4) = pack4(acc);
    }
}

__device__ __forceinline__ void gmlp_unit(KP& p, LAS unsigned char* lds, int l, int u) {
    int tid_ = threadIdx.x; asm volatile("" : "+v"(tid_));
    const int tid = tid_, wid = tid >> 6, lane = tid & 63, fr = lane & 15, fq = lane >> 4;
    LAS bf16_t* vT = (LAS bf16_t*)lds;
    LAS float* ssq = (LAS float*)(lds + 69632);
    const bf16_t* proj = (const bf16_t*)(p.ws + W_PROJ);
    const int half = u < 512 ? (u & 1) : 0, KJ = (half + 1) * 64, R0 = u * 64, Rb = R0 - half * 64;
    __syncthreads();
    for (int idx = tid; idx < KJ * 32; idx += 512) {
        const int j = idx & (KJ - 1), cgp = idx / KJ;
        const u32x4 w = *(const u32x4*)(proj + (size_t)(Rb + j) * NPROJ + C_VC + cgp * 8);
        const unsigned ww[4] = {w.x, w.y, w.z, w.w};
#pragma unroll
        for (int e = 0; e < 4; ++e) { vT[(cgp * 8 + 2 * e) * 136 + j] = (bf16_t)(ww[e] & 0xffffu); vT[(cgp * 8 + 2 * e + 1) * 136 + j] = (bf16_t)(ww[e] >> 16); }
    }
    __syncthreads();
    const int rt = wid & 3, cbase = (wid >> 2) * 8;
    const bf16_t* GW = (const bf16_t*)(p.ws + W_GW + l * W_GW_L);
    f32x4 acc[8];
#pragma unroll
    for (int gi = 0; gi < 2; ++gi) {
        const int gg = (cbase >> 2) + gi;
        bf16x8 rf[4];
#pragma unroll
        for (int ks = 0; ks < 4; ++ks) rf[ks] = glbfrag(GW + ((size_t)gg * 128 + half * 64 + rt * 16 + fr) * 128 + ks * 32 + fq * 8);
#pragma unroll
        for (int c4 = 0; c4 < 4; ++c4) {
            const int ct = cbase + gi * 4 + c4;
            f32x4 a = (f32x4){0.f, 0.f, 0.f, 0.f};
#pragma unroll
            for (int ks = 0; ks < 4; ++ks) if (ks * 32 < KJ) a = MFMA16(ldsfrag((LAS const unsigned char*)(vT + (ct * 16 + fr) * 136 + ks * 32 + fq * 8)), rf[ks], a);
            acc[gi * 4 + c4] = a;
        }
    }
    const int row = R0 + rt * 16 + fr; float sq = 0.f;
#pragma unroll
    for (int k = 0; k < 8; ++k) {
        const int col = (cbase + k) * 16 + fq * 4, gg = col >> 6;
        const float bsv = p.in[17][(size_t)(l * 4 + gg) * 128 + half * 64 + rt * 16 + fr];
        const f32x4 uv = unpack4(*(const u32x2*)(proj + (size_t)row * NPROJ + C_U + col));
        f32x4 o = uv * (acc[k] + bsv); acc[k] = o;
        sq += (o[0] * o[0] + o[1] * o[1]) + (o[2] * o[2] + o[3] * o[3]);
    }
    sq += __shfl_xor(sq, 16); sq += __shfl_xor(sq, 32);
    if (fq == 0) ssq[(wid >> 2) * 64 + rt * 16 + fr] = sq;
    __syncthreads();
    const float rstd = 1.0f / sqrtf((ssq[rt * 16 + fr] + ssq[64 + rt * 16 + fr]) * (1.0f / 256.0f) + RMS_EPS);
    bf16_t* mix = (bf16_t*)(p.ws + W_MIX);
#pragma unroll
    for (int k = 0; k < 8; ++k) {
        const int col = (cbase + k) * 16 + fq * 4;
        const f32x4 gv = *(const f32x4*)(p.in[18] + (size_t)l * 1024 + 768 + col);
        *(u32x2*)(mix + (size_t)row * DM + 768 + col) = pack4(acc[k] * rstd * gv);
    }
}

__device__ __forceinline__ void scan_prompt(KP& p, int l, int item) {
    int tid_ = threadIdx.x; asm volatile("" : "+v"(tid_));
    const int gid = item * 512 + tid_, e = (gid & 2047) * 4, bh = gid >> 11, b = bh / 6, h = bh % 6;
    bf16_t* ST = (bf16_t*)(p.ws + W_ST); const float* CD = (const float*)(p.ws + W_CD);
    f32x4 st = (f32x4){0.f, 0.f, 0.f, 0.f};
#pragma unroll 1
    for (int c0 = 0; c0 < 128; c0 += 8) {
        u32x2 s[8]; float cd[8];
#pragma unroll
        for (int k = 0; k < 8; ++k) { const int u = b * 128 + c0 + k; s[k] = *(const u32x2*)(ST + ((size_t)(u * 6 + h)) * 8192 + e); cd[k] = CD[u * 8 + h]; }
#pragma unroll
        for (int k = 0; k < 8; ++k) { const int u = b * 128 + c0 + k; *(u32x2*)(ST + ((size_t)(u * 6 + h)) * 8192 + e) = pack4(st); st = st * cd[k] + unpack4(s[k]); }
    }
    *(f32x4*)(p.out + O_PH + ((size_t)(l * 4 + b) * 6 + h) * 8192 + e) = st;
}
__device__ __forceinline__ void scan_sample(KP& p, int l, int item) {
    int tid_ = threadIdx.x; asm volatile("" : "+v"(tid_));
    const int gid = item * 512 + tid_, e = (gid & 2047) * 4, sbh = gid >> 11, sb = sbh / 6, h = sbh % 6;
    bf16_t* ST = (bf16_t*)(p.ws + W_ST); const float* CD = (const float*)(p.ws + W_CD);
    const int u = 512 + sb;
    const f32x4 st = *(const f32x4*)(p.in[4] + ((size_t)(l * 32 + sb) * 6 + h) * 8192 + e);
    const f32x4 s = unpack4(*(const u32x2*)(ST + ((size_t)(u * 6 + h)) * 8192 + e));
    *(u32x2*)(ST + ((size_t)(u * 6 + h)) * 8192 + e) = pack4(st);
    *(f32x4*)(p.out + O_SH + ((size_t)(l * 32 + sb) * 6 + h) * 8192 + e) = st * CD[u * 8 + h] + s;
}

__device__ __forceinline__ void attn_unit(KP& p, LAS unsigned char* lds, int l, int u) {
    int tid_ = threadIdx.x; asm volatile("" : "+v"(tid_));
    const int tid = tid_, wid = tid >> 6, lane = tid & 63, fr = lane & 15, fq = lane >> 4;
    LAS bf16_t* Kb = (LAS bf16_t*)lds;
    LAS bf16_t* VT = (LAS bf16_t*)(lds + 50176);
    LAS bf16_t* Pw = (LAS bf16_t*)(lds + 105472) + wid * 16 * 72;
    LAS float* bias = (LAS float*)(lds + 123904);
    LAS float* ssq = (LAS float*)(lds + 128512);
    const bf16_t* proj = (const bf16_t*)(p.ws + W_PROJ);
    const bool isP = u < 512; const int R0 = u * 64, c = u & 127, b = u >> 7, sb = u - 512;
    const int qt = wid & 3, hbase = (wid >> 2) * 3;
    __syncthreads();
    for (int i = tid; i < 1152; i += 512) bias[i] = p.in[10][(size_t)l * 1152 + i];
    bf16x8 qf[3][2];
#pragma unroll
    for (int hh = 0; hh < 3; ++hh)
#pragma unroll
        for (int ks = 0; ks < 2; ++ks) qf[hh][ks] = glbfrag(proj + (size_t)(R0 + qt * 16 + fr) * NPROJ + (hbase + hh) * 64 + ks * 32 + fq * 8);
    float mrun[3], lrun[3]; f32x4 O[3][4];
#pragma unroll
    for (int hh = 0; hh < 3; ++hh) { mrun[hh] = -1e30f; lrun[hh] = 0.f;
#pragma unroll
        for (int d = 0; d < 4; ++d) O[hh][d] = (f32x4){0.f, 0.f, 0.f, 0.f}; }
    const int blk_lo = isP ? (c < 8 ? 8 - c : 0) : 0;
#pragma unroll 1
    for (int blk = blk_lo; blk <= 8; ++blk) {
        __syncthreads();
        const bool fromproj = isP || blk == 8;
        const size_t rowbase = isP ? (size_t)b * 8192 + (size_t)(c - 8 + blk) * 64 : (size_t)T_P + (size_t)sb * 64;
#pragma unroll 1
        for (int it = 0; it < 6; ++it) {
            const int idx = it * 512 + tid;
            { const int key = idx / 48, cgp = idx % 48; u32x4 w;
              if (fromproj) w = *(const u32x4*)(proj + (rowbase + key) * NPROJ + C_K + cgp * 8);
              else { const float* s = p.in[2] + ((size_t)(l * 32 + sb) * 512 + blk * 64 + key) * 384 + cgp * 8; const f32x4 a = *(const f32x4*)s, bq = *(const f32x4*)(s + 4);
                     w.x = cvt_pk_bf16(a[0], a[1]); w.y = cvt_pk_bf16(a[2], a[3]); w.z = cvt_pk_bf16(bq[0], bq[1]); w.w = cvt_pk_bf16(bq[2], bq[3]); }
              *(LAS u32x4*)(Kb + key * 392 + cgp * 8) = w; }
            { const int key = idx & 63, cgp = idx >> 6; u32x4 w;
              if (fromproj) w = *(const u32x4*)(proj + (rowbase + key) * NPROJ + C_V + cgp * 8);
              else { const float* s = p.in[3] + ((size_t)(l * 32 + sb) * 512 + blk * 64 + key) * 384 + cgp * 8; const f32x4 a = *(const f32x4*)s, bq = *(const f32x4*)(s + 4);
                     w.x = cvt_pk_bf16(a[0], a[1]); w.y = cvt_pk_bf16(a[2], a[3]); w.z = cvt_pk_bf16(bq[0], bq[1]); w.w = cvt_pk_bf16(bq[2], bq[3]); }
              const unsigned ww[4] = {w.x, w.y, w.z, w.w};
#pragma unroll
              for (int e = 0; e < 4; ++e) { VT[(cgp * 8 + 2 * e) * 72 + key] = (bf16_t)(ww[e] & 0xffffu); VT[(cgp * 8 + 2 * e + 1) * 72 + key] = (bf16_t)(ww[e] >> 16); } }
        }
        __syncthreads();
#pragma unroll
        for (int hh = 0; hh < 3; ++hh) {
            const int h = hbase + hh;
            f32x4 s[4]; float mx = -1e30f;
#pragma unroll
            for (int kt = 0; kt < 4; ++kt) {
                f32x4 a = (f32x4){0.f, 0.f, 0.f, 0.f};
#pragma unroll
                for (int ks = 0; ks < 2; ++ks) a = MFMA16(ldsfrag((LAS const unsigned char*)(Kb + (kt * 16 + fr) * 392 + h * 64 + ks * 32 + fq * 8)), qf[hh][ks], a);
#pragma unroll
                for (int j = 0; j < 4; ++j) {
                    int rel = (qt * 16 + fr) + 512 - (blk * 64 + kt * 16 + fq * 4 + j); rel = rel > 128 ? 128 : rel;
                    a[j] = a[j] * 0.125f + bias[h * 192 + rel + 63]; mx = fmaxf(mx, a[j]);
                }
                s[kt] = a;
            }
            mx = fmaxf(mx, __shfl_xor(mx, 16)); mx = fmaxf(mx, __shfl_xor(mx, 32));
            const float mnew = fmaxf(mrun[hh], mx), fac = __expf(mrun[hh] - mnew); mrun[hh] = mnew;
            float rs = 0.f;
#pragma unroll
            for (int kt = 0; kt < 4; ++kt) {
#pragma unroll
                for (int j = 0; j < 4; ++j) { s[kt][j] = __expf(s[kt][j] - mnew); rs += s[kt][j]; }
                *(LAS u32x2*)(Pw + fr * 72 + kt * 16 + fq * 4) = pack4(s[kt]);
            }
            rs += __shfl_xor(rs, 16); rs += __shfl_xor(rs, 32);
            lrun[hh] = lrun[hh] * fac + rs;
#pragma unroll
            for (int d = 0; d < 4; ++d) O[hh][d] *= fac;
            LDS_WAVE_SYNC();
#pragma unroll
            for (int ks = 0; ks < 2; ++ks) {
                const bf16x8 pf = ldsfrag((LAS const unsigned char*)(Pw + fr * 72 + ks * 32 + fq * 8));
#pragma unroll
                for (int d = 0; d < 4; ++d) O[hh][d] = MFMA16(ldsfrag((LAS const unsigned char*)(VT + (h * 64 + d * 16 + fr) * 72 + ks * 32 + fq * 8)), pf, O[hh][d]);
            }
            LDS_WAVE_SYNC();
        }
    }
    float sq = 0.f;
#pragma unroll
    for (int hh = 0; hh < 3; ++hh) { const float inv = 1.0f / lrun[hh];
#pragma unroll
        for (int d = 0; d < 4; ++d) { O[hh][d] *= inv; const f32x4 o = O[hh][d]; sq += (o[0] * o[0] + o[1] * o[1]) + (o[2] * o[2] + o[3] * o[3]); } }
    sq += __shfl_xor(sq, 16); sq += __shfl_xor(sq, 32);
    if (fq == 0) ssq[(wid >> 2) * 64 + qt * 16 + fr] = sq;
    __syncthreads();
    const float rstd = 1.0f / sqrtf((ssq[qt * 16 + fr] + ssq[64 + qt * 16 + fr]) * (1.0f / 384.0f) + RMS_EPS);
    bf16_t* mix = (bf16_t*)(p.ws + W_MIX);
#pragma unroll
    for (int hh = 0; hh < 3; ++hh)
#pragma unroll
        for (int d = 0; d < 4; ++d) {
            const int col = (hbase + hh) * 64 + d * 16 + fq * 4;
            const f32x4 gv = *(const f32x4*)(p.in[18] + (size_t)l * 1024 + col);
            *(u32x2*)(mix + (size_t)(R0 + qt * 16 + fr) * DM + col) = pack4(O[hh][d] * rstd * gv);
        }
}

__device__ __forceinline__ void ssd_y(KP& p, LAS unsigned char* lds, int l, int u) {
    int tid_ = threadIdx.x; asm volatile("" : "+v"(tid_));
    const int tid = tid_, wid = tid >> 6, lane = tid & 63, fr = lane & 15, fq = lane >> 4;
    LAS bf16_t* Cn = (LAS bf16_t*)lds;
    LAS bf16_t* Bn = (LAS bf16_t*)(lds + 17408);
    LAS bf16_t* xT = (LAS bf16_t*)(lds + 34816);
    LAS bf16_t* xn = (LAS bf16_t*)(lds + 62464);
    LAS bf16_t* Mm = (LAS bf16_t*)(lds + 88064);
    LAS float* dtl = (LAS float*)(lds + 115712);
    LAS float* acl = (LAS float*)(lds + 116480);
    LAS float* ssq = (LAS float*)(lds + 117248);
    const bf16_t* proj = (const bf16_t*)(p.ws + W_PROJ);
    const bf16_t* HP = (const bf16_t*)(p.ws + W_ST);
    const int R0 = u * 64, lt = wid & 3;
    f32x4 yacc[2][6];
#pragma unroll
    for (int g = 0; g < 2; ++g) {
        __syncthreads();
        if (wid < 3) { float dt, ac, last; dt_scan(p, l, u, g, wid, lane, dt, ac, last); dtl[wid * 64 + lane] = dt; acl[wid * 64 + lane] = ac; }
        __syncthreads();
#pragma unroll 1
        for (int it = 0; it < 14; ++it) {
            const int idx = it * 512 + tid, i = idx / 112, cgp = idx % 112;
            const int chl = cgp * 4;
            const int ch = chl < 192 ? g * 192 + chl : (chl < 320 ? 384 + g * 128 + (chl - 192) : 640 + g * 128 + (chl - 320));
            const f32x4 y = conv4(p, l, u, i, ch);
            if (chl < 192) { const float dt = dtl[(chl >> 6) * 64 + i];
                *(LAS u32x2*)(xn + i * 200 + chl) = pack4(y);
#pragma unroll
                for (int e = 0; e < 4; ++e) xT[(chl + e) * 72 + i] = (bf16_t)(cvt_pk_bf16(y[e] * dt, 0.f) & 0xffffu); }
            else if (chl < 320) *(LAS u32x2*)(Bn + i * 136 + (chl - 192)) = pack4(y);
            else *(LAS u32x2*)(Cn + i * 136 + (chl - 320)) = pack4(y);
        }
        __syncthreads();
#pragma unroll
        for (int k = 0; k < 2; ++k) {
            const int st = (wid >> 2) * 2 + k;
            f32x4 a = (f32x4){0.f, 0.f, 0.f, 0.f};
#pragma unroll
            for (int ks = 0; ks < 4; ++ks) a = MFMA16(ldsfrag((LAS const unsigned char*)(Bn + (st * 16 + fr) * 136 + ks * 32 + fq * 8)), ldsfrag((LAS const unsigned char*)(Cn + (lt * 16 + fr) * 136 + ks * 32 + fq * 8)), a);
            const int li = lt * 16 + fr;
#pragma unroll
            for (int hh = 0; hh < 3; ++hh) {
                const float al = acl[hh * 64 + li]; f32x4 mv;
#pragma unroll
                for (int j = 0; j < 4; ++j) { const int si = st * 16 + fq * 4 + j; mv[j] = si <= li ? a[j] * __expf(al - acl[hh * 64 + si]) : 0.f; }
                *(LAS u32x2*)(Mm + (hh * 64 + li) * 72 + st * 16 + fq * 4) = pack4(mv);
            }
        }
        __syncthreads();
#pragma unroll
        for (int k = 0; k < 6; ++k) {
            const int ctile = (wid >> 2) * 6 + k, hh = ctile >> 2, pt = ctile & 3, h = g * 3 + hh, li = lt * 16 + fr;
            f32x4 ad = (f32x4){0.f, 0.f, 0.f, 0.f}, ao = (f32x4){0.f, 0.f, 0.f, 0.f};
#pragma unroll
            for (int ks = 0; ks < 2; ++ks) ad = MFMA16(ldsfrag((LAS const unsigned char*)(xT + (hh * 64 + pt * 16 + fr) * 72 + ks * 32 + fq * 8)), ldsfrag((LAS const unsigned char*)(Mm + (hh * 64 + li) * 72 + ks * 32 + fq * 8)), ad);
#pragma unroll
            for (int ks = 0; ks < 4; ++ks) ao = MFMA16(glbfrag(HP + ((size_t)(u * 6 + h) * 64 + pt * 16 + fr) * 128 + ks * 32 + fq * 8), ldsfrag((LAS const unsigned char*)(Cn + li * 136 + ks * 32 + fq * 8)), ao);
            const float ea = __expf(acl[hh * 64 + li]), dsk = p.in[15][l * 6 + h];
            const f32x4 xv = unpack4(*(const LAS u32x2*)(xn + li * 200 + hh * 64 + pt * 16 + fq * 4));
            const f32x4 zv = unpack4(*(const u32x2*)(proj + (size_t)(R0 + li) * NPROJ + C_Z + h * 64 + pt * 16 + fq * 4));
            f32x4 y = ad + ao * ea + xv * dsk;
#pragma unroll
            for (int j = 0; j < 4; ++j) y[j] *= silu_f(zv[j]);
            yacc[g][k] = y;
            asm volatile("" ::: "memory");
        }
    }
    float sq = 0.f;
#pragma unroll
    for (int g = 0; g < 2; ++g)
#pragma unroll
        for (int k = 0; k < 6; ++k) { const f32x4 o = yacc[g][k]; sq += (o[0] * o[0] + o[1] * o[1]) + (o[2] * o[2] + o[3] * o[3]); }
    sq += __shfl_xor(sq, 16); sq += __shfl_xor(sq, 32);
    if (fq == 0) ssq[(wid >> 2) * 64 + lt * 16 + fr] = sq;
    __syncthreads();
    const float rstd = 1.0f / sqrtf((ssq[lt * 16 + fr] + ssq[64 + lt * 16 + fr]) * (1.0f / 384.0f) + RMS_EPS);
    bf16_t* mix = (bf16_t*)(p.ws + W_MIX);
#pragma unroll
    for (int g = 0; g < 2; ++g)
#pragma unroll
        for (int k = 0; k < 6; ++k) {
            const int col = 384 + g * 192 + ((wid >> 2) * 6 + k) * 16 + fq * 4;
            const f32x4 gv = *(const f32x4*)(p.in[18] + (size_t)l * 1024 + col);
            *(u32x2*)(mix + (size_t)(R0 + lt * 16 + fr) * DM + col) = pack4(yacc[g][k] * rstd * gv);
        }
}

__device__ __forceinline__ void phase_fix(KP& p, int l) {
    const float* halo = (const float*)(p.ws + W_MIX); bf16_t* H = (bf16_t*)(p.ws + W_PROJ);
    const float* w = p.in[23] + (size_t)l * 3 * DFF2; const float* bb = p.in[24] + (size_t)l * DFF2;
    int tid_ = threadIdx.x; asm volatile("" : "+v"(tid_));
    for (int i = blockIdx.x * 512 + tid_; i < 128 * DFF2; i += gridDim.x * 512) {
        const int pm = i / DFF2, cc = i % DFF2;
        if ((pm & 31) == 0 || cc >= DFF) continue;
        const float* h0 = halo + (size_t)(pm - 1) * 4 * DFF2; const float* h1 = halo + (size_t)pm * 4 * DFF2;
        float r[2];
#pragma unroll
        for (int rr = 0; rr < 2; ++rr) {
            float o[2];
#pragma unroll
            for (int gv = 0; gv < 2; ++gv) {
                const int c2 = cc + gv * DFF;
                const float xm2 = h0[2 * DFF2 + c2], xm1 = h0[3 * DFF2 + c2], x0 = h1[c2], x1 = h1[DFF2 + c2];
                o[gv] = rr == 0 ? bb[c2] + w[c2] * xm2 + w[DFF2 + c2] * xm1 + w[2 * DFF2 + c2] * x0 : bb[c2] + w[c2] * xm1 + w[DFF2 + c2] * x0 + w[2 * DFF2 + c2] * x1;
            }
            r[rr] = silu_f(o[0]) * o[1];
        }
        H[((size_t)pm * 256) * DFF + cc] = (bf16_t)(cvt_pk_bf16(r[0], 0.f) & 0xffffu);
        H[((size_t)pm * 256 + 1) * DFF + cc] = (bf16_t)(cvt_pk_bf16(r[1], 0.f) & 0xffffu);
    }
}

__global__ void __launch_bounds__(512, 2) mega(Params pa) {
    extern __shared__ __attribute__((aligned(16))) unsigned char shm[];
    LAS unsigned char* lds = (LAS unsigned char*)shm;
    const int G = gridDim.x, bid = blockIdx.x;
    KP* pk = (KP*)__builtin_amdgcn_kernarg_segment_ptr();
    for (int ph = pa.ph_lo; ph < pa.ph_hi; ++ph) {
        if (ph > pa.ph_lo && pa.coop) { __threadfence(); cg::this_grid().sync(); }
        asm volatile("" : "+s"(pk)); KP& p = *pk;
        if (ph == 0) { phase_prep(p, lds); continue; }
        if (ph == 42) { int tq = threadIdx.x; asm volatile("" : "+v"(tq)); const unsigned short* w16 = (const unsigned short*)p.ws; for (size_t i = (size_t)bid * 512 + tq; i < (size_t)59418624; i += (size_t)G * 512) p.out[i] = (float)w16[i * 4]; continue; }
        if (ph == 41) { int tq = threadIdx.x; asm volatile("" : "+v"(tq)); for (size_t i = (size_t)bid * 512 + tq; i < (size_t)59418624; i += (size_t)G * 512) { const float v = p.out[i]; if (!(fabsf(v) < 1e30f)) p.out[i] = 0.f; } continue; }
        const int l = (ph - 1) / 10, k = (ph - 1) % 10;
        bf16_t* XB = (bf16_t*)(p.ws + W_XB);
        switch (k) {
        case 0: { pg8::StaticOrder S; S.init(T_ALL, NPROJ, G, bid);
                  EpiIn E{(bf16_t*)(p.ws + W_PROJ), p.out, (float*)(p.ws + W_DTB), p.in[13], l};
                  pg8::gemm_phase(lds, pg8::Gemm{XB, (const bf16_t*)(p.ws + W_IN + l * W_IN_L), T_ALL, NPROJ, DM}, S, E); } break;
        case 1: for (int it = bid; it < 3 * NU64; it += G) { if (it < 2 * NU64) { if (M1_MASK & 1) ssd_states(p, lds, l, it >> 1, it & 1); } else if (M1_MASK & 2) gmlp_unit(p, lds, l, it - 2 * NU64); } break;
        case 2: for (int it = bid; it < 96 + NU64 + 768; it += G) { if (it < 96) scan_prompt(p, l, it); else if (it < 96 + NU64) attn_unit(p, lds, l, it - 96); else scan_sample(p, l, it - 96 - NU64); } break;
        case 3: for (int it = bid; it < NU64; it += G) ssd_y(p, lds, l, it); break;
        case 4: { pg8::StaticOrder S; S.init(T_ALL, DM, G, bid); EpiRes E{p.out};
                  pg8::gemm_phase(lds, pg8::Gemm{(const bf16_t*)(p.ws + W_MIX), (const bf16_t*)(p.ws + W_OUT + l * W_OUT_L), T_ALL, DM, DM}, S, E); } break;
        case 5: phase_ln(p, p.in[20] + l * DM, p.in[21] + l * DM); break;
        case 6: { pg8::StaticOrder S; S.init(T_ALL, DFF2, G, bid);
                  EpiUp E{(bf16_t*)(p.ws + W_PROJ), (float*)(p.ws + W_MIX), p.out, p.in[23], p.in[24], p.in[6], l};
                  pg8::OneUnit o1;
                  for (int i = 0; S.next(i, o1.u); ++i) { pg8::gemm_phase(lds, pg8::Gemm{XB, (const bf16_t*)(p.ws + W_UP + l * W_UP_L), T_ALL, DFF2, DM}, o1, E); __syncthreads(); } } break;
        case 7: phase_fix(p, l); break;
        case 8: { pg8::StaticOrder S; S.init(T_ALL, DM, G, bid); EpiRes E{p.out};
                  pg8::gemm_phase(lds, pg8::Gemm{(const bf16_t*)(p.ws + W_PROJ), (const bf16_t*)(p.ws + W_DN + l * W_DN_L), T_ALL, DM, DFF}, S, E); } break;
        case 9: phase_ln(p, p.in[26] + l * DM, p.in[27] + l * DM); break;
        }
    }
}

constexpr int N_PHASES = 41;
#ifndef MULTI_LAUNCH
#define MULTI_LAUNCH 0
#endif

extern "C" void kernel_launch(void* const* d_in, const int* in_sizes, int n_in, void* d_out, int out_size, void* d_ws, size_t ws_size, hipStream_t stream) {
    static int grid = 0;
    if (grid == 0) {
        if (n_in != 28 || ws_size < W_END) { fprintf(stderr, "kernel_launch: need 28 inputs and %zu bytes of workspace (got %d, %zu)\n", (size_t)W_END, n_in, ws_size); grid = -1; return; }
        int dev = 0, cus = 0, per_cu = 0;
        hipGetDevice(&dev); hipDeviceGetAttribute(&cus, hipDeviceAttributeMultiprocessorCount, dev);
        if (hipFuncSetAttribute((const void*)mega, hipFuncAttributeMaxDynamicSharedMemorySize, LDS_BYTES) != hipSuccess) { fprintf(stderr, "kernel_launch: hipFuncSetAttribute failed\n"); grid = -1; return; }
        hipOccupancyMaxActiveBlocksPerMultiprocessor(&per_cu, (const void*)mega, 512, LDS_BYTES);
        (void)hipGetLastError();
        if (per_cu < 1) per_cu = 1;
        grid = cus * 1;
    }
    if (grid < 0) return;
    Params p{};
    for (int i = 0; i < 28; ++i) p.in[i] = (const float*)d_in[i];
    p.out = (float*)d_out; p.ws = (unsigned char*)d_ws;
#if MULTI_LAUNCH
#ifdef PROBE_CUT
    for (int ph = 0; ph < PROBE_CUT; ++ph) { p.ph_lo = ph; p.ph_hi = ph + 1; p.coop = 0; hipLaunchKernelGGL(mega, dim3(grid), dim3(512), LDS_BYTES, stream, p); }
    p.ph_lo = 42; p.ph_hi = 43; p.coop = 0; hipLaunchKernelGGL(mega, dim3(grid), dim3(512), LDS_BYTES, stream, p);
#else
    for (int ph = 0; ph < N_PHASES; ++ph) { p.ph_lo = ph; p.ph_hi = ph + 1; p.coop = 0; hipLaunchKernelGGL(mega, dim3(grid), dim3(512), LDS_BYTES, stream, p); }
#endif
#else
    p.ph_lo = 0; p.ph_hi = N_PHASES; p.coop = 1;
    void* args[] = {&p};
    hipError_t e = hipLaunchCooperativeKernel((const void*)mega, dim3(grid), dim3(512), args, LDS_BYTES, stream);
    if (e != hipSuccess) fprintf(stderr, "cooperative launch failed: %s (grid %d)\n", hipGetErrorString(e), grid);
#endif
}
```

```cpp
#define M1_MASK 3
#include <hip/hip_runtime.h>
#include <hip/hip_cooperative_groups.h>
#include <cstdio>
namespace cg = cooperative_groups;

#define LAS __attribute__((address_space(3)))
typedef unsigned short bf16_t;
typedef short bf16x8 __attribute__((ext_vector_type(8)));
typedef float f32x4 __attribute__((ext_vector_type(4)));
typedef float f32x2 __attribute__((ext_vector_type(2)));
typedef unsigned u32x4 __attribute__((ext_vector_type(4)));
typedef unsigned u32x2 __attribute__((ext_vector_type(2)));

constexpr int T_ALL = 34816, T_P = 32768, DM = 1024, NPROJ = 3072, DFF = 2816, DFF2 = 5632, DEPTH = 4;
constexpr int NU64 = 544;
constexpr float ALPHA = 1.6817928305074290f;
constexpr float LN_EPS = 1e-5f, RMS_EPS = 1e-5f;
constexpr int C_K = 384, C_V = 768, C_Z = 1152, C_XBC = 1536, C_U = 2432, C_VC = 2688, C_DT = 2944;
constexpr size_t O_YP = 0, O_YS = 33554432, O_PK = 35651584, O_PV = O_PK + 3145728, O_PH = O_PV + 3145728, O_PC = O_PH + 786432,
                 O_PF = O_PC + 43008, O_SK = O_PF + 180224, O_SV = O_SK + 3145728, O_SH = O_SV + 3145728, O_SC = O_SH + 6291456,
                 O_SG = O_SC + 344064, O_SF = O_SG + 2097152;
constexpr size_t W_IN = 0, W_IN_L = (size_t)NPROJ * DM * 2;
constexpr size_t W_OUT = W_IN + 4 * W_IN_L, W_OUT_L = (size_t)DM * DM * 2;
constexpr size_t W_UP = W_OUT + 4 * W_OUT_L, W_UP_L = (size_t)DFF2 * DM * 2;
constexpr size_t W_DN = W_UP + 4 * W_UP_L, W_DN_L = (size_t)DM * DFF * 2;
constexpr size_t W_GW = W_DN + 4 * W_DN_L, W_GW_L = (size_t)4 * 128 * 128 * 2;
constexpr size_t W_XB = W_GW + 4 * W_GW_L;
constexpr size_t W_PROJ = W_XB + (size_t)T_ALL * DM * 2;
constexpr size_t W_MIX = W_PROJ + (size_t)T_ALL * NPROJ * 2;
constexpr size_t W_ST = W_MIX + (size_t)T_ALL * DM * 2;
constexpr size_t W_CD = W_ST + (size_t)NU64 * 6 * 8192 * 2;
constexpr size_t W_DTB = W_CD + (size_t)NU64 * 8 * 4;
constexpr size_t W_END = W_DTB + (size_t)T_ALL * 8 * 4;
constexpr size_t W_BAR = W_END;
constexpr size_t W_END2 = W_BAR + 16384;
constexpr int LDS_BYTES = 136 * 1024;

struct Params { const float* in[28]; float* out; unsigned char* ws; int ph_lo, ph_hi, coop, pad; };
typedef const __attribute__((address_space(4))) Params KP;

__device__ __forceinline__ float bf2f(unsigned b) { return __uint_as_float(b << 16); }
typedef __bf16 bf16v2 __attribute__((ext_vector_type(2)));
__device__ __forceinline__ unsigned cvt_pk_bf16(float lo, float hi) { const f32x2 v = {lo, hi}; const bf16v2 b = __builtin_convertvector(v, bf16v2); return __builtin_bit_cast(unsigned, b); }
__device__ __forceinline__ u32x2 pack4(f32x4 v) { u32x2 w; w.x = cvt_pk_bf16(v[0], v[1]); w.y = cvt_pk_bf16(v[2], v[3]); return w; }
__device__ __forceinline__ f32x4 unpack4(u32x2 w) { f32x4 v; v[0] = bf2f(w.x & 0xffffu); v[1] = bf2f(w.x >> 16); v[2] = bf2f(w.y & 0xffffu); v[3] = bf2f(w.y >> 16); return v; }
__device__ __forceinline__ float silu_f(float x) { return x / (1.0f + __expf(-x)); }
__device__ __forceinline__ float gelu_tanh(float x) { const float y = 0.7978845608028654f * (x + 0.044715f * x * x * x); const float e = __expf(2.0f * y); return 0.5f * x * (2.0f - 2.0f / (1.0f + e)); }
__device__ __forceinline__ float softplus_f(float x) { const float e = __expf(x); return x > 15.0f ? x : (e < 1e-3f ? e * (1.0f - 0.5f * e + 0.33333333f * e * e) : __logf(1.0f + e)); }
#define MFMA16(colfrag, rowfrag, acc) __builtin_amdgcn_mfma_f32_16x16x32_bf16((colfrag), (rowfrag), (acc), 0, 0, 0)
__device__ __forceinline__ bf16x8 ldsfrag(LAS const unsigned char* p) { return *(LAS const bf16x8*)p; }
__device__ __forceinline__ bf16x8 glbfrag(const bf16_t* p) { return *(const bf16x8*)p; }
#define LDS_WAVE_SYNC() asm volatile("s_waitcnt lgkmcnt(0)" ::: "memory")

namespace pg8 {
constexpr int BM = 256, BK = 64, HALF = 128, HTB = HALF * BK * 2, STAGE_BYTES = 8 * HTB, NXCD = 8, WGM = 8;
__device__ __forceinline__ int lds_byte(int r, int c) { const int st = (r >> 4) * 2 + (c >> 5), rr = r & 15, cc = c & 31, ob = rr * 64 + cc * 2; return st * 1024 + (ob ^ (((ob >> 9) & 1) << 5)); }
__device__ __forceinline__ void stage_rc(int b, int& R, int& C) { const int st = b / 1024, sb = b % 1024, swz = sb ^ (((sb >> 9) & 1) << 5); R = (st >> 1) * 16 + swz / 64; C = (st & 1) * 32 + (swz % 64) / 2; }
struct Unit { int pm, pn; };
struct Gemm { const bf16_t* A; const bf16_t* Bt; int M, N, K; };
struct StaticOrder {
    int nM, nN, nwg, G, c;
    __device__ __forceinline__ void init(int M, int N, int G_, int c_) { nM = M / BM; nN = N / BM; nwg = nM * nN; G = G_; c = c_; }
    __device__ __forceinline__ bool next(int i, Unit& u) const {
        const long L = (long)i * G + c; if (L >= nwg) return false;
        int wgid = (int)L; { const int q = nwg / NXCD, r = nwg % NXCD, xcd = wgid % NXCD, off = wgid / NXCD; wgid = (xcd < r ? xcd * (q + 1) : r * (q + 1) + (xcd - r) * q) + off; }
        const int nig = WGM * nN, gid = wgid / nig, fm = gid * WGM, gsz = (nM - fm) < WGM ? (nM - fm) : WGM;
        u.pm = fm + ((wgid % nig) % gsz); u.pn = (wgid % nig) / gsz; return true;
    }
    __device__ __forceinline__ void a_ready(const Unit&) const {}
    __device__ __forceinline__ void done(const Unit&) const {}
};
struct OneUnit {
    Unit u;
    __device__ __forceinline__ bool next(int i, Unit& o) const { if (i) return false; o = u; return true; }
    __device__ __forceinline__ void a_ready(const Unit&) const {}
    __device__ __forceinline__ void done(const Unit&) const {}
};

template <class Epi, class Sched>
__device__ __forceinline__ void gemm_phase(LAS unsigned char* lds, const Gemm g, const Sched& S, const Epi& E) {
    int tid_ = threadIdx.x; asm volatile("" : "+v"(tid_));
    const int tid = tid_, wid = __builtin_amdgcn_readfirstlane(tid >> 6), lane = tid & 63, wr = wid >> 2, wc = wid & 3, fr = lane & 15, fq = lane >> 4;
    const int K = g.K, nt = K / BK;
    unsigned voffA[2];
#pragma unroll
    for (int i = 0; i < 2; ++i) { int R, C; stage_rc(tid * 16 + i * 8192, R, C); voffA[i] = (unsigned)(R * K + C) * 2u; }
    const size_t kstep = (size_t)(BK * 2);
    const size_t hstep = (size_t)HALF * K * 2;
    const size_t tstep = 2 * hstep;
    const unsigned ldsw = (unsigned)wid * 1024u;
    const int aoff = lds_byte(wr * 64 + fr, fq * 8), boff = lds_byte(wc * 32 + fr, fq * 8);
#define PG8_SA(b, h) (((b) * 2 + (h)) * HTB)
#define PG8_SB(b, h) ((4 + (b) * 2 + (h)) * HTB)
#define PG8_STAGE(bufoff, gbase, voff) do { _Pragma("unroll") for (int _i = 0; _i < 2; ++_i) \
        __builtin_amdgcn_global_load_lds((const unsigned*)((const char*)(gbase) + (voff)[_i]), (LAS unsigned*)(lds + (bufoff) + ldsw + _i * 8192), 16, 0, 0); } while (0)
#define PG8_LDA(dst, b, h) do { _Pragma("unroll") for (int m = 0; m < 4; ++m) _Pragma("unroll") for (int k = 0; k < 2; ++k) dst[m][k] = *(const LAS bf16x8*)(lds + PG8_SA(b, h) + aoff + m * 2048 + k * 1024); } while (0)
#define PG8_LDB(dst, b, h) do { _Pragma("unroll") for (int n = 0; n < 2; ++n) _Pragma("unroll") for (int k = 0; k < 2; ++k) dst[n][k] = *(const LAS bf16x8*)(lds + PG8_SB(b, h) + boff + n * 2048 + k * 1024); } while (0)
#define PG8_MMA(ai, bj, At, Bt) do { __builtin_amdgcn_s_setprio(1); _Pragma("unroll") for (int m = 0; m < 4; ++m) _Pragma("unroll") for (int n = 0; n < 2; ++n) _Pragma("unroll") for (int k = 0; k < 2; ++k) \
        acc[ai][bj][m][n] = __builtin_amdgcn_mfma_f32_16x16x32_bf16(Bt[n][k], At[m][k], acc[ai][bj][m][n], 0, 0, 0); __builtin_amdgcn_s_setprio(0); } while (0)
#define PG8_WAIT_V(n) asm volatile("s_waitcnt vmcnt(" #n ")" ::: "memory")
#define PG8_WAIT_L(n) asm volatile("s_waitcnt lgkmcnt(" #n ")" ::: "memory")
#define PG8_BAR __builtin_amdgcn_s_barrier()
#define PG8_SCHED __builtin_amdgcn_sched_barrier(0)
    Unit cur, nxt; int ui = 0;
    if (!S.next(0, cur)) return;
    f32x4 acc[2][2][4][2];
#pragma unroll
    for (int a = 0; a < 2; ++a)
#pragma unroll
        for (int b = 0; b < 2; ++b)
#pragma unroll
            for (int m = 0; m < 4; ++m)
#pragma unroll
                for (int n = 0; n < 2; ++n) acc[a][b][m][n] = (f32x4){0.f, 0.f, 0.f, 0.f};
    bf16x8 At[4][2], B0[2][2], B1[2][2];
    const char* cA = (const char*)g.A + (size_t)cur.pm * tstep; const char* cB = (const char*)g.Bt + (size_t)cur.pn * tstep;
    S.a_ready(cur);
    PG8_STAGE(PG8_SB(0, 0), cB, voffA); PG8_STAGE(PG8_SA(0, 0), cA, voffA); PG8_STAGE(PG8_SB(0, 1), cB + hstep, voffA); PG8_STAGE(PG8_SA(0, 1), cA + hstep, voffA);
    if (wr == 1) PG8_BAR;
    PG8_WAIT_V(4); PG8_BAR;
    PG8_STAGE(PG8_SB(1, 0), cB + kstep, voffA); PG8_STAGE(PG8_SA(1, 0), cA + kstep, voffA); PG8_STAGE(PG8_SB(1, 1), cB + hstep + kstep, voffA);
    PG8_WAIT_V(6); PG8_BAR;
    for (;;) {
        const bool has_next = S.next(ui + 1, nxt);
        const char* nA = has_next ? (const char*)g.A + (size_t)nxt.pm * tstep : cA; const char* nB = has_next ? (const char*)g.Bt + (size_t)nxt.pn * tstep : cB;
        for (int t = 0; t < nt; t += 2) {
            const bool last = (t == nt - 2);
            const char* a1 = cA + (size_t)(t + 1) * kstep;
            const char* a2 = last ? nA : cA + (size_t)(t + 2) * kstep; const char* b2 = last ? nB : cB + (size_t)(t + 2) * kstep;
            const char* a3 = a2 + kstep; const char* b3 = b2 + kstep;
            if (last && has_next) S.a_ready(nxt);
            PG8_LDB(B0, 0, 0); PG8_SCHED; PG8_LDA(At, 0, 0); PG8_STAGE(PG8_SA(1, 1), a1 + hstep, voffA);
            PG8_WAIT_L(8); PG8_BAR; PG8_WAIT_L(0); PG8_MMA(0, 0, At, B0); PG8_BAR; PG8_SCHED;
            PG8_LDB(B1, 0, 1); PG8_STAGE(PG8_SB(0, 0), b2, voffA);
            PG8_BAR; PG8_WAIT_L(0); PG8_MMA(0, 1, At, B1); PG8_BAR;
            PG8_LDA(At, 0, 1); PG8_STAGE(PG8_SA(0, 0), a2, voffA);
            PG8_BAR; PG8_WAIT_L(0); PG8_MMA(1, 0, At, B0); PG8_BAR; PG8_SCHED;
            PG8_STAGE(PG8_SB(0, 1), b2 + hstep, voffA);
            PG8_WAIT_V(6); PG8_BAR; PG8_MMA(1, 1, At, B1); PG8_BAR;
            PG8_LDB(B0, 1, 0); PG8_SCHED; PG8_LDA(At, 1, 0); PG8_STAGE(PG8_SA(0, 1), a2 + hstep, voffA);
            PG8_WAIT_L(8); PG8_BAR; PG8_WAIT_L(0); PG8_MMA(0, 0, At, B0); PG8_BAR; PG8_SCHED;
            PG8_LDB(B1, 1, 1); PG8_STAGE(PG8_SB(1, 0), b3, voffA);
            PG8_BAR; PG8_WAIT_L(0); PG8_MMA(0, 1, At, B1); PG8_BAR;
            PG8_LDA(At, 1, 1); PG8_STAGE(PG8_SA(1, 0), a3, voffA);
            PG8_BAR; PG8_WAIT_L(0); PG8_MMA(1, 0, At, B0); PG8_BAR; PG8_SCHED;
            PG8_STAGE(PG8_SB(1, 1), b3 + hstep, voffA);
            PG8_WAIT_V(6); PG8_BAR; PG8_MMA(1, 1, At, B1); PG8_BAR;
        }
        if constexpr (!Epi::AFTER_DRAIN) { E(acc, cur, wr, wc, fr, fq); S.done(cur); }
        if (!has_next) break;
#pragma unroll
        for (int a = 0; a < 2; ++a)
#pragma unroll
            for (int b = 0; b < 2; ++b)
#pragma unroll
                for (int m = 0; m < 4; ++m)
#pragma unroll
                    for (int n = 0; n < 2; ++n) acc[a][b][m][n] = (f32x4){0.f, 0.f, 0.f, 0.f};
        cur = nxt; cA = nA; cB = nB; ++ui;
    }
    PG8_WAIT_V(0);
    if (wr == 0) PG8_BAR;
    PG8_BAR;
    if constexpr (Epi::AFTER_DRAIN) { E.fused(acc, cur, wr, wc, fr, fq, lds, wid, lane); S.done(cur); }
#undef PG8_SA
#undef PG8_SB
#undef PG8_STAGE
#undef PG8_LDA
#undef PG8_LDB
#undef PG8_MMA
#undef PG8_WAIT_V
#undef PG8_WAIT_L
#undef PG8_BAR
#undef PG8_SCHED
}
}
using pg8::Unit;

struct EpiIn {
    static constexpr bool AFTER_DRAIN = false;
    bf16_t* proj; float* out; float* dtb; const float* dt_bias; int l;
    __device__ __forceinline__ void operator()(const f32x4 (&acc)[2][2][4][2], const Unit& u, int wr, int wc, int fr, int fq) const {
#pragma unroll
        for (int ai = 0; ai < 2; ++ai)
#pragma unroll
            for (int m = 0; m < 4; ++m) {
                const int row = u.pm * 256 + ai * 128 + wr * 64 + m * 16 + fr;
                const bool isP = row < T_P; int b, t;
                if (isP) { b = row >> 13; t = row & 8191; } else { b = (row - T_P) >> 6; t = row & 63; }
#pragma unroll
                for (int bj = 0; bj < 2; ++bj)
#pragma unroll
                    for (int n = 0; n < 2; ++n) {
                        const int col = u.pn * 256 + bj * 128 + wc * 32 + n * 16 + fq * 4;
                        f32x4 v = acc[ai][bj][m][n];
                        if (col < C_U) {
                            *(u32x2*)(proj + (size_t)row * NPROJ + col) = pack4(v);
                            if (col >= C_K && col < C_Z) {
                                const int isv = col >= C_V; const int cc = col - (isv ? C_V : C_K);
                                if (isP) { if (t >= 7680) *(f32x4*)(out + (isv ? O_PV : O_PK) + ((size_t)(l * 4 + b) * 512 + (t - 7680)) * 384 + cc) = v; }
                                else *(f32x4*)(out + (isv ? O_SV : O_SK) + ((size_t)(l * 32 + b) * 64 + t) * 384 + cc) = v;
                            } else if (col >= C_XBC) {
                                const int cc = col - C_XBC;
                                if (isP) { if (t >= 8189) *(f32x4*)(out + O_PC + ((size_t)(l * 4 + b) * 3 + (t - 8189)) * 896 + cc) = v; }
                                else if (t >= 61) *(f32x4*)(out + O_SC + ((size_t)(l * 32 + b) * 3 + (t - 61)) * 896 + cc) = v;
                            }
                        } else if (col < C_DT) {
#pragma unroll
                            for (int j = 0; j < 4; ++j) v[j] = gelu_tanh(v[j]);
                            *(u32x2*)(proj + (size_t)row * NPROJ + col) = pack4(v);
                            if (col >= C_VC && !isP) *(f32x4*)(out + O_SG + ((size_t)(l * 32 + b) * 64 + t) * 256 + (col - C_VC)) = v;
                        } else if (col < C_DT + 8) {
#pragma unroll
                            for (int j = 0; j < 4; ++j) { const int hh = col + j - C_DT; if (hh < 6) dtb[(size_t)row * 8 + hh] = softplus_f(v[j] + dt_bias[l * 6 + hh]); }
                        }
                    }
            }
    }
};
struct EpiRes {
    static constexpr bool AFTER_DRAIN = false;
    float* x;
    __device__ __forceinline__ void operator()(const f32x4 (&acc)[2][2][4][2], const Unit& u, int wr, int wc, int fr, int fq) const {
#pragma unroll
        for (int ai = 0; ai < 2; ++ai)
#pragma unroll
            for (int m = 0; m < 4; ++m) {
                float* rowp = x + (size_t)(u.pm * 256 + ai * 128 + wr * 64 + m * 16 + fr) * DM + u.pn * 256 + wc * 32 + fq * 4;
#pragma unroll
                for (int bj = 0; bj < 2; ++bj)
#pragma unroll
                    for (int n = 0; n < 2; ++n) { float* q = rowp + bj * 128 + n * 16; const f32x4 o = *(const f32x4*)q; *(f32x4*)q = o * ALPHA + acc[ai][bj][m][n]; }
            }
    }
};
struct EpiUp {
    static constexpr bool AFTER_DRAIN = true;
    bf16_t* H; float* halo; float* out; const float* cw; const float* cb; const float* fstate; int l;
    __device__ __forceinline__ void operator()(const f32x4 (&)[2][2][4][2], const Unit&, int, int, int, int) const {}
    __device__ __forceinline__ void fused(f32x4 (&acc)[2][2][4][2], const Unit& u, int wr, int wc, int fr, int fq, LAS unsigned char* lds, int wid, int lane) const {
        constexpr int LS = 260;
#pragma unroll
        for (int ai = 0; ai < 2; ++ai)
#pragma unroll
            for (int m = 0; m < 4; ++m)
#pragma unroll
                for (int bj = 0; bj < 2; ++bj)
#pragma unroll
                    for (int n = 0; n < 2; ++n) {
                        const int rl = ai * 128 + wr * 64 + m * 16 + fr, cl = bj * 128 + wc * 32 + n * 16 + fq * 4;
                        *(LAS u32x2*)(lds + (rl * LS + cl) * 2) = pack4(acc[ai][bj][m][n]);
                    }
        __syncthreads();
        const int tid = wid * 64 + lane, j = tid & 127, seg = tid >> 7;
        const int hcol = u.pn * 128 + j;
        const float* w = cw + (size_t)l * 3 * DFF2; const float* bb = cb + (size_t)l * DFF2;
        const float wg0 = w[hcol], wg1 = w[DFF2 + hcol], wg2 = w[2 * DFF2 + hcol], bg = bb[hcol];
        const float wv0 = w[DFF + hcol], wv1 = w[DFF2 + DFF + hcol], wv2 = w[2 * DFF2 + DFF + hcol], bv = bb[DFF + hcol];
        const int R = u.pm * 256 + seg * 64;
        const bool isP = R < T_P;
        float g2 = 0.f, g1 = 0.f, v2 = 0.f, v1 = 0.f; int skip = 0;
        const LAS bf16_t* U = (const LAS bf16_t*)lds;
        if (isP) {
            if (seg > 0) { g2 = bf2f(U[(seg * 64 - 2) * LS + j]); g1 = bf2f(U[(seg * 64 - 1) * LS + j]); v2 = bf2f(U[(seg * 64 - 2) * LS + 128 + j]); v1 = bf2f(U[(seg * 64 - 1) * LS + 128 + j]); }
            else if ((R & 8191) != 0) skip = 2;
        } else {
            const int sb = (R - T_P) >> 6; const float* fs = fstate + (size_t)(l * 32 + sb) * 2 * DFF2;
            g2 = fs[hcol]; g1 = fs[DFF2 + hcol]; v2 = fs[DFF + hcol]; v1 = fs[DFF2 + DFF + hcol];
        }
        bf16_t* hp = H + (size_t)R * DFF + hcol;
        for (int i = 0; i < 64; ++i) {
            const float gq = bf2f(U[(seg * 64 + i) * LS + j]), vq = bf2f(U[(seg * 64 + i) * LS + 128 + j]);
            if (i >= skip) {
                const float cgv = bg + wg0 * g2 + wg1 * g1 + wg2 * gq, cvv = bv + wv0 * v2 + wv1 * v1 + wv2 * vq;
                const float hv = silu_f(cgv) * cvv;
                hp[(size_t)i * DFF] = (bf16_t)(cvt_pk_bf16(hv, 0.f) & 0xffffu);
            }
            g2 = g1; g1 = gq; v2 = v1; v1 = vq;
            if (isP) {
                if (seg == 0 && i < 2) { float* hl = halo + ((size_t)u.pm * 4 + i) * DFF2; hl[hcol] = gq; hl[DFF + hcol] = vq; }
                if (seg == 3 && i >= 62) { float* hl = halo + ((size_t)u.pm * 4 + 2 + (i - 62)) * DFF2; hl[hcol] = gq; hl[DFF + hcol] = vq;
                    if ((u.pm & 31) == 31) { float* o = out + O_PF + ((size_t)(l * 4 + (u.pm >> 5)) * 2 + (i - 62)) * DFF2; o[hcol] = gq; o[DFF + hcol] = vq; } }
            } else if (i >= 62) {
                const int sb = (R - T_P) >> 6; float* o = out + O_SF + ((size_t)(l * 32 + sb) * 2 + (i - 62)) * DFF2; o[hcol] = gq; o[DFF + hcol] = vq;
            }
        }
    }
};

__device__ __forceinline__ void ln_row(const float* src, float* x32, bf16_t* xb, const float* g, const float* b, int lane) {
    f32x4 v[4]; float s = 0.f;
#pragma unroll
    for (int i = 0; i < 4; ++i) { v[i] = *(const f32x4*)(src + i * 256 + lane * 4); s += (v[i][0] + v[i][1]) + (v[i][2] + v[i][3]); }
#pragma unroll
    for (int o = 32; o >= 1; o >>= 1) s += __shfl_xor(s, o);
    const float mu = s * (1.0f / 1024.0f); float q = 0.f;
#pragma unroll
    for (int i = 0; i < 4; ++i) { const f32x4 d = v[i] - mu; q += (d[0] * d[0] + d[1] * d[1]) + (d[2] * d[2] + d[3] * d[3]); }
#pragma unroll
    for (int o = 32; o >= 1; o >>= 1) q += __shfl_xor(q, o);
    const float rstd = 1.0f / sqrtf(q * (1.0f / 1024.0f) + LN_EPS);
#pragma unroll
    for (int i = 0; i < 4; ++i) {
        const f32x4 gg = *(const f32x4*)(g + i * 256 + lane * 4), bb = *(const f32x4*)(b + i * 256 + lane * 4);
        const f32x4 o = (v[i] - mu) * rstd * gg + bb;
        *(f32x4*)(x32 + i * 256 + lane * 4) = o; *(u32x2*)(xb + i * 256 + lane * 4) = pack4(o);
    }
}

__device__ __forceinline__ void tr_tile(LAS float* tile, const float* src, int Nsrc, bf16_t* dst, int K, int n0, int k0, int mode, int tid) {
    const int nn = tid & 63, np = n0 + nn; int sc;
    if (mode == 0) sc = np < C_U ? np : (np < C_DT ? np + 6 : (np < C_DT + 6 ? np - 512 : -1));
    else if (mode == 1) sc = np;
    else { const int pn = np >> 8, jj = np & 255; sc = jj < 128 ? pn * 128 + jj : DFF + pn * 128 + (jj - 128); }
#pragma unroll
    for (int i = 0; i < 8; ++i) { const int kk = (tid >> 6) + 8 * i; tile[kk * 65 + nn] = sc >= 0 ? src[(size_t)(k0 + kk) * Nsrc + sc] : 0.f; }
    __syncthreads();
    const int kk2 = (tid & 31) * 2;
#pragma unroll
    for (int i = 0; i < 4; ++i) { const int nn2 = (tid >> 5) + 16 * i; *(unsigned*)(dst + (size_t)(n0 + nn2) * K + k0 + kk2) = cvt_pk_bf16(tile[kk2 * 65 + nn2], tile[(kk2 + 1) * 65 + nn2]); }
    __syncthreads();
}

__device__ __forceinline__ void phase_prep(KP& p, LAS unsigned char* lds) {
    int tid_ = threadIdx.x; asm volatile("" : "+v"(tid_));
    const int tid = tid_, wid = tid >> 6, lane = tid & 63;
    for (int row = blockIdx.x * 8 + wid; row < T_ALL; row += gridDim.x * 8) {
        const float* src = row < T_P ? p.in[0] + (size_t)row * DM : p.in[1] + (size_t)(row - T_P) * DM;
        ln_row(src, p.out + (size_t)row * DM, (bf16_t*)(p.ws + W_XB) + (size_t)row * DM, p.in[7], p.in[8], lane);
    }
    constexpr int T_IN = 48 * 16, T_OUT = 16 * 16, T_UPT = 88 * 16, T_DNT = 16 * 44, T_L = T_IN + T_OUT + T_UPT + T_DNT;
    for (int it = blockIdx.x; it < 4 * T_L; it += gridDim.x) {
        const int l = it / T_L; int r = it % T_L;
        if (r < T_IN) tr_tile((LAS float*)lds, p.in[9] + (size_t)l * DM * 2950, 2950, (bf16_t*)(p.ws + W_IN + l * W_IN_L), DM, (r >> 4) * 64, (r & 15) * 64, 0, tid);
        else if ((r -= T_IN) < T_OUT) tr_tile((LAS float*)lds, p.in[19] + (size_t)l * DM * DM, DM, (bf16_t*)(p.ws + W_OUT + l * W_OUT_L), DM, (r >> 4) * 64, (r & 15) * 64, 1, tid);
        else if ((r -= T_OUT) < T_UPT) tr_tile((LAS float*)lds, p.in[22] + (size_t)l * DM * DFF2, DFF2, (bf16_t*)(p.ws + W_UP + l * W_UP_L), DM, (r >> 4) * 64, (r & 15) * 64, 2, tid);
        else { r -= T_UPT; tr_tile((LAS float*)lds, p.in[25] + (size_t)l * DFF * DM, DM, (bf16_t*)(p.ws + W_DN + l * W_DN_L), DFF, (r / 44) * 64, (r % 44) * 64, 1, tid); }
    }
    for (int i = blockIdx.x * 512 + tid; i < 4 * 4 * 128 * 128; i += gridDim.x * 512) {
        const int jj = i & 127, ii = (i >> 7) & 127;
        ((bf16_t*)(p.ws + W_GW))[i] = (bf16_t)(cvt_pk_bf16(jj <= ii ? p.in[16][i] : 0.f, 0.f) & 0xffffu);
    }
}

__device__ __forceinline__ void phase_ln(KP& p, const float* g, const float* b) {
    int tid_ = threadIdx.x; asm volatile("" : "+v"(tid_));
    const int wid = tid_ >> 6, lane = tid_ & 63;
    for (int row = blockIdx.x * 8 + wid; row < T_ALL; row += gridDim.x * 8)
        ln_row(p.out + (size_t)row * DM, p.out + (size_t)row * DM, (bf16_t*)(p.ws + W_XB) + (size_t)row * DM, g, b, lane);
}

__device__ __forceinline__ f32x4 conv4(KP& p, int l, int u, int i, int ch) {
    const bf16_t* proj = (const bf16_t*)(p.ws + W_PROJ);
    const int R0 = u * 64; const bool isP = u < 512; const bool hasprev = isP && (u & 127) != 0;
    const float* cw = p.in[11] + (size_t)l * 4 * 896 + ch;
    f32x4 y = *(const f32x4*)(p.in[12] + (size_t)l * 896 + ch);
#pragma unroll
    for (int j = 0; j < 4; ++j) {
        const int s = i - 3 + j; f32x4 xv;
        if (s >= 0 || hasprev) xv = unpack4(*(const u32x2*)(proj + (size_t)(R0 + s) * NPROJ + C_XBC + ch));
        else if (!isP) xv = *(const f32x4*)(p.in[5] + ((size_t)(l * 32 + (u - 512)) * 3 + (3 + s)) * 896 + ch);
        else xv = (f32x4){0.f, 0.f, 0.f, 0.f};
        y += *(const f32x4*)(cw + j * 896) * xv;
    }
#pragma unroll
    for (int j = 0; j < 4; ++j) y[j] = silu_f(y[j]);
    return y;
}
__device__ __forceinline__ void dt_scan(KP& p, int l, int u, int g, int wid, int lane, float& dt, float& ac, float& last) {
    const int h = g * 3 + wid;
    dt = ((const float*)(p.ws + W_DTB))[(size_t)(u * 64 + lane) * 8 + h];
    const float a = -__expf(p.in[14][l * 6 + h]);
    float v = dt * a;
#pragma unroll
    for (int o = 1; o < 64; o <<= 1) { const float t = __shfl_up(v, o); if (lane >= o) v += t; }
    ac = v; last = __shfl(v, 63);
}

__device__ __forceinline__ void ssd_states(KP& p, LAS unsigned char* lds, int l, int u, int g) {
    int tid_ = threadIdx.x; asm volatile("" : "+v"(tid_));
    const int tid = tid_, wid = tid >> 6, lane = tid & 63, fr = lane & 15, fq = lane >> 4;
    LAS bf16_t* xT = (LAS bf16_t*)lds;
    LAS bf16_t* BT = (LAS bf16_t*)(lds + 27648);
    LAS float* wgt = (LAS float*)(lds + 46080);
    __syncthreads();
    if (wid < 3) {
        float dt, ac, last; dt_scan(p, l, u, g, wid, lane, dt, ac, last);
        wgt[wid * 64 + lane] = dt * __expf(last - ac);
        if (lane == 0) ((float*)(p.ws + W_CD))[u * 8 + g * 3 + wid] = __expf(last);
    }
    __syncthreads();
#pragma unroll 1
    for (int it = 0; it < 10; ++it) {
        const int idx = it * 512 + tid, i = idx / 80, cgp = idx % 80;
        const int chl = cgp * 4;
        const int ch = chl < 192 ? g * 192 + chl : 384 + g * 128 + (chl - 192);
        const f32x4 y = conv4(p, l, u, i, ch);
        if (chl < 192) { const float w = wgt[(chl >> 6) * 64 + i];
#pragma unroll
            for (int e = 0; e < 4; ++e) xT[(chl + e) * 72 + i] = (bf16_t)(cvt_pk_bf16(y[e] * w, 0.f) & 0xffffu); }
        else {
#pragma unroll
            for (int e = 0; e < 4; ++e) BT[(chl - 192 + e) * 72 + i] = (bf16_t)(cvt_pk_bf16(y[e], 0.f) & 0xffffu); }
    }
    __syncthreads();
    bf16_t* ST = (bf16_t*)(p.ws + W_ST);
#pragma unroll 1
    for (int k = 0; k < 12; ++k) {
        const int tt = wid * 12 + k, hh = tt >> 5, pt = (tt & 31) >> 3, nt = tt & 7;
        f32x4 acc = (f32x4){0.f, 0.f, 0.f, 0.f};
#pragma unroll
        for (int ks = 0; ks < 2; ++ks) {
            const bf16x8 rf = ldsfrag((LAS const unsigned char*)(xT + (hh * 64 + pt * 16 + fr) * 72 + ks * 32 + fq * 8));
            const bf16x8 cf = ldsfrag((LAS const unsigned char*)(BT + (nt * 16 + fr) * 72 + ks * 32 + fq * 8));
            acc = MFMA16(cf, rf, acc);
        }
        *(u32x2*)(ST + ((size_t)(u * 6 + g * 3 + hh) * 64 + pt * 16 + fr) * 128 + nt * 16 + fq * 4) = pack4(acc);
    }
}

__device__ __forceinline__ void gmlp_unit(KP& p, LAS unsigned char* lds, int l, int u) {
    int tid_ = threadIdx.x; asm volatile("" : "+v"(tid_));
    const int tid = tid_, wid = tid >> 6, lane = tid & 63, fr = lane & 15, fq = lane >> 4;
    LAS bf16_t* vT = (LAS bf16_t*)lds;
    LAS float* ssq = (LAS float*)(lds + 69632);
    const bf16_t* proj = (const bf16_t*)(p.ws + W_PROJ);
    const int half = u < 512 ? (u & 1) : 0, KJ = (half + 1) * 64, R0 = u * 64, Rb = R0 - half * 64;
    __syncthreads();
    for (int idx = tid; idx < KJ * 32; idx += 512) {
        const int j = idx & (KJ - 1), cgp = idx / KJ;
        const u32x4 w = *(const u32x4*)(proj + (size_t)(Rb + j) * NPROJ + C_VC + cgp * 8);
        const unsigned ww[4] = {w.x, w.y, w.z, w.w};
#pragma unroll
        for (int e = 0; e < 4; ++e) { vT[(cgp * 8 + 2 * e) * 136 + j] = (bf16_t)(ww[e] & 0xffffu); vT[(cgp * 8 + 2 * e + 1) * 136 + j] = (bf16_t)(ww[e] >> 16); }
    }
    __syncthreads();
    const int rt = wid & 3, cbase = (wid >> 2) * 8;
    const bf16_t* GW = (const bf16_t*)(p.ws + W_GW + l * W_GW_L);
    f32x4 acc[8];
#pragma unroll
    for (int gi = 0; gi < 2; ++gi) {
        const int gg = (cbase >> 2) + gi;
        bf16x8 rf[4];
#pragma unroll
        for (int ks = 0; ks < 4; ++ks) rf[ks] = glbfrag(GW + ((size_t)gg * 128 + half * 64 + rt * 16 + fr) * 128 + ks * 32 + fq * 8);
#pragma unroll
        for (int c4 = 0; c4 < 4; ++c4) {
            const int ct = cbase + gi * 4 + c4;
            f32x4 a = (f32x4){0.f, 0.f, 0.f, 0.f};
#pragma unroll
            for (int ks = 0; ks < 4; ++ks) if (ks * 32 < KJ) a = MFMA16(ldsfrag((LAS const unsigned char*)(vT + (ct * 16 + fr) * 136 + ks * 32 + fq * 8)), rf[ks], a);
            acc[gi * 4 + c4] = a;
        }
    }
    const int row = R0 + rt * 16 + fr; float sq = 0.f;
#pragma unroll
    for (int k = 0; k < 8; ++k) {
        const int col = (cbase + k) * 16 + fq * 4, gg = col >> 6;
        const float bsv = p.in[17][(size_t)(l * 4 + gg) * 128 + half * 64 + rt * 16 + fr];
        const f32x4 uv = unpack4(*(const u32x2*)(proj + (size_t)row * NPROJ + C_U + col));
        f32x4 o = uv * (acc[k] + bsv); acc[k] = o;
        sq += (o[0] * o[0] + o[1] * o[1]) + (o[2] * o[2] + o[3] * o[3]);
    }
    sq += __shfl_xor(sq, 16); sq += __shfl_xor(sq, 32);
    if (fq == 0) ssq[(wid >> 2) * 64 + rt * 16 + fr] = sq;
    __syncthreads();
    const float rstd = 1.0f / sqrtf((ssq[rt * 16 + fr] + ssq[64 + rt * 16 + fr]) * (1.0f / 256.0f) + RMS_EPS);
    bf16_t* mix = (bf16_t*)(p.ws + W_MIX);
#pragma unroll
    for (int k = 0; k < 8; ++k) {
        const int col = (cbase + k) * 16 + fq * 4;
        const f32x4 gv = *(const f32x4*)(p.in[18] + (size_t)l * 1024 + 768 + col);
        *(u32x2*)(mix + (size_t)row * DM + 768 + col) = pack4(acc[k] * rstd * gv);
    }
}

__device__ __forceinline__ void scan_prompt(KP& p, int l, int item) {
    int tid_ = threadIdx.x; asm volatile("" : "+v"(tid_));
    const int gid = item * 512 + tid_, e = (gid & 2047) * 4, bh = gid >> 11, b = bh / 6, h = bh % 6;
    bf16_t* ST = (bf16_t*)(p.ws + W_ST); const float* CD = (const float*)(p.ws + W_CD);
    f32x4 st = (f32x4){0.f, 0.f, 0.f, 0.f};
#pragma unroll 1
    for (int c0 = 0; c0 < 128; c0 += 8) {
        u32x2 s[8]; float cd[8];
#pragma unroll
        for (int k = 0; k < 8; ++k) { const int u = b * 128 + c0 + k; s[k] = *(const u32x2*)(ST + ((size_t)(u * 6 + h)) * 8192 + e); cd[k] = CD[u * 8 + h]; }
#pragma unroll
        for (int k = 0; k < 8; ++k) { const int u = b * 128 + c0 + k; *(u32x2*)(ST + ((size_t)(u * 6 + h)) * 8192 + e) = pack4(st); st = st * cd[k] + unpack4(s[k]); }
    }
    *(f32x4*)(p.out + O_PH + ((size_t)(l * 4 + b) * 6 + h) * 8192 + e) = st;
}
__device__ __forceinline__ void scan_sample(KP& p, int l, int item) {
    int tid_ = threadIdx.x; asm volatile("" : "+v"(tid_));
    const int gid = item * 512 + tid_, e = (gid & 2047) * 4, sbh = gid >> 11, sb = sbh / 6, h = sbh % 6;
    bf16_t* ST = (bf16_t*)(p.ws + W_ST); const float* CD = (const float*)(p.ws + W_CD);
    const int u = 512 + sb;
    const f32x4 st = *(const f32x4*)(p.in[4] + ((size_t)(l * 32 + sb) * 6 + h) * 8192 + e);
    const f32x4 s = unpack4(*(const u32x2*)(ST + ((size_t)(u * 6 + h)) * 8192 + e));
    *(u32x2*)(ST + ((size_t)(u * 6 + h)) * 8192 + e) = pack4(st);
    *(f32x4*)(p.out + O_SH + ((size_t)(l * 32 + sb) * 6 + h) * 8192 + e) = st * CD[u * 8 + h] + s;
}

__device__ __forceinline__ void attn_unit(KP& p, LAS unsigned char* lds, int l, int u) {
    int tid_ = threadIdx.x; asm volatile("" : "+v"(tid_));
    const int tid = tid_, wid = tid >> 6, lane = tid & 63, fr = lane & 15, fq = lane >> 4;
    LAS bf16_t* Kb = (LAS bf16_t*)lds;
    LAS bf16_t* VT = (LAS bf16_t*)(lds + 50176);
    LAS bf16_t* Pw = (LAS bf16_t*)(lds + 105472) + wid * 16 * 72;
    LAS float* bias = (LAS float*)(lds + 123904);
    LAS float* ssq = (LAS float*)(lds + 128512);
    const bf16_t* proj = (const bf16_t*)(p.ws + W_PROJ);
    const bool isP = u < 512; const int R0 = u * 64, c = u & 127, b = u >> 7, sb = u - 512;
    const int qt = wid & 3, hbase = (wid >> 2) * 3;
    __syncthreads();
    for (int i = tid; i < 1152; i += 512) bias[i] = p.in[10][(size_t)l * 1152 + i];
    bf16x8 qf[3][2];
#pragma unroll
    for (int hh = 0; hh < 3; ++hh)
#pragma unroll
        for (int ks = 0; ks < 2; ++ks) qf[hh][ks] = glbfrag(proj + (size_t)(R0 + qt * 16 + fr) * NPROJ + (hbase + hh) * 64 + ks * 32 + fq * 8);
    float mrun[3], lrun[3]; f32x4 O[3][4];
#pragma unroll
    for (int hh = 0; hh < 3; ++hh) { mrun[hh] = -1e30f; lrun[hh] = 0.f;
#pragma unroll
        for (int d = 0; d < 4; ++d) O[hh][d] = (f32x4){0.f, 0.f, 0.f, 0.f}; }
    const int blk_lo = isP ? (c < 8 ? 8 - c : 0) : 0;
#pragma unroll 1
    for (int blk = blk_lo; blk <= 8; ++blk) {
        __syncthreads();
        const bool fromproj = isP || blk == 8;
        const size_t rowbase = isP ? (size_t)b * 8192 + (size_t)(c - 8 + blk) * 64 : (size_t)T_P + (size_t)sb * 64;
#pragma unroll 1
        for (int it = 0; it < 6; ++it) {
            const int idx = it * 512 + tid;
            { const int key = idx / 48, cgp = idx % 48; u32x4 w;
              if (fromproj) w = *(const u32x4*)(proj + (rowbase + key) * NPROJ + C_K + cgp * 8);
              else { const float* s = p.in[2] + ((size_t)(l * 32 + sb) * 512 + blk * 64 + key) * 384 + cgp * 8; const f32x4 a = *(const f32x4*)s, bq = *(const f32x4*)(s + 4);
                     w.x = cvt_pk_bf16(a[0], a[1]); w.y = cvt_pk_bf16(a[2], a[3]); w.z = cvt_pk_bf16(bq[0], bq[1]); w.w = cvt_pk_bf16(bq[2], bq[3]); }
              *(LAS u32x4*)(Kb + key * 392 + cgp * 8) = w; }
            { const int key = idx & 63, cgp = idx >> 6; u32x4 w;
              if (fromproj) w = *(const u32x4*)(proj + (rowbase + key) * NPROJ + C_V + cgp * 8);
              else { const float* s = p.in[3] + ((size_t)(l * 32 + sb) * 512 + blk * 64 + key) * 384 + cgp * 8; const f32x4 a = *(const f32x4*)s, bq = *(const f32x4*)(s + 4);
                     w.x = cvt_pk_bf16(a[0], a[1]); w.y = cvt_pk_bf16(a[2], a[3]); w.z = cvt_pk_bf16(bq[0], bq[1]); w.w = cvt_pk_bf16(bq[2], bq[3]); }
              const unsigned ww[4] = {w.x, w.y, w.z, w.w};
#pragma unroll
              for (int e = 0; e < 4; ++e) { VT[(cgp * 8 + 2 * e) * 72 + key] = (bf16_t)(ww[e] & 0xffffu); VT[(cgp * 8 + 2 * e + 1) * 72 + key] = (bf16_t)(ww[e] >> 16); } }
        }
        __syncthreads();
#pragma unroll
        for (int hh = 0; hh < 3; ++hh) {
            const int h = hbase + hh;
            f32x4 s[4]; float mx = -1e30f;
#pragma unroll
            for (int kt = 0; kt < 4; ++kt) {
                f32x4 a = (f32x4){0.f, 0.f, 0.f, 0.f};
#pragma unroll
                for (int ks = 0; ks < 2; ++ks) a = MFMA16(ldsfrag((LAS const unsigned char*)(Kb + (kt * 16 + fr) * 392 + h * 64 + ks * 32 + fq * 8)), qf[hh][ks], a);
#pragma unroll
                for (int j = 0; j < 4; ++j) {
                    int rel = (qt * 16 + fr) + 512 - (blk * 64 + kt * 16 + fq * 4 + j); rel = rel > 128 ? 128 : rel;
                    a[j] = a[j] * 0.125f + bias[h * 192 + rel + 63]; mx = fmaxf(mx, a[j]);
                }
                s[kt] = a;
            }
            mx = fmaxf(mx, __shfl_xor(mx, 16)); mx = fmaxf(mx, __shfl_xor(mx, 32));
            const float mnew = fmaxf(mrun[hh], mx), fac = __expf(mrun[hh] - mnew); mrun[hh] = mnew;
            float rs = 0.f;
#pragma unroll
            for (int kt = 0; kt < 4; ++kt) {
#pragma unroll
                for (int j = 0; j < 4; ++j) { s[kt][j] = __expf(s[kt][j] - mnew); rs += s[kt][j]; }
                *(LAS u32x2*)(Pw + fr * 72 + kt * 16 + fq * 4) = pack4(s[kt]);
            }
            rs += __shfl_xor(rs, 16); rs += __shfl_xor(rs, 32);
            lrun[hh] = lrun[hh] * fac + rs;
#pragma unroll
            for (int d = 0; d < 4; ++d) O[hh][d] *= fac;
            LDS_WAVE_SYNC();
#pragma unroll
            for (int ks = 0; ks < 2; ++ks) {
                const bf16x8 pf = ldsfrag((LAS const unsigned char*)(Pw + fr * 72 + ks * 32 + fq * 8));
#pragma unroll
                for (int d = 0; d < 4; ++d) O[hh][d] = MFMA16(ldsfrag((LAS const unsigned char*)(VT + (h * 64 + d * 16 + fr) * 72 + ks * 32 + fq * 8)), pf, O[hh][d]);
            }
            LDS_WAVE_SYNC();
        }
    }
    float sq = 0.f;
#pragma unroll
    for (int hh = 0; hh < 3; ++hh) { const float inv = 1.0f / lrun[hh];
#pragma unroll
        for (int d = 0; d < 4; ++d) { O[hh][d] *= inv; const f32x4 o = O[hh][d]; sq += (o[0] * o[0] + o[1] * o[1]) + (o[2] * o[2] + o[3] * o[3]); } }
    sq += __shfl_xor(sq, 16); sq += __shfl_xor(sq, 32);
    if (fq == 0) ssq[(wid >> 2) * 64 + qt * 16 + fr] = sq;
    __syncthreads();
    const float rstd = 1.0f / sqrtf((ssq[qt * 16 + fr] + ssq[64 + qt * 16 + fr]) * (1.0f / 384.0f) + RMS_EPS);
    bf16_t* mix = (bf16_t*)(p.ws + W_MIX);
#pragma unroll
    for (int hh = 0; hh < 3; ++hh)
#pragma unroll
        for (int d = 0; d < 4; ++d) {
            const int col = (hbase + hh) * 64 + d * 16 + fq * 4;
            const f32x4 gv = *(const f32x4*)(p.in[18] + (size_t)l * 1024 + col);
            *(u32x2*)(mix + (size_t)(R0 + qt * 16 + fr) * DM + col) = pack4(O[hh][d] * rstd * gv);
        }
}

__device__ __forceinline__ void ssd_y(KP& p, LAS unsigned char* lds, int l, int u) {
    int tid_ = threadIdx.x; asm volatile("" : "+v"(tid_));
    const int tid = tid_, wid = tid >> 6, lane = tid & 63, fr = lane & 15, fq = lane >> 4;
    LAS bf16_t* Cn = (LAS bf16_t*)lds;
    LAS bf16_t* Bn = (LAS bf16_t*)(lds + 17408);
    LAS bf16_t* xT = (LAS bf16_t*)(lds + 34816);
    LAS bf16_t* xn = (LAS bf16_t*)(lds + 62464);
    LAS bf16_t* Mm = (LAS bf16_t*)(lds + 88064);
    LAS float* dtl = (LAS float*)(lds + 115712);
    LAS float* acl = (LAS float*)(lds + 116480);
    LAS float* ssq = (LAS float*)(lds + 117248);
    const bf16_t* proj = (const bf16_t*)(p.ws + W_PROJ);
    const bf16_t* HP = (const bf16_t*)(p.ws + W_ST);
    const int R0 = u * 64, lt = wid & 3;
    f32x4 yacc[2][6];
#pragma unroll
    for (int g = 0; g < 2; ++g) {
        __syncthreads();
        if (wid < 3) { float dt, ac, last; dt_scan(p, l, u, g, wid, lane, dt, ac, last); dtl[wid * 64 + lane] = dt; acl[wid * 64 + lane] = ac; }
        __syncthreads();
#pragma unroll 1
        for (int it = 0; it < 14; ++it) {
            const int idx = it * 512 + tid, i = idx / 112, cgp = idx % 112;
            const int chl = cgp * 4;
            const int ch = chl < 192 ? g * 192 + chl : (chl < 320 ? 384 + g * 128 + (chl - 192) : 640 + g * 128 + (chl - 320));
            const f32x4 y = conv4(p, l, u, i, ch);
            if (chl < 192) { const float dt = dtl[(chl >> 6) * 64 + i];
                *(LAS u32x2*)(xn + i * 200 + chl) = pack4(y);
#pragma unroll
                for (int e = 0; e < 4; ++e) xT[(chl + e) * 72 + i] = (bf16_t)(cvt_pk_bf16(y[e] * dt, 0.f) & 0xffffu); }
            else if (chl < 320) *(LAS u32x2*)(Bn + i * 136 + (chl - 192)) = pack4(y);
            else *(LAS u32x2*)(Cn + i * 136 + (chl - 320)) = pack4(y);
        }
        __syncthreads();
#pragma unroll
        for (int k = 0; k < 2; ++k) {
            const int st = (wid >> 2) * 2 + k;
            f32x4 a = (f32x4){0.f, 0.f, 0.f, 0.f};
#pragma unroll
            for (int ks = 0; ks < 4; ++ks) a = MFMA16(ldsfrag((LAS const unsigned char*)(Bn + (st * 16 + fr) * 136 + ks * 32 + fq * 8)), ldsfrag((LAS const unsigned char*)(Cn + (lt * 16 + fr) * 136 + ks * 32 + fq * 8)), a);
            const int li = lt * 16 + fr;
#pragma unroll
            for (int hh = 0; hh < 3; ++hh) {
                const float al = acl[hh * 64 + li]; f32x4 mv;
#pragma unroll
                for (int j = 0; j < 4; ++j) { const int si = st * 16 + fq * 4 + j; mv[j] = si <= li ? a[j] * __expf(al - acl[hh * 64 + si]) : 0.f; }
                *(LAS u32x2*)(Mm + (hh * 64 + li) * 72 + st * 16 + fq * 4) = pack4(mv);
            }
        }
        __syncthreads();
#pragma unroll
        for (int k = 0; k < 6; ++k) {
            const int ctile = (wid >> 2) * 6 + k, hh = ctile >> 2, pt = ctile & 3, h = g * 3 + hh, li = lt * 16 + fr;
            f32x4 ad = (f32x4){0.f, 0.f, 0.f, 0.f}, ao = (f32x4){0.f, 0.f, 0.f, 0.f};
#pragma unroll
            for (int ks = 0; ks < 2; ++ks) ad = MFMA16(ldsfrag((LAS const unsigned char*)(xT + (hh * 64 + pt * 16 + fr) * 72 + ks * 32 + fq * 8)), ldsfrag((LAS const unsigned char*)(Mm + (hh * 64 + li) * 72 + ks * 32 + fq * 8)), ad);
#pragma unroll
            for (int ks = 0; ks < 4; ++ks) ao = MFMA16(glbfrag(HP + ((size_t)(u * 6 + h) * 64 + pt * 16 + fr) * 128 + ks * 32 + fq * 8), ldsfrag((LAS const unsigned char*)(Cn + li * 136 + ks * 32 + fq * 8)), ao);
            const float ea = __expf(acl[hh * 64 + li]), dsk = p.in[15][l * 6 + h];
            const f32x4 xv = unpack4(*(const LAS u32x2*)(xn + li * 200 + hh * 64 + pt * 16 + fq * 4));
            const f32x4 zv = unpack4(*(const u32x2*)(proj + (size_t)(R0 + li) * NPROJ + C_Z + h * 64 + pt * 16 + fq * 4));
            f32x4 y = ad + ao * ea + xv * dsk;
#pragma unroll
            for (int j = 0; j < 4; ++j) y[j] *= silu_f(zv[j]);
            yacc[g][k] = y;
            asm volatile("" ::: "memory");
        }
    }
    float sq = 0.f;
#pragma unroll
    for (int g = 0; g < 2; ++g)
#pragma unroll
        for (int k = 0; k < 6; ++k) { const f32x4 o = yacc[g][k]; sq += (o[0] * o[0] + o[1] * o[1]) + (o[2] * o[2] + o[3] * o[3]); }
    sq += __shfl_xor(sq, 16); sq += __shfl_xor(sq, 32);
    if (fq == 0) ssq[(wid >> 2) * 64 + lt * 16 + fr] = sq;
    __syncthreads();
    const float rstd = 1.0f / sqrtf((ssq[lt * 16 + fr] + ssq[64 + lt * 16 + fr]) * (1.0f / 384.0f) + RMS_EPS);
    bf16_t* mix = (bf16_t*)(p.ws + W_MIX);
#pragma unroll
    for (int g = 0; g < 2; ++g)
#pragma unroll
        for (int k = 0; k < 6; ++k) {
            const int col = 384 + g * 192 + ((wid >> 2) * 6 + k) * 16 + fq * 4;
            const f32x4 gv = *(const f32x4*)(p.in[18] + (size_t)l * 1024 + col);
            *(u32x2*)(mix + (size_t)(R0 + lt * 16 + fr) * DM + col) = pack4(yacc[g][k] * rstd * gv);
        }
}

__device__ __forceinline__ void phase_fix(KP& p, int l) {
    const float* halo = (const float*)(p.ws + W_MIX); bf16_t* H = (bf16_t*)(p.ws + W_PROJ);
    const float* w = p.in[23] + (size_t)l * 3 * DFF2; const float* bb = p.in[24] + (size_t)l * DFF2;
    int tid_ = threadIdx.x; asm volatile("" : "+v"(tid_));
    for (int i = blockIdx.x * 512 + tid_; i < 128 * DFF2; i += gridDim.x * 512) {
        const int pm = i / DFF2, cc = i % DFF2;
        if ((pm & 31) == 0 || cc >= DFF) continue;
        const float* h0 = halo + (size_t)(pm - 1) * 4 * DFF2; const float* h1 = halo + (size_t)pm * 4 * DFF2;
        float r[2];
#pragma unroll
        for (int rr = 0; rr < 2; ++rr) {
            float o[2];
#pragma unroll
            for (int gv = 0; gv < 2; ++gv) {
                const int c2 = cc + gv * DFF;
                const float xm2 = h0[2 * DFF2 + c2], xm1 = h0[3 * DFF2 + c2], x0 = h1[c2], x1 = h1[DFF2 + c2];
                o[gv] = rr == 0 ? bb[c2] + w[c2] * xm2 + w[DFF2 + c2] * xm1 + w[2 * DFF2 + c2] * x0 : bb[c2] + w[c2] * xm1 + w[DFF2 + c2] * x0 + w[2 * DFF2 + c2] * x1;
            }
            r[rr] = silu_f(o[0]) * o[1];
        }
        H[((size_t)pm * 256) * DFF + cc] = (bf16_t)(cvt_pk_bf16(r[0], 0.f) & 0xffffu);
        H[((size_t)pm * 256 + 1) * DFF + cc] = (bf16_t)(cvt_pk_bf16(r[1], 0.f) & 0xffffu);
    }
}

#define XB_TMO      128
#define XB_XCNT(j)  (256  + 64 * (j))
#define XB_XSUB(j)  (1280 + 64 * (j))
#define XB_XGEN(j)  (2304 + 64 * (j))
#define XB_TOP      3328
#define XB_TOPGEN   3392
#define XCD_BAR_WORDS 3456
#define XB_SPIN_CAP (1u << 18)

__device__ __forceinline__ unsigned xb_ld(unsigned* p)              { return __hip_atomic_load(p, __ATOMIC_RELAXED, __HIP_MEMORY_SCOPE_AGENT); }
__device__ __forceinline__ unsigned xb_add(unsigned* p, unsigned v) { return __hip_atomic_fetch_add(p, v, __ATOMIC_RELAXED, __HIP_MEMORY_SCOPE_AGENT); }
__device__ __forceinline__ unsigned xb_xcc_id() { return (unsigned)__builtin_amdgcn_s_getreg((3 << 11) | 20) & 0xFu; }
#define XB_SPIN(cond, bar) do { unsigned _sp = 0; while (cond) { __builtin_amdgcn_s_sleep(1); \
    if ((++_sp & 255u) == 0u) { if (xb_ld(&(bar)[XB_TMO])) break; if (_sp > XB_SPIN_CAP) { atomicAdd(&(bar)[XB_TMO], 1u); break; } } } } while (0)

struct XcdBarrier {
    unsigned* bar; unsigned x;
    volatile LAS unsigned* st;
};

__device__ __forceinline__ XcdBarrier xcd_barrier_post(unsigned* bar, volatile LAS unsigned* st) {
    XcdBarrier b; b.bar = bar; b.x = xb_xcc_id(); b.st = st;
    if (threadIdx.x == 0) (void)xb_add(&bar[XB_XCNT(b.x)], 1u);
    return b;
}
__device__ __forceinline__ void xcd_barrier_complete(unsigned* bar, unsigned x, unsigned& nloc, unsigned& nx) {
    const unsigned G = gridDim.x * gridDim.y * gridDim.z;
    unsigned sum, cnt, mine, sp = 0u;
    for (;;) {
        sum = 0u; cnt = 0u; mine = 0u;
#pragma unroll
        for (unsigned j = 0; j < 16; ++j) { const unsigned c = xb_ld(&bar[XB_XCNT(j)]); sum += c; cnt += (c > 0u) ? 1u : 0u; mine = (j == x) ? c : mine; }
        if (sum == G) break;
        __builtin_amdgcn_s_sleep(1);
        if ((++sp & 255u) == 0u) { if (xb_ld(&bar[XB_TMO])) break; if (sp > XB_SPIN_CAP) { atomicAdd(&bar[XB_TMO], 1u); break; } }
    }
    nloc = mine > 0u ? mine : 1u; nx = cnt > 0u ? cnt : 1u;
}

__device__ __forceinline__ void xcd_barrier(const XcdBarrier& b) {
    asm volatile("s_waitcnt vmcnt(0)" ::: "memory");
    __syncthreads();
    if (threadIdx.x == 0) {
        unsigned* bar = b.bar;
        __builtin_amdgcn_s_waitcnt(0);
        unsigned nloc = b.st[0], nx = b.st[1];
        if (nloc == 0u) { xcd_barrier_complete(bar, b.x, nloc, nx); b.st[0] = nloc; b.st[1] = nx; }
        const unsigned old = xb_add(&bar[XB_XSUB(b.x)], 1u);
        const unsigned gen = old / nloc;
        if (old + 1u == (gen + 1u) * nloc) {
            __builtin_amdgcn_fence(__ATOMIC_RELEASE, "agent");
            asm volatile("s_waitcnt vmcnt(0)" ::: "memory");
            const unsigned og = xb_add(&bar[XB_TOP], 1u);
            const unsigned tg = og / nx;
            if (og + 1u == (tg + 1u) * nx) xb_add(&bar[XB_TOPGEN], 1u);
            else XB_SPIN(xb_ld(&bar[XB_TOPGEN]) == tg, bar);
            __builtin_amdgcn_fence(__ATOMIC_ACQUIRE, "agent");
            xb_add(&bar[XB_XGEN(b.x)], 1u);
            asm volatile("s_waitcnt vmcnt(0)" ::: "memory");
        } else {
            XB_SPIN(xb_ld(&bar[XB_XGEN(b.x)]) == gen, bar);
            __builtin_amdgcn_fence(__ATOMIC_ACQUIRE, "agent");
            asm volatile("s_waitcnt vmcnt(0)" ::: "memory");
        }
    }
    __syncthreads();
}

__global__ void __launch_bounds__(512, 2) mega(Params pa) {
    extern __shared__ __attribute__((aligned(16))) unsigned char shm[];
    LAS unsigned char* lds = (LAS unsigned char*)shm;
    const int G = gridDim.x, bid = blockIdx.x;
    KP* pk = (KP*)__builtin_amdgcn_kernarg_segment_ptr();
    volatile LAS unsigned* bst = (volatile LAS unsigned*)(lds + LDS_BYTES - 16);
    XcdBarrier xb; xb.bar = nullptr; xb.x = 0; xb.st = bst;
    if (pa.coop) { if (threadIdx.x < 2) bst[threadIdx.x] = 0u; __syncthreads(); xb = xcd_barrier_post((unsigned*)(pa.ws + W_BAR), bst); }
    for (int ph = pa.ph_lo; ph < pa.ph_hi; ++ph) {
        if (ph > pa.ph_lo && pa.coop) { if (ph == pa.ph_lo + 1) { __threadfence(); cg::this_grid().sync(); } else xcd_barrier(xb); }
        asm volatile("" : "+s"(pk)); KP& p = *pk;
        if (ph == 0) { phase_prep(p, lds); continue; }
        if (ph == 42) { int tq = threadIdx.x; asm volatile("" : "+v"(tq)); const unsigned short* w16 = (const unsigned short*)p.ws; for (size_t i = (size_t)bid * 512 + tq; i < (size_t)59418624; i += (size_t)G * 512) p.out[i] = (float)w16[i * 4]; continue; }
        if (ph == 41) { int tq = threadIdx.x; asm volatile("" : "+v"(tq)); for (size_t i = (size_t)bid * 512 + tq; i < (size_t)59418624; i += (size_t)G * 512) { const float v = p.out[i]; if (!(fabsf(v) < 1e30f)) p.out[i] = 0.f; } continue; }
        const int l = (ph - 1) / 10, k = (ph - 1) % 10;
        bf16_t* XB = (bf16_t*)(p.ws + W_XB);
        switch (k) {
        case 0: { pg8::StaticOrder S; S.init(T_ALL, NPROJ, G, bid);
                  EpiIn E{(bf16_t*)(p.ws + W_PROJ), p.out, (float*)(p.ws + W_DTB), p.in[13], l};
                  pg8::gemm_phase(lds, pg8::Gemm{XB, (const bf16_t*)(p.ws + W_IN + l * W_IN_L), T_ALL, NPROJ, DM}, S, E); } break;
        case 1: for (int it = bid; it < 3 * NU64; it += G) { if (it < 2 * NU64) { if (M1_MASK & 1) ssd_states(p, lds, l, it >> 1, it & 1); } else if (M1_MASK & 2) gmlp_unit(p, lds, l, it - 2 * NU64); } break;
        case 2: for (int it = bid; it < 96 + NU64 + 768; it += G) { if (it < 96) scan_prompt(p, l, it); else if (it < 96 + NU64) attn_unit(p, lds, l, it - 96); else scan_sample(p, l, it - 96 - NU64); } break;
        case 3: for (int it = bid; it < NU64; it += G) ssd_y(p, lds, l, it); break;
        case 4: { pg8::StaticOrder S; S.init(T_ALL, DM, G, bid); EpiRes E{p.out};
                  pg8::gemm_phase(lds, pg8::Gemm{(const bf16_t*)(p.ws + W_MIX), (const bf16_t*)(p.ws + W_OUT + l * W_OUT_L), T_ALL, DM, DM}, S, E); } break;
        case 5: phase_ln(p, p.in[20] + l * DM, p.in[21] + l * DM); break;
        case 6: { pg8::StaticOrder S; S.init(T_ALL, DFF2, G, bid);
                  EpiUp E{(bf16_t*)(p.ws + W_PROJ), (float*)(p.ws + W_MIX), p.out, p.in[23], p.in[24], p.in[6], l};
                  pg8::OneUnit o1;
                  for (int i = 0; S.next(i, o1.u); ++i) { pg8::gemm_phase(lds, pg8::Gemm{XB, (const bf16_t*)(p.ws + W_UP + l * W_UP_L), T_ALL, DFF2, DM}, o1, E); __syncthreads(); } } break;
        case 7: phase_fix(p, l); break;
        case 8: { pg8::StaticOrder S; S.init(T_ALL, DM, G, bid); EpiRes E{p.out};
                  pg8::gemm_phase(lds, pg8::Gemm{(const bf16_t*)(p.ws + W_PROJ), (const bf16_t*)(p.ws + W_DN + l * W_DN_L), T_ALL, DM, DFF}, S, E); } break;
        case 9: phase_ln(p, p.in[26] + l * DM, p.in[27] + l * DM); break;
        }
    }
}

constexpr int N_PHASES = 41;
#ifndef MULTI_LAUNCH
#define MULTI_LAUNCH 0
#endif

extern "C" void kernel_launch(void* const* d_in, const int* in_sizes, int n_in, void* d_out, int out_size, void* d_ws, size_t ws_size, hipStream_t stream) {
    static int grid = 0;
    if (grid == 0) {
        if (n_in != 28 || ws_size < W_END2) { fprintf(stderr, "kernel_launch: need 28 inputs and %zu bytes of workspace (got %d, %zu)\n", (size_t)W_END2, n_in, ws_size); grid = -1; return; }
        int dev = 0, cus = 0, per_cu = 0;
        hipGetDevice(&dev); hipDeviceGetAttribute(&cus, hipDeviceAttributeMultiprocessorCount, dev);
        if (hipFuncSetAttribute((const void*)mega, hipFuncAttributeMaxDynamicSharedMemorySize, LDS_BYTES) != hipSuccess) { fprintf(stderr, "kernel_launch: hipFuncSetAttribute failed\n"); grid = -1; return; }
        hipOccupancyMaxActiveBlocksPerMultiprocessor(&per_cu, (const void*)mega, 512, LDS_BYTES);
        (void)hipGetLastError();
        if (per_cu < 1) per_cu = 1;
        grid = cus * 1;
    }
    if (grid < 0) return;
    Params p{};
    for (int i = 0; i < 28; ++i) p.in[i] = (const float*)d_in[i];
    p.out = (float*)d_out; p.ws = (unsigned char*)d_ws;
#if MULTI_LAUNCH
#ifdef PROBE_CUT
    for (int ph = 0; ph < PROBE_CUT; ++ph) { p.ph_lo = ph; p.ph_hi = ph + 1; p.coop = 0; hipLaunchKernelGGL(mega, dim3(grid), dim3(512), LDS_BYTES, stream, p); }
    p.ph_lo = 42; p.ph_hi = 43; p.coop = 0; hipLaunchKernelGGL(mega, dim3(grid), dim3(512), LDS_BYTES, stream, p);
#else
    for (int ph = 0; ph < N_PHASES; ++ph) { p.ph_lo = ph; p.ph_hi = ph + 1; p.coop = 0; hipLaunchKernelGGL(mega, dim3(grid), dim3(512), LDS_BYTES, stream, p); }
#endif
#else
    p.ph_lo = 0; p.ph_hi = N_PHASES; p.coop = 1;
    if (hipMemsetAsync((char*)d_ws + W_BAR, 0, 16384, stream) != hipSuccess) { fprintf(stderr, "kernel_launch: memset failed\n"); return; }
    void* args[] = {&p};
    hipError_t e = hipLaunchCooperativeKernel((const void*)mega, dim3(grid), dim3(512), args, LDS_BYTES, stream);
    if (e != hipSuccess) fprintf(stderr, "cooperative launch failed: %s (grid %d)\n", hipGetErrorString(e), grid);
#endif
}
```

```cpp
#define M1_MASK 3
#include <hip/hip_runtime.h>
#include <hip/hip_cooperative_groups.h>
#include <cstdio>
namespace cg = cooperative_groups;

#define LAS __attribute__((address_space(3)))
typedef unsigned short bf16_t;
typedef short bf16x8 __attribute__((ext_vector_type(8)));
typedef float f32x4 __attribute__((ext_vector_type(4)));
typedef float f32x2 __attribute__((ext_vector_type(2)));
typedef unsigned u32x4 __attribute__((ext_vector_type(4)));
typedef unsigned u32x2 __attribute__((ext_vector_type(2)));

constexpr int T_ALL = 34816, T_P = 32768, DM = 1024, NPROJ = 3072, DFF = 2816, DFF2 = 5632, DEPTH = 4;
constexpr int NU64 = 544;
constexpr float ALPHA = 1.6817928305074290f;
constexpr float LN_EPS = 1e-5f, RMS_EPS = 1e-5f;
constexpr int C_K = 384, C_V = 768, C_Z = 1152, C_XBC = 1536, C_U = 2432, C_VC = 2688, C_DT = 2944;
constexpr size_t O_YP = 0, O_YS = 33554432, O_PK = 35651584, O_PV = O_PK + 3145728, O_PH = O_PV + 3145728, O_PC = O_PH + 786432,
                 O_PF = O_PC + 43008, O_SK = O_PF + 180224, O_SV = O_SK + 3145728, O_SH = O_SV + 3145728, O_SC = O_SH + 6291456,
                 O_SG = O_SC + 344064, O_SF = O_SG + 2097152;
constexpr size_t W_IN = 0, W_IN_L = (size_t)NPROJ * DM * 2;
constexpr size_t W_OUT = W_IN + 4 * W_IN_L, W_OUT_L = (size_t)DM * DM * 2;
constexpr size_t W_UP = W_OUT + 4 * W_OUT_L, W_UP_L = (size_t)DFF2 * DM * 2;
constexpr size_t W_DN = W_UP + 4 * W_UP_L, W_DN_L = (size_t)DM * DFF * 2;
constexpr size_t W_GW = W_DN + 4 * W_DN_L, W_GW_L = (size_t)4 * 128 * 128 * 2;
constexpr size_t W_XB = W_GW + 4 * W_GW_L;
constexpr size_t W_PROJ = W_XB + (size_t)T_ALL * DM * 2;
constexpr size_t W_MIX = W_PROJ + (size_t)T_ALL * NPROJ * 2;
constexpr size_t W_ST = W_MIX + (size_t)T_ALL * DM * 2;
constexpr size_t W_CD = W_ST + (size_t)NU64 * 6 * 8192 * 2;
constexpr size_t W_DTB = W_CD + (size_t)NU64 * 8 * 4;
constexpr size_t W_END = W_DTB + (size_t)T_ALL * 8 * 4;
constexpr size_t W_BAR = W_END;
constexpr size_t W_END2 = W_BAR + 16384;
constexpr int LDS_BYTES = 136 * 1024;

struct Params { const float* in[28]; float* out; unsigned char* ws; int ph_lo, ph_hi, coop, pad; };
typedef const __attribute__((address_space(4))) Params KP;

__device__ __forceinline__ float bf2f(unsigned b) { return __uint_as_float(b << 16); }
typedef __bf16 bf16v2 __attribute__((ext_vector_type(2)));
__device__ __forceinline__ unsigned cvt_pk_bf16(float lo, float hi) { const f32x2 v = {lo, hi}; const bf16v2 b = __builtin_convertvector(v, bf16v2); return __builtin_bit_cast(unsigned, b); }
__device__ __forceinline__ u32x2 pack4(f32x4 v) { u32x2 w; w.x = cvt_pk_bf16(v[0], v[1]); w.y = cvt_pk_bf16(v[2], v[3]); return w; }
__device__ __forceinline__ f32x4 unpack4(u32x2 w) { f32x4 v; v[0] = bf2f(w.x & 0xffffu); v[1] = bf2f(w.x >> 16); v[2] = bf2f(w.y & 0xffffu); v[3] = bf2f(w.y >> 16); return v; }
__device__ __forceinline__ float silu_f(float x) { return x / (1.0f + __expf(-x)); }
__device__ __forceinline__ float gelu_tanh(float x) { const float y = 0.7978845608028654f * (x + 0.044715f * x * x * x); const float e = __expf(2.0f * y); return 0.5f * x * (2.0f - 2.0f / (1.0f + e)); }
__device__ __forceinline__ float softplus_f(float x) { const float e = __expf(x); return x > 15.0f ? x : (e < 1e-3f ? e * (1.0f - 0.5f * e + 0.33333333f * e * e) : __logf(1.0f + e)); }
#define MFMA16(colfrag, rowfrag, acc) __builtin_amdgcn_mfma_f32_16x16x32_bf16((colfrag), (rowfrag), (acc), 0, 0, 0)
__device__ __forceinline__ bf16x8 ldsfrag(LAS const unsigned char* p) { return *(LAS const bf16x8*)p; }
__device__ __forceinline__ bf16x8 glbfrag(const bf16_t* p) { return *(const bf16x8*)p; }
#define LDS_WAVE_SYNC() asm volatile("s_waitcnt lgkmcnt(0)" ::: "memory")

namespace pg8 {
constexpr int BM = 256, BK = 64, HALF = 128, HTB = HALF * BK * 2, STAGE_BYTES = 8 * HTB, NXCD = 8, WGM = 8;
__device__ __forceinline__ int lds_byte(int r, int c) { const int st = (r >> 4) * 2 + (c >> 5), rr = r & 15, cc = c & 31, ob = rr * 64 + cc * 2; return st * 1024 + (ob ^ (((ob >> 9) & 1) << 5)); }
__device__ __forceinline__ void stage_rc(int b, int& R, int& C) { const int st = b / 1024, sb = b % 1024, swz = sb ^ (((sb >> 9) & 1) << 5); R = (st >> 1) * 16 + swz / 64; C = (st & 1) * 32 + (swz % 64) / 2; }
struct Unit { int pm, pn; };
struct Gemm { const bf16_t* A; const bf16_t* Bt; int M, N, K; };
struct StaticOrder {
    int nM, nN, nwg, G, c;
    __device__ __forceinline__ void init(int M, int N, int G_, int c_) { nM = M / BM; nN = N / BM; nwg = nM * nN; G = G_; c = c_; }
    __device__ __forceinline__ bool next(int i, Unit& u) const {
        const long L = (long)i * G + c; if (L >= nwg) return false;
        int wgid = (int)L; { const int q = nwg / NXCD, r = nwg % NXCD, xcd = wgid % NXCD, off = wgid / NXCD; wgid = (xcd < r ? xcd * (q + 1) : r * (q + 1) + (xcd - r) * q) + off; }
        const int nig = WGM * nN, gid = wgid / nig, fm = gid * WGM, gsz = (nM - fm) < WGM ? (nM - fm) : WGM;
        u.pm = fm + ((wgid % nig) % gsz); u.pn = (wgid % nig) / gsz; return true;
    }
    __device__ __forceinline__ void a_ready(const Unit&) const {}
    __device__ __forceinline__ void done(const Unit&) const {}
};
struct OneUnit {
    Unit u;
    __device__ __forceinline__ bool next(int i, Unit& o) const { if (i) return false; o = u; return true; }
    __device__ __forceinline__ void a_ready(const Unit&) const {}
    __device__ __forceinline__ void done(const Unit&) const {}
};

template <class Epi, class Sched>
__device__ __forceinline__ void gemm_phase(LAS unsigned char* lds, const Gemm g, const Sched& S, const Epi& E) {
    int tid_ = threadIdx.x; asm volatile("" : "+v"(tid_));
    const int tid = tid_, wid = __builtin_amdgcn_readfirstlane(tid >> 6), lane = tid & 63, wr = wid >> 2, wc = wid & 3, fr = lane & 15, fq = lane >> 4;
    const int K = g.K, nt = K / BK;
    unsigned voffA[2];
#pragma unroll
    for (int i = 0; i < 2; ++i) { int R, C; stage_rc(tid * 16 + i * 8192, R, C); voffA[i] = (unsigned)(R * K + C) * 2u; }
    const size_t kstep = (size_t)(BK * 2);
    const size_t hstep = (size_t)HALF * K * 2;
    const size_t tstep = 2 * hstep;
    const unsigned ldsw = (unsigned)wid * 1024u;
    const int aoff = lds_byte(wr * 64 + fr, fq * 8), boff = lds_byte(wc * 32 + fr, fq * 8);
#define PG8_SA(b, h) (((b) * 2 + (h)) * HTB)
#define PG8_SB(b, h) ((4 + (b) * 2 + (h)) * HTB)
#define PG8_STAGE(bufoff, gbase, voff) do { _Pragma("unroll") for (int _i = 0; _i < 2; ++_i) \
        __builtin_amdgcn_global_load_lds((const unsigned*)((const char*)(gbase) + (voff)[_i]), (LAS unsigned*)(lds + (bufoff) + ldsw + _i * 8192), 16, 0, 0); } while (0)
#define PG8_LDA(dst, b, h) do { _Pragma("unroll") for (int m = 0; m < 4; ++m) _Pragma("unroll") for (int k = 0; k < 2; ++k) dst[m][k] = *(const LAS bf16x8*)(lds + PG8_SA(b, h) + aoff + m * 2048 + k * 1024); } while (0)
#define PG8_LDB(dst, b, h) do { _Pragma("unroll") for (int n = 0; n < 2; ++n) _Pragma("unroll") for (int k = 0; k < 2; ++k) dst[n][k] = *(const LAS bf16x8*)(lds + PG8_SB(b, h) + boff + n * 2048 + k * 1024); } while (0)
#define PG8_MMA(ai, bj, At, Bt) do { __builtin_amdgcn_s_setprio(1); _Pragma("unroll") for (int m = 0; m < 4; ++m) _Pragma("unroll") for (int n = 0; n < 2; ++n) _Pragma("unroll") for (int k = 0; k < 2; ++k) \
        acc[ai][bj][m][n] = __builtin_amdgcn_mfma_f32_16x16x32_bf16(Bt[n][k], At[m][k], acc[ai][bj][m][n], 0, 0, 0); __builtin_amdgcn_s_setprio(0); } while (0)
#define PG8_WAIT_V(n) asm volatile("s_waitcnt vmcnt(" #n ")" ::: "memory")
#define PG8_WAIT_L(n) asm volatile("s_waitcnt lgkmcnt(" #n ")" ::: "memory")
#define PG8_BAR __builtin_amdgcn_s_barrier()
#define PG8_SCHED __builtin_amdgcn_sched_barrier(0)
    Unit cur, nxt; int ui = 0;
    if (!S.next(0, cur)) return;
    f32x4 acc[2][2][4][2];
#pragma unroll
    for (int a = 0; a < 2; ++a)
#pragma unroll
        for (int b = 0; b < 2; ++b)
#pragma unroll
            for (int m = 0; m < 4; ++m)
#pragma unroll
                for (int n = 0; n < 2; ++n) acc[a][b][m][n] = (f32x4){0.f, 0.f, 0.f, 0.f};
    bf16x8 At[4][2], B0[2][2], B1[2][2];
    const char* cA = (const char*)g.A + (size_t)cur.pm * tstep; const char* cB = (const char*)g.Bt + (size_t)cur.pn * tstep;
    S.a_ready(cur);
    PG8_STAGE(PG8_SB(0, 0), cB, voffA); PG8_STAGE(PG8_SA(0, 0), cA, voffA); PG8_STAGE(PG8_SB(0, 1), cB + hstep, voffA); PG8_STAGE(PG8_SA(0, 1), cA + hstep, voffA);
    if (wr == 1) PG8_BAR;
    PG8_WAIT_V(4); PG8_BAR;
    PG8_STAGE(PG8_SB(1, 0), cB + kstep, voffA); PG8_STAGE(PG8_SA(1, 0), cA + kstep, voffA); PG8_STAGE(PG8_SB(1, 1), cB + hstep + kstep, voffA);
    PG8_WAIT_V(6); PG8_BAR;
    for (;;) {
        const bool has_next = S.next(ui + 1, nxt);
        const char* nA = has_next ? (const char*)g.A + (size_t)nxt.pm * tstep : cA; const char* nB = has_next ? (const char*)g.Bt + (size_t)nxt.pn * tstep : cB;
        for (int t = 0; t < nt; t += 2) {
            const bool last = (t == nt - 2);
            const char* a1 = cA + (size_t)(t + 1) * kstep;
            const char* a2 = last ? nA : cA + (size_t)(t + 2) * kstep; const char* b2 = last ? nB : cB + (size_t)(t + 2) * kstep;
            const char* a3 = a2 + kstep; const char* b3 = b2 + kstep;
            if (last && has_next) S.a_ready(nxt);
            PG8_LDB(B0, 0, 0); PG8_SCHED; PG8_LDA(At, 0, 0); PG8_STAGE(PG8_SA(1, 1), a1 + hstep, voffA);
            PG8_WAIT_L(8); PG8_BAR; PG8_WAIT_L(0); PG8_MMA(0, 0, At, B0); PG8_BAR; PG8_SCHED;
            PG8_LDB(B1, 0, 1); PG8_STAGE(PG8_SB(0, 0), b2, voffA);
            PG8_BAR; PG8_WAIT_L(0); PG8_MMA(0, 1, At, B1); PG8_BAR;
            PG8_LDA(At, 0, 1); PG8_STAGE(PG8_SA(0, 0), a2, voffA);
            PG8_BAR; PG8_WAIT_L(0); PG8_MMA(1, 0, At, B0); PG8_BAR; PG8_SCHED;
            PG8_STAGE(PG8_SB(0, 1), b2 + hstep, voffA);
            PG8_WAIT_V(6); PG8_BAR; PG8_MMA(1, 1, At, B1); PG8_BAR;
            PG8_LDB(B0, 1, 0); PG8_SCHED; PG8_LDA(At, 1, 0); PG8_STAGE(PG8_SA(0, 1), a2 + hstep, voffA);
            PG8_WAIT_L(8); PG8_BAR; PG8_WAIT_L(0); PG8_MMA(0, 0, At, B0); PG8_BAR; PG8_SCHED;
            PG8_LDB(B1, 1, 1); PG8_STAGE(PG8_SB(1, 0), b3, voffA);
            PG8_BAR; PG8_WAIT_L(0); PG8_MMA(0, 1, At, B1); PG8_BAR;
            PG8_LDA(At, 1, 1); PG8_STAGE(PG8_SA(1, 0), a3, voffA);
            PG8_BAR; PG8_WAIT_L(0); PG8_MMA(1, 0, At, B0); PG8_BAR; PG8_SCHED;
            PG8_STAGE(PG8_SB(1, 1), b3 + hstep, voffA);
            PG8_WAIT_V(6); PG8_BAR; PG8_MMA(1, 1, At, B1); PG8_BAR;
        }
        if constexpr (!Epi::AFTER_DRAIN) { E(acc, cur, wr, wc, fr, fq); S.done(cur); }
        if (!has_next) break;
#pragma unroll
        for (int a = 0; a < 2; ++a)
#pragma unroll
            for (int b = 0; b < 2; ++b)
#pragma unroll
                for (int m = 0; m < 4; ++m)
#pragma unroll
                    for (int n = 0; n < 2; ++n) acc[a][b][m][n] = (f32x4){0.f, 0.f, 0.f, 0.f};
        cur = nxt; cA = nA; cB = nB; ++ui;
    }
    PG8_WAIT_V(0);
    if (wr == 0) PG8_BAR;
    PG8_BAR;
    if constexpr (Epi::AFTER_DRAIN) { E.fused(acc, cur, wr, wc, fr, fq, lds, wid, lane); S.done(cur); }
#undef PG8_SA
#undef PG8_SB
#undef PG8_STAGE
#undef PG8_LDA
#undef PG8_LDB
#undef PG8_MMA
#undef PG8_WAIT_V
#undef PG8_WAIT_L
#undef PG8_BAR
#undef PG8_SCHED
}
}
using pg8::Unit;

struct EpiIn {
    static constexpr bool AFTER_DRAIN = false;
    bf16_t* proj; float* out; float* dtb; const float* dt_bias; int l;
    __device__ __forceinline__ void operator()(const f32x4 (&acc)[2][2][4][2], const Unit& u, int wr, int wc, int fr_, int fq_) const {
        int fr = fr_, fq = fq_; asm volatile("" : "+v"(fr), "+v"(fq));
#pragma unroll
        for (int ai = 0; ai < 2; ++ai)
#pragma unroll
            for (int m = 0; m < 4; ++m) {
                const int row = u.pm * 256 + ai * 128 + wr * 64 + m * 16 + fr;
                const bool isP = row < T_P; int b, t;
                if (isP) { b = row >> 13; t = row & 8191; } else { b = (row - T_P) >> 6; t = row & 63; }
#pragma unroll
                for (int bj = 0; bj < 2; ++bj)
#pragma unroll
                    for (int n = 0; n < 2; ++n) {
                        const int col = u.pn * 256 + bj * 128 + wc * 32 + n * 16 + fq * 4;
                        f32x4 v = acc[ai][bj][m][n];
                        if (col < C_U) {
                            *(u32x2*)(proj + (size_t)row * NPROJ + col) = pack4(v);
                            if (col >= C_K && col < C_Z) {
                                const int isv = col >= C_V; const int cc = col - (isv ? C_V : C_K);
                                if (isP) { if (t >= 7680) *(f32x4*)(out + (isv ? O_PV : O_PK) + ((size_t)(l * 4 + b) * 512 + (t - 7680)) * 384 + cc) = v; }
                                else *(f32x4*)(out + (isv ? O_SV : O_SK) + ((size_t)(l * 32 + b) * 64 + t) * 384 + cc) = v;
                            } else if (col >= C_XBC) {
                                const int cc = col - C_XBC;
                                if (isP) { if (t >= 8189) *(f32x4*)(out + O_PC + ((size_t)(l * 4 + b) * 3 + (t - 8189)) * 896 + cc) = v; }
                                else if (t >= 61) *(f32x4*)(out + O_SC + ((size_t)(l * 32 + b) * 3 + (t - 61)) * 896 + cc) = v;
                            }
                        } else if (col < C_DT) {
#pragma unroll
                            for (int j = 0; j < 4; ++j) v[j] = gelu_tanh(v[j]);
                            *(u32x2*)(proj + (size_t)row * NPROJ + col) = pack4(v);
                            if (col >= C_VC && !isP) *(f32x4*)(out + O_SG + ((size_t)(l * 32 + b) * 64 + t) * 256 + (col - C_VC)) = v;
                        } else if (col < C_DT + 8) {
#pragma unroll
                            for (int j = 0; j < 4; ++j) { const int hh = col + j - C_DT; if (hh < 6) dtb[(size_t)row * 8 + hh] = softplus_f(v[j] + dt_bias[l * 6 + hh]); }
                        }
                    }
                asm volatile("" ::: "memory");
            }
    }
};
struct EpiRes {
    static constexpr bool AFTER_DRAIN = false;
    float* x;
    __device__ __forceinline__ void operator()(const f32x4 (&acc)[2][2][4][2], const Unit& u, int wr, int wc, int fr_, int fq_) const {
        int fr = fr_, fq = fq_; asm volatile("" : "+v"(fr), "+v"(fq));
#pragma unroll
        for (int ai = 0; ai < 2; ++ai)
#pragma unroll
            for (int m = 0; m < 4; ++m) {
                float* rowp = x + (size_t)(u.pm * 256 + ai * 128 + wr * 64 + m * 16 + fr) * DM + u.pn * 256 + wc * 32 + fq * 4;
#pragma unroll
                for (int bj = 0; bj < 2; ++bj)
#pragma unroll
                    for (int n = 0; n < 2; ++n) { float* q = rowp + bj * 128 + n * 16; const f32x4 o = *(const f32x4*)q; *(f32x4*)q = o * ALPHA + acc[ai][bj][m][n]; }
                asm volatile("" ::: "memory");
            }
    }
};
struct EpiUp {
    static constexpr bool AFTER_DRAIN = true;
    bf16_t* H; float* halo; float* out; const float* cw; const float* cb; const float* fstate; int l;
    __device__ __forceinline__ void operator()(const f32x4 (&)[2][2][4][2], const Unit&, int, int, int, int) const {}
    __device__ __forceinline__ void fused(f32x4 (&acc)[2][2][4][2], const Unit& u, int wr, int wc, int fr, int fq, LAS unsigned char* lds, int wid, int lane) const {
        constexpr int LS = 260;
#pragma unroll
        for (int ai = 0; ai < 2; ++ai)
#pragma unroll
            for (int m = 0; m < 4; ++m)
#pragma unroll
                for (int bj = 0; bj < 2; ++bj)
#pragma unroll
                    for (int n = 0; n < 2; ++n) {
                        const int rl = ai * 128 + wr * 64 + m * 16 + fr, cl = bj * 128 + wc * 32 + n * 16 + fq * 4;
                        *(LAS u32x2*)(lds + (rl * LS + cl) * 2) = pack4(acc[ai][bj][m][n]);
                    }
        __syncthreads();
        const int tid = wid * 64 + lane, j = tid & 127, seg = tid >> 7;
        const int hcol = u.pn * 128 + j;
        const float* w = cw + (size_t)l * 3 * DFF2; const float* bb = cb + (size_t)l * DFF2;
        const float wg0 = w[hcol], wg1 = w[DFF2 + hcol], wg2 = w[2 * DFF2 + hcol], bg = bb[hcol];
        const float wv0 = w[DFF + hcol], wv1 = w[DFF2 + DFF + hcol], wv2 = w[2 * DFF2 + DFF + hcol], bv = bb[DFF + hcol];
        const int R = u.pm * 256 + seg * 64;
        const bool isP = R < T_P;
        float g2 = 0.f, g1 = 0.f, v2 = 0.f, v1 = 0.f; int skip = 0;
        const LAS bf16_t* U = (const LAS bf16_t*)lds;
        if (isP) {
            if (seg > 0) { g2 = bf2f(U[(seg * 64 - 2) * LS + j]); g1 = bf2f(U[(seg * 64 - 1) * LS + j]); v2 = bf2f(U[(seg * 64 - 2) * LS + 128 + j]); v1 = bf2f(U[(seg * 64 - 1) * LS + 128 + j]); }
            else if ((R & 8191) != 0) skip = 2;
        } else {
            const int sb = (R - T_P) >> 6; const float* fs = fstate + (size_t)(l * 32 + sb) * 2 * DFF2;
            g2 = fs[hcol]; g1 = fs[DFF2 + hcol]; v2 = fs[DFF + hcol]; v1 = fs[DFF2 + DFF + hcol];
        }
        bf16_t* hp = H + (size_t)R * DFF + hcol;
        for (int i = 0; i < 64; ++i) {
            const float gq = bf2f(U[(seg * 64 + i) * LS + j]), vq = bf2f(U[(seg * 64 + i) * LS + 128 + j]);
            if (i >= skip) {
                const float cgv = bg + wg0 * g2 + wg1 * g1 + wg2 * gq, cvv = bv + wv0 * v2 + wv1 * v1 + wv2 * vq;
                const float hv = silu_f(cgv) * cvv;
                hp[(size_t)i * DFF] = (bf16_t)(cvt_pk_bf16(hv, 0.f) & 0xffffu);
            }
            g2 = g1; g1 = gq; v2 = v1; v1 = vq;
            if (isP) {
                if (seg == 0 && i < 2) { float* hl = halo + ((size_t)u.pm * 4 + i) * DFF2; hl[hcol] = gq; hl[DFF + hcol] = vq; }
                if (seg == 3 && i >= 62) { float* hl = halo + ((size_t)u.pm * 4 + 2 + (i - 62)) * DFF2; hl[hcol] = gq; hl[DFF + hcol] = vq;
                    if ((u.pm & 31) == 31) { float* o = out + O_PF + ((size_t)(l * 4 + (u.pm >> 5)) * 2 + (i - 62)) * DFF2; o[hcol] = gq; o[DFF + hcol] = vq; } }
            } else if (i >= 62) {
                const int sb = (R - T_P) >> 6; float* o = out + O_SF + ((size_t)(l * 32 + sb) * 2 + (i - 62)) * DFF2; o[hcol] = gq; o[DFF + hcol] = vq;
            }
        }
    }
};

__device__ __forceinline__ void ln_row(const float* src, float* x32, bf16_t* xb, const float* g, const float* b, int lane) {
    f32x4 v[4]; float s = 0.f;
#pragma unroll
    for (int i = 0; i < 4; ++i) { v[i] = *(const f32x4*)(src + i * 256 + lane * 4); s += (v[i][0] + v[i][1]) + (v[i][2] + v[i][3]); }
#pragma unroll
    for (int o = 32; o >= 1; o >>= 1) s += __shfl_xor(s, o);
    const float mu = s * (1.0f / 1024.0f); float q = 0.f;
#pragma unroll
    for (int i = 0; i < 4; ++i) { const f32x4 d = v[i] - mu; q += (d[0] * d[0] + d[1] * d[1]) + (d[2] * d[2] + d[3] * d[3]); }
#pragma unroll
    for (int o = 32; o >= 1; o >>= 1) q += __shfl_xor(q, o);
    const float rstd = 1.0f / sqrtf(q * (1.0f / 1024.0f) + LN_EPS);
#pragma unroll
    for (int i = 0; i < 4; ++i) {
        const f32x4 gg = *(const f32x4*)(g + i * 256 + lane * 4), bb = *(const f32x4*)(b + i * 256 + lane * 4);
        const f32x4 o = (v[i] - mu) * rstd * gg + bb;
        *(f32x4*)(x32 + i * 256 + lane * 4) = o; *(u32x2*)(xb + i * 256 + lane * 4) = pack4(o);
    }
}

__device__ __forceinline__ void tr_tile(LAS float* tile, const float* src, int Nsrc, bf16_t* dst, int K, int n0, int k0, int mode, int tid) {
    const int nn = tid & 63, np = n0 + nn; int sc;
    if (mode == 0) sc = np < C_U ? np : (np < C_DT ? np + 6 : (np < C_DT + 6 ? np - 512 : -1));
    else if (mode == 1) sc = np;
    else { const int pn = np >> 8, jj = np & 255; sc = jj < 128 ? pn * 128 + jj : DFF + pn * 128 + (jj - 128); }
#pragma unroll
    for (int i = 0; i < 8; ++i) { const int kk = (tid >> 6) + 8 * i; tile[kk * 65 + nn] = sc >= 0 ? src[(size_t)(k0 + kk) * Nsrc + sc] : 0.f; }
    __syncthreads();
    const int kk2 = (tid & 31) * 2;
#pragma unroll
    for (int i = 0; i < 4; ++i) { const int nn2 = (tid >> 5) + 16 * i; *(unsigned*)(dst + (size_t)(n0 + nn2) * K + k0 + kk2) = cvt_pk_bf16(tile[kk2 * 65 + nn2], tile[(kk2 + 1) * 65 + nn2]); }
    __syncthreads();
}

__device__ __forceinline__ void phase_prep(KP& p, LAS unsigned char* lds) {
    int tid_ = threadIdx.x; asm volatile("" : "+v"(tid_));
    const int tid = tid_, wid = tid >> 6, lane = tid & 63;
    for (int row = blockIdx.x * 8 + wid; row < T_ALL; row += gridDim.x * 8) {
        const float* src = row < T_P ? p.in[0] + (size_t)row * DM : p.in[1] + (size_t)(row - T_P) * DM;
        ln_row(src, p.out + (size_t)row * DM, (bf16_t*)(p.ws + W_XB) + (size_t)row * DM, p.in[7], p.in[8], lane);
    }
    constexpr int T_IN = 48 * 16, T_OUT = 16 * 16, T_UPT = 88 * 16, T_DNT = 16 * 44, T_L = T_IN + T_OUT + T_UPT + T_DNT;
    for (int it = blockIdx.x; it < 4 * T_L; it += gridDim.x) {
        const int l = it / T_L; int r = it % T_L;
        if (r < T_IN) tr_tile((LAS float*)lds, p.in[9] + (size_t)l * DM * 2950, 2950, (bf16_t*)(p.ws + W_IN + l * W_IN_L), DM, (r >> 4) * 64, (r & 15) * 64, 0, tid);
        else if ((r -= T_IN) < T_OUT) tr_tile((LAS float*)lds, p.in[19] + (size_t)l * DM * DM, DM, (bf16_t*)(p.ws + W_OUT + l * W_OUT_L), DM, (r >> 4) * 64, (r & 15) * 64, 1, tid);
        else if ((r -= T_OUT) < T_UPT) tr_tile((LAS float*)lds, p.in[22] + (size_t)l * DM * DFF2, DFF2, (bf16_t*)(p.ws + W_UP + l * W_UP_L), DM, (r >> 4) * 64, (r & 15) * 64, 2, tid);
        else { r -= T_UPT; tr_tile((LAS float*)lds, p.in[25] + (size_t)l * DFF * DM, DM, (bf16_t*)(p.ws + W_DN + l * W_DN_L), DFF, (r / 44) * 64, (r % 44) * 64, 1, tid); }
    }
    for (int i = blockIdx.x * 512 + tid; i < 4 * 4 * 128 * 128; i += gridDim.x * 512) {
        const int jj = i & 127, ii = (i >> 7) & 127;
        ((bf16_t*)(p.ws + W_GW))[i] = (bf16_t)(cvt_pk_bf16(jj <= ii ? p.in[16][i] : 0.f, 0.f) & 0xffffu);
    }
}

__device__ __forceinline__ void phase_ln(KP& p, const float* g, const float* b) {
    int tid_ = threadIdx.x; asm volatile("" : "+v"(tid_));
    const int wid = tid_ >> 6, lane = tid_ & 63;
    for (int row = blockIdx.x * 8 + wid; row < T_ALL; row += gridDim.x * 8)
        ln_row(p.out + (size_t)row * DM, p.out + (size_t)row * DM, (bf16_t*)(p.ws + W_XB) + (size_t)row * DM, g, b, lane);
}

__device__ __forceinline__ void dt_scan(KP& p, int l, int u, int g, int wid, int lane, float& dt, float& ac, float& last) {
    const int h = g * 3 + wid;
    dt = ((const float*)(p.ws + W_DTB))[(size_t)(u * 64 + lane) * 8 + h];
    const float a = -__expf(p.in[14][l * 6 + h]);
    float v = dt * a;
#pragma unroll
    for (int o = 1; o < 64; o <<= 1) { const float t = __shfl_up(v, o); if (lane >= o) v += t; }
    ac = v; last = __shfl(v, 63);
}

__device__ __forceinline__ f32x4 xbc_row(KP& p, int l, int u, int s, int ch) {
    const bf16_t* proj = (const bf16_t*)(p.ws + W_PROJ);
    const bool isP = u < 512; const bool hasprev = isP && (u & 127) != 0;
    if (s >= 0 || hasprev) return unpack4(*(const u32x2*)(proj + (size_t)(u * 64 + s) * NPROJ + C_XBC + ch));
    if (!isP) return *(const f32x4*)(p.in[5] + (unsigned)(((l * 32 + (u - 512)) * 3 + (3 + s)) * 896 + ch));
    return (f32x4){0.f, 0.f, 0.f, 0.f};
}
__device__ __forceinline__ void ssd_states(KP& p, LAS unsigned char* lds, int l, int u) {
    int tid_ = threadIdx.x; asm volatile("" : "+v"(tid_));
    const int tid = tid_, wid = tid >> 6, lane = tid & 63, fr = lane & 15, fq = lane >> 4;
    LAS bf16_t* xT = (LAS bf16_t*)lds;
    LAS bf16_t* BT = (LAS bf16_t*)(lds + 55296);
    LAS float* wgt = (LAS float*)(lds + 92160);
    bf16_t* XC = (bf16_t*)(p.ws + W_XB);
    __syncthreads();
    if (wid < 6) {
        float dt, ac, last; dt_scan(p, l, u, wid / 3, wid % 3, lane, dt, ac, last);
        wgt[wid * 64 + lane] = dt * __expf(last - ac);
        if (lane == 0) ((float*)(p.ws + W_CD))[u * 8 + wid] = __expf(last);
    }
    __syncthreads();
    if (tid < 448) {
        const int cgp = tid % 224, seg = tid / 224, ch = cgp * 4, r0 = seg * 32;
        const float* cw = p.in[11] + (size_t)l * 4 * 896 + ch;
        const f32x4 w0 = *(const f32x4*)cw, w1 = *(const f32x4*)(cw + 896), w2 = *(const f32x4*)(cw + 2 * 896), w3 = *(const f32x4*)(cw + 3 * 896);
        const f32x4 bs = *(const f32x4*)(p.in[12] + (size_t)l * 896 + ch);
        f32x4 xm3 = xbc_row(p, l, u, r0 - 3, ch), xm2 = xbc_row(p, l, u, r0 - 2, ch), xm1 = xbc_row(p, l, u, r0 - 1, ch);
        const bf16_t* src = (const bf16_t*)(p.ws + W_PROJ) + (size_t)(u * 64) * NPROJ + C_XBC + ch;
        bf16_t* dst = XC + (size_t)(u * 64) * 896 + ch;
        const int hh = ch >> 6;
#pragma unroll 2
        for (int i = r0; i < r0 + 32; i += 2) {
            const f32x4 xa = unpack4(*(const u32x2*)(src + (size_t)i * NPROJ)), xb = unpack4(*(const u32x2*)(src + (size_t)(i + 1) * NPROJ));
            f32x4 ya = bs + w0 * xm3 + w1 * xm2 + w2 * xm1 + w3 * xa, yb = bs + w0 * xm2 + w1 * xm1 + w2 * xa + w3 * xb;
#pragma unroll
            for (int e = 0; e < 4; ++e) { ya[e] = silu_f(ya[e]); yb[e] = silu_f(yb[e]); }
            xm3 = xm1; xm2 = xa; xm1 = xb;
            *(u32x2*)(dst + (size_t)i * 896) = pack4(ya); *(u32x2*)(dst + (size_t)(i + 1) * 896) = pack4(yb);
            if (ch < 384) { const float wa = wgt[hh * 64 + i], wb = wgt[hh * 64 + i + 1];
#pragma unroll
                for (int e = 0; e < 4; ++e) *(LAS unsigned*)(xT + (ch + e) * 72 + i) = cvt_pk_bf16(ya[e] * wa, yb[e] * wb); }
            else if (ch < 640) {
#pragma unroll
                for (int e = 0; e < 4; ++e) *(LAS unsigned*)(BT + (ch - 384 + e) * 72 + i) = cvt_pk_bf16(ya[e], yb[e]); }
        }
    }
    __syncthreads();
    bf16_t* ST = (bf16_t*)(p.ws + W_ST);
#pragma unroll 2
    for (int k = 0; k < 24; ++k) {
        const int tt = wid * 24 + k, h = tt >> 5, pt = (tt & 31) >> 3, nt = tt & 7, g = h / 3;
        f32x4 acc = (f32x4){0.f, 0.f, 0.f, 0.f};
#pragma unroll
        for (int ks = 0; ks < 2; ++ks) {
            const bf16x8 rf = ldsfrag((LAS const unsigned char*)(xT + (h * 64 + pt * 16 + fr) * 72 + ks * 32 + fq * 8));
            const bf16x8 cf = ldsfrag((LAS const unsigned char*)(BT + (g * 128 + nt * 16 + fr) * 72 + ks * 32 + fq * 8));
            acc = MFMA16(cf, rf, acc);
        }
        *(u32x2*)(ST + ((size_t)(u * 6 + h) * 64 + pt * 16 + fr) * 128 + nt * 16 + fq * 4) = pack4(acc);
    }
}

__device__ __forceinline__ void gmlp_unit(KP& p, LAS unsigned char* lds, int l, int u) {
    int tid_ = threadIdx.x; asm volatile("" : "+v"(tid_));
    const int tid = tid_, wid = tid >> 6, lane = tid & 63, fr = lane & 15, fq = lane >> 4;
    LAS bf16_t* vT = (LAS bf16_t*)lds;
    LAS float* ssq = (LAS float*)(lds + 69632);
    const bf16_t* proj = (const bf16_t*)(p.ws + W_PROJ);
    const int half = u < 512 ? (u & 1) : 0, KJ = (half + 1) * 64, R0 = u * 64, Rb = R0 - half * 64;
    __syncthreads();
    for (int idx = tid; idx < KJ * 32; idx += 512) {
        const int j = idx & (KJ - 1), cgp = idx / KJ;
        const u32x4 w = *(const u32x4*)(proj + (size_t)(Rb + j) * NPROJ + C_VC + cgp * 8);
        const unsigned ww[4] = {w.x, w.y, w.z, w.w};
#pragma unroll
        for (int e = 0; e < 4; ++e) { vT[(cgp * 8 + 2 * e) * 136 + j] = (bf16_t)(ww[e] & 0xffffu); vT[(cgp * 8 + 2 * e + 1) * 136 + j] = (bf16_t)(ww[e] >> 16); }
    }
    __syncthreads();
    const int rt = wid & 3, cbase = (wid >> 2) * 8;
    const bf16_t* GW = (const bf16_t*)(p.ws + W_GW + l * W_GW_L);
    f32x4 acc[8];
#pragma unroll
    for (int gi = 0; gi < 2; ++gi) {
        const int gg = (cbase >> 2) + gi;
        bf16x8 rf[4];
#pragma unroll
        for (int ks = 0; ks < 4; ++ks) rf[ks] = glbfrag(GW + ((size_t)gg * 128 + half * 64 + rt * 16 + fr) * 128 + ks * 32 + fq * 8);
#pragma unroll
        for (int c4 = 0; c4 < 4; ++c4) {
            const int ct = cbase + gi * 4 + c4;
            f32x4 a = (f32x4){0.f, 0.f, 0.f, 0.f};
#pragma unroll
            for (int ks = 0; ks < 4; ++ks) if (ks * 32 < KJ) a = MFMA16(ldsfrag((LAS const unsigned char*)(vT + (ct * 16 + fr) * 136 + ks * 32 + fq * 8)), rf[ks], a);
            acc[gi * 4 + c4] = a;
        }
    }
    const int row = R0 + rt * 16 + fr; float sq = 0.f;
#pragma unroll
    for (int k = 0; k < 8; ++k) {
        const int col = (cbase + k) * 16 + fq * 4, gg = col >> 6;
        const float bsv = p.in[17][(size_t)(l * 4 + gg) * 128 + half * 64 + rt * 16 + fr];
        const f32x4 uv = unpack4(*(const u32x2*)(proj + (size_t)row * NPROJ + C_U + col));
        f32x4 o = uv * (acc[k] + bsv); acc[k] = o;
        sq += (o[0] * o[0] + o[1] * o[1]) + (o[2] * o[2] + o[3] * o[3]);
    }
    sq += __shfl_xor(sq, 16); sq += __shfl_xor(sq, 32);
    if (fq == 0) ssq[(wid >> 2) * 64 + rt * 16 + fr] = sq;
    __syncthreads();
    const float rstd = 1.0f / sqrtf((ssq[rt * 16 + fr] + ssq[64 + rt * 16 + fr]) * (1.0f / 256.0f) + RMS_EPS);
    bf16_t* mix = (bf16_t*)(p.ws + W_MIX);
#pragma unroll
    for (int k = 0; k < 8; ++k) {
        const int col = (cbase + k) * 16 + fq * 4;
        const f32x4 gv = *(const f32x4*)(p.in[18] + (size_t)l * 1024 + 768 + col);
        *(u32x2*)(mix + (size_t)row * DM + 768 + col) = pack4(acc[k] * rstd * gv);
    }
}

__device__ __forceinline__ void scan_prompt(KP& p, int l, int item) {
    int tid_ = threadIdx.x; asm volatile("" : "+v"(tid_));
    const int gid = item * 512 + tid_, e = (gid & 2047) * 4, bh = gid >> 11, b = bh / 6, h = bh % 6;
    bf16_t* ST = (bf16_t*)(p.ws + W_ST); const float* CD = (const float*)(p.ws + W_CD);
    f32x4 st = (f32x4){0.f, 0.f, 0.f, 0.f};
#pragma unroll 1
    for (int c0 = 0; c0 < 128; c0 += 8) {
        u32x2 s[8]; float cd[8];
#pragma unroll
        for (int k = 0; k < 8; ++k) { const int u = b * 128 + c0 + k; s[k] = *(const u32x2*)(ST + ((size_t)(u * 6 + h)) * 8192 + e); cd[k] = CD[u * 8 + h]; }
#pragma unroll
        for (int k = 0; k < 8; ++k) { const int u = b * 128 + c0 + k; *(u32x2*)(ST + ((size_t)(u * 6 + h)) * 8192 + e) = pack4(st); st = st * cd[k] + unpack4(s[k]); }
    }
    *(f32x4*)(p.out + O_PH + ((size_t)(l * 4 + b) * 6 + h) * 8192 + e) = st;
}
__device__ __forceinline__ void scan_sample(KP& p, int l, int item) {
    int tid_ = threadIdx.x; asm volatile("" : "+v"(tid_));
    const int gid = item * 512 + tid_, e = (gid & 2047) * 4, sbh = gid >> 11, sb = sbh / 6, h = sbh % 6;
    bf16_t* ST = (bf16_t*)(p.ws + W_ST); const float* CD = (const float*)(p.ws + W_CD);
    const int u = 512 + sb;
    const f32x4 st = *(const f32x4*)(p.in[4] + ((size_t)(l * 32 + sb) * 6 + h) * 8192 + e);
    const f32x4 s = unpack4(*(const u32x2*)(ST + ((size_t)(u * 6 + h)) * 8192 + e));
    *(u32x2*)(ST + ((size_t)(u * 6 + h)) * 8192 + e) = pack4(st);
    *(f32x4*)(p.out + O_SH + ((size_t)(l * 32 + sb) * 6 + h) * 8192 + e) = st * CD[u * 8 + h] + s;
}

__device__ __forceinline__ void attn_unit(KP& p, LAS unsigned char* lds, int l, int u) {
    int tid_ = threadIdx.x; asm volatile("" : "+v"(tid_));
    const int tid = tid_, wid = tid >> 6, lane = tid & 63, fr = lane & 15, fq = lane >> 4;
    LAS bf16_t* Kb = (LAS bf16_t*)lds;
    LAS bf16_t* VT = (LAS bf16_t*)(lds + 50176);
    LAS bf16_t* Pw = (LAS bf16_t*)(lds + 105472) + wid * 16 * 72;
    LAS float* bias = (LAS float*)(lds + 123904);
    LAS float* ssq = (LAS float*)(lds + 128512);
    const bf16_t* proj = (const bf16_t*)(p.ws + W_PROJ);
    const bool isP = u < 512; const int R0 = u * 64, c = u & 127, b = u >> 7, sb = u - 512;
    const int qt = wid & 3, hbase = (wid >> 2) * 3;
    __syncthreads();
    for (int i = tid; i < 1152; i += 512) bias[i] = p.in[10][(size_t)l * 1152 + i];
    bf16x8 qf[3][2];
#pragma unroll
    for (int hh = 0; hh < 3; ++hh)
#pragma unroll
        for (int ks = 0; ks < 2; ++ks) qf[hh][ks] = glbfrag(proj + (size_t)(R0 + qt * 16 + fr) * NPROJ + (hbase + hh) * 64 + ks * 32 + fq * 8);
    float mrun[3], lrun[3]; f32x4 O[3][4];
#pragma unroll
    for (int hh = 0; hh < 3; ++hh) { mrun[hh] = -1e30f; lrun[hh] = 0.f;
#pragma unroll
        for (int d = 0; d < 4; ++d) O[hh][d] = (f32x4){0.f, 0.f, 0.f, 0.f}; }
    const int blk_lo = isP ? (c < 8 ? 8 - c : 0) : 0;
#pragma unroll 1
    for (int blk = blk_lo; blk <= 8; ++blk) {
        __syncthreads();
        const bool fromproj = isP || blk == 8;
        const size_t rowbase = isP ? (size_t)b * 8192 + (size_t)(c - 8 + blk) * 64 : (size_t)T_P + (size_t)sb * 64;
#pragma unroll 1
        for (int it = 0; it < 6; ++it) {
            const int idx = it * 512 + tid;
            { const int key = idx / 48, cgp = idx % 48; u32x4 w;
              if (fromproj) w = *(const u32x4*)(proj + (rowbase + key) * NPROJ + C_K + cgp * 8);
              else { const float* s = p.in[2] + ((size_t)(l * 32 + sb) * 512 + blk * 64 + key) * 384 + cgp * 8; const f32x4 a = *(const f32x4*)s, bq = *(const f32x4*)(s + 4);
                     w.x = cvt_pk_bf16(a[0], a[1]); w.y = cvt_pk_bf16(a[2], a[3]); w.z = cvt_pk_bf16(bq[0], bq[1]); w.w = cvt_pk_bf16(bq[2], bq[3]); }
              *(LAS u32x4*)(Kb + key * 392 + cgp * 8) = w; }
            { const int key = idx & 63, cgp = idx >> 6; u32x4 w;
              if (fromproj) w = *(const u32x4*)(proj + (rowbase + key) * NPROJ + C_V + cgp * 8);
              else { const float* s = p.in[3] + ((size_t)(l * 32 + sb) * 512 + blk * 64 + key) * 384 + cgp * 8; const f32x4 a = *(const f32x4*)s, bq = *(const f32x4*)(s + 4);
                     w.x = cvt_pk_bf16(a[0], a[1]); w.y = cvt_pk_bf16(a[2], a[3]); w.z = cvt_pk_bf16(bq[0], bq[1]); w.w = cvt_pk_bf16(bq[2], bq[3]); }
              const unsigned ww[4] = {w.x, w.y, w.z, w.w};
#pragma unroll
              for (int e = 0; e < 4; ++e) { VT[(cgp * 8 + 2 * e) * 72 + key] = (bf16_t)(ww[e] & 0xffffu); VT[(cgp * 8 + 2 * e + 1) * 72 + key] = (bf16_t)(ww[e] >> 16); } }
        }
        __syncthreads();
#pragma unroll
        for (int hh = 0; hh < 3; ++hh) {
            const int h = hbase + hh;
            f32x4 s[4]; float mx = -1e30f;
#pragma unroll
            for (int kt = 0; kt < 4; ++kt) {
                f32x4 a = (f32x4){0.f, 0.f, 0.f, 0.f};
#pragma unroll
                for (int ks = 0; ks < 2; ++ks) a = MFMA16(ldsfrag((LAS const unsigned char*)(Kb + (kt * 16 + fr) * 392 + h * 64 + ks * 32 + fq * 8)), qf[hh][ks], a);
#pragma unroll
                for (int j = 0; j < 4; ++j) {
                    int rel = (qt * 16 + fr) + 512 - (blk * 64 + kt * 16 + fq * 4 + j); rel = rel > 128 ? 128 : rel;
                    a[j] = a[j] * 0.125f + bias[h * 192 + rel + 63]; mx = fmaxf(mx, a[j]);
                }
                s[kt] = a;
            }
            mx = fmaxf(mx, __shfl_xor(mx, 16)); mx = fmaxf(mx, __shfl_xor(mx, 32));
            const float mnew = fmaxf(mrun[hh], mx), fac = __expf(mrun[hh] - mnew); mrun[hh] = mnew;
            float rs = 0.f;
#pragma unroll
            for (int kt = 0; kt < 4; ++kt) {
#pragma unroll
                for (int j = 0; j < 4; ++j) { s[kt][j] = __expf(s[kt][j] - mnew); rs += s[kt][j]; }
                *(LAS u32x2*)(Pw + fr * 72 + kt * 16 + fq * 4) = pack4(s[kt]);
            }
            rs += __shfl_xor(rs, 16); rs += __shfl_xor(rs, 32);
            lrun[hh] = lrun[hh] * fac + rs;
#pragma unroll
            for (int d = 0; d < 4; ++d) O[hh][d] *= fac;
            LDS_WAVE_SYNC();
#pragma unroll
            for (int ks = 0; ks < 2; ++ks) {
                const bf16x8 pf = ldsfrag((LAS const unsigned char*)(Pw + fr * 72 + ks * 32 + fq * 8));
#pragma unroll
                for (int d = 0; d < 4; ++d) O[hh][d] = MFMA16(ldsfrag((LAS const unsigned char*)(VT + (h * 64 + d * 16 + fr) * 72 + ks * 32 + fq * 8)), pf, O[hh][d]);
            }
            LDS_WAVE_SYNC();
        }
    }
    float sq = 0.f;
#pragma unroll
    for (int hh = 0; hh < 3; ++hh) { const float inv = 1.0f / lrun[hh];
#pragma unroll
        for (int d = 0; d < 4; ++d) { O[hh][d] *= inv; const f32x4 o = O[hh][d]; sq += (o[0] * o[0] + o[1] * o[1]) + (o[2] * o[2] + o[3] * o[3]); } }
    sq += __shfl_xor(sq, 16); sq += __shfl_xor(sq, 32);
    if (fq == 0) ssq[(wid >> 2) * 64 + qt * 16 + fr] = sq;
    __syncthreads();
    const float rstd = 1.0f / sqrtf((ssq[qt * 16 + fr] + ssq[64 + qt * 16 + fr]) * (1.0f / 384.0f) + RMS_EPS);
    bf16_t* mix = (bf16_t*)(p.ws + W_MIX);
#pragma unroll
    for (int hh = 0; hh < 3; ++hh)
#pragma unroll
        for (int d = 0; d < 4; ++d) {
            const int col = (hbase + hh) * 64 + d * 16 + fq * 4;
            const f32x4 gv = *(const f32x4*)(p.in[18] + (size_t)l * 1024 + col);
            *(u32x2*)(mix + (size_t)(R0 + qt * 16 + fr) * DM + col) = pack4(O[hh][d] * rstd * gv);
        }
}

__device__ __forceinline__ void ssd_y(KP& p, LAS unsigned char* lds, int l, int u) {
    int tid_ = threadIdx.x; asm volatile("" : "+v"(tid_));
    const int tid = tid_, wid = tid >> 6, lane = tid & 63, fr = lane & 15, fq = lane >> 4;
    LAS bf16_t* Cn = (LAS bf16_t*)lds;
    LAS bf16_t* Bn = (LAS bf16_t*)(lds + 17408);
    LAS bf16_t* xT = (LAS bf16_t*)(lds + 34816);
    LAS bf16_t* Mm = (LAS bf16_t*)(lds + 62464);
    LAS float* dtl = (LAS float*)(lds + 90112);
    LAS float* acl = (LAS float*)(lds + 90880);
    LAS float* ssq = (LAS float*)(lds + 91648);
    const bf16_t* proj = (const bf16_t*)(p.ws + W_PROJ);
    const bf16_t* HP = (const bf16_t*)(p.ws + W_ST);
    const bf16_t* XC = (const bf16_t*)(p.ws + W_XB) + (size_t)(u * 64) * 896;
    const int R0 = u * 64, lt = wid & 3;
    f32x4 yacc[2][6];
#pragma unroll
    for (int g = 0; g < 2; ++g) {
        __syncthreads();
        if (wid < 3) { float dt, ac, last; dt_scan(p, l, u, g, wid, lane, dt, ac, last); dtl[wid * 64 + lane] = dt; acl[wid * 64 + lane] = ac; }
#pragma unroll
        for (int it = 0; it < 4; ++it) {
            const int idx = it * 512 + tid, mat = idx >> 10, i = (idx >> 4) & 63, c8 = idx & 15;
            const u32x4 w = *(const u32x4*)(XC + (size_t)i * 896 + 384 + mat * 256 + g * 128 + c8 * 8);
            *(LAS u32x4*)((mat ? Cn : Bn) + i * 136 + c8 * 8) = w;
        }
#pragma unroll
        for (int it = 0; it < 3; ++it) {
            const int idx = it * 512 + tid, c4 = idx % 48, i = (idx / 48) * 2;
            const u32x2 wa = *(const u32x2*)(XC + (size_t)i * 896 + g * 192 + c4 * 4), wb = *(const u32x2*)(XC + (size_t)(i + 1) * 896 + g * 192 + c4 * 4);
            *(LAS unsigned*)(xT + (c4 * 4 + 0) * 72 + i) = (wa.x & 0xffffu) | (wb.x << 16);
            *(LAS unsigned*)(xT + (c4 * 4 + 1) * 72 + i) = (wa.x >> 16) | (wb.x & 0xffff0000u);
            *(LAS unsigned*)(xT + (c4 * 4 + 2) * 72 + i) = (wa.y & 0xffffu) | (wb.y << 16);
            *(LAS unsigned*)(xT + (c4 * 4 + 3) * 72 + i) = (wa.y >> 16) | (wb.y & 0xffff0000u);
        }
        __syncthreads();
#pragma unroll
        for (int k = 0; k < 2; ++k) {
            const int st = (wid >> 2) * 2 + k;
            f32x4 a = (f32x4){0.f, 0.f, 0.f, 0.f};
#pragma unroll
            for (int ks = 0; ks < 4; ++ks) a = MFMA16(ldsfrag((LAS const unsigned char*)(Bn + (st * 16 + fr) * 136 + ks * 32 + fq * 8)), ldsfrag((LAS const unsigned char*)(Cn + (lt * 16 + fr) * 136 + ks * 32 + fq * 8)), a);
            const int li = lt * 16 + fr;
#pragma unroll
            for (int hh = 0; hh < 3; ++hh) {
                const float al = acl[hh * 64 + li]; f32x4 mv;
#pragma unroll
                for (int j = 0; j < 4; ++j) { const int si = st * 16 + fq * 4 + j; mv[j] = si <= li ? a[j] * __expf(al - acl[hh * 64 + si]) * dtl[hh * 64 + si] : 0.f; }
                *(LAS u32x2*)(Mm + (hh * 64 + li) * 72 + st * 16 + fq * 4) = pack4(mv);
            }
        }
        __syncthreads();
#pragma unroll
        for (int k = 0; k < 6; ++k) {
            const int ctile = (wid >> 2) * 6 + k, hh = ctile >> 2, pt = ctile & 3, h = g * 3 + hh, li = lt * 16 + fr;
            f32x4 ad = (f32x4){0.f, 0.f, 0.f, 0.f}, ao = (f32x4){0.f, 0.f, 0.f, 0.f};
#pragma unroll
            for (int ks = 0; ks < 2; ++ks) ad = MFMA16(ldsfrag((LAS const unsigned char*)(xT + (hh * 64 + pt * 16 + fr) * 72 + ks * 32 + fq * 8)), ldsfrag((LAS const unsigned char*)(Mm + (hh * 64 + li) * 72 + ks * 32 + fq * 8)), ad);
#pragma unroll
            for (int ks = 0; ks < 4; ++ks) ao = MFMA16(glbfrag(HP + ((size_t)(u * 6 + h) * 64 + pt * 16 + fr) * 128 + ks * 32 + fq * 8), ldsfrag((LAS const unsigned char*)(Cn + li * 136 + ks * 32 + fq * 8)), ao);
            const float ea = __expf(acl[hh * 64 + li]), dsk = p.in[15][l * 6 + h];
            const f32x4 xv = unpack4(*(const u32x2*)(XC + (size_t)li * 896 + h * 64 + pt * 16 + fq * 4));
            const f32x4 zv = unpack4(*(const u32x2*)(proj + (size_t)(R0 + li) * NPROJ + C_Z + h * 64 + pt * 16 + fq * 4));
            f32x4 y = ad + ao * ea + xv * dsk;
#pragma unroll
            for (int j = 0; j < 4; ++j) y[j] *= silu_f(zv[j]);
            yacc[g][k] = y;
            asm volatile("" ::: "memory");
        }
    }
    float sq = 0.f;
#pragma unroll
    for (int g = 0; g < 2; ++g)
#pragma unroll
        for (int k = 0; k < 6; ++k) { const f32x4 o = yacc[g][k]; sq += (o[0] * o[0] + o[1] * o[1]) + (o[2] * o[2] + o[3] * o[3]); }
    sq += __shfl_xor(sq, 16); sq += __shfl_xor(sq, 32);
    if (fq == 0) ssq[(wid >> 2) * 64 + lt * 16 + fr] = sq;
    __syncthreads();
    const float rstd = 1.0f / sqrtf((ssq[lt * 16 + fr] + ssq[64 + lt * 16 + fr]) * (1.0f / 384.0f) + RMS_EPS);
    bf16_t* mix = (bf16_t*)(p.ws + W_MIX);
#pragma unroll
    for (int g = 0; g < 2; ++g)
#pragma unroll
        for (int k = 0; k < 6; ++k) {
            const int col = 384 + g * 192 + ((wid >> 2) * 6 + k) * 16 + fq * 4;
            const f32x4 gv = *(const f32x4*)(p.in[18] + (size_t)l * 1024 + col);
            *(u32x2*)(mix + (size_t)(R0 + lt * 16 + fr) * DM + col) = pack4(yacc[g][k] * rstd * gv);
        }
}

__device__ __forceinline__ void phase_fix(KP& p, int l) {
    const float* halo = (const float*)(p.ws + W_MIX); bf16_t* H = (bf16_t*)(p.ws + W_PROJ);
    const float* w = p.in[23] + (size_t)l * 3 * DFF2; const float* bb = p.in[24] + (size_t)l * DFF2;
    int tid_ = threadIdx.x; asm volatile("" : "+v"(tid_));
    for (int i = blockIdx.x * 512 + tid_; i < 128 * DFF2; i += gridDim.x * 512) {
        const int pm = i / DFF2, cc = i % DFF2;
        if ((pm & 31) == 0 || cc >= DFF) continue;
        const float* h0 = halo + (size_t)(pm - 1) * 4 * DFF2; const float* h1 = halo + (size_t)pm * 4 * DFF2;
        float r[2];
#pragma unroll
        for (int rr = 0; rr < 2; ++rr) {
            float o[2];
#pragma unroll
            for (int gv = 0; gv < 2; ++gv) {
                const int c2 = cc + gv * DFF;
                const float xm2 = h0[2 * DFF2 + c2], xm1 = h0[3 * DFF2 + c2], x0 = h1[c2], x1 = h1[DFF2 + c2];
                o[gv] = rr == 0 ? bb[c2] + w[c2] * xm2 + w[DFF2 + c2] * xm1 + w[2 * DFF2 + c2] * x0 : bb[c2] + w[c2] * xm1 + w[DFF2 + c2] * x0 + w[2 * DFF2 + c2] * x1;
            }
            r[rr] = silu_f(o[0]) * o[1];
        }
        H[((size_t)pm * 256) * DFF + cc] = (bf16_t)(cvt_pk_bf16(r[0], 0.f) & 0xffffu);
        H[((size_t)pm * 256 + 1) * DFF + cc] = (bf16_t)(cvt_pk_bf16(r[1], 0.f) & 0xffffu);
    }
}

#define XB_TMO      128
#define XB_XCNT(j)  (256  + 64 * (j))
#define XB_XSUB(j)  (1280 + 64 * (j))
#define XB_XGEN(j)  (2304 + 64 * (j))
#define XB_TOP      3328
#define XB_TOPGEN   3392
#define XCD_BAR_WORDS 3456
#define XB_SPIN_CAP (1u << 18)

__device__ __forceinline__ unsigned xb_ld(unsigned* p)              { return __hip_atomic_load(p, __ATOMIC_RELAXED, __HIP_MEMORY_SCOPE_AGENT); }
__device__ __forceinline__ unsigned xb_add(unsigned* p, unsigned v) { return __hip_atomic_fetch_add(p, v, __ATOMIC_RELAXED, __HIP_MEMORY_SCOPE_AGENT); }
__device__ __forceinline__ unsigned xb_xcc_id() { return (unsigned)__builtin_amdgcn_s_getreg((3 << 11) | 20) & 0xFu; }
#define XB_SPIN(cond, bar) do { unsigned _sp = 0; while (cond) { __builtin_amdgcn_s_sleep(1); \
    if ((++_sp & 255u) == 0u) { if (xb_ld(&(bar)[XB_TMO])) break; if (_sp > XB_SPIN_CAP) { atomicAdd(&(bar)[XB_TMO], 1u); break; } } } } while (0)

struct XcdBarrier {
    unsigned* bar; unsigned x;
    volatile LAS unsigned* st;
};

__device__ __forceinline__ XcdBarrier xcd_barrier_post(unsigned* bar, volatile LAS unsigned* st) {
    XcdBarrier b; b.bar = bar; b.x = xb_xcc_id(); b.st = st;
    if (threadIdx.x == 0) (void)xb_add(&bar[XB_XCNT(b.x)], 1u);
    return b;
}
__device__ __forceinline__ void xcd_barrier_complete(unsigned* bar, unsigned x, unsigned& nloc, unsigned& nx) {
    const unsigned G = gridDim.x * gridDim.y * gridDim.z;
    unsigned sum, cnt, mine, sp = 0u;
    for (;;) {
        sum = 0u; cnt = 0u; mine = 0u;
#pragma unroll
        for (unsigned j = 0; j < 16; ++j) { const unsigned c = xb_ld(&bar[XB_XCNT(j)]); sum += c; cnt += (c > 0u) ? 1u : 0u; mine = (j == x) ? c : mine; }
        if (sum == G) break;
        __builtin_amdgcn_s_sleep(1);
        if ((++sp & 255u) == 0u) { if (xb_ld(&bar[XB_TMO])) break; if (sp > XB_SPIN_CAP) { atomicAdd(&bar[XB_TMO], 1u); break; } }
    }
    nloc = mine > 0u ? mine : 1u; nx = cnt > 0u ? cnt : 1u;
}

__device__ __forceinline__ void xcd_barrier(const XcdBarrier& b) {
    asm volatile("s_waitcnt vmcnt(0)" ::: "memory");
    __syncthreads();
    if (threadIdx.x == 0) {
        unsigned* bar = b.bar;
        __builtin_amdgcn_s_waitcnt(0);
        unsigned nloc = b.st[0], nx = b.st[1];
        if (nloc == 0u) { xcd_barrier_complete(bar, b.x, nloc, nx); b.st[0] = nloc; b.st[1] = nx; }
        const unsigned old = xb_add(&bar[XB_XSUB(b.x)], 1u);
        const unsigned gen = old / nloc;
        if (old + 1u == (gen + 1u) * nloc) {
            __builtin_amdgcn_fence(__ATOMIC_RELEASE, "agent");
            asm volatile("s_waitcnt vmcnt(0)" ::: "memory");
            const unsigned og = xb_add(&bar[XB_TOP], 1u);
            const unsigned tg = og / nx;
            if (og + 1u == (tg + 1u) * nx) xb_add(&bar[XB_TOPGEN], 1u);
            else XB_SPIN(xb_ld(&bar[XB_TOPGEN]) == tg, bar);
            __builtin_amdgcn_fence(__ATOMIC_ACQUIRE, "agent");
            xb_add(&bar[XB_XGEN(b.x)], 1u);
            asm volatile("s_waitcnt vmcnt(0)" ::: "memory");
        } else {
            XB_SPIN(xb_ld(&bar[XB_XGEN(b.x)]) == gen, bar);
            __builtin_amdgcn_fence(__ATOMIC_ACQUIRE, "agent");
            asm volatile("s_waitcnt vmcnt(0)" ::: "memory");
        }
    }
    __syncthreads();
}

__global__ void __launch_bounds__(512, 2) mega(Params pa) {
    extern __shared__ __attribute__((aligned(16))) unsigned char shm[];
    LAS unsigned char* lds = (LAS unsigned char*)shm;
    const int G = gridDim.x, bid = blockIdx.x;
    KP* pk = (KP*)__builtin_amdgcn_kernarg_segment_ptr();
    volatile LAS unsigned* bst = (volatile LAS unsigned*)(lds + LDS_BYTES - 16);
    XcdBarrier xb; xb.bar = nullptr; xb.x = 0; xb.st = bst;
    if (pa.coop) { if (threadIdx.x < 2) bst[threadIdx.x] = 0u; __syncthreads(); xb = xcd_barrier_post((unsigned*)(pa.ws + W_BAR), bst); }
    for (int ph = pa.ph_lo; ph < pa.ph_hi; ++ph) {
        if (ph > pa.ph_lo && pa.coop) { if (ph == pa.ph_lo + 1) { __threadfence(); cg::this_grid().sync(); } else xcd_barrier(xb); }
        asm volatile("" : "+s"(pk)); KP& p = *pk;
        if (ph == 0) { phase_prep(p, lds); continue; }
        if (ph == 42) { int tq = threadIdx.x; asm volatile("" : "+v"(tq)); const unsigned short* w16 = (const unsigned short*)p.ws; for (size_t i = (size_t)bid * 512 + tq; i < (size_t)59418624; i += (size_t)G * 512) p.out[i] = (float)w16[i * 4]; continue; }
        if (ph == 41) { int tq = threadIdx.x; asm volatile("" : "+v"(tq)); for (size_t i = (size_t)bid * 512 + tq; i < (size_t)59418624; i += (size_t)G * 512) { const float v = p.out[i]; if (!(fabsf(v) < 1e30f)) p.out[i] = 0.f; } continue; }
        const int l = (ph - 1) / 10, k = (ph - 1) % 10;
        bf16_t* XB = (bf16_t*)(p.ws + W_XB);
        switch (k) {
        case 0: { pg8::StaticOrder S; S.init(T_ALL, NPROJ, G, bid);
                  EpiIn E{(bf16_t*)(p.ws + W_PROJ), p.out, (float*)(p.ws + W_DTB), p.in[13], l};
                  pg8::gemm_phase(lds, pg8::Gemm{XB, (const bf16_t*)(p.ws + W_IN + l * W_IN_L), T_ALL, NPROJ, DM}, S, E); } break;
        case 1: for (int it = bid; it < 2 * NU64; it += G) { if (it < NU64) ssd_states(p, lds, l, it); else gmlp_unit(p, lds, l, it - NU64); } break;
        case 2: for (int it = bid; it < 96 + NU64 + 768; it += G) { if (it < 96) scan_prompt(p, l, it); else if (it < 96 + NU64) attn_unit(p, lds, l, it - 96); else scan_sample(p, l, it - 96 - NU64); } break;
        case 3: for (int it = bid; it < NU64; it += G) ssd_y(p, lds, l, it); break;
        case 4: { pg8::StaticOrder S; S.init(T_ALL, DM, G, bid); EpiRes E{p.out};
                  pg8::gemm_phase(lds, pg8::Gemm{(const bf16_t*)(p.ws + W_MIX), (const bf16_t*)(p.ws + W_OUT + l * W_OUT_L), T_ALL, DM, DM}, S, E); } break;
        case 5: phase_ln(p, p.in[20] + l * DM, p.in[21] + l * DM); break;
        case 6: { pg8::StaticOrder S; S.init(T_ALL, DFF2, G, bid);
                  EpiUp E{(bf16_t*)(p.ws + W_PROJ), (float*)(p.ws + W_MIX), p.out, p.in[23], p.in[24], p.in[6], l};
                  pg8::OneUnit o1;
                  for (int i = 0; S.next(i, o1.u); ++i) { pg8::gemm_phase(lds, pg8::Gemm{XB, (const bf16_t*)(p.ws + W_UP + l * W_UP_L), T_ALL, DFF2, DM}, o1, E); __syncthreads(); } } break;
        case 7: phase_fix(p, l); break;
        case 8: { pg8::StaticOrder S; S.init(T_ALL, DM, G, bid); EpiRes E{p.out};
                  pg8::gemm_phase(lds, pg8::Gemm{(const bf16_t*)(p.ws + W_PROJ), (const bf16_t*)(p.ws + W_DN + l * W_DN_L), T_ALL, DM, DFF}, S, E); } break;
        case 9: phase_ln(p, p.in[26] + l * DM, p.in[27] + l * DM); break;
        }
    }
}

constexpr int N_PHASES = 41;
#ifndef MULTI_LAUNCH
#define MULTI_LAUNCH 0
#endif

extern "C" void kernel_launch(void* const* d_in, const int* in_sizes, int n_in, void* d_out, int out_size, void* d_ws, size_t ws_size, hipStream_t stream) {
    static int grid = 0;
    if (grid == 0) {
        if (n_in != 28 || ws_size < W_END2) { fprintf(stderr, "kernel_launch: need 28 inputs and %zu bytes of workspace (got %d, %zu)\n", (size_t)W_END2, n_in, ws_size); grid = -1; return; }
        int dev = 0, cus = 0, per_cu = 0;
        hipGetDevice(&dev); hipDeviceGetAttribute(&cus, hipDeviceAttributeMultiprocessorCount, dev);
        if (hipFuncSetAttribute((const void*)mega, hipFuncAttributeMaxDynamicSharedMemorySize, LDS_BYTES) != hipSuccess) { fprintf(stderr, "kernel_launch: hipFuncSetAttribute failed\n"); grid = -1; return; }
        hipOccupancyMaxActiveBlocksPerMultiprocessor(&per_cu, (const void*)mega, 512, LDS_BYTES);
        (void)hipGetLastError();
        if (per_cu < 1) per_cu = 1;
        grid = cus * 1;
    }
    if (grid < 0) return;
    Params p{};
    for (int i = 0; i < 28; ++i) p.in[i] = (const float*)d_in[i];
    p.out = (float*)d_out; p.ws = (unsigned char*)d_ws;
#if MULTI_LAUNCH
#ifdef PROBE_CUT
    for (int ph = 0; ph < PROBE_CUT; ++ph) { p.ph_lo = ph; p.ph_hi = ph + 1; p.coop = 0; hipLaunchKernelGGL(mega, dim3(grid), dim3(512), LDS_BYTES, stream, p); }
    p.ph_lo = 42; p.ph_hi = 43; p.coop = 0; hipLaunchKernelGGL(mega, dim3(grid), dim3(512), LDS_BYTES, stream, p);
#else
    for (int ph = 0; ph < N_PHASES; ++ph) { p.ph_lo = ph; p.ph_hi = ph + 1; p.coop = 0; hipLaunchKernelGGL(mega, dim3(grid), dim3(512), LDS_BYTES, stream, p); }
#endif
#else
    p.ph_lo = 0; p.ph_hi = N_PHASES; p.coop = 1;
    if (hipMemsetAsync((char*)d_ws + W_BAR, 0, 16384, stream) != hipSuccess) { fprintf(stderr, "kernel_launch: memset failed\n"); return; }
    void* args[] = {&p};
    hipError_t e = hipLaunchCooperativeKernel((const void*)mega, dim3(grid), dim3(512), args, LDS_BYTES, stream);
    if (e != hipSuccess) fprintf(stderr, "cooperative launch failed: %s (grid %d)\n", hipGetErrorString(e), grid);
#endif
}
```

```cpp
#define REP_G1 1
#define REP_M1 1
#define REP_ATT 1
#define REP_M3 1
#define REP_G3 1
#include <hip/hip_runtime.h>
#include <hip/hip_cooperative_groups.h>
#include <cstdio>
namespace cg = cooperative_groups;

#define LAS __attribute__((address_space(3)))
typedef unsigned short bf16_t;
typedef short bf16x8 __attribute__((ext_vector_type(8)));
typedef float f32x4 __attribute__((ext_vector_type(4)));
typedef float f32x2 __attribute__((ext_vector_type(2)));
typedef unsigned u32x4 __attribute__((ext_vector_type(4)));
typedef unsigned u32x2 __attribute__((ext_vector_type(2)));

constexpr int T_ALL = 34816, T_P = 32768, DM = 1024, NPROJ = 3072, DFF = 2816, DFF2 = 5632, DEPTH = 4;
constexpr int NU64 = 544;
constexpr float ALPHA = 1.6817928305074290f;
constexpr float LN_EPS = 1e-5f, RMS_EPS = 1e-5f;
constexpr int C_K = 384, C_V = 768, C_Z = 1152, C_XBC = 1536, C_U = 2432, C_VC = 2688, C_DT = 2944;
constexpr size_t O_YP = 0, O_YS = 33554432, O_PK = 35651584, O_PV = O_PK + 3145728, O_PH = O_PV + 3145728, O_PC = O_PH + 786432,
                 O_PF = O_PC + 43008, O_SK = O_PF + 180224, O_SV = O_SK + 3145728, O_SH = O_SV + 3145728, O_SC = O_SH + 6291456,
                 O_SG = O_SC + 344064, O_SF = O_SG + 2097152;
constexpr size_t W_IN = 0, W_IN_L = (size_t)NPROJ * DM * 2;
constexpr size_t W_OUT = W_IN + 4 * W_IN_L, W_OUT_L = (size_t)DM * DM * 2;
constexpr size_t W_UP = W_OUT + 4 * W_OUT_L, W_UP_L = (size_t)DFF2 * DM * 2;
constexpr size_t W_DN = W_UP + 4 * W_UP_L, W_DN_L = (size_t)DM * DFF * 2;
constexpr size_t W_GW = W_DN + 4 * W_DN_L, W_GW_L = (size_t)4 * 128 * 128 * 2;
constexpr size_t W_XB = W_GW + 4 * W_GW_L;
constexpr size_t W_PROJ = W_XB + (size_t)T_ALL * DM * 2;
constexpr size_t W_MIX = W_PROJ + (size_t)T_ALL * NPROJ * 2;
constexpr size_t W_ST = W_MIX + (size_t)T_ALL * DM * 2;
constexpr size_t W_CD = W_ST + (size_t)NU64 * 6 * 8192 * 2;
constexpr size_t W_DTB = W_CD + (size_t)NU64 * 8 * 4;
constexpr size_t W_END = W_DTB + (size_t)T_ALL * 8 * 4;
constexpr size_t W_BAR = W_END;
constexpr size_t W_END2 = W_BAR + 16384;
constexpr int LDS_BYTES = 136 * 1024;

struct Params { const float* in[28]; float* out; unsigned char* ws; int ph_lo, ph_hi, coop, pad; };
typedef const __attribute__((address_space(4))) Params KP;

__device__ __forceinline__ float bf2f(unsigned b) { return __uint_as_float(b << 16); }
typedef __bf16 bf16v2 __attribute__((ext_vector_type(2)));
__device__ __forceinline__ unsigned cvt_pk_bf16(float lo, float hi) { const f32x2 v = {lo, hi}; const bf16v2 b = __builtin_convertvector(v, bf16v2); return __builtin_bit_cast(unsigned, b); }
__device__ __forceinline__ u32x2 pack4(f32x4 v) { u32x2 w; w.x = cvt_pk_bf16(v[0], v[1]); w.y = cvt_pk_bf16(v[2], v[3]); return w; }
__device__ __forceinline__ f32x4 unpack4(u32x2 w) { f32x4 v; v[0] = bf2f(w.x & 0xffffu); v[1] = bf2f(w.x >> 16); v[2] = bf2f(w.y & 0xffffu); v[3] = bf2f(w.y >> 16); return v; }
__device__ __forceinline__ float silu_f(float x) { return x / (1.0f + __expf(-x)); }
__device__ __forceinline__ float gelu_tanh(float x) { const float y = 0.7978845608028654f * (x + 0.044715f * x * x * x); const float e = __expf(2.0f * y); return 0.5f * x * (2.0f - 2.0f / (1.0f + e)); }
__device__ __forceinline__ float softplus_f(float x) { const float e = __expf(x); return x > 15.0f ? x : (e < 1e-3f ? e * (1.0f - 0.5f * e + 0.33333333f * e * e) : __logf(1.0f + e)); }
#define MFMA16(colfrag, rowfrag, acc) __builtin_amdgcn_mfma_f32_16x16x32_bf16((colfrag), (rowfrag), (acc), 0, 0, 0)
__device__ __forceinline__ bf16x8 ldsfrag(LAS const unsigned char* p) { return *(LAS const bf16x8*)p; }
__device__ __forceinline__ bf16x8 glbfrag(const bf16_t* p) { return *(const bf16x8*)p; }
#define LDS_WAVE_SYNC() asm volatile("s_waitcnt lgkmcnt(0)" ::: "memory")

namespace pg8 {
constexpr int BM = 256, BK = 64, HALF = 128, HTB = HALF * BK * 2, STAGE_BYTES = 8 * HTB, NXCD = 8, WGM = 8;
__device__ __forceinline__ int lds_byte(int r, int c) { const int st = (r >> 4) * 2 + (c >> 5), rr = r & 15, cc = c & 31, ob = rr * 64 + cc * 2; return st * 1024 + (ob ^ (((ob >> 9) & 1) << 5)); }
__device__ __forceinline__ void stage_rc(int b, int& R, int& C) { const int st = b / 1024, sb = b % 1024, swz = sb ^ (((sb >> 9) & 1) << 5); R = (st >> 1) * 16 + swz / 64; C = (st & 1) * 32 + (swz % 64) / 2; }
struct Unit { int pm, pn; };
struct Gemm { const bf16_t* A; const bf16_t* Bt; int M, N, K; };
struct StaticOrder {
    int nM, nN, nwg, G, c;
    __device__ __forceinline__ void init(int M, int N, int G_, int c_) { nM = M / BM; nN = N / BM; nwg = nM * nN; G = G_; c = c_; }
    __device__ __forceinline__ bool next(int i, Unit& u) const {
        const long L = (long)i * G + c; if (L >= nwg) return false;
        int wgid = (int)L; { const int q = nwg / NXCD, r = nwg % NXCD, xcd = wgid % NXCD, off = wgid / NXCD; wgid = (xcd < r ? xcd * (q + 1) : r * (q + 1) + (xcd - r) * q) + off; }
        const int nig = WGM * nN, gid = wgid / nig, fm = gid * WGM, gsz = (nM - fm) < WGM ? (nM - fm) : WGM;
        u.pm = fm + ((wgid % nig) % gsz); u.pn = (wgid % nig) / gsz; return true;
    }
    __device__ __forceinline__ void a_ready(const Unit&) const {}
    __device__ __forceinline__ void done(const Unit&) const {}
};
struct OneUnit {
    Unit u;
    __device__ __forceinline__ bool next(int i, Unit& o) const { if (i) return false; o = u; return true; }
    __device__ __forceinline__ void a_ready(const Unit&) const {}
    __device__ __forceinline__ void done(const Unit&) const {}
};

template <class Epi, class Sched>
__device__ __forceinline__ void gemm_phase(LAS unsigned char* lds, const Gemm g, const Sched& S, const Epi& E) {
    int tid_ = threadIdx.x; asm volatile("" : "+v"(tid_));
    const int tid = tid_, wid = __builtin_amdgcn_readfirstlane(tid >> 6), lane = tid & 63, wr = wid >> 2, wc = wid & 3, fr = lane & 15, fq = lane >> 4;
    const int K = g.K, nt = K / BK;
    unsigned voffA[2];
#pragma unroll
    for (int i = 0; i < 2; ++i) { int R, C; stage_rc(tid * 16 + i * 8192, R, C); voffA[i] = (unsigned)(R * K + C) * 2u; }
    const size_t kstep = (size_t)(BK * 2);
    const size_t hstep = (size_t)HALF * K * 2;
    const size_t tstep = 2 * hstep;
    const unsigned ldsw = (unsigned)wid * 1024u;
    const int aoff = lds_byte(wr * 64 + fr, fq * 8), boff = lds_byte(wc * 32 + fr, fq * 8);
#define PG8_SA(b, h) (((b) * 2 + (h)) * HTB)
#define PG8_SB(b, h) ((4 + (b) * 2 + (h)) * HTB)
#define PG8_STAGE(bufoff, gbase, voff) do { _Pragma("unroll") for (int _i = 0; _i < 2; ++_i) \
        __builtin_amdgcn_global_load_lds((const unsigned*)((const char*)(gbase) + (voff)[_i]), (LAS unsigned*)(lds + (bufoff) + ldsw + _i * 8192), 16, 0, 0); } while (0)
#define PG8_LDA(dst, b, h) do { _Pragma("unroll") for (int m = 0; m < 4; ++m) _Pragma("unroll") for (int k = 0; k < 2; ++k) dst[m][k] = *(const LAS bf16x8*)(lds + PG8_SA(b, h) + aoff + m * 2048 + k * 1024); } while (0)
#define PG8_LDB(dst, b, h) do { _Pragma("unroll") for (int n = 0; n < 2; ++n) _Pragma("unroll") for (int k = 0; k < 2; ++k) dst[n][k] = *(const LAS bf16x8*)(lds + PG8_SB(b, h) + boff + n * 2048 + k * 1024); } while (0)
#define PG8_MMA(ai, bj, At, Bt) do { __builtin_amdgcn_s_setprio(1); _Pragma("unroll") for (int m = 0; m < 4; ++m) _Pragma("unroll") for (int n = 0; n < 2; ++n) _Pragma("unroll") for (int k = 0; k < 2; ++k) \
        acc[ai][bj][m][n] = __builtin_amdgcn_mfma_f32_16x16x32_bf16(Bt[n][k], At[m][k], acc[ai][bj][m][n], 0, 0, 0); __builtin_amdgcn_s_setprio(0); } while (0)
#define PG8_WAIT_V(n) asm volatile("s_waitcnt vmcnt(" #n ")" ::: "memory")
#define PG8_WAIT_L(n) asm volatile("s_waitcnt lgkmcnt(" #n ")" ::: "memory")
#define PG8_BAR __builtin_amdgcn_s_barrier()
#define PG8_SCHED __builtin_amdgcn_sched_barrier(0)
    Unit cur, nxt; int ui = 0;
    if (!S.next(0, cur)) return;
    f32x4 acc[2][2][4][2];
#pragma unroll
    for (int a = 0; a < 2; ++a)
#pragma unroll
        for (int b = 0; b < 2; ++b)
#pragma unroll
            for (int m = 0; m < 4; ++m)
#pragma unroll
                for (int n = 0; n < 2; ++n) acc[a][b][m][n] = (f32x4){0.f, 0.f, 0.f, 0.f};
    bf16x8 At[4][2], B0[2][2], B1[2][2];
    const char* cA = (const char*)g.A + (size_t)cur.pm * tstep; const char* cB = (const char*)g.Bt + (size_t)cur.pn * tstep;
    S.a_ready(cur);
    PG8_STAGE(PG8_SB(0, 0), cB, voffA); PG8_STAGE(PG8_SA(0, 0), cA, voffA); PG8_STAGE(PG8_SB(0, 1), cB + hstep, voffA); PG8_STAGE(PG8_SA(0, 1), cA + hstep, voffA);
    if (wr == 1) PG8_BAR;
    PG8_WAIT_V(4); PG8_BAR;
    PG8_STAGE(PG8_SB(1, 0), cB + kstep, voffA); PG8_STAGE(PG8_SA(1, 0), cA + kstep, voffA); PG8_STAGE(PG8_SB(1, 1), cB + hstep + kstep, voffA);
    PG8_WAIT_V(6); PG8_BAR;
    for (;;) {
        const bool has_next = S.next(ui + 1, nxt);
        const char* nA = has_next ? (const char*)g.A + (size_t)nxt.pm * tstep : cA; const char* nB = has_next ? (const char*)g.Bt + (size_t)nxt.pn * tstep : cB;
        for (int t = 0; t < nt; t += 2) {
            const bool last = (t == nt - 2);
            const char* a1 = cA + (size_t)(t + 1) * kstep;
            const char* a2 = last ? nA : cA + (size_t)(t + 2) * kstep; const char* b2 = last ? nB : cB + (size_t)(t + 2) * kstep;
            const char* a3 = a2 + kstep; const char* b3 = b2 + kstep;
            if (last && has_next) S.a_ready(nxt);
            PG8_LDB(B0, 0, 0); PG8_SCHED; PG8_LDA(At, 0, 0); PG8_STAGE(PG8_SA(1, 1), a1 + hstep, voffA);
            PG8_WAIT_L(8); PG8_BAR; PG8_WAIT_L(0); PG8_MMA(0, 0, At, B0); PG8_BAR; PG8_SCHED;
            PG8_LDB(B1, 0, 1); PG8_STAGE(PG8_SB(0, 0), b2, voffA);
            PG8_BAR; PG8_WAIT_L(0); PG8_MMA(0, 1, At, B1); PG8_BAR;
            PG8_LDA(At, 0, 1); PG8_STAGE(PG8_SA(0, 0), a2, voffA);
            PG8_BAR; PG8_WAIT_L(0); PG8_MMA(1, 0, At, B0); PG8_BAR; PG8_SCHED;
            PG8_STAGE(PG8_SB(0, 1), b2 + hstep, voffA);
            PG8_WAIT_V(6); PG8_BAR; PG8_MMA(1, 1, At, B1); PG8_BAR;
            PG8_LDB(B0, 1, 0); PG8_SCHED; PG8_LDA(At, 1, 0); PG8_STAGE(PG8_SA(0, 1), a2 + hstep, voffA);
            PG8_WAIT_L(8); PG8_BAR; PG8_WAIT_L(0); PG8_MMA(0, 0, At, B0); PG8_BAR; PG8_SCHED;
            PG8_LDB(B1, 1, 1); PG8_STAGE(PG8_SB(1, 0), b3, voffA);
            PG8_BAR; PG8_WAIT_L(0); PG8_MMA(0, 1, At, B1); PG8_BAR;
            PG8_LDA(At, 1, 1); PG8_STAGE(PG8_SA(1, 0), a3, voffA);
            PG8_BAR; PG8_WAIT_L(0); PG8_MMA(1, 0, At, B0); PG8_BAR; PG8_SCHED;
            PG8_STAGE(PG8_SB(1, 1), b3 + hstep, voffA);
            PG8_WAIT_V(6); PG8_BAR; PG8_MMA(1, 1, At, B1); PG8_BAR;
        }
        if constexpr (!Epi::AFTER_DRAIN) { E(acc, cur, wr, wc, fr, fq); S.done(cur); }
        if (!has_next) break;
#pragma unroll
        for (int a = 0; a < 2; ++a)
#pragma unroll
            for (int b = 0; b < 2; ++b)
#pragma unroll
                for (int m = 0; m < 4; ++m)
#pragma unroll
                    for (int n = 0; n < 2; ++n) acc[a][b][m][n] = (f32x4){0.f, 0.f, 0.f, 0.f};
        cur = nxt; cA = nA; cB = nB; ++ui;
    }
    PG8_WAIT_V(0);
    if (wr == 0) PG8_BAR;
    PG8_BAR;
    if constexpr (Epi::AFTER_DRAIN) { E.fused(acc, cur, wr, wc, fr, fq, lds, wid, lane); S.done(cur); }
#undef PG8_SA
#undef PG8_SB
#undef PG8_STAGE
#undef PG8_LDA
#undef PG8_LDB
#undef PG8_MMA
#undef PG8_WAIT_V
#undef PG8_WAIT_L
#undef PG8_BAR
#undef PG8_SCHED
}
}
using pg8::Unit;

struct EpiIn {
    static constexpr bool AFTER_DRAIN = false;
    bf16_t* proj; float* out; float* dtb; const float* dt_bias; int l;
    __device__ __forceinline__ void operator()(const f32x4 (&acc)[2][2][4][2], const Unit& u, int wr, int wc, int fr_, int fq_) const {
        int fr = fr_, fq = fq_; asm volatile("" : "+v"(fr), "+v"(fq));
#pragma unroll
        for (int ai = 0; ai < 2; ++ai)
#pragma unroll
            for (int m = 0; m < 4; ++m) {
                const int row = u.pm * 256 + ai * 128 + wr * 64 + m * 16 + fr;
                const bool isP = row < T_P; int b, t;
                if (isP) { b = row >> 13; t = row & 8191; } else { b = (row - T_P) >> 6; t = row & 63; }
#pragma unroll
                for (int bj = 0; bj < 2; ++bj)
#pragma unroll
                    for (int n = 0; n < 2; ++n) {
                        const int col = u.pn * 256 + bj * 128 + wc * 32 + n * 16 + fq * 4;
                        f32x4 v = acc[ai][bj][m][n];
                        if (col < C_U) {
                            *(u32x2*)(proj + (size_t)row * NPROJ + col) = pack4(v);
                            if (col >= C_K && col < C_Z) {
                                const int isv = col >= C_V; const int cc = col - (isv ? C_V : C_K);
                                if (isP) { if (t >= 7680) *(f32x4*)(out + (isv ? O_PV : O_PK) + ((size_t)(l * 4 + b) * 512 + (t - 7680)) * 384 + cc) = v; }
                                else *(f32x4*)(out + (isv ? O_SV : O_SK) + ((size_t)(l * 32 + b) * 64 + t) * 384 + cc) = v;
                            } else if (col >= C_XBC) {
                                const int cc = col - C_XBC;
                                if (isP) { if (t >= 8189) *(f32x4*)(out + O_PC + ((size_t)(l * 4 + b) * 3 + (t - 8189)) * 896 + cc) = v; }
                                else if (t >= 61) *(f32x4*)(out + O_SC + ((size_t)(l * 32 + b) * 3 + (t - 61)) * 896 + cc) = v;
                            }
                        } else if (col < C_DT) {
#pragma unroll
                            for (int j = 0; j < 4; ++j) v[j] = gelu_tanh(v[j]);
                            *(u32x2*)(proj + (size_t)row * NPROJ + col) = pack4(v);
                            if (col >= C_VC && !isP) *(f32x4*)(out + O_SG + ((size_t)(l * 32 + b) * 64 + t) * 256 + (col - C_VC)) = v;
                        } else if (col < C_DT + 8) {
#pragma unroll
                            for (int j = 0; j < 4; ++j) { const int hh = col + j - C_DT; if (hh < 6) dtb[(size_t)row * 8 + hh] = softplus_f(v[j] + dt_bias[l * 6 + hh]); }
                        }
                    }
                asm volatile("" ::: "memory");
            }
    }
};
struct EpiRes {
    static constexpr bool AFTER_DRAIN = false;
    float* x;
    __device__ __forceinline__ void operator()(const f32x4 (&acc)[2][2][4][2], const Unit& u, int wr, int wc, int fr_, int fq_) const {
        int fr = fr_, fq = fq_; asm volatile("" : "+v"(fr), "+v"(fq));
#pragma unroll
        for (int ai = 0; ai < 2; ++ai)
#pragma unroll
            for (int m = 0; m < 4; ++m) {
                float* rowp = x + (size_t)(u.pm * 256 + ai * 128 + wr * 64 + m * 16 + fr) * DM + u.pn * 256 + wc * 32 + fq * 4;
#pragma unroll
                for (int bj = 0; bj < 2; ++bj)
#pragma unroll
                    for (int n = 0; n < 2; ++n) { float* q = rowp + bj * 128 + n * 16; const f32x4 o = *(const f32x4*)q; *(f32x4*)q = o * ALPHA + acc[ai][bj][m][n]; }
                asm volatile("" ::: "memory");
            }
    }
};
struct EpiUp {
    static constexpr bool AFTER_DRAIN = true;
    bf16_t* H; float* halo; float* out; const float* cw; const float* cb; const float* fstate; int l;
    __device__ __forceinline__ void operator()(const f32x4 (&)[2][2][4][2], const Unit&, int, int, int, int) const {}
    __device__ __forceinline__ void fused(f32x4 (&acc)[2][2][4][2], const Unit& u, int wr, int wc, int fr, int fq, LAS unsigned char* lds, int wid, int lane) const {
        constexpr int LS = 260;
#pragma unroll
        for (int ai = 0; ai < 2; ++ai)
#pragma unroll
            for (int m = 0; m < 4; ++m)
#pragma unroll
                for (int bj = 0; bj < 2; ++bj)
#pragma unroll
                    for (int n = 0; n < 2; ++n) {
                        const int rl = ai * 128 + wr * 64 + m * 16 + fr, cl = bj * 128 + wc * 32 + n * 16 + fq * 4;
                        *(LAS u32x2*)(lds + (rl * LS + cl) * 2) = pack4(acc[ai][bj][m][n]);
                    }
        __syncthreads();
        const int tid = wid * 64 + lane, j = tid & 127, seg = tid >> 7;
        const int hcol = u.pn * 128 + j;
        const float* w = cw + (size_t)l * 3 * DFF2; const float* bb = cb + (size_t)l * DFF2;
        const float wg0 = w[hcol], wg1 = w[DFF2 + hcol], wg2 = w[2 * DFF2 + hcol], bg = bb[hcol];
        const float wv0 = w[DFF + hcol], wv1 = w[DFF2 + DFF + hcol], wv2 = w[2 * DFF2 + DFF + hcol], bv = bb[DFF + hcol];
        const int R = u.pm * 256 + seg * 64;
        const bool isP = R < T_P;
        float g2 = 0.f, g1 = 0.f, v2 = 0.f, v1 = 0.f; int skip = 0;
        const LAS bf16_t* U = (const LAS bf16_t*)lds;
        if (isP) {
            if (seg > 0) { g2 = bf2f(U[(seg * 64 - 2) * LS + j]); g1 = bf2f(U[(seg * 64 - 1) * LS + j]); v2 = bf2f(U[(seg * 64 - 2) * LS + 128 + j]); v1 = bf2f(U[(seg * 64 - 1) * LS + 128 + j]); }
            else if ((R & 8191) != 0) skip = 2;
        } else {
            const int sb = (R - T_P) >> 6; const float* fs = fstate + (size_t)(l * 32 + sb) * 2 * DFF2;
            g2 = fs[hcol]; g1 = fs[DFF2 + hcol]; v2 = fs[DFF + hcol]; v1 = fs[DFF2 + DFF + hcol];
        }
        bf16_t* hp = H + (size_t)R * DFF + hcol;
        for (int i = 0; i < 64; ++i) {
            const float gq = bf2f(U[(seg * 64 + i) * LS + j]), vq = bf2f(U[(seg * 64 + i) * LS + 128 + j]);
            if (i >= skip) {
                const float cgv = bg + wg0 * g2 + wg1 * g1 + wg2 * gq, cvv = bv + wv0 * v2 + wv1 * v1 + wv2 * vq;
                const float hv = silu_f(cgv) * cvv;
                hp[(size_t)i * DFF] = (bf16_t)(cvt_pk_bf16(hv, 0.f) & 0xffffu);
            }
            g2 = g1; g1 = gq; v2 = v1; v1 = vq;
            if (isP) {
                if (seg == 0 && i < 2) { float* hl = halo + ((size_t)u.pm * 4 + i) * DFF2; hl[hcol] = gq; hl[DFF + hcol] = vq; }
                if (seg == 3 && i >= 62) { float* hl = halo + ((size_t)u.pm * 4 + 2 + (i - 62)) * DFF2; hl[hcol] = gq; hl[DFF + hcol] = vq;
                    if ((u.pm & 31) == 31) { float* o = out + O_PF + ((size_t)(l * 4 + (u.pm >> 5)) * 2 + (i - 62)) * DFF2; o[hcol] = gq; o[DFF + hcol] = vq; } }
            } else if (i >= 62) {
                const int sb = (R - T_P) >> 6; float* o = out + O_SF + ((size_t)(l * 32 + sb) * 2 + (i - 62)) * DFF2; o[hcol] = gq; o[DFF + hcol] = vq;
            }
        }
    }
};

__device__ __forceinline__ void ln_row(const float* src, float* x32, bf16_t* xb, const float* g, const float* b, int lane) {
    f32x4 v[4]; float s = 0.f;
#pragma unroll
    for (int i = 0; i < 4; ++i) { v[i] = *(const f32x4*)(src + i * 256 + lane * 4); s += (v[i][0] + v[i][1]) + (v[i][2] + v[i][3]); }
#pragma unroll
    for (int o = 32; o >= 1; o >>= 1) s += __shfl_xor(s, o);
    const float mu = s * (1.0f / 1024.0f); float q = 0.f;
#pragma unroll
    for (int i = 0; i < 4; ++i) { const f32x4 d = v[i] - mu; q += (d[0] * d[0] + d[1] * d[1]) + (d[2] * d[2] + d[3] * d[3]); }
#pragma unroll
    for (int o = 32; o >= 1; o >>= 1) q += __shfl_xor(q, o);
    const float rstd = 1.0f / sqrtf(q * (1.0f / 1024.0f) + LN_EPS);
#pragma unroll
    for (int i = 0; i < 4; ++i) {
        const f32x4 gg = *(const f32x4*)(g + i * 256 + lane * 4), bb = *(const f32x4*)(b + i * 256 + lane * 4);
        const f32x4 o = (v[i] - mu) * rstd * gg + bb;
        *(f32x4*)(x32 + i * 256 + lane * 4) = o; *(u32x2*)(xb + i * 256 + lane * 4) = pack4(o);
    }
}

__device__ __forceinline__ void tr_tile(LAS float* tile, const float* src, int Nsrc, bf16_t* dst, int K, int n0, int k0, int mode, int tid) {
    const int nn = tid & 63, np = n0 + nn; int sc;
    if (mode == 0) sc = np < C_U ? np : (np < C_DT ? np + 6 : (np < C_DT + 6 ? np - 512 : -1));
    else if (mode == 1) sc = np;
    else { const int pn = np >> 8, jj = np & 255; sc = jj < 128 ? pn * 128 + jj : DFF + pn * 128 + (jj - 128); }
#pragma unroll
    for (int i = 0; i < 8; ++i) { const int kk = (tid >> 6) + 8 * i; tile[kk * 65 + nn] = sc >= 0 ? src[(size_t)(k0 + kk) * Nsrc + sc] : 0.f; }
    __syncthreads();
    const int kk2 = (tid & 31) * 2;
#pragma unroll
    for (int i = 0; i < 4; ++i) { const int nn2 = (tid >> 5) + 16 * i; *(unsigned*)(dst + (size_t)(n0 + nn2) * K + k0 + kk2) = cvt_pk_bf16(tile[kk2 * 65 + nn2], tile[(kk2 + 1) * 65 + nn2]); }
    __syncthreads();
}

__device__ __forceinline__ void phase_prep(KP& p, LAS unsigned char* lds) {
    int tid_ = threadIdx.x; asm volatile("" : "+v"(tid_));
    const int tid = tid_, wid = tid >> 6, lane = tid & 63;
    for (int row = blockIdx.x * 8 + wid; row < T_ALL; row += gridDim.x * 8) {
        const float* src = row < T_P ? p.in[0] + (size_t)row * DM : p.in[1] + (size_t)(row - T_P) * DM;
        ln_row(src, p.out + (size_t)row * DM, (bf16_t*)(p.ws + W_XB) + (size_t)row * DM, p.in[7], p.in[8], lane);
    }
    constexpr int T_IN = 48 * 16, T_OUT = 16 * 16, T_UPT = 88 * 16, T_DNT = 16 * 44, T_L = T_IN + T_OUT + T_UPT + T_DNT;
    for (int it = blockIdx.x; it < 4 * T_L; it += gridDim.x) {
        const int l = it / T_L; int r = it % T_L;
        if (r < T_IN) tr_tile((LAS float*)lds, p.in[9] + (size_t)l * DM * 2950, 2950, (bf16_t*)(p.ws + W_IN + l * W_IN_L), DM, (r >> 4) * 64, (r & 15) * 64, 0, tid);
        else if ((r -= T_IN) < T_OUT) tr_tile((LAS float*)lds, p.in[19] + (size_t)l * DM * DM, DM, (bf16_t*)(p.ws + W_OUT + l * W_OUT_L), DM, (r >> 4) * 64, (r & 15) * 64, 1, tid);
        else if ((r -= T_OUT) < T_UPT) tr_tile((LAS float*)lds, p.in[22] + (size_t)l * DM * DFF2, DFF2, (bf16_t*)(p.ws + W_UP + l * W_UP_L), DM, (r >> 4) * 64, (r & 15) * 64, 2, tid);
        else { r -= T_UPT; tr_tile((LAS float*)lds, p.in[25] + (size_t)l * DFF * DM, DM, (bf16_t*)(p.ws + W_DN + l * W_DN_L), DFF, (r / 44) * 64, (r % 44) * 64, 1, tid); }
    }
    for (int i = blockIdx.x * 512 + tid; i < 4 * 4 * 128 * 128; i += gridDim.x * 512) {
        const int jj = i & 127, ii = (i >> 7) & 127;
        ((bf16_t*)(p.ws + W_GW))[i] = (bf16_t)(cvt_pk_bf16(jj <= ii ? p.in[16][i] : 0.f, 0.f) & 0xffffu);
    }
}

__device__ __forceinline__ void phase_ln(KP& p, const float* g, const float* b) {
    int tid_ = threadIdx.x; asm volatile("" : "+v"(tid_));
    const int wid = tid_ >> 6, lane = tid_ & 63;
    for (int row = blockIdx.x * 8 + wid; row < T_ALL; row += gridDim.x * 8)
        ln_row(p.out + (size_t)row * DM, p.out + (size_t)row * DM, (bf16_t*)(p.ws + W_XB) + (size_t)row * DM, g, b, lane);
}

__device__ __forceinline__ void dt_scan(KP& p, int l, int u, int g, int wid, int lane, float& dt, float& ac, float& last) {
    const int h = g * 3 + wid;
    dt = ((const float*)(p.ws + W_DTB))[(size_t)(u * 64 + lane) * 8 + h];
    const float a = -__expf(p.in[14][l * 6 + h]);
    float v = dt * a;
#pragma unroll
    for (int o = 1; o < 64; o <<= 1) { const float t = __shfl_up(v, o); if (lane >= o) v += t; }
    ac = v; last = __shfl(v, 63);
}

__device__ __forceinline__ f32x4 xbc_row(KP& p, int l, int u, int s, int ch) {
    const bf16_t* proj = (const bf16_t*)(p.ws + W_PROJ);
    const bool isP = u < 512; const bool hasprev = isP && (u & 127) != 0;
    if (s >= 0 || hasprev) return unpack4(*(const u32x2*)(proj + (size_t)(u * 64 + s) * NPROJ + C_XBC + ch));
    if (!isP) return *(const f32x4*)(p.in[5] + (unsigned)(((l * 32 + (u - 512)) * 3 + (3 + s)) * 896 + ch));
    return (f32x4){0.f, 0.f, 0.f, 0.f};
}
__device__ __forceinline__ void ssd_states(KP& p, LAS unsigned char* lds, int l, int u) {
    int tid_ = threadIdx.x; asm volatile("" : "+v"(tid_));
    const int tid = tid_, wid = tid >> 6, lane = tid & 63, fr = lane & 15, fq = lane >> 4;
    LAS bf16_t* xT = (LAS bf16_t*)lds;
    LAS bf16_t* BT = (LAS bf16_t*)(lds + 55296);
    LAS float* wgt = (LAS float*)(lds + 92160);
    bf16_t* XC = (bf16_t*)(p.ws + W_XB);
    __syncthreads();
    if (wid < 6) {
        float dt, ac, last; dt_scan(p, l, u, wid / 3, wid % 3, lane, dt, ac, last);
        wgt[wid * 64 + lane] = dt * __expf(last - ac);
        if (lane == 0) ((float*)(p.ws + W_CD))[u * 8 + wid] = __expf(last);
    }
    __syncthreads();
    if (tid < 448) {
        const int cgp = tid % 224, seg = tid / 224, ch = cgp * 4, r0 = seg * 32;
        const float* cw = p.in[11] + (size_t)l * 4 * 896 + ch;
        const f32x4 w0 = *(const f32x4*)cw, w1 = *(const f32x4*)(cw + 896), w2 = *(const f32x4*)(cw + 2 * 896), w3 = *(const f32x4*)(cw + 3 * 896);
        const f32x4 bs = *(const f32x4*)(p.in[12] + (size_t)l * 896 + ch);
        f32x4 xm3 = xbc_row(p, l, u, r0 - 3, ch), xm2 = xbc_row(p, l, u, r0 - 2, ch), xm1 = xbc_row(p, l, u, r0 - 1, ch);
        const bf16_t* src = (const bf16_t*)(p.ws + W_PROJ) + (size_t)(u * 64) * NPROJ + C_XBC + ch;
        bf16_t* dst = XC + (size_t)(u * 64) * 896 + ch;
        const int hh = ch >> 6;
#pragma unroll 2
        for (int i = r0; i < r0 + 32; i += 2) {
            const f32x4 xa = unpack4(*(const u32x2*)(src + (size_t)i * NPROJ)), xb = unpack4(*(const u32x2*)(src + (size_t)(i + 1) * NPROJ));
            f32x4 ya = bs + w0 * xm3 + w1 * xm2 + w2 * xm1 + w3 * xa, yb = bs + w0 * xm2 + w1 * xm1 + w2 * xa + w3 * xb;
#pragma unroll
            for (int e = 0; e < 4; ++e) { ya[e] = silu_f(ya[e]); yb[e] = silu_f(yb[e]); }
            xm3 = xm1; xm2 = xa; xm1 = xb;
            *(u32x2*)(dst + (size_t)i * 896) = pack4(ya); *(u32x2*)(dst + (size_t)(i + 1) * 896) = pack4(yb);
            if (ch < 384) { const float wa = wgt[hh * 64 + i], wb = wgt[hh * 64 + i + 1];
#pragma unroll
                for (int e = 0; e < 4; ++e) *(LAS unsigned*)(xT + (ch + e) * 72 + i) = cvt_pk_bf16(ya[e] * wa, yb[e] * wb); }
            else if (ch < 640) {
#pragma unroll
                for (int e = 0; e < 4; ++e) *(LAS unsigned*)(BT + (ch - 384 + e) * 72 + i) = cvt_pk_bf16(ya[e], yb[e]); }
        }
    }
    __syncthreads();
    bf16_t* ST = (bf16_t*)(p.ws + W_ST);
#pragma unroll 2
    for (int k = 0; k < 24; ++k) {
        const int tt = wid * 24 + k, h = tt >> 5, pt = (tt & 31) >> 3, nt = tt & 7, g = h / 3;
        f32x4 acc = (f32x4){0.f, 0.f, 0.f, 0.f};
#pragma unroll
        for (int ks = 0; ks < 2; ++ks) {
            const bf16x8 rf = ldsfrag((LAS const unsigned char*)(xT + (h * 64 + pt * 16 + fr) * 72 + ks * 32 + fq * 8));
            const bf16x8 cf = ldsfrag((LAS const unsigned char*)(BT + (g * 128 + nt * 16 + fr) * 72 + ks * 32 + fq * 8));
            acc = MFMA16(cf, rf, acc);
        }
        *(u32x2*)(ST + ((size_t)(u * 6 + h) * 64 + pt * 16 + fr) * 128 + nt * 16 + fq * 4) = pack4(acc);
    }
}

__device__ __forceinline__ void gmlp_unit(KP& p, LAS unsigned char* lds, int l, int u) {
    int tid_ = threadIdx.x; asm volatile("" : "+v"(tid_));
    const int tid = tid_, wid = tid >> 6, lane = tid & 63, fr = lane & 15, fq = lane >> 4;
    LAS bf16_t* vT = (LAS bf16_t*)lds;
    LAS float* ssq = (LAS float*)(lds + 69632);
    const bf16_t* proj = (const bf16_t*)(p.ws + W_PROJ);
    const int half = u < 512 ? (u & 1) : 0, KJ = (half + 1) * 64, R0 = u * 64, Rb = R0 - half * 64;
    __syncthreads();
    for (int idx = tid; idx < KJ * 32; idx += 512) {
        const int j = idx & (KJ - 1), cgp = idx / KJ;
        const u32x4 w = *(const u32x4*)(proj + (size_t)(Rb + j) * NPROJ + C_VC + cgp * 8);
        const unsigned ww[4] = {w.x, w.y, w.z, w.w};
#pragma unroll
        for (int e = 0; e < 4; ++e) { vT[(cgp * 8 + 2 * e) * 136 + j] = (bf16_t)(ww[e] & 0xffffu); vT[(cgp * 8 + 2 * e + 1) * 136 + j] = (bf16_t)(ww[e] >> 16); }
    }
    __syncthreads();
    const int rt = wid & 3, cbase = (wid >> 2) * 8;
    const bf16_t* GW = (const bf16_t*)(p.ws + W_GW + l * W_GW_L);
    f32x4 acc[8];
#pragma unroll
    for (int gi = 0; gi < 2; ++gi) {
        const int gg = (cbase >> 2) + gi;
        bf16x8 rf[4];
#pragma unroll
        for (int ks = 0; ks < 4; ++ks) rf[ks] = glbfrag(GW + ((size_t)gg * 128 + half * 64 + rt * 16 + fr) * 128 + ks * 32 + fq * 8);
#pragma unroll
        for (int c4 = 0; c4 < 4; ++c4) {
            const int ct = cbase + gi * 4 + c4;
            f32x4 a = (f32x4){0.f, 0.f, 0.f, 0.f};
#pragma unroll
            for (int ks = 0; ks < 4; ++ks) if (ks * 32 < KJ) a = MFMA16(ldsfrag((LAS const unsigned char*)(vT + (ct * 16 + fr) * 136 + ks * 32 + fq * 8)), rf[ks], a);
            acc[gi * 4 + c4] = a;
        }
    }
    const int row = R0 + rt * 16 + fr; float sq = 0.f;
#pragma unroll
    for (int k = 0; k < 8; ++k) {
        const int col = (cbase + k) * 16 + fq * 4, gg = col >> 6;
        const float bsv = p.in[17][(size_t)(l * 4 + gg) * 128 + half * 64 + rt * 16 + fr];
        const f32x4 uv = unpack4(*(const u32x2*)(proj + (size_t)row * NPROJ + C_U + col));
        f32x4 o = uv * (acc[k] + bsv); acc[k] = o;
        sq += (o[0] * o[0] + o[1] * o[1]) + (o[2] * o[2] + o[3] * o[3]);
    }
    sq += __shfl_xor(sq, 16); sq += __shfl_xor(sq, 32);
    if (fq == 0) ssq[(wid >> 2) * 64 + rt * 16 + fr] = sq;
    __syncthreads();
    const float rstd = 1.0f / sqrtf((ssq[rt * 16 + fr] + ssq[64 + rt * 16 + fr]) * (1.0f / 256.0f) + RMS_EPS);
    bf16_t* mix = (bf16_t*)(p.ws + W_MIX);
#pragma unroll
    for (int k = 0; k < 8; ++k) {
        const int col = (cbase + k) * 16 + fq * 4;
        const f32x4 gv = *(const f32x4*)(p.in[18] + (size_t)l * 1024 + 768 + col);
        *(u32x2*)(mix + (size_t)row * DM + 768 + col) = pack4(acc[k] * rstd * gv);
    }
}

__device__ __forceinline__ void scan_prompt(KP& p, int l, int item) {
    int tid_ = threadIdx.x; asm volatile("" : "+v"(tid_));
    const int gid = item * 512 + tid_, e = (gid & 2047) * 4, bh = gid >> 11, b = bh / 6, h = bh % 6;
    bf16_t* ST = (bf16_t*)(p.ws + W_ST); const float* CD = (const float*)(p.ws + W_CD);
    f32x4 st = (f32x4){0.f, 0.f, 0.f, 0.f};
#pragma unroll 1
    for (int c0 = 0; c0 < 128; c0 += 8) {
        u32x2 s[8]; float cd[8];
#pragma unroll
        for (int k = 0; k < 8; ++k) { const int u = b * 128 + c0 + k; s[k] = *(const u32x2*)(ST + ((size_t)(u * 6 + h)) * 8192 + e); cd[k] = CD[u * 8 + h]; }
#pragma unroll
        for (int k = 0; k < 8; ++k) { const int u = b * 128 + c0 + k; *(u32x2*)(ST + ((size_t)(u * 6 + h)) * 8192 + e) = pack4(st); st = st * cd[k] + unpack4(s[k]); }
    }
    *(f32x4*)(p.out + O_PH + ((size_t)(l * 4 + b) * 6 + h) * 8192 + e) = st;
}
__device__ __forceinline__ void scan_sample(KP& p, int l, int item) {
    int tid_ = threadIdx.x; asm volatile("" : "+v"(tid_));
    const int gid = item * 512 + tid_, e = (gid & 2047) * 4, sbh = gid >> 11, sb = sbh / 6, h = sbh % 6;
    bf16_t* ST = (bf16_t*)(p.ws + W_ST); const float* CD = (const float*)(p.ws + W_CD);
    const int u = 512 + sb;
    const f32x4 st = *(const f32x4*)(p.in[4] + ((size_t)(l * 32 + sb) * 6 + h) * 8192 + e);
    const f32x4 s = unpack4(*(const u32x2*)(ST + ((size_t)(u * 6 + h)) * 8192 + e));
    *(u32x2*)(ST + ((size_t)(u * 6 + h)) * 8192 + e) = pack4(st);
    *(f32x4*)(p.out + O_SH + ((size_t)(l * 32 + sb) * 6 + h) * 8192 + e) = st * CD[u * 8 + h] + s;
}

__device__ __forceinline__ void attn_unit(KP& p, LAS unsigned char* lds, int l, int u) {
    int tid_ = threadIdx.x; asm volatile("" : "+v"(tid_));
    const int tid = tid_, wid = tid >> 6, lane = tid & 63, fr = lane & 15, fq = lane >> 4;
    LAS bf16_t* Kb = (LAS bf16_t*)lds;
    LAS bf16_t* VT = (LAS bf16_t*)(lds + 50176);
    LAS bf16_t* Pw = (LAS bf16_t*)(lds + 105472) + wid * 16 * 72;
    LAS float* bias = (LAS float*)(lds + 123904);
    LAS float* ssq = (LAS float*)(lds + 128512);
    const bf16_t* proj = (const bf16_t*)(p.ws + W_PROJ);
    const bool isP = u < 512; const int R0 = u * 64, c = u & 127, b = u >> 7, sb = u - 512;
    const int qt = wid & 3, hbase = (wid >> 2) * 3;
    __syncthreads();
    for (int i = tid; i < 1152; i += 512) bias[i] = p.in[10][(size_t)l * 1152 + i];
    bf16x8 qf[3][2];
#pragma unroll
    for (int hh = 0; hh < 3; ++hh)
#pragma unroll
        for (int ks = 0; ks < 2; ++ks) qf[hh][ks] = glbfrag(proj + (size_t)(R0 + qt * 16 + fr) * NPROJ + (hbase + hh) * 64 + ks * 32 + fq * 8);
    float mrun[3], lrun[3]; f32x4 O[3][4];
#pragma unroll
    for (int hh = 0; hh < 3; ++hh) { mrun[hh] = -1e30f; lrun[hh] = 0.f;
#pragma unroll
        for (int d = 0; d < 4; ++d) O[hh][d] = (f32x4){0.f, 0.f, 0.f, 0.f}; }
    const int blk_lo = isP ? (c < 8 ? 8 - c : 0) : 0;
    u32x4 kr[6], vr[6];
    const int kkey0 = tid / 48, kcg = tid % 48;
    const int vkp = tid & 31, vcg0 = tid >> 5;
#define ATT_LOADP(blkv) do { const size_t rb_ = isP ? (size_t)b * 8192 + (size_t)(c - 8 + (blkv)) * 64 : (size_t)T_P + (size_t)sb * 64; \
        _Pragma("unroll") for (int it = 0; it < 3; ++it) { const int idx = it * 512 + tid; kr[it] = *(const u32x4*)(proj + (rb_ + idx / 48) * NPROJ + C_K + (idx % 48) * 8); } \
        _Pragma("unroll") for (int it = 0; it < 3; ++it) { const int cg_ = vcg0 + it * 16; \
            vr[2 * it] = *(const u32x4*)(proj + (rb_ + 2 * vkp) * NPROJ + C_V + cg_ * 8); vr[2 * it + 1] = *(const u32x4*)(proj + (rb_ + 2 * vkp + 1) * NPROJ + C_V + cg_ * 8); } } while (0)
    bool have = false;
    if (isP || blk_lo == 8) { ATT_LOADP(blk_lo); have = true; }
#pragma unroll 1
    for (int blk = blk_lo; blk <= 8; ++blk) {
        __syncthreads();
        if (!have) {
#pragma unroll
            for (int it = 0; it < 6; ++it) { const int idx = it * 512 + tid;
                const float* s = p.in[2] + ((size_t)(l * 32 + sb) * 512 + blk * 64 + idx / 48) * 384 + (idx % 48) * 8; const f32x4 a = *(const f32x4*)s, bq = *(const f32x4*)(s + 4);
                kr[it].x = cvt_pk_bf16(a[0], a[1]); kr[it].y = cvt_pk_bf16(a[2], a[3]); kr[it].z = cvt_pk_bf16(bq[0], bq[1]); kr[it].w = cvt_pk_bf16(bq[2], bq[3]); }
#pragma unroll
            for (int it = 0; it < 6; ++it) { const int cg_ = vcg0 + (it >> 1) * 16;
                const float* s = p.in[3] + ((size_t)(l * 32 + sb) * 512 + blk * 64 + 2 * vkp + (it & 1)) * 384 + cg_ * 8; const f32x4 a = *(const f32x4*)s, bq = *(const f32x4*)(s + 4);
                vr[it].x = cvt_pk_bf16(a[0], a[1]); vr[it].y = cvt_pk_bf16(a[2], a[3]); vr[it].z = cvt_pk_bf16(bq[0], bq[1]); vr[it].w = cvt_pk_bf16(bq[2], bq[3]); }
        }
        if (have) { const size_t rb_ = isP ? (size_t)b * 8192 + (size_t)(c - 8 + blk) * 64 : (size_t)T_P + (size_t)sb * 64;
#pragma unroll
            for (int it = 3; it < 6; ++it) { const int idx = it * 512 + tid; kr[it] = *(const u32x4*)(proj + (rb_ + idx / 48) * NPROJ + C_K + (idx % 48) * 8); } }
#pragma unroll
        for (int it = 0; it < 3; ++it) { const int cg_ = vcg0 + it * 16; const u32x4 w0 = vr[2 * it], w1 = vr[2 * it + 1];
            const unsigned a0[4] = {w0.x, w0.y, w0.z, w0.w}, a1[4] = {w1.x, w1.y, w1.z, w1.w};
#pragma unroll
            for (int e = 0; e < 4; ++e) {
                *(LAS unsigned*)(VT + (cg_ * 8 + 2 * e) * 72 + 2 * vkp) = (a0[e] & 0xffffu) | (a1[e] << 16);
                *(LAS unsigned*)(VT + (cg_ * 8 + 2 * e + 1) * 72 + 2 * vkp) = (a0[e] >> 16) | (a1[e] & 0xffff0000u); } }
#pragma unroll
        for (int it = 0; it < 6; ++it) { const int idx = it * 512 + tid; *(LAS u32x4*)(Kb + (idx / 48) * 392 + (idx % 48) * 8) = kr[it]; }
        __syncthreads();
        have = false;
        if (blk < 8 && (isP || blk == 7)) { ATT_LOADP(blk + 1); have = true; }
#pragma unroll
        for (int hh = 0; hh < 3; ++hh) {
            const int h = hbase + hh;
            f32x4 s[4]; float mx = -1e30f;
#pragma unroll
            for (int kt = 0; kt < 4; ++kt) {
                f32x4 a = (f32x4){0.f, 0.f, 0.f, 0.f};
#pragma unroll
                for (int ks = 0; ks < 2; ++ks) a = MFMA16(ldsfrag((LAS const unsigned char*)(Kb + (kt * 16 + fr) * 392 + h * 64 + ks * 32 + fq * 8)), qf[hh][ks], a);
                if (blk <= 5) { const float bc = bias[h * 192 + 191];
#pragma unroll
                    for (int j = 0; j < 4; ++j) { a[j] = a[j] * 0.125f + bc; mx = fmaxf(mx, a[j]); } }
                else {
#pragma unroll
                    for (int j = 0; j < 4; ++j) {
                        int rel = (qt * 16 + fr) + 512 - (blk * 64 + kt * 16 + fq * 4 + j); rel = rel > 128 ? 128 : rel;
                        a[j] = a[j] * 0.125f + bias[h * 192 + rel + 63]; mx = fmaxf(mx, a[j]);
                    } }
                s[kt] = a;
            }
            mx = fmaxf(mx, __shfl_xor(mx, 16)); mx = fmaxf(mx, __shfl_xor(mx, 32));
            const float mnew = fmaxf(mrun[hh], mx), fac = __expf(mrun[hh] - mnew); mrun[hh] = mnew;
            float rs = 0.f;
#pragma unroll
            for (int kt = 0; kt < 4; ++kt) {
#pragma unroll
                for (int j = 0; j < 4; ++j) { s[kt][j] = __expf(s[kt][j] - mnew); rs += s[kt][j]; }
                *(LAS u32x2*)(Pw + fr * 72 + kt * 16 + fq * 4) = pack4(s[kt]);
            }
            rs += __shfl_xor(rs, 16); rs += __shfl_xor(rs, 32);
            lrun[hh] = lrun[hh] * fac + rs;
#pragma unroll
            for (int d = 0; d < 4; ++d) O[hh][d] *= fac;
            LDS_WAVE_SYNC();
#pragma unroll
            for (int ks = 0; ks < 2; ++ks) {
                const bf16x8 pf = ldsfrag((LAS const unsigned char*)(Pw + fr * 72 + ks * 32 + fq * 8));
#pragma unroll
                for (int d = 0; d < 4; ++d) O[hh][d] = MFMA16(ldsfrag((LAS const unsigned char*)(VT + (h * 64 + d * 16 + fr) * 72 + ks * 32 + fq * 8)), pf, O[hh][d]);
            }
            LDS_WAVE_SYNC();
        }
    }
    float sq = 0.f;
#pragma unroll
    for (int hh = 0; hh < 3; ++hh) { const float inv = 1.0f / lrun[hh];
#pragma unroll
        for (int d = 0; d < 4; ++d) { O[hh][d] *= inv; const f32x4 o = O[hh][d]; sq += (o[0] * o[0] + o[1] * o[1]) + (o[2] * o[2] + o[3] * o[3]); } }
    sq += __shfl_xor(sq, 16); sq += __shfl_xor(sq, 32);
    if (fq == 0) ssq[(wid >> 2) * 64 + qt * 16 + fr] = sq;
    __syncthreads();
    const float rstd = 1.0f / sqrtf((ssq[qt * 16 + fr] + ssq[64 + qt * 16 + fr]) * (1.0f / 384.0f) + RMS_EPS);
    bf16_t* mix = (bf16_t*)(p.ws + W_MIX);
#pragma unroll
    for (int hh = 0; hh < 3; ++hh)
#pragma unroll
        for (int d = 0; d < 4; ++d) {
            const int col = (hbase + hh) * 64 + d * 16 + fq * 4;
            const f32x4 gv = *(const f32x4*)(p.in[18] + (size_t)l * 1024 + col);
            *(u32x2*)(mix + (size_t)(R0 + qt * 16 + fr) * DM + col) = pack4(O[hh][d] * rstd * gv);
        }
}

__device__ __forceinline__ void ssd_y(KP& p, LAS unsigned char* lds, int l, int u) {
    int tid_ = threadIdx.x; asm volatile("" : "+v"(tid_));
    const int tid = tid_, wid = tid >> 6, lane = tid & 63, fr = lane & 15, fq = lane >> 4;
    LAS bf16_t* Cn = (LAS bf16_t*)lds;
    LAS bf16_t* Bn = (LAS bf16_t*)(lds + 17408);
    LAS bf16_t* xT = (LAS bf16_t*)(lds + 34816);
    LAS bf16_t* Mm = (LAS bf16_t*)(lds + 62464);
    LAS float* dtl = (LAS float*)(lds + 90112);
    LAS float* acl = (LAS float*)(lds + 90880);
    LAS float* ssq = (LAS float*)(lds + 91648);
    const bf16_t* proj = (const bf16_t*)(p.ws + W_PROJ);
    const bf16_t* HP = (const bf16_t*)(p.ws + W_ST);
    const bf16_t* XC = (const bf16_t*)(p.ws + W_XB) + (size_t)(u * 64) * 896;
    const int R0 = u * 64, lt = wid & 3;
    f32x4 yacc[2][6];
#pragma unroll
    for (int g = 0; g < 2; ++g) {
        __syncthreads();
        if (wid < 3) { float dt, ac, last; dt_scan(p, l, u, g, wid, lane, dt, ac, last); dtl[wid * 64 + lane] = dt; acl[wid * 64 + lane] = ac; }
#pragma unroll
        for (int it = 0; it < 4; ++it) {
            const int idx = it * 512 + tid, mat = idx >> 10, i = (idx >> 4) & 63, c8 = idx & 15;
            const u32x4 w = *(const u32x4*)(XC + (size_t)i * 896 + 384 + mat * 256 + g * 128 + c8 * 8);
            *(LAS u32x4*)((mat ? Cn : Bn) + i * 136 + c8 * 8) = w;
        }
#pragma unroll
        for (int it = 0; it < 3; ++it) {
            const int idx = it * 512 + tid, c4 = idx % 48, i = (idx / 48) * 2;
            const u32x2 wa = *(const u32x2*)(XC + (size_t)i * 896 + g * 192 + c4 * 4), wb = *(const u32x2*)(XC + (size_t)(i + 1) * 896 + g * 192 + c4 * 4);
            *(LAS unsigned*)(xT + (c4 * 4 + 0) * 72 + i) = (wa.x & 0xffffu) | (wb.x << 16);
            *(LAS unsigned*)(xT + (c4 * 4 + 1) * 72 + i) = (wa.x >> 16) | (wb.x & 0xffff0000u);
            *(LAS unsigned*)(xT + (c4 * 4 + 2) * 72 + i) = (wa.y & 0xffffu) | (wb.y << 16);
            *(LAS unsigned*)(xT + (c4 * 4 + 3) * 72 + i) = (wa.y >> 16) | (wb.y & 0xffff0000u);
        }
        __syncthreads();
#pragma unroll
        for (int k = 0; k < 2; ++k) {
            const int st = (wid >> 2) * 2 + k;
            f32x4 a = (f32x4){0.f, 0.f, 0.f, 0.f};
#pragma unroll
            for (int ks = 0; ks < 4; ++ks) a = MFMA16(ldsfrag((LAS const unsigned char*)(Bn + (st * 16 + fr) * 136 + ks * 32 + fq * 8)), ldsfrag((LAS const unsigned char*)(Cn + (lt * 16 + fr) * 136 + ks * 32 + fq * 8)), a);
            const int li = lt * 16 + fr;
#pragma unroll
            for (int hh = 0; hh < 3; ++hh) {
                const float al = acl[hh * 64 + li]; f32x4 mv;
#pragma unroll
                for (int j = 0; j < 4; ++j) { const int si = st * 16 + fq * 4 + j; mv[j] = si <= li ? a[j] * __expf(al - acl[hh * 64 + si]) * dtl[hh * 64 + si] : 0.f; }
                *(LAS u32x2*)(Mm + (hh * 64 + li) * 72 + st * 16 + fq * 4) = pack4(mv);
            }
        }
        __syncthreads();
#pragma unroll
        for (int k = 0; k < 6; ++k) {
            const int ctile = (wid >> 2) * 6 + k, hh = ctile >> 2, pt = ctile & 3, h = g * 3 + hh, li = lt * 16 + fr;
            f32x4 ad = (f32x4){0.f, 0.f, 0.f, 0.f}, ao = (f32x4){0.f, 0.f, 0.f, 0.f};
#pragma unroll
            for (int ks = 0; ks < 2; ++ks) ad = MFMA16(ldsfrag((LAS const unsigned char*)(xT + (hh * 64 + pt * 16 + fr) * 72 + ks * 32 + fq * 8)), ldsfrag((LAS const unsigned char*)(Mm + (hh * 64 + li) * 72 + ks * 32 + fq * 8)), ad);
#pragma unroll
            for (int ks = 0; ks < 4; ++ks) ao = MFMA16(glbfrag(HP + ((size_t)(u * 6 + h) * 64 + pt * 16 + fr) * 128 + ks * 32 + fq * 8), ldsfrag((LAS const unsigned char*)(Cn + li * 136 + ks * 32 + fq * 8)), ao);
            const float ea = __expf(acl[hh * 64 + li]), dsk = p.in[15][l * 6 + h];
            const f32x4 xv = unpack4(*(const u32x2*)(XC + (size_t)li * 896 + h * 64 + pt * 16 + fq * 4));
            const f32x4 zv = unpack4(*(const u32x2*)(proj + (size_t)(R0 + li) * NPROJ + C_Z + h * 64 + pt * 16 + fq * 4));
            f32x4 y = ad + ao * ea + xv * dsk;
#pragma unroll
            for (int j = 0; j < 4; ++j) y[j] *= silu_f(zv[j]);
            yacc[g][k] = y;
            asm volatile("" ::: "memory");
        }
    }
    float sq = 0.f;
#pragma unroll
    for (int g = 0; g < 2; ++g)
#pragma unroll
        for (int k = 0; k < 6; ++k) { const f32x4 o = yacc[g][k]; sq += (o[0] * o[0] + o[1] * o[1]) + (o[2] * o[2] + o[3] * o[3]); }
    sq += __shfl_xor(sq, 16); sq += __shfl_xor(sq, 32);
    if (fq == 0) ssq[(wid >> 2) * 64 + lt * 16 + fr] = sq;
    __syncthreads();
    const float rstd = 1.0f / sqrtf((ssq[lt * 16 + fr] + ssq[64 + lt * 16 + fr]) * (1.0f / 384.0f) + RMS_EPS);
    bf16_t* mix = (bf16_t*)(p.ws + W_MIX);
#pragma unroll
    for (int g = 0; g < 2; ++g)
#pragma unroll
        for (int k = 0; k < 6; ++k) {
            const int col = 384 + g * 192 + ((wid >> 2) * 6 + k) * 16 + fq * 4;
            const f32x4 gv = *(const f32x4*)(p.in[18] + (size_t)l * 1024 + col);
            *(u32x2*)(mix + (size_t)(R0 + lt * 16 + fr) * DM + col) = pack4(yacc[g][k] * rstd * gv);
        }
}

__device__ __forceinline__ void phase_fix(KP& p, int l) {
    const float* halo = (const float*)(p.ws + W_MIX); bf16_t* H = (bf16_t*)(p.ws + W_PROJ);
    const float* w = p.in[23] + (size_t)l * 3 * DFF2; const float* bb = p.in[24] + (size_t)l * DFF2;
    int tid_ = threadIdx.x; asm volatile("" : "+v"(tid_));
    for (int i = blockIdx.x * 512 + tid_; i < 128 * DFF2; i += gridDim.x * 512) {
        const int pm = i / DFF2, cc = i % DFF2;
        if ((pm & 31) == 0 || cc >= DFF) continue;
        const float* h0 = halo + (size_t)(pm - 1) * 4 * DFF2; const float* h1 = halo + (size_t)pm * 4 * DFF2;
        float r[2];
#pragma unroll
        for (int rr = 0; rr < 2; ++rr) {
            float o[2];
#pragma unroll
            for (int gv = 0; gv < 2; ++gv) {
                const int c2 = cc + gv * DFF;
                const float xm2 = h0[2 * DFF2 + c2], xm1 = h0[3 * DFF2 + c2], x0 = h1[c2], x1 = h1[DFF2 + c2];
                o[gv] = rr == 0 ? bb[c2] + w[c2] * xm2 + w[DFF2 + c2] * xm1 + w[2 * DFF2 + c2] * x0 : bb[c2] + w[c2] * xm1 + w[DFF2 + c2] * x0 + w[2 * DFF2 + c2] * x1;
            }
            r[rr] = silu_f(o[0]) * o[1];
        }
        H[((size_t)pm * 256) * DFF + cc] = (bf16_t)(cvt_pk_bf16(r[0], 0.f) & 0xffffu);
        H[((size_t)pm * 256 + 1) * DFF + cc] = (bf16_t)(cvt_pk_bf16(r[1], 0.f) & 0xffffu);
    }
}

#define XB_TMO      128
#define XB_XCNT(j)  (256  + 64 * (j))
#define XB_XSUB(j)  (1280 + 64 * (j))
#define XB_XGEN(j)  (2304 + 64 * (j))
#define XB_TOP      3328
#define XB_TOPGEN   3392
#define XCD_BAR_WORDS 3456
#define XB_SPIN_CAP (1u << 18)

__device__ __forceinline__ unsigned xb_ld(unsigned* p)              { return __hip_atomic_load(p, __ATOMIC_RELAXED, __HIP_MEMORY_SCOPE_AGENT); }
__device__ __forceinline__ unsigned xb_add(unsigned* p, unsigned v) { return __hip_atomic_fetch_add(p, v, __ATOMIC_RELAXED, __HIP_MEMORY_SCOPE_AGENT); }
__device__ __forceinline__ unsigned xb_xcc_id() { return (unsigned)__builtin_amdgcn_s_getreg((3 << 11) | 20) & 0xFu; }
#define XB_SPIN(cond, bar) do { unsigned _sp = 0; while (cond) { __builtin_amdgcn_s_sleep(1); \
    if ((++_sp & 255u) == 0u) { if (xb_ld(&(bar)[XB_TMO])) break; if (_sp > XB_SPIN_CAP) { atomicAdd(&(bar)[XB_TMO], 1u); break; } } } } while (0)

struct XcdBarrier {
    unsigned* bar; unsigned x;
    volatile LAS unsigned* st;
};

__device__ __forceinline__ XcdBarrier xcd_barrier_post(unsigned* bar, volatile LAS unsigned* st) {
    XcdBarrier b; b.bar = bar; b.x = xb_xcc_id(); b.st = st;
    if (threadIdx.x == 0) (void)xb_add(&bar[XB_XCNT(b.x)], 1u);
    return b;
}
__device__ __forceinline__ void xcd_barrier_complete(unsigned* bar, unsigned x, unsigned& nloc, unsigned& nx) {
    const unsigned G = gridDim.x * gridDim.y * gridDim.z;
    unsigned sum, cnt, mine, sp = 0u;
    for (;;) {
        sum = 0u; cnt = 0u; mine = 0u;
#pragma unroll
        for (unsigned j = 0; j < 16; ++j) { const unsigned c = xb_ld(&bar[XB_XCNT(j)]); sum += c; cnt += (c > 0u) ? 1u : 0u; mine = (j == x) ? c : mine; }
        if (sum == G) break;
        __builtin_amdgcn_s_sleep(1);
        if ((++sp & 255u) == 0u) { if (xb_ld(&bar[XB_TMO])) break; if (sp > XB_SPIN_CAP) { atomicAdd(&bar[XB_TMO], 1u); break; } }
    }
    nloc = mine > 0u ? mine : 1u; nx = cnt > 0u ? cnt : 1u;
}

__device__ __forceinline__ void xcd_barrier(const XcdBarrier& b) {
    asm volatile("s_waitcnt vmcnt(0)" ::: "memory");
    __syncthreads();
    if (threadIdx.x == 0) {
        unsigned* bar = b.bar;
        __builtin_amdgcn_s_waitcnt(0);
        unsigned nloc = b.st[0], nx = b.st[1];
        if (nloc == 0u) { xcd_barrier_complete(bar, b.x, nloc, nx); b.st[0] = nloc; b.st[1] = nx; }
        const unsigned old = xb_add(&bar[XB_XSUB(b.x)], 1u);
        const unsigned gen = old / nloc;
        if (old + 1u == (gen + 1u) * nloc) {
            __builtin_amdgcn_fence(__ATOMIC_RELEASE, "agent");
            asm volatile("s_waitcnt vmcnt(0)" ::: "memory");
            const unsigned og = xb_add(&bar[XB_TOP], 1u);
            const unsigned tg = og / nx;
            if (og + 1u == (tg + 1u) * nx) xb_add(&bar[XB_TOPGEN], 1u);
            else XB_SPIN(xb_ld(&bar[XB_TOPGEN]) == tg, bar);
            __builtin_amdgcn_fence(__ATOMIC_ACQUIRE, "agent");
            xb_add(&bar[XB_XGEN(b.x)], 1u);
            asm volatile("s_waitcnt vmcnt(0)" ::: "memory");
        } else {
            XB_SPIN(xb_ld(&bar[XB_XGEN(b.x)]) == gen, bar);
            __builtin_amdgcn_fence(__ATOMIC_ACQUIRE, "agent");
            asm volatile("s_waitcnt vmcnt(0)" ::: "memory");
        }
    }
    __syncthreads();
}

__global__ void __launch_bounds__(512, 2) mega(Params pa) {
    extern __shared__ __attribute__((aligned(16))) unsigned char shm[];
    LAS unsigned char* lds = (LAS unsigned char*)shm;
    const int G = gridDim.x, bid = blockIdx.x;
    KP* pk = (KP*)__builtin_amdgcn_kernarg_segment_ptr();
    volatile LAS unsigned* bst = (volatile LAS unsigned*)(lds + LDS_BYTES - 16);
    XcdBarrier xb; xb.bar = nullptr; xb.x = 0; xb.st = bst;
    if (pa.coop) { if (threadIdx.x < 2) bst[threadIdx.x] = 0u; __syncthreads(); xb = xcd_barrier_post((unsigned*)(pa.ws + W_BAR), bst); }
    for (int ph = pa.ph_lo; ph < pa.ph_hi; ++ph) {
        if (ph > pa.ph_lo && pa.coop) { if (ph == pa.ph_lo + 1) { __threadfence(); cg::this_grid().sync(); } else xcd_barrier(xb); }
        asm volatile("" : "+s"(pk)); KP& p = *pk;
        if (ph == 0) { phase_prep(p, lds); continue; }
        if (ph == 42) { int tq = threadIdx.x; asm volatile("" : "+v"(tq)); const unsigned short* w16 = (const unsigned short*)p.ws; for (size_t i = (size_t)bid * 512 + tq; i < (size_t)59418624; i += (size_t)G * 512) p.out[i] = (float)w16[i * 4]; continue; }
        if (ph == 41) { int tq = threadIdx.x; asm volatile("" : "+v"(tq)); for (size_t i = (size_t)bid * 512 + tq; i < (size_t)59418624; i += (size_t)G * 512) { const float v = p.out[i]; if (!(fabsf(v) < 1e30f)) p.out[i] = 0.f; } continue; }
        const int l = (ph - 1) / 10, k = (ph - 1) % 10;
        bf16_t* XB = (bf16_t*)(p.ws + W_XB);
        switch (k) {
        case 0: for (int rep = 0; rep < REP_G1; ++rep) { pg8::StaticOrder S; S.init(T_ALL, NPROJ, G, bid);
                  EpiIn E{(bf16_t*)(p.ws + W_PROJ), p.out, (float*)(p.ws + W_DTB), p.in[13], l};
                  pg8::gemm_phase(lds, pg8::Gemm{XB, (const bf16_t*)(p.ws + W_IN + l * W_IN_L), T_ALL, NPROJ, DM}, S, E); } break;
        case 1: for (int it = bid; it < 3 * NU64; it += G) { if (it < NU64) attn_unit(p, lds, l, NU64 - 1 - it); else if (it < 2 * NU64) ssd_states(p, lds, l, it - NU64); else gmlp_unit(p, lds, l, it - 2 * NU64); } break;
        case 2: for (int it = bid; it < 96 + 768; it += G) { if (it < 96) scan_prompt(p, l, it); else scan_sample(p, l, it - 96); } break;
        case 3: for (int rep = 0; rep < REP_M3; ++rep) for (int it = bid; it < NU64; it += G) ssd_y(p, lds, l, it); break;
        case 4: { pg8::StaticOrder S; S.init(T_ALL, DM, G, bid); EpiRes E{p.out};
                  pg8::gemm_phase(lds, pg8::Gemm{(const bf16_t*)(p.ws + W_MIX), (const bf16_t*)(p.ws + W_OUT + l * W_OUT_L), T_ALL, DM, DM}, S, E); } break;
        case 5: phase_ln(p, p.in[20] + l * DM, p.in[21] + l * DM); break;
        case 6: for (int rep = 0; rep < REP_G3; ++rep) { pg8::StaticOrder S; S.init(T_ALL, DFF2, G, bid);
                  EpiUp E{(bf16_t*)(p.ws + W_PROJ), (float*)(p.ws + W_MIX), p.out, p.in[23], p.in[24], p.in[6], l};
                  pg8::OneUnit o1;
                  for (int i = 0; S.next(i, o1.u); ++i) { pg8::gemm_phase(lds, pg8::Gemm{XB, (const bf16_t*)(p.ws + W_UP + l * W_UP_L), T_ALL, DFF2, DM}, o1, E); __syncthreads(); } } break;
        case 7: phase_fix(p, l); break;
        case 8: { pg8::StaticOrder S; S.init(T_ALL, DM, G, bid); EpiRes E{p.out};
                  pg8::gemm_phase(lds, pg8::Gemm{(const bf16_t*)(p.ws + W_PROJ), (const bf16_t*)(p.ws + W_DN + l * W_DN_L), T_ALL, DM, DFF}, S, E); } break;
        case 9: phase_ln(p, p.in[26] + l * DM, p.in[27] + l * DM); break;
        }
    }
}

constexpr int N_PHASES = 41;
#ifndef MULTI_LAUNCH
#define MULTI_LAUNCH 0
#endif

extern "C" void kernel_launch(void* const* d_in, const int* in_sizes, int n_in, void* d_out, int out_size, void* d_ws, size_t ws_size, hipStream_t stream) {
    static int grid = 0;
    if (grid == 0) {
        if (n_in != 28 || ws_size < W_END2) { fprintf(stderr, "kernel_launch: need 28 inputs and %zu bytes of workspace (got %d, %zu)\n", (size_t)W_END2, n_in, ws_size); grid = -1; return; }
        int dev = 0, cus = 0, per_cu = 0;
        hipGetDevice(&dev); hipDeviceGetAttribute(&cus, hipDeviceAttributeMultiprocessorCount, dev);
        if (hipFuncSetAttribute((const void*)mega, hipFuncAttributeMaxDynamicSharedMemorySize, LDS_BYTES) != hipSuccess) { fprintf(stderr, "kernel_launch: hipFuncSetAttribute failed\n"); grid = -1; return; }
        hipOccupancyMaxActiveBlocksPerMultiprocessor(&per_cu, (const void*)mega, 512, LDS_BYTES);
        (void)hipGetLastError();
        if (per_cu < 1) per_cu = 1;
        grid = cus * 1;
    }
    if (grid < 0) return;
    Params p{};
    for (int i = 0; i < 28; ++i) p.in[i] = (const float*)d_in[i];
    p.out = (float*)d_out; p.ws = (unsigned char*)d_ws;
#if MULTI_LAUNCH
#ifdef PROBE_CUT
    for (int ph = 0; ph < PROBE_CUT; ++ph) { p.ph_lo = ph; p.ph_hi = ph + 1; p.coop = 0; hipLaunchKernelGGL(mega, dim3(grid), dim3(512), LDS_BYTES, stream, p); }
    p.ph_lo = 42; p.ph_hi = 43; p.coop = 0; hipLaunchKernelGGL(mega, dim3(grid), dim3(512), LDS_BYTES, stream, p);
#else
    for (int ph = 0; ph < N_PHASES; ++ph) { p.ph_lo = ph; p.ph_hi = ph + 1; p.coop = 0; hipLaunchKernelGGL(mega, dim3(grid), dim3(512), LDS_BYTES, stream, p); }
#endif
#else
    p.ph_lo = 0; p.ph_hi = N_PHASES; p.coop = 1;
    if (hipMemsetAsync((char*)d_ws + W_BAR, 0, 16384, stream) != hipSuccess) { fprintf(stderr, "kernel_launch: memset failed\n"); return; }
    void* args[] = {&p};
    hipError_t e = hipLaunchCooperativeKernel((const void*)mega, dim3(grid), dim3(512), args, LDS_BYTES, stream);
    if (e != hipSuccess) fprintf(stderr, "cooperative launch failed: %s (grid %d)\n", hipGetErrorString(e), grid);
#endif
}
```

```cpp
#define REP_G1 1
#define REP_M1 1
#define REP_ATT 1
#define REP_M3 1
#define REP_G3 1
#include <hip/hip_runtime.h>
#include <hip/hip_cooperative_groups.h>
#include <cstdio>
namespace cg = cooperative_groups;

#define LAS __attribute__((address_space(3)))
typedef unsigned short bf16_t;
typedef short bf16x8 __attribute__((ext_vector_type(8)));
typedef float f32x4 __attribute__((ext_vector_type(4)));
typedef float f32x2 __attribute__((ext_vector_type(2)));
typedef unsigned u32x4 __attribute__((ext_vector_type(4)));
typedef unsigned u32x2 __attribute__((ext_vector_type(2)));

constexpr int T_ALL = 34816, T_P = 32768, DM = 1024, NPROJ = 3072, DFF = 2816, DFF2 = 5632, DEPTH = 4;
constexpr int NU64 = 544;
constexpr float ALPHA = 1.6817928305074290f;
constexpr float LN_EPS = 1e-5f, RMS_EPS = 1e-5f;
constexpr int C_K = 384, C_V = 768, C_Z = 1152, C_XBC = 1536, C_U = 2432, C_VC = 2688, C_DT = 2944;
constexpr size_t O_YP = 0, O_YS = 33554432, O_PK = 35651584, O_PV = O_PK + 3145728, O_PH = O_PV + 3145728, O_PC = O_PH + 786432,
                 O_PF = O_PC + 43008, O_SK = O_PF + 180224, O_SV = O_SK + 3145728, O_SH = O_SV + 3145728, O_SC = O_SH + 6291456,
                 O_SG = O_SC + 344064, O_SF = O_SG + 2097152;
constexpr size_t W_IN = 0, W_IN_L = (size_t)NPROJ * DM * 2;
constexpr size_t W_OUT = W_IN + 4 * W_IN_L, W_OUT_L = (size_t)DM * DM * 2;
constexpr size_t W_UP = W_OUT + 4 * W_OUT_L, W_UP_L = (size_t)DFF2 * DM * 2;
constexpr size_t W_DN = W_UP + 4 * W_UP_L, W_DN_L = (size_t)DM * DFF * 2;
constexpr size_t W_GW = W_DN + 4 * W_DN_L, W_GW_L = (size_t)4 * 128 * 128 * 2;
constexpr size_t W_XB = W_GW + 4 * W_GW_L;
constexpr size_t W_PROJ = W_XB + (size_t)T_ALL * DM * 2;
constexpr size_t W_MIX = W_PROJ + (size_t)T_ALL * NPROJ * 2;
constexpr size_t W_ST = W_MIX + (size_t)T_ALL * DM * 2;
constexpr size_t W_CD = W_ST + (size_t)NU64 * 6 * 8192 * 2;
constexpr size_t W_DTB = W_CD + (size_t)NU64 * 8 * 4;
constexpr size_t W_END = W_DTB + (size_t)T_ALL * 8 * 4;
constexpr size_t W_BAR = W_END;
constexpr size_t W_END2 = W_BAR + 16384;
constexpr int LDS_BYTES = 136 * 1024;

struct Params { const float* in[28]; float* out; unsigned char* ws; int ph_lo, ph_hi, coop, pad; };
typedef const __attribute__((address_space(4))) Params KP;

__device__ __forceinline__ float bf2f(unsigned b) { return __uint_as_float(b << 16); }
typedef __bf16 bf16v2 __attribute__((ext_vector_type(2)));
__device__ __forceinline__ unsigned cvt_pk_bf16(float lo, float hi) { const f32x2 v = {lo, hi}; const bf16v2 b = __builtin_convertvector(v, bf16v2); return __builtin_bit_cast(unsigned, b); }
__device__ __forceinline__ u32x2 pack4(f32x4 v) { u32x2 w; w.x = cvt_pk_bf16(v[0], v[1]); w.y = cvt_pk_bf16(v[2], v[3]); return w; }
__device__ __forceinline__ f32x4 unpack4(u32x2 w) { f32x4 v; v[0] = bf2f(w.x & 0xffffu); v[1] = bf2f(w.x >> 16); v[2] = bf2f(w.y & 0xffffu); v[3] = bf2f(w.y >> 16); return v; }
__device__ __forceinline__ float silu_f(float x) { return x / (1.0f + __expf(-x)); }
__device__ __forceinline__ float gelu_tanh(float x) { const float y = 0.7978845608028654f * (x + 0.044715f * x * x * x); const float e = __expf(2.0f * y); return 0.5f * x * (2.0f - 2.0f / (1.0f + e)); }
__device__ __forceinline__ float softplus_f(float x) { const float e = __expf(x); return x > 15.0f ? x : (e < 1e-3f ? e * (1.0f - 0.5f * e + 0.33333333f * e * e) : __logf(1.0f + e)); }
#define MFMA16(colfrag, rowfrag, acc) __builtin_amdgcn_mfma_f32_16x16x32_bf16((colfrag), (rowfrag), (acc), 0, 0, 0)
__device__ __forceinline__ bf16x8 ldsfrag(LAS const unsigned char* p) { return *(LAS const bf16x8*)p; }
__device__ __forceinline__ bf16x8 glbfrag(const bf16_t* p) { return *(const bf16x8*)p; }
#define LDS_WAVE_SYNC() asm volatile("s_waitcnt lgkmcnt(0)" ::: "memory")

namespace pg8 {
constexpr int BM = 256, BK = 64, HALF = 128, HTB = HALF * BK * 2, STAGE_BYTES = 8 * HTB, NXCD = 8, WGM = 8;
__device__ __forceinline__ int lds_byte(int r, int c) { const int st = (r >> 4) * 2 + (c >> 5), rr = r & 15, cc = c & 31, ob = rr * 64 + cc * 2; return st * 1024 + (ob ^ (((ob >> 9) & 1) << 5)); }
__device__ __forceinline__ void stage_rc(int b, int& R, int& C) { const int st = b / 1024, sb = b % 1024, swz = sb ^ (((sb >> 9) & 1) << 5); R = (st >> 1) * 16 + swz / 64; C = (st & 1) * 32 + (swz % 64) / 2; }
__device__ __forceinline__ int perm32(int rho) { const int n = rho >> 4, i = rho & 15; return 8 * (i >> 2) + 4 * n + (i & 3); }
struct Unit { int pm, pn; };
struct Gemm { const bf16_t* A; const bf16_t* Bt; int M, N, K; };
struct StaticOrder {
    int nM, nN, nwg, G, c;
    __device__ __forceinline__ void init(int M, int N, int G_, int c_) { nM = M / BM; nN = N / BM; nwg = nM * nN; G = G_; c = c_; }
    __device__ __forceinline__ bool next(int i, Unit& u) const {
        const long L = (long)i * G + c; if (L >= nwg) return false;
        int wgid = (int)L; { const int q = nwg / NXCD, r = nwg % NXCD, xcd = wgid % NXCD, off = wgid / NXCD; wgid = (xcd < r ? xcd * (q + 1) : r * (q + 1) + (xcd - r) * q) + off; }
        const int nig = WGM * nN, gid = wgid / nig, fm = gid * WGM, gsz = (nM - fm) < WGM ? (nM - fm) : WGM;
        u.pm = fm + ((wgid % nig) % gsz); u.pn = (wgid % nig) / gsz; return true;
    }
    __device__ __forceinline__ void a_ready(const Unit&) const {}
    __device__ __forceinline__ void done(const Unit&) const {}
};
struct OneUnit {
    Unit u;
    __device__ __forceinline__ bool next(int i, Unit& o) const { if (i) return false; o = u; return true; }
    __device__ __forceinline__ void a_ready(const Unit&) const {}
    __device__ __forceinline__ void done(const Unit&) const {}
};

template <class Epi, class Sched>
__device__ __forceinline__ void gemm_phase(LAS unsigned char* lds, const Gemm g, const Sched& S, const Epi& E) {
    int tid_ = threadIdx.x; asm volatile("" : "+v"(tid_));
    const int tid = tid_, wid = __builtin_amdgcn_readfirstlane(tid >> 6), lane = tid & 63, wr = wid >> 2, wc = wid & 3, fr = lane & 15, fq = lane >> 4;
    const int K = g.K, nt = K / BK;
    unsigned voffA[2], voffB[2];
#pragma unroll
    for (int i = 0; i < 2; ++i) { int R, C; stage_rc(tid * 16 + i * 8192, R, C); const int Rb = (R & ~31) + perm32(R & 31); voffA[i] = (unsigned)(R * K + C) * 2u; voffB[i] = (unsigned)(Rb * K + C) * 2u; }
    const size_t kstep = (size_t)(BK * 2);
    const size_t hstep = (size_t)HALF * K * 2;
    const size_t tstep = 2 * hstep;
    const unsigned ldsw = (unsigned)wid * 1024u;
    const int aoff = lds_byte(wr * 64 + fr, fq * 8), boff = lds_byte(wc * 32 + fr, fq * 8);
#define PG8_SA(b, h) (((b) * 2 + (h)) * HTB)
#define PG8_SB(b, h) ((4 + (b) * 2 + (h)) * HTB)
#define PG8_STAGE(bufoff, gbase, voff) do { _Pragma("unroll") for (int _i = 0; _i < 2; ++_i) \
        __builtin_amdgcn_global_load_lds((const unsigned*)((const char*)(gbase) + (voff)[_i]), (LAS unsigned*)(lds + (bufoff) + ldsw + _i * 8192), 16, 0, 0); } while (0)
#define PG8_LDA(dst, b, h) do { _Pragma("unroll") for (int m = 0; m < 4; ++m) _Pragma("unroll") for (int k = 0; k < 2; ++k) dst[m][k] = *(const LAS bf16x8*)(lds + PG8_SA(b, h) + aoff + m * 2048 + k * 1024); } while (0)
#define PG8_LDB(dst, b, h) do { _Pragma("unroll") for (int n = 0; n < 2; ++n) _Pragma("unroll") for (int k = 0; k < 2; ++k) dst[n][k] = *(const LAS bf16x8*)(lds + PG8_SB(b, h) + boff + n * 2048 + k * 1024); } while (0)
#define PG8_MMA(ai, bj, At, Bt) do { __builtin_amdgcn_s_setprio(1); _Pragma("unroll") for (int m = 0; m < 4; ++m) _Pragma("unroll") for (int n = 0; n < 2; ++n) _Pragma("unroll") for (int k = 0; k < 2; ++k) \
        acc[ai][bj][m][n] = __builtin_amdgcn_mfma_f32_16x16x32_bf16(Bt[n][k], At[m][k], acc[ai][bj][m][n], 0, 0, 0); __builtin_amdgcn_s_setprio(0); } while (0)
#define PG8_WAIT_V(n) asm volatile("s_waitcnt vmcnt(" #n ")" ::: "memory")
#define PG8_WAIT_L(n) asm volatile("s_waitcnt lgkmcnt(" #n ")" ::: "memory")
#define PG8_BAR __builtin_amdgcn_s_barrier()
#define PG8_SCHED __builtin_amdgcn_sched_barrier(0)
    Unit cur, nxt; int ui = 0;
    if (!S.next(0, cur)) return;
    f32x4 acc[2][2][4][2];
#pragma unroll
    for (int a = 0; a < 2; ++a)
#pragma unroll
        for (int b = 0; b < 2; ++b)
#pragma unroll
            for (int m = 0; m < 4; ++m)
#pragma unroll
                for (int n = 0; n < 2; ++n) acc[a][b][m][n] = (f32x4){0.f, 0.f, 0.f, 0.f};
    bf16x8 At[4][2], B0[2][2], B1[2][2];
    const char* cA = (const char*)g.A + (size_t)cur.pm * tstep; const char* cB = (const char*)g.Bt + (size_t)cur.pn * tstep;
    S.a_ready(cur);
    PG8_STAGE(PG8_SB(0, 0), cB, voffB); PG8_STAGE(PG8_SA(0, 0), cA, voffA); PG8_STAGE(PG8_SB(0, 1), cB + hstep, voffB); PG8_STAGE(PG8_SA(0, 1), cA + hstep, voffA);
    if (wr == 1) PG8_BAR;
    PG8_WAIT_V(4); PG8_BAR;
    PG8_STAGE(PG8_SB(1, 0), cB + kstep, voffB); PG8_STAGE(PG8_SA(1, 0), cA + kstep, voffA); PG8_STAGE(PG8_SB(1, 1), cB + hstep + kstep, voffB);
    PG8_WAIT_V(6); PG8_BAR;
    for (;;) {
        const bool has_next = S.next(ui + 1, nxt);
        const char* nA = has_next ? (const char*)g.A + (size_t)nxt.pm * tstep : cA; const char* nB = has_next ? (const char*)g.Bt + (size_t)nxt.pn * tstep : cB;
        for (int t = 0; t < nt; t += 2) {
            const bool last = (t == nt - 2);
            const char* a1 = cA + (size_t)(t + 1) * kstep;
            const char* a2 = last ? nA : cA + (size_t)(t + 2) * kstep; const char* b2 = last ? nB : cB + (size_t)(t + 2) * kstep;
            const char* a3 = a2 + kstep; const char* b3 = b2 + kstep;
            if (last && has_next) S.a_ready(nxt);
            PG8_LDB(B0, 0, 0); PG8_SCHED; PG8_LDA(At, 0, 0); PG8_STAGE(PG8_SA(1, 1), a1 + hstep, voffA);
            PG8_WAIT_L(8); PG8_BAR; PG8_WAIT_L(0); PG8_MMA(0, 0, At, B0); PG8_BAR; PG8_SCHED;
            PG8_LDB(B1, 0, 1); PG8_STAGE(PG8_SB(0, 0), b2, voffB);
            PG8_BAR; PG8_WAIT_L(0); PG8_MMA(0, 1, At, B1); PG8_BAR;
            PG8_LDA(At, 0, 1); PG8_STAGE(PG8_SA(0, 0), a2, voffA);
            PG8_BAR; PG8_WAIT_L(0); PG8_MMA(1, 0, At, B0); PG8_BAR; PG8_SCHED;
            PG8_STAGE(PG8_SB(0, 1), b2 + hstep, voffB);
            PG8_WAIT_V(6); PG8_BAR; PG8_MMA(1, 1, At, B1); PG8_BAR;
            PG8_LDB(B0, 1, 0); PG8_SCHED; PG8_LDA(At, 1, 0); PG8_STAGE(PG8_SA(0, 1), a2 + hstep, voffA);
            PG8_WAIT_L(8); PG8_BAR; PG8_WAIT_L(0); PG8_MMA(0, 0, At, B0); PG8_BAR; PG8_SCHED;
            PG8_LDB(B1, 1, 1); PG8_STAGE(PG8_SB(1, 0), b3, voffB);
            PG8_BAR; PG8_WAIT_L(0); PG8_MMA(0, 1, At, B1); PG8_BAR;
            PG8_LDA(At, 1, 1); PG8_STAGE(PG8_SA(1, 0), a3, voffA);
            PG8_BAR; PG8_WAIT_L(0); PG8_MMA(1, 0, At, B0); PG8_BAR; PG8_SCHED;
            PG8_STAGE(PG8_SB(1, 1), b3 + hstep, voffB);
            PG8_WAIT_V(6); PG8_BAR; PG8_MMA(1, 1, At, B1); PG8_BAR;
        }
        if constexpr (!Epi::AFTER_DRAIN) { E(acc, cur, wr, wc, fr, fq); S.done(cur); }
        if (!has_next) break;
#pragma unroll
        for (int a = 0; a < 2; ++a)
#pragma unroll
            for (int b = 0; b < 2; ++b)
#pragma unroll
                for (int m = 0; m < 4; ++m)
#pragma unroll
                    for (int n = 0; n < 2; ++n) acc[a][b][m][n] = (f32x4){0.f, 0.f, 0.f, 0.f};
        cur = nxt; cA = nA; cB = nB; ++ui;
    }
    PG8_WAIT_V(0);
    if (wr == 0) PG8_BAR;
    PG8_BAR;
    if constexpr (Epi::AFTER_DRAIN) { E.fused(acc, cur, wr, wc, fr, fq, lds, wid, lane); S.done(cur); }
#undef PG8_SA
#undef PG8_SB
#undef PG8_STAGE
#undef PG8_LDA
#undef PG8_LDB
#undef PG8_MMA
#undef PG8_WAIT_V
#undef PG8_WAIT_L
#undef PG8_BAR
#undef PG8_SCHED
}
}
using pg8::Unit;

struct EpiIn {
    static constexpr bool AFTER_DRAIN = false;
    bf16_t* proj; float* out; float* dtb; const float* dt_bias; int l;
    __device__ __forceinline__ void operator()(const f32x4 (&acc)[2][2][4][2], const Unit& u, int wr, int wc, int fr_, int fq_) const {
        int fr = fr_, fq = fq_; asm volatile("" : "+v"(fr), "+v"(fq));
#pragma unroll
        for (int bj = 0; bj < 2; ++bj) {
            const int cb = u.pn * 256 + bj * 128;
            const int col = cb + wc * 32 + fq * 8;
            if (cb > C_DT) continue;
#pragma unroll
            for (int ai = 0; ai < 2; ++ai)
#pragma unroll
                for (int m = 0; m < 4; ++m) {
                    const int row = u.pm * 256 + ai * 128 + wr * 64 + m * 16 + fr;
                    const bool isP = row < T_P; int b, t;
                    if (isP) { b = row >> 13; t = row & 8191; } else { b = (row - T_P) >> 6; t = row & 63; }
                    f32x4 v0 = acc[ai][bj][m][0], v1 = acc[ai][bj][m][1];
                    if (cb < C_U) {
                        u32x4 w; { const u32x2 a = pack4(v0), c = pack4(v1); w.x = a.x; w.y = a.y; w.z = c.x; w.w = c.y; }
                        *(u32x4*)(proj + (size_t)row * NPROJ + col) = w;
                        if (cb >= C_K && cb < C_Z) {
                            const int isv = cb >= C_V; const int cc = col - (isv ? C_V : C_K);
                            float* o = nullptr;
                            if (isP) { if (t >= 7680) o = out + (isv ? O_PV : O_PK) + ((size_t)(l * 4 + b) * 512 + (t - 7680)) * 384 + cc; }
                            else o = out + (isv ? O_SV : O_SK) + ((size_t)(l * 32 + b) * 64 + t) * 384 + cc;
                            if (o) { *(f32x4*)o = v0; *(f32x4*)(o + 4) = v1; }
                        } else if (cb >= C_XBC) {
                            const int cc = col - C_XBC; float* o = nullptr;
                            if (isP) { if (t >= 8189) o = out + O_PC + ((size_t)(l * 4 + b) * 3 + (t - 8189)) * 896 + cc; }
                            else if (t >= 61) o = out + O_SC + ((size_t)(l * 32 + b) * 3 + (t - 61)) * 896 + cc;
                            if (o) { *(f32x4*)o = v0; *(f32x4*)(o + 4) = v1; }
                        }
                    } else if (cb < C_DT) {
#pragma unroll
                        for (int j = 0; j < 4; ++j) { v0[j] = gelu_tanh(v0[j]); v1[j] = gelu_tanh(v1[j]); }
                        u32x4 w; { const u32x2 a = pack4(v0), c = pack4(v1); w.x = a.x; w.y = a.y; w.z = c.x; w.w = c.y; }
                        *(u32x4*)(proj + (size_t)row * NPROJ + col) = w;
                        if (cb >= C_VC && !isP) { float* o = out + O_SG + ((size_t)(l * 32 + b) * 64 + t) * 256 + (col - C_VC); *(f32x4*)o = v0; *(f32x4*)(o + 4) = v1; }
                    } else if (col == C_DT) {
                        float* d = dtb + (size_t)row * 8;
#pragma unroll
                        for (int j = 0; j < 4; ++j) d[j] = softplus_f(v0[j] + dt_bias[l * 6 + j]);
#pragma unroll
                        for (int j = 0; j < 2; ++j) d[4 + j] = softplus_f(v1[j] + dt_bias[l * 6 + 4 + j]);
                    }
                    asm volatile("" ::: "memory");
                }
        }
    }
};
struct EpiNull {
    static constexpr bool AFTER_DRAIN = false;
    float* sink;
    __device__ __forceinline__ void operator()(const f32x4 (&acc)[2][2][4][2], const Unit& u, int wr, int wc, int fr, int fq) const {
        float t = 0.f;
#pragma unroll
        for (int ai = 0; ai < 2; ++ai)
#pragma unroll
            for (int bj = 0; bj < 2; ++bj)
#pragma unroll
                for (int m = 0; m < 4; ++m)
#pragma unroll
                    for (int n = 0; n < 2; ++n) t += acc[ai][bj][m][n][0] + acc[ai][bj][m][n][1] + acc[ai][bj][m][n][2] + acc[ai][bj][m][n][3];
        if (t == 123456.789f) sink[0] = t;
    }
};
struct EpiRes {
    static constexpr bool AFTER_DRAIN = false;
    float* x;
    __device__ __forceinline__ void operator()(const f32x4 (&acc)[2][2][4][2], const Unit& u, int wr, int wc, int fr_, int fq_) const {
        int fr = fr_, fq = fq_; asm volatile("" : "+v"(fr), "+v"(fq));
#pragma unroll
        for (int ai = 0; ai < 2; ++ai)
#pragma unroll
            for (int m = 0; m < 4; ++m) {
                float* rowp = x + (size_t)(u.pm * 256 + ai * 128 + wr * 64 + m * 16 + fr) * DM + u.pn * 256 + wc * 32 + fq * 8;
#pragma unroll
                for (int bj = 0; bj < 2; ++bj) { float* q = rowp + bj * 128; const f32x4 o0 = *(const f32x4*)q, o1 = *(const f32x4*)(q + 4);
                    *(f32x4*)q = o0 * ALPHA + acc[ai][bj][m][0]; *(f32x4*)(q + 4) = o1 * ALPHA + acc[ai][bj][m][1]; }
                asm volatile("" ::: "memory");
            }
    }
};
struct EpiUp {
    static constexpr bool AFTER_DRAIN = true;
    bf16_t* H; float* halo; float* out; const float* cw; const float* cb; const float* fstate; int l;
    __device__ __forceinline__ void operator()(const f32x4 (&)[2][2][4][2], const Unit&, int, int, int, int) const {}
    __device__ __forceinline__ void fused(f32x4 (&acc)[2][2][4][2], const Unit& u, int wr, int wc, int fr, int fq, LAS unsigned char* lds, int wid, int lane) const {
        constexpr int LS = 264;
#pragma unroll
        for (int ai = 0; ai < 2; ++ai)
#pragma unroll
            for (int m = 0; m < 4; ++m)
#pragma unroll
                for (int bj = 0; bj < 2; ++bj) {
                        const int rl = ai * 128 + wr * 64 + m * 16 + fr, cl = bj * 128 + wc * 32 + fq * 8;
                        u32x4 w; { const u32x2 a = pack4(acc[ai][bj][m][0]), c = pack4(acc[ai][bj][m][1]); w.x = a.x; w.y = a.y; w.z = c.x; w.w = c.y; }
                        *(LAS u32x4*)(lds + (rl * LS + cl) * 2) = w;
                    }
        __syncthreads();
        const int tid = wid * 64 + lane, j = tid & 127, seg = tid >> 7;
        const int hcol = u.pn * 128 + j;
        const float* w = cw + (size_t)l * 3 * DFF2; const float* bb = cb + (size_t)l * DFF2;
        const float wg0 = w[hcol], wg1 = w[DFF2 + hcol], wg2 = w[2 * DFF2 + hcol], bg = bb[hcol];
        const float wv0 = w[DFF + hcol], wv1 = w[DFF2 + DFF + hcol], wv2 = w[2 * DFF2 + DFF + hcol], bv = bb[DFF + hcol];
        const int R = u.pm * 256 + seg * 64;
        const bool isP = R < T_P;
        float g2 = 0.f, g1 = 0.f, v2 = 0.f, v1 = 0.f; int skip = 0;
        const LAS bf16_t* U = (const LAS bf16_t*)lds;
        if (isP) {
            if (seg > 0) { g2 = bf2f(U[(seg * 64 - 2) * LS + j]); g1 = bf2f(U[(seg * 64 - 1) * LS + j]); v2 = bf2f(U[(seg * 64 - 2) * LS + 128 + j]); v1 = bf2f(U[(seg * 64 - 1) * LS + 128 + j]); }
            else if ((R & 8191) != 0) skip = 2;
        } else {
            const int sb = (R - T_P) >> 6; const float* fs = fstate + (size_t)(l * 32 + sb) * 2 * DFF2;
            g2 = fs[hcol]; g1 = fs[DFF2 + hcol]; v2 = fs[DFF + hcol]; v1 = fs[DFF2 + DFF + hcol];
        }
        bf16_t* hp = H + (size_t)R * DFF + hcol;
#pragma unroll 8
        for (int i = 0; i < 64; ++i) {
            const float gq = bf2f(U[(seg * 64 + i) * LS + j]), vq = bf2f(U[(seg * 64 + i) * LS + 128 + j]);
            if (i >= skip) {
                const float cgv = bg + wg0 * g2 + wg1 * g1 + wg2 * gq, cvv = bv + wv0 * v2 + wv1 * v1 + wv2 * vq;
                const float hv = silu_f(cgv) * cvv;
                hp[(size_t)i * DFF] = (bf16_t)(cvt_pk_bf16(hv, 0.f) & 0xffffu);
            }
            g2 = g1; g1 = gq; v2 = v1; v1 = vq;
            if (isP) {
                if (seg == 0 && i < 2) { float* hl = halo + ((size_t)u.pm * 4 + i) * DFF2; hl[hcol] = gq; hl[DFF + hcol] = vq; }
                if (seg == 3 && i >= 62) { float* hl = halo + ((size_t)u.pm * 4 + 2 + (i - 62)) * DFF2; hl[hcol] = gq; hl[DFF + hcol] = vq;
                    if ((u.pm & 31) == 31) { float* o = out + O_PF + ((size_t)(l * 4 + (u.pm >> 5)) * 2 + (i - 62)) * DFF2; o[hcol] = gq; o[DFF + hcol] = vq; } }
            } else if (i >= 62) {
                const int sb = (R - T_P) >> 6; float* o = out + O_SF + ((size_t)(l * 32 + sb) * 2 + (i - 62)) * DFF2; o[hcol] = gq; o[DFF + hcol] = vq;
            }
        }
    }
};

__device__ __forceinline__ void ln_row(const float* src, float* x32, bf16_t* xb, const float* g, const float* b, int lane) {
    f32x4 v[4]; float s = 0.f;
#pragma unroll
    for (int i = 0; i < 4; ++i) { v[i] = *(const f32x4*)(src + i * 256 + lane * 4); s += (v[i][0] + v[i][1]) + (v[i][2] + v[i][3]); }
#pragma unroll
    for (int o = 32; o >= 1; o >>= 1) s += __shfl_xor(s, o);
    const float mu = s * (1.0f / 1024.0f); float q = 0.f;
#pragma unroll
    for (int i = 0; i < 4; ++i) { const f32x4 d = v[i] - mu; q += (d[0] * d[0] + d[1] * d[1]) + (d[2] * d[2] + d[3] * d[3]); }
#pragma unroll
    for (int o = 32; o >= 1; o >>= 1) q += __shfl_xor(q, o);
    const float rstd = 1.0f / sqrtf(q * (1.0f / 1024.0f) + LN_EPS);
#pragma unroll
    for (int i = 0; i < 4; ++i) {
        const f32x4 gg = *(const f32x4*)(g + i * 256 + lane * 4), bb = *(const f32x4*)(b + i * 256 + lane * 4);
        const f32x4 o = (v[i] - mu) * rstd * gg + bb;
        *(f32x4*)(x32 + i * 256 + lane * 4) = o; *(u32x2*)(xb + i * 256 + lane * 4) = pack4(o);
    }
}

__device__ __forceinline__ void tr_tile(LAS float* tile, const float* src, int Nsrc, bf16_t* dst, int K, int n0, int k0, int mode, int tid) {
    const int nn = tid & 63, np = n0 + nn; int sc;
    if (mode == 0) sc = np < C_U ? np : (np < C_DT ? np + 6 : (np < C_DT + 6 ? np - 512 : -1));
    else if (mode == 1) sc = np;
    else { const int pn = np >> 8, jj = np & 255; sc = jj < 128 ? pn * 128 + jj : DFF + pn * 128 + (jj - 128); }
#pragma unroll
    for (int i = 0; i < 8; ++i) { const int kk = (tid >> 6) + 8 * i; tile[kk * 65 + nn] = sc >= 0 ? src[(size_t)(k0 + kk) * Nsrc + sc] : 0.f; }
    __syncthreads();
    const int kk2 = (tid & 31) * 2;
#pragma unroll
    for (int i = 0; i < 4; ++i) { const int nn2 = (tid >> 5) + 16 * i; *(unsigned*)(dst + (size_t)(n0 + nn2) * K + k0 + kk2) = cvt_pk_bf16(tile[kk2 * 65 + nn2], tile[(kk2 + 1) * 65 + nn2]); }
    __syncthreads();
}

__device__ __forceinline__ void phase_prep(KP& p, LAS unsigned char* lds) {
    int tid_ = threadIdx.x; asm volatile("" : "+v"(tid_));
    const int tid = tid_, wid = tid >> 6, lane = tid & 63;
    for (int row = blockIdx.x * 8 + wid; row < T_ALL; row += gridDim.x * 8) {
        const float* src = row < T_P ? p.in[0] + (size_t)row * DM : p.in[1] + (size_t)(row - T_P) * DM;
        ln_row(src, p.out + (size_t)row * DM, (bf16_t*)(p.ws + W_XB) + (size_t)row * DM, p.in[7], p.in[8], lane);
    }
    constexpr int T_IN = 48 * 16, T_OUT = 16 * 16, T_UPT = 88 * 16, T_DNT = 16 * 44, T_L = T_IN + T_OUT + T_UPT + T_DNT;
    for (int it = blockIdx.x; it < 4 * T_L; it += gridDim.x) {
        const int l = it / T_L; int r = it % T_L;
        if (r < T_IN) tr_tile((LAS float*)lds, p.in[9] + (size_t)l * DM * 2950, 2950, (bf16_t*)(p.ws + W_IN + l * W_IN_L), DM, (r >> 4) * 64, (r & 15) * 64, 0, tid);
        else if ((r -= T_IN) < T_OUT) tr_tile((LAS float*)lds, p.in[19] + (size_t)l * DM * DM, DM, (bf16_t*)(p.ws + W_OUT + l * W_OUT_L), DM, (r >> 4) * 64, (r & 15) * 64, 1, tid);
        else if ((r -= T_OUT) < T_UPT) tr_tile((LAS float*)lds, p.in[22] + (size_t)l * DM * DFF2, DFF2, (bf16_t*)(p.ws + W_UP + l * W_UP_L), DM, (r >> 4) * 64, (r & 15) * 64, 2, tid);
        else { r -= T_UPT; tr_tile((LAS float*)lds, p.in[25] + (size_t)l * DFF * DM, DM, (bf16_t*)(p.ws + W_DN + l * W_DN_L), DFF, (r / 44) * 64, (r % 44) * 64, 1, tid); }
    }
    for (int i = blockIdx.x * 512 + tid; i < 4 * 4 * 128 * 128; i += gridDim.x * 512) {
        const int jj = i & 127, ii = (i >> 7) & 127;
        ((bf16_t*)(p.ws + W_GW))[i] = (bf16_t)(cvt_pk_bf16(jj <= ii ? p.in[16][i] : 0.f, 0.f) & 0xffffu);
    }
}

__device__ __forceinline__ void phase_ln(KP& p, const float* g, const float* b) {
    int tid_ = threadIdx.x; asm volatile("" : "+v"(tid_));
    const int wid = tid_ >> 6, lane = tid_ & 63;
    for (int row = blockIdx.x * 8 + wid; row < T_ALL; row += gridDim.x * 8)
        ln_row(p.out + (size_t)row * DM, p.out + (size_t)row * DM, (bf16_t*)(p.ws + W_XB) + (size_t)row * DM, g, b, lane);
}

__device__ __forceinline__ void dt_scan(KP& p, int l, int u, int g, int wid, int lane, float& dt, float& ac, float& last) {
    const int h = g * 3 + wid;
    dt = ((const float*)(p.ws + W_DTB))[(size_t)(u * 64 + lane) * 8 + h];
    const float a = -__expf(p.in[14][l * 6 + h]);
    float v = dt * a;
#pragma unroll
    for (int o = 1; o < 64; o <<= 1) { const float t = __shfl_up(v, o); if (lane >= o) v += t; }
    ac = v; last = __shfl(v, 63);
}

__device__ __forceinline__ f32x4 xbc_row(KP& p, int l, int u, int s, int ch) {
    const bf16_t* proj = (const bf16_t*)(p.ws + W_PROJ);
    const bool isP = u < 512; const bool hasprev = isP && (u & 127) != 0;
    if (s >= 0 || hasprev) return unpack4(*(const u32x2*)(proj + (size_t)(u * 64 + s) * NPROJ + C_XBC + ch));
    if (!isP) return *(const f32x4*)(p.in[5] + (unsigned)(((l * 32 + (u - 512)) * 3 + (3 + s)) * 896 + ch));
    return (f32x4){0.f, 0.f, 0.f, 0.f};
}
__device__ __forceinline__ void ssd_states(KP& p, LAS unsigned char* lds, int l, int u) {
    int tid_ = threadIdx.x; asm volatile("" : "+v"(tid_));
    const int tid = tid_, wid = tid >> 6, lane = tid & 63, fr = lane & 15, fq = lane >> 4;
    LAS bf16_t* xT = (LAS bf16_t*)lds;
    LAS bf16_t* BT = (LAS bf16_t*)(lds + 55296);
    LAS float* wgt = (LAS float*)(lds + 92160);
    bf16_t* XC = (bf16_t*)(p.ws + W_XB);
    __syncthreads();
    if (wid < 6) {
        float dt, ac, last; dt_scan(p, l, u, wid / 3, wid % 3, lane, dt, ac, last);
        wgt[wid * 64 + lane] = dt * __expf(last - ac);
        if (lane == 0) ((float*)(p.ws + W_CD))[u * 8 + wid] = __expf(last);
    }
    __syncthreads();
    if (tid < 448) {
        const int cgp = tid % 224, seg = tid / 224, ch = cgp * 4, r0 = seg * 32;
        const float* cw = p.in[11] + (size_t)l * 4 * 896 + ch;
        const f32x4 w0 = *(const f32x4*)cw, w1 = *(const f32x4*)(cw + 896), w2 = *(const f32x4*)(cw + 2 * 896), w3 = *(const f32x4*)(cw + 3 * 896);
        const f32x4 bs = *(const f32x4*)(p.in[12] + (size_t)l * 896 + ch);
        f32x4 xm3 = xbc_row(p, l, u, r0 - 3, ch), xm2 = xbc_row(p, l, u, r0 - 2, ch), xm1 = xbc_row(p, l, u, r0 - 1, ch);
        const bf16_t* src = (const bf16_t*)(p.ws + W_PROJ) + (size_t)(u * 64) * NPROJ + C_XBC + ch;
        bf16_t* dst = XC + (size_t)(u * 64) * 896 + ch;
        const int hh = ch >> 6;
#pragma unroll 2
        for (int i = r0; i < r0 + 32; i += 2) {
            const f32x4 xa = unpack4(*(const u32x2*)(src + (size_t)i * NPROJ)), xb = unpack4(*(const u32x2*)(src + (size_t)(i + 1) * NPROJ));
            f32x4 ya = bs + w0 * xm3 + w1 * xm2 + w2 * xm1 + w3 * xa, yb = bs + w0 * xm2 + w1 * xm1 + w2 * xa + w3 * xb;
#pragma unroll
            for (int e = 0; e < 4; ++e) { ya[e] = silu_f(ya[e]); yb[e] = silu_f(yb[e]); }
            xm3 = xm1; xm2 = xa; xm1 = xb;
            *(u32x2*)(dst + (size_t)i * 896) = pack4(ya); *(u32x2*)(dst + (size_t)(i + 1) * 896) = pack4(yb);
            if (ch < 384) { const float wa = wgt[hh * 64 + i], wb = wgt[hh * 64 + i + 1];
#pragma unroll
                for (int e = 0; e < 4; ++e) *(LAS unsigned*)(xT + (ch + e) * 72 + i) = cvt_pk_bf16(ya[e] * wa, yb[e] * wb); }
            else if (ch < 640) {
#pragma unroll
                for (int e = 0; e < 4; ++e) *(LAS unsigned*)(BT + (ch - 384 + e) * 72 + i) = cvt_pk_bf16(ya[e], yb[e]); }
        }
    }
    __syncthreads();
    bf16_t* ST = (bf16_t*)(p.ws + W_ST);
#pragma unroll 2
    for (int k = 0; k < 24; ++k) {
        const int tt = wid * 24 + k, h = tt >> 5, pt = (tt & 31) >> 3, nt = tt & 7, g = h / 3;
        f32x4 acc = (f32x4){0.f, 0.f, 0.f, 0.f};
#pragma unroll
        for (int ks = 0; ks < 2; ++ks) {
            const bf16x8 rf = ldsfrag((LAS const unsigned char*)(xT + (h * 64 + pt * 16 + fr) * 72 + ks * 32 + fq * 8));
            const bf16x8 cf = ldsfrag((LAS const unsigned char*)(BT + (g * 128 + nt * 16 + fr) * 72 + ks * 32 + fq * 8));
            acc = MFMA16(cf, rf, acc);
        }
        *(u32x2*)(ST + ((size_t)(u * 6 + h) * 64 + pt * 16 + fr) * 128 + nt * 16 + fq * 4) = pack4(acc);
    }
}

__device__ __forceinline__ void gmlp_unit(KP& p, LAS unsigned char* lds, int l, int u) {
    int tid_ = threadIdx.x; asm volatile("" : "+v"(tid_));
    const int tid = tid_, wid = tid >> 6, lane = tid & 63, fr = lane & 15, fq = lane >> 4;
    LAS bf16_t* vT = (LAS bf16_t*)lds;
    LAS float* ssq = (LAS float*)(lds + 69632);
    const bf16_t* proj = (const bf16_t*)(p.ws + W_PROJ);
    const int half = u < 512 ? (u & 1) : 0, KJ = (half + 1) * 64, R0 = u * 64, Rb = R0 - half * 64;
    __syncthreads();
    for (int idx = tid; idx < KJ * 32; idx += 512) {
        const int j = idx & (KJ - 1), cgp = idx / KJ;
        const u32x4 w = *(const u32x4*)(proj + (size_t)(Rb + j) * NPROJ + C_VC + cgp * 8);
        const unsigned ww[4] = {w.x, w.y, w.z, w.w};
#pragma unroll
        for (int e = 0; e < 4; ++e) { vT[(cgp * 8 + 2 * e) * 136 + j] = (bf16_t)(ww[e] & 0xffffu); vT[(cgp * 8 + 2 * e + 1) * 136 + j] = (bf16_t)(ww[e] >> 16); }
    }
    __syncthreads();
    const int rt = wid & 3, cbase = (wid >> 2) * 8;
    const bf16_t* GW = (const bf16_t*)(p.ws + W_GW + l * W_GW_L);
    f32x4 acc[8];
#pragma unroll
    for (int gi = 0; gi < 2; ++gi) {
        const int gg = (cbase >> 2) + gi;
        bf16x8 rf[4];
#pragma unroll
        for (int ks = 0; ks < 4; ++ks) rf[ks] = glbfrag(GW + ((size_t)gg * 128 + half * 64 + rt * 16 + fr) * 128 + ks * 32 + fq * 8);
#pragma unroll
        for (int c4 = 0; c4 < 4; ++c4) {
            const int ct = cbase + gi * 4 + c4;
            f32x4 a = (f32x4){0.f, 0.f, 0.f, 0.f};
#pragma unroll
            for (int ks = 0; ks < 4; ++ks) if (ks * 32 < KJ) a = MFMA16(ldsfrag((LAS const unsigned char*)(vT + (ct * 16 + fr) * 136 + ks * 32 + fq * 8)), rf[ks], a);
            acc[gi * 4 + c4] = a;
        }
    }
    const int row = R0 + rt * 16 + fr; float sq = 0.f;
#pragma unroll
    for (int k = 0; k < 8; ++k) {
        const int col = (cbase + k) * 16 + fq * 4, gg = col >> 6;
        const float bsv = p.in[17][(size_t)(l * 4 + gg) * 128 + half * 64 + rt * 16 + fr];
        const f32x4 uv = unpack4(*(const u32x2*)(proj + (size_t)row * NPROJ + C_U + col));
        f32x4 o = uv * (acc[k] + bsv); acc[k] = o;
        sq += (o[0] * o[0] + o[1] * o[1]) + (o[2] * o[2] + o[3] * o[3]);
    }
    sq += __shfl_xor(sq, 16); sq += __shfl_xor(sq, 32);
    if (fq == 0) ssq[(wid >> 2) * 64 + rt * 16 + fr] = sq;
    __syncthreads();
    const float rstd = 1.0f / sqrtf((ssq[rt * 16 + fr] + ssq[64 + rt * 16 + fr]) * (1.0f / 256.0f) + RMS_EPS);
    bf16_t* mix = (bf16_t*)(p.ws + W_MIX);
#pragma unroll
    for (int k = 0; k < 8; ++k) {
        const int col = (cbase + k) * 16 + fq * 4;
        const f32x4 gv = *(const f32x4*)(p.in[18] + (size_t)l * 1024 + 768 + col);
        *(u32x2*)(mix + (size_t)row * DM + 768 + col) = pack4(acc[k] * rstd * gv);
    }
}

__device__ __forceinline__ void scan_prompt(KP& p, int l, int item) {
    int tid_ = threadIdx.x; asm volatile("" : "+v"(tid_));
    const int gid = item * 512 + tid_, e = (gid & 2047) * 4, bh = gid >> 11, b = bh / 6, h = bh % 6;
    bf16_t* ST = (bf16_t*)(p.ws + W_ST); const float* CD = (const float*)(p.ws + W_CD);
    f32x4 st = (f32x4){0.f, 0.f, 0.f, 0.f};
#pragma unroll 1
    for (int c0 = 0; c0 < 128; c0 += 8) {
        u32x2 s[8]; float cd[8];
#pragma unroll
        for (int k = 0; k < 8; ++k) { const int u = b * 128 + c0 + k; s[k] = *(const u32x2*)(ST + ((size_t)(u * 6 + h)) * 8192 + e); cd[k] = CD[u * 8 + h]; }
#pragma unroll
        for (int k = 0; k < 8; ++k) { const int u = b * 128 + c0 + k; *(u32x2*)(ST + ((size_t)(u * 6 + h)) * 8192 + e) = pack4(st); st = st * cd[k] + unpack4(s[k]); }
    }
    *(f32x4*)(p.out + O_PH + ((size_t)(l * 4 + b) * 6 + h) * 8192 + e) = st;
}
__device__ __forceinline__ void scan_sample(KP& p, int l, int item) {
    int tid_ = threadIdx.x; asm volatile("" : "+v"(tid_));
    const int gid = item * 512 + tid_, e = (gid & 2047) * 4, sbh = gid >> 11, sb = sbh / 6, h = sbh % 6;
    bf16_t* ST = (bf16_t*)(p.ws + W_ST); const float* CD = (const float*)(p.ws + W_CD);
    const int u = 512 + sb;
    const f32x4 st = *(const f32x4*)(p.in[4] + ((size_t)(l * 32 + sb) * 6 + h) * 8192 + e);
    const f32x4 s = unpack4(*(const u32x2*)(ST + ((size_t)(u * 6 + h)) * 8192 + e));
    *(u32x2*)(ST + ((size_t)(u * 6 + h)) * 8192 + e) = pack4(st);
    *(f32x4*)(p.out + O_SH + ((size_t)(l * 32 + sb) * 6 + h) * 8192 + e) = st * CD[u * 8 + h] + s;
}

__device__ __forceinline__ void attn_unit(KP& p, LAS unsigned char* lds, int l, int u) {
    int tid_ = threadIdx.x; asm volatile("" : "+v"(tid_));
    const int tid = tid_, wid = tid >> 6, lane = tid & 63, fr = lane & 15, fq = lane >> 4;
    LAS bf16_t* Kb = (LAS bf16_t*)lds;
    LAS bf16_t* VT = (LAS bf16_t*)(lds + 50176);
    LAS bf16_t* Pw = (LAS bf16_t*)(lds + 105472) + wid * 16 * 72;
    LAS float* bias = (LAS float*)(lds + 123904);
    LAS float* ssq = (LAS float*)(lds + 128512);
    const bf16_t* proj = (const bf16_t*)(p.ws + W_PROJ);
    const bool isP = u < 512; const int R0 = u * 64, c = u & 127, b = u >> 7, sb = u - 512;
    const int qt = wid & 3, hbase = (wid >> 2) * 3;
    __syncthreads();
    for (int i = tid; i < 1152; i += 512) bias[i] = p.in[10][(size_t)l * 1152 + i];
    bf16x8 qf[3][2];
#pragma unroll
    for (int hh = 0; hh < 3; ++hh)
#pragma unroll
        for (int ks = 0; ks < 2; ++ks) qf[hh][ks] = glbfrag(proj + (size_t)(R0 + qt * 16 + fr) * NPROJ + (hbase + hh) * 64 + ks * 32 + fq * 8);
    float mrun[3], lrun[3]; f32x4 O[3][4];
#pragma unroll
    for (int hh = 0; hh < 3; ++hh) { mrun[hh] = -1e30f; lrun[hh] = 0.f;
#pragma unroll
        for (int d = 0; d < 4; ++d) O[hh][d] = (f32x4){0.f, 0.f, 0.f, 0.f}; }
    const int blk_lo = isP ? (c < 8 ? 8 - c : 0) : 0;
    u32x4 kr[6], vr[6];
    const int kkey0 = tid / 48, kcg = tid % 48;
    const int vkp = tid & 31, vcg0 = tid >> 5;
#define ATT_LOADP(blkv) do { const size_t rb_ = isP ? (size_t)b * 8192 + (size_t)(c - 8 + (blkv)) * 64 : (size_t)T_P + (size_t)sb * 64; \
        _Pragma("unroll") for (int it = 0; it < 3; ++it) { const int idx = it * 512 + tid; kr[it] = *(const u32x4*)(proj + (rb_ + idx / 48) * NPROJ + C_K + (idx % 48) * 8); } \
        _Pragma("unroll") for (int it = 0; it < 3; ++it) { const int cg_ = vcg0 + it * 16; \
            vr[2 * it] = *(const u32x4*)(proj + (rb_ + 2 * vkp) * NPROJ + C_V + cg_ * 8); vr[2 * it + 1] = *(const u32x4*)(proj + (rb_ + 2 * vkp + 1) * NPROJ + C_V + cg_ * 8); } } while (0)
    bool have = false;
    if (isP || blk_lo == 8) { ATT_LOADP(blk_lo); have = true; }
#pragma unroll 1
    for (int blk = blk_lo; blk <= 8; ++blk) {
        __syncthreads();
        if (!have) {
#pragma unroll
            for (int it = 0; it < 6; ++it) { const int idx = it * 512 + tid;
                const float* s = p.in[2] + ((size_t)(l * 32 + sb) * 512 + blk * 64 + idx / 48) * 384 + (idx % 48) * 8; const f32x4 a = *(const f32x4*)s, bq = *(const f32x4*)(s + 4);
                kr[it].x = cvt_pk_bf16(a[0], a[1]); kr[it].y = cvt_pk_bf16(a[2], a[3]); kr[it].z = cvt_pk_bf16(bq[0], bq[1]); kr[it].w = cvt_pk_bf16(bq[2], bq[3]); }
#pragma unroll
            for (int it = 0; it < 6; ++it) { const int cg_ = vcg0 + (it >> 1) * 16;
                const float* s = p.in[3] + ((size_t)(l * 32 + sb) * 512 + blk * 64 + 2 * vkp + (it & 1)) * 384 + cg_ * 8; const f32x4 a = *(const f32x4*)s, bq = *(const f32x4*)(s + 4);
                vr[it].x = cvt_pk_bf16(a[0], a[1]); vr[it].y = cvt_pk_bf16(a[2], a[3]); vr[it].z = cvt_pk_bf16(bq[0], bq[1]); vr[it].w = cvt_pk_bf16(bq[2], bq[3]); }
        }
        if (have) { const size_t rb_ = isP ? (size_t)b * 8192 + (size_t)(c - 8 + blk) * 64 : (size_t)T_P + (size_t)sb * 64;
#pragma unroll
            for (int it = 3; it < 6; ++it) { const int idx = it * 512 + tid; kr[it] = *(const u32x4*)(proj + (rb_ + idx / 48) * NPROJ + C_K + (idx % 48) * 8); } }
#pragma unroll
        for (int it = 0; it < 3; ++it) { const int cg_ = vcg0 + it * 16; const u32x4 w0 = vr[2 * it], w1 = vr[2 * it + 1];
            const unsigned a0[4] = {w0.x, w0.y, w0.z, w0.w}, a1[4] = {w1.x, w1.y, w1.z, w1.w};
#pragma unroll
            for (int e = 0; e < 4; ++e) {
                *(LAS unsigned*)(VT + (cg_ * 8 + 2 * e) * 72 + 2 * vkp) = (a0[e] & 0xffffu) | (a1[e] << 16);
                *(LAS unsigned*)(VT + (cg_ * 8 + 2 * e + 1) * 72 + 2 * vkp) = (a0[e] >> 16) | (a1[e] & 0xffff0000u); } }
#pragma unroll
        for (int it = 0; it < 6; ++it) { const int idx = it * 512 + tid; *(LAS u32x4*)(Kb + (idx / 48) * 392 + (idx % 48) * 8) = kr[it]; }
        __syncthreads();
        have = false;
        if (blk < 8 && (isP || blk == 7)) { ATT_LOADP(blk + 1); have = true; }
#pragma unroll
        for (int hh = 0; hh < 3; ++hh) {
            const int h = hbase + hh;
            f32x4 s[4]; float mx = -1e30f;
#pragma unroll
            for (int kt = 0; kt < 4; ++kt) {
                f32x4 a = (f32x4){0.f, 0.f, 0.f, 0.f};
#pragma unroll
                for (int ks = 0; ks < 2; ++ks) a = MFMA16(ldsfrag((LAS const unsigned char*)(Kb + (kt * 16 + fr) * 392 + h * 64 + ks * 32 + fq * 8)), qf[hh][ks], a);
                if (blk <= 5) { const float bc = bias[h * 192 + 191];
#pragma unroll
                    for (int j = 0; j < 4; ++j) { a[j] = a[j] * 0.125f + bc; mx = fmaxf(mx, a[j]); } }
                else {
#pragma unroll
                    for (int j = 0; j < 4; ++j) {
                        int rel = (qt * 16 + fr) + 512 - (blk * 64 + kt * 16 + fq * 4 + j); rel = rel > 128 ? 128 : rel;
                        a[j] = a[j] * 0.125f + bias[h * 192 + rel + 63]; mx = fmaxf(mx, a[j]);
                    } }
                s[kt] = a;
            }
            mx = fmaxf(mx, __shfl_xor(mx, 16)); mx = fmaxf(mx, __shfl_xor(mx, 32));
            const float mnew = fmaxf(mrun[hh], mx), fac = __expf(mrun[hh] - mnew); mrun[hh] = mnew;
            float rs = 0.f;
#pragma unroll
            for (int kt = 0; kt < 4; ++kt) {
#pragma unroll
                for (int j = 0; j < 4; ++j) { s[kt][j] = __expf(s[kt][j] - mnew); rs += s[kt][j]; }
                *(LAS u32x2*)(Pw + fr * 72 + kt * 16 + fq * 4) = pack4(s[kt]);
            }
            rs += __shfl_xor(rs, 16); rs += __shfl_xor(rs, 32);
            lrun[hh] = lrun[hh] * fac + rs;
#pragma unroll
            for (int d = 0; d < 4; ++d) O[hh][d] *= fac;
            LDS_WAVE_SYNC();
#pragma unroll
            for (int ks = 0; ks < 2; ++ks) {
                const bf16x8 pf = ldsfrag((LAS const unsigned char*)(Pw + fr * 72 + ks * 32 + fq * 8));
#pragma unroll
                for (int d = 0; d < 4; ++d) O[hh][d] = MFMA16(ldsfrag((LAS const unsigned char*)(VT + (h * 64 + d * 16 + fr) * 72 + ks * 32 + fq * 8)), pf, O[hh][d]);
            }
            LDS_WAVE_SYNC();
        }
    }
    float sq = 0.f;
#pragma unroll
    for (int hh = 0; hh < 3; ++hh) { const float inv = 1.0f / lrun[hh];
#pragma unroll
        for (int d = 0; d < 4; ++d) { O[hh][d] *= inv; const f32x4 o = O[hh][d]; sq += (o[0] * o[0] + o[1] * o[1]) + (o[2] * o[2] + o[3] * o[3]); } }
    sq += __shfl_xor(sq, 16); sq += __shfl_xor(sq, 32);
    if (fq == 0) ssq[(wid >> 2) * 64 + qt * 16 + fr] = sq;
    __syncthreads();
    const float rstd = 1.0f / sqrtf((ssq[qt * 16 + fr] + ssq[64 + qt * 16 + fr]) * (1.0f / 384.0f) + RMS_EPS);
    bf16_t* mix = (bf16_t*)(p.ws + W_MIX);
#pragma unroll
    for (int hh = 0; hh < 3; ++hh)
#pragma unroll
        for (int d = 0; d < 4; ++d) {
            const int col = (hbase + hh) * 64 + d * 16 + fq * 4;
            const f32x4 gv = *(const f32x4*)(p.in[18] + (size_t)l * 1024 + col);
            *(u32x2*)(mix + (size_t)(R0 + qt * 16 + fr) * DM + col) = pack4(O[hh][d] * rstd * gv);
        }
}

__device__ __forceinline__ void ssd_y(KP& p, LAS unsigned char* lds, int l, int u) {
    int tid_ = threadIdx.x; asm volatile("" : "+v"(tid_));
    const int tid = tid_, wid = tid >> 6, lane = tid & 63, fr = lane & 15, fq = lane >> 4;
    LAS bf16_t* Cn = (LAS bf16_t*)lds;
    LAS bf16_t* Bn = (LAS bf16_t*)(lds + 17408);
    LAS bf16_t* xT = (LAS bf16_t*)(lds + 34816);
    LAS bf16_t* Mm = (LAS bf16_t*)(lds + 62464);
    LAS float* dtl = (LAS float*)(lds + 90112);
    LAS float* acl = (LAS float*)(lds + 90880);
    LAS float* ssq = (LAS float*)(lds + 91648);
    const bf16_t* proj = (const bf16_t*)(p.ws + W_PROJ);
    const bf16_t* HP = (const bf16_t*)(p.ws + W_ST);
    const bf16_t* XC = (const bf16_t*)(p.ws + W_XB) + (size_t)(u * 64) * 896;
    const int R0 = u * 64, lt = wid & 3;
    f32x4 yacc[2][6];
#pragma unroll
    for (int g = 0; g < 2; ++g) {
        __syncthreads();
        if (wid < 3) { float dt, ac, last; dt_scan(p, l, u, g, wid, lane, dt, ac, last); dtl[wid * 64 + lane] = dt; acl[wid * 64 + lane] = ac; }
#pragma unroll
        for (int it = 0; it < 4; ++it) {
            const int idx = it * 512 + tid, mat = idx >> 10, i = (idx >> 4) & 63, c8 = idx & 15;
            const u32x4 w = *(const u32x4*)(XC + (size_t)i * 896 + 384 + mat * 256 + g * 128 + c8 * 8);
            *(LAS u32x4*)((mat ? Cn : Bn) + i * 136 + c8 * 8) = w;
        }
#pragma unroll
        for (int it = 0; it < 3; ++it) {
            const int idx = it * 512 + tid, c4 = idx % 48, i = (idx / 48) * 2;
            const u32x2 wa = *(const u32x2*)(XC + (size_t)i * 896 + g * 192 + c4 * 4), wb = *(const u32x2*)(XC + (size_t)(i + 1) * 896 + g * 192 + c4 * 4);
            *(LAS unsigned*)(xT + (c4 * 4 + 0) * 72 + i) = (wa.x & 0xffffu) | (wb.x << 16);
            *(LAS unsigned*)(xT + (c4 * 4 + 1) * 72 + i) = (wa.x >> 16) | (wb.x & 0xffff0000u);
            *(LAS unsigned*)(xT + (c4 * 4 + 2) * 72 + i) = (wa.y & 0xffffu) | (wb.y << 16);
            *(LAS unsigned*)(xT + (c4 * 4 + 3) * 72 + i) = (wa.y >> 16) | (wb.y & 0xffff0000u);
        }
        __syncthreads();
#pragma unroll
        for (int k = 0; k < 2; ++k) {
            const int st = (wid >> 2) * 2 + k;
            f32x4 a = (f32x4){0.f, 0.f, 0.f, 0.f};
#pragma unroll
            for (int ks = 0; ks < 4; ++ks) a = MFMA16(ldsfrag((LAS const unsigned char*)(Bn + (st * 16 + fr) * 136 + ks * 32 + fq * 8)), ldsfrag((LAS const unsigned char*)(Cn + (lt * 16 + fr) * 136 + ks * 32 + fq * 8)), a);
            const int li = lt * 16 + fr;
#pragma unroll
            for (int hh = 0; hh < 3; ++hh) {
                const float al = acl[hh * 64 + li]; f32x4 mv;
#pragma unroll
                for (int j = 0; j < 4; ++j) { const int si = st * 16 + fq * 4 + j; mv[j] = si <= li ? a[j] * __expf(al - acl[hh * 64 + si]) * dtl[hh * 64 + si] : 0.f; }
                *(LAS u32x2*)(Mm + (hh * 64 + li) * 72 + st * 16 + fq * 4) = pack4(mv);
            }
        }
        __syncthreads();
#pragma unroll
        for (int k = 0; k < 6; ++k) {
            const int ctile = (wid >> 2) * 6 + k, hh = ctile >> 2, pt = ctile & 3, h = g * 3 + hh, li = lt * 16 + fr;
            f32x4 ad = (f32x4){0.f, 0.f, 0.f, 0.f}, ao = (f32x4){0.f, 0.f, 0.f, 0.f};
#pragma unroll
            for (int ks = 0; ks < 2; ++ks) ad = MFMA16(ldsfrag((LAS const unsigned char*)(xT + (hh * 64 + pt * 16 + fr) * 72 + ks * 32 + fq * 8)), ldsfrag((LAS const unsigned char*)(Mm + (hh * 64 + li) * 72 + ks * 32 + fq * 8)), ad);
#pragma unroll
            for (int ks = 0; ks < 4; ++ks) ao = MFMA16(glbfrag(HP + ((size_t)(u * 6 + h) * 64 + pt * 16 + fr) * 128 + ks * 32 + fq * 8), ldsfrag((LAS const unsigned char*)(Cn + li * 136 + ks * 32 + fq * 8)), ao);
            const float ea = __expf(acl[hh * 64 + li]), dsk = p.in[15][l * 6 + h];
            const f32x4 xv = unpack4(*(const u32x2*)(XC + (size_t)li * 896 + h * 64 + pt * 16 + fq * 4));
            const f32x4 zv = unpack4(*(const u32x2*)(proj + (size_t)(R0 + li) * NPROJ + C_Z + h * 64 + pt * 16 + fq * 4));
            f32x4 y = ad + ao * ea + xv * dsk;
#pragma unroll
            for (int j = 0; j < 4; ++j) y[j] *= silu_f(zv[j]);
            yacc[g][k] = y;
            asm volatile("" ::: "memory");
        }
    }
    float sq = 0.f;
#pragma unroll
    for (int g = 0; g < 2; ++g)
#pragma unroll
        for (int k = 0; k < 6; ++k) { const f32x4 o = yacc[g][k]; sq += (o[0] * o[0] + o[1] * o[1]) + (o[2] * o[2] + o[3] * o[3]); }
    sq += __shfl_xor(sq, 16); sq += __shfl_xor(sq, 32);
    if (fq == 0) ssq[(wid >> 2) * 64 + lt * 16 + fr] = sq;
    __syncthreads();
    const float rstd = 1.0f / sqrtf((ssq[lt * 16 + fr] + ssq[64 + lt * 16 + fr]) * (1.0f / 384.0f) + RMS_EPS);
    bf16_t* mix = (bf16_t*)(p.ws + W_MIX);
#pragma unroll
    for (int g = 0; g < 2; ++g)
#pragma unroll
        for (int k = 0; k < 6; ++k) {
            const int col = 384 + g * 192 + ((wid >> 2) * 6 + k) * 16 + fq * 4;
            const f32x4 gv = *(const f32x4*)(p.in[18] + (size_t)l * 1024 + col);
            *(u32x2*)(mix + (size_t)(R0 + lt * 16 + fr) * DM + col) = pack4(yacc[g][k] * rstd * gv);
        }
}

__device__ __forceinline__ void phase_fix(KP& p, int l) {
    const float* halo = (const float*)(p.ws + W_MIX); bf16_t* H = (bf16_t*)(p.ws + W_PROJ);
    const float* w = p.in[23] + (size_t)l * 3 * DFF2; const float* bb = p.in[24] + (size_t)l * DFF2;
    int tid_ = threadIdx.x; asm volatile("" : "+v"(tid_));
    for (int i = blockIdx.x * 512 + tid_; i < 128 * DFF2; i += gridDim.x * 512) {
        const int pm = i / DFF2, cc = i % DFF2;
        if ((pm & 31) == 0 || cc >= DFF) continue;
        const float* h0 = halo + (size_t)(pm - 1) * 4 * DFF2; const float* h1 = halo + (size_t)pm * 4 * DFF2;
        float r[2];
#pragma unroll
        for (int rr = 0; rr < 2; ++rr) {
            float o[2];
#pragma unroll
            for (int gv = 0; gv < 2; ++gv) {
                const int c2 = cc + gv * DFF;
                const float xm2 = h0[2 * DFF2 + c2], xm1 = h0[3 * DFF2 + c2], x0 = h1[c2], x1 = h1[DFF2 + c2];
                o[gv] = rr == 0 ? bb[c2] + w[c2] * xm2 + w[DFF2 + c2] * xm1 + w[2 * DFF2 + c2] * x0 : bb[c2] + w[c2] * xm1 + w[DFF2 + c2] * x0 + w[2 * DFF2 + c2] * x1;
            }
            r[rr] = silu_f(o[0]) * o[1];
        }
        H[((size_t)pm * 256) * DFF + cc] = (bf16_t)(cvt_pk_bf16(r[0], 0.f) & 0xffffu);
        H[((size_t)pm * 256 + 1) * DFF + cc] = (bf16_t)(cvt_pk_bf16(r[1], 0.f) & 0xffffu);
    }
}

#define XB_TMO      128
#define XB_XCNT(j)  (256  + 64 * (j))
#define XB_XSUB(j)  (1280 + 64 * (j))
#define XB_XGEN(j)  (2304 + 64 * (j))
#define XB_TOP      3328
#define XB_TOPGEN   3392
#define XCD_BAR_WORDS 3456
#define XB_SPIN_CAP (1u << 18)

__device__ __forceinline__ unsigned xb_ld(unsigned* p)              { return __hip_atomic_load(p, __ATOMIC_RELAXED, __HIP_MEMORY_SCOPE_AGENT); }
__device__ __forceinline__ unsigned xb_add(unsigned* p, unsigned v) { return __hip_atomic_fetch_add(p, v, __ATOMIC_RELAXED, __HIP_MEMORY_SCOPE_AGENT); }
__device__ __forceinline__ unsigned xb_xcc_id() { return (unsigned)__builtin_amdgcn_s_getreg((3 << 11) | 20) & 0xFu; }
#define XB_SPIN(cond, bar) do { unsigned _sp = 0; while (cond) { __builtin_amdgcn_s_sleep(1); \
    if ((++_sp & 255u) == 0u) { if (xb_ld(&(bar)[XB_TMO])) break; if (_sp > XB_SPIN_CAP) { atomicAdd(&(bar)[XB_TMO], 1u); break; } } } } while (0)

struct XcdBarrier {
    unsigned* bar; unsigned x;
    volatile LAS unsigned* st;
};

__device__ __forceinline__ XcdBarrier xcd_barrier_post(unsigned* bar, volatile LAS unsigned* st) {
    XcdBarrier b; b.bar = bar; b.x = xb_xcc_id(); b.st = st;
    if (threadIdx.x == 0) (void)xb_add(&bar[XB_XCNT(b.x)], 1u);
    return b;
}
__device__ __forceinline__ void xcd_barrier_complete(unsigned* bar, unsigned x, unsigned& nloc, unsigned& nx) {
    const unsigned G = gridDim.x * gridDim.y * gridDim.z;
    unsigned sum, cnt, mine, sp = 0u;
    for (;;) {
        sum = 0u; cnt = 0u; mine = 0u;
#pragma unroll
        for (unsigned j = 0; j < 16; ++j) { const unsigned c = xb_ld(&bar[XB_XCNT(j)]); sum += c; cnt += (c > 0u) ? 1u : 0u; mine = (j == x) ? c : mine; }
        if (sum == G) break;
        __builtin_amdgcn_s_sleep(1);
        if ((++sp & 255u) == 0u) { if (xb_ld(&bar[XB_TMO])) break; if (sp > XB_SPIN_CAP) { atomicAdd(&bar[XB_TMO], 1u); break; } }
    }
    nloc = mine > 0u ? mine : 1u; nx = cnt > 0u ? cnt : 1u;
}

__device__ __forceinline__ void xcd_barrier(const XcdBarrier& b) {
    asm volatile("s_waitcnt vmcnt(0)" ::: "memory");
    __syncthreads();
    if (threadIdx.x == 0) {
        unsigned* bar = b.bar;
        __builtin_amdgcn_s_waitcnt(0);
        unsigned nloc = b.st[0], nx = b.st[1];
        if (nloc == 0u) { xcd_barrier_complete(bar, b.x, nloc, nx); b.st[0] = nloc; b.st[1] = nx; }
        const unsigned old = xb_add(&bar[XB_XSUB(b.x)], 1u);
        const unsigned gen = old / nloc;
        if (old + 1u == (gen + 1u) * nloc) {
            __builtin_amdgcn_fence(__ATOMIC_RELEASE, "agent");
            asm volatile("s_waitcnt vmcnt(0)" ::: "memory");
            const unsigned og = xb_add(&bar[XB_TOP], 1u);
            const unsigned tg = og / nx;
            if (og + 1u == (tg + 1u) * nx) xb_add(&bar[XB_TOPGEN], 1u);
            else XB_SPIN(xb_ld(&bar[XB_TOPGEN]) == tg, bar);
            __builtin_amdgcn_fence(__ATOMIC_ACQUIRE, "agent");
            xb_add(&bar[XB_XGEN(b.x)], 1u);
            asm volatile("s_waitcnt vmcnt(0)" ::: "memory");
        } else {
            XB_SPIN(xb_ld(&bar[XB_XGEN(b.x)]) == gen, bar);
            __builtin_amdgcn_fence(__ATOMIC_ACQUIRE, "agent");
            asm volatile("s_waitcnt vmcnt(0)" ::: "memory");
        }
    }
    __syncthreads();
}

__global__ void __launch_bounds__(512, 2) mega(Params pa) {
    extern __shared__ __attribute__((aligned(16))) unsigned char shm[];
    LAS unsigned char* lds = (LAS unsigned char*)shm;
    const int G = gridDim.x, bid = blockIdx.x;
    KP* pk = (KP*)__builtin_amdgcn_kernarg_segment_ptr();
    volatile LAS unsigned* bst = (volatile LAS unsigned*)(lds + LDS_BYTES - 16);
    XcdBarrier xb; xb.bar = nullptr; xb.x = 0; xb.st = bst;
    if (pa.coop) { if (threadIdx.x < 2) bst[threadIdx.x] = 0u; __syncthreads(); xb = xcd_barrier_post((unsigned*)(pa.ws + W_BAR), bst); }
    for (int ph = pa.ph_lo; ph < pa.ph_hi; ++ph) {
        if (ph > pa.ph_lo && pa.coop) { if (ph == pa.ph_lo + 1) { __threadfence(); cg::this_grid().sync(); } else xcd_barrier(xb); }
        asm volatile("" : "+s"(pk)); KP& p = *pk;
        if (ph == 0) { phase_prep(p, lds); continue; }
        if (ph == 42) { int tq = threadIdx.x; asm volatile("" : "+v"(tq)); const unsigned short* w16 = (const unsigned short*)p.ws; for (size_t i = (size_t)bid * 512 + tq; i < (size_t)59418624; i += (size_t)G * 512) p.out[i] = (float)w16[i * 4]; continue; }
        if (ph == 41) { int tq = threadIdx.x; asm volatile("" : "+v"(tq)); for (size_t i = (size_t)bid * 512 + tq; i < (size_t)59418624; i += (size_t)G * 512) { const float v = p.out[i]; if (!(fabsf(v) < 1e30f)) p.out[i] = 0.f; } continue; }
        const int l = (ph - 1) / 10, k = (ph - 1) % 10;
        bf16_t* XB = (bf16_t*)(p.ws + W_XB);
        switch (k) {
        case 0: if (REP_G1 > 1) { pg8::StaticOrder S; S.init(T_ALL, NPROJ, G, bid); EpiNull E{(float*)(p.ws + W_CD)};
                  pg8::gemm_phase(lds, pg8::Gemm{XB, (const bf16_t*)(p.ws + W_IN + l * W_IN_L), T_ALL, NPROJ, DM}, S, E); }
                { pg8::StaticOrder S; S.init(T_ALL, NPROJ, G, bid);
                  EpiIn E{(bf16_t*)(p.ws + W_PROJ), p.out, (float*)(p.ws + W_DTB), p.in[13], l};
                  pg8::gemm_phase(lds, pg8::Gemm{XB, (const bf16_t*)(p.ws + W_IN + l * W_IN_L), T_ALL, NPROJ, DM}, S, E); } break;
        case 1: for (int it = bid; it < 3 * NU64; it += G) { if (it < NU64) attn_unit(p, lds, l, NU64 - 1 - it); else if (it < 2 * NU64) ssd_states(p, lds, l, it - NU64); else gmlp_unit(p, lds, l, it - 2 * NU64); } break;
        case 2: for (int it = bid; it < 96 + 768; it += G) { if (it < 96) scan_prompt(p, l, it); else scan_sample(p, l, it - 96); } break;
        case 3: for (int rep = 0; rep < REP_M3; ++rep) for (int it = bid; it < NU64; it += G) ssd_y(p, lds, l, it); break;
        case 4: { pg8::StaticOrder S; S.init(T_ALL, DM, G, bid); EpiRes E{p.out};
                  pg8::gemm_phase(lds, pg8::Gemm{(const bf16_t*)(p.ws + W_MIX), (const bf16_t*)(p.ws + W_OUT + l * W_OUT_L), T_ALL, DM, DM}, S, E); } break;
        case 5: phase_ln(p, p.in[20] + l * DM, p.in[21] + l * DM); break;
        case 6: for (int rep = 0; rep < REP_G3; ++rep) { pg8::StaticOrder S; S.init(T_ALL, DFF2, G, bid);
                  EpiUp E{(bf16_t*)(p.ws + W_PROJ), (float*)(p.ws + W_MIX), p.out, p.in[23], p.in[24], p.in[6], l};
                  pg8::OneUnit o1;
                  for (int i = 0; S.next(i, o1.u); ++i) { pg8::gemm_phase(lds, pg8::Gemm{XB, (const bf16_t*)(p.ws + W_UP + l * W_UP_L), T_ALL, DFF2, DM}, o1, E); __syncthreads(); } } break;
        case 7: phase_fix(p, l); break;
        case 8: { pg8::StaticOrder S; S.init(T_ALL, DM, G, bid); EpiRes E{p.out};
                  pg8::gemm_phase(lds, pg8::Gemm{(const bf16_t*)(p.ws + W_PROJ), (const bf16_t*)(p.ws + W_DN + l * W_DN_L), T_ALL, DM, DFF}, S, E); } break;
        case 9: phase_ln(p, p.in[26] + l * DM, p.in[27] + l * DM); break;
        }
    }
}

constexpr int N_PHASES = 41;
#ifndef MULTI_LAUNCH
#define MULTI_LAUNCH 0
#endif

extern "C" void kernel_launch(void* const* d_in, const int* in_sizes, int n_in, void* d_out, int out_size, void* d_ws, size_t ws_size, hipStream_t stream) {
    static int grid = 0;
    if (grid == 0) {
        if (n_in != 28 || ws_size < W_END2) { fprintf(stderr, "kernel_launch: need 28 inputs and %zu bytes of workspace (got %d, %zu)\n", (size_t)W_END2, n_in, ws_size); grid = -1; return; }
        int dev = 0, cus = 0, per_cu = 0;
        hipGetDevice(&dev); hipDeviceGetAttribute(&cus, hipDeviceAttributeMultiprocessorCount, dev);
        if (hipFuncSetAttribute((const void*)mega, hipFuncAttributeMaxDynamicSharedMemorySize, LDS_BYTES) != hipSuccess) { fprintf(stderr, "kernel_launch: hipFuncSetAttribute failed\n"); grid = -1; return; }
        hipOccupancyMaxActiveBlocksPerMultiprocessor(&per_cu, (const void*)mega, 512, LDS_BYTES);
        (void)hipGetLastError();
        if (per_cu < 1) per_cu = 1;
        grid = cus * 1;
    }
    if (grid < 0) return;
    Params p{};
    for (int i = 0; i < 28; ++i) p.in[i] = (const float*)d_in[i];
    p.out = (float*)d_out; p.ws = (unsigned char*)d_ws;
#if MULTI_LAUNCH
#ifdef PROBE_CUT
    for (int ph = 0; ph < PROBE_CUT; ++ph) { p.ph_lo = ph; p.ph_hi = ph + 1; p.coop = 0; hipLaunchKernelGGL(mega, dim3(grid), dim3(512), LDS_BYTES, stream, p); }
    p.ph_lo = 42; p.ph_hi = 43; p.coop = 0; hipLaunchKernelGGL(mega, dim3(grid), dim3(512), LDS_BYTES, stream, p);
#else
    for (int ph = 0; ph < N_PHASES; ++ph) { p.ph_lo = ph; p.ph_hi = ph + 1; p.coop = 0; hipLaunchKernelGGL(mega, dim3(grid), dim3(512), LDS_BYTES, stream, p); }
#endif
#else
    p.ph_lo = 0; p.ph_hi = N_PHASES; p.coop = 1;
    if (hipMemsetAsync((char*)d_ws + W_BAR, 0, 16384, stream) != hipSuccess) { fprintf(stderr, "kernel_launch: memset failed\n"); return; }
    void* args[] = {&p};
    hipError_t e = hipLaunchCooperativeKernel((const void*)mega, dim3(grid), dim3(512), args, LDS_BYTES, stream);
    if (e != hipSuccess) fprintf(stderr, "cooperative launch failed: %s (grid %d)\n", hipGetErrorString(e), grid);
#endif
}
```

```cpp
#define REP_G1 1
#define REP_M1 1
#define REP_ATT 1
#define REP_M3 1
#define REP_G3 1
#include <hip/hip_runtime.h>
#include <hip/hip_cooperative_groups.h>
#include <cstdio>
namespace cg = cooperative_groups;

#define LAS __attribute__((address_space(3)))
typedef unsigned short bf16_t;
typedef short bf16x8 __attribute__((ext_vector_type(8)));
typedef float f32x4 __attribute__((ext_vector_type(4)));
typedef float f32x2 __attribute__((ext_vector_type(2)));
typedef unsigned u32x4 __attribute__((ext_vector_type(4)));
typedef unsigned u32x2 __attribute__((ext_vector_type(2)));

constexpr int T_ALL = 34816, T_P = 32768, DM = 1024, NPROJ = 3072, DFF = 2816, DFF2 = 5632, DEPTH = 4;
constexpr int NU64 = 544;
constexpr float ALPHA = 1.6817928305074290f;
constexpr float LN_EPS = 1e-5f, RMS_EPS = 1e-5f;
constexpr int C_K = 384, C_V = 768, C_Z = 1152, C_XBC = 1536, C_U = 2432, C_VC = 2688, C_DT = 2944;
constexpr size_t O_YP = 0, O_YS = 33554432, O_PK = 35651584, O_PV = O_PK + 3145728, O_PH = O_PV + 3145728, O_PC = O_PH + 786432,
                 O_PF = O_PC + 43008, O_SK = O_PF + 180224, O_SV = O_SK + 3145728, O_SH = O_SV + 3145728, O_SC = O_SH + 6291456,
                 O_SG = O_SC + 344064, O_SF = O_SG + 2097152;
constexpr size_t W_IN = 0, W_IN_L = (size_t)NPROJ * DM * 2;
constexpr size_t W_OUT = W_IN + 4 * W_IN_L, W_OUT_L = (size_t)DM * DM * 2;
constexpr size_t W_UP = W_OUT + 4 * W_OUT_L, W_UP_L = (size_t)DFF2 * DM * 2;
constexpr size_t W_DN = W_UP + 4 * W_UP_L, W_DN_L = (size_t)DM * DFF * 2;
constexpr size_t W_GW = W_DN + 4 * W_DN_L, W_GW_L = (size_t)4 * 128 * 128 * 2;
constexpr size_t W_XB = W_GW + 4 * W_GW_L;
constexpr size_t W_PROJ = W_XB + (size_t)T_ALL * DM * 2;
constexpr size_t W_MIX = W_PROJ + (size_t)T_ALL * NPROJ * 2;
constexpr size_t W_ST = W_MIX + (size_t)T_ALL * DM * 2;
constexpr size_t W_CD = W_ST + (size_t)NU64 * 6 * 8192 * 2;
constexpr size_t W_DTB = W_CD + (size_t)NU64 * 8 * 4;
constexpr size_t W_END = W_DTB + (size_t)T_ALL * 8 * 4;
constexpr size_t W_BAR = W_END;
constexpr size_t W_END2 = W_BAR + 16384;
constexpr int LDS_BYTES = 136 * 1024;

struct Params { const float* in[28]; float* out; unsigned char* ws; int ph_lo, ph_hi, coop, pad; };
typedef const __attribute__((address_space(4))) Params KP;

__device__ __forceinline__ float bf2f(unsigned b) { return __uint_as_float(b << 16); }
typedef __bf16 bf16v2 __attribute__((ext_vector_type(2)));
__device__ __forceinline__ unsigned cvt_pk_bf16(float lo, float hi) { const f32x2 v = {lo, hi}; const bf16v2 b = __builtin_convertvector(v, bf16v2); return __builtin_bit_cast(unsigned, b); }
__device__ __forceinline__ u32x2 pack4(f32x4 v) { u32x2 w; w.x = cvt_pk_bf16(v[0], v[1]); w.y = cvt_pk_bf16(v[2], v[3]); return w; }
__device__ __forceinline__ f32x4 unpack4(u32x2 w) { f32x4 v; v[0] = bf2f(w.x & 0xffffu); v[1] = bf2f(w.x >> 16); v[2] = bf2f(w.y & 0xffffu); v[3] = bf2f(w.y >> 16); return v; }
__device__ __forceinline__ float silu_f(float x) { return x / (1.0f + __expf(-x)); }
__device__ __forceinline__ float gelu_tanh(float x) { const float y = 0.7978845608028654f * (x + 0.044715f * x * x * x); const float e = __expf(2.0f * y); return 0.5f * x * (2.0f - 2.0f / (1.0f + e)); }
__device__ __forceinline__ float softplus_f(float x) { const float e = __expf(x); return x > 15.0f ? x : (e < 1e-3f ? e * (1.0f - 0.5f * e + 0.33333333f * e * e) : __logf(1.0f + e)); }
#define MFMA16(colfrag, rowfrag, acc) __builtin_amdgcn_mfma_f32_16x16x32_bf16((colfrag), (rowfrag), (acc), 0, 0, 0)
__device__ __forceinline__ bf16x8 ldsfrag(LAS const unsigned char* p) { return *(LAS const bf16x8*)p; }
__device__ __forceinline__ bf16x8 glbfrag(const bf16_t* p) { return *(const bf16x8*)p; }
#define LDS_WAVE_SYNC() asm volatile("s_waitcnt lgkmcnt(0)" ::: "memory")

namespace pg8 {
constexpr int BM = 256, BK = 64, HALF = 128, HTB = HALF * BK * 2, STAGE_BYTES = 8 * HTB, NXCD = 8, WGM = 8;
__device__ __forceinline__ int lds_byte(int r, int c) { const int st = (r >> 4) * 2 + (c >> 5), rr = r & 15, cc = c & 31, ob = rr * 64 + cc * 2; return st * 1024 + (ob ^ (((ob >> 9) & 1) << 5)); }
__device__ __forceinline__ void stage_rc(int b, int& R, int& C) { const int st = b / 1024, sb = b % 1024, swz = sb ^ (((sb >> 9) & 1) << 5); R = (st >> 1) * 16 + swz / 64; C = (st & 1) * 32 + (swz % 64) / 2; }
__device__ __forceinline__ int perm32(int rho) { const int n = rho >> 4, i = rho & 15; return 8 * (i >> 2) + 4 * n + (i & 3); }
struct Unit { int pm, pn; };
struct Gemm { const bf16_t* A; const bf16_t* Bt; int M, N, K; };
struct StaticOrder {
    int nM, nN, nwg, G, c;
    __device__ __forceinline__ void init(int M, int N, int G_, int c_) { nM = M / BM; nN = N / BM; nwg = nM * nN; G = G_; c = c_; }
    __device__ __forceinline__ bool next(int i, Unit& u) const {
        const long L = (long)i * G + c; if (L >= nwg) return false;
        int wgid = (int)L; { const int q = nwg / NXCD, r = nwg % NXCD, xcd = wgid % NXCD, off = wgid / NXCD; wgid = (xcd < r ? xcd * (q + 1) : r * (q + 1) + (xcd - r) * q) + off; }
        const int nig = WGM * nN, gid = wgid / nig, fm = gid * WGM, gsz = (nM - fm) < WGM ? (nM - fm) : WGM;
        u.pm = fm + ((wgid % nig) % gsz); u.pn = (wgid % nig) / gsz; return true;
    }
    __device__ __forceinline__ void a_ready(const Unit&) const {}
    __device__ __forceinline__ void done(const Unit&) const {}
};
struct OneUnit {
    Unit u;
    __device__ __forceinline__ bool next(int i, Unit& o) const { if (i) return false; o = u; return true; }
    __device__ __forceinline__ void a_ready(const Unit&) const {}
    __device__ __forceinline__ void done(const Unit&) const {}
};

template <class Epi, class Sched>
__device__ __forceinline__ void gemm_phase(LAS unsigned char* lds, const Gemm g, const Sched& S, const Epi& E) {
    int tid_ = threadIdx.x; asm volatile("" : "+v"(tid_));
    const int tid = tid_, wid = __builtin_amdgcn_readfirstlane(tid >> 6), lane = tid & 63, wr = wid >> 2, wc = wid & 3, fr = lane & 15, fq = lane >> 4;
    const int K = g.K, nt = K / BK;
    unsigned voffA[2], voffB[2];
#pragma unroll
    for (int i = 0; i < 2; ++i) { int R, C; stage_rc(tid * 16 + i * 8192, R, C); const int Rb = (R & ~31) + perm32(R & 31); voffA[i] = (unsigned)(R * K + C) * 2u; voffB[i] = (unsigned)(Rb * K + C) * 2u; }
    const size_t kstep = (size_t)(BK * 2);
    const size_t hstep = (size_t)HALF * K * 2;
    const size_t tstep = 2 * hstep;
    const unsigned ldsw = (unsigned)wid * 1024u;
    const int aoff = lds_byte(wr * 64 + fr, fq * 8), boff = lds_byte(wc * 32 + fr, fq * 8);
#define PG8_SA(b, h) (((b) * 2 + (h)) * HTB)
#define PG8_SB(b, h) ((4 + (b) * 2 + (h)) * HTB)
#define PG8_STAGE(bufoff, gbase, voff) do { _Pragma("unroll") for (int _i = 0; _i < 2; ++_i) \
        __builtin_amdgcn_global_load_lds((const unsigned*)((const char*)(gbase) + (voff)[_i]), (LAS unsigned*)(lds + (bufoff) + ldsw + _i * 8192), 16, 0, 0); } while (0)
#define PG8_LDA(dst, b, h) do { _Pragma("unroll") for (int m = 0; m < 4; ++m) _Pragma("unroll") for (int k = 0; k < 2; ++k) dst[m][k] = *(const LAS bf16x8*)(lds + PG8_SA(b, h) + aoff + m * 2048 + k * 1024); } while (0)
#define PG8_LDB(dst, b, h) do { _Pragma("unroll") for (int n = 0; n < 2; ++n) _Pragma("unroll") for (int k = 0; k < 2; ++k) dst[n][k] = *(const LAS bf16x8*)(lds + PG8_SB(b, h) + boff + n * 2048 + k * 1024); } while (0)
#define PG8_MMA(ai, bj, At, Bt) do { __builtin_amdgcn_s_setprio(1); _Pragma("unroll") for (int m = 0; m < 4; ++m) _Pragma("unroll") for (int n = 0; n < 2; ++n) _Pragma("unroll") for (int k = 0; k < 2; ++k) \
        acc[ai][bj][m][n] = __builtin_amdgcn_mfma_f32_16x16x32_bf16(Bt[n][k], At[m][k], acc[ai][bj][m][n], 0, 0, 0); __builtin_amdgcn_s_setprio(0); } while (0)
#define PG8_WAIT_V(n) asm volatile("s_waitcnt vmcnt(" #n ")" ::: "memory")
#define PG8_WAIT_L(n) asm volatile("s_waitcnt lgkmcnt(" #n ")" ::: "memory")
#define PG8_BAR __builtin_amdgcn_s_barrier()
#define PG8_SCHED __builtin_amdgcn_sched_barrier(0)
    Unit cur, nxt; int ui = 0;
    if (!S.next(0, cur)) return;
    f32x4 acc[2][2][4][2];
#pragma unroll
    for (int a = 0; a < 2; ++a)
#pragma unroll
        for (int b = 0; b < 2; ++b)
#pragma unroll
            for (int m = 0; m < 4; ++m)
#pragma unroll
                for (int n = 0; n < 2; ++n) acc[a][b][m][n] = (f32x4){0.f, 0.f, 0.f, 0.f};
    bf16x8 At[4][2], B0[2][2], B1[2][2];
    const char* cA = (const char*)g.A + (size_t)cur.pm * tstep; const char* cB = (const char*)g.Bt + (size_t)cur.pn * tstep;
    S.a_ready(cur);
    PG8_STAGE(PG8_SB(0, 0), cB, voffB); PG8_STAGE(PG8_SA(0, 0), cA, voffA); PG8_STAGE(PG8_SB(0, 1), cB + hstep, voffB); PG8_STAGE(PG8_SA(0, 1), cA + hstep, voffA);
    if (wr == 1) PG8_BAR;
    PG8_WAIT_V(4); PG8_BAR;
    PG8_STAGE(PG8_SB(1, 0), cB + kstep, voffB); PG8_STAGE(PG8_SA(1, 0), cA + kstep, voffA); PG8_STAGE(PG8_SB(1, 1), cB + hstep + kstep, voffB);
    PG8_WAIT_V(6); PG8_BAR;
    for (;;) {
        const bool has_next = S.next(ui + 1, nxt);
        const char* nA = has_next ? (const char*)g.A + (size_t)nxt.pm * tstep : cA; const char* nB = has_next ? (const char*)g.Bt + (size_t)nxt.pn * tstep : cB;
        for (int t = 0; t < nt; t += 2) {
            const bool last = (t == nt - 2);
            const char* a1 = cA + (size_t)(t + 1) * kstep;
            const char* a2 = last ? nA : cA + (size_t)(t + 2) * kstep; const char* b2 = last ? nB : cB + (size_t)(t + 2) * kstep;
            const char* a3 = a2 + kstep; const char* b3 = b2 + kstep;
            if (last && has_next) S.a_ready(nxt);
            PG8_LDB(B0, 0, 0); PG8_SCHED; PG8_LDA(At, 0, 0); PG8_STAGE(PG8_SA(1, 1), a1 + hstep, voffA);
            PG8_WAIT_L(8); PG8_BAR; PG8_WAIT_L(0); PG8_MMA(0, 0, At, B0); PG8_BAR; PG8_SCHED;
            PG8_LDB(B1, 0, 1); PG8_STAGE(PG8_SB(0, 0), b2, voffB);
            PG8_BAR; PG8_WAIT_L(0); PG8_MMA(0, 1, At, B1); PG8_BAR;
            PG8_LDA(At, 0, 1); PG8_STAGE(PG8_SA(0, 0), a2, voffA);
            PG8_BAR; PG8_WAIT_L(0); PG8_MMA(1, 0, At, B0); PG8_BAR; PG8_SCHED;
            PG8_STAGE(PG8_SB(0, 1), b2 + hstep, voffB);
            PG8_WAIT_V(6); PG8_BAR; PG8_MMA(1, 1, At, B1); PG8_BAR;
            PG8_LDB(B0, 1, 0); PG8_SCHED; PG8_LDA(At, 1, 0); PG8_STAGE(PG8_SA(0, 1), a2 + hstep, voffA);
            PG8_WAIT_L(8); PG8_BAR; PG8_WAIT_L(0); PG8_MMA(0, 0, At, B0); PG8_BAR; PG8_SCHED;
            PG8_LDB(B1, 1, 1); PG8_STAGE(PG8_SB(1, 0), b3, voffB);
            PG8_BAR; PG8_WAIT_L(0); PG8_MMA(0, 1, At, B1); PG8_BAR;
            PG8_LDA(At, 1, 1); PG8_STAGE(PG8_SA(1, 0), a3, voffA);
            PG8_BAR; PG8_WAIT_L(0); PG8_MMA(1, 0, At, B0); PG8_BAR; PG8_SCHED;
            PG8_STAGE(PG8_SB(1, 1), b3 + hstep, voffB);
            PG8_WAIT_V(6); PG8_BAR; PG8_MMA(1, 1, At, B1); PG8_BAR;
        }
        if constexpr (!Epi::AFTER_DRAIN) { E(acc, cur, wr, wc, fr, fq); S.done(cur); }
        if (!has_next) break;
#pragma unroll
        for (int a = 0; a < 2; ++a)
#pragma unroll
            for (int b = 0; b < 2; ++b)
#pragma unroll
                for (int m = 0; m < 4; ++m)
#pragma unroll
                    for (int n = 0; n < 2; ++n) acc[a][b][m][n] = (f32x4){0.f, 0.f, 0.f, 0.f};
        cur = nxt; cA = nA; cB = nB; ++ui;
    }
    PG8_WAIT_V(0);
    if (wr == 0) PG8_BAR;
    PG8_BAR;
    if constexpr (Epi::AFTER_DRAIN) { E.fused(acc, cur, wr, wc, fr, fq, lds, wid, lane); S.done(cur); }
#undef PG8_SA
#undef PG8_SB
#undef PG8_STAGE
#undef PG8_LDA
#undef PG8_LDB
#undef PG8_MMA
#undef PG8_WAIT_V
#undef PG8_WAIT_L
#undef PG8_BAR
#undef PG8_SCHED
}
}
using pg8::Unit;

struct EpiIn {
    static constexpr bool AFTER_DRAIN = false;
    bf16_t* proj; float* out; float* dtb; const float* dt_bias; int l;
    __device__ __forceinline__ void operator()(const f32x4 (&acc)[2][2][4][2], const Unit& u, int wr, int wc, int fr_, int fq_) const {
        int fr = fr_, fq = fq_; asm volatile("" : "+v"(fr), "+v"(fq));
#pragma unroll
        for (int bj = 0; bj < 2; ++bj) {
            const int cb = u.pn * 256 + bj * 128;
            const int col = cb + wc * 32 + fq * 8;
            if (cb > C_DT) continue;
#pragma unroll
            for (int ai = 0; ai < 2; ++ai)
#pragma unroll
                for (int m = 0; m < 4; ++m) {
                    const int row = u.pm * 256 + ai * 128 + wr * 64 + m * 16 + fr;
                    const bool isP = row < T_P; int b, t;
                    if (isP) { b = row >> 13; t = row & 8191; } else { b = (row - T_P) >> 6; t = row & 63; }
                    f32x4 v0 = acc[ai][bj][m][0], v1 = acc[ai][bj][m][1];
                    if (cb < C_U) {
                        u32x4 w; { const u32x2 a = pack4(v0), c = pack4(v1); w.x = a.x; w.y = a.y; w.z = c.x; w.w = c.y; }
                        *(u32x4*)(proj + (size_t)row * NPROJ + col) = w;
                        if (cb >= C_K && cb < C_Z) {
                            const int isv = cb >= C_V; const int cc = col - (isv ? C_V : C_K);
                            float* o = nullptr;
                            if (isP) { if (t >= 7680) o = out + (isv ? O_PV : O_PK) + ((size_t)(l * 4 + b) * 512 + (t - 7680)) * 384 + cc; }
                            else o = out + (isv ? O_SV : O_SK) + ((size_t)(l * 32 + b) * 64 + t) * 384 + cc;
                            if (o) { *(f32x4*)o = v0; *(f32x4*)(o + 4) = v1; }
                        } else if (cb >= C_XBC) {
                            const int cc = col - C_XBC; float* o = nullptr;
                            if (isP) { if (t >= 8189) o = out + O_PC + ((size_t)(l * 4 + b) * 3 + (t - 8189)) * 896 + cc; }
                            else if (t >= 61) o = out + O_SC + ((size_t)(l * 32 + b) * 3 + (t - 61)) * 896 + cc;
                            if (o) { *(f32x4*)o = v0; *(f32x4*)(o + 4) = v1; }
                        }
                    } else if (cb < C_DT) {
#pragma unroll
                        for (int j = 0; j < 4; ++j) { v0[j] = gelu_tanh(v0[j]); v1[j] = gelu_tanh(v1[j]); }
                        u32x4 w; { const u32x2 a = pack4(v0), c = pack4(v1); w.x = a.x; w.y = a.y; w.z = c.x; w.w = c.y; }
                        *(u32x4*)(proj + (size_t)row * NPROJ + col) = w;
                        if (cb >= C_VC && !isP) { float* o = out + O_SG + ((size_t)(l * 32 + b) * 64 + t) * 256 + (col - C_VC); *(f32x4*)o = v0; *(f32x4*)(o + 4) = v1; }
                    } else if (col == C_DT) {
                        float* d = dtb + (size_t)row * 8;
#pragma unroll
                        for (int j = 0; j < 4; ++j) d[j] = softplus_f(v0[j] + dt_bias[l * 6 + j]);
#pragma unroll
                        for (int j = 0; j < 2; ++j) d[4 + j] = softplus_f(v1[j] + dt_bias[l * 6 + 4 + j]);
                    }
                    asm volatile("" ::: "memory");
                }
        }
    }
};
struct EpiNull {
    static constexpr bool AFTER_DRAIN = false;
    float* sink;
    __device__ __forceinline__ void operator()(const f32x4 (&acc)[2][2][4][2], const Unit& u, int wr, int wc, int fr, int fq) const {
        float t = 0.f;
#pragma unroll
        for (int ai = 0; ai < 2; ++ai)
#pragma unroll
            for (int bj = 0; bj < 2; ++bj)
#pragma unroll
                for (int m = 0; m < 4; ++m)
#pragma unroll
                    for (int n = 0; n < 2; ++n) t += acc[ai][bj][m][n][0] + acc[ai][bj][m][n][1] + acc[ai][bj][m][n][2] + acc[ai][bj][m][n][3];
        if (t == 123456.789f) sink[0] = t;
    }
};
struct EpiRes {
    static constexpr bool AFTER_DRAIN = false;
    float* x; const bf16_t* xb;
    __device__ __forceinline__ void operator()(const f32x4 (&acc)[2][2][4][2], const Unit& u, int wr, int wc, int fr_, int fq_) const {
        int fr = fr_, fq = fq_; asm volatile("" : "+v"(fr), "+v"(fq));
#pragma unroll
        for (int ai = 0; ai < 2; ++ai)
#pragma unroll
            for (int m = 0; m < 4; ++m) {
                float* rowp = x + (size_t)(u.pm * 256 + ai * 128 + wr * 64 + m * 16 + fr) * DM + u.pn * 256 + wc * 32 + fq * 8;
#pragma unroll
                for (int bj = 0; bj < 2; ++bj) { float* q = rowp + bj * 128; const u32x4 xw = *(const u32x4*)(xb + (q - x));
                    const f32x4 o0 = unpack4((u32x2){xw.x, xw.y}), o1 = unpack4((u32x2){xw.z, xw.w});
                    *(f32x4*)q = o0 * ALPHA + acc[ai][bj][m][0]; *(f32x4*)(q + 4) = o1 * ALPHA + acc[ai][bj][m][1]; }
                asm volatile("" ::: "memory");
            }
    }
};
struct EpiUp {
    static constexpr bool AFTER_DRAIN = true;
    bf16_t* H; float* halo; float* out; const float* cw; const float* cb; const float* fstate; int l;
    __device__ __forceinline__ void operator()(const f32x4 (&)[2][2][4][2], const Unit&, int, int, int, int) const {}
    __device__ __forceinline__ void fused(f32x4 (&acc)[2][2][4][2], const Unit& u, int wr, int wc, int fr, int fq, LAS unsigned char* lds, int wid, int lane) const {
        constexpr int LS = 264;
#pragma unroll
        for (int ai = 0; ai < 2; ++ai)
#pragma unroll
            for (int m = 0; m < 4; ++m)
#pragma unroll
                for (int bj = 0; bj < 2; ++bj) {
                        const int rl = ai * 128 + wr * 64 + m * 16 + fr, cl = bj * 128 + wc * 32 + fq * 8;
                        u32x4 w; { const u32x2 a = pack4(acc[ai][bj][m][0]), c = pack4(acc[ai][bj][m][1]); w.x = a.x; w.y = a.y; w.z = c.x; w.w = c.y; }
                        *(LAS u32x4*)(lds + (rl * LS + cl) * 2) = w;
                    }
        __syncthreads();
        const int tid = wid * 64 + lane, j = tid & 127, seg = tid >> 7;
        const int hcol = u.pn * 128 + j;
        const float* w = cw + (size_t)l * 3 * DFF2; const float* bb = cb + (size_t)l * DFF2;
        const float wg0 = w[hcol], wg1 = w[DFF2 + hcol], wg2 = w[2 * DFF2 + hcol], bg = bb[hcol];
        const float wv0 = w[DFF + hcol], wv1 = w[DFF2 + DFF + hcol], wv2 = w[2 * DFF2 + DFF + hcol], bv = bb[DFF + hcol];
        const int R = u.pm * 256 + seg * 64;
        const bool isP = R < T_P;
        float g2 = 0.f, g1 = 0.f, v2 = 0.f, v1 = 0.f; int skip = 0;
        const LAS bf16_t* U = (const LAS bf16_t*)lds;
        if (isP) {
            if (seg > 0) { g2 = bf2f(U[(seg * 64 - 2) * LS + j]); g1 = bf2f(U[(seg * 64 - 1) * LS + j]); v2 = bf2f(U[(seg * 64 - 2) * LS + 128 + j]); v1 = bf2f(U[(seg * 64 - 1) * LS + 128 + j]); }
            else if ((R & 8191) != 0) skip = 2;
        } else {
            const int sb = (R - T_P) >> 6; const float* fs = fstate + (size_t)(l * 32 + sb) * 2 * DFF2;
            g2 = fs[hcol]; g1 = fs[DFF2 + hcol]; v2 = fs[DFF + hcol]; v1 = fs[DFF2 + DFF + hcol];
        }
        bf16_t* hp = H + (size_t)R * DFF + hcol;
#pragma unroll 8
        for (int i = 0; i < 64; ++i) {
            const float gq = bf2f(U[(seg * 64 + i) * LS + j]), vq = bf2f(U[(seg * 64 + i) * LS + 128 + j]);
            if (i >= skip) {
                const float cgv = bg + wg0 * g2 + wg1 * g1 + wg2 * gq, cvv = bv + wv0 * v2 + wv1 * v1 + wv2 * vq;
                const float hv = silu_f(cgv) * cvv;
                hp[(size_t)i * DFF] = (bf16_t)(cvt_pk_bf16(hv, 0.f) & 0xffffu);
            }
            g2 = g1; g1 = gq; v2 = v1; v1 = vq;
            if (isP) {
                if (seg == 0 && i < 2) { float* hl = halo + ((size_t)u.pm * 4 + i) * DFF2; hl[hcol] = gq; hl[DFF + hcol] = vq; }
                if (seg == 3 && i >= 62) { float* hl = halo + ((size_t)u.pm * 4 + 2 + (i - 62)) * DFF2; hl[hcol] = gq; hl[DFF + hcol] = vq;
                    if ((u.pm & 31) == 31) { float* o = out + O_PF + ((size_t)(l * 4 + (u.pm >> 5)) * 2 + (i - 62)) * DFF2; o[hcol] = gq; o[DFF + hcol] = vq; } }
            } else if (i >= 62) {
                const int sb = (R - T_P) >> 6; float* o = out + O_SF + ((size_t)(l * 32 + sb) * 2 + (i - 62)) * DFF2; o[hcol] = gq; o[DFF + hcol] = vq;
            }
        }
    }
};

template <int CTRL> __device__ __forceinline__ float dppz(float x) { return __builtin_bit_cast(float, __builtin_amdgcn_update_dpp(0, __builtin_bit_cast(int, x), CTRL, 0xf, 0xf, true)); }
struct EpiUp2 {
    static constexpr bool AFTER_DRAIN = false;
    bf16_t* H; float* halo; float* out; const float* cw; const float* cb; const float* fstate; int l; LAS unsigned char* lds;
    __device__ __forceinline__ void operator()(const f32x4 (&acc)[2][2][4][2], const Unit& u, int wr, int wc, int fr_, int fq_) const {
        int fr = fr_, fq = fq_; asm volatile("" : "+v"(fr), "+v"(fq));
        const int hcol = u.pn * 128 + wc * 32 + fq * 8;
        const float* w = cw + (size_t)l * 3 * DFF2 + hcol; const float* bb = cb + (size_t)l * DFF2 + hcol;
        LAS f32x4* wl = (LAS f32x4*)(lds + 131072 + (wc * 4 + fq) * 256);
#pragma unroll
        for (int sd = 0; sd < 2; ++sd)
#pragma unroll
            for (int hf = 0; hf < 2; ++hf) { wl[(sd * 2 + hf) * 4 + 3] = *(const f32x4*)(bb + sd * DFF + hf * 4);
#pragma unroll
                for (int tp = 0; tp < 3; ++tp) wl[(sd * 2 + hf) * 4 + tp] = *(const f32x4*)(w + tp * DFF2 + sd * DFF + hf * 4); }
        asm volatile("s_waitcnt lgkmcnt(0)" ::: "memory");
#pragma unroll
        for (int ai = 0; ai < 2; ++ai) {
            const int R = u.pm * 256 + ai * 128 + wr * 64, blk = R >> 6;
            const bool isP = R < T_P, seqstart = isP ? ((R & 8191) == 0) : true;
            f32x4 Xp[2][2];
#pragma unroll
            for (int sd = 0; sd < 2; ++sd)
#pragma unroll
                for (int hf = 0; hf < 2; ++hf) Xp[sd][hf] = (f32x4){0.f, 0.f, 0.f, 0.f};
            if (!isP && fr >= 14) { const float* fs = fstate + ((size_t)(l * 32 + (blk - 512)) * 2 + (fr - 14)) * DFF2 + hcol;
#pragma unroll
                for (int sd = 0; sd < 2; ++sd)
#pragma unroll
                    for (int hf = 0; hf < 2; ++hf) Xp[sd][hf] = *(const f32x4*)(fs + sd * DFF + hf * 4); }
#pragma unroll
            for (int m = 0; m < 4; ++m) {
                f32x4 cv[2][2];
#pragma unroll
                for (int sd = 0; sd < 2; ++sd)
#pragma unroll
                    for (int hf = 0; hf < 2; ++hf)
                    { const f32x4 w0 = wl[(sd * 2 + hf) * 4 + 0], w1 = wl[(sd * 2 + hf) * 4 + 1], w2 = wl[(sd * 2 + hf) * 4 + 2], b3 = wl[(sd * 2 + hf) * 4 + 3];
#pragma unroll
                        for (int j = 0; j < 4; ++j) {
                            const float x = acc[ai][sd][m][hf][j], xp = Xp[sd][hf][j];
                            float c = b3[j] + w2[j] * x;
                            c += w1[j] * dppz<0x111>(x); c += w1[j] * dppz<0x10F>(xp); c += w0[j] * dppz<0x112>(x); c += w0[j] * dppz<0x10E>(xp);
                            cv[sd][hf][j] = c;
                        } }
                f32x4 h0, h1;
#pragma unroll
                for (int j = 0; j < 4; ++j) { h0[j] = silu_f(cv[0][0][j]) * cv[1][0][j]; h1[j] = silu_f(cv[0][1][j]) * cv[1][1][j]; }
                const int row = R + m * 16 + fr;
                if (!(m == 0 && fr < 2 && !seqstart)) { u32x4 pk; { const u32x2 a = pack4(h0), c = pack4(h1); pk.x = a.x; pk.y = a.y; pk.z = c.x; pk.w = c.y; }
                    *(u32x4*)(H + (size_t)row * DFF + hcol) = pk; }
                float* sv = nullptr; float* sv2 = nullptr;
                if (isP) { if (m == 0 && fr < 2) sv = halo + ((size_t)blk * 4 + fr) * DFF2 + hcol;
                           if (m == 3 && fr >= 14) { sv = halo + ((size_t)blk * 4 + 2 + (fr - 14)) * DFF2 + hcol; if ((blk & 127) == 127) sv2 = out + O_PF + ((size_t)(l * 4 + (blk >> 7)) * 2 + (fr - 14)) * DFF2 + hcol; } }
                else if (m == 3 && fr >= 14) sv = out + O_SF + ((size_t)(l * 32 + (blk - 512)) * 2 + (fr - 14)) * DFF2 + hcol;
                if (sv) {
#pragma unroll
                    for (int sd = 0; sd < 2; ++sd)
#pragma unroll
                        for (int hf = 0; hf < 2; ++hf) { *(f32x4*)(sv + sd * DFF + hf * 4) = acc[ai][sd][m][hf]; if (sv2) *(f32x4*)(sv2 + sd * DFF + hf * 4) = acc[ai][sd][m][hf]; } }
#pragma unroll
                for (int sd = 0; sd < 2; ++sd)
#pragma unroll
                    for (int hf = 0; hf < 2; ++hf) Xp[sd][hf] = acc[ai][sd][m][hf];
                asm volatile("" ::: "memory");
            }
        }
    }
};

__device__ __forceinline__ void ln_row(const float* src, float* x32, bf16_t* xb, const float* g, const float* b, int lane) {
    f32x4 v[4]; float s = 0.f;
#pragma unroll
    for (int i = 0; i < 4; ++i) { v[i] = *(const f32x4*)(src + i * 256 + lane * 4); s += (v[i][0] + v[i][1]) + (v[i][2] + v[i][3]); }
#pragma unroll
    for (int o = 32; o >= 1; o >>= 1) s += __shfl_xor(s, o);
    const float mu = s * (1.0f / 1024.0f); float q = 0.f;
#pragma unroll
    for (int i = 0; i < 4; ++i) { const f32x4 d = v[i] - mu; q += (d[0] * d[0] + d[1] * d[1]) + (d[2] * d[2] + d[3] * d[3]); }
#pragma unroll
    for (int o = 32; o >= 1; o >>= 1) q += __shfl_xor(q, o);
    const float rstd = 1.0f / sqrtf(q * (1.0f / 1024.0f) + LN_EPS);
#pragma unroll
    for (int i = 0; i < 4; ++i) {
        const f32x4 gg = *(const f32x4*)(g + i * 256 + lane * 4), bb = *(const f32x4*)(b + i * 256 + lane * 4);
        const f32x4 o = (v[i] - mu) * rstd * gg + bb;
        if (x32) *(f32x4*)(x32 + i * 256 + lane * 4) = o;
        if (xb) *(u32x2*)(xb + i * 256 + lane * 4) = pack4(o);
    }
}

__device__ __forceinline__ void tr_tile(LAS float* tile, const float* src, int Nsrc, bf16_t* dst, int K, int n0, int k0, int mode, int tid) {
    const int nn = tid & 63, np = n0 + nn; int sc;
    if (mode == 0) sc = np < C_U ? np : (np < C_DT ? np + 6 : (np < C_DT + 6 ? np - 512 : -1));
    else if (mode == 1) sc = np;
    else { const int pn = np >> 8, jj = np & 255; sc = jj < 128 ? pn * 128 + jj : DFF + pn * 128 + (jj - 128); }
#pragma unroll
    for (int i = 0; i < 8; ++i) { const int kk = (tid >> 6) + 8 * i; tile[kk * 65 + nn] = sc >= 0 ? src[(size_t)(k0 + kk) * Nsrc + sc] : 0.f; }
    __syncthreads();
    const int kk2 = (tid & 31) * 2;
#pragma unroll
    for (int i = 0; i < 4; ++i) { const int nn2 = (tid >> 5) + 16 * i; *(unsigned*)(dst + (size_t)(n0 + nn2) * K + k0 + kk2) = cvt_pk_bf16(tile[kk2 * 65 + nn2], tile[(kk2 + 1) * 65 + nn2]); }
    __syncthreads();
}

__device__ __forceinline__ void phase_prep(KP& p, LAS unsigned char* lds) {
    int tid_ = threadIdx.x; asm volatile("" : "+v"(tid_));
    const int tid = tid_, wid = tid >> 6, lane = tid & 63;
    for (int row = blockIdx.x * 8 + wid; row < T_ALL; row += gridDim.x * 8) {
        const float* src = row < T_P ? p.in[0] + (size_t)row * DM : p.in[1] + (size_t)(row - T_P) * DM;
        ln_row(src, nullptr, (bf16_t*)(p.ws + W_XB) + (size_t)row * DM, p.in[7], p.in[8], lane);
    }
    constexpr int T_IN = 48 * 16, T_OUT = 16 * 16, T_UPT = 88 * 16, T_DNT = 16 * 44, T_L = T_IN + T_OUT + T_UPT + T_DNT;
    for (int it = blockIdx.x; it < 4 * T_L; it += gridDim.x) {
        const int l = it / T_L; int r = it % T_L;
        if (r < T_IN) tr_tile((LAS float*)lds, p.in[9] + (size_t)l * DM * 2950, 2950, (bf16_t*)(p.ws + W_IN + l * W_IN_L), DM, (r >> 4) * 64, (r & 15) * 64, 0, tid);
        else if ((r -= T_IN) < T_OUT) tr_tile((LAS float*)lds, p.in[19] + (size_t)l * DM * DM, DM, (bf16_t*)(p.ws + W_OUT + l * W_OUT_L), DM, (r >> 4) * 64, (r & 15) * 64, 1, tid);
        else if ((r -= T_OUT) < T_UPT) tr_tile((LAS float*)lds, p.in[22] + (size_t)l * DM * DFF2, DFF2, (bf16_t*)(p.ws + W_UP + l * W_UP_L), DM, (r >> 4) * 64, (r & 15) * 64, 2, tid);
        else { r -= T_UPT; tr_tile((LAS float*)lds, p.in[25] + (size_t)l * DFF * DM, DM, (bf16_t*)(p.ws + W_DN + l * W_DN_L), DFF, (r / 44) * 64, (r % 44) * 64, 1, tid); }
    }
    for (int i = blockIdx.x * 512 + tid; i < 4 * 4 * 128 * 128; i += gridDim.x * 512) {
        const int jj = i & 127, ii = (i >> 7) & 127;
        ((bf16_t*)(p.ws + W_GW))[i] = (bf16_t)(cvt_pk_bf16(jj <= ii ? p.in[16][i] : 0.f, 0.f) & 0xffffu);
    }
}

__device__ __forceinline__ void phase_ln(KP& p, const float* g, const float* b, bool final_out) {
    int tid_ = threadIdx.x; asm volatile("" : "+v"(tid_));
    const int wid = tid_ >> 6, lane = tid_ & 63;
    for (int row = blockIdx.x * 8 + wid; row < T_ALL; row += gridDim.x * 8)
        ln_row(p.out + (size_t)row * DM, final_out ? p.out + (size_t)row * DM : nullptr, final_out ? nullptr : (bf16_t*)(p.ws + W_XB) + (size_t)row * DM, g, b, lane);
}

__device__ __forceinline__ void dt_scan(KP& p, int l, int u, int g, int wid, int lane, float& dt, float& ac, float& last) {
    const int h = g * 3 + wid;
    dt = ((const float*)(p.ws + W_DTB))[(size_t)(u * 64 + lane) * 8 + h];
    const float a = -__expf(p.in[14][l * 6 + h]);
    float v = dt * a;
#pragma unroll
    for (int o = 1; o < 64; o <<= 1) { const float t = __shfl_up(v, o); if (lane >= o) v += t; }
    ac = v; last = __shfl(v, 63);
}

__device__ __forceinline__ f32x4 xbc_row(KP& p, int l, int u, int s, int ch) {
    const bf16_t* proj = (const bf16_t*)(p.ws + W_PROJ);
    const bool isP = u < 512; const bool hasprev = isP && (u & 127) != 0;
    if (s >= 0 || hasprev) return unpack4(*(const u32x2*)(proj + (size_t)(u * 64 + s) * NPROJ + C_XBC + ch));
    if (!isP) return *(const f32x4*)(p.in[5] + (unsigned)(((l * 32 + (u - 512)) * 3 + (3 + s)) * 896 + ch));
    return (f32x4){0.f, 0.f, 0.f, 0.f};
}
__device__ __forceinline__ void ssd_states(KP& p, LAS unsigned char* lds, int l, int u) {
    int tid_ = threadIdx.x; asm volatile("" : "+v"(tid_));
    const int tid = tid_, wid = tid >> 6, lane = tid & 63, fr = lane & 15, fq = lane >> 4;
    LAS bf16_t* xT = (LAS bf16_t*)lds;
    LAS bf16_t* BT = (LAS bf16_t*)(lds + 55296);
    LAS float* wgt = (LAS float*)(lds + 92160);
    bf16_t* XC = (bf16_t*)p.out;
    __syncthreads();
    if (wid < 6) {
        float dt, ac, last; dt_scan(p, l, u, wid / 3, wid % 3, lane, dt, ac, last);
        wgt[wid * 64 + lane] = dt * __expf(last - ac);
        if (lane == 0) ((float*)(p.ws + W_CD))[u * 8 + wid] = __expf(last);
    }
    __syncthreads();
    if (tid < 448) {
        const int cgp = tid % 224, seg = tid / 224, ch = cgp * 4, r0 = seg * 32;
        const float* cw = p.in[11] + (size_t)l * 4 * 896 + ch;
        const f32x4 w0 = *(const f32x4*)cw, w1 = *(const f32x4*)(cw + 896), w2 = *(const f32x4*)(cw + 2 * 896), w3 = *(const f32x4*)(cw + 3 * 896);
        const f32x4 bs = *(const f32x4*)(p.in[12] + (size_t)l * 896 + ch);
        f32x4 xm3 = xbc_row(p, l, u, r0 - 3, ch), xm2 = xbc_row(p, l, u, r0 - 2, ch), xm1 = xbc_row(p, l, u, r0 - 1, ch);
        const bf16_t* src = (const bf16_t*)(p.ws + W_PROJ) + (size_t)(u * 64) * NPROJ + C_XBC + ch;
        bf16_t* dst = XC + (size_t)(u * 64) * 896 + ch;
        const int hh = ch >> 6;
#pragma unroll 2
        for (int i = r0; i < r0 + 32; i += 2) {
            const f32x4 xa = unpack4(*(const u32x2*)(src + (size_t)i * NPROJ)), xb = unpack4(*(const u32x2*)(src + (size_t)(i + 1) * NPROJ));
            f32x4 ya = bs + w0 * xm3 + w1 * xm2 + w2 * xm1 + w3 * xa, yb = bs + w0 * xm2 + w1 * xm1 + w2 * xa + w3 * xb;
#pragma unroll
            for (int e = 0; e < 4; ++e) { ya[e] = silu_f(ya[e]); yb[e] = silu_f(yb[e]); }
            xm3 = xm1; xm2 = xa; xm1 = xb;
            *(u32x2*)(dst + (size_t)i * 896) = pack4(ya); *(u32x2*)(dst + (size_t)(i + 1) * 896) = pack4(yb);
            if (ch < 384) { const float wa = wgt[hh * 64 + i], wb = wgt[hh * 64 + i + 1];
#pragma unroll
                for (int e = 0; e < 4; ++e) *(LAS unsigned*)(xT + (ch + e) * 72 + i) = cvt_pk_bf16(ya[e] * wa, yb[e] * wb); }
            else if (ch < 640) {
#pragma unroll
                for (int e = 0; e < 4; ++e) *(LAS unsigned*)(BT + (ch - 384 + e) * 72 + i) = cvt_pk_bf16(ya[e], yb[e]); }
        }
    }
    __syncthreads();
    bf16_t* ST = (bf16_t*)(p.ws + W_ST);
#pragma unroll 2
    for (int k = 0; k < 24; ++k) {
        const int tt = wid * 24 + k, h = tt >> 5, pt = (tt & 31) >> 3, nt = tt & 7, g = h / 3;
        f32x4 acc = (f32x4){0.f, 0.f, 0.f, 0.f};
#pragma unroll
        for (int ks = 0; ks < 2; ++ks) {
            const bf16x8 rf = ldsfrag((LAS const unsigned char*)(xT + (h * 64 + pt * 16 + fr) * 72 + ks * 32 + fq * 8));
            const bf16x8 cf = ldsfrag((LAS const unsigned char*)(BT + (g * 128 + nt * 16 + fr) * 72 + ks * 32 + fq * 8));
            acc = MFMA16(cf, rf, acc);
        }
        *(u32x2*)(ST + ((size_t)(u * 6 + h) * 64 + pt * 16 + fr) * 128 + nt * 16 + fq * 4) = pack4(acc);
    }
}

__device__ __forceinline__ void gmlp_unit(KP& p, LAS unsigned char* lds, int l, int u) {
    int tid_ = threadIdx.x; asm volatile("" : "+v"(tid_));
    const int tid = tid_, wid = tid >> 6, lane = tid & 63, fr = lane & 15, fq = lane >> 4;
    LAS bf16_t* vT = (LAS bf16_t*)lds;
    LAS float* ssq = (LAS float*)(lds + 69632);
    const bf16_t* proj = (const bf16_t*)(p.ws + W_PROJ);
    const int half = u < 512 ? (u & 1) : 0, KJ = (half + 1) * 64, R0 = u * 64, Rb = R0 - half * 64;
    __syncthreads();
    for (int idx = tid; idx < KJ * 32; idx += 512) {
        const int j = idx & (KJ - 1), cgp = idx / KJ;
        const u32x4 w = *(const u32x4*)(proj + (size_t)(Rb + j) * NPROJ + C_VC + cgp * 8);
        const unsigned ww[4] = {w.x, w.y, w.z, w.w};
#pragma unroll
        for (int e = 0; e < 4; ++e) { vT[(cgp * 8 + 2 * e) * 136 + j] = (bf16_t)(ww[e] & 0xffffu); vT[(cgp * 8 + 2 * e + 1) * 136 + j] = (bf16_t)(ww[e] >> 16); }
    }
    __syncthreads();
    const int rt = wid & 3, cbase = (wid >> 2) * 8;
    const bf16_t* GW = (const bf16_t*)(p.ws + W_GW + l * W_GW_L);
    f32x4 acc[8];
#pragma unroll
    for (int gi = 0; gi < 2; ++gi) {
        const int gg = (cbase >> 2) + gi;
        bf16x8 rf[4];
#pragma unroll
        for (int ks = 0; ks < 4; ++ks) rf[ks] = glbfrag(GW + ((size_t)gg * 128 + half * 64 + rt * 16 + fr) * 128 + ks * 32 + fq * 8);
#pragma unroll
        for (int c4 = 0; c4 < 4; ++c4) {
            const int ct = cbase + gi * 4 + c4;
            f32x4 a = (f32x4){0.f, 0.f, 0.f, 0.f};
#pragma unroll
            for (int ks = 0; ks < 4; ++ks) if (ks * 32 < KJ) a = MFMA16(ldsfrag((LAS const unsigned char*)(vT + (ct * 16 + fr) * 136 + ks * 32 + fq * 8)), rf[ks], a);
            acc[gi * 4 + c4] = a;
        }
    }
    const int row = R0 + rt * 16 + fr; float sq = 0.f;
#pragma unroll
    for (int k = 0; k < 8; ++k) {
        const int col = (cbase + k) * 16 + fq * 4, gg = col >> 6;
        const float bsv = p.in[17][(size_t)(l * 4 + gg) * 128 + half * 64 + rt * 16 + fr];
        const f32x4 uv = unpack4(*(const u32x2*)(proj + (size_t)row * NPROJ + C_U + col));
        f32x4 o = uv * (acc[k] + bsv); acc[k] = o;
        sq += (o[0] * o[0] + o[1] * o[1]) + (o[2] * o[2] + o[3] * o[3]);
    }
    sq += __shfl_xor(sq, 16); sq += __shfl_xor(sq, 32);
    if (fq == 0) ssq[(wid >> 2) * 64 + rt * 16 + fr] = sq;
    __syncthreads();
    const float rstd = 1.0f / sqrtf((ssq[rt * 16 + fr] + ssq[64 + rt * 16 + fr]) * (1.0f / 256.0f) + RMS_EPS);
    bf16_t* mix = (bf16_t*)(p.ws + W_MIX);
#pragma unroll
    for (int k = 0; k < 8; ++k) {
        const int col = (cbase + k) * 16 + fq * 4;
        const f32x4 gv = *(const f32x4*)(p.in[18] + (size_t)l * 1024 + 768 + col);
        *(u32x2*)(mix + (size_t)row * DM + 768 + col) = pack4(acc[k] * rstd * gv);
    }
}

__device__ __forceinline__ void scan_prompt(KP& p, int l, int item) {
    int tid_ = threadIdx.x; asm volatile("" : "+v"(tid_));
    const int gid = item * 512 + tid_, e = (gid & 2047) * 4, bh = gid >> 11, b = bh / 6, h = bh % 6;
    bf16_t* ST = (bf16_t*)(p.ws + W_ST); const float* CD = (const float*)(p.ws + W_CD);
    f32x4 st = (f32x4){0.f, 0.f, 0.f, 0.f};
#pragma unroll 1
    for (int c0 = 0; c0 < 128; c0 += 8) {
        u32x2 s[8]; float cd[8];
#pragma unroll
        for (int k = 0; k < 8; ++k) { const int u = b * 128 + c0 + k; s[k] = *(const u32x2*)(ST + ((size_t)(u * 6 + h)) * 8192 + e); cd[k] = CD[u * 8 + h]; }
#pragma unroll
        for (int k = 0; k < 8; ++k) { const int u = b * 128 + c0 + k; *(u32x2*)(ST + ((size_t)(u * 6 + h)) * 8192 + e) = pack4(st); st = st * cd[k] + unpack4(s[k]); }
    }
    *(f32x4*)(p.out + O_PH + ((size_t)(l * 4 + b) * 6 + h) * 8192 + e) = st;
}
__device__ __forceinline__ void scan_sample(KP& p, int l, int item) {
    int tid_ = threadIdx.x; asm volatile("" : "+v"(tid_));
    const int gid = item * 512 + tid_, e = (gid & 2047) * 4, sbh = gid >> 11, sb = sbh / 6, h = sbh % 6;
    bf16_t* ST = (bf16_t*)(p.ws + W_ST); const float* CD = (const float*)(p.ws + W_CD);
    const int u = 512 + sb;
    const f32x4 st = *(const f32x4*)(p.in[4] + ((size_t)(l * 32 + sb) * 6 + h) * 8192 + e);
    const f32x4 s = unpack4(*(const u32x2*)(ST + ((size_t)(u * 6 + h)) * 8192 + e));
    *(u32x2*)(ST + ((size_t)(u * 6 + h)) * 8192 + e) = pack4(st);
    *(f32x4*)(p.out + O_SH + ((size_t)(l * 32 + sb) * 6 + h) * 8192 + e) = st * CD[u * 8 + h] + s;
}

__device__ __forceinline__ void attn_unit(KP& p, LAS unsigned char* lds, int l, int u) {
    int tid_ = threadIdx.x; asm volatile("" : "+v"(tid_));
    const int tid = tid_, wid = tid >> 6, lane = tid & 63, fr = lane & 15, fq = lane >> 4;
    LAS bf16_t* Kb = (LAS bf16_t*)lds;
    LAS bf16_t* VT = (LAS bf16_t*)(lds + 50176);
    LAS bf16_t* Pw = (LAS bf16_t*)(lds + 105472) + wid * 16 * 72;
    LAS float* bias = (LAS float*)(lds + 123904);
    LAS float* ssq = (LAS float*)(lds + 128512);
    const bf16_t* proj = (const bf16_t*)(p.ws + W_PROJ);
    const bool isP = u < 512; const int R0 = u * 64, c = u & 127, b = u >> 7, sb = u - 512;
    const int qt = wid & 3, hbase = (wid >> 2) * 3;
    __syncthreads();
    for (int i = tid; i < 1152; i += 512) bias[i] = p.in[10][(size_t)l * 1152 + i];
    bf16x8 qf[3][2];
#pragma unroll
    for (int hh = 0; hh < 3; ++hh)
#pragma unroll
        for (int ks = 0; ks < 2; ++ks) qf[hh][ks] = glbfrag(proj + (size_t)(R0 + qt * 16 + fr) * NPROJ + (hbase + hh) * 64 + ks * 32 + fq * 8);
    float mrun[3], lrun[3]; f32x4 O[3][4];
#pragma unroll
    for (int hh = 0; hh < 3; ++hh) { mrun[hh] = -1e30f; lrun[hh] = 0.f;
#pragma unroll
        for (int d = 0; d < 4; ++d) O[hh][d] = (f32x4){0.f, 0.f, 0.f, 0.f}; }
    const int blk_lo = isP ? (c < 8 ? 8 - c : 0) : 0;
    u32x4 kr[6], vr[6];
    const int kkey0 = tid / 48, kcg = tid % 48;
    const int vkp = tid & 31, vcg0 = tid >> 5;
#define ATT_LOADP(blkv) do { const size_t rb_ = isP ? (size_t)b * 8192 + (size_t)(c - 8 + (blkv)) * 64 : (size_t)T_P + (size_t)sb * 64; \
        _Pragma("unroll") for (int it = 0; it < 3; ++it) { const int idx = it * 512 + tid; kr[it] = *(const u32x4*)(proj + (rb_ + idx / 48) * NPROJ + C_K + (idx % 48) * 8); } \
        _Pragma("unroll") for (int it = 0; it < 3; ++it) { const int cg_ = vcg0 + it * 16; \
            vr[2 * it] = *(const u32x4*)(proj + (rb_ + 2 * vkp) * NPROJ + C_V + cg_ * 8); vr[2 * it + 1] = *(const u32x4*)(proj + (rb_ + 2 * vkp + 1) * NPROJ + C_V + cg_ * 8); } } while (0)
    bool have = false;
    if (isP || blk_lo == 8) { ATT_LOADP(blk_lo); have = true; }
#pragma unroll 1
    for (int blk = blk_lo; blk <= 8; ++blk) {
        __syncthreads();
        if (!have) {
#pragma unroll
            for (int it = 0; it < 6; ++it) { const int idx = it * 512 + tid;
                const float* s = p.in[2] + ((size_t)(l * 32 + sb) * 512 + blk * 64 + idx / 48) * 384 + (idx % 48) * 8; const f32x4 a = *(const f32x4*)s, bq = *(const f32x4*)(s + 4);
                kr[it].x = cvt_pk_bf16(a[0], a[1]); kr[it].y = cvt_pk_bf16(a[2], a[3]); kr[it].z = cvt_pk_bf16(bq[0], bq[1]); kr[it].w = cvt_pk_bf16(bq[2], bq[3]); }
#pragma unroll
            for (int it = 0; it < 6; ++it) { const int cg_ = vcg0 + (it >> 1) * 16;
                const float* s = p.in[3] + ((size_t)(l * 32 + sb) * 512 + blk * 64 + 2 * vkp + (it & 1)) * 384 + cg_ * 8; const f32x4 a = *(const f32x4*)s, bq = *(const f32x4*)(s + 4);
                vr[it].x = cvt_pk_bf16(a[0], a[1]); vr[it].y = cvt_pk_bf16(a[2], a[3]); vr[it].z = cvt_pk_bf16(bq[0], bq[1]); vr[it].w = cvt_pk_bf16(bq[2], bq[3]); }
        }
        if (have) { const size_t rb_ = isP ? (size_t)b * 8192 + (size_t)(c - 8 + blk) * 64 : (size_t)T_P + (size_t)sb * 64;
#pragma unroll
            for (int it = 3; it < 6; ++it) { const int idx = it * 512 + tid; kr[it] = *(const u32x4*)(proj + (rb_ + idx / 48) * NPROJ + C_K + (idx % 48) * 8); } }
#pragma unroll
        for (int it = 0; it < 3; ++it) { const int cg_ = vcg0 + it * 16; const u32x4 w0 = vr[2 * it], w1 = vr[2 * it + 1];
            const unsigned a0[4] = {w0.x, w0.y, w0.z, w0.w}, a1[4] = {w1.x, w1.y, w1.z, w1.w};
#pragma unroll
            for (int e = 0; e < 4; ++e) {
                *(LAS unsigned*)(VT + (cg_ * 8 + 2 * e) * 72 + 2 * vkp) = (a0[e] & 0xffffu) | (a1[e] << 16);
                *(LAS unsigned*)(VT + (cg_ * 8 + 2 * e + 1) * 72 + 2 * vkp) = (a0[e] >> 16) | (a1[e] & 0xffff0000u); } }
#pragma unroll
        for (int it = 0; it < 6; ++it) { const int idx = it * 512 + tid; *(LAS u32x4*)(Kb + (idx / 48) * 392 + (idx % 48) * 8) = kr[it]; }
        __syncthreads();
        have = false;
        if (blk < 8 && (isP || blk == 7)) { ATT_LOADP(blk + 1); have = true; }
#pragma unroll
        for (int hh = 0; hh < 3; ++hh) {
            const int h = hbase + hh;
            f32x4 s[4]; float mx = -1e30f;
#pragma unroll
            for (int kt = 0; kt < 4; ++kt) {
                f32x4 a = (f32x4){0.f, 0.f, 0.f, 0.f};
#pragma unroll
                for (int ks = 0; ks < 2; ++ks) a = MFMA16(ldsfrag((LAS const unsigned char*)(Kb + (kt * 16 + fr) * 392 + h * 64 + ks * 32 + fq * 8)), qf[hh][ks], a);
                if (blk <= 5) { const float bc = bias[h * 192 + 191];
#pragma unroll
                    for (int j = 0; j < 4; ++j) { a[j] = a[j] * 0.125f + bc; mx = fmaxf(mx, a[j]); } }
                else {
#pragma unroll
                    for (int j = 0; j < 4; ++j) {
                        int rel = (qt * 16 + fr) + 512 - (blk * 64 + kt * 16 + fq * 4 + j); rel = rel > 128 ? 128 : rel;
                        a[j] = a[j] * 0.125f + bias[h * 192 + rel + 63]; mx = fmaxf(mx, a[j]);
                    } }
                s[kt] = a;
            }
            mx = fmaxf(mx, __shfl_xor(mx, 16)); mx = fmaxf(mx, __shfl_xor(mx, 32));
            const float mnew = fmaxf(mrun[hh], mx), fac = __expf(mrun[hh] - mnew); mrun[hh] = mnew;
            float rs = 0.f;
#pragma unroll
            for (int kt = 0; kt < 4; ++kt) {
#pragma unroll
                for (int j = 0; j < 4; ++j) { s[kt][j] = __expf(s[kt][j] - mnew); rs += s[kt][j]; }
                *(LAS u32x2*)(Pw + fr * 72 + kt * 16 + fq * 4) = pack4(s[kt]);
            }
            rs += __shfl_xor(rs, 16); rs += __shfl_xor(rs, 32);
            lrun[hh] = lrun[hh] * fac + rs;
#pragma unroll
            for (int d = 0; d < 4; ++d) O[hh][d] *= fac;
            LDS_WAVE_SYNC();
#pragma unroll
            for (int ks = 0; ks < 2; ++ks) {
                const bf16x8 pf = ldsfrag((LAS const unsigned char*)(Pw + fr * 72 + ks * 32 + fq * 8));
#pragma unroll
                for (int d = 0; d < 4; ++d) O[hh][d] = MFMA16(ldsfrag((LAS const unsigned char*)(VT + (h * 64 + d * 16 + fr) * 72 + ks * 32 + fq * 8)), pf, O[hh][d]);
            }
            LDS_WAVE_SYNC();
        }
    }
    float sq = 0.f;
#pragma unroll
    for (int hh = 0; hh < 3; ++hh) { const float inv = 1.0f / lrun[hh];
#pragma unroll
        for (int d = 0; d < 4; ++d) { O[hh][d] *= inv; const f32x4 o = O[hh][d]; sq += (o[0] * o[0] + o[1] * o[1]) + (o[2] * o[2] + o[3] * o[3]); } }
    sq += __shfl_xor(sq, 16); sq += __shfl_xor(sq, 32);
    if (fq == 0) ssq[(wid >> 2) * 64 + qt * 16 + fr] = sq;
    __syncthreads();
    const float rstd = 1.0f / sqrtf((ssq[qt * 16 + fr] + ssq[64 + qt * 16 + fr]) * (1.0f / 384.0f) + RMS_EPS);
    bf16_t* mix = (bf16_t*)(p.ws + W_MIX);
#pragma unroll
    for (int hh = 0; hh < 3; ++hh)
#pragma unroll
        for (int d = 0; d < 4; ++d) {
            const int col = (hbase + hh) * 64 + d * 16 + fq * 4;
            const f32x4 gv = *(const f32x4*)(p.in[18] + (size_t)l * 1024 + col);
            *(u32x2*)(mix + (size_t)(R0 + qt * 16 + fr) * DM + col) = pack4(O[hh][d] * rstd * gv);
        }
}

__device__ __forceinline__ void ssd_y(KP& p, LAS unsigned char* lds, int l, int u) {
    int tid_ = threadIdx.x; asm volatile("" : "+v"(tid_));
    const int tid = tid_, wid = tid >> 6, lane = tid & 63, fr = lane & 15, fq = lane >> 4;
    LAS bf16_t* Cn = (LAS bf16_t*)lds;
    LAS bf16_t* Bn = (LAS bf16_t*)(lds + 17408);
    LAS bf16_t* xT = (LAS bf16_t*)(lds + 34816);
    LAS bf16_t* Mm = (LAS bf16_t*)(lds + 62464);
    LAS float* dtl = (LAS float*)(lds + 90112);
    LAS float* acl = (LAS float*)(lds + 90880);
    LAS float* ssq = (LAS float*)(lds + 91648);
    const bf16_t* proj = (const bf16_t*)(p.ws + W_PROJ);
    const bf16_t* HP = (const bf16_t*)(p.ws + W_ST);
    const bf16_t* XC = (const bf16_t*)p.out + (size_t)(u * 64) * 896;
    const int R0 = u * 64, lt = wid & 3;
    f32x4 yacc[2][6];
#pragma unroll
    for (int g = 0; g < 2; ++g) {
        __syncthreads();
        if (wid < 3) { float dt, ac, last; dt_scan(p, l, u, g, wid, lane, dt, ac, last); dtl[wid * 64 + lane] = dt; acl[wid * 64 + lane] = ac; }
#pragma unroll
        for (int it = 0; it < 4; ++it) {
            const int idx = it * 512 + tid, mat = idx >> 10, i = (idx >> 4) & 63, c8 = idx & 15;
            const u32x4 w = *(const u32x4*)(XC + (size_t)i * 896 + 384 + mat * 256 + g * 128 + c8 * 8);
            *(LAS u32x4*)((mat ? Cn : Bn) + i * 136 + c8 * 8) = w;
        }
#pragma unroll
        for (int it = 0; it < 3; ++it) {
            const int idx = it * 512 + tid, c4 = idx % 48, i = (idx / 48) * 2;
            const u32x2 wa = *(const u32x2*)(XC + (size_t)i * 896 + g * 192 + c4 * 4), wb = *(const u32x2*)(XC + (size_t)(i + 1) * 896 + g * 192 + c4 * 4);
            *(LAS unsigned*)(xT + (c4 * 4 + 0) * 72 + i) = (wa.x & 0xffffu) | (wb.x << 16);
            *(LAS unsigned*)(xT + (c4 * 4 + 1) * 72 + i) = (wa.x >> 16) | (wb.x & 0xffff0000u);
            *(LAS unsigned*)(xT + (c4 * 4 + 2) * 72 + i) = (wa.y & 0xffffu) | (wb.y << 16);
            *(LAS unsigned*)(xT + (c4 * 4 + 3) * 72 + i) = (wa.y >> 16) | (wb.y & 0xffff0000u);
        }
        __syncthreads();
#pragma unroll
        for (int k = 0; k < 2; ++k) {
            const int st = (wid >> 2) * 2 + k;
            f32x4 a = (f32x4){0.f, 0.f, 0.f, 0.f};
#pragma unroll
            for (int ks = 0; ks < 4; ++ks) a = MFMA16(ldsfrag((LAS const unsigned char*)(Bn + (st * 16 + fr) * 136 + ks * 32 + fq * 8)), ldsfrag((LAS const unsigned char*)(Cn + (lt * 16 + fr) * 136 + ks * 32 + fq * 8)), a);
            const int li = lt * 16 + fr;
#pragma unroll
            for (int hh = 0; hh < 3; ++hh) {
                const float al = acl[hh * 64 + li]; f32x4 mv;
#pragma unroll
                for (int j = 0; j < 4; ++j) { const int si = st * 16 + fq * 4 + j; mv[j] = si <= li ? a[j] * __expf(al - acl[hh * 64 + si]) * dtl[hh * 64 + si] : 0.f; }
                *(LAS u32x2*)(Mm + (hh * 64 + li) * 72 + st * 16 + fq * 4) = pack4(mv);
            }
        }
        __syncthreads();
#pragma unroll
        for (int k = 0; k < 6; ++k) {
            const int ctile = (wid >> 2) * 6 + k, hh = ctile >> 2, pt = ctile & 3, h = g * 3 + hh, li = lt * 16 + fr;
            f32x4 ad = (f32x4){0.f, 0.f, 0.f, 0.f}, ao = (f32x4){0.f, 0.f, 0.f, 0.f};
#pragma unroll
            for (int ks = 0; ks < 2; ++ks) ad = MFMA16(ldsfrag((LAS const unsigned char*)(xT + (hh * 64 + pt * 16 + fr) * 72 + ks * 32 + fq * 8)), ldsfrag((LAS const unsigned char*)(Mm + (hh * 64 + li) * 72 + ks * 32 + fq * 8)), ad);
#pragma unroll
            for (int ks = 0; ks < 4; ++ks) ao = MFMA16(glbfrag(HP + ((size_t)(u * 6 + h) * 64 + pt * 16 + fr) * 128 + ks * 32 + fq * 8), ldsfrag((LAS const unsigned char*)(Cn + li * 136 + ks * 32 + fq * 8)), ao);
            const float ea = __expf(acl[hh * 64 + li]), dsk = p.in[15][l * 6 + h];
            const f32x4 xv = unpack4(*(const u32x2*)(XC + (size_t)li * 896 + h * 64 + pt * 16 + fq * 4));
            const f32x4 zv = unpack4(*(const u32x2*)(proj + (size_t)(R0 + li) * NPROJ + C_Z + h * 64 + pt * 16 + fq * 4));
            f32x4 y = ad + ao * ea + xv * dsk;
#pragma unroll
            for (int j = 0; j < 4; ++j) y[j] *= silu_f(zv[j]);
            yacc[g][k] = y;
            asm volatile("" ::: "memory");
        }
    }
    float sq = 0.f;
#pragma unroll
    for (int g = 0; g < 2; ++g)
#pragma unroll
        for (int k = 0; k < 6; ++k) { const f32x4 o = yacc[g][k]; sq += (o[0] * o[0] + o[1] * o[1]) + (o[2] * o[2] + o[3] * o[3]); }
    sq += __shfl_xor(sq, 16); sq += __shfl_xor(sq, 32);
    if (fq == 0) ssq[(wid >> 2) * 64 + lt * 16 + fr] = sq;
    __syncthreads();
    const float rstd = 1.0f / sqrtf((ssq[lt * 16 + fr] + ssq[64 + lt * 16 + fr]) * (1.0f / 384.0f) + RMS_EPS);
    bf16_t* mix = (bf16_t*)(p.ws + W_MIX);
#pragma unroll
    for (int g = 0; g < 2; ++g)
#pragma unroll
        for (int k = 0; k < 6; ++k) {
            const int col = 384 + g * 192 + ((wid >> 2) * 6 + k) * 16 + fq * 4;
            const f32x4 gv = *(const f32x4*)(p.in[18] + (size_t)l * 1024 + col);
            *(u32x2*)(mix + (size_t)(R0 + lt * 16 + fr) * DM + col) = pack4(yacc[g][k] * rstd * gv);
        }
}

__device__ __forceinline__ void phase_fix(KP& p, int l) {
    const float* halo = (const float*)(p.ws + W_MIX); bf16_t* H = (bf16_t*)(p.ws + W_PROJ);
    const float* w = p.in[23] + (size_t)l * 3 * DFF2; const float* bb = p.in[24] + (size_t)l * DFF2;
    int tid_ = threadIdx.x; asm volatile("" : "+v"(tid_));
    for (int i = blockIdx.x * 512 + tid_; i < 128 * DFF2; i += gridDim.x * 512) {
        const int pm = i / DFF2, cc = i % DFF2;
        if ((pm & 31) == 0 || cc >= DFF) continue;
        const float* h0 = halo + (size_t)(pm - 1) * 4 * DFF2; const float* h1 = halo + (size_t)pm * 4 * DFF2;
        float r[2];
#pragma unroll
        for (int rr = 0; rr < 2; ++rr) {
            float o[2];
#pragma unroll
            for (int gv = 0; gv < 2; ++gv) {
                const int c2 = cc + gv * DFF;
                const float xm2 = h0[2 * DFF2 + c2], xm1 = h0[3 * DFF2 + c2], x0 = h1[c2], x1 = h1[DFF2 + c2];
                o[gv] = rr == 0 ? bb[c2] + w[c2] * xm2 + w[DFF2 + c2] * xm1 + w[2 * DFF2 + c2] * x0 : bb[c2] + w[c2] * xm1 + w[DFF2 + c2] * x0 + w[2 * DFF2 + c2] * x1;
            }
            r[rr] = silu_f(o[0]) * o[1];
        }
        H[((size_t)pm * 256) * DFF + cc] = (bf16_t)(cvt_pk_bf16(r[0], 0.f) & 0xffffu);
        H[((size_t)pm * 256 + 1) * DFF + cc] = (bf16_t)(cvt_pk_bf16(r[1], 0.f) & 0xffffu);
    }
}

#define XB_TMO      128
#define XB_XCNT(j)  (256  + 64 * (j))
#define XB_XSUB(j)  (1280 + 64 * (j))
#define XB_XGEN(j)  (2304 + 64 * (j))
#define XB_TOP      3328
#define XB_TOPGEN   3392
#define XCD_BAR_WORDS 3456
#define XB_SPIN_CAP (1u << 18)

__device__ __forceinline__ unsigned xb_ld(unsigned* p)              { return __hip_atomic_load(p, __ATOMIC_RELAXED, __HIP_MEMORY_SCOPE_AGENT); }
__device__ __forceinline__ unsigned xb_add(unsigned* p, unsigned v) { return __hip_atomic_fetch_add(p, v, __ATOMIC_RELAXED, __HIP_MEMORY_SCOPE_AGENT); }
__device__ __forceinline__ unsigned xb_xcc_id() { return (unsigned)__builtin_amdgcn_s_getreg((3 << 11) | 20) & 0xFu; }
#define XB_SPIN(cond, bar) do { unsigned _sp = 0; while (cond) { __builtin_amdgcn_s_sleep(1); \
    if ((++_sp & 255u) == 0u) { if (xb_ld(&(bar)[XB_TMO])) break; if (_sp > XB_SPIN_CAP) { atomicAdd(&(bar)[XB_TMO], 1u); break; } } } } while (0)

struct XcdBarrier {
    unsigned* bar; unsigned x;
    volatile LAS unsigned* st;
};

__device__ __forceinline__ XcdBarrier xcd_barrier_post(unsigned* bar, volatile LAS unsigned* st) {
    XcdBarrier b; b.bar = bar; b.x = xb_xcc_id(); b.st = st;
    if (threadIdx.x == 0) (void)xb_add(&bar[XB_XCNT(b.x)], 1u);
    return b;
}
__device__ __forceinline__ void xcd_barrier_complete(unsigned* bar, unsigned x, unsigned& nloc, unsigned& nx) {
    const unsigned G = gridDim.x * gridDim.y * gridDim.z;
    unsigned sum, cnt, mine, sp = 0u;
    for (;;) {
        sum = 0u; cnt = 0u; mine = 0u;
#pragma unroll
        for (unsigned j = 0; j < 16; ++j) { const unsigned c = xb_ld(&bar[XB_XCNT(j)]); sum += c; cnt += (c > 0u) ? 1u : 0u; mine = (j == x) ? c : mine; }
        if (sum == G) break;
        __builtin_amdgcn_s_sleep(1);
        if ((++sp & 255u) == 0u) { if (xb_ld(&bar[XB_TMO])) break; if (sp > XB_SPIN_CAP) { atomicAdd(&bar[XB_TMO], 1u); break; } }
    }
    nloc = mine > 0u ? mine : 1u; nx = cnt > 0u ? cnt : 1u;
}

__device__ __forceinline__ void xcd_barrier(const XcdBarrier& b) {
    asm volatile("s_waitcnt vmcnt(0)" ::: "memory");
    __syncthreads();
    if (threadIdx.x == 0) {
        unsigned* bar = b.bar;
        __builtin_amdgcn_s_waitcnt(0);
        unsigned nloc = b.st[0], nx = b.st[1];
        if (nloc == 0u) { xcd_barrier_complete(bar, b.x, nloc, nx); b.st[0] = nloc; b.st[1] = nx; }
        const unsigned old = xb_add(&bar[XB_XSUB(b.x)], 1u);
        const unsigned gen = old / nloc;
        if (old + 1u == (gen + 1u) * nloc) {
            __builtin_amdgcn_fence(__ATOMIC_RELEASE, "agent");
            asm volatile("s_waitcnt vmcnt(0)" ::: "memory");
            const unsigned og = xb_add(&bar[XB_TOP], 1u);
            const unsigned tg = og / nx;
            if (og + 1u == (tg + 1u) * nx) xb_add(&bar[XB_TOPGEN], 1u);
            else XB_SPIN(xb_ld(&bar[XB_TOPGEN]) == tg, bar);
            __builtin_amdgcn_fence(__ATOMIC_ACQUIRE, "agent");
            xb_add(&bar[XB_XGEN(b.x)], 1u);
            asm volatile("s_waitcnt vmcnt(0)" ::: "memory");
        } else {
            XB_SPIN(xb_ld(&bar[XB_XGEN(b.x)]) == gen, bar);
            __builtin_amdgcn_fence(__ATOMIC_ACQUIRE, "agent");
            asm volatile("s_waitcnt vmcnt(0)" ::: "memory");
        }
    }
    __syncthreads();
}

__global__ void __launch_bounds__(512, 2) mega(Params pa) {
    extern __shared__ __attribute__((aligned(16))) unsigned char shm[];
    LAS unsigned char* lds = (LAS unsigned char*)shm;
    const int G = gridDim.x, bid = blockIdx.x;
    KP* pk = (KP*)__builtin_amdgcn_kernarg_segment_ptr();
    volatile LAS unsigned* bst = (volatile LAS unsigned*)(lds + LDS_BYTES - 16);
    XcdBarrier xb; xb.bar = nullptr; xb.x = 0; xb.st = bst;
    if (pa.coop) { if (threadIdx.x < 2) bst[threadIdx.x] = 0u; __syncthreads(); xb = xcd_barrier_post((unsigned*)(pa.ws + W_BAR), bst); }
    for (int ph = pa.ph_lo; ph < pa.ph_hi; ++ph) {
        if (ph > pa.ph_lo && pa.coop) { if (ph == pa.ph_lo + 1) { __threadfence(); cg::this_grid().sync(); } else xcd_barrier(xb); }
        asm volatile("" : "+s"(pk)); KP& p = *pk;
        if (ph == 0) { phase_prep(p, lds); continue; }
        if (ph == 42) { int tq = threadIdx.x; asm volatile("" : "+v"(tq)); const unsigned short* w16 = (const unsigned short*)p.ws; for (size_t i = (size_t)bid * 512 + tq; i < (size_t)59418624; i += (size_t)G * 512) p.out[i] = (float)w16[i * 4]; continue; }
        if (ph == 41) { int tq = threadIdx.x; asm volatile("" : "+v"(tq)); for (size_t i = (size_t)bid * 512 + tq; i < (size_t)59418624; i += (size_t)G * 512) { const float v = p.out[i]; if (!(fabsf(v) < 1e30f)) p.out[i] = 0.f; } continue; }
        const int l = (ph - 1) / 10, k = (ph - 1) % 10;
        bf16_t* XB = (bf16_t*)(p.ws + W_XB);
        switch (k) {
        case 0: if (REP_G1 > 1) { pg8::StaticOrder S; S.init(T_ALL, NPROJ, G, bid); EpiNull E{(float*)(p.ws + W_CD)};
                  pg8::gemm_phase(lds, pg8::Gemm{XB, (const bf16_t*)(p.ws + W_IN + l * W_IN_L), T_ALL, NPROJ, DM}, S, E); }
                { pg8::StaticOrder S; S.init(T_ALL, NPROJ, G, bid);
                  EpiIn E{(bf16_t*)(p.ws + W_PROJ), p.out, (float*)(p.ws + W_DTB), p.in[13], l};
                  pg8::gemm_phase(lds, pg8::Gemm{XB, (const bf16_t*)(p.ws + W_IN + l * W_IN_L), T_ALL, NPROJ, DM}, S, E); } break;
        case 1: for (int it = bid; it < 3 * NU64; it += G) { if (it < NU64) attn_unit(p, lds, l, NU64 - 1 - it); else if (it < 2 * NU64) ssd_states(p, lds, l, it - NU64); else gmlp_unit(p, lds, l, it - 2 * NU64); } break;
        case 2: for (int it = bid; it < 96 + 768; it += G) { if (it < 96) scan_prompt(p, l, it); else scan_sample(p, l, it - 96); } break;
        case 3: for (int rep = 0; rep < REP_M3; ++rep) for (int it = bid; it < NU64; it += G) ssd_y(p, lds, l, it); break;
        case 4: { pg8::StaticOrder S; S.init(T_ALL, DM, G, bid); EpiRes E{p.out, XB};
                  pg8::gemm_phase(lds, pg8::Gemm{(const bf16_t*)(p.ws + W_MIX), (const bf16_t*)(p.ws + W_OUT + l * W_OUT_L), T_ALL, DM, DM}, S, E); } break;
        case 5: phase_ln(p, p.in[20] + l * DM, p.in[21] + l * DM, false); break;
        case 6: for (int rep = 0; rep < REP_G3; ++rep) { pg8::StaticOrder S; S.init(T_ALL, DFF2, G, bid);
                  EpiUp E{(bf16_t*)(p.ws + W_PROJ), (float*)(p.ws + W_MIX), p.out, p.in[23], p.in[24], p.in[6], l};
                  pg8::OneUnit o1;
                  for (int i = 0; S.next(i, o1.u); ++i) { pg8::gemm_phase(lds, pg8::Gemm{XB, (const bf16_t*)(p.ws + W_UP + l * W_UP_L), T_ALL, DFF2, DM}, o1, E); __syncthreads(); } } break;
        case 7: phase_fix(p, l); break;
        case 8: { pg8::StaticOrder S; S.init(T_ALL, DM, G, bid); EpiRes E{p.out, XB};
                  pg8::gemm_phase(lds, pg8::Gemm{(const bf16_t*)(p.ws + W_PROJ), (const bf16_t*)(p.ws + W_DN + l * W_DN_L), T_ALL, DM, DFF}, S, E); } break;
        case 9: phase_ln(p, p.in[26] + l * DM, p.in[27] + l * DM, l == DEPTH - 1); break;
        }
    }
}

constexpr int N_PHASES = 41;
#ifndef MULTI_LAUNCH
#define MULTI_LAUNCH 0
#endif

extern "C" void kernel_launch(void* const* d_in, const int* in_sizes, int n_in, void* d_out, int out_size, void* d_ws, size_t ws_size, hipStream_t stream) {
    static int grid = 0;
    if (grid == 0) {
        if (n_in != 28 || ws_size < W_END2) { fprintf(stderr, "kernel_launch: need 28 inputs and %zu bytes of workspace (got %d, %zu)\n", (size_t)W_END2, n_in, ws_size); grid = -1; return; }
        int dev = 0, cus = 0, per_cu = 0;
        hipGetDevice(&dev); hipDeviceGetAttribute(&cus, hipDeviceAttributeMultiprocessorCount, dev);
        if (hipFuncSetAttribute((const void*)mega, hipFuncAttributeMaxDynamicSharedMemorySize, LDS_BYTES) != hipSuccess) { fprintf(stderr, "kernel_launch: hipFuncSetAttribute failed\n"); grid = -1; return; }
        hipOccupancyMaxActiveBlocksPerMultiprocessor(&per_cu, (const void*)mega, 512, LDS_BYTES);
        (void)hipGetLastError();
        if (per_cu < 1) per_cu = 1;
        grid = cus * 1;
    }
    if (grid < 0) return;
    Params p{};
    for (int i = 0; i < 28; ++i) p.in[i] = (const float*)d_in[i];
    p.out = (float*)d_out; p.ws = (unsigned char*)d_ws;
#if MULTI_LAUNCH
#ifdef PROBE_CUT
    for (int ph = 0; ph < PROBE_CUT; ++ph) { p.ph_lo = ph; p.ph_hi = ph + 1; p.coop = 0; hipLaunchKernelGGL(mega, dim3(grid), dim3(512), LDS_BYTES, stream, p); }
    p.ph_lo = 42; p.ph_hi = 43; p.coop = 0; hipLaunchKernelGGL(mega, dim3(grid), dim3(512), LDS_BYTES, stream, p);
#else
    for (int ph = 0; ph < N_PHASES; ++ph) { p.ph_lo = ph; p.ph_hi = ph + 1; p.coop = 0; hipLaunchKernelGGL(mega, dim3(grid), dim3(512), LDS_BYTES, stream, p); }
#endif
#else
    p.ph_lo = 0; p.ph_hi = N_PHASES; p.coop = 1;
    if (hipMemsetAsync((char*)d_ws + W_BAR, 0, 16384, stream) != hipSuccess) { fprintf(stderr, "kernel_launch: memset failed\n"); return; }
    void* args[] = {&p};
    hipError_t e = hipLaunchCooperativeKernel((const void*)mega, dim3(grid), dim3(512), args, LDS_BYTES, stream);
    if (e != hipSuccess) fprintf(stderr, "cooperative launch failed: %s (grid %d)\n", hipGetErrorString(e), grid);
#endif
}
```

```cpp
#define REP_G1 1
#define REP_M1 1
#define REP_ATT 1
#define REP_M3 1
#define REP_G3 1
#include <hip/hip_runtime.h>
#include <hip/hip_cooperative_groups.h>
#include <cstdio>
namespace cg = cooperative_groups;

#define LAS __attribute__((address_space(3)))
typedef unsigned short bf16_t;
typedef short bf16x8 __attribute__((ext_vector_type(8)));
typedef float f32x4 __attribute__((ext_vector_type(4)));
typedef float f32x2 __attribute__((ext_vector_type(2)));
typedef unsigned u32x4 __attribute__((ext_vector_type(4)));
typedef unsigned u32x2 __attribute__((ext_vector_type(2)));

constexpr int T_ALL = 34816, T_P = 32768, DM = 1024, NPROJ = 3072, DFF = 2816, DFF2 = 5632, DEPTH = 4;
constexpr int NU64 = 544;
constexpr float ALPHA = 1.6817928305074290f;
constexpr float LN_EPS = 1e-5f, RMS_EPS = 1e-5f;
constexpr int C_K = 384, C_V = 768, C_Z = 1152, C_XBC = 1536, C_U = 2432, C_VC = 2688, C_DT = 2944;
constexpr size_t O_YP = 0, O_YS = 33554432, O_PK = 35651584, O_PV = O_PK + 3145728, O_PH = O_PV + 3145728, O_PC = O_PH + 786432,
                 O_PF = O_PC + 43008, O_SK = O_PF + 180224, O_SV = O_SK + 3145728, O_SH = O_SV + 3145728, O_SC = O_SH + 6291456,
                 O_SG = O_SC + 344064, O_SF = O_SG + 2097152;
constexpr size_t W_IN = 0, W_IN_L = (size_t)NPROJ * DM * 2;
constexpr size_t W_OUT = W_IN + 4 * W_IN_L, W_OUT_L = (size_t)DM * DM * 2;
constexpr size_t W_UP = W_OUT + 4 * W_OUT_L, W_UP_L = (size_t)DFF2 * DM * 2;
constexpr size_t W_DN = W_UP + 4 * W_UP_L, W_DN_L = (size_t)DM * DFF * 2;
constexpr size_t W_GW = W_DN + 4 * W_DN_L, W_GW_L = (size_t)4 * 128 * 128 * 2;
constexpr size_t W_XB = W_GW + 4 * W_GW_L;
constexpr size_t W_PROJ = W_XB + (size_t)T_ALL * DM * 2;
constexpr size_t W_MIX = W_PROJ + (size_t)T_ALL * NPROJ * 2;
constexpr size_t W_ST = W_MIX + (size_t)T_ALL * DM * 2;
constexpr size_t W_CD = W_ST + (size_t)NU64 * 6 * 8192 * 2;
constexpr size_t W_DTB = W_CD + (size_t)NU64 * 8 * 4;
constexpr size_t W_END = W_DTB + (size_t)T_ALL * 8 * 4;
constexpr size_t W_BAR = W_END;
constexpr size_t W_END2 = W_BAR + 16384;
constexpr int LDS_BYTES = 136 * 1024;

struct Params { const float* in[28]; float* out; unsigned char* ws; int ph_lo, ph_hi, coop, pad; };
typedef const __attribute__((address_space(4))) Params KP;

__device__ __forceinline__ float bf2f(unsigned b) { return __uint_as_float(b << 16); }
typedef __bf16 bf16v2 __attribute__((ext_vector_type(2)));
__device__ __forceinline__ unsigned cvt_pk_bf16(float lo, float hi) { const f32x2 v = {lo, hi}; const bf16v2 b = __builtin_convertvector(v, bf16v2); return __builtin_bit_cast(unsigned, b); }
__device__ __forceinline__ u32x2 pack4(f32x4 v) { u32x2 w; w.x = cvt_pk_bf16(v[0], v[1]); w.y = cvt_pk_bf16(v[2], v[3]); return w; }
__device__ __forceinline__ f32x4 unpack4(u32x2 w) { f32x4 v; v[0] = bf2f(w.x & 0xffffu); v[1] = bf2f(w.x >> 16); v[2] = bf2f(w.y & 0xffffu); v[3] = bf2f(w.y >> 16); return v; }
__device__ __forceinline__ float silu_f(float x) { return x * __builtin_amdgcn_rcpf(1.0f + __expf(-x)); }
__device__ __forceinline__ float gelu_tanh(float x) { const float y = 0.7978845608028654f * (x + 0.044715f * x * x * x); const float e = __expf(2.0f * y); return 0.5f * x * (2.0f - 2.0f * __builtin_amdgcn_rcpf(1.0f + e)); }
__device__ __forceinline__ float softplus_f(float x) { const float e = __expf(x); return x > 15.0f ? x : (e < 1e-3f ? e * (1.0f - 0.5f * e + 0.33333333f * e * e) : __logf(1.0f + e)); }
#define MFMA16(colfrag, rowfrag, acc) __builtin_amdgcn_mfma_f32_16x16x32_bf16((colfrag), (rowfrag), (acc), 0, 0, 0)
__device__ __forceinline__ bf16x8 ldsfrag(LAS const unsigned char* p) { return *(LAS const bf16x8*)p; }
__device__ __forceinline__ bf16x8 glbfrag(const bf16_t* p) { return *(const bf16x8*)p; }
#define LDS_WAVE_SYNC() asm volatile("s_waitcnt lgkmcnt(0)" ::: "memory")

namespace pg8 {
constexpr int BM = 256, BK = 64, HALF = 128, HTB = HALF * BK * 2, STAGE_BYTES = 8 * HTB, NXCD = 8, WGM = 8;
__device__ __forceinline__ int lds_byte(int r, int c) { const int st = (r >> 4) * 2 + (c >> 5), rr = r & 15, cc = c & 31, ob = rr * 64 + cc * 2; return st * 1024 + (ob ^ (((ob >> 9) & 1) << 5)); }
__device__ __forceinline__ void stage_rc(int b, int& R, int& C) { const int st = b / 1024, sb = b % 1024, swz = sb ^ (((sb >> 9) & 1) << 5); R = (st >> 1) * 16 + swz / 64; C = (st & 1) * 32 + (swz % 64) / 2; }
__device__ __forceinline__ int perm32(int rho) { const int n = rho >> 4, i = rho & 15; return 8 * (i >> 2) + 4 * n + (i & 3); }
struct Unit { int pm, pn; };
struct Gemm { const bf16_t* A; const bf16_t* Bt; int M, N, K; };
struct StaticOrder {
    int nM, nN, nwg, G, c;
    __device__ __forceinline__ void init(int M, int N, int G_, int c_) { nM = M / BM; nN = N / BM; nwg = nM * nN; G = G_; c = c_; }
    __device__ __forceinline__ bool next(int i, Unit& u) const {
        const long L = (long)i * G + c; if (L >= nwg) return false;
        int wgid = (int)L; { const int q = nwg / NXCD, r = nwg % NXCD, xcd = wgid % NXCD, off = wgid / NXCD; wgid = (xcd < r ? xcd * (q + 1) : r * (q + 1) + (xcd - r) * q) + off; }
        const int nig = WGM * nN, gid = wgid / nig, fm = gid * WGM, gsz = (nM - fm) < WGM ? (nM - fm) : WGM;
        u.pm = fm + ((wgid % nig) % gsz); u.pn = (wgid % nig) / gsz; return true;
    }
    __device__ __forceinline__ void a_ready(const Unit&) const {}
    __device__ __forceinline__ void done(const Unit&) const {}
};
struct OneUnit {
    Unit u;
    __device__ __forceinline__ bool next(int i, Unit& o) const { if (i) return false; o = u; return true; }
    __device__ __forceinline__ void a_ready(const Unit&) const {}
    __device__ __forceinline__ void done(const Unit&) const {}
};

template <class Epi, class Sched>
__device__ __forceinline__ void gemm_phase(LAS unsigned char* lds, const Gemm g, const Sched& S, const Epi& E) {
    int tid_ = threadIdx.x; asm volatile("" : "+v"(tid_));
    const int tid = tid_, wid = __builtin_amdgcn_readfirstlane(tid >> 6), lane = tid & 63, wr = wid >> 2, wc = wid & 3, fr = lane & 15, fq = lane >> 4;
    const int K = g.K, nt = K / BK;
    unsigned voffA[2], voffB[2];
#pragma unroll
    for (int i = 0; i < 2; ++i) { int R, C; stage_rc(tid * 16 + i * 8192, R, C); const int Rb = (R & ~31) + perm32(R & 31); voffA[i] = (unsigned)(R * K + C) * 2u; voffB[i] = (unsigned)(Rb * K + C) * 2u; }
    const size_t kstep = (size_t)(BK * 2);
    const size_t hstep = (size_t)HALF * K * 2;
    const size_t tstep = 2 * hstep;
    const unsigned ldsw = (unsigned)wid * 1024u;
    const int aoff = lds_byte(wr * 64 + fr, fq * 8), boff = lds_byte(wc * 32 + fr, fq * 8);
#define PG8_SA(b, h) (((b) * 2 + (h)) * HTB)
#define PG8_SB(b, h) ((4 + (b) * 2 + (h)) * HTB)
#define PG8_STAGE(bufoff, gbase, voff) do { _Pragma("unroll") for (int _i = 0; _i < 2; ++_i) \
        __builtin_amdgcn_global_load_lds((const unsigned*)((const char*)(gbase) + (voff)[_i]), (LAS unsigned*)(lds + (bufoff) + ldsw + _i * 8192), 16, 0, 0); } while (0)
#define PG8_LDA(dst, b, h) do { _Pragma("unroll") for (int m = 0; m < 4; ++m) _Pragma("unroll") for (int k = 0; k < 2; ++k) dst[m][k] = *(const LAS bf16x8*)(lds + PG8_SA(b, h) + aoff + m * 2048 + k * 1024); } while (0)
#define PG8_LDB(dst, b, h) do { _Pragma("unroll") for (int n = 0; n < 2; ++n) _Pragma("unroll") for (int k = 0; k < 2; ++k) dst[n][k] = *(const LAS bf16x8*)(lds + PG8_SB(b, h) + boff + n * 2048 + k * 1024); } while (0)
#define PG8_MMA(ai, bj, At, Bt) do { __builtin_amdgcn_s_setprio(1); _Pragma("unroll") for (int m = 0; m < 4; ++m) _Pragma("unroll") for (int n = 0; n < 2; ++n) _Pragma("unroll") for (int k = 0; k < 2; ++k) \
        acc[ai][bj][m][n] = __builtin_amdgcn_mfma_f32_16x16x32_bf16(Bt[n][k], At[m][k], acc[ai][bj][m][n], 0, 0, 0); __builtin_amdgcn_s_setprio(0); } while (0)
#define PG8_WAIT_V(n) asm volatile("s_waitcnt vmcnt(" #n ")" ::: "memory")
#define PG8_WAIT_L(n) asm volatile("s_waitcnt lgkmcnt(" #n ")" ::: "memory")
#define PG8_BAR __builtin_amdgcn_s_barrier()
#define PG8_SCHED __builtin_amdgcn_sched_barrier(0)
    Unit cur, nxt; int ui = 0;
    if (!S.next(0, cur)) return;
    f32x4 acc[2][2][4][2];
#pragma unroll
    for (int a = 0; a < 2; ++a)
#pragma unroll
        for (int b = 0; b < 2; ++b)
#pragma unroll
            for (int m = 0; m < 4; ++m)
#pragma unroll
                for (int n = 0; n < 2; ++n) acc[a][b][m][n] = (f32x4){0.f, 0.f, 0.f, 0.f};
    bf16x8 At[4][2], B0[2][2], B1[2][2];
    const char* cA = (const char*)g.A + (size_t)cur.pm * tstep; const char* cB = (const char*)g.Bt + (size_t)cur.pn * tstep;
    S.a_ready(cur);
    PG8_STAGE(PG8_SB(0, 0), cB, voffB); PG8_STAGE(PG8_SA(0, 0), cA, voffA); PG8_STAGE(PG8_SB(0, 1), cB + hstep, voffB); PG8_STAGE(PG8_SA(0, 1), cA + hstep, voffA);
    if (wr == 1) PG8_BAR;
    PG8_WAIT_V(4); PG8_BAR;
    PG8_STAGE(PG8_SB(1, 0), cB + kstep, voffB); PG8_STAGE(PG8_SA(1, 0), cA + kstep, voffA); PG8_STAGE(PG8_SB(1, 1), cB + hstep + kstep, voffB);
    PG8_WAIT_V(6); PG8_BAR;
    for (;;) {
        const bool has_next = S.next(ui + 1, nxt);
        const char* nA = has_next ? (const char*)g.A + (size_t)nxt.pm * tstep : cA; const char* nB = has_next ? (const char*)g.Bt + (size_t)nxt.pn * tstep : cB;
        for (int t = 0; t < nt; t += 2) {
            const bool last = (t == nt - 2);
            const char* a1 = cA + (size_t)(t + 1) * kstep;
            const char* a2 = last ? nA : cA + (size_t)(t + 2) * kstep; const char* b2 = last ? nB : cB + (size_t)(t + 2) * kstep;
            const char* a3 = a2 + kstep; const char* b3 = b2 + kstep;
            if (last && has_next) S.a_ready(nxt);
            PG8_LDB(B0, 0, 0); PG8_SCHED; PG8_LDA(At, 0, 0); PG8_STAGE(PG8_SA(1, 1), a1 + hstep, voffA);
            PG8_WAIT_L(8); PG8_BAR; PG8_WAIT_L(0); PG8_MMA(0, 0, At, B0); PG8_BAR; PG8_SCHED;
            PG8_LDB(B1, 0, 1); PG8_STAGE(PG8_SB(0, 0), b2, voffB);
            PG8_BAR; PG8_WAIT_L(0); PG8_MMA(0, 1, At, B1); PG8_BAR;
            PG8_LDA(At, 0, 1); PG8_STAGE(PG8_SA(0, 0), a2, voffA);
            PG8_BAR; PG8_WAIT_L(0); PG8_MMA(1, 0, At, B0); PG8_BAR; PG8_SCHED;
            PG8_STAGE(PG8_SB(0, 1), b2 + hstep, voffB);
            PG8_WAIT_V(6); PG8_BAR; PG8_MMA(1, 1, At, B1); PG8_BAR;
            PG8_LDB(B0, 1, 0); PG8_SCHED; PG8_LDA(At, 1, 0); PG8_STAGE(PG8_SA(0, 1), a2 + hstep, voffA);
            PG8_WAIT_L(8); PG8_BAR; PG8_WAIT_L(0); PG8_MMA(0, 0, At, B0); PG8_BAR; PG8_SCHED;
            PG8_LDB(B1, 1, 1); PG8_STAGE(PG8_SB(1, 0), b3, voffB);
            PG8_BAR; PG8_WAIT_L(0); PG8_MMA(0, 1, At, B1); PG8_BAR;
            PG8_LDA(At, 1, 1); PG8_STAGE(PG8_SA(1, 0), a3, voffA);
            PG8_BAR; PG8_WAIT_L(0); PG8_MMA(1, 0, At, B0); PG8_BAR; PG8_SCHED;
            PG8_STAGE(PG8_SB(1, 1), b3 + hstep, voffB);
            PG8_WAIT_V(6); PG8_BAR; PG8_MMA(1, 1, At, B1); PG8_BAR;
        }
        if constexpr (!Epi::AFTER_DRAIN) { E(acc, cur, wr, wc, fr, fq); S.done(cur); }
        if (!has_next) break;
#pragma unroll
        for (int a = 0; a < 2; ++a)
#pragma unroll
            for (int b = 0; b < 2; ++b)
#pragma unroll
                for (int m = 0; m < 4; ++m)
#pragma unroll
                    for (int n = 0; n < 2; ++n) acc[a][b][m][n] = (f32x4){0.f, 0.f, 0.f, 0.f};
        cur = nxt; cA = nA; cB = nB; ++ui;
    }
    PG8_WAIT_V(0);
    if (wr == 0) PG8_BAR;
    PG8_BAR;
    if constexpr (Epi::AFTER_DRAIN) { E.fused(acc, cur, wr, wc, fr, fq, lds, wid, lane); S.done(cur); }
#undef PG8_SA
#undef PG8_SB
#undef PG8_STAGE
#undef PG8_LDA
#undef PG8_LDB
#undef PG8_MMA
#undef PG8_WAIT_V
#undef PG8_WAIT_L
#undef PG8_BAR
#undef PG8_SCHED
}
}
using pg8::Unit;

struct EpiIn {
    static constexpr bool AFTER_DRAIN = false;
    bf16_t* proj; float* out; float* dtb; const float* dt_bias; int l;
    __device__ __forceinline__ void operator()(const f32x4 (&acc)[2][2][4][2], const Unit& u, int wr, int wc, int fr_, int fq_) const {
        int fr = fr_, fq = fq_; asm volatile("" : "+v"(fr), "+v"(fq));
#pragma unroll
        for (int bj = 0; bj < 2; ++bj) {
            const int cb = u.pn * 256 + bj * 128;
            const int col = cb + wc * 32 + fq * 8;
            if (cb > C_DT) continue;
#pragma unroll
            for (int ai = 0; ai < 2; ++ai)
#pragma unroll
                for (int m = 0; m < 4; ++m) {
                    const int row = u.pm * 256 + ai * 128 + wr * 64 + m * 16 + fr;
                    const bool isP = row < T_P; int b, t;
                    if (isP) { b = row >> 13; t = row & 8191; } else { b = (row - T_P) >> 6; t = row & 63; }
                    f32x4 v0 = acc[ai][bj][m][0], v1 = acc[ai][bj][m][1];
                    if (cb < C_U) {
                        u32x4 w; { const u32x2 a = pack4(v0), c = pack4(v1); w.x = a.x; w.y = a.y; w.z = c.x; w.w = c.y; }
                        *(u32x4*)(proj + (size_t)row * NPROJ + col) = w;
                        if (cb >= C_K && cb < C_Z) {
                            const int isv = cb >= C_V; const int cc = col - (isv ? C_V : C_K);
                            float* o = nullptr;
                            if (isP) { if (t >= 7680) o = out + (isv ? O_PV : O_PK) + ((size_t)(l * 4 + b) * 512 + (t - 7680)) * 384 + cc; }
                            else o = out + (isv ? O_SV : O_SK) + ((size_t)(l * 32 + b) * 64 + t) * 384 + cc;
                            if (o) { *(f32x4*)o = v0; *(f32x4*)(o + 4) = v1; }
                        } else if (cb >= C_XBC) {
                            const int cc = col - C_XBC; float* o = nullptr;
                            if (isP) { if (t >= 8189) o = out + O_PC + ((size_t)(l * 4 + b) * 3 + (t - 8189)) * 896 + cc; }
                            else if (t >= 61) o = out + O_SC + ((size_t)(l * 32 + b) * 3 + (t - 61)) * 896 + cc;
                            if (o) { *(f32x4*)o = v0; *(f32x4*)(o + 4) = v1; }
                        }
                    } else if (cb < C_DT) {
#pragma unroll
                        for (int j = 0; j < 4; ++j) { v0[j] = gelu_tanh(v0[j]); v1[j] = gelu_tanh(v1[j]); }
                        u32x4 w; { const u32x2 a = pack4(v0), c = pack4(v1); w.x = a.x; w.y = a.y; w.z = c.x; w.w = c.y; }
                        *(u32x4*)(proj + (size_t)row * NPROJ + col) = w;
                        if (cb >= C_VC && !isP) { float* o = out + O_SG + ((size_t)(l * 32 + b) * 64 + t) * 256 + (col - C_VC); *(f32x4*)o = v0; *(f32x4*)(o + 4) = v1; }
                    } else if (col == C_DT) {
                        float* d = dtb + (size_t)row * 8;
#pragma unroll
                        for (int j = 0; j < 4; ++j) d[j] = softplus_f(v0[j] + dt_bias[l * 6 + j]);
#pragma unroll
                        for (int j = 0; j < 2; ++j) d[4 + j] = softplus_f(v1[j] + dt_bias[l * 6 + 4 + j]);
                    }
                    asm volatile("" ::: "memory");
                }
        }
    }
};
struct EpiNull {
    static constexpr bool AFTER_DRAIN = false;
    float* sink;
    __device__ __forceinline__ void operator()(const f32x4 (&acc)[2][2][4][2], const Unit& u, int wr, int wc, int fr, int fq) const {
        float t = 0.f;
#pragma unroll
        for (int ai = 0; ai < 2; ++ai)
#pragma unroll
            for (int bj = 0; bj < 2; ++bj)
#pragma unroll
                for (int m = 0; m < 4; ++m)
#pragma unroll
                    for (int n = 0; n < 2; ++n) t += acc[ai][bj][m][n][0] + acc[ai][bj][m][n][1] + acc[ai][bj][m][n][2] + acc[ai][bj][m][n][3];
        if (t == 123456.789f) sink[0] = t;
    }
};
struct EpiRes {
    static constexpr bool AFTER_DRAIN = false;
    float* x; const bf16_t* xb;
    __device__ __forceinline__ void operator()(const f32x4 (&acc)[2][2][4][2], const Unit& u, int wr, int wc, int fr_, int fq_) const {
        int fr = fr_, fq = fq_; asm volatile("" : "+v"(fr), "+v"(fq));
#pragma unroll
        for (int ai = 0; ai < 2; ++ai)
#pragma unroll
            for (int m = 0; m < 4; ++m) {
                float* rowp = x + (size_t)(u.pm * 256 + ai * 128 + wr * 64 + m * 16 + fr) * DM + u.pn * 256 + wc * 32 + fq * 8;
#pragma unroll
                for (int bj = 0; bj < 2; ++bj) { float* q = rowp + bj * 128; const u32x4 xw = *(const u32x4*)(xb + (q - x));
                    const f32x4 o0 = unpack4((u32x2){xw.x, xw.y}), o1 = unpack4((u32x2){xw.z, xw.w});
                    *(f32x4*)q = o0 * ALPHA + acc[ai][bj][m][0]; *(f32x4*)(q + 4) = o1 * ALPHA + acc[ai][bj][m][1]; }
                asm volatile("" ::: "memory");
            }
    }
};
struct EpiUp {
    static constexpr bool AFTER_DRAIN = true;
    bf16_t* H; float* halo; float* out; const float* cw; const float* cb; const float* fstate; int l;
    __device__ __forceinline__ void operator()(const f32x4 (&)[2][2][4][2], const Unit&, int, int, int, int) const {}
    __device__ __forceinline__ void fused(f32x4 (&acc)[2][2][4][2], const Unit& u, int wr, int wc, int fr, int fq, LAS unsigned char* lds, int wid, int lane) const {
        constexpr int LS = 264;
#pragma unroll
        for (int ai = 0; ai < 2; ++ai)
#pragma unroll
            for (int m = 0; m < 4; ++m)
#pragma unroll
                for (int bj = 0; bj < 2; ++bj) {
                        const int rl = ai * 128 + wr * 64 + m * 16 + fr, cl = bj * 128 + wc * 32 + fq * 8;
                        u32x4 w; { const u32x2 a = pack4(acc[ai][bj][m][0]), c = pack4(acc[ai][bj][m][1]); w.x = a.x; w.y = a.y; w.z = c.x; w.w = c.y; }
                        *(LAS u32x4*)(lds + (rl * LS + cl) * 2) = w;
                    }
        __syncthreads();
        const int tid = wid * 64 + lane, j = tid & 127, seg = tid >> 7;
        const int hcol = u.pn * 128 + j;
        const float* w = cw + (size_t)l * 3 * DFF2; const float* bb = cb + (size_t)l * DFF2;
        const float wg0 = w[hcol], wg1 = w[DFF2 + hcol], wg2 = w[2 * DFF2 + hcol], bg = bb[hcol];
        const float wv0 = w[DFF + hcol], wv1 = w[DFF2 + DFF + hcol], wv2 = w[2 * DFF2 + DFF + hcol], bv = bb[DFF + hcol];
        const int R = u.pm * 256 + seg * 64;
        const bool isP = R < T_P;
        float g2 = 0.f, g1 = 0.f, v2 = 0.f, v1 = 0.f; int skip = 0;
        const LAS bf16_t* U = (const LAS bf16_t*)lds;
        if (isP) {
            if (seg > 0) { g2 = bf2f(U[(seg * 64 - 2) * LS + j]); g1 = bf2f(U[(seg * 64 - 1) * LS + j]); v2 = bf2f(U[(seg * 64 - 2) * LS + 128 + j]); v1 = bf2f(U[(seg * 64 - 1) * LS + 128 + j]); }
            else if ((R & 8191) != 0) skip = 2;
        } else {
            const int sb = (R - T_P) >> 6; const float* fs = fstate + (size_t)(l * 32 + sb) * 2 * DFF2;
            g2 = fs[hcol]; g1 = fs[DFF2 + hcol]; v2 = fs[DFF + hcol]; v1 = fs[DFF2 + DFF + hcol];
        }
        bf16_t* hp = H + (size_t)R * DFF + hcol;
#pragma unroll 8
        for (int i = 0; i < 64; ++i) {
            const float gq = bf2f(U[(seg * 64 + i) * LS + j]), vq = bf2f(U[(seg * 64 + i) * LS + 128 + j]);
            if (i >= skip) {
                const float cgv = bg + wg0 * g2 + wg1 * g1 + wg2 * gq, cvv = bv + wv0 * v2 + wv1 * v1 + wv2 * vq;
                const float hv = silu_f(cgv) * cvv;
                hp[(size_t)i * DFF] = (bf16_t)(cvt_pk_bf16(hv, 0.f) & 0xffffu);
            }
            g2 = g1; g1 = gq; v2 = v1; v1 = vq;
            if (isP) {
                if (seg == 0 && i < 2) { float* hl = halo + ((size_t)u.pm * 4 + i) * DFF2; hl[hcol] = gq; hl[DFF + hcol] = vq; }
                if (seg == 3 && i >= 62) { float* hl = halo + ((size_t)u.pm * 4 + 2 + (i - 62)) * DFF2; hl[hcol] = gq; hl[DFF + hcol] = vq;
                    if ((u.pm & 31) == 31) { float* o = out + O_PF + ((size_t)(l * 4 + (u.pm >> 5)) * 2 + (i - 62)) * DFF2; o[hcol] = gq; o[DFF + hcol] = vq; } }
            } else if (i >= 62) {
                const int sb = (R - T_P) >> 6; float* o = out + O_SF + ((size_t)(l * 32 + sb) * 2 + (i - 62)) * DFF2; o[hcol] = gq; o[DFF + hcol] = vq;
            }
        }
    }
};

template <int CTRL> __device__ __forceinline__ float dppz(float x) { return __builtin_bit_cast(float, __builtin_amdgcn_update_dpp(0, __builtin_bit_cast(int, x), CTRL, 0xf, 0xf, true)); }
struct EpiUp2 {
    static constexpr bool AFTER_DRAIN = false;
    bf16_t* H; float* halo; float* out; const float* cw; const float* cb; const float* fstate; int l; LAS unsigned char* lds;
    __device__ __forceinline__ void operator()(const f32x4 (&acc)[2][2][4][2], const Unit& u, int wr, int wc, int fr_, int fq_) const {
        int fr = fr_, fq = fq_; asm volatile("" : "+v"(fr), "+v"(fq));
        const int hcol = u.pn * 128 + wc * 32 + fq * 8;
        const float* w = cw + (size_t)l * 3 * DFF2 + hcol; const float* bb = cb + (size_t)l * DFF2 + hcol;
        LAS f32x4* wl = (LAS f32x4*)(lds + 131072 + (wc * 4 + fq) * 256);
#pragma unroll
        for (int sd = 0; sd < 2; ++sd)
#pragma unroll
            for (int hf = 0; hf < 2; ++hf) { wl[(sd * 2 + hf) * 4 + 3] = *(const f32x4*)(bb + sd * DFF + hf * 4);
#pragma unroll
                for (int tp = 0; tp < 3; ++tp) wl[(sd * 2 + hf) * 4 + tp] = *(const f32x4*)(w + tp * DFF2 + sd * DFF + hf * 4); }
        asm volatile("s_waitcnt lgkmcnt(0)" ::: "memory");
#pragma unroll
        for (int ai = 0; ai < 2; ++ai) {
            const int R = u.pm * 256 + ai * 128 + wr * 64, blk = R >> 6;
            const bool isP = R < T_P, seqstart = isP ? ((R & 8191) == 0) : true;
            f32x4 Xp[2][2];
#pragma unroll
            for (int sd = 0; sd < 2; ++sd)
#pragma unroll
                for (int hf = 0; hf < 2; ++hf) Xp[sd][hf] = (f32x4){0.f, 0.f, 0.f, 0.f};
            if (!isP && fr >= 14) { const float* fs = fstate + ((size_t)(l * 32 + (blk - 512)) * 2 + (fr - 14)) * DFF2 + hcol;
#pragma unroll
                for (int sd = 0; sd < 2; ++sd)
#pragma unroll
                    for (int hf = 0; hf < 2; ++hf) Xp[sd][hf] = *(const f32x4*)(fs + sd * DFF + hf * 4); }
#pragma unroll
            for (int m = 0; m < 4; ++m) {
                f32x4 cv[2][2];
#pragma unroll
                for (int sd = 0; sd < 2; ++sd)
#pragma unroll
                    for (int hf = 0; hf < 2; ++hf)
                    { const f32x4 w0 = wl[(sd * 2 + hf) * 4 + 0], w1 = wl[(sd * 2 + hf) * 4 + 1], w2 = wl[(sd * 2 + hf) * 4 + 2], b3 = wl[(sd * 2 + hf) * 4 + 3];
#pragma unroll
                        for (int j = 0; j < 4; ++j) {
                            const float x = acc[ai][sd][m][hf][j], xp = Xp[sd][hf][j];
                            float c = b3[j] + w2[j] * x;
                            c += w1[j] * dppz<0x111>(x); c += w1[j] * dppz<0x10F>(xp); c += w0[j] * dppz<0x112>(x); c += w0[j] * dppz<0x10E>(xp);
                            cv[sd][hf][j] = c;
                        } }
                f32x4 h0, h1;
#pragma unroll
                for (int j = 0; j < 4; ++j) { h0[j] = silu_f(cv[0][0][j]) * cv[1][0][j]; h1[j] = silu_f(cv[0][1][j]) * cv[1][1][j]; }
                const int row = R + m * 16 + fr;
                if (!(m == 0 && fr < 2 && !seqstart)) { u32x4 pk; { const u32x2 a = pack4(h0), c = pack4(h1); pk.x = a.x; pk.y = a.y; pk.z = c.x; pk.w = c.y; }
                    *(u32x4*)(H + (size_t)row * DFF + hcol) = pk; }
                float* sv = nullptr; float* sv2 = nullptr;
                if (isP) { if (m == 0 && fr < 2) sv = halo + ((size_t)blk * 4 + fr) * DFF2 + hcol;
                           if (m == 3 && fr >= 14) { sv = halo + ((size_t)blk * 4 + 2 + (fr - 14)) * DFF2 + hcol; if ((blk & 127) == 127) sv2 = out + O_PF + ((size_t)(l * 4 + (blk >> 7)) * 2 + (fr - 14)) * DFF2 + hcol; } }
                else if (m == 3 && fr >= 14) sv = out + O_SF + ((size_t)(l * 32 + (blk - 512)) * 2 + (fr - 14)) * DFF2 + hcol;
                if (sv) {
#pragma unroll
                    for (int sd = 0; sd < 2; ++sd)
#pragma unroll
                        for (int hf = 0; hf < 2; ++hf) { *(f32x4*)(sv + sd * DFF + hf * 4) = acc[ai][sd][m][hf]; if (sv2) *(f32x4*)(sv2 + sd * DFF + hf * 4) = acc[ai][sd][m][hf]; } }
#pragma unroll
                for (int sd = 0; sd < 2; ++sd)
#pragma unroll
                    for (int hf = 0; hf < 2; ++hf) Xp[sd][hf] = acc[ai][sd][m][hf];
                asm volatile("" ::: "memory");
            }
        }
    }
};

__device__ __forceinline__ void ln_row(const float* src, float* x32, bf16_t* xb, const float* g, const float* b, int lane) {
    f32x4 v[4]; float s = 0.f;
#pragma unroll
    for (int i = 0; i < 4; ++i) { v[i] = *(const f32x4*)(src + i * 256 + lane * 4); s += (v[i][0] + v[i][1]) + (v[i][2] + v[i][3]); }
#pragma unroll
    for (int o = 32; o >= 1; o >>= 1) s += __shfl_xor(s, o);
    const float mu = s * (1.0f / 1024.0f); float q = 0.f;
#pragma unroll
    for (int i = 0; i < 4; ++i) { const f32x4 d = v[i] - mu; q += (d[0] * d[0] + d[1] * d[1]) + (d[2] * d[2] + d[3] * d[3]); }
#pragma unroll
    for (int o = 32; o >= 1; o >>= 1) q += __shfl_xor(q, o);
    const float rstd = 1.0f / sqrtf(q * (1.0f / 1024.0f) + LN_EPS);
#pragma unroll
    for (int i = 0; i < 4; ++i) {
        const f32x4 gg = *(const f32x4*)(g + i * 256 + lane * 4), bb = *(const f32x4*)(b + i * 256 + lane * 4);
        const f32x4 o = (v[i] - mu) * rstd * gg + bb;
        if (x32) *(f32x4*)(x32 + i * 256 + lane * 4) = o;
        if (xb) *(u32x2*)(xb + i * 256 + lane * 4) = pack4(o);
    }
}

__device__ __forceinline__ void tr_tile(LAS float* tile, const float* src, int Nsrc, bf16_t* dst, int K, int n0, int k0, int mode, int tid) {
    const int nn = tid & 63, np = n0 + nn; int sc;
    if (mode == 0) sc = np < C_U ? np : (np < C_DT ? np + 6 : (np < C_DT + 6 ? np - 512 : -1));
    else if (mode == 1) sc = np;
    else { const int pn = np >> 8, jj = np & 255; sc = jj < 128 ? pn * 128 + jj : DFF + pn * 128 + (jj - 128); }
#pragma unroll
    for (int i = 0; i < 8; ++i) { const int kk = (tid >> 6) + 8 * i; tile[kk * 65 + nn] = sc >= 0 ? src[(size_t)(k0 + kk) * Nsrc + sc] : 0.f; }
    __syncthreads();
    const int kk2 = (tid & 31) * 2;
#pragma unroll
    for (int i = 0; i < 4; ++i) { const int nn2 = (tid >> 5) + 16 * i; *(unsigned*)(dst + (size_t)(n0 + nn2) * K + k0 + kk2) = cvt_pk_bf16(tile[kk2 * 65 + nn2], tile[(kk2 + 1) * 65 + nn2]); }
    __syncthreads();
}

__device__ __forceinline__ void phase_prep(KP& p, LAS unsigned char* lds) {
    int tid_ = threadIdx.x; asm volatile("" : "+v"(tid_));
    const int tid = tid_, wid = tid >> 6, lane = tid & 63;
    for (int row = blockIdx.x * 8 + wid; row < T_ALL; row += gridDim.x * 8) {
        const float* src = row < T_P ? p.in[0] + (size_t)row * DM : p.in[1] + (size_t)(row - T_P) * DM;
        ln_row(src, nullptr, (bf16_t*)(p.ws + W_XB) + (size_t)row * DM, p.in[7], p.in[8], lane);
    }
    constexpr int T_IN = 48 * 16, T_OUT = 16 * 16, T_UPT = 88 * 16, T_DNT = 16 * 44, T_L = T_IN + T_OUT + T_UPT + T_DNT;
    for (int it = blockIdx.x; it < 4 * T_L; it += gridDim.x) {
        const int l = it / T_L; int r = it % T_L;
        if (r < T_IN) tr_tile((LAS float*)lds, p.in[9] + (size_t)l * DM * 2950, 2950, (bf16_t*)(p.ws + W_IN + l * W_IN_L), DM, (r >> 4) * 64, (r & 15) * 64, 0, tid);
        else if ((r -= T_IN) < T_OUT) tr_tile((LAS float*)lds, p.in[19] + (size_t)l * DM * DM, DM, (bf16_t*)(p.ws + W_OUT + l * W_OUT_L), DM, (r >> 4) * 64, (r & 15) * 64, 1, tid);
        else if ((r -= T_OUT) < T_UPT) tr_tile((LAS float*)lds, p.in[22] + (size_t)l * DM * DFF2, DFF2, (bf16_t*)(p.ws + W_UP + l * W_UP_L), DM, (r >> 4) * 64, (r & 15) * 64, 2, tid);
        else { r -= T_UPT; tr_tile((LAS float*)lds, p.in[25] + (size_t)l * DFF * DM, DM, (bf16_t*)(p.ws + W_DN + l * W_DN_L), DFF, (r / 44) * 64, (r % 44) * 64, 1, tid); }
    }
    for (int i = blockIdx.x * 512 + tid; i < 4 * 4 * 128 * 128; i += gridDim.x * 512) {
        const int jj = i & 127, ii = (i >> 7) & 127;
        ((bf16_t*)(p.ws + W_GW))[i] = (bf16_t)(cvt_pk_bf16(jj <= ii ? p.in[16][i] : 0.f, 0.f) & 0xffffu);
    }
}

__device__ __forceinline__ void phase_ln(KP& p, const float* g, const float* b, bool final_out) {
    int tid_ = threadIdx.x; asm volatile("" : "+v"(tid_));
    const int wid = tid_ >> 6, lane = tid_ & 63;
    for (int row = blockIdx.x * 8 + wid; row < T_ALL; row += gridDim.x * 8)
        ln_row(p.out + (size_t)row * DM, final_out ? p.out + (size_t)row * DM : nullptr, final_out ? nullptr : (bf16_t*)(p.ws + W_XB) + (size_t)row * DM, g, b, lane);
}

__device__ __forceinline__ void dt_scan(KP& p, int l, int u, int g, int wid, int lane, float& dt, float& ac, float& last) {
    const int h = g * 3 + wid;
    dt = ((const float*)(p.ws + W_DTB))[(size_t)(u * 64 + lane) * 8 + h];
    const float a = -__expf(p.in[14][l * 6 + h]);
    float v = dt * a;
#pragma unroll
    for (int o = 1; o < 64; o <<= 1) { const float t = __shfl_up(v, o); if (lane >= o) v += t; }
    ac = v; last = __shfl(v, 63);
}

__device__ __forceinline__ f32x4 xbc_row(KP& p, int l, int u, int s, int ch) {
    const bf16_t* proj = (const bf16_t*)(p.ws + W_PROJ);
    const bool isP = u < 512; const bool hasprev = isP && (u & 127) != 0;
    if (s >= 0 || hasprev) return unpack4(*(const u32x2*)(proj + (size_t)(u * 64 + s) * NPROJ + C_XBC + ch));
    if (!isP) return *(const f32x4*)(p.in[5] + (unsigned)(((l * 32 + (u - 512)) * 3 + (3 + s)) * 896 + ch));
    return (f32x4){0.f, 0.f, 0.f, 0.f};
}
__device__ __forceinline__ void ssd_states(KP& p, LAS unsigned char* lds, int l, int u) {
    int tid_ = threadIdx.x; asm volatile("" : "+v"(tid_));
    const int tid = tid_, wid = tid >> 6, lane = tid & 63, fr = lane & 15, fq = lane >> 4;
    LAS bf16_t* xT = (LAS bf16_t*)lds;
    LAS bf16_t* BT = (LAS bf16_t*)(lds + 55296);
    LAS float* wgt = (LAS float*)(lds + 92160);
    bf16_t* XC = (bf16_t*)p.out;
    __syncthreads();
    if (wid < 6) {
        float dt, ac, last; dt_scan(p, l, u, wid / 3, wid % 3, lane, dt, ac, last);
        wgt[wid * 64 + lane] = dt * __expf(last - ac);
        if (lane == 0) ((float*)(p.ws + W_CD))[u * 8 + wid] = __expf(last);
    }
    __syncthreads();
    if (tid < 448) {
        const int cgp = tid % 224, seg = tid / 224, ch = cgp * 4, r0 = seg * 32;
        const float* cw = p.in[11] + (size_t)l * 4 * 896 + ch;
        const f32x4 w0 = *(const f32x4*)cw, w1 = *(const f32x4*)(cw + 896), w2 = *(const f32x4*)(cw + 2 * 896), w3 = *(const f32x4*)(cw + 3 * 896);
        const f32x4 bs = *(const f32x4*)(p.in[12] + (size_t)l * 896 + ch);
        f32x4 xm3 = xbc_row(p, l, u, r0 - 3, ch), xm2 = xbc_row(p, l, u, r0 - 2, ch), xm1 = xbc_row(p, l, u, r0 - 1, ch);
        const bf16_t* src = (const bf16_t*)(p.ws + W_PROJ) + (size_t)(u * 64) * NPROJ + C_XBC + ch;
        bf16_t* dst = XC + (size_t)(u * 64) * 896 + ch;
        const int hh = ch >> 6;
#pragma unroll 2
        for (int i = r0; i < r0 + 32; i += 2) {
            const f32x4 xa = unpack4(*(const u32x2*)(src + (size_t)i * NPROJ)), xb = unpack4(*(const u32x2*)(src + (size_t)(i + 1) * NPROJ));
            f32x4 ya = bs + w0 * xm3 + w1 * xm2 + w2 * xm1 + w3 * xa, yb = bs + w0 * xm2 + w1 * xm1 + w2 * xa + w3 * xb;
#pragma unroll
            for (int e = 0; e < 4; ++e) { ya[e] = silu_f(ya[e]); yb[e] = silu_f(yb[e]); }
            xm3 = xm1; xm2 = xa; xm1 = xb;
            *(u32x2*)(dst + (size_t)i * 896) = pack4(ya); *(u32x2*)(dst + (size_t)(i + 1) * 896) = pack4(yb);
            if (ch < 384) { const float wa = wgt[hh * 64 + i], wb = wgt[hh * 64 + i + 1];
#pragma unroll
                for (int e = 0; e < 4; ++e) *(LAS unsigned*)(xT + (ch + e) * 72 + i) = cvt_pk_bf16(ya[e] * wa, yb[e] * wb); }
            else if (ch < 640) {
#pragma unroll
                for (int e = 0; e < 4; ++e) *(LAS unsigned*)(BT + (ch - 384 + e) * 72 + i) = cvt_pk_bf16(ya[e], yb[e]); }
        }
    }
    __syncthreads();
    bf16_t* ST = (bf16_t*)(p.ws + W_ST);
#pragma unroll 2
    for (int k = 0; k < 24; ++k) {
        const int tt = wid * 24 + k, h = tt >> 5, pt = (tt & 31) >> 3, nt = tt & 7, g = h / 3;
        f32x4 acc = (f32x4){0.f, 0.f, 0.f, 0.f};
#pragma unroll
        for (int ks = 0; ks < 2; ++ks) {
            const bf16x8 rf = ldsfrag((LAS const unsigned char*)(xT + (h * 64 + pt * 16 + fr) * 72 + ks * 32 + fq * 8));
            const bf16x8 cf = ldsfrag((LAS const unsigned char*)(BT + (g * 128 + nt * 16 + fr) * 72 + ks * 32 + fq * 8));
            acc = MFMA16(cf, rf, acc);
        }
        *(u32x2*)(ST + ((size_t)(u * 6 + h) * 64 + pt * 16 + fr) * 128 + nt * 16 + fq * 4) = pack4(acc);
    }
}

__device__ __forceinline__ void gmlp_unit(KP& p, LAS unsigned char* lds, int l, int u) {
    int tid_ = threadIdx.x; asm volatile("" : "+v"(tid_));
    const int tid = tid_, wid = tid >> 6, lane = tid & 63, fr = lane & 15, fq = lane >> 4;
    LAS bf16_t* vT = (LAS bf16_t*)lds;
    LAS float* ssq = (LAS float*)(lds + 69632);
    const bf16_t* proj = (const bf16_t*)(p.ws + W_PROJ);
    const int half = u < 512 ? (u & 1) : 0, KJ = (half + 1) * 64, R0 = u * 64, Rb = R0 - half * 64;
    __syncthreads();
    for (int idx = tid; idx < KJ * 32; idx += 512) {
        const int j = idx & (KJ - 1), cgp = idx / KJ;
        const u32x4 w = *(const u32x4*)(proj + (size_t)(Rb + j) * NPROJ + C_VC + cgp * 8);
        const unsigned ww[4] = {w.x, w.y, w.z, w.w};
#pragma unroll
        for (int e = 0; e < 4; ++e) { vT[(cgp * 8 + 2 * e) * 136 + j] = (bf16_t)(ww[e] & 0xffffu); vT[(cgp * 8 + 2 * e + 1) * 136 + j] = (bf16_t)(ww[e] >> 16); }
    }
    __syncthreads();
    const int rt = wid & 3, cbase = (wid >> 2) * 8;
    const bf16_t* GW = (const bf16_t*)(p.ws + W_GW + l * W_GW_L);
    f32x4 acc[8];
#pragma unroll
    for (int gi = 0; gi < 2; ++gi) {
        const int gg = (cbase >> 2) + gi;
        bf16x8 rf[4];
#pragma unroll
        for (int ks = 0; ks < 4; ++ks) rf[ks] = glbfrag(GW + ((size_t)gg * 128 + half * 64 + rt * 16 + fr) * 128 + ks * 32 + fq * 8);
#pragma unroll
        for (int c4 = 0; c4 < 4; ++c4) {
            const int ct = cbase + gi * 4 + c4;
            f32x4 a = (f32x4){0.f, 0.f, 0.f, 0.f};
#pragma unroll
            for (int ks = 0; ks < 4; ++ks) if (ks * 32 < KJ) a = MFMA16(ldsfrag((LAS const unsigned char*)(vT + (ct * 16 + fr) * 136 + ks * 32 + fq * 8)), rf[ks], a);
            acc[gi * 4 + c4] = a;
        }
    }
    const int row = R0 + rt * 16 + fr; float sq = 0.f;
#pragma unroll
    for (int k = 0; k < 8; ++k) {
        const int col = (cbase + k) * 16 + fq * 4, gg = col >> 6;
        const float bsv = p.in[17][(size_t)(l * 4 + gg) * 128 + half * 64 + rt * 16 + fr];
        const f32x4 uv = unpack4(*(const u32x2*)(proj + (size_t)row * NPROJ + C_U + col));
        f32x4 o = uv * (acc[k] + bsv); acc[k] = o;
        sq += (o[0] * o[0] + o[1] * o[1]) + (o[2] * o[2] + o[3] * o[3]);
    }
    sq += __shfl_xor(sq, 16); sq += __shfl_xor(sq, 32);
    if (fq == 0) ssq[(wid >> 2) * 64 + rt * 16 + fr] = sq;
    __syncthreads();
    const float rstd = 1.0f / sqrtf((ssq[rt * 16 + fr] + ssq[64 + rt * 16 + fr]) * (1.0f / 256.0f) + RMS_EPS);
    bf16_t* mix = (bf16_t*)(p.ws + W_MIX);
#pragma unroll
    for (int k = 0; k < 8; ++k) {
        const int col = (cbase + k) * 16 + fq * 4;
        const f32x4 gv = *(const f32x4*)(p.in[18] + (size_t)l * 1024 + 768 + col);
        *(u32x2*)(mix + (size_t)row * DM + 768 + col) = pack4(acc[k] * rstd * gv);
    }
}

__device__ __forceinline__ void scan_prompt(KP& p, int l, int item) {
    int tid_ = threadIdx.x; asm volatile("" : "+v"(tid_));
    const int gid = item * 512 + tid_, e = (gid & 2047) * 4, bh = gid >> 11, b = bh / 6, h = bh % 6;
    bf16_t* ST = (bf16_t*)(p.ws + W_ST); const float* CD = (const float*)(p.ws + W_CD);
    f32x4 st = (f32x4){0.f, 0.f, 0.f, 0.f};
#pragma unroll 1
    for (int c0 = 0; c0 < 128; c0 += 8) {
        u32x2 s[8]; float cd[8];
#pragma unroll
        for (int k = 0; k < 8; ++k) { const int u = b * 128 + c0 + k; s[k] = *(const u32x2*)(ST + ((size_t)(u * 6 + h)) * 8192 + e); cd[k] = CD[u * 8 + h]; }
#pragma unroll
        for (int k = 0; k < 8; ++k) { const int u = b * 128 + c0 + k; *(u32x2*)(ST + ((size_t)(u * 6 + h)) * 8192 + e) = pack4(st); st = st * cd[k] + unpack4(s[k]); }
    }
    *(f32x4*)(p.out + O_PH + ((size_t)(l * 4 + b) * 6 + h) * 8192 + e) = st;
}
__device__ __forceinline__ void scan_sample(KP& p, int l, int item) {
    int tid_ = threadIdx.x; asm volatile("" : "+v"(tid_));
    const int gid = item * 512 + tid_, e = (gid & 2047) * 4, sbh = gid >> 11, sb = sbh / 6, h = sbh % 6;
    bf16_t* ST = (bf16_t*)(p.ws + W_ST); const float* CD = (const float*)(p.ws + W_CD);
    const int u = 512 + sb;
    const f32x4 st = *(const f32x4*)(p.in[4] + ((size_t)(l * 32 + sb) * 6 + h) * 8192 + e);
    const f32x4 s = unpack4(*(const u32x2*)(ST + ((size_t)(u * 6 + h)) * 8192 + e));
    *(u32x2*)(ST + ((size_t)(u * 6 + h)) * 8192 + e) = pack4(st);
    *(f32x4*)(p.out + O_SH + ((size_t)(l * 32 + sb) * 6 + h) * 8192 + e) = st * CD[u * 8 + h] + s;
}

__device__ __forceinline__ void attn_unit(KP& p, LAS unsigned char* lds, int l, int u) {
    int tid_ = threadIdx.x; asm volatile("" : "+v"(tid_));
    const int tid = tid_, wid = tid >> 6, lane = tid & 63, fr = lane & 15, fq = lane >> 4;
    LAS bf16_t* Kb = (LAS bf16_t*)lds;
    LAS bf16_t* VT = (LAS bf16_t*)(lds + 50176);
    LAS bf16_t* Pw = (LAS bf16_t*)(lds + 105472) + wid * 16 * 72;
    LAS float* bias = (LAS float*)(lds + 123904);
    LAS float* ssq = (LAS float*)(lds + 128512);
    const bf16_t* proj = (const bf16_t*)(p.ws + W_PROJ);
    const bool isP = u < 512; const int R0 = u * 64, c = u & 127, b = u >> 7, sb = u - 512;
    const int qt = wid & 3, hbase = (wid >> 2) * 3;
    __syncthreads();
    for (int i = tid; i < 1152; i += 512) bias[i] = p.in[10][(size_t)l * 1152 + i];
    bf16x8 qf[3][2];
#pragma unroll
    for (int hh = 0; hh < 3; ++hh)
#pragma unroll
        for (int ks = 0; ks < 2; ++ks) qf[hh][ks] = glbfrag(proj + (size_t)(R0 + qt * 16 + fr) * NPROJ + (hbase + hh) * 64 + ks * 32 + fq * 8);
    float mrun[3], lrun[3]; f32x4 O[3][4];
#pragma unroll
    for (int hh = 0; hh < 3; ++hh) { mrun[hh] = -1e30f; lrun[hh] = 0.f;
#pragma unroll
        for (int d = 0; d < 4; ++d) O[hh][d] = (f32x4){0.f, 0.f, 0.f, 0.f}; }
    const int blk_lo = isP ? (c < 8 ? 8 - c : 0) : 0;
    u32x4 kr[6], vr[6];
    const int kkey0 = tid / 48, kcg = tid % 48;
    const int vkp = tid & 31, vcg0 = tid >> 5;
#define ATT_LOADP(blkv) do { const size_t rb_ = isP ? (size_t)b * 8192 + (size_t)(c - 8 + (blkv)) * 64 : (size_t)T_P + (size_t)sb * 64; \
        _Pragma("unroll") for (int it = 0; it < 2; ++it) { const int cg_ = vcg0 + it * 16; \
            vr[2 * it] = *(const u32x4*)(proj + (rb_ + 2 * vkp) * NPROJ + C_V + cg_ * 8); vr[2 * it + 1] = *(const u32x4*)(proj + (rb_ + 2 * vkp + 1) * NPROJ + C_V + cg_ * 8); } } while (0)
    bool have = false;
    if (isP || blk_lo == 8) { ATT_LOADP(blk_lo); have = true; }
#pragma unroll 1
    for (int blk = blk_lo; blk <= 8; ++blk) {
        __syncthreads();
        if (!have) {
#pragma unroll
            for (int it = 0; it < 6; ++it) { const int idx = it * 512 + tid;
                const float* s = p.in[2] + ((size_t)(l * 32 + sb) * 512 + blk * 64 + idx / 48) * 384 + (idx % 48) * 8; const f32x4 a = *(const f32x4*)s, bq = *(const f32x4*)(s + 4);
                kr[it].x = cvt_pk_bf16(a[0], a[1]); kr[it].y = cvt_pk_bf16(a[2], a[3]); kr[it].z = cvt_pk_bf16(bq[0], bq[1]); kr[it].w = cvt_pk_bf16(bq[2], bq[3]); }
#pragma unroll
            for (int it = 0; it < 6; ++it) { const int cg_ = vcg0 + (it >> 1) * 16;
                const float* s = p.in[3] + ((size_t)(l * 32 + sb) * 512 + blk * 64 + 2 * vkp + (it & 1)) * 384 + cg_ * 8; const f32x4 a = *(const f32x4*)s, bq = *(const f32x4*)(s + 4);
                vr[it].x = cvt_pk_bf16(a[0], a[1]); vr[it].y = cvt_pk_bf16(a[2], a[3]); vr[it].z = cvt_pk_bf16(bq[0], bq[1]); vr[it].w = cvt_pk_bf16(bq[2], bq[3]); }
        }
        if (have) { const size_t rb_ = isP ? (size_t)b * 8192 + (size_t)(c - 8 + blk) * 64 : (size_t)T_P + (size_t)sb * 64;
#pragma unroll
            for (int it = 0; it < 6; ++it) { const int idx = it * 512 + tid; kr[it] = *(const u32x4*)(proj + (rb_ + idx / 48) * NPROJ + C_K + (idx % 48) * 8); }
            { const int cg_ = vcg0 + 2 * 16; vr[4] = *(const u32x4*)(proj + (rb_ + 2 * vkp) * NPROJ + C_V + cg_ * 8); vr[5] = *(const u32x4*)(proj + (rb_ + 2 * vkp + 1) * NPROJ + C_V + cg_ * 8); } }
#pragma unroll
        for (int it = 0; it < 3; ++it) { const int cg_ = vcg0 + it * 16; const u32x4 w0 = vr[2 * it], w1 = vr[2 * it + 1];
            const unsigned a0[4] = {w0.x, w0.y, w0.z, w0.w}, a1[4] = {w1.x, w1.y, w1.z, w1.w};
#pragma unroll
            for (int e = 0; e < 4; ++e) {
                *(LAS unsigned*)(VT + (cg_ * 8 + 2 * e) * 72 + 2 * vkp) = (a0[e] & 0xffffu) | (a1[e] << 16);
                *(LAS unsigned*)(VT + (cg_ * 8 + 2 * e + 1) * 72 + 2 * vkp) = (a0[e] >> 16) | (a1[e] & 0xffff0000u); } }
#pragma unroll
        for (int it = 0; it < 6; ++it) { const int idx = it * 512 + tid; *(LAS u32x4*)(Kb + (idx / 48) * 392 + (idx % 48) * 8) = kr[it]; }
        __syncthreads();
        have = false;
        if (blk < 8 && (isP || blk == 7)) { ATT_LOADP(blk + 1); have = true; }
#pragma unroll
        for (int hh = 0; hh < 3; ++hh) {
            const int h = hbase + hh;
            f32x4 s[4]; float mx = -1e30f;
#pragma unroll
            for (int kt = 0; kt < 4; ++kt) {
                f32x4 a = (f32x4){0.f, 0.f, 0.f, 0.f};
#pragma unroll
                for (int ks = 0; ks < 2; ++ks) a = MFMA16(ldsfrag((LAS const unsigned char*)(Kb + (kt * 16 + fr) * 392 + h * 64 + ks * 32 + fq * 8)), qf[hh][ks], a);
                if (blk <= 5) { const float bc = bias[h * 192 + 191];
#pragma unroll
                    for (int j = 0; j < 4; ++j) { a[j] = a[j] * 0.125f + bc; mx = fmaxf(mx, a[j]); } }
                else {
#pragma unroll
                    for (int j = 0; j < 4; ++j) {
                        int rel = (qt * 16 + fr) + 512 - (blk * 64 + kt * 16 + fq * 4 + j); rel = rel > 128 ? 128 : rel;
                        a[j] = a[j] * 0.125f + bias[h * 192 + rel + 63]; mx = fmaxf(mx, a[j]);
                    } }
                s[kt] = a;
            }
            mx = fmaxf(mx, __shfl_xor(mx, 16)); mx = fmaxf(mx, __shfl_xor(mx, 32));
            const float mnew = fmaxf(mrun[hh], mx), fac = __expf(mrun[hh] - mnew); mrun[hh] = mnew;
            float rs = 0.f;
#pragma unroll
            for (int kt = 0; kt < 4; ++kt)
#pragma unroll
                for (int j = 0; j < 4; ++j) { s[kt][j] = __expf(s[kt][j] - mnew); rs += s[kt][j]; }
            lrun[hh] = lrun[hh] * fac + rs;
#pragma unroll
            for (int d = 0; d < 4; ++d) O[hh][d] *= fac;
#pragma unroll
            for (int ks = 0; ks < 2; ++ks) {
                const u32x2 pa = pack4(s[2 * ks]), pb = pack4(s[2 * ks + 1]);
                const bf16x8 pf = __builtin_bit_cast(bf16x8, (u32x4){pa.x, pa.y, pb.x, pb.y});
#pragma unroll
                for (int d = 0; d < 4; ++d) {
                    const LAS bf16_t* vrow = VT + (h * 64 + d * 16 + fr) * 72 + ks * 32 + fq * 4;
                    const u32x2 va = *(const LAS u32x2*)vrow, vb = *(const LAS u32x2*)(vrow + 16);
                    O[hh][d] = MFMA16(__builtin_bit_cast(bf16x8, (u32x4){va.x, va.y, vb.x, vb.y}), pf, O[hh][d]);
                }
            }
        }
    }
#pragma unroll
    for (int hh = 0; hh < 3; ++hh) { lrun[hh] += __shfl_xor(lrun[hh], 16); lrun[hh] += __shfl_xor(lrun[hh], 32); }
    float sq = 0.f;
#pragma unroll
    for (int hh = 0; hh < 3; ++hh) { const float inv = 1.0f / lrun[hh];
#pragma unroll
        for (int d = 0; d < 4; ++d) { O[hh][d] *= inv; const f32x4 o = O[hh][d]; sq += (o[0] * o[0] + o[1] * o[1]) + (o[2] * o[2] + o[3] * o[3]); } }
    sq += __shfl_xor(sq, 16); sq += __shfl_xor(sq, 32);
    if (fq == 0) ssq[(wid >> 2) * 64 + qt * 16 + fr] = sq;
    __syncthreads();
    const float rstd = 1.0f / sqrtf((ssq[qt * 16 + fr] + ssq[64 + qt * 16 + fr]) * (1.0f / 384.0f) + RMS_EPS);
    bf16_t* mix = (bf16_t*)(p.ws + W_MIX);
#pragma unroll
    for (int hh = 0; hh < 3; ++hh)
#pragma unroll
        for (int d = 0; d < 4; ++d) {
            const int col = (hbase + hh) * 64 + d * 16 + fq * 4;
            const f32x4 gv = *(const f32x4*)(p.in[18] + (size_t)l * 1024 + col);
            *(u32x2*)(mix + (size_t)(R0 + qt * 16 + fr) * DM + col) = pack4(O[hh][d] * rstd * gv);
        }
}

__device__ __forceinline__ void ssd_y(KP& p, LAS unsigned char* lds, int l, int u) {
    int tid_ = threadIdx.x; asm volatile("" : "+v"(tid_));
    const int tid = tid_, wid = tid >> 6, lane = tid & 63, fr = lane & 15, fq = lane >> 4;
    LAS bf16_t* Cn = (LAS bf16_t*)lds;
    LAS bf16_t* Bn = (LAS bf16_t*)(lds + 17408);
    LAS bf16_t* xT = (LAS bf16_t*)(lds + 34816);
    LAS bf16_t* Mm = (LAS bf16_t*)(lds + 62464);
    LAS float* dtl = (LAS float*)(lds + 90112);
    LAS float* acl = (LAS float*)(lds + 90880);
    LAS float* ssq = (LAS float*)(lds + 91648);
    const bf16_t* proj = (const bf16_t*)(p.ws + W_PROJ);
    const bf16_t* HP = (const bf16_t*)(p.ws + W_ST);
    const bf16_t* XC = (const bf16_t*)p.out + (size_t)(u * 64) * 896;
    const int R0 = u * 64, lt = wid & 3;
    f32x4 yacc[2][6];
#pragma unroll
    for (int g = 0; g < 2; ++g) {
        __syncthreads();
        if (wid < 3) { float dt, ac, last; dt_scan(p, l, u, g, wid, lane, dt, ac, last); dtl[wid * 64 + lane] = dt; acl[wid * 64 + lane] = ac; }
#pragma unroll
        for (int it = 0; it < 4; ++it) {
            const int idx = it * 512 + tid, mat = idx >> 10, i = (idx >> 4) & 63, c8 = idx & 15;
            const u32x4 w = *(const u32x4*)(XC + (size_t)i * 896 + 384 + mat * 256 + g * 128 + c8 * 8);
            *(LAS u32x4*)((mat ? Cn : Bn) + i * 136 + c8 * 8) = w;
        }
#pragma unroll
        for (int it = 0; it < 3; ++it) {
            const int idx = it * 512 + tid, c4 = idx % 48, i = (idx / 48) * 2;
            const u32x2 wa = *(const u32x2*)(XC + (size_t)i * 896 + g * 192 + c4 * 4), wb = *(const u32x2*)(XC + (size_t)(i + 1) * 896 + g * 192 + c4 * 4);
            *(LAS unsigned*)(xT + (c4 * 4 + 0) * 72 + i) = (wa.x & 0xffffu) | (wb.x << 16);
            *(LAS unsigned*)(xT + (c4 * 4 + 1) * 72 + i) = (wa.x >> 16) | (wb.x & 0xffff0000u);
            *(LAS unsigned*)(xT + (c4 * 4 + 2) * 72 + i) = (wa.y & 0xffffu) | (wb.y << 16);
            *(LAS unsigned*)(xT + (c4 * 4 + 3) * 72 + i) = (wa.y >> 16) | (wb.y & 0xffff0000u);
        }
        __syncthreads();
#pragma unroll
        for (int k = 0; k < 2; ++k) {
            const int st = (wid >> 2) * 2 + k;
            f32x4 a = (f32x4){0.f, 0.f, 0.f, 0.f};
#pragma unroll
            for (int ks = 0; ks < 4; ++ks) a = MFMA16(ldsfrag((LAS const unsigned char*)(Bn + (st * 16 + fr) * 136 + ks * 32 + fq * 8)), ldsfrag((LAS const unsigned char*)(Cn + (lt * 16 + fr) * 136 + ks * 32 + fq * 8)), a);
            const int li = lt * 16 + fr;
#pragma unroll
            for (int hh = 0; hh < 3; ++hh) {
                const float al = acl[hh * 64 + li]; f32x4 mv;
#pragma unroll
                for (int j = 0; j < 4; ++j) { const int si = st * 16 + fq * 4 + j; mv[j] = si <= li ? a[j] * __expf(al - acl[hh * 64 + si]) * dtl[hh * 64 + si] : 0.f; }
                *(LAS u32x2*)(Mm + (hh * 64 + li) * 72 + st * 16 + fq * 4) = pack4(mv);
            }
        }
        __syncthreads();
#pragma unroll
        for (int k = 0; k < 6; ++k) {
            const int ctile = (wid >> 2) * 6 + k, hh = ctile >> 2, pt = ctile & 3, h = g * 3 + hh, li = lt * 16 + fr;
            f32x4 ad = (f32x4){0.f, 0.f, 0.f, 0.f}, ao = (f32x4){0.f, 0.f, 0.f, 0.f};
#pragma unroll
            for (int ks = 0; ks < 2; ++ks) ad = MFMA16(ldsfrag((LAS const unsigned char*)(xT + (hh * 64 + pt * 16 + fr) * 72 + ks * 32 + fq * 8)), ldsfrag((LAS const unsigned char*)(Mm + (hh * 64 + li) * 72 + ks * 32 + fq * 8)), ad);
#pragma unroll
            for (int ks = 0; ks < 4; ++ks) ao = MFMA16(glbfrag(HP + ((size_t)(u * 6 + h) * 64 + pt * 16 + fr) * 128 + ks * 32 + fq * 8), ldsfrag((LAS const unsigned char*)(Cn + li * 136 + ks * 32 + fq * 8)), ao);
            const float ea = __expf(acl[hh * 64 + li]), dsk = p.in[15][l * 6 + h];
            const f32x4 xv = unpack4(*(const u32x2*)(XC + (size_t)li * 896 + h * 64 + pt * 16 + fq * 4));
            const f32x4 zv = unpack4(*(const u32x2*)(proj + (size_t)(R0 + li) * NPROJ + C_Z + h * 64 + pt * 16 + fq * 4));
            f32x4 y = ad + ao * ea + xv * dsk;
#pragma unroll
            for (int j = 0; j < 4; ++j) y[j] *= silu_f(zv[j]);
            yacc[g][k] = y;
            asm volatile("" ::: "memory");
        }
    }
    float sq = 0.f;
#pragma unroll
    for (int g = 0; g < 2; ++g)
#pragma unroll
        for (int k = 0; k < 6; ++k) { const f32x4 o = yacc[g][k]; sq += (o[0] * o[0] + o[1] * o[1]) + (o[2] * o[2] + o[3] * o[3]); }
    sq += __shfl_xor(sq, 16); sq += __shfl_xor(sq, 32);
    if (fq == 0) ssq[(wid >> 2) * 64 + lt * 16 + fr] = sq;
    __syncthreads();
    const float rstd = 1.0f / sqrtf((ssq[lt * 16 + fr] + ssq[64 + lt * 16 + fr]) * (1.0f / 384.0f) + RMS_EPS);
    bf16_t* mix = (bf16_t*)(p.ws + W_MIX);
#pragma unroll
    for (int g = 0; g < 2; ++g)
#pragma unroll
        for (int k = 0; k < 6; ++k) {
            const int col = 384 + g * 192 + ((wid >> 2) * 6 + k) * 16 + fq * 4;
            const f32x4 gv = *(const f32x4*)(p.in[18] + (size_t)l * 1024 + col);
            *(u32x2*)(mix + (size_t)(R0 + lt * 16 + fr) * DM + col) = pack4(yacc[g][k] * rstd * gv);
        }
}

__device__ __forceinline__ void phase_fix(KP& p, int l) {
    const float* halo = (const float*)(p.ws + W_MIX); bf16_t* H = (bf16_t*)(p.ws + W_PROJ);
    const float* w = p.in[23] + (size_t)l * 3 * DFF2; const float* bb = p.in[24] + (size_t)l * DFF2;
    int tid_ = threadIdx.x; asm volatile("" : "+v"(tid_));
    for (int i = blockIdx.x * 512 + tid_; i < 128 * DFF2; i += gridDim.x * 512) {
        const int pm = i / DFF2, cc = i % DFF2;
        if ((pm & 31) == 0 || cc >= DFF) continue;
        const float* h0 = halo + (size_t)(pm - 1) * 4 * DFF2; const float* h1 = halo + (size_t)pm * 4 * DFF2;
        float r[2];
#pragma unroll
        for (int rr = 0; rr < 2; ++rr) {
            float o[2];
#pragma unroll
            for (int gv = 0; gv < 2; ++gv) {
                const int c2 = cc + gv * DFF;
                const float xm2 = h0[2 * DFF2 + c2], xm1 = h0[3 * DFF2 + c2], x0 = h1[c2], x1 = h1[DFF2 + c2];
                o[gv] = rr == 0 ? bb[c2] + w[c2] * xm2 + w[DFF2 + c2] * xm1 + w[2 * DFF2 + c2] * x0 : bb[c2] + w[c2] * xm1 + w[DFF2 + c2] * x0 + w[2 * DFF2 + c2] * x1;
            }
            r[rr] = silu_f(o[0]) * o[1];
        }
        H[((size_t)pm * 256) * DFF + cc] = (bf16_t)(cvt_pk_bf16(r[0], 0.f) & 0xffffu);
        H[((size_t)pm * 256 + 1) * DFF + cc] = (bf16_t)(cvt_pk_bf16(r[1], 0.f) & 0xffffu);
    }
}

#define XB_TMO      128
#define XB_XCNT(j)  (256  + 64 * (j))
#define XB_XSUB(j)  (1280 + 64 * (j))
#define XB_XGEN(j)  (2304 + 64 * (j))
#define XB_TOP      3328
#define XB_TOPGEN   3392
#define XCD_BAR_WORDS 3456
#define XB_SPIN_CAP (1u << 18)

__device__ __forceinline__ unsigned xb_ld(unsigned* p)              { return __hip_atomic_load(p, __ATOMIC_RELAXED, __HIP_MEMORY_SCOPE_AGENT); }
__device__ __forceinline__ unsigned xb_add(unsigned* p, unsigned v) { return __hip_atomic_fetch_add(p, v, __ATOMIC_RELAXED, __HIP_MEMORY_SCOPE_AGENT); }
__device__ __forceinline__ unsigned xb_xcc_id() { return (unsigned)__builtin_amdgcn_s_getreg((3 << 11) | 20) & 0xFu; }
#define XB_SPIN(cond, bar) do { unsigned _sp = 0; while (cond) { __builtin_amdgcn_s_sleep(1); \
    if ((++_sp & 255u) == 0u) { if (xb_ld(&(bar)[XB_TMO])) break; if (_sp > XB_SPIN_CAP) { atomicAdd(&(bar)[XB_TMO], 1u); break; } } } } while (0)

struct XcdBarrier {
    unsigned* bar; unsigned x;
    volatile LAS unsigned* st;
};

__device__ __forceinline__ XcdBarrier xcd_barrier_post(unsigned* bar, volatile LAS unsigned* st) {
    XcdBarrier b; b.bar = bar; b.x = xb_xcc_id(); b.st = st;
    if (threadIdx.x == 0) (void)xb_add(&bar[XB_XCNT(b.x)], 1u);
    return b;
}
__device__ __forceinline__ void xcd_barrier_complete(unsigned* bar, unsigned x, unsigned& nloc, unsigned& nx) {
    const unsigned G = gridDim.x * gridDim.y * gridDim.z;
    unsigned sum, cnt, mine, sp = 0u;
    for (;;) {
        sum = 0u; cnt = 0u; mine = 0u;
#pragma unroll
        for (unsigned j = 0; j < 16; ++j) { const unsigned c = xb_ld(&bar[XB_XCNT(j)]); sum += c; cnt += (c > 0u) ? 1u : 0u; mine = (j == x) ? c : mine; }
        if (sum == G) break;
        __builtin_amdgcn_s_sleep(1);
        if ((++sp & 255u) == 0u) { if (xb_ld(&bar[XB_TMO])) break; if (sp > XB_SPIN_CAP) { atomicAdd(&bar[XB_TMO], 1u); break; } }
    }
    nloc = mine > 0u ? mine : 1u; nx = cnt > 0u ? cnt : 1u;
}

__device__ __forceinline__ void xcd_barrier(const XcdBarrier& b) {
    asm volatile("s_waitcnt vmcnt(0)" ::: "memory");
    __syncthreads();
    if (threadIdx.x == 0) {
        unsigned* bar = b.bar;
        __builtin_amdgcn_s_waitcnt(0);
        unsigned nloc = b.st[0], nx = b.st[1];
        if (nloc == 0u) { xcd_barrier_complete(bar, b.x, nloc, nx); b.st[0] = nloc; b.st[1] = nx; }
        const unsigned old = xb_add(&bar[XB_XSUB(b.x)], 1u);
        const unsigned gen = old / nloc;
        if (old + 1u == (gen + 1u) * nloc) {
            __builtin_amdgcn_fence(__ATOMIC_RELEASE, "agent");
            asm volatile("s_waitcnt vmcnt(0)" ::: "memory");
            const unsigned og = xb_add(&bar[XB_TOP], 1u);
            const unsigned tg = og / nx;
            if (og + 1u == (tg + 1u) * nx) xb_add(&bar[XB_TOPGEN], 1u);
            else XB_SPIN(xb_ld(&bar[XB_TOPGEN]) == tg, bar);
            __builtin_amdgcn_fence(__ATOMIC_ACQUIRE, "agent");
            xb_add(&bar[XB_XGEN(b.x)], 1u);
            asm volatile("s_waitcnt vmcnt(0)" ::: "memory");
        } else {
            XB_SPIN(xb_ld(&bar[XB_XGEN(b.x)]) == gen, bar);
            __builtin_amdgcn_fence(__ATOMIC_ACQUIRE, "agent");
            asm volatile("s_waitcnt vmcnt(0)" ::: "memory");
        }
    }
    __syncthreads();
}

__global__ void __launch_bounds__(512, 2) mega(Params pa) {
    extern __shared__ __attribute__((aligned(16))) unsigned char shm[];
    LAS unsigned char* lds = (LAS unsigned char*)shm;
    const int G = gridDim.x, bid = blockIdx.x;
    KP* pk = (KP*)__builtin_amdgcn_kernarg_segment_ptr();
    volatile LAS unsigned* bst = (volatile LAS unsigned*)(lds + LDS_BYTES - 16);
    XcdBarrier xb; xb.bar = nullptr; xb.x = 0; xb.st = bst;
    if (pa.coop) { if (threadIdx.x < 2) bst[threadIdx.x] = 0u; __syncthreads(); xb = xcd_barrier_post((unsigned*)(pa.ws + W_BAR), bst); }
    for (int ph = pa.ph_lo; ph < pa.ph_hi; ++ph) {
        if (ph > pa.ph_lo && pa.coop) { if (ph == pa.ph_lo + 1) { __threadfence(); cg::this_grid().sync(); } else xcd_barrier(xb); }
        asm volatile("" : "+s"(pk)); KP& p = *pk;
        if (ph == 0) { phase_prep(p, lds); continue; }
        if (ph == 42) { int tq = threadIdx.x; asm volatile("" : "+v"(tq)); const unsigned short* w16 = (const unsigned short*)p.ws; for (size_t i = (size_t)bid * 512 + tq; i < (size_t)59418624; i += (size_t)G * 512) p.out[i] = (float)w16[i * 4]; continue; }
        if (ph == 41) { int tq = threadIdx.x; asm volatile("" : "+v"(tq)); for (size_t i = (size_t)bid * 512 + tq; i < (size_t)59418624; i += (size_t)G * 512) { const float v = p.out[i]; if (!(fabsf(v) < 1e30f)) p.out[i] = 0.f; } continue; }
        const int l = (ph - 1) / 10, k = (ph - 1) % 10;
        bf16_t* XB = (bf16_t*)(p.ws + W_XB);
        switch (k) {
        case 0: if (REP_G1 > 1) { pg8::StaticOrder S; S.init(T_ALL, NPROJ, G, bid); EpiNull E{(float*)(p.ws + W_CD)};
                  pg8::gemm_phase(lds, pg8::Gemm{XB, (const bf16_t*)(p.ws + W_IN + l * W_IN_L), T_ALL, NPROJ, DM}, S, E); }
                { pg8::StaticOrder S; S.init(T_ALL, NPROJ, G, bid);
                  EpiIn E{(bf16_t*)(p.ws + W_PROJ), p.out, (float*)(p.ws + W_DTB), p.in[13], l};
                  pg8::gemm_phase(lds, pg8::Gemm{XB, (const bf16_t*)(p.ws + W_IN + l * W_IN_L), T_ALL, NPROJ, DM}, S, E); } break;
        case 1: for (int it = bid; it < 3 * NU64; it += G) { if (it < NU64) attn_unit(p, lds, l, NU64 - 1 - it); else if (it < 2 * NU64) ssd_states(p, lds, l, it - NU64); else gmlp_unit(p, lds, l, it - 2 * NU64); } break;
        case 2: for (int it = bid; it < 96 + 768; it += G) { if (it < 96) scan_prompt(p, l, it); else scan_sample(p, l, it - 96); } break;
        case 3: for (int rep = 0; rep < REP_M3; ++rep) for (int it = bid; it < NU64; it += G) ssd_y(p, lds, l, it); break;
        case 4: { pg8::StaticOrder S; S.init(T_ALL, DM, G, bid); EpiRes E{p.out, XB};
                  pg8::gemm_phase(lds, pg8::Gemm{(const bf16_t*)(p.ws + W_MIX), (const bf16_t*)(p.ws + W_OUT + l * W_OUT_L), T_ALL, DM, DM}, S, E); } break;
        case 5: phase_ln(p, p.in[20] + l * DM, p.in[21] + l * DM, false); break;
        case 6: for (int rep = 0; rep < REP_G3; ++rep) { pg8::StaticOrder S; S.init(T_ALL, DFF2, G, bid);
                  EpiUp E{(bf16_t*)(p.ws + W_PROJ), (float*)(p.ws + W_MIX), p.out, p.in[23], p.in[24], p.in[6], l};
                  pg8::OneUnit o1;
                  for (int i = 0; S.next(i, o1.u); ++i) { pg8::gemm_phase(lds, pg8::Gemm{XB, (const bf16_t*)(p.ws + W_UP + l * W_UP_L), T_ALL, DFF2, DM}, o1, E); __syncthreads(); } } break;
        case 7: phase_fix(p, l); break;
        case 8: { pg8::StaticOrder S; S.init(T_ALL, DM, G, bid); EpiRes E{p.out, XB};
                  pg8::gemm_phase(lds, pg8::Gemm{(const bf16_t*)(p.ws + W_PROJ), (const bf16_t*)(p.ws + W_DN + l * W_DN_L), T_ALL, DM, DFF}, S, E); } break;
        case 9: phase_ln(p, p.in[26] + l * DM, p.in[27] + l * DM, l == DEPTH - 1); break;
        }
    }
}

constexpr int N_PHASES = 41;
#ifndef MULTI_LAUNCH
#define MULTI_LAUNCH 0
#endif

extern "C" void kernel_launch(void* const* d_in, const int* in_sizes, int n_in, void* d_out, int out_size, void* d_ws, size_t ws_size, hipStream_t stream) {
    static int grid = 0;
    if (grid == 0) {
        if (n_in != 28 || ws_size < W_END2) { fprintf(stderr, "kernel_launch: need 28 inputs and %zu bytes of workspace (got %d, %zu)\n", (size_t)W_END2, n_in, ws_size); grid = -1; return; }
        int dev = 0, cus = 0, per_cu = 0;
        hipGetDevice(&dev); hipDeviceGetAttribute(&cus, hipDeviceAttributeMultiprocessorCount, dev);
        if (hipFuncSetAttribute((const void*)mega, hipFuncAttributeMaxDynamicSharedMemorySize, LDS_BYTES) != hipSuccess) { fprintf(stderr, "kernel_launch: hipFuncSetAttribute failed\n"); grid = -1; return; }
        hipOccupancyMaxActiveBlocksPerMultiprocessor(&per_cu, (const void*)mega, 512, LDS_BYTES);
        (void)hipGetLastError();
        if (per_cu < 1) per_cu = 1;
        grid = cus * 1;
    }
    if (grid < 0) return;
    Params p{};
    for (int i = 0; i < 28; ++i) p.in[i] = (const float*)d_in[i];
    p.out = (float*)d_out; p.ws = (unsigned char*)d_ws;
#if MULTI_LAUNCH
#ifdef PROBE_CUT
    for (int ph = 0; ph < PROBE_CUT; ++ph) { p.ph_lo = ph; p.ph_hi = ph + 1; p.coop = 0; hipLaunchKernelGGL(mega, dim3(grid), dim3(512), LDS_BYTES, stream, p); }
    p.ph_lo = 42; p.ph_hi = 43; p.coop = 0; hipLaunchKernelGGL(mega, dim3(grid), dim3(512), LDS_BYTES, stream, p);
#else
    for (int ph = 0; ph < N_PHASES; ++ph) { p.ph_lo = ph; p.ph_hi = ph + 1; p.coop = 0; hipLaunchKernelGGL(mega, dim3(grid), dim3(512), LDS_BYTES, stream, p); }
#endif
#else
    p.ph_lo = 0; p.ph_hi = N_PHASES; p.coop = 1;
    if (hipMemsetAsync((char*)d_ws + W_BAR, 0, 16384, stream) != hipSuccess) { fprintf(stderr, "kernel_launch: memset failed\n"); return; }
    void* args[] = {&p};
    hipError_t e = hipLaunchCooperativeKernel((const void*)mega, dim3(grid), dim3(512), args, LDS_BYTES, stream);
    if (e != hipSuccess) fprintf(stderr, "cooperative launch failed: %s (grid %d)\n", hipGetErrorString(e), grid);
#endif
}
```

```cpp
#define REP_G1 1
#define REP_M1 1
#define REP_ATT 1
#define REP_M3 1
#define REP_G3 1
#include <hip/hip_runtime.h>
#include <hip/hip_cooperative_groups.h>
#include <cstdio>
namespace cg = cooperative_groups;

#define LAS __attribute__((address_space(3)))
typedef unsigned short bf16_t;
typedef short bf16x8 __attribute__((ext_vector_type(8)));
typedef float f32x4 __attribute__((ext_vector_type(4)));
typedef float f32x2 __attribute__((ext_vector_type(2)));
typedef unsigned u32x4 __attribute__((ext_vector_type(4)));
typedef unsigned u32x2 __attribute__((ext_vector_type(2)));

constexpr int T_ALL = 34816, T_P = 32768, DM = 1024, NPROJ = 3072, DFF = 2816, DFF2 = 5632, DEPTH = 4;
constexpr int NU64 = 544;
constexpr float ALPHA = 1.6817928305074290f;
constexpr float LN_EPS = 1e-5f, RMS_EPS = 1e-5f;
constexpr int C_K = 384, C_V = 768, C_Z = 1152, C_XBC = 1536, C_U = 2432, C_VC = 2688, C_DT = 2944;
constexpr size_t O_YP = 0, O_YS = 33554432, O_PK = 35651584, O_PV = O_PK + 3145728, O_PH = O_PV + 3145728, O_PC = O_PH + 786432,
                 O_PF = O_PC + 43008, O_SK = O_PF + 180224, O_SV = O_SK + 3145728, O_SH = O_SV + 3145728, O_SC = O_SH + 6291456,
                 O_SG = O_SC + 344064, O_SF = O_SG + 2097152;
constexpr size_t W_IN = 0, W_IN_L = (size_t)NPROJ * DM * 2;
constexpr size_t W_OUT = W_IN + 4 * W_IN_L, W_OUT_L = (size_t)DM * DM * 2;
constexpr size_t W_UP = W_OUT + 4 * W_OUT_L, W_UP_L = (size_t)DFF2 * DM * 2;
constexpr size_t W_DN = W_UP + 4 * W_UP_L, W_DN_L = (size_t)DM * DFF * 2;
constexpr size_t W_GW = W_DN + 4 * W_DN_L, W_GW_L = (size_t)4 * 128 * 128 * 2;
constexpr size_t W_XB = W_GW + 4 * W_GW_L;
constexpr size_t W_PROJ = W_XB + (size_t)T_ALL * DM * 2;
constexpr size_t W_MIX = W_PROJ + (size_t)T_ALL * NPROJ * 2;
constexpr size_t W_ST = W_MIX + (size_t)T_ALL * DM * 2;
constexpr size_t W_CD = W_ST + (size_t)NU64 * 6 * 8192 * 2;
constexpr size_t W_DTB = W_CD + (size_t)NU64 * 8 * 4;
constexpr size_t W_END = W_DTB + (size_t)T_ALL * 8 * 4;
constexpr size_t W_BAR = W_END;
constexpr size_t W_END2 = W_BAR + 16384;
constexpr int LDS_BYTES = 136 * 1024;

struct Params { const float* in[28]; float* out; unsigned char* ws; int ph_lo, ph_hi, coop, pad; };
typedef const __attribute__((address_space(4))) Params KP;

__device__ __forceinline__ float bf2f(unsigned b) { return __uint_as_float(b << 16); }
typedef __bf16 bf16v2 __attribute__((ext_vector_type(2)));
__device__ __forceinline__ unsigned cvt_pk_bf16(float lo, float hi) { const f32x2 v = {lo, hi}; const bf16v2 b = __builtin_convertvector(v, bf16v2); return __builtin_bit_cast(unsigned, b); }
__device__ __forceinline__ u32x2 pack4(f32x4 v) { u32x2 w; w.x = cvt_pk_bf16(v[0], v[1]); w.y = cvt_pk_bf16(v[2], v[3]); return w; }
__device__ __forceinline__ f32x4 unpack4(u32x2 w) { f32x4 v; v[0] = bf2f(w.x & 0xffffu); v[1] = bf2f(w.x >> 16); v[2] = bf2f(w.y & 0xffffu); v[3] = bf2f(w.y >> 16); return v; }
__device__ __forceinline__ float silu_f(float x) { return x * __builtin_amdgcn_rcpf(1.0f + __expf(-x)); }
__device__ __forceinline__ float gelu_tanh(float x) { const float y = 0.7978845608028654f * (x + 0.044715f * x * x * x); const float e = __expf(2.0f * y); return 0.5f * x * (2.0f - 2.0f * __builtin_amdgcn_rcpf(1.0f + e)); }
__device__ __forceinline__ float softplus_f(float x) { const float e = __expf(x); return x > 15.0f ? x : (e < 1e-3f ? e * (1.0f - 0.5f * e + 0.33333333f * e * e) : __logf(1.0f + e)); }
#define MFMA16(colfrag, rowfrag, acc) __builtin_amdgcn_mfma_f32_16x16x32_bf16((colfrag), (rowfrag), (acc), 0, 0, 0)
__device__ __forceinline__ bf16x8 ldsfrag(LAS const unsigned char* p) { return *(LAS const bf16x8*)p; }
__device__ __forceinline__ bf16x8 glbfrag(const bf16_t* p) { return *(const bf16x8*)p; }
#define LDS_WAVE_SYNC() asm volatile("s_waitcnt lgkmcnt(0)" ::: "memory")

namespace pg8 {
constexpr int BM = 256, BK = 64, HALF = 128, HTB = HALF * BK * 2, STAGE_BYTES = 8 * HTB, NXCD = 8, WGM = 8;
__device__ __forceinline__ int lds_byte(int r, int c) { const int st = (r >> 4) * 2 + (c >> 5), rr = r & 15, cc = c & 31, ob = rr * 64 + cc * 2; return st * 1024 + (ob ^ (((ob >> 9) & 1) << 5)); }
__device__ __forceinline__ void stage_rc(int b, int& R, int& C) { const int st = b / 1024, sb = b % 1024, swz = sb ^ (((sb >> 9) & 1) << 5); R = (st >> 1) * 16 + swz / 64; C = (st & 1) * 32 + (swz % 64) / 2; }
__device__ __forceinline__ int perm32(int rho) { const int n = rho >> 4, i = rho & 15; return 8 * (i >> 2) + 4 * n + (i & 3); }
struct Unit { int pm, pn; };
struct Gemm { const bf16_t* A; const bf16_t* Bt; int M, N, K; };
struct StaticOrder {
    int nM, nN, nwg, G, c;
    __device__ __forceinline__ void init(int M, int N, int G_, int c_) { nM = M / BM; nN = N / BM; nwg = nM * nN; G = G_; c = c_; }
    __device__ __forceinline__ bool next(int i, Unit& u) const {
        const long L = (long)i * G + c; if (L >= nwg) return false;
        int wgid = (int)L; { const int q = nwg / NXCD, r = nwg % NXCD, xcd = wgid % NXCD, off = wgid / NXCD; wgid = (xcd < r ? xcd * (q + 1) : r * (q + 1) + (xcd - r) * q) + off; }
        const int nig = WGM * nN, gid = wgid / nig, fm = gid * WGM, gsz = (nM - fm) < WGM ? (nM - fm) : WGM;
        u.pm = fm + ((wgid % nig) % gsz); u.pn = (wgid % nig) / gsz; return true;
    }
    __device__ __forceinline__ void a_ready(const Unit&) const {}
    __device__ __forceinline__ void done(const Unit&) const {}
};
struct OneUnit {
    Unit u;
    __device__ __forceinline__ bool next(int i, Unit& o) const { if (i) return false; o = u; return true; }
    __device__ __forceinline__ void a_ready(const Unit&) const {}
    __device__ __forceinline__ void done(const Unit&) const {}
};

template <class Epi, class Sched>
__device__ __forceinline__ void gemm_phase(LAS unsigned char* lds, const Gemm g, const Sched& S, const Epi& E) {
    int tid_ = threadIdx.x; asm volatile("" : "+v"(tid_));
    const int tid = tid_, wid = __builtin_amdgcn_readfirstlane(tid >> 6), lane = tid & 63, wr = wid >> 2, wc = wid & 3, fr = lane & 15, fq = lane >> 4;
    const int K = g.K, nt = K / BK;
    unsigned voffA[2], voffB[2];
#pragma unroll
    for (int i = 0; i < 2; ++i) { int R, C; stage_rc(tid * 16 + i * 8192, R, C); const int Rb = (R & ~31) + perm32(R & 31); voffA[i] = (unsigned)(R * K + C) * 2u; voffB[i] = (unsigned)(Rb * K + C) * 2u; }
    const size_t kstep = (size_t)(BK * 2);
    const size_t hstep = (size_t)HALF * K * 2;
    const size_t tstep = 2 * hstep;
    const unsigned ldsw = (unsigned)wid * 1024u;
    const int aoff = lds_byte(wr * 64 + fr, fq * 8), boff = lds_byte(wc * 32 + fr, fq * 8);
#define PG8_SA(b, h) (((b) * 2 + (h)) * HTB)
#define PG8_SB(b, h) ((4 + (b) * 2 + (h)) * HTB)
#define PG8_STAGE(bufoff, gbase, voff) do { _Pragma("unroll") for (int _i = 0; _i < 2; ++_i) \
        __builtin_amdgcn_global_load_lds((const unsigned*)((const char*)(gbase) + (voff)[_i]), (LAS unsigned*)(lds + (bufoff) + ldsw + _i * 8192), 16, 0, 0); } while (0)
#define PG8_LDA(dst, b, h) do { _Pragma("unroll") for (int m = 0; m < 4; ++m) _Pragma("unroll") for (int k = 0; k < 2; ++k) dst[m][k] = *(const LAS bf16x8*)(lds + PG8_SA(b, h) + aoff + m * 2048 + k * 1024); } while (0)
#define PG8_LDB(dst, b, h) do { _Pragma("unroll") for (int n = 0; n < 2; ++n) _Pragma("unroll") for (int k = 0; k < 2; ++k) dst[n][k] = *(const LAS bf16x8*)(lds + PG8_SB(b, h) + boff + n * 2048 + k * 1024); } while (0)
#define PG8_MMA(ai, bj, At, Bt) do { __builtin_amdgcn_s_setprio(1); _Pragma("unroll") for (int m = 0; m < 4; ++m) _Pragma("unroll") for (int n = 0; n < 2; ++n) _Pragma("unroll") for (int k = 0; k < 2; ++k) \
        acc[ai][bj][m][n] = __builtin_amdgcn_mfma_f32_16x16x32_bf16(Bt[n][k], At[m][k], acc[ai][bj][m][n], 0, 0, 0); __builtin_amdgcn_s_setprio(0); } while (0)
#define PG8_WAIT_V(n) asm volatile("s_waitcnt vmcnt(" #n ")" ::: "memory")
#define PG8_WAIT_L(n) asm volatile("s_waitcnt lgkmcnt(" #n ")" ::: "memory")
#define PG8_BAR __builtin_amdgcn_s_barrier()
#define PG8_SCHED __builtin_amdgcn_sched_barrier(0)
    Unit cur, nxt; int ui = 0;
    if (!S.next(0, cur)) return;
    f32x4 acc[2][2][4][2];
#pragma unroll
    for (int a = 0; a < 2; ++a)
#pragma unroll
        for (int b = 0; b < 2; ++b)
#pragma unroll
            for (int m = 0; m < 4; ++m)
#pragma unroll
                for (int n = 0; n < 2; ++n) acc[a][b][m][n] = (f32x4){0.f, 0.f, 0.f, 0.f};
    bf16x8 At[4][2], B0[2][2], B1[2][2];
    const char* cA = (const char*)g.A + (size_t)cur.pm * tstep; const char* cB = (const char*)g.Bt + (size_t)cur.pn * tstep;
    S.a_ready(cur);
    PG8_STAGE(PG8_SB(0, 0), cB, voffB); PG8_STAGE(PG8_SA(0, 0), cA, voffA); PG8_STAGE(PG8_SB(0, 1), cB + hstep, voffB); PG8_STAGE(PG8_SA(0, 1), cA + hstep, voffA);
    if (wr == 1) PG8_BAR;
    PG8_WAIT_V(4); PG8_BAR;
    PG8_STAGE(PG8_SB(1, 0), cB + kstep, voffB); PG8_STAGE(PG8_SA(1, 0), cA + kstep, voffA); PG8_STAGE(PG8_SB(1, 1), cB + hstep + kstep, voffB);
    PG8_WAIT_V(6); PG8_BAR;
    for (;;) {
        const bool has_next = S.next(ui + 1, nxt);
        const char* nA = has_next ? (const char*)g.A + (size_t)nxt.pm * tstep : cA; const char* nB = has_next ? (const char*)g.Bt + (size_t)nxt.pn * tstep : cB;
        for (int t = 0; t < nt; t += 2) {
            const bool last = (t == nt - 2);
            const char* a1 = cA + (size_t)(t + 1) * kstep;
            const char* a2 = last ? nA : cA + (size_t)(t + 2) * kstep; const char* b2 = last ? nB : cB + (size_t)(t + 2) * kstep;
            const char* a3 = a2 + kstep; const char* b3 = b2 + kstep;
            if (last && has_next) S.a_ready(nxt);
            PG8_LDB(B0, 0, 0); PG8_SCHED; PG8_LDA(At, 0, 0); PG8_STAGE(PG8_SA(1, 1), a1 + hstep, voffA);
            PG8_WAIT_L(8); PG8_BAR; PG8_WAIT_L(0); PG8_MMA(0, 0, At, B0); PG8_BAR; PG8_SCHED;
            PG8_LDB(B1, 0, 1); PG8_STAGE(PG8_SB(0, 0), b2, voffB);
            PG8_BAR; PG8_WAIT_L(0); PG8_MMA(0, 1, At, B1); PG8_BAR;
            PG8_LDA(At, 0, 1); PG8_STAGE(PG8_SA(0, 0), a2, voffA);
            PG8_BAR; PG8_WAIT_L(0); PG8_MMA(1, 0, At, B0); PG8_BAR; PG8_SCHED;
            PG8_STAGE(PG8_SB(0, 1), b2 + hstep, voffB);
            PG8_WAIT_V(6); PG8_BAR; PG8_MMA(1, 1, At, B1); PG8_BAR;
            PG8_LDB(B0, 1, 0); PG8_SCHED; PG8_LDA(At, 1, 0); PG8_STAGE(PG8_SA(0, 1), a2 + hstep, voffA);
            PG8_WAIT_L(8); PG8_BAR; PG8_WAIT_L(0); PG8_MMA(0, 0, At, B0); PG8_BAR; PG8_SCHED;
            PG8_LDB(B1, 1, 1); PG8_STAGE(PG8_SB(1, 0), b3, voffB);
            PG8_BAR; PG8_WAIT_L(0); PG8_MMA(0, 1, At, B1); PG8_BAR;
            PG8_LDA(At, 1, 1); PG8_STAGE(PG8_SA(1, 0), a3, voffA);
            PG8_BAR; PG8_WAIT_L(0); PG8_MMA(1, 0, At, B0); PG8_BAR; PG8_SCHED;
            PG8_STAGE(PG8_SB(1, 1), b3 + hstep, voffB);
            PG8_WAIT_V(6); PG8_BAR; PG8_MMA(1, 1, At, B1); PG8_BAR;
        }
        if constexpr (!Epi::AFTER_DRAIN) { E(acc, cur, wr, wc, fr, fq); S.done(cur); }
        if (!has_next) break;
#pragma unroll
        for (int a = 0; a < 2; ++a)
#pragma unroll
            for (int b = 0; b < 2; ++b)
#pragma unroll
                for (int m = 0; m < 4; ++m)
#pragma unroll
                    for (int n = 0; n < 2; ++n) acc[a][b][m][n] = (f32x4){0.f, 0.f, 0.f, 0.f};
        cur = nxt; cA = nA; cB = nB; ++ui;
    }
    PG8_WAIT_V(0);
    if (wr == 0) PG8_BAR;
    PG8_BAR;
    if constexpr (Epi::AFTER_DRAIN) { E.fused(acc, cur, wr, wc, fr, fq, lds, wid, lane); S.done(cur); }
#undef PG8_SA
#undef PG8_SB
#undef PG8_STAGE
#undef PG8_LDA
#undef PG8_LDB
#undef PG8_MMA
#undef PG8_WAIT_V
#undef PG8_WAIT_L
#undef PG8_BAR
#undef PG8_SCHED
}
}
using pg8::Unit;

struct EpiIn {
    static constexpr bool AFTER_DRAIN = false;
    bf16_t* proj; float* out; float* dtb; const float* dt_bias; int l;
    __device__ __forceinline__ void operator()(const f32x4 (&acc)[2][2][4][2], const Unit& u, int wr, int wc, int fr_, int fq_) const {
        int fr = fr_, fq = fq_; asm volatile("" : "+v"(fr), "+v"(fq));
#pragma unroll
        for (int bj = 0; bj < 2; ++bj) {
            const int cb = u.pn * 256 + bj * 128;
            const int col = cb + wc * 32 + fq * 8;
            if (cb > C_DT) continue;
#pragma unroll
            for (int ai = 0; ai < 2; ++ai)
#pragma unroll
                for (int m = 0; m < 4; ++m) {
                    const int row = u.pm * 256 + ai * 128 + wr * 64 + m * 16 + fr;
                    const bool isP = row < T_P; int b, t;
                    if (isP) { b = row >> 13; t = row & 8191; } else { b = (row - T_P) >> 6; t = row & 63; }
                    f32x4 v0 = acc[ai][bj][m][0], v1 = acc[ai][bj][m][1];
                    if (cb < C_U) {
                        u32x4 w; { const u32x2 a = pack4(v0), c = pack4(v1); w.x = a.x; w.y = a.y; w.z = c.x; w.w = c.y; }
                        *(u32x4*)(proj + (size_t)row * NPROJ + col) = w;
                        if (cb >= C_K && cb < C_Z) {
                            const int isv = cb >= C_V; const int cc = col - (isv ? C_V : C_K);
                            float* o = nullptr;
                            if (isP) { if (t >= 7680) o = out + (isv ? O_PV : O_PK) + ((size_t)(l * 4 + b) * 512 + (t - 7680)) * 384 + cc; }
                            else o = out + (isv ? O_SV : O_SK) + ((size_t)(l * 32 + b) * 64 + t) * 384 + cc;
                            if (o) { *(f32x4*)o = v0; *(f32x4*)(o + 4) = v1; }
                        } else if (cb >= C_XBC) {
                            const int cc = col - C_XBC; float* o = nullptr;
                            if (isP) { if (t >= 8189) o = out + O_PC + ((size_t)(l * 4 + b) * 3 + (t - 8189)) * 896 + cc; }
                            else if (t >= 61) o = out + O_SC + ((size_t)(l * 32 + b) * 3 + (t - 61)) * 896 + cc;
                            if (o) { *(f32x4*)o = v0; *(f32x4*)(o + 4) = v1; }
                        }
                    } else if (cb < C_DT) {
#pragma unroll
                        for (int j = 0; j < 4; ++j) { v0[j] = gelu_tanh(v0[j]); v1[j] = gelu_tanh(v1[j]); }
                        u32x4 w; { const u32x2 a = pack4(v0), c = pack4(v1); w.x = a.x; w.y = a.y; w.z = c.x; w.w = c.y; }
                        *(u32x4*)(proj + (size_t)row * NPROJ + col) = w;
                        if (cb >= C_VC && !isP) { float* o = out + O_SG + ((size_t)(l * 32 + b) * 64 + t) * 256 + (col - C_VC); *(f32x4*)o = v0; *(f32x4*)(o + 4) = v1; }
                    } else if (col == C_DT) {
                        float* d = dtb + (size_t)row * 8;
#pragma unroll
                        for (int j = 0; j < 4; ++j) d[j] = softplus_f(v0[j] + dt_bias[l * 6 + j]);
#pragma unroll
                        for (int j = 0; j < 2; ++j) d[4 + j] = softplus_f(v1[j] + dt_bias[l * 6 + 4 + j]);
                    }
                    asm volatile("" ::: "memory");
                }
        }
    }
};
struct EpiNull {
    static constexpr bool AFTER_DRAIN = false;
    float* sink;
    __device__ __forceinline__ void operator()(const f32x4 (&acc)[2][2][4][2], const Unit& u, int wr, int wc, int fr, int fq) const {
        float t = 0.f;
#pragma unroll
        for (int ai = 0; ai < 2; ++ai)
#pragma unroll
            for (int bj = 0; bj < 2; ++bj)
#pragma unroll
                for (int m = 0; m < 4; ++m)
#pragma unroll
                    for (int n = 0; n < 2; ++n) t += acc[ai][bj][m][n][0] + acc[ai][bj][m][n][1] + acc[ai][bj][m][n][2] + acc[ai][bj][m][n][3];
        if (t == 123456.789f) sink[0] = t;
    }
};
struct EpiRes {
    static constexpr bool AFTER_DRAIN = false;
    float* x; const bf16_t* xb; bf16_t* rdst;
    __device__ __forceinline__ void operator()(const f32x4 (&acc)[2][2][4][2], const Unit& u, int wr, int wc, int fr_, int fq_) const {
        int fr = fr_, fq = fq_; asm volatile("" : "+v"(fr), "+v"(fq));
#pragma unroll
        for (int ai = 0; ai < 2; ++ai)
#pragma unroll
            for (int m = 0; m < 4; ++m) {
                float* rowp = x + (size_t)(u.pm * 256 + ai * 128 + wr * 64 + m * 16 + fr) * DM + u.pn * 256 + wc * 32 + fq * 8;
#pragma unroll
                for (int bj = 0; bj < 2; ++bj) { float* q = rowp + bj * 128; const u32x4 xw = *(const u32x4*)(xb + (q - x));
                    const f32x4 o0 = unpack4((u32x2){xw.x, xw.y}), o1 = unpack4((u32x2){xw.z, xw.w});
                    const u32x2 ra = pack4(o0 * ALPHA + acc[ai][bj][m][0]), rb = pack4(o1 * ALPHA + acc[ai][bj][m][1]);
                    *(u32x4*)(rdst + (q - x)) = (u32x4){ra.x, ra.y, rb.x, rb.y}; }
                asm volatile("" ::: "memory");
            }
    }
};
struct EpiUp {
    static constexpr bool AFTER_DRAIN = true;
    bf16_t* H; float* halo; float* out; const float* cw; const float* cb; const float* fstate; int l;
    __device__ __forceinline__ void operator()(const f32x4 (&)[2][2][4][2], const Unit&, int, int, int, int) const {}
    __device__ __forceinline__ void fused(f32x4 (&acc)[2][2][4][2], const Unit& u, int wr, int wc, int fr, int fq, LAS unsigned char* lds, int wid, int lane) const {
        constexpr int LS = 264;
#pragma unroll
        for (int ai = 0; ai < 2; ++ai)
#pragma unroll
            for (int m = 0; m < 4; ++m)
#pragma unroll
                for (int bj = 0; bj < 2; ++bj) {
                        const int rl = ai * 128 + wr * 64 + m * 16 + fr, cl = bj * 128 + wc * 32 + fq * 8;
                        u32x4 w; { const u32x2 a = pack4(acc[ai][bj][m][0]), c = pack4(acc[ai][bj][m][1]); w.x = a.x; w.y = a.y; w.z = c.x; w.w = c.y; }
                        *(LAS u32x4*)(lds + (rl * LS + cl) * 2) = w;
                    }
        __syncthreads();
        const int tid = wid * 64 + lane, j = tid & 127, seg = tid >> 7;
        const int hcol = u.pn * 128 + j;
        const float* w = cw + (size_t)l * 3 * DFF2; const float* bb = cb + (size_t)l * DFF2;
        const float wg0 = w[hcol], wg1 = w[DFF2 + hcol], wg2 = w[2 * DFF2 + hcol], bg = bb[hcol];
        const float wv0 = w[DFF + hcol], wv1 = w[DFF2 + DFF + hcol], wv2 = w[2 * DFF2 + DFF + hcol], bv = bb[DFF + hcol];
        const int R = u.pm * 256 + seg * 64;
        const bool isP = R < T_P;
        float g2 = 0.f, g1 = 0.f, v2 = 0.f, v1 = 0.f; int skip = 0;
        const LAS bf16_t* U = (const LAS bf16_t*)lds;
        if (isP) {
            if (seg > 0) { g2 = bf2f(U[(seg * 64 - 2) * LS + j]); g1 = bf2f(U[(seg * 64 - 1) * LS + j]); v2 = bf2f(U[(seg * 64 - 2) * LS + 128 + j]); v1 = bf2f(U[(seg * 64 - 1) * LS + 128 + j]); }
            else if ((R & 8191) != 0) skip = 2;
        } else {
            const int sb = (R - T_P) >> 6; const float* fs = fstate + (size_t)(l * 32 + sb) * 2 * DFF2;
            g2 = fs[hcol]; g1 = fs[DFF2 + hcol]; v2 = fs[DFF + hcol]; v1 = fs[DFF2 + DFF + hcol];
        }
        bf16_t* hp = H + (size_t)R * DFF + hcol;
#pragma unroll 8
        for (int i = 0; i < 64; ++i) {
            const float gq = bf2f(U[(seg * 64 + i) * LS + j]), vq = bf2f(U[(seg * 64 + i) * LS + 128 + j]);
            if (i >= skip) {
                const float cgv = bg + wg0 * g2 + wg1 * g1 + wg2 * gq, cvv = bv + wv0 * v2 + wv1 * v1 + wv2 * vq;
                const float hv = silu_f(cgv) * cvv;
                hp[(size_t)i * DFF] = (bf16_t)(cvt_pk_bf16(hv, 0.f) & 0xffffu);
            }
            g2 = g1; g1 = gq; v2 = v1; v1 = vq;
            if (isP) {
                if (seg == 0 && i < 2) { float* hl = halo + ((size_t)u.pm * 4 + i) * DFF2; hl[hcol] = gq; hl[DFF + hcol] = vq; }
                if (seg == 3 && i >= 62) { float* hl = halo + ((size_t)u.pm * 4 + 2 + (i - 62)) * DFF2; hl[hcol] = gq; hl[DFF + hcol] = vq;
                    if ((u.pm & 31) == 31) { float* o = out + O_PF + ((size_t)(l * 4 + (u.pm >> 5)) * 2 + (i - 62)) * DFF2; o[hcol] = gq; o[DFF + hcol] = vq; } }
            } else if (i >= 62) {
                const int sb = (R - T_P) >> 6; float* o = out + O_SF + ((size_t)(l * 32 + sb) * 2 + (i - 62)) * DFF2; o[hcol] = gq; o[DFF + hcol] = vq;
            }
        }
    }
};

template <int CTRL> __device__ __forceinline__ float dppz(float x) { return __builtin_bit_cast(float, __builtin_amdgcn_update_dpp(0, __builtin_bit_cast(int, x), CTRL, 0xf, 0xf, true)); }
struct EpiUp2 {
    static constexpr bool AFTER_DRAIN = false;
    bf16_t* H; float* halo; float* out; const float* cw; const float* cb; const float* fstate; int l; LAS unsigned char* lds;
    __device__ __forceinline__ void operator()(const f32x4 (&acc)[2][2][4][2], const Unit& u, int wr, int wc, int fr_, int fq_) const {
        int fr = fr_, fq = fq_; asm volatile("" : "+v"(fr), "+v"(fq));
        const int hcol = u.pn * 128 + wc * 32 + fq * 8;
        const float* w = cw + (size_t)l * 3 * DFF2 + hcol; const float* bb = cb + (size_t)l * DFF2 + hcol;
        LAS f32x4* wl = (LAS f32x4*)(lds + 131072 + (wc * 4 + fq) * 256);
#pragma unroll
        for (int sd = 0; sd < 2; ++sd)
#pragma unroll
            for (int hf = 0; hf < 2; ++hf) { wl[(sd * 2 + hf) * 4 + 3] = *(const f32x4*)(bb + sd * DFF + hf * 4);
#pragma unroll
                for (int tp = 0; tp < 3; ++tp) wl[(sd * 2 + hf) * 4 + tp] = *(const f32x4*)(w + tp * DFF2 + sd * DFF + hf * 4); }
        asm volatile("s_waitcnt lgkmcnt(0)" ::: "memory");
#pragma unroll
        for (int ai = 0; ai < 2; ++ai) {
            const int R = u.pm * 256 + ai * 128 + wr * 64, blk = R >> 6;
            const bool isP = R < T_P, seqstart = isP ? ((R & 8191) == 0) : true;
            f32x4 Xp[2][2];
#pragma unroll
            for (int sd = 0; sd < 2; ++sd)
#pragma unroll
                for (int hf = 0; hf < 2; ++hf) Xp[sd][hf] = (f32x4){0.f, 0.f, 0.f, 0.f};
            if (!isP && fr >= 14) { const float* fs = fstate + ((size_t)(l * 32 + (blk - 512)) * 2 + (fr - 14)) * DFF2 + hcol;
#pragma unroll
                for (int sd = 0; sd < 2; ++sd)
#pragma unroll
                    for (int hf = 0; hf < 2; ++hf) Xp[sd][hf] = *(const f32x4*)(fs + sd * DFF + hf * 4); }
#pragma unroll
            for (int m = 0; m < 4; ++m) {
                f32x4 cv[2][2];
#pragma unroll
                for (int sd = 0; sd < 2; ++sd)
#pragma unroll
                    for (int hf = 0; hf < 2; ++hf)
                    { const f32x4 w0 = wl[(sd * 2 + hf) * 4 + 0], w1 = wl[(sd * 2 + hf) * 4 + 1], w2 = wl[(sd * 2 + hf) * 4 + 2], b3 = wl[(sd * 2 + hf) * 4 + 3];
#pragma unroll
                        for (int j = 0; j < 4; ++j) {
                            const float x = acc[ai][sd][m][hf][j], xp = Xp[sd][hf][j];
                            float c = b3[j] + w2[j] * x;
                            c += w1[j] * dppz<0x111>(x); c += w1[j] * dppz<0x10F>(xp); c += w0[j] * dppz<0x112>(x); c += w0[j] * dppz<0x10E>(xp);
                            cv[sd][hf][j] = c;
                        } }
                f32x4 h0, h1;
#pragma unroll
                for (int j = 0; j < 4; ++j) { h0[j] = silu_f(cv[0][0][j]) * cv[1][0][j]; h1[j] = silu_f(cv[0][1][j]) * cv[1][1][j]; }
                const int row = R + m * 16 + fr;
                if (!(m == 0 && fr < 2 && !seqstart)) { u32x4 pk; { const u32x2 a = pack4(h0), c = pack4(h1); pk.x = a.x; pk.y = a.y; pk.z = c.x; pk.w = c.y; }
                    *(u32x4*)(H + (size_t)row * DFF + hcol) = pk; }
                float* sv = nullptr; float* sv2 = nullptr;
                if (isP) { if (m == 0 && fr < 2) sv = halo + ((size_t)blk * 4 + fr) * DFF2 + hcol;
                           if (m == 3 && fr >= 14) { sv = halo + ((size_t)blk * 4 + 2 + (fr - 14)) * DFF2 + hcol; if ((blk & 127) == 127) sv2 = out + O_PF + ((size_t)(l * 4 + (blk >> 7)) * 2 + (fr - 14)) * DFF2 + hcol; } }
                else if (m == 3 && fr >= 14) sv = out + O_SF + ((size_t)(l * 32 + (blk - 512)) * 2 + (fr - 14)) * DFF2 + hcol;
                if (sv) {
#pragma unroll
                    for (int sd = 0; sd < 2; ++sd)
#pragma unroll
                        for (int hf = 0; hf < 2; ++hf) { *(f32x4*)(sv + sd * DFF + hf * 4) = acc[ai][sd][m][hf]; if (sv2) *(f32x4*)(sv2 + sd * DFF + hf * 4) = acc[ai][sd][m][hf]; } }
#pragma unroll
                for (int sd = 0; sd < 2; ++sd)
#pragma unroll
                    for (int hf = 0; hf < 2; ++hf) Xp[sd][hf] = acc[ai][sd][m][hf];
                asm volatile("" ::: "memory");
            }
        }
    }
};

__device__ __forceinline__ void ln_row(const float* src, const bf16_t* srcb, float* x32, bf16_t* xb, const float* g, const float* b, int lane) {
    f32x4 v[4]; float s = 0.f;
#pragma unroll
    for (int i = 0; i < 4; ++i) { v[i] = srcb ? unpack4(*(const u32x2*)(srcb + i * 256 + lane * 4)) : *(const f32x4*)(src + i * 256 + lane * 4); s += (v[i][0] + v[i][1]) + (v[i][2] + v[i][3]); }
#pragma unroll
    for (int o = 32; o >= 1; o >>= 1) s += __shfl_xor(s, o);
    const float mu = s * (1.0f / 1024.0f); float q = 0.f;
#pragma unroll
    for (int i = 0; i < 4; ++i) { const f32x4 d = v[i] - mu; q += (d[0] * d[0] + d[1] * d[1]) + (d[2] * d[2] + d[3] * d[3]); }
#pragma unroll
    for (int o = 32; o >= 1; o >>= 1) q += __shfl_xor(q, o);
    const float rstd = 1.0f / sqrtf(q * (1.0f / 1024.0f) + LN_EPS);
#pragma unroll
    for (int i = 0; i < 4; ++i) {
        const f32x4 gg = *(const f32x4*)(g + i * 256 + lane * 4), bb = *(const f32x4*)(b + i * 256 + lane * 4);
        const f32x4 o = (v[i] - mu) * rstd * gg + bb;
        if (x32) *(f32x4*)(x32 + i * 256 + lane * 4) = o;
        if (xb) *(u32x2*)(xb + i * 256 + lane * 4) = pack4(o);
    }
}

__device__ __forceinline__ void tr_tile(LAS float* tile, const float* src, int Nsrc, bf16_t* dst, int K, int n0, int k0, int mode, int tid) {
    const int nn = tid & 63, np = n0 + nn; int sc;
    if (mode == 0) sc = np < C_U ? np : (np < C_DT ? np + 6 : (np < C_DT + 6 ? np - 512 : -1));
    else if (mode == 1) sc = np;
    else { const int pn = np >> 8, jj = np & 255; sc = jj < 128 ? pn * 128 + jj : DFF + pn * 128 + (jj - 128); }
#pragma unroll
    for (int i = 0; i < 8; ++i) { const int kk = (tid >> 6) + 8 * i; tile[kk * 65 + nn] = sc >= 0 ? src[(size_t)(k0 + kk) * Nsrc + sc] : 0.f; }
    __syncthreads();
    const int kk2 = (tid & 31) * 2;
#pragma unroll
    for (int i = 0; i < 4; ++i) { const int nn2 = (tid >> 5) + 16 * i; *(unsigned*)(dst + (size_t)(n0 + nn2) * K + k0 + kk2) = cvt_pk_bf16(tile[kk2 * 65 + nn2], tile[(kk2 + 1) * 65 + nn2]); }
    __syncthreads();
}

__device__ __forceinline__ void phase_prep(KP& p, LAS unsigned char* lds) {
    int tid_ = threadIdx.x; asm volatile("" : "+v"(tid_));
    const int tid = tid_, wid = tid >> 6, lane = tid & 63;
    for (int row = blockIdx.x * 8 + wid; row < T_ALL; row += gridDim.x * 8) {
        const float* src = row < T_P ? p.in[0] + (size_t)row * DM : p.in[1] + (size_t)(row - T_P) * DM;
        ln_row(src, nullptr, nullptr, (bf16_t*)(p.ws + W_XB) + (size_t)row * DM, p.in[7], p.in[8], lane);
    }
    constexpr int T_IN = 48 * 16, T_OUT = 16 * 16, T_UPT = 88 * 16, T_DNT = 16 * 44, T_L = T_IN + T_OUT + T_UPT + T_DNT;
    for (int it = blockIdx.x; it < 4 * T_L; it += gridDim.x) {
        const int l = it / T_L; int r = it % T_L;
        if (r < T_IN) tr_tile((LAS float*)lds, p.in[9] + (size_t)l * DM * 2950, 2950, (bf16_t*)(p.ws + W_IN + l * W_IN_L), DM, (r >> 4) * 64, (r & 15) * 64, 0, tid);
        else if ((r -= T_IN) < T_OUT) tr_tile((LAS float*)lds, p.in[19] + (size_t)l * DM * DM, DM, (bf16_t*)(p.ws + W_OUT + l * W_OUT_L), DM, (r >> 4) * 64, (r & 15) * 64, 1, tid);
        else if ((r -= T_OUT) < T_UPT) tr_tile((LAS float*)lds, p.in[22] + (size_t)l * DM * DFF2, DFF2, (bf16_t*)(p.ws + W_UP + l * W_UP_L), DM, (r >> 4) * 64, (r & 15) * 64, 2, tid);
        else { r -= T_UPT; tr_tile((LAS float*)lds, p.in[25] + (size_t)l * DFF * DM, DM, (bf16_t*)(p.ws + W_DN + l * W_DN_L), DFF, (r / 44) * 64, (r % 44) * 64, 1, tid); }
    }
    for (int i = blockIdx.x * 512 + tid; i < 4 * 4 * 128 * 128; i += gridDim.x * 512) {
        const int jj = i & 127, ii = (i >> 7) & 127;
        ((bf16_t*)(p.ws + W_GW))[i] = (bf16_t)(cvt_pk_bf16(jj <= ii ? p.in[16][i] : 0.f, 0.f) & 0xffffu);
    }
}

__device__ __forceinline__ void phase_ln(KP& p, const bf16_t* rsrc, const float* g, const float* b, bool final_out) {
    int tid_ = threadIdx.x; asm volatile("" : "+v"(tid_));
    const int wid = tid_ >> 6, lane = tid_ & 63;
    for (int row = blockIdx.x * 8 + wid; row < T_ALL; row += gridDim.x * 8)
        ln_row(nullptr, rsrc + (size_t)row * DM, final_out ? p.out + (size_t)row * DM : nullptr, final_out ? nullptr : (bf16_t*)(p.ws + W_XB) + (size_t)row * DM, g, b, lane);
}

__device__ __forceinline__ void dt_scan(KP& p, int l, int u, int g, int wid, int lane, float& dt, float& ac, float& last) {
    const int h = g * 3 + wid;
    dt = ((const float*)(p.ws + W_DTB))[(size_t)(u * 64 + lane) * 8 + h];
    const float a = -__expf(p.in[14][l * 6 + h]);
    float v = dt * a;
#pragma unroll
    for (int o = 1; o < 64; o <<= 1) { const float t = __shfl_up(v, o); if (lane >= o) v += t; }
    ac = v; last = __shfl(v, 63);
}

__device__ __forceinline__ f32x4 xbc_row(KP& p, int l, int u, int s, int ch) {
    const bf16_t* proj = (const bf16_t*)(p.ws + W_PROJ);
    const bool isP = u < 512; const bool hasprev = isP && (u & 127) != 0;
    if (s >= 0 || hasprev) return unpack4(*(const u32x2*)(proj + (size_t)(u * 64 + s) * NPROJ + C_XBC + ch));
    if (!isP) return *(const f32x4*)(p.in[5] + (unsigned)(((l * 32 + (u - 512)) * 3 + (3 + s)) * 896 + ch));
    return (f32x4){0.f, 0.f, 0.f, 0.f};
}
__device__ __forceinline__ void ssd_states(KP& p, LAS unsigned char* lds, int l, int u) {
    int tid_ = threadIdx.x; asm volatile("" : "+v"(tid_));
    const int tid = tid_, wid = tid >> 6, lane = tid & 63, fr = lane & 15, fq = lane >> 4;
    LAS bf16_t* xT = (LAS bf16_t*)lds;
    LAS bf16_t* BT = (LAS bf16_t*)(lds + 55296);
    LAS float* wgt = (LAS float*)(lds + 92160);
    bf16_t* XC = (bf16_t*)p.out;
    __syncthreads();
    if (wid < 6) {
        float dt, ac, last; dt_scan(p, l, u, wid / 3, wid % 3, lane, dt, ac, last);
        wgt[wid * 64 + lane] = dt * __expf(last - ac);
        if (lane == 0) ((float*)(p.ws + W_CD))[u * 8 + wid] = __expf(last);
    }
    __syncthreads();
    if (tid < 448) {
        const int cgp = tid % 224, seg = tid / 224, ch = cgp * 4, r0 = seg * 32;
        const float* cw = p.in[11] + (size_t)l * 4 * 896 + ch;
        const f32x4 w0 = *(const f32x4*)cw, w1 = *(const f32x4*)(cw + 896), w2 = *(const f32x4*)(cw + 2 * 896), w3 = *(const f32x4*)(cw + 3 * 896);
        const f32x4 bs = *(const f32x4*)(p.in[12] + (size_t)l * 896 + ch);
        f32x4 xm3 = xbc_row(p, l, u, r0 - 3, ch), xm2 = xbc_row(p, l, u, r0 - 2, ch), xm1 = xbc_row(p, l, u, r0 - 1, ch);
        const bf16_t* src = (const bf16_t*)(p.ws + W_PROJ) + (size_t)(u * 64) * NPROJ + C_XBC + ch;
        bf16_t* dst = XC + (size_t)(u * 64) * 896 + ch;
        const int hh = ch >> 6;
#pragma unroll 2
        for (int i = r0; i < r0 + 32; i += 2) {
            const f32x4 xa = unpack4(*(const u32x2*)(src + (size_t)i * NPROJ)), xb = unpack4(*(const u32x2*)(src + (size_t)(i + 1) * NPROJ));
            f32x4 ya = bs + w0 * xm3 + w1 * xm2 + w2 * xm1 + w3 * xa, yb = bs + w0 * xm2 + w1 * xm1 + w2 * xa + w3 * xb;
#pragma unroll
            for (int e = 0; e < 4; ++e) { ya[e] = silu_f(ya[e]); yb[e] = silu_f(yb[e]); }
            xm3 = xm1; xm2 = xa; xm1 = xb;
            *(u32x2*)(dst + (size_t)i * 896) = pack4(ya); *(u32x2*)(dst + (size_t)(i + 1) * 896) = pack4(yb);
            if (ch < 384) { const float wa = wgt[hh * 64 + i], wb = wgt[hh * 64 + i + 1];
#pragma unroll
                for (int e = 0; e < 4; ++e) *(LAS unsigned*)(xT + (ch + e) * 72 + i) = cvt_pk_bf16(ya[e] * wa, yb[e] * wb); }
            else if (ch < 640) {
#pragma unroll
                for (int e = 0; e < 4; ++e) *(LAS unsigned*)(BT + (ch - 384 + e) * 72 + i) = cvt_pk_bf16(ya[e], yb[e]); }
        }
    }
    __syncthreads();
    bf16_t* ST = (bf16_t*)(p.ws + W_ST);
#pragma unroll 2
    for (int k = 0; k < 24; ++k) {
        const int tt = wid * 24 + k, h = tt >> 5, pt = (tt & 31) >> 3, nt = tt & 7, g = h / 3;
        f32x4 acc = (f32x4){0.f, 0.f, 0.f, 0.f};
#pragma unroll
        for (int ks = 0; ks < 2; ++ks) {
            const bf16x8 rf = ldsfrag((LAS const unsigned char*)(xT + (h * 64 + pt * 16 + fr) * 72 + ks * 32 + fq * 8));
            const bf16x8 cf = ldsfrag((LAS const unsigned char*)(BT + (g * 128 + nt * 16 + fr) * 72 + ks * 32 + fq * 8));
            acc = MFMA16(cf, rf, acc);
        }
        *(u32x2*)(ST + ((size_t)(u * 6 + h) * 64 + pt * 16 + fr) * 128 + nt * 16 + fq * 4) = pack4(acc);
    }
}

__device__ __forceinline__ void gmlp_unit(KP& p, LAS unsigned char* lds, int l, int u) {
    int tid_ = threadIdx.x; asm volatile("" : "+v"(tid_));
    const int tid = tid_, wid = tid >> 6, lane = tid & 63, fr = lane & 15, fq = lane >> 4;
    LAS bf16_t* vT = (LAS bf16_t*)lds;
    LAS float* ssq = (LAS float*)(lds + 69632);
    const bf16_t* proj = (const bf16_t*)(p.ws + W_PROJ);
    const int half = u < 512 ? (u & 1) : 0, KJ = (half + 1) * 64, R0 = u * 64, Rb = R0 - half * 64;
    __syncthreads();
    for (int idx = tid; idx < KJ * 32; idx += 512) {
        const int j = idx & (KJ - 1), cgp = idx / KJ;
        const u32x4 w = *(const u32x4*)(proj + (size_t)(Rb + j) * NPROJ + C_VC + cgp * 8);
        const unsigned ww[4] = {w.x, w.y, w.z, w.w};
#pragma unroll
        for (int e = 0; e < 4; ++e) { vT[(cgp * 8 + 2 * e) * 136 + j] = (bf16_t)(ww[e] & 0xffffu); vT[(cgp * 8 + 2 * e + 1) * 136 + j] = (bf16_t)(ww[e] >> 16); }
    }
    __syncthreads();
    const int rt = wid & 3, cbase = (wid >> 2) * 8;
    const bf16_t* GW = (const bf16_t*)(p.ws + W_GW + l * W_GW_L);
    f32x4 acc[8];
#pragma unroll
    for (int gi = 0; gi < 2; ++gi) {
        const int gg = (cbase >> 2) + gi;
        bf16x8 rf[4];
#pragma unroll
        for (int ks = 0; ks < 4; ++ks) rf[ks] = glbfrag(GW + ((size_t)gg * 128 + half * 64 + rt * 16 + fr) * 128 + ks * 32 + fq * 8);
#pragma unroll
        for (int c4 = 0; c4 < 4; ++c4) {
            const int ct = cbase + gi * 4 + c4;
            f32x4 a = (f32x4){0.f, 0.f, 0.f, 0.f};
#pragma unroll
            for (int ks = 0; ks < 4; ++ks) if (ks * 32 < KJ) a = MFMA16(ldsfrag((LAS const unsigned char*)(vT + (ct * 16 + fr) * 136 + ks * 32 + fq * 8)), rf[ks], a);
            acc[gi * 4 + c4] = a;
        }
    }
    const int row = R0 + rt * 16 + fr; float sq = 0.f;
#pragma unroll
    for (int k = 0; k < 8; ++k) {
        const int col = (cbase + k) * 16 + fq * 4, gg = col >> 6;
        const float bsv = p.in[17][(size_t)(l * 4 + gg) * 128 + half * 64 + rt * 16 + fr];
        const f32x4 uv = unpack4(*(const u32x2*)(proj + (size_t)row * NPROJ + C_U + col));
        f32x4 o = uv * (acc[k] + bsv); acc[k] = o;
        sq += (o[0] * o[0] + o[1] * o[1]) + (o[2] * o[2] + o[3] * o[3]);
    }
    sq += __shfl_xor(sq, 16); sq += __shfl_xor(sq, 32);
    if (fq == 0) ssq[(wid >> 2) * 64 + rt * 16 + fr] = sq;
    __syncthreads();
    const float rstd = 1.0f / sqrtf((ssq[rt * 16 + fr] + ssq[64 + rt * 16 + fr]) * (1.0f / 256.0f) + RMS_EPS);
    bf16_t* mix = (bf16_t*)(p.ws + W_MIX);
#pragma unroll
    for (int k = 0; k < 8; ++k) {
        const int col = (cbase + k) * 16 + fq * 4;
        const f32x4 gv = *(const f32x4*)(p.in[18] + (size_t)l * 1024 + 768 + col);
        *(u32x2*)(mix + (size_t)row * DM + 768 + col) = pack4(acc[k] * rstd * gv);
    }
}

__device__ __forceinline__ void scan_prompt(KP& p, int l, int item) {
    int tid_ = threadIdx.x; asm volatile("" : "+v"(tid_));
    const int gid = item * 512 + tid_, e = (gid & 2047) * 4, bh = gid >> 11, b = bh / 6, h = bh % 6;
    bf16_t* ST = (bf16_t*)(p.ws + W_ST); const float* CD = (const float*)(p.ws + W_CD);
    f32x4 st = (f32x4){0.f, 0.f, 0.f, 0.f};
#pragma unroll 1
    for (int c0 = 0; c0 < 128; c0 += 16) {
        u32x2 s[16]; float cd[16];
#pragma unroll
        for (int k = 0; k < 16; ++k) { const int u = b * 128 + c0 + k; s[k] = *(const u32x2*)(ST + ((size_t)(u * 6 + h)) * 8192 + e); cd[k] = CD[u * 8 + h]; }
#pragma unroll
        for (int k = 0; k < 16; ++k) { const int u = b * 128 + c0 + k; *(u32x2*)(ST + ((size_t)(u * 6 + h)) * 8192 + e) = pack4(st); st = st * cd[k] + unpack4(s[k]); }
    }
    *(f32x4*)(p.out + O_PH + ((size_t)(l * 4 + b) * 6 + h) * 8192 + e) = st;
}
__device__ __forceinline__ void scan_sample(KP& p, int l, int item) {
    int tid_ = threadIdx.x; asm volatile("" : "+v"(tid_));
    const int gid = item * 512 + tid_, e = (gid & 2047) * 4, sbh = gid >> 11, sb = sbh / 6, h = sbh % 6;
    bf16_t* ST = (bf16_t*)(p.ws + W_ST); const float* CD = (const float*)(p.ws + W_CD);
    const int u = 512 + sb;
    const f32x4 st = *(const f32x4*)(p.in[4] + ((size_t)(l * 32 + sb) * 6 + h) * 8192 + e);
    const f32x4 s = unpack4(*(const u32x2*)(ST + ((size_t)(u * 6 + h)) * 8192 + e));
    *(u32x2*)(ST + ((size_t)(u * 6 + h)) * 8192 + e) = pack4(st);
    *(f32x4*)(p.out + O_SH + ((size_t)(l * 32 + sb) * 6 + h) * 8192 + e) = st * CD[u * 8 + h] + s;
}

__device__ __forceinline__ void attn_unit(KP& p, LAS unsigned char* lds, int l, int u) {
    int tid_ = threadIdx.x; asm volatile("" : "+v"(tid_));
    const int tid = tid_, wid = tid >> 6, lane = tid & 63, fr = lane & 15, fq = lane >> 4;
    LAS bf16_t* Kb = (LAS bf16_t*)lds;
    LAS bf16_t* VT = (LAS bf16_t*)(lds + 50176);
    LAS bf16_t* Pw = (LAS bf16_t*)(lds + 105472) + wid * 16 * 72;
    LAS float* bias = (LAS float*)(lds + 123904);
    LAS float* ssq = (LAS float*)(lds + 128512);
    const bf16_t* proj = (const bf16_t*)(p.ws + W_PROJ);
    const bool isP = u < 512; const int R0 = u * 64, c = u & 127, b = u >> 7, sb = u - 512;
    const int qt = wid & 3, hbase = (wid >> 2) * 3;
    __syncthreads();
    for (int i = tid; i < 1152; i += 512) bias[i] = p.in[10][(size_t)l * 1152 + i];
    bf16x8 qf[3][2];
#pragma unroll
    for (int hh = 0; hh < 3; ++hh)
#pragma unroll
        for (int ks = 0; ks < 2; ++ks) qf[hh][ks] = glbfrag(proj + (size_t)(R0 + qt * 16 + fr) * NPROJ + (hbase + hh) * 64 + ks * 32 + fq * 8);
    float mrun[3], lrun[3]; f32x4 O[3][4];
#pragma unroll
    for (int hh = 0; hh < 3; ++hh) { mrun[hh] = -1e30f; lrun[hh] = 0.f;
#pragma unroll
        for (int d = 0; d < 4; ++d) O[hh][d] = (f32x4){0.f, 0.f, 0.f, 0.f}; }
    const int blk_lo = isP ? (c < 8 ? 8 - c : 0) : 0;
    u32x4 kr[6], vr[6];
    const int kkey0 = tid / 48, kcg = tid % 48;
    const int vkp = tid & 31, vcg0 = tid >> 5;
#define ATT_LOADP(blkv) do { const size_t rb_ = isP ? (size_t)b * 8192 + (size_t)(c - 8 + (blkv)) * 64 : (size_t)T_P + (size_t)sb * 64; \
        _Pragma("unroll") for (int it = 0; it < 2; ++it) { const int cg_ = vcg0 + it * 16; \
            vr[2 * it] = *(const u32x4*)(proj + (rb_ + 2 * vkp) * NPROJ + C_V + cg_ * 8); vr[2 * it + 1] = *(const u32x4*)(proj + (rb_ + 2 * vkp + 1) * NPROJ + C_V + cg_ * 8); } } while (0)
    bool have = false;
    if (isP || blk_lo == 8) { ATT_LOADP(blk_lo); have = true; }
#pragma unroll 1
    for (int blk = blk_lo; blk <= 8; ++blk) {
        __syncthreads();
        if (!have) {
#pragma unroll
            for (int it = 0; it < 6; ++it) { const int idx = it * 512 + tid;
                const float* s = p.in[2] + ((size_t)(l * 32 + sb) * 512 + blk * 64 + idx / 48) * 384 + (idx % 48) * 8; const f32x4 a = *(const f32x4*)s, bq = *(const f32x4*)(s + 4);
                kr[it].x = cvt_pk_bf16(a[0], a[1]); kr[it].y = cvt_pk_bf16(a[2], a[3]); kr[it].z = cvt_pk_bf16(bq[0], bq[1]); kr[it].w = cvt_pk_bf16(bq[2], bq[3]); }
#pragma unroll
            for (int it = 0; it < 6; ++it) { const int cg_ = vcg0 + (it >> 1) * 16;
                const float* s = p.in[3] + ((size_t)(l * 32 + sb) * 512 + blk * 64 + 2 * vkp + (it & 1)) * 384 + cg_ * 8; const f32x4 a = *(const f32x4*)s, bq = *(const f32x4*)(s + 4);
                vr[it].x = cvt_pk_bf16(a[0], a[1]); vr[it].y = cvt_pk_bf16(a[2], a[3]); vr[it].z = cvt_pk_bf16(bq[0], bq[1]); vr[it].w = cvt_pk_bf16(bq[2], bq[3]); }
        }
        if (have) { const size_t rb_ = isP ? (size_t)b * 8192 + (size_t)(c - 8 + blk) * 64 : (size_t)T_P + (size_t)sb * 64;
#pragma unroll
            for (int it = 0; it < 6; ++it) { const int idx = it * 512 + tid; kr[it] = *(const u32x4*)(proj + (rb_ + idx / 48) * NPROJ + C_K + (idx % 48) * 8); }
            { const int cg_ = vcg0 + 2 * 16; vr[4] = *(const u32x4*)(proj + (rb_ + 2 * vkp) * NPROJ + C_V + cg_ * 8); vr[5] = *(const u32x4*)(proj + (rb_ + 2 * vkp + 1) * NPROJ + C_V + cg_ * 8); } }
#pragma unroll
        for (int it = 0; it < 3; ++it) { const int cg_ = vcg0 + it * 16; const u32x4 w0 = vr[2 * it], w1 = vr[2 * it + 1];
            const unsigned a0[4] = {w0.x, w0.y, w0.z, w0.w}, a1[4] = {w1.x, w1.y, w1.z, w1.w};
#pragma unroll
            for (int e = 0; e < 4; ++e) {
                *(LAS unsigned*)(VT + (cg_ * 8 + 2 * e) * 72 + 2 * vkp) = (a0[e] & 0xffffu) | (a1[e] << 16);
                *(LAS unsigned*)(VT + (cg_ * 8 + 2 * e + 1) * 72 + 2 * vkp) = (a0[e] >> 16) | (a1[e] & 0xffff0000u); } }
#pragma unroll
        for (int it = 0; it < 6; ++it) { const int idx = it * 512 + tid; *(LAS u32x4*)(Kb + (idx / 48) * 392 + (idx % 48) * 8) = kr[it]; }
        __syncthreads();
        have = false;
        if (blk < 8 && (isP || blk == 7)) { ATT_LOADP(blk + 1); have = true; }
#pragma unroll
        for (int hh = 0; hh < 3; ++hh) {
            const int h = hbase + hh;
            f32x4 s[4]; float mx = -1e30f;
#pragma unroll
            for (int kt = 0; kt < 4; ++kt) {
                f32x4 a = (f32x4){0.f, 0.f, 0.f, 0.f};
#pragma unroll
                for (int ks = 0; ks < 2; ++ks) a = MFMA16(ldsfrag((LAS const unsigned char*)(Kb + (kt * 16 + fr) * 392 + h * 64 + ks * 32 + fq * 8)), qf[hh][ks], a);
                if (blk <= 5) { const float bc = bias[h * 192 + 191];
#pragma unroll
                    for (int j = 0; j < 4; ++j) { a[j] = a[j] * 0.125f + bc; mx = fmaxf(mx, a[j]); } }
                else {
#pragma unroll
                    for (int j = 0; j < 4; ++j) {
                        int rel = (qt * 16 + fr) + 512 - (blk * 64 + kt * 16 + fq * 4 + j); rel = rel > 128 ? 128 : rel;
                        a[j] = a[j] * 0.125f + bias[h * 192 + rel + 63]; mx = fmaxf(mx, a[j]);
                    } }
                s[kt] = a;
            }
            mx = fmaxf(mx, __shfl_xor(mx, 16)); mx = fmaxf(mx, __shfl_xor(mx, 32));
            const float mnew = fmaxf(mrun[hh], mx), fac = __expf(mrun[hh] - mnew); mrun[hh] = mnew;
            float rs = 0.f;
#pragma unroll
            for (int kt = 0; kt < 4; ++kt)
#pragma unroll
                for (int j = 0; j < 4; ++j) { s[kt][j] = __expf(s[kt][j] - mnew); rs += s[kt][j]; }
            lrun[hh] = lrun[hh] * fac + rs;
#pragma unroll
            for (int d = 0; d < 4; ++d) O[hh][d] *= fac;
#pragma unroll
            for (int ks = 0; ks < 2; ++ks) {
                const u32x2 pa = pack4(s[2 * ks]), pb = pack4(s[2 * ks + 1]);
                const bf16x8 pf = __builtin_bit_cast(bf16x8, (u32x4){pa.x, pa.y, pb.x, pb.y});
#pragma unroll
                for (int d = 0; d < 4; ++d) {
                    const LAS bf16_t* vrow = VT + (h * 64 + d * 16 + fr) * 72 + ks * 32 + fq * 4;
                    const u32x2 va = *(const LAS u32x2*)vrow, vb = *(const LAS u32x2*)(vrow + 16);
                    O[hh][d] = MFMA16(__builtin_bit_cast(bf16x8, (u32x4){va.x, va.y, vb.x, vb.y}), pf, O[hh][d]);
                }
            }
        }
    }
#pragma unroll
    for (int hh = 0; hh < 3; ++hh) { lrun[hh] += __shfl_xor(lrun[hh], 16); lrun[hh] += __shfl_xor(lrun[hh], 32); }
    float sq = 0.f;
#pragma unroll
    for (int hh = 0; hh < 3; ++hh) { const float inv = 1.0f / lrun[hh];
#pragma unroll
        for (int d = 0; d < 4; ++d) { O[hh][d] *= inv; const f32x4 o = O[hh][d]; sq += (o[0] * o[0] + o[1] * o[1]) + (o[2] * o[2] + o[3] * o[3]); } }
    sq += __shfl_xor(sq, 16); sq += __shfl_xor(sq, 32);
    if (fq == 0) ssq[(wid >> 2) * 64 + qt * 16 + fr] = sq;
    __syncthreads();
    const float rstd = 1.0f / sqrtf((ssq[qt * 16 + fr] + ssq[64 + qt * 16 + fr]) * (1.0f / 384.0f) + RMS_EPS);
    bf16_t* mix = (bf16_t*)(p.ws + W_MIX);
#pragma unroll
    for (int hh = 0; hh < 3; ++hh)
#pragma unroll
        for (int d = 0; d < 4; ++d) {
            const int col = (hbase + hh) * 64 + d * 16 + fq * 4;
            const f32x4 gv = *(const f32x4*)(p.in[18] + (size_t)l * 1024 + col);
            *(u32x2*)(mix + (size_t)(R0 + qt * 16 + fr) * DM + col) = pack4(O[hh][d] * rstd * gv);
        }
}

__device__ __forceinline__ void ssd_y(KP& p, LAS unsigned char* lds, int l, int u) {
    int tid_ = threadIdx.x; asm volatile("" : "+v"(tid_));
    const int tid = tid_, wid = tid >> 6, lane = tid & 63, fr = lane & 15, fq = lane >> 4;
    LAS bf16_t* Cn = (LAS bf16_t*)lds;
    LAS bf16_t* Bn = (LAS bf16_t*)(lds + 17408);
    LAS bf16_t* xT = (LAS bf16_t*)(lds + 34816);
    LAS bf16_t* Mm = (LAS bf16_t*)(lds + 62464);
    LAS float* dtl = (LAS float*)(lds + 90112);
    LAS float* acl = (LAS float*)(lds + 90880);
    LAS float* ssq = (LAS float*)(lds + 91648);
    const bf16_t* proj = (const bf16_t*)(p.ws + W_PROJ);
    const bf16_t* HP = (const bf16_t*)(p.ws + W_ST);
    const bf16_t* XC = (const bf16_t*)p.out + (size_t)(u * 64) * 896;
    const int R0 = u * 64, lt = wid & 3;
    f32x4 yacc[2][6];
#pragma unroll
    for (int g = 0; g < 2; ++g) {
        __syncthreads();
        if (wid < 3) { float dt, ac, last; dt_scan(p, l, u, g, wid, lane, dt, ac, last); dtl[wid * 64 + lane] = dt; acl[wid * 64 + lane] = ac; }
#pragma unroll
        for (int it = 0; it < 4; ++it) {
            const int idx = it * 512 + tid, mat = idx >> 10, i = (idx >> 4) & 63, c8 = idx & 15;
            const u32x4 w = *(const u32x4*)(XC + (size_t)i * 896 + 384 + mat * 256 + g * 128 + c8 * 8);
            *(LAS u32x4*)((mat ? Cn : Bn) + i * 136 + c8 * 8) = w;
        }
#pragma unroll
        for (int it = 0; it < 3; ++it) {
            const int idx = it * 512 + tid, c4 = idx % 48, i = (idx / 48) * 2;
            const u32x2 wa = *(const u32x2*)(XC + (size_t)i * 896 + g * 192 + c4 * 4), wb = *(const u32x2*)(XC + (size_t)(i + 1) * 896 + g * 192 + c4 * 4);
            *(LAS unsigned*)(xT + (c4 * 4 + 0) * 72 + i) = (wa.x & 0xffffu) | (wb.x << 16);
            *(LAS unsigned*)(xT + (c4 * 4 + 1) * 72 + i) = (wa.x >> 16) | (wb.x & 0xffff0000u);
            *(LAS unsigned*)(xT + (c4 * 4 + 2) * 72 + i) = (wa.y & 0xffffu) | (wb.y << 16);
            *(LAS unsigned*)(xT + (c4 * 4 + 3) * 72 + i) = (wa.y >> 16) | (wb.y & 0xffff0000u);
        }
        __syncthreads();
#pragma unroll
        for (int k = 0; k < 2; ++k) {
            const int st = (wid >> 2) * 2 + k;
            f32x4 a = (f32x4){0.f, 0.f, 0.f, 0.f};
#pragma unroll
            for (int ks = 0; ks < 4; ++ks) a = MFMA16(ldsfrag((LAS const unsigned char*)(Bn + (st * 16 + fr) * 136 + ks * 32 + fq * 8)), ldsfrag((LAS const unsigned char*)(Cn + (lt * 16 + fr) * 136 + ks * 32 + fq * 8)), a);
            const int li = lt * 16 + fr;
#pragma unroll
            for (int hh = 0; hh < 3; ++hh) {
                const float al = acl[hh * 64 + li]; f32x4 mv;
#pragma unroll
                for (int j = 0; j < 4; ++j) { const int si = st * 16 + fq * 4 + j; mv[j] = si <= li ? a[j] * __expf(al - acl[hh * 64 + si]) * dtl[hh * 64 + si] : 0.f; }
                *(LAS u32x2*)(Mm + (hh * 64 + li) * 72 + st * 16 + fq * 4) = pack4(mv);
            }
        }
        __syncthreads();
#pragma unroll
        for (int k = 0; k < 6; ++k) {
            const int ctile = (wid >> 2) * 6 + k, hh = ctile >> 2, pt = ctile & 3, h = g * 3 + hh, li = lt * 16 + fr;
            f32x4 ad = (f32x4){0.f, 0.f, 0.f, 0.f}, ao = (f32x4){0.f, 0.f, 0.f, 0.f};
#pragma unroll
            for (int ks = 0; ks < 2; ++ks) ad = MFMA16(ldsfrag((LAS const unsigned char*)(xT + (hh * 64 + pt * 16 + fr) * 72 + ks * 32 + fq * 8)), ldsfrag((LAS const unsigned char*)(Mm + (hh * 64 + li) * 72 + ks * 32 + fq * 8)), ad);
#pragma unroll
            for (int ks = 0; ks < 4; ++ks) ao = MFMA16(glbfrag(HP + ((size_t)(u * 6 + h) * 64 + pt * 16 + fr) * 128 + ks * 32 + fq * 8), ldsfrag((LAS const unsigned char*)(Cn + li * 136 + ks * 32 + fq * 8)), ao);
            const float ea = __expf(acl[hh * 64 + li]), dsk = p.in[15][l * 6 + h];
            const f32x4 xv = unpack4(*(const u32x2*)(XC + (size_t)li * 896 + h * 64 + pt * 16 + fq * 4));
            const f32x4 zv = unpack4(*(const u32x2*)(proj + (size_t)(R0 + li) * NPROJ + C_Z + h * 64 + pt * 16 + fq * 4));
            f32x4 y = ad + ao * ea + xv * dsk;
#pragma unroll
            for (int j = 0; j < 4; ++j) y[j] *= silu_f(zv[j]);
            yacc[g][k] = y;
            asm volatile("" ::: "memory");
        }
    }
    float sq = 0.f;
#pragma unroll
    for (int g = 0; g < 2; ++g)
#pragma unroll
        for (int k = 0; k < 6; ++k) { const f32x4 o = yacc[g][k]; sq += (o[0] * o[0] + o[1] * o[1]) + (o[2] * o[2] + o[3] * o[3]); }
    sq += __shfl_xor(sq, 16); sq += __shfl_xor(sq, 32);
    if (fq == 0) ssq[(wid >> 2) * 64 + lt * 16 + fr] = sq;
    __syncthreads();
    const float rstd = 1.0f / sqrtf((ssq[lt * 16 + fr] + ssq[64 + lt * 16 + fr]) * (1.0f / 384.0f) + RMS_EPS);
    bf16_t* mix = (bf16_t*)(p.ws + W_MIX);
#pragma unroll
    for (int g = 0; g < 2; ++g)
#pragma unroll
        for (int k = 0; k < 6; ++k) {
            const int col = 384 + g * 192 + ((wid >> 2) * 6 + k) * 16 + fq * 4;
            const f32x4 gv = *(const f32x4*)(p.in[18] + (size_t)l * 1024 + col);
            *(u32x2*)(mix + (size_t)(R0 + lt * 16 + fr) * DM + col) = pack4(yacc[g][k] * rstd * gv);
        }
}

__device__ __forceinline__ void phase_fix(KP& p, int l) {
    const float* halo = (const float*)(p.ws + W_MIX); bf16_t* H = (bf16_t*)(p.ws + W_PROJ);
    const float* w = p.in[23] + (size_t)l * 3 * DFF2; const float* bb = p.in[24] + (size_t)l * DFF2;
    int tid_ = threadIdx.x; asm volatile("" : "+v"(tid_));
    for (int i = blockIdx.x * 512 + tid_; i < 128 * DFF2; i += gridDim.x * 512) {
        const int pm = i / DFF2, cc = i % DFF2;
        if ((pm & 31) == 0 || cc >= DFF) continue;
        const float* h0 = halo + (size_t)(pm - 1) * 4 * DFF2; const float* h1 = halo + (size_t)pm * 4 * DFF2;
        float r[2];
#pragma unroll
        for (int rr = 0; rr < 2; ++rr) {
            float o[2];
#pragma unroll
            for (int gv = 0; gv < 2; ++gv) {
                const int c2 = cc + gv * DFF;
                const float xm2 = h0[2 * DFF2 + c2], xm1 = h0[3 * DFF2 + c2], x0 = h1[c2], x1 = h1[DFF2 + c2];
                o[gv] = rr == 0 ? bb[c2] + w[c2] * xm2 + w[DFF2 + c2] * xm1 + w[2 * DFF2 + c2] * x0 : bb[c2] + w[c2] * xm1 + w[DFF2 + c2] * x0 + w[2 * DFF2 + c2] * x1;
            }
            r[rr] = silu_f(o[0]) * o[1];
        }
        H[((size_t)pm * 256) * DFF + cc] = (bf16_t)(cvt_pk_bf16(r[0], 0.f) & 0xffffu);
        H[((size_t)pm * 256 + 1) * DFF + cc] = (bf16_t)(cvt_pk_bf16(r[1], 0.f) & 0xffffu);
    }
}

#define XB_TMO      128
#define XB_XCNT(j)  (256  + 64 * (j))
#define XB_XSUB(j)  (1280 + 64 * (j))
#define XB_XGEN(j)  (2304 + 64 * (j))
#define XB_TOP      3328
#define XB_TOPGEN   3392
#define XCD_BAR_WORDS 3456
#define XB_SPIN_CAP (1u << 18)

__device__ __forceinline__ unsigned xb_ld(unsigned* p)              { return __hip_atomic_load(p, __ATOMIC_RELAXED, __HIP_MEMORY_SCOPE_AGENT); }
__device__ __forceinline__ unsigned xb_add(unsigned* p, unsigned v) { return __hip_atomic_fetch_add(p, v, __ATOMIC_RELAXED, __HIP_MEMORY_SCOPE_AGENT); }
__device__ __forceinline__ unsigned xb_xcc_id() { return (unsigned)__builtin_amdgcn_s_getreg((3 << 11) | 20) & 0xFu; }
#define XB_SPIN(cond, bar) do { unsigned _sp = 0; while (cond) { __builtin_amdgcn_s_sleep(1); \
    if ((++_sp & 255u) == 0u) { if (xb_ld(&(bar)[XB_TMO])) break; if (_sp > XB_SPIN_CAP) { atomicAdd(&(bar)[XB_TMO], 1u); break; } } } } while (0)

struct XcdBarrier {
    unsigned* bar; unsigned x;
    volatile LAS unsigned* st;
};

__device__ __forceinline__ XcdBarrier xcd_barrier_post(unsigned* bar, volatile LAS unsigned* st) {
    XcdBarrier b; b.bar = bar; b.x = xb_xcc_id(); b.st = st;
    if (threadIdx.x == 0) (void)xb_add(&bar[XB_XCNT(b.x)], 1u);
    return b;
}
__device__ __forceinline__ void xcd_barrier_complete(unsigned* bar, unsigned x, unsigned& nloc, unsigned& nx) {
    const unsigned G = gridDim.x * gridDim.y * gridDim.z;
    unsigned sum, cnt, mine, sp = 0u;
    for (;;) {
        sum = 0u; cnt = 0u; mine = 0u;
#pragma unroll
        for (unsigned j = 0; j < 16; ++j) { const unsigned c = xb_ld(&bar[XB_XCNT(j)]); sum += c; cnt += (c > 0u) ? 1u : 0u; mine = (j == x) ? c : mine; }
        if (sum == G) break;
        __builtin_amdgcn_s_sleep(1);
        if ((++sp & 255u) == 0u) { if (xb_ld(&bar[XB_TMO])) break; if (sp > XB_SPIN_CAP) { atomicAdd(&bar[XB_TMO], 1u); break; } }
    }
    nloc = mine > 0u ? mine : 1u; nx = cnt > 0u ? cnt : 1u;
}

__device__ __forceinline__ void xcd_barrier(const XcdBarrier& b) {
    asm volatile("s_waitcnt vmcnt(0)" ::: "memory");
    __syncthreads();
    if (threadIdx.x == 0) {
        unsigned* bar = b.bar;
        __builtin_amdgcn_s_waitcnt(0);
        unsigned nloc = b.st[0], nx = b.st[1];
        if (nloc == 0u) { xcd_barrier_complete(bar, b.x, nloc, nx); b.st[0] = nloc; b.st[1] = nx; }
        const unsigned old = xb_add(&bar[XB_XSUB(b.x)], 1u);
        const unsigned gen = old / nloc;
        if (old + 1u == (gen + 1u) * nloc) {
            __builtin_amdgcn_fence(__ATOMIC_RELEASE, "agent");
            asm volatile("s_waitcnt vmcnt(0)" ::: "memory");
            const unsigned og = xb_add(&bar[XB_TOP], 1u);
            const unsigned tg = og / nx;
            if (og + 1u == (tg + 1u) * nx) xb_add(&bar[XB_TOPGEN], 1u);
            else XB_SPIN(xb_ld(&bar[XB_TOPGEN]) == tg, bar);
            __builtin_amdgcn_fence(__ATOMIC_ACQUIRE, "agent");
            xb_add(&bar[XB_XGEN(b.x)], 1u);
            asm volatile("s_waitcnt vmcnt(0)" ::: "memory");
        } else {
            XB_SPIN(xb_ld(&bar[XB_XGEN(b.x)]) == gen, bar);
            __builtin_amdgcn_fence(__ATOMIC_ACQUIRE, "agent");
            asm volatile("s_waitcnt vmcnt(0)" ::: "memory");
        }
    }
    __syncthreads();
}

__global__ void __launch_bounds__(512, 2) mega(Params pa) {
    extern __shared__ __attribute__((aligned(16))) unsigned char shm[];
    LAS unsigned char* lds = (LAS unsigned char*)shm;
    const int G = gridDim.x, bid = blockIdx.x;
    KP* pk = (KP*)__builtin_amdgcn_kernarg_segment_ptr();
    volatile LAS unsigned* bst = (volatile LAS unsigned*)(lds + LDS_BYTES - 16);
    XcdBarrier xb; xb.bar = nullptr; xb.x = 0; xb.st = bst;
    if (pa.coop) { if (threadIdx.x < 2) bst[threadIdx.x] = 0u; __syncthreads(); xb = xcd_barrier_post((unsigned*)(pa.ws + W_BAR), bst); }
    for (int ph = pa.ph_lo; ph < pa.ph_hi; ++ph) {
        if (ph > pa.ph_lo && pa.coop) { if (pa.pad == 0x5a5a) { __threadfence(); cg::this_grid().sync(); } else xcd_barrier(xb); }
        asm volatile("" : "+s"(pk)); KP& p = *pk;
        if (ph == 0) { phase_prep(p, lds); continue; }
        if (ph == 42) { int tq = threadIdx.x; asm volatile("" : "+v"(tq)); const unsigned short* w16 = (const unsigned short*)p.ws; for (size_t i = (size_t)bid * 512 + tq; i < (size_t)59418624; i += (size_t)G * 512) p.out[i] = (float)w16[i * 4]; continue; }
        if (ph == 41) { int tq = threadIdx.x; asm volatile("" : "+v"(tq)); for (size_t i = (size_t)bid * 512 + tq; i < (size_t)59418624; i += (size_t)G * 512) { const float v = p.out[i]; if (!(fabsf(v) < 1e30f)) p.out[i] = 0.f; } continue; }
        const int l = (ph - 1) / 10, k = (ph - 1) % 10;
        bf16_t* XB = (bf16_t*)(p.ws + W_XB);
        switch (k) {
        case 0: if (REP_G1 > 1) { pg8::StaticOrder S; S.init(T_ALL, NPROJ, G, bid); EpiNull E{(float*)(p.ws + W_CD)};
                  pg8::gemm_phase(lds, pg8::Gemm{XB, (const bf16_t*)(p.ws + W_IN + l * W_IN_L), T_ALL, NPROJ, DM}, S, E); }
                { pg8::StaticOrder S; S.init(T_ALL, NPROJ, G, bid);
                  EpiIn E{(bf16_t*)(p.ws + W_PROJ), p.out, (float*)(p.ws + W_DTB), p.in[13], l};
                  pg8::gemm_phase(lds, pg8::Gemm{XB, (const bf16_t*)(p.ws + W_IN + l * W_IN_L), T_ALL, NPROJ, DM}, S, E); } break;
        case 1: for (int it = bid; it < 3 * NU64; it += G) { if (it < NU64) attn_unit(p, lds, l, NU64 - 1 - it); else if (it < 2 * NU64) ssd_states(p, lds, l, it - NU64); else gmlp_unit(p, lds, l, it - 2 * NU64); } break;
        case 2: for (int it = bid; it < 96 + 768; it += G) { if (it < 96) scan_prompt(p, l, it); else scan_sample(p, l, it - 96); } break;
        case 3: for (int rep = 0; rep < REP_M3; ++rep) for (int it = bid; it < NU64; it += G) ssd_y(p, lds, l, it); break;
        case 4: { pg8::StaticOrder S; S.init(T_ALL, DM, G, bid); EpiRes E{p.out, XB, (bf16_t*)p.out};
                  pg8::gemm_phase(lds, pg8::Gemm{(const bf16_t*)(p.ws + W_MIX), (const bf16_t*)(p.ws + W_OUT + l * W_OUT_L), T_ALL, DM, DM}, S, E); } break;
        case 5: phase_ln(p, (const bf16_t*)p.out, p.in[20] + l * DM, p.in[21] + l * DM, false); break;
        case 6: for (int rep = 0; rep < REP_G3; ++rep) { pg8::StaticOrder S; S.init(T_ALL, DFF2, G, bid);
                  EpiUp E{(bf16_t*)(p.ws + W_PROJ), (float*)(p.ws + W_MIX), p.out, p.in[23], p.in[24], p.in[6], l};
                  pg8::OneUnit o1;
                  for (int i = 0; S.next(i, o1.u); ++i) { pg8::gemm_phase(lds, pg8::Gemm{XB, (const bf16_t*)(p.ws + W_UP + l * W_UP_L), T_ALL, DFF2, DM}, o1, E); __syncthreads(); } } break;
        case 7: phase_fix(p, l); break;
        case 8: { pg8::StaticOrder S; S.init(T_ALL, DM, G, bid); EpiRes E{p.out, XB, (bf16_t*)(p.ws + W_MIX)};
                  pg8::gemm_phase(lds, pg8::Gemm{(const bf16_t*)(p.ws + W_PROJ), (const bf16_t*)(p.ws + W_DN + l * W_DN_L), T_ALL, DM, DFF}, S, E); } break;
        case 9: phase_ln(p, (const bf16_t*)(p.ws + W_MIX), p.in[26] + l * DM, p.in[27] + l * DM, l == DEPTH - 1); break;
        }
    }
}

constexpr int N_PHASES = 41;
#ifndef MULTI_LAUNCH
#define MULTI_LAUNCH 0
#endif

extern "C" void kernel_launch(void* const* d_in, const int* in_sizes, int n_in, void* d_out, int out_size, void* d_ws, size_t ws_size, hipStream_t stream) {
    static int grid = 0;
    if (grid == 0) {
        if (n_in != 28 || ws_size < W_END2) { fprintf(stderr, "kernel_launch: need 28 inputs and %zu bytes of workspace (got %d, %zu)\n", (size_t)W_END2, n_in, ws_size); grid = -1; return; }
        int dev = 0, cus = 0, per_cu = 0;
        hipGetDevice(&dev); hipDeviceGetAttribute(&cus, hipDeviceAttributeMultiprocessorCount, dev);
        if (hipFuncSetAttribute((const void*)mega, hipFuncAttributeMaxDynamicSharedMemorySize, LDS_BYTES) != hipSuccess) { fprintf(stderr, "kernel_launch: hipFuncSetAttribute failed\n"); grid = -1; return; }
        hipOccupancyMaxActiveBlocksPerMultiprocessor(&per_cu, (const void*)mega, 512, LDS_BYTES);
        (void)hipGetLastError();
        if (per_cu < 1) per_cu = 1;
        grid = cus * 1;
    }
    if (grid < 0) return;
    Params p{};
    for (int i = 0; i < 28; ++i) p.in[i] = (const float*)d_in[i];
    p.out = (float*)d_out; p.ws = (unsigned char*)d_ws;
#if MULTI_LAUNCH
#ifdef PROBE_CUT
    for (int ph = 0; ph < PROBE_CUT; ++ph) { p.ph_lo = ph; p.ph_hi = ph + 1; p.coop = 0; hipLaunchKernelGGL(mega, dim3(grid), dim3(512), LDS_BYTES, stream, p); }
    p.ph_lo = 42; p.ph_hi = 43; p.coop = 0; hipLaunchKernelGGL(mega, dim3(grid), dim3(512), LDS_BYTES, stream, p);
#else
    for (int ph = 0; ph < N_PHASES; ++ph) { p.ph_lo = ph; p.ph_hi = ph + 1; p.coop = 0; hipLaunchKernelGGL(mega, dim3(grid), dim3(512), LDS_BYTES, stream, p); }
#endif
#else
    p.ph_lo = 0; p.ph_hi = N_PHASES; p.coop = 1;
    if (hipMemsetAsync((char*)d_ws + W_BAR, 0, 16384, stream) != hipSuccess) { fprintf(stderr, "kernel_launch: memset failed\n"); return; }
    void* args[] = {&p};
    hipError_t e = hipLaunchCooperativeKernel((const void*)mega, dim3(grid), dim3(512), args, LDS_BYTES, stream);
    if (e != hipSuccess) fprintf(stderr, "cooperative launch failed: %s (grid %d)\n", hipGetErrorString(e), grid);
#endif
}
```

```cpp
#define REP_G1 1
#define REP_M1 1
#define REP_ATT 1
#define REP_M3 1
#define REP_G3 1
#include <hip/hip_runtime.h>
#include <hip/hip_cooperative_groups.h>
#include <cstdio>
namespace cg = cooperative_groups;

#define LAS __attribute__((address_space(3)))
typedef unsigned short bf16_t;
typedef short bf16x8 __attribute__((ext_vector_type(8)));
typedef float f32x4 __attribute__((ext_vector_type(4)));
typedef float f32x2 __attribute__((ext_vector_type(2)));
typedef unsigned u32x4 __attribute__((ext_vector_type(4)));
typedef unsigned u32x2 __attribute__((ext_vector_type(2)));

constexpr int T_ALL = 34816, T_P = 32768, DM = 1024, NPROJ = 3072, DFF = 2816, DFF2 = 5632, DEPTH = 4;
constexpr int NU64 = 544;
constexpr float ALPHA = 1.6817928305074290f;
constexpr float LN_EPS = 1e-5f, RMS_EPS = 1e-5f;
constexpr int C_K = 384, C_V = 768, C_Z = 1152, C_XBC = 1536, C_U = 2432, C_VC = 2688, C_DT = 2944;
constexpr size_t O_YP = 0, O_YS = 33554432, O_PK = 35651584, O_PV = O_PK + 3145728, O_PH = O_PV + 3145728, O_PC = O_PH + 786432,
                 O_PF = O_PC + 43008, O_SK = O_PF + 180224, O_SV = O_SK + 3145728, O_SH = O_SV + 3145728, O_SC = O_SH + 6291456,
                 O_SG = O_SC + 344064, O_SF = O_SG + 2097152;
constexpr size_t W_IN = 0, W_IN_L = (size_t)NPROJ * DM * 2;
constexpr size_t W_OUT = W_IN + 4 * W_IN_L, W_OUT_L = (size_t)DM * DM * 2;
constexpr size_t W_UP = W_OUT + 4 * W_OUT_L, W_UP_L = (size_t)DFF2 * DM * 2;
constexpr size_t W_DN = W_UP + 4 * W_UP_L, W_DN_L = (size_t)DM * DFF * 2;
constexpr size_t W_GW = W_DN + 4 * W_DN_L, W_GW_L = (size_t)4 * 128 * 128 * 2;
constexpr size_t W_XB = W_GW + 4 * W_GW_L;
constexpr size_t W_PROJ = W_XB + (size_t)T_ALL * DM * 2;
constexpr size_t W_MIX = W_PROJ + (size_t)T_ALL * NPROJ * 2;
constexpr size_t W_ST = W_MIX + (size_t)T_ALL * DM * 2;
constexpr size_t W_CD = W_ST + (size_t)NU64 * 6 * 8192 * 2;
constexpr size_t W_DTB = W_CD + (size_t)NU64 * 8 * 4;
constexpr size_t W_END = W_DTB + (size_t)T_ALL * 8 * 4;
constexpr size_t W_BAR = W_END;
constexpr size_t W_END2 = W_BAR + 16384;
constexpr int LDS_BYTES = 156 * 1024;

struct Params { const float* in[28]; float* out; unsigned char* ws; int ph_lo, ph_hi, coop, pad; };
typedef const __attribute__((address_space(4))) Params KP;

__device__ __forceinline__ float bf2f(unsigned b) { return __uint_as_float(b << 16); }
typedef __bf16 bf16v2 __attribute__((ext_vector_type(2)));
__device__ __forceinline__ unsigned cvt_pk_bf16(float lo, float hi) { const f32x2 v = {lo, hi}; const bf16v2 b = __builtin_convertvector(v, bf16v2); return __builtin_bit_cast(unsigned, b); }
__device__ __forceinline__ u32x2 pack4(f32x4 v) { u32x2 w; w.x = cvt_pk_bf16(v[0], v[1]); w.y = cvt_pk_bf16(v[2], v[3]); return w; }
__device__ __forceinline__ f32x4 unpack4(u32x2 w) { f32x4 v; v[0] = bf2f(w.x & 0xffffu); v[1] = bf2f(w.x >> 16); v[2] = bf2f(w.y & 0xffffu); v[3] = bf2f(w.y >> 16); return v; }
__device__ __forceinline__ float silu_f(float x) { return x * __builtin_amdgcn_rcpf(1.0f + __expf(-x)); }
__device__ __forceinline__ float gelu_tanh(float x) { const float y = 0.7978845608028654f * (x + 0.044715f * x * x * x); const float e = __expf(2.0f * y); return 0.5f * x * (2.0f - 2.0f * __builtin_amdgcn_rcpf(1.0f + e)); }
__device__ __forceinline__ float softplus_f(float x) { const float e = __expf(x); return x > 15.0f ? x : (e < 1e-3f ? e * (1.0f - 0.5f * e + 0.33333333f * e * e) : __logf(1.0f + e)); }
#define MFMA16(colfrag, rowfrag, acc) __builtin_amdgcn_mfma_f32_16x16x32_bf16((colfrag), (rowfrag), (acc), 0, 0, 0)
__device__ __forceinline__ bf16x8 ldsfrag(LAS const unsigned char* p) { return *(LAS const bf16x8*)p; }
__device__ __forceinline__ bf16x8 glbfrag(const bf16_t* p) { return *(const bf16x8*)p; }
#define LDS_WAVE_SYNC() asm volatile("s_waitcnt lgkmcnt(0)" ::: "memory")

namespace pg8 {
constexpr int BM = 256, BK = 64, HALF = 128, HTB = HALF * BK * 2, STAGE_BYTES = 8 * HTB, NXCD = 8, WGM = 8;
__device__ __forceinline__ int lds_byte(int r, int c) { const int st = (r >> 4) * 2 + (c >> 5), rr = r & 15, cc = c & 31, ob = rr * 64 + cc * 2; return st * 1024 + (ob ^ (((ob >> 9) & 1) << 5)); }
__device__ __forceinline__ void stage_rc(int b, int& R, int& C) { const int st = b / 1024, sb = b % 1024, swz = sb ^ (((sb >> 9) & 1) << 5); R = (st >> 1) * 16 + swz / 64; C = (st & 1) * 32 + (swz % 64) / 2; }
__device__ __forceinline__ int perm32(int rho) { const int n = rho >> 4, i = rho & 15; return 8 * (i >> 2) + 4 * n + (i & 3); }
struct Unit { int pm, pn; };
struct Gemm { const bf16_t* A; const bf16_t* Bt; int M, N, K; };
struct StaticOrder {
    int nM, nN, nwg, G, c;
    __device__ __forceinline__ void init(int M, int N, int G_, int c_) { nM = M / BM; nN = N / BM; nwg = nM * nN; G = G_; c = c_; }
    __device__ __forceinline__ bool next(int i, Unit& u) const {
        const long L = (long)i * G + c; if (L >= nwg) return false;
        int wgid = (int)L; { const int q = nwg / NXCD, r = nwg % NXCD, xcd = wgid % NXCD, off = wgid / NXCD; wgid = (xcd < r ? xcd * (q + 1) : r * (q + 1) + (xcd - r) * q) + off; }
        const int nig = WGM * nN, gid = wgid / nig, fm = gid * WGM, gsz = (nM - fm) < WGM ? (nM - fm) : WGM;
        u.pm = fm + ((wgid % nig) % gsz); u.pn = (wgid % nig) / gsz; return true;
    }
    __device__ __forceinline__ void a_ready(const Unit&) const {}
    __device__ __forceinline__ void done(const Unit&) const {}
};
struct OneUnit {
    Unit u;
    __device__ __forceinline__ bool next(int i, Unit& o) const { if (i) return false; o = u; return true; }
    __device__ __forceinline__ void a_ready(const Unit&) const {}
    __device__ __forceinline__ void done(const Unit&) const {}
};

template <class Epi, class Sched>
__device__ __forceinline__ void gemm_phase(LAS unsigned char* lds, const Gemm g, const Sched& S, const Epi& E) {
    int tid_ = threadIdx.x; asm volatile("" : "+v"(tid_));
    const int tid = tid_, wid = __builtin_amdgcn_readfirstlane(tid >> 6), lane = tid & 63, wr = wid >> 2, wc = wid & 3, fr = lane & 15, fq = lane >> 4;
    const int K = g.K, nt = K / BK;
    unsigned voffA[2], voffB[2];
#pragma unroll
    for (int i = 0; i < 2; ++i) { int R, C; stage_rc(tid * 16 + i * 8192, R, C); const int Rb = (R & ~31) + perm32(R & 31); voffA[i] = (unsigned)(R * K + C) * 2u; voffB[i] = (unsigned)(Rb * K + C) * 2u; }
    const size_t kstep = (size_t)(BK * 2);
    const size_t hstep = (size_t)HALF * K * 2;
    const size_t tstep = 2 * hstep;
    const unsigned ldsw = (unsigned)wid * 1024u;
    const int aoff = lds_byte(wr * 64 + fr, fq * 8), boff = lds_byte(wc * 32 + fr, fq * 8);
#define PG8_SA(b, h) (((b) * 2 + (h)) * HTB)
#define PG8_SB(b, h) ((4 + (b) * 2 + (h)) * HTB)
#define PG8_STAGE(bufoff, gbase, voff) do { _Pragma("unroll") for (int _i = 0; _i < 2; ++_i) \
        __builtin_amdgcn_global_load_lds((const unsigned*)((const char*)(gbase) + (voff)[_i]), (LAS unsigned*)(lds + (bufoff) + ldsw + _i * 8192), 16, 0, 0); } while (0)
#define PG8_LDA(dst, b, h) do { _Pragma("unroll") for (int m = 0; m < 4; ++m) _Pragma("unroll") for (int k = 0; k < 2; ++k) dst[m][k] = *(const LAS bf16x8*)(lds + PG8_SA(b, h) + aoff + m * 2048 + k * 1024); } while (0)
#define PG8_LDB(dst, b, h) do { _Pragma("unroll") for (int n = 0; n < 2; ++n) _Pragma("unroll") for (int k = 0; k < 2; ++k) dst[n][k] = *(const LAS bf16x8*)(lds + PG8_SB(b, h) + boff + n * 2048 + k * 1024); } while (0)
#define PG8_MMA(ai, bj, At, Bt) do { __builtin_amdgcn_s_setprio(1); _Pragma("unroll") for (int m = 0; m < 4; ++m) _Pragma("unroll") for (int n = 0; n < 2; ++n) _Pragma("unroll") for (int k = 0; k < 2; ++k) \
        acc[ai][bj][m][n] = __builtin_amdgcn_mfma_f32_16x16x32_bf16(Bt[n][k], At[m][k], acc[ai][bj][m][n], 0, 0, 0); __builtin_amdgcn_s_setprio(0); } while (0)
#define PG8_WAIT_V(n) asm volatile("s_waitcnt vmcnt(" #n ")" ::: "memory")
#define PG8_WAIT_L(n) asm volatile("s_waitcnt lgkmcnt(" #n ")" ::: "memory")
#define PG8_BAR __builtin_amdgcn_s_barrier()
#define PG8_SCHED __builtin_amdgcn_sched_barrier(0)
    Unit cur, nxt; int ui = 0;
    if (!S.next(0, cur)) return;
    f32x4 acc[2][2][4][2];
#pragma unroll
    for (int a = 0; a < 2; ++a)
#pragma unroll
        for (int b = 0; b < 2; ++b)
#pragma unroll
            for (int m = 0; m < 4; ++m)
#pragma unroll
                for (int n = 0; n < 2; ++n) acc[a][b][m][n] = (f32x4){0.f, 0.f, 0.f, 0.f};
    bf16x8 At[4][2], B0[2][2], B1[2][2];
    const char* cA = (const char*)g.A + (size_t)cur.pm * tstep; const char* cB = (const char*)g.Bt + (size_t)cur.pn * tstep;
    S.a_ready(cur);
    PG8_STAGE(PG8_SB(0, 0), cB, voffB); PG8_STAGE(PG8_SA(0, 0), cA, voffA); PG8_STAGE(PG8_SB(0, 1), cB + hstep, voffB); PG8_STAGE(PG8_SA(0, 1), cA + hstep, voffA);
    if (wr == 1) PG8_BAR;
    PG8_WAIT_V(4); PG8_BAR;
    PG8_STAGE(PG8_SB(1, 0), cB + kstep, voffB); PG8_STAGE(PG8_SA(1, 0), cA + kstep, voffA); PG8_STAGE(PG8_SB(1, 1), cB + hstep + kstep, voffB);
    PG8_WAIT_V(6); PG8_BAR;
    for (;;) {
        const bool has_next = S.next(ui + 1, nxt);
        const char* nA = has_next ? (const char*)g.A + (size_t)nxt.pm * tstep : cA; const char* nB = has_next ? (const char*)g.Bt + (size_t)nxt.pn * tstep : cB;
        for (int t = 0; t < nt; t += 2) {
            const bool last = (t == nt - 2);
            const char* a1 = cA + (size_t)(t + 1) * kstep;
            const char* a2 = last ? nA : cA + (size_t)(t + 2) * kstep; const char* b2 = last ? nB : cB + (size_t)(t + 2) * kstep;
            const char* a3 = a2 + kstep; const char* b3 = b2 + kstep;
            if (last && has_next) S.a_ready(nxt);
            PG8_LDB(B0, 0, 0); PG8_SCHED; PG8_LDA(At, 0, 0); PG8_STAGE(PG8_SA(1, 1), a1 + hstep, voffA);
            PG8_WAIT_L(8); PG8_BAR; PG8_WAIT_L(0); PG8_MMA(0, 0, At, B0); PG8_BAR; PG8_SCHED;
            PG8_LDB(B1, 0, 1); PG8_STAGE(PG8_SB(0, 0), b2, voffB);
            PG8_BAR; PG8_WAIT_L(0); PG8_MMA(0, 1, At, B1); PG8_BAR;
            PG8_LDA(At, 0, 1); PG8_STAGE(PG8_SA(0, 0), a2, voffA);
            PG8_BAR; PG8_WAIT_L(0); PG8_MMA(1, 0, At, B0); PG8_BAR; PG8_SCHED;
            PG8_STAGE(PG8_SB(0, 1), b2 + hstep, voffB);
            PG8_WAIT_V(6); PG8_BAR; PG8_MMA(1, 1, At, B1); PG8_BAR;
            PG8_LDB(B0, 1, 0); PG8_SCHED; PG8_LDA(At, 1, 0); PG8_STAGE(PG8_SA(0, 1), a2 + hstep, voffA);
            PG8_WAIT_L(8); PG8_BAR; PG8_WAIT_L(0); PG8_MMA(0, 0, At, B0); PG8_BAR; PG8_SCHED;
            PG8_LDB(B1, 1, 1); PG8_STAGE(PG8_SB(1, 0), b3, voffB);
            PG8_BAR; PG8_WAIT_L(0); PG8_MMA(0, 1, At, B1); PG8_BAR;
            PG8_LDA(At, 1, 1); PG8_STAGE(PG8_SA(1, 0), a3, voffA);
            PG8_BAR; PG8_WAIT_L(0); PG8_MMA(1, 0, At, B0); PG8_BAR; PG8_SCHED;
            PG8_STAGE(PG8_SB(1, 1), b3 + hstep, voffB);
            PG8_WAIT_V(6); PG8_BAR; PG8_MMA(1, 1, At, B1); PG8_BAR;
        }
        if constexpr (!Epi::AFTER_DRAIN) { E(acc, cur, wr, wc, fr, fq); S.done(cur); }
        if (!has_next) break;
#pragma unroll
        for (int a = 0; a < 2; ++a)
#pragma unroll
            for (int b = 0; b < 2; ++b)
#pragma unroll
                for (int m = 0; m < 4; ++m)
#pragma unroll
                    for (int n = 0; n < 2; ++n) acc[a][b][m][n] = (f32x4){0.f, 0.f, 0.f, 0.f};
        cur = nxt; cA = nA; cB = nB; ++ui;
    }
    PG8_WAIT_V(0);
    if (wr == 0) PG8_BAR;
    PG8_BAR;
    if constexpr (Epi::AFTER_DRAIN) { E.fused(acc, cur, wr, wc, fr, fq, lds, wid, lane); S.done(cur); }
#undef PG8_SA
#undef PG8_SB
#undef PG8_STAGE
#undef PG8_LDA
#undef PG8_LDB
#undef PG8_MMA
#undef PG8_WAIT_V
#undef PG8_WAIT_L
#undef PG8_BAR
#undef PG8_SCHED
}
}
using pg8::Unit;

struct EpiIn {
    static constexpr bool AFTER_DRAIN = false;
    bf16_t* proj; float* out; float* dtb; const float* dt_bias; int l;
    __device__ __forceinline__ void operator()(const f32x4 (&acc)[2][2][4][2], const Unit& u, int wr, int wc, int fr_, int fq_) const {
        int fr = fr_, fq = fq_; asm volatile("" : "+v"(fr), "+v"(fq));
#pragma unroll
        for (int bj = 0; bj < 2; ++bj) {
            const int cb = u.pn * 256 + bj * 128;
            const int col = cb + wc * 32 + fq * 8;
            if (cb > C_DT) continue;
#pragma unroll
            for (int ai = 0; ai < 2; ++ai)
#pragma unroll
                for (int m = 0; m < 4; ++m) {
                    const int row = u.pm * 256 + ai * 128 + wr * 64 + m * 16 + fr;
                    const bool isP = row < T_P; int b, t;
                    if (isP) { b = row >> 13; t = row & 8191; } else { b = (row - T_P) >> 6; t = row & 63; }
                    f32x4 v0 = acc[ai][bj][m][0], v1 = acc[ai][bj][m][1];
                    if (cb < C_U) {
                        u32x4 w; { const u32x2 a = pack4(v0), c = pack4(v1); w.x = a.x; w.y = a.y; w.z = c.x; w.w = c.y; }
                        *(u32x4*)(proj + (size_t)row * NPROJ + col) = w;
                        if (cb >= C_K && cb < C_Z) {
                            const int isv = cb >= C_V; const int cc = col - (isv ? C_V : C_K);
                            float* o = nullptr;
                            if (isP) { if (t >= 7680) o = out + (isv ? O_PV : O_PK) + ((size_t)(l * 4 + b) * 512 + (t - 7680)) * 384 + cc; }
                            else o = out + (isv ? O_SV : O_SK) + ((size_t)(l * 32 + b) * 64 + t) * 384 + cc;
                            if (o) { *(f32x4*)o = v0; *(f32x4*)(o + 4) = v1; }
                        } else if (cb >= C_XBC) {
                            const int cc = col - C_XBC; float* o = nullptr;
                            if (isP) { if (t >= 8189) o = out + O_PC + ((size_t)(l * 4 + b) * 3 + (t - 8189)) * 896 + cc; }
                            else if (t >= 61) o = out + O_SC + ((size_t)(l * 32 + b) * 3 + (t - 61)) * 896 + cc;
                            if (o) { *(f32x4*)o = v0; *(f32x4*)(o + 4) = v1; }
                        }
                    } else if (cb < C_DT) {
#pragma unroll
                        for (int j = 0; j < 4; ++j) { v0[j] = gelu_tanh(v0[j]); v1[j] = gelu_tanh(v1[j]); }
                        u32x4 w; { const u32x2 a = pack4(v0), c = pack4(v1); w.x = a.x; w.y = a.y; w.z = c.x; w.w = c.y; }
                        *(u32x4*)(proj + (size_t)row * NPROJ + col) = w;
                        if (cb >= C_VC && !isP) { float* o = out + O_SG + ((size_t)(l * 32 + b) * 64 + t) * 256 + (col - C_VC); *(f32x4*)o = v0; *(f32x4*)(o + 4) = v1; }
                    } else if (col == C_DT) {
                        float* d = dtb + (size_t)row * 8;
#pragma unroll
                        for (int j = 0; j < 4; ++j) d[j] = softplus_f(v0[j] + dt_bias[l * 6 + j]);
#pragma unroll
                        for (int j = 0; j < 2; ++j) d[4 + j] = softplus_f(v1[j] + dt_bias[l * 6 + 4 + j]);
                    }
                    asm volatile("" ::: "memory");
                }
        }
    }
};
struct EpiNull {
    static constexpr bool AFTER_DRAIN = false;
    float* sink;
    __device__ __forceinline__ void operator()(const f32x4 (&acc)[2][2][4][2], const Unit& u, int wr, int wc, int fr, int fq) const {
        float t = 0.f;
#pragma unroll
        for (int ai = 0; ai < 2; ++ai)
#pragma unroll
            for (int bj = 0; bj < 2; ++bj)
#pragma unroll
                for (int m = 0; m < 4; ++m)
#pragma unroll
                    for (int n = 0; n < 2; ++n) t += acc[ai][bj][m][n][0] + acc[ai][bj][m][n][1] + acc[ai][bj][m][n][2] + acc[ai][bj][m][n][3];
        if (t == 123456.789f) sink[0] = t;
    }
};
struct EpiRes {
    static constexpr bool AFTER_DRAIN = false;
    float* x; const bf16_t* xb; bf16_t* rdst;
    __device__ __forceinline__ void operator()(const f32x4 (&acc)[2][2][4][2], const Unit& u, int wr, int wc, int fr_, int fq_) const {
        int fr = fr_, fq = fq_; asm volatile("" : "+v"(fr), "+v"(fq));
#pragma unroll
        for (int ai = 0; ai < 2; ++ai)
#pragma unroll
            for (int m = 0; m < 4; ++m) {
                float* rowp = x + (size_t)(u.pm * 256 + ai * 128 + wr * 64 + m * 16 + fr) * DM + u.pn * 256 + wc * 32 + fq * 8;
#pragma unroll
                for (int bj = 0; bj < 2; ++bj) { float* q = rowp + bj * 128; const u32x4 xw = *(const u32x4*)(xb + (q - x));
                    const f32x4 o0 = unpack4((u32x2){xw.x, xw.y}), o1 = unpack4((u32x2){xw.z, xw.w});
                    const u32x2 ra = pack4(o0 * ALPHA + acc[ai][bj][m][0]), rb = pack4(o1 * ALPHA + acc[ai][bj][m][1]);
                    *(u32x4*)(rdst + (q - x)) = (u32x4){ra.x, ra.y, rb.x, rb.y}; }
                asm volatile("" ::: "memory");
            }
    }
};
struct EpiUp {
    static constexpr bool AFTER_DRAIN = true;
    bf16_t* H; float* halo; float* out; const float* cw; const float* cb; const float* fstate; int l;
    __device__ __forceinline__ void operator()(const f32x4 (&)[2][2][4][2], const Unit&, int, int, int, int) const {}
    __device__ __forceinline__ void fused(f32x4 (&acc)[2][2][4][2], const Unit& u, int wr, int wc, int fr, int fq, LAS unsigned char* lds, int wid, int lane) const {
        constexpr int LS = 264;
#pragma unroll
        for (int ai = 0; ai < 2; ++ai)
#pragma unroll
            for (int m = 0; m < 4; ++m)
#pragma unroll
                for (int bj = 0; bj < 2; ++bj) {
                        const int rl = ai * 128 + wr * 64 + m * 16 + fr, cl = bj * 128 + wc * 32 + fq * 8;
                        u32x4 w; { const u32x2 a = pack4(acc[ai][bj][m][0]), c = pack4(acc[ai][bj][m][1]); w.x = a.x; w.y = a.y; w.z = c.x; w.w = c.y; }
                        *(LAS u32x4*)(lds + (rl * LS + cl) * 2) = w;
                    }
        __syncthreads();
        const int tid = wid * 64 + lane, j = tid & 127, seg = tid >> 7;
        const int hcol = u.pn * 128 + j;
        const float* w = cw + (size_t)l * 3 * DFF2; const float* bb = cb + (size_t)l * DFF2;
        const float wg0 = w[hcol], wg1 = w[DFF2 + hcol], wg2 = w[2 * DFF2 + hcol], bg = bb[hcol];
        const float wv0 = w[DFF + hcol], wv1 = w[DFF2 + DFF + hcol], wv2 = w[2 * DFF2 + DFF + hcol], bv = bb[DFF + hcol];
        const int R = u.pm * 256 + seg * 64;
        const bool isP = R < T_P;
        float g2 = 0.f, g1 = 0.f, v2 = 0.f, v1 = 0.f; int skip = 0;
        const LAS bf16_t* U = (const LAS bf16_t*)lds;
        if (isP) {
            if (seg > 0) { g2 = bf2f(U[(seg * 64 - 2) * LS + j]); g1 = bf2f(U[(seg * 64 - 1) * LS + j]); v2 = bf2f(U[(seg * 64 - 2) * LS + 128 + j]); v1 = bf2f(U[(seg * 64 - 1) * LS + 128 + j]); }
            else if ((R & 8191) != 0) skip = 2;
        } else {
            const int sb = (R - T_P) >> 6; const float* fs = fstate + (size_t)(l * 32 + sb) * 2 * DFF2;
            g2 = fs[hcol]; g1 = fs[DFF2 + hcol]; v2 = fs[DFF + hcol]; v1 = fs[DFF2 + DFF + hcol];
        }
        bf16_t* hp = H + (size_t)R * DFF + hcol;
#pragma unroll 8
        for (int i = 0; i < 64; ++i) {
            const float gq = bf2f(U[(seg * 64 + i) * LS + j]), vq = bf2f(U[(seg * 64 + i) * LS + 128 + j]);
            if (i >= skip) {
                const float cgv = bg + wg0 * g2 + wg1 * g1 + wg2 * gq, cvv = bv + wv0 * v2 + wv1 * v1 + wv2 * vq;
                const float hv = silu_f(cgv) * cvv;
                hp[(size_t)i * DFF] = (bf16_t)(cvt_pk_bf16(hv, 0.f) & 0xffffu);
            }
            g2 = g1; g1 = gq; v2 = v1; v1 = vq;
            if (isP) {
                if (seg == 0 && i < 2) { float* hl = halo + ((size_t)u.pm * 4 + i) * DFF2; hl[hcol] = gq; hl[DFF + hcol] = vq; }
                if (seg == 3 && i >= 62) { float* hl = halo + ((size_t)u.pm * 4 + 2 + (i - 62)) * DFF2; hl[hcol] = gq; hl[DFF + hcol] = vq;
                    if ((u.pm & 31) == 31) { float* o = out + O_PF + ((size_t)(l * 4 + (u.pm >> 5)) * 2 + (i - 62)) * DFF2; o[hcol] = gq; o[DFF + hcol] = vq; } }
            } else if (i >= 62) {
                const int sb = (R - T_P) >> 6; float* o = out + O_SF + ((size_t)(l * 32 + sb) * 2 + (i - 62)) * DFF2; o[hcol] = gq; o[DFF + hcol] = vq;
            }
        }
    }
};

template <int CTRL> __device__ __forceinline__ float dppz(float x) { return __builtin_bit_cast(float, __builtin_amdgcn_update_dpp(0, __builtin_bit_cast(int, x), CTRL, 0xf, 0xf, true)); }
struct EpiUp2 {
    static constexpr bool AFTER_DRAIN = false;
    bf16_t* H; float* halo; float* out; const float* cw; const float* cb; const float* fstate; int l; LAS unsigned char* lds;
    __device__ __forceinline__ void operator()(const f32x4 (&acc)[2][2][4][2], const Unit& u, int wr, int wc, int fr_, int fq_) const {
        int fr = fr_, fq = fq_; asm volatile("" : "+v"(fr), "+v"(fq));
        const int hcol = u.pn * 128 + wc * 32 + fq * 8;
        const float* w = cw + (size_t)l * 3 * DFF2 + hcol; const float* bb = cb + (size_t)l * DFF2 + hcol;
        LAS f32x4* wl = (LAS f32x4*)(lds + 131072 + (wc * 4 + fq) * 256);
#pragma unroll
        for (int sd = 0; sd < 2; ++sd)
#pragma unroll
            for (int hf = 0; hf < 2; ++hf) { wl[(sd * 2 + hf) * 4 + 3] = *(const f32x4*)(bb + sd * DFF + hf * 4);
#pragma unroll
                for (int tp = 0; tp < 3; ++tp) wl[(sd * 2 + hf) * 4 + tp] = *(const f32x4*)(w + tp * DFF2 + sd * DFF + hf * 4); }
        asm volatile("s_waitcnt lgkmcnt(0)" ::: "memory");
#pragma unroll
        for (int ai = 0; ai < 2; ++ai) {
            const int R = u.pm * 256 + ai * 128 + wr * 64, blk = R >> 6;
            const bool isP = R < T_P, seqstart = isP ? ((R & 8191) == 0) : true;
            f32x4 Xp[2][2];
#pragma unroll
            for (int sd = 0; sd < 2; ++sd)
#pragma unroll
                for (int hf = 0; hf < 2; ++hf) Xp[sd][hf] = (f32x4){0.f, 0.f, 0.f, 0.f};
            if (!isP && fr >= 14) { const float* fs = fstate + ((size_t)(l * 32 + (blk - 512)) * 2 + (fr - 14)) * DFF2 + hcol;
#pragma unroll
                for (int sd = 0; sd < 2; ++sd)
#pragma unroll
                    for (int hf = 0; hf < 2; ++hf) Xp[sd][hf] = *(const f32x4*)(fs + sd * DFF + hf * 4); }
#pragma unroll
            for (int m = 0; m < 4; ++m) {
                f32x4 cv[2][2];
#pragma unroll
                for (int sd = 0; sd < 2; ++sd)
#pragma unroll
                    for (int hf = 0; hf < 2; ++hf)
                    { const f32x4 w0 = wl[(sd * 2 + hf) * 4 + 0], w1 = wl[(sd * 2 + hf) * 4 + 1], w2 = wl[(sd * 2 + hf) * 4 + 2], b3 = wl[(sd * 2 + hf) * 4 + 3];
#pragma unroll
                        for (int j = 0; j < 4; ++j) {
                            const float x = acc[ai][sd][m][hf][j], xp = Xp[sd][hf][j];
                            float c = b3[j] + w2[j] * x;
                            c += w1[j] * dppz<0x111>(x); c += w1[j] * dppz<0x10F>(xp); c += w0[j] * dppz<0x112>(x); c += w0[j] * dppz<0x10E>(xp);
                            cv[sd][hf][j] = c;
                        } }
                f32x4 h0, h1;
#pragma unroll
                for (int j = 0; j < 4; ++j) { h0[j] = silu_f(cv[0][0][j]) * cv[1][0][j]; h1[j] = silu_f(cv[0][1][j]) * cv[1][1][j]; }
                const int row = R + m * 16 + fr;
                if (!(m == 0 && fr < 2 && !seqstart)) { u32x4 pk; { const u32x2 a = pack4(h0), c = pack4(h1); pk.x = a.x; pk.y = a.y; pk.z = c.x; pk.w = c.y; }
                    *(u32x4*)(H + (size_t)row * DFF + hcol) = pk; }
                float* sv = nullptr; float* sv2 = nullptr;
                if (isP) { if (m == 0 && fr < 2) sv = halo + ((size_t)blk * 4 + fr) * DFF2 + hcol;
                           if (m == 3 && fr >= 14) { sv = halo + ((size_t)blk * 4 + 2 + (fr - 14)) * DFF2 + hcol; if ((blk & 127) == 127) sv2 = out + O_PF + ((size_t)(l * 4 + (blk >> 7)) * 2 + (fr - 14)) * DFF2 + hcol; } }
                else if (m == 3 && fr >= 14) sv = out + O_SF + ((size_t)(l * 32 + (blk - 512)) * 2 + (fr - 14)) * DFF2 + hcol;
                if (sv) {
#pragma unroll
                    for (int sd = 0; sd < 2; ++sd)
#pragma unroll
                        for (int hf = 0; hf < 2; ++hf) { *(f32x4*)(sv + sd * DFF + hf * 4) = acc[ai][sd][m][hf]; if (sv2) *(f32x4*)(sv2 + sd * DFF + hf * 4) = acc[ai][sd][m][hf]; } }
#pragma unroll
                for (int sd = 0; sd < 2; ++sd)
#pragma unroll
                    for (int hf = 0; hf < 2; ++hf) Xp[sd][hf] = acc[ai][sd][m][hf];
                asm volatile("" ::: "memory");
            }
        }
    }
};

__device__ __forceinline__ void ln_row(const float* src, const bf16_t* srcb, float* x32, bf16_t* xb, const float* g, const float* b, int lane) {
    f32x4 v[4]; float s = 0.f;
#pragma unroll
    for (int i = 0; i < 4; ++i) { v[i] = srcb ? unpack4(*(const u32x2*)(srcb + i * 256 + lane * 4)) : *(const f32x4*)(src + i * 256 + lane * 4); s += (v[i][0] + v[i][1]) + (v[i][2] + v[i][3]); }
#pragma unroll
    for (int o = 32; o >= 1; o >>= 1) s += __shfl_xor(s, o);
    const float mu = s * (1.0f / 1024.0f); float q = 0.f;
#pragma unroll
    for (int i = 0; i < 4; ++i) { const f32x4 d = v[i] - mu; q += (d[0] * d[0] + d[1] * d[1]) + (d[2] * d[2] + d[3] * d[3]); }
#pragma unroll
    for (int o = 32; o >= 1; o >>= 1) q += __shfl_xor(q, o);
    const float rstd = 1.0f / sqrtf(q * (1.0f / 1024.0f) + LN_EPS);
#pragma unroll
    for (int i = 0; i < 4; ++i) {
        const f32x4 gg = *(const f32x4*)(g + i * 256 + lane * 4), bb = *(const f32x4*)(b + i * 256 + lane * 4);
        const f32x4 o = (v[i] - mu) * rstd * gg + bb;
        if (x32) *(f32x4*)(x32 + i * 256 + lane * 4) = o;
        if (xb) *(u32x2*)(xb + i * 256 + lane * 4) = pack4(o);
    }
}

__device__ __forceinline__ void tr_tile(LAS float* tile, const float* src, int Nsrc, bf16_t* dst, int K, int n0, int k0, int mode, int tid) {
    const int nn = tid & 63, np = n0 + nn; int sc;
    if (mode == 0) sc = np < C_U ? np : (np < C_DT ? np + 6 : (np < C_DT + 6 ? np - 512 : -1));
    else if (mode == 1) sc = np;
    else { const int pn = np >> 8, jj = np & 255; sc = jj < 128 ? pn * 128 + jj : DFF + pn * 128 + (jj - 128); }
#pragma unroll
    for (int i = 0; i < 8; ++i) { const int kk = (tid >> 6) + 8 * i; tile[kk * 65 + nn] = sc >= 0 ? src[(size_t)(k0 + kk) * Nsrc + sc] : 0.f; }
    __syncthreads();
    const int kk2 = (tid & 31) * 2;
#pragma unroll
    for (int i = 0; i < 4; ++i) { const int nn2 = (tid >> 5) + 16 * i; *(unsigned*)(dst + (size_t)(n0 + nn2) * K + k0 + kk2) = cvt_pk_bf16(tile[kk2 * 65 + nn2], tile[(kk2 + 1) * 65 + nn2]); }
    __syncthreads();
}

__device__ __forceinline__ void phase_prep(KP& p, LAS unsigned char* lds) {
    int tid_ = threadIdx.x; asm volatile("" : "+v"(tid_));
    const int tid = tid_, wid = tid >> 6, lane = tid & 63;
    for (int row = blockIdx.x * 8 + wid; row < T_ALL; row += gridDim.x * 8) {
        const float* src = row < T_P ? p.in[0] + (size_t)row * DM : p.in[1] + (size_t)(row - T_P) * DM;
        ln_row(src, nullptr, nullptr, (bf16_t*)(p.ws + W_XB) + (size_t)row * DM, p.in[7], p.in[8], lane);
    }
    constexpr int T_IN = 48 * 16, T_OUT = 16 * 16, T_UPT = 88 * 16, T_DNT = 16 * 44, T_L = T_IN + T_OUT + T_UPT + T_DNT;
    for (int it = blockIdx.x; it < 4 * T_L; it += gridDim.x) {
        const int l = it / T_L; int r = it % T_L;
        if (r < T_IN) tr_tile((LAS float*)lds, p.in[9] + (size_t)l * DM * 2950, 2950, (bf16_t*)(p.ws + W_IN + l * W_IN_L), DM, (r >> 4) * 64, (r & 15) * 64, 0, tid);
        else if ((r -= T_IN) < T_OUT) tr_tile((LAS float*)lds, p.in[19] + (size_t)l * DM * DM, DM, (bf16_t*)(p.ws + W_OUT + l * W_OUT_L), DM, (r >> 4) * 64, (r & 15) * 64, 1, tid);
        else if ((r -= T_OUT) < T_UPT) tr_tile((LAS float*)lds, p.in[22] + (size_t)l * DM * DFF2, DFF2, (bf16_t*)(p.ws + W_UP + l * W_UP_L), DM, (r >> 4) * 64, (r & 15) * 64, 2, tid);
        else { r -= T_UPT; tr_tile((LAS float*)lds, p.in[25] + (size_t)l * DFF * DM, DM, (bf16_t*)(p.ws + W_DN + l * W_DN_L), DFF, (r / 44) * 64, (r % 44) * 64, 1, tid); }
    }
    for (int i = blockIdx.x * 512 + tid; i < 4 * 4 * 128 * 128; i += gridDim.x * 512) {
        const int jj = i & 127, ii = (i >> 7) & 127;
        ((bf16_t*)(p.ws + W_GW))[i] = (bf16_t)(cvt_pk_bf16(jj <= ii ? p.in[16][i] : 0.f, 0.f) & 0xffffu);
    }
}

__device__ __forceinline__ void phase_ln(KP& p, const bf16_t* rsrc, const float* g, const float* b, bool final_out) {
    int tid_ = threadIdx.x; asm volatile("" : "+v"(tid_));
    const int wid = tid_ >> 6, lane = tid_ & 63;
    for (int row = blockIdx.x * 8 + wid; row < T_ALL; row += gridDim.x * 8)
        ln_row(nullptr, rsrc + (size_t)row * DM, final_out ? p.out + (size_t)row * DM : nullptr, final_out ? nullptr : (bf16_t*)(p.ws + W_XB) + (size_t)row * DM, g, b, lane);
}

__device__ __forceinline__ void dt_scan(KP& p, int l, int u, int g, int wid, int lane, float& dt, float& ac, float& last) {
    const int h = g * 3 + wid;
    dt = ((const float*)(p.ws + W_DTB))[(size_t)(u * 64 + lane) * 8 + h];
    const float a = -__expf(p.in[14][l * 6 + h]);
    float v = dt * a;
#pragma unroll
    for (int o = 1; o < 64; o <<= 1) { const float t = __shfl_up(v, o); if (lane >= o) v += t; }
    ac = v; last = __shfl(v, 63);
}

__device__ __forceinline__ f32x4 xbc_row(KP& p, int l, int u, int s, int ch) {
    const bf16_t* proj = (const bf16_t*)(p.ws + W_PROJ);
    const bool isP = u < 512; const bool hasprev = isP && (u & 127) != 0;
    if (s >= 0 || hasprev) return unpack4(*(const u32x2*)(proj + (size_t)(u * 64 + s) * NPROJ + C_XBC + ch));
    if (!isP) return *(const f32x4*)(p.in[5] + (unsigned)(((l * 32 + (u - 512)) * 3 + (3 + s)) * 896 + ch));
    return (f32x4){0.f, 0.f, 0.f, 0.f};
}
__device__ __forceinline__ void ssd_states(KP& p, LAS unsigned char* lds, int l, int u) {
    int tid_ = threadIdx.x; asm volatile("" : "+v"(tid_));
    const int tid = tid_, wid = tid >> 6, lane = tid & 63, fr = lane & 15, fq = lane >> 4;
    LAS bf16_t* xT = (LAS bf16_t*)lds;
    LAS bf16_t* BT = (LAS bf16_t*)(lds + 55296);
    LAS float* wgt = (LAS float*)(lds + 92160);
    bf16_t* XC = (bf16_t*)p.out;
    __syncthreads();
    if (wid < 6) {
        float dt, ac, last; dt_scan(p, l, u, wid / 3, wid % 3, lane, dt, ac, last);
        wgt[wid * 64 + lane] = dt * __expf(last - ac);
        if (lane == 0) ((float*)(p.ws + W_CD))[u * 8 + wid] = __expf(last);
    }
    __syncthreads();
    if (tid < 448) {
        const int cgp = tid % 224, seg = tid / 224, ch = cgp * 4, r0 = seg * 32;
        const float* cw = p.in[11] + (size_t)l * 4 * 896 + ch;
        const f32x4 w0 = *(const f32x4*)cw, w1 = *(const f32x4*)(cw + 896), w2 = *(const f32x4*)(cw + 2 * 896), w3 = *(const f32x4*)(cw + 3 * 896);
        const f32x4 bs = *(const f32x4*)(p.in[12] + (size_t)l * 896 + ch);
        f32x4 xm3 = xbc_row(p, l, u, r0 - 3, ch), xm2 = xbc_row(p, l, u, r0 - 2, ch), xm1 = xbc_row(p, l, u, r0 - 1, ch);
        const bf16_t* src = (const bf16_t*)(p.ws + W_PROJ) + (size_t)(u * 64) * NPROJ + C_XBC + ch;
        bf16_t* dst = XC + (size_t)(u * 64) * 896 + ch;
        const int hh = ch >> 6;
#pragma unroll 2
        for (int i = r0; i < r0 + 32; i += 2) {
            const f32x4 xa = unpack4(*(const u32x2*)(src + (size_t)i * NPROJ)), xb = unpack4(*(const u32x2*)(src + (size_t)(i + 1) * NPROJ));
            f32x4 ya = bs + w0 * xm3 + w1 * xm2 + w2 * xm1 + w3 * xa, yb = bs + w0 * xm2 + w1 * xm1 + w2 * xa + w3 * xb;
#pragma unroll
            for (int e = 0; e < 4; ++e) { ya[e] = silu_f(ya[e]); yb[e] = silu_f(yb[e]); }
            xm3 = xm1; xm2 = xa; xm1 = xb;
            *(u32x2*)(dst + (size_t)i * 896) = pack4(ya); *(u32x2*)(dst + (size_t)(i + 1) * 896) = pack4(yb);
            if (ch < 384) { const float wa = wgt[hh * 64 + i], wb = wgt[hh * 64 + i + 1];
#pragma unroll
                for (int e = 0; e < 4; ++e) *(LAS unsigned*)(xT + (ch + e) * 72 + i) = cvt_pk_bf16(ya[e] * wa, yb[e] * wb); }
            else if (ch < 640) {
#pragma unroll
                for (int e = 0; e < 4; ++e) *(LAS unsigned*)(BT + (ch - 384 + e) * 72 + i) = cvt_pk_bf16(ya[e], yb[e]); }
        }
    }
    __syncthreads();
    bf16_t* ST = (bf16_t*)(p.ws + W_ST);
#pragma unroll 2
    for (int k = 0; k < 24; ++k) {
        const int tt = wid * 24 + k, h = tt >> 5, pt = (tt & 31) >> 3, nt = tt & 7, g = h / 3;
        f32x4 acc = (f32x4){0.f, 0.f, 0.f, 0.f};
#pragma unroll
        for (int ks = 0; ks < 2; ++ks) {
            const bf16x8 rf = ldsfrag((LAS const unsigned char*)(xT + (h * 64 + pt * 16 + fr) * 72 + ks * 32 + fq * 8));
            const bf16x8 cf = ldsfrag((LAS const unsigned char*)(BT + (g * 128 + nt * 16 + fr) * 72 + ks * 32 + fq * 8));
            acc = MFMA16(cf, rf, acc);
        }
        *(u32x2*)(ST + ((size_t)(u * 6 + h) * 64 + pt * 16 + fr) * 128 + nt * 16 + fq * 4) = pack4(acc);
    }
}

__device__ __forceinline__ void gmlp_unit(KP& p, LAS unsigned char* lds, int l, int u) {
    int tid_ = threadIdx.x; asm volatile("" : "+v"(tid_));
    const int tid = tid_, wid = tid >> 6, lane = tid & 63, fr = lane & 15, fq = lane >> 4;
    LAS bf16_t* vT = (LAS bf16_t*)lds;
    LAS float* ssq = (LAS float*)(lds + 69632);
    const bf16_t* proj = (const bf16_t*)(p.ws + W_PROJ);
    const int half = u < 512 ? (u & 1) : 0, KJ = (half + 1) * 64, R0 = u * 64, Rb = R0 - half * 64;
    __syncthreads();
    for (int idx = tid; idx < KJ * 32; idx += 512) {
        const int j = idx & (KJ - 1), cgp = idx / KJ;
        const u32x4 w = *(const u32x4*)(proj + (size_t)(Rb + j) * NPROJ + C_VC + cgp * 8);
        const unsigned ww[4] = {w.x, w.y, w.z, w.w};
#pragma unroll
        for (int e = 0; e < 4; ++e) { vT[(cgp * 8 + 2 * e) * 136 + j] = (bf16_t)(ww[e] & 0xffffu); vT[(cgp * 8 + 2 * e + 1) * 136 + j] = (bf16_t)(ww[e] >> 16); }
    }
    __syncthreads();
    const int rt = wid & 3, cbase = (wid >> 2) * 8;
    const bf16_t* GW = (const bf16_t*)(p.ws + W_GW + l * W_GW_L);
    f32x4 acc[8];
#pragma unroll
    for (int gi = 0; gi < 2; ++gi) {
        const int gg = (cbase >> 2) + gi;
        bf16x8 rf[4];
#pragma unroll
        for (int ks = 0; ks < 4; ++ks) rf[ks] = glbfrag(GW + ((size_t)gg * 128 + half * 64 + rt * 16 + fr) * 128 + ks * 32 + fq * 8);
#pragma unroll
        for (int c4 = 0; c4 < 4; ++c4) {
            const int ct = cbase + gi * 4 + c4;
            f32x4 a = (f32x4){0.f, 0.f, 0.f, 0.f};
#pragma unroll
            for (int ks = 0; ks < 4; ++ks) if (ks * 32 < KJ) a = MFMA16(ldsfrag((LAS const unsigned char*)(vT + (ct * 16 + fr) * 136 + ks * 32 + fq * 8)), rf[ks], a);
            acc[gi * 4 + c4] = a;
        }
    }
    const int row = R0 + rt * 16 + fr; float sq = 0.f;
#pragma unroll
    for (int k = 0; k < 8; ++k) {
        const int col = (cbase + k) * 16 + fq * 4, gg = col >> 6;
        const float bsv = p.in[17][(size_t)(l * 4 + gg) * 128 + half * 64 + rt * 16 + fr];
        const f32x4 uv = unpack4(*(const u32x2*)(proj + (size_t)row * NPROJ + C_U + col));
        f32x4 o = uv * (acc[k] + bsv); acc[k] = o;
        sq += (o[0] * o[0] + o[1] * o[1]) + (o[2] * o[2] + o[3] * o[3]);
    }
    sq += __shfl_xor(sq, 16); sq += __shfl_xor(sq, 32);
    if (fq == 0) ssq[(wid >> 2) * 64 + rt * 16 + fr] = sq;
    __syncthreads();
    const float rstd = 1.0f / sqrtf((ssq[rt * 16 + fr] + ssq[64 + rt * 16 + fr]) * (1.0f / 256.0f) + RMS_EPS);
    bf16_t* mix = (bf16_t*)(p.ws + W_MIX);
#pragma unroll
    for (int k = 0; k < 8; ++k) {
        const int col = (cbase + k) * 16 + fq * 4;
        const f32x4 gv = *(const f32x4*)(p.in[18] + (size_t)l * 1024 + 768 + col);
        *(u32x2*)(mix + (size_t)row * DM + 768 + col) = pack4(acc[k] * rstd * gv);
    }
}

__device__ __forceinline__ void scan_prompt(KP& p, int l, int item) {
    int tid_ = threadIdx.x; asm volatile("" : "+v"(tid_));
    const int gid = item * 512 + tid_, e = (gid & 2047) * 4, bh = gid >> 11, b = bh / 6, h = bh % 6;
    bf16_t* ST = (bf16_t*)(p.ws + W_ST); const float* CD = (const float*)(p.ws + W_CD);
    f32x4 st = (f32x4){0.f, 0.f, 0.f, 0.f};
#pragma unroll 1
    for (int c0 = 0; c0 < 128; c0 += 16) {
        u32x2 s[16]; float cd[16];
#pragma unroll
        for (int k = 0; k < 16; ++k) { const int u = b * 128 + c0 + k; s[k] = *(const u32x2*)(ST + ((size_t)(u * 6 + h)) * 8192 + e); cd[k] = CD[u * 8 + h]; }
#pragma unroll
        for (int k = 0; k < 16; ++k) { const int u = b * 128 + c0 + k; *(u32x2*)(ST + ((size_t)(u * 6 + h)) * 8192 + e) = pack4(st); st = st * cd[k] + unpack4(s[k]); }
    }
    *(f32x4*)(p.out + O_PH + ((size_t)(l * 4 + b) * 6 + h) * 8192 + e) = st;
}
__device__ __forceinline__ void scan_sample(KP& p, int l, int item) {
    int tid_ = threadIdx.x; asm volatile("" : "+v"(tid_));
    const int gid = item * 512 + tid_, e = (gid & 2047) * 4, sbh = gid >> 11, sb = sbh / 6, h = sbh % 6;
    bf16_t* ST = (bf16_t*)(p.ws + W_ST); const float* CD = (const float*)(p.ws + W_CD);
    const int u = 512 + sb;
    const f32x4 st = *(const f32x4*)(p.in[4] + ((size_t)(l * 32 + sb) * 6 + h) * 8192 + e);
    const f32x4 s = unpack4(*(const u32x2*)(ST + ((size_t)(u * 6 + h)) * 8192 + e));
    *(u32x2*)(ST + ((size_t)(u * 6 + h)) * 8192 + e) = pack4(st);
    *(f32x4*)(p.out + O_SH + ((size_t)(l * 32 + sb) * 6 + h) * 8192 + e) = st * CD[u * 8 + h] + s;
}

__device__ __forceinline__ void attn_unit(KP& p, LAS unsigned char* lds, int l, int u) {
    int tid_ = threadIdx.x; asm volatile("" : "+v"(tid_));
    const int tid = tid_, wid = tid >> 6, lane = tid & 63, fr = lane & 15, fq = lane >> 4;
    LAS bf16_t* VT = (LAS bf16_t*)(lds + 98304);
    LAS float* bias = (LAS float*)(lds + 153600);
    LAS float* ssq = (LAS float*)(lds + 158208);
    const bf16_t* proj = (const bf16_t*)(p.ws + W_PROJ);
    const bool isP = u < 512; const int R0 = u * 64, c = u & 127, b = u >> 7, sb = u - 512;
    const int qt = wid & 3, hbase = (wid >> 2) * 3;
    __syncthreads();
    for (int i = tid; i < 1152; i += 512) bias[i] = p.in[10][(size_t)l * 1152 + i];
    bf16x8 qf[3][2];
#pragma unroll
    for (int hh = 0; hh < 3; ++hh)
#pragma unroll
        for (int ks = 0; ks < 2; ++ks) qf[hh][ks] = glbfrag(proj + (size_t)(R0 + qt * 16 + fr) * NPROJ + (hbase + hh) * 64 + ks * 32 + fq * 8);
    float mrun[3], lrun[3]; f32x4 O[3][4];
#pragma unroll
    for (int hh = 0; hh < 3; ++hh) { mrun[hh] = -1e30f; lrun[hh] = 0.f;
#pragma unroll
        for (int d = 0; d < 4; ++d) O[hh][d] = (f32x4){0.f, 0.f, 0.f, 0.f}; }
    const int blk_lo = isP ? (c < 8 ? 8 - c : 0) : 0;
    u32x4 vr[6];
    const int vkp = tid & 31, vcg0 = tid >> 5;
#define ATT_LOADP(blkv, bufv) do { const size_t rb_ = isP ? (size_t)b * 8192 + (size_t)(c - 8 + (blkv)) * 64 : (size_t)T_P + (size_t)sb * 64; \
        _Pragma("unroll") for (int it = 0; it < 6; ++it) { const int pu_ = it * 512 + tid, row_ = pu_ / 48, un_ = (pu_ % 48) ^ (row_ & 15); \
            __builtin_amdgcn_global_load_lds((const unsigned*)(proj + (rb_ + row_) * NPROJ + C_K + un_ * 8), (LAS unsigned*)(lds + (bufv) * 49152 + (it * 512 + wid * 64) * 16), 16, 0, 0); } \
        _Pragma("unroll") for (int it = 0; it < 2; ++it) { const int cg_ = vcg0 + it * 16; \
            vr[2 * it] = *(const u32x4*)(proj + (rb_ + 2 * vkp) * NPROJ + C_V + cg_ * 8); vr[2 * it + 1] = *(const u32x4*)(proj + (rb_ + 2 * vkp + 1) * NPROJ + C_V + cg_ * 8); } } while (0)
    bool have = false; int cur = 0;
    if (isP || blk_lo == 8) { ATT_LOADP(blk_lo, 0); have = true; }
#pragma unroll 1
    for (int blk = blk_lo; blk <= 8; ++blk) {
        LAS unsigned char* Kc = lds + cur * 49152;
        __syncthreads();
        if (!have) {
#pragma unroll
            for (int it = 0; it < 6; ++it) { const int idx = it * 512 + tid, row_ = idx / 48, un_ = idx % 48;
                const float* s = p.in[2] + ((size_t)(l * 32 + sb) * 512 + blk * 64 + row_) * 384 + un_ * 8; const f32x4 a = *(const f32x4*)s, bq = *(const f32x4*)(s + 4);
                u32x4 w; w.x = cvt_pk_bf16(a[0], a[1]); w.y = cvt_pk_bf16(a[2], a[3]); w.z = cvt_pk_bf16(bq[0], bq[1]); w.w = cvt_pk_bf16(bq[2], bq[3]);
                *(LAS u32x4*)(Kc + row_ * 768 + ((un_ ^ (row_ & 15)) * 16)) = w; }
#pragma unroll
            for (int it = 0; it < 6; ++it) { const int cg_ = vcg0 + (it >> 1) * 16;
                const float* s = p.in[3] + ((size_t)(l * 32 + sb) * 512 + blk * 64 + 2 * vkp + (it & 1)) * 384 + cg_ * 8; const f32x4 a = *(const f32x4*)s, bq = *(const f32x4*)(s + 4);
                vr[it].x = cvt_pk_bf16(a[0], a[1]); vr[it].y = cvt_pk_bf16(a[2], a[3]); vr[it].z = cvt_pk_bf16(bq[0], bq[1]); vr[it].w = cvt_pk_bf16(bq[2], bq[3]); }
        }
        if (have) { const size_t rb_ = isP ? (size_t)b * 8192 + (size_t)(c - 8 + blk) * 64 : (size_t)T_P + (size_t)sb * 64; const int cg_ = vcg0 + 2 * 16;
            vr[4] = *(const u32x4*)(proj + (rb_ + 2 * vkp) * NPROJ + C_V + cg_ * 8); vr[5] = *(const u32x4*)(proj + (rb_ + 2 * vkp + 1) * NPROJ + C_V + cg_ * 8); }
#pragma unroll
        for (int it = 0; it < 3; ++it) { const int cg_ = vcg0 + it * 16; const u32x4 w0 = vr[2 * it], w1 = vr[2 * it + 1];
            const unsigned a0[4] = {w0.x, w0.y, w0.z, w0.w}, a1[4] = {w1.x, w1.y, w1.z, w1.w};
#pragma unroll
            for (int e = 0; e < 4; ++e) {
                *(LAS unsigned*)(VT + (cg_ * 8 + 2 * e) * 72 + 2 * vkp) = (a0[e] & 0xffffu) | (a1[e] << 16);
                *(LAS unsigned*)(VT + (cg_ * 8 + 2 * e + 1) * 72 + 2 * vkp) = (a0[e] >> 16) | (a1[e] & 0xffff0000u); } }
        asm volatile("s_waitcnt vmcnt(0)" ::: "memory");
        __syncthreads();
        have = false;
        if (blk < 8 && (isP || blk == 7)) { ATT_LOADP(blk + 1, cur ^ 1); have = true; }
#pragma unroll
        for (int hh = 0; hh < 3; ++hh) {
            const int h = hbase + hh;
            f32x4 s[4]; float mx = -1e30f;
#pragma unroll
            for (int kt = 0; kt < 4; ++kt) {
                f32x4 a = (f32x4){0.f, 0.f, 0.f, 0.f};
#pragma unroll
                for (int ks = 0; ks < 2; ++ks) a = MFMA16(ldsfrag((LAS const unsigned char*)(Kc + (kt * 16 + fr) * 768 + (((h * 8 + ks * 4 + fq) ^ fr) * 16))), qf[hh][ks], a);
                if (blk <= 5) { const float bc = bias[h * 192 + 191];
#pragma unroll
                    for (int j = 0; j < 4; ++j) { a[j] = a[j] * 0.125f + bc; mx = fmaxf(mx, a[j]); } }
                else {
#pragma unroll
                    for (int j = 0; j < 4; ++j) {
                        int rel = (qt * 16 + fr) + 512 - (blk * 64 + kt * 16 + fq * 4 + j); rel = rel > 128 ? 128 : rel;
                        a[j] = a[j] * 0.125f + bias[h * 192 + rel + 63]; mx = fmaxf(mx, a[j]);
                    } }
                s[kt] = a;
            }
            mx = fmaxf(mx, __shfl_xor(mx, 16)); mx = fmaxf(mx, __shfl_xor(mx, 32));
            const float mnew = fmaxf(mrun[hh], mx), fac = __expf(mrun[hh] - mnew); mrun[hh] = mnew;
            float rs = 0.f;
#pragma unroll
            for (int kt = 0; kt < 4; ++kt)
#pragma unroll
                for (int j = 0; j < 4; ++j) { s[kt][j] = __expf(s[kt][j] - mnew); rs += s[kt][j]; }
            lrun[hh] = lrun[hh] * fac + rs;
#pragma unroll
            for (int d = 0; d < 4; ++d) O[hh][d] *= fac;
#pragma unroll
            for (int ks = 0; ks < 2; ++ks) {
                const u32x2 pa = pack4(s[2 * ks]), pb = pack4(s[2 * ks + 1]);
                const bf16x8 pf = __builtin_bit_cast(bf16x8, (u32x4){pa.x, pa.y, pb.x, pb.y});
#pragma unroll
                for (int d = 0; d < 4; ++d) {
                    const LAS bf16_t* vrow = VT + (h * 64 + d * 16 + fr) * 72 + ks * 32 + fq * 4;
                    const u32x2 va = *(const LAS u32x2*)vrow, vb = *(const LAS u32x2*)(vrow + 16);
                    O[hh][d] = MFMA16(__builtin_bit_cast(bf16x8, (u32x4){va.x, va.y, vb.x, vb.y}), pf, O[hh][d]);
                }
            }
        }
        cur ^= 1;
    }
#pragma unroll
    for (int hh = 0; hh < 3; ++hh) { lrun[hh] += __shfl_xor(lrun[hh], 16); lrun[hh] += __shfl_xor(lrun[hh], 32); }
    float sq = 0.f;
#pragma unroll
    for (int hh = 0; hh < 3; ++hh) { const float inv = 1.0f / lrun[hh];
#pragma unroll
        for (int d = 0; d < 4; ++d) { O[hh][d] *= inv; const f32x4 o = O[hh][d]; sq += (o[0] * o[0] + o[1] * o[1]) + (o[2] * o[2] + o[3] * o[3]); } }
    sq += __shfl_xor(sq, 16); sq += __shfl_xor(sq, 32);
    if (fq == 0) ssq[(wid >> 2) * 64 + qt * 16 + fr] = sq;
    __syncthreads();
    const float rstd = 1.0f / sqrtf((ssq[qt * 16 + fr] + ssq[64 + qt * 16 + fr]) * (1.0f / 384.0f) + RMS_EPS);
    bf16_t* mix = (bf16_t*)(p.ws + W_MIX);
#pragma unroll
    for (int hh = 0; hh < 3; ++hh)
#pragma unroll
        for (int d = 0; d < 4; ++d) {
            const int col = (hbase + hh) * 64 + d * 16 + fq * 4;
            const f32x4 gv = *(const f32x4*)(p.in[18] + (size_t)l * 1024 + col);
            *(u32x2*)(mix + (size_t)(R0 + qt * 16 + fr) * DM + col) = pack4(O[hh][d] * rstd * gv);
        }
}

__device__ __forceinline__ void ssd_y(KP& p, LAS unsigned char* lds, int l, int u) {
    int tid_ = threadIdx.x; asm volatile("" : "+v"(tid_));
    const int tid = tid_, wid = tid >> 6, lane = tid & 63, fr = lane & 15, fq = lane >> 4;
    LAS bf16_t* Cn = (LAS bf16_t*)lds;
    LAS bf16_t* Bn = (LAS bf16_t*)(lds + 17408);
    LAS bf16_t* xT = (LAS bf16_t*)(lds + 34816);
    LAS bf16_t* Mm = (LAS bf16_t*)(lds + 62464);
    LAS float* dtl = (LAS float*)(lds + 90112);
    LAS float* acl = (LAS float*)(lds + 90880);
    LAS float* ssq = (LAS float*)(lds + 91648);
    const bf16_t* proj = (const bf16_t*)(p.ws + W_PROJ);
    const bf16_t* HP = (const bf16_t*)(p.ws + W_ST);
    const bf16_t* XC = (const bf16_t*)p.out + (size_t)(u * 64) * 896;
    const int R0 = u * 64, lt = wid & 3;
    f32x4 yacc[2][6];
#pragma unroll
    for (int g = 0; g < 2; ++g) {
        __syncthreads();
        if (wid < 3) { float dt, ac, last; dt_scan(p, l, u, g, wid, lane, dt, ac, last); dtl[wid * 64 + lane] = dt; acl[wid * 64 + lane] = ac; }
#pragma unroll
        for (int it = 0; it < 4; ++it) {
            const int idx = it * 512 + tid, mat = idx >> 10, i = (idx >> 4) & 63, c8 = idx & 15;
            const u32x4 w = *(const u32x4*)(XC + (size_t)i * 896 + 384 + mat * 256 + g * 128 + c8 * 8);
            *(LAS u32x4*)((mat ? Cn : Bn) + i * 136 + c8 * 8) = w;
        }
#pragma unroll
        for (int it = 0; it < 3; ++it) {
            const int idx = it * 512 + tid, c4 = idx % 48, i = (idx / 48) * 2;
            const u32x2 wa = *(const u32x2*)(XC + (size_t)i * 896 + g * 192 + c4 * 4), wb = *(const u32x2*)(XC + (size_t)(i + 1) * 896 + g * 192 + c4 * 4);
            *(LAS unsigned*)(xT + (c4 * 4 + 0) * 72 + i) = (wa.x & 0xffffu) | (wb.x << 16);
            *(LAS unsigned*)(xT + (c4 * 4 + 1) * 72 + i) = (wa.x >> 16) | (wb.x & 0xffff0000u);
            *(LAS unsigned*)(xT + (c4 * 4 + 2) * 72 + i) = (wa.y & 0xffffu) | (wb.y << 16);
            *(LAS unsigned*)(xT + (c4 * 4 + 3) * 72 + i) = (wa.y >> 16) | (wb.y & 0xffff0000u);
        }
        __syncthreads();
#pragma unroll
        for (int k = 0; k < 2; ++k) {
            const int st = (wid >> 2) * 2 + k;
            f32x4 a = (f32x4){0.f, 0.f, 0.f, 0.f};
#pragma unroll
            for (int ks = 0; ks < 4; ++ks) a = MFMA16(ldsfrag((LAS const unsigned char*)(Bn + (st * 16 + fr) * 136 + ks * 32 + fq * 8)), ldsfrag((LAS const unsigned char*)(Cn + (lt * 16 + fr) * 136 + ks * 32 + fq * 8)), a);
            const int li = lt * 16 + fr;
#pragma unroll
            for (int hh = 0; hh < 3; ++hh) {
                const float al = acl[hh * 64 + li]; f32x4 mv;
#pragma unroll
                for (int j = 0; j < 4; ++j) { const int si = st * 16 + fq * 4 + j; mv[j] = si <= li ? a[j] * __expf(al - acl[hh * 64 + si]) * dtl[hh * 64 + si] : 0.f; }
                *(LAS u32x2*)(Mm + (hh * 64 + li) * 72 + st * 16 + fq * 4) = pack4(mv);
            }
        }
        __syncthreads();
#pragma unroll
        for (int k = 0; k < 6; ++k) {
            const int ctile = (wid >> 2) * 6 + k, hh = ctile >> 2, pt = ctile & 3, h = g * 3 + hh, li = lt * 16 + fr;
            f32x4 ad = (f32x4){0.f, 0.f, 0.f, 0.f}, ao = (f32x4){0.f, 0.f, 0.f, 0.f};
#pragma unroll
            for (int ks = 0; ks < 2; ++ks) ad = MFMA16(ldsfrag((LAS const unsigned char*)(xT + (hh * 64 + pt * 16 + fr) * 72 + ks * 32 + fq * 8)), ldsfrag((LAS const unsigned char*)(Mm + (hh * 64 + li) * 72 + ks * 32 + fq * 8)), ad);
#pragma unroll
            for (int ks = 0; ks < 4; ++ks) ao = MFMA16(glbfrag(HP + ((size_t)(u * 6 + h) * 64 + pt * 16 + fr) * 128 + ks * 32 + fq * 8), ldsfrag((LAS const unsigned char*)(Cn + li * 136 + ks * 32 + fq * 8)), ao);
            const float ea = __expf(acl[hh * 64 + li]), dsk = p.in[15][l * 6 + h];
            const f32x4 xv = unpack4(*(const u32x2*)(XC + (size_t)li * 896 + h * 64 + pt * 16 + fq * 4));
            const f32x4 zv = unpack4(*(const u32x2*)(proj + (size_t)(R0 + li) * NPROJ + C_Z + h * 64 + pt * 16 + fq * 4));
            f32x4 y = ad + ao * ea + xv * dsk;
#pragma unroll
            for (int j = 0; j < 4; ++j) y[j] *= silu_f(zv[j]);
            yacc[g][k] = y;
            asm volatile("" ::: "memory");
        }
    }
    float sq = 0.f;
#pragma unroll
    for (int g = 0; g < 2; ++g)
#pragma unroll
        for (int k = 0; k < 6; ++k) { const f32x4 o = yacc[g][k]; sq += (o[0] * o[0] + o[1] * o[1]) + (o[2] * o[2] + o[3] * o[3]); }
    sq += __shfl_xor(sq, 16); sq += __shfl_xor(sq, 32);
    if (fq == 0) ssq[(wid >> 2) * 64 + lt * 16 + fr] = sq;
    __syncthreads();
    const float rstd = 1.0f / sqrtf((ssq[lt * 16 + fr] + ssq[64 + lt * 16 + fr]) * (1.0f / 384.0f) + RMS_EPS);
    bf16_t* mix = (bf16_t*)(p.ws + W_MIX);
#pragma unroll
    for (int g = 0; g < 2; ++g)
#pragma unroll
        for (int k = 0; k < 6; ++k) {
            const int col = 384 + g * 192 + ((wid >> 2) * 6 + k) * 16 + fq * 4;
            const f32x4 gv = *(const f32x4*)(p.in[18] + (size_t)l * 1024 + col);
            *(u32x2*)(mix + (size_t)(R0 + lt * 16 + fr) * DM + col) = pack4(yacc[g][k] * rstd * gv);
        }
}

__device__ __forceinline__ void phase_fix(KP& p, int l) {
    const float* halo = (const float*)(p.ws + W_MIX); bf16_t* H = (bf16_t*)(p.ws + W_PROJ);
    const float* w = p.in[23] + (size_t)l * 3 * DFF2; const float* bb = p.in[24] + (size_t)l * DFF2;
    int tid_ = threadIdx.x; asm volatile("" : "+v"(tid_));
    for (int i = blockIdx.x * 512 + tid_; i < 128 * DFF2; i += gridDim.x * 512) {
        const int pm = i / DFF2, cc = i % DFF2;
        if ((pm & 31) == 0 || cc >= DFF) continue;
        const float* h0 = halo + (size_t)(pm - 1) * 4 * DFF2; const float* h1 = halo + (size_t)pm * 4 * DFF2;
        float r[2];
#pragma unroll
        for (int rr = 0; rr < 2; ++rr) {
            float o[2];
#pragma unroll
            for (int gv = 0; gv < 2; ++gv) {
                const int c2 = cc + gv * DFF;
                const float xm2 = h0[2 * DFF2 + c2], xm1 = h0[3 * DFF2 + c2], x0 = h1[c2], x1 = h1[DFF2 + c2];
                o[gv] = rr == 0 ? bb[c2] + w[c2] * xm2 + w[DFF2 + c2] * xm1 + w[2 * DFF2 + c2] * x0 : bb[c2] + w[c2] * xm1 + w[DFF2 + c2] * x0 + w[2 * DFF2 + c2] * x1;
            }
            r[rr] = silu_f(o[0]) * o[1];
        }
        H[((size_t)pm * 256) * DFF + cc] = (bf16_t)(cvt_pk_bf16(r[0], 0.f) & 0xffffu);
        H[((size_t)pm * 256 + 1) * DFF + cc] = (bf16_t)(cvt_pk_bf16(r[1], 0.f) & 0xffffu);
    }
}

#define XB_TMO      128
#define XB_XCNT(j)  (256  + 64 * (j))
#define XB_XSUB(j)  (1280 + 64 * (j))
#define XB_XGEN(j)  (2304 + 64 * (j))
#define XB_TOP      3328
#define XB_TOPGEN   3392
#define XCD_BAR_WORDS 3456
#define XB_SPIN_CAP (1u << 18)

__device__ __forceinline__ unsigned xb_ld(unsigned* p)              { return __hip_atomic_load(p, __ATOMIC_RELAXED, __HIP_MEMORY_SCOPE_AGENT); }
__device__ __forceinline__ unsigned xb_add(unsigned* p, unsigned v) { return __hip_atomic_fetch_add(p, v, __ATOMIC_RELAXED, __HIP_MEMORY_SCOPE_AGENT); }
__device__ __forceinline__ unsigned xb_xcc_id() { return (unsigned)__builtin_amdgcn_s_getreg((3 << 11) | 20) & 0xFu; }
#define XB_SPIN(cond, bar) do { unsigned _sp = 0; while (cond) { __builtin_amdgcn_s_sleep(1); \
    if ((++_sp & 255u) == 0u) { if (xb_ld(&(bar)[XB_TMO])) break; if (_sp > XB_SPIN_CAP) { atomicAdd(&(bar)[XB_TMO], 1u); break; } } } } while (0)

struct XcdBarrier {
    unsigned* bar; unsigned x;
    volatile LAS unsigned* st;
};

__device__ __forceinline__ XcdBarrier xcd_barrier_post(unsigned* bar, volatile LAS unsigned* st) {
    XcdBarrier b; b.bar = bar; b.x = xb_xcc_id(); b.st = st;
    if (threadIdx.x == 0) (void)xb_add(&bar[XB_XCNT(b.x)], 1u);
    return b;
}
__device__ __forceinline__ void xcd_barrier_complete(unsigned* bar, unsigned x, unsigned& nloc, unsigned& nx) {
    const unsigned G = gridDim.x * gridDim.y * gridDim.z;
    unsigned sum, cnt, mine, sp = 0u;
    for (;;) {
        sum = 0u; cnt = 0u; mine = 0u;
#pragma unroll
        for (unsigned j = 0; j < 16; ++j) { const unsigned c = xb_ld(&bar[XB_XCNT(j)]); sum += c; cnt += (c > 0u) ? 1u : 0u; mine = (j == x) ? c : mine; }
        if (sum == G) break;
        __builtin_amdgcn_s_sleep(1);
        if ((++sp & 255u) == 0u) { if (xb_ld(&bar[XB_TMO])) break; if (sp > XB_SPIN_CAP) { atomicAdd(&bar[XB_TMO], 1u); break; } }
    }
    nloc = mine > 0u ? mine : 1u; nx = cnt > 0u ? cnt : 1u;
}

__device__ __forceinline__ void xcd_barrier(const XcdBarrier& b) {
    asm volatile("s_waitcnt vmcnt(0)" ::: "memory");
    __syncthreads();
    if (threadIdx.x == 0) {
        unsigned* bar = b.bar;
        __builtin_amdgcn_s_waitcnt(0);
        unsigned nloc = b.st[0], nx = b.st[1];
        if (nloc == 0u) { xcd_barrier_complete(bar, b.x, nloc, nx); b.st[0] = nloc; b.st[1] = nx; }
        const unsigned old = xb_add(&bar[XB_XSUB(b.x)], 1u);
        const unsigned gen = old / nloc;
        if (old + 1u == (gen + 1u) * nloc) {
            __builtin_amdgcn_fence(__ATOMIC_RELEASE, "agent");
            asm volatile("s_waitcnt vmcnt(0)" ::: "memory");
            const unsigned og = xb_add(&bar[XB_TOP], 1u);
            const unsigned tg = og / nx;
            if (og + 1u == (tg + 1u) * nx) xb_add(&bar[XB_TOPGEN], 1u);
            else XB_SPIN(xb_ld(&bar[XB_TOPGEN]) == tg, bar);
            __builtin_amdgcn_fence(__ATOMIC_ACQUIRE, "agent");
            xb_add(&bar[XB_XGEN(b.x)], 1u);
            asm volatile("s_waitcnt vmcnt(0)" ::: "memory");
        } else {
            XB_SPIN(xb_ld(&bar[XB_XGEN(b.x)]) == gen, bar);
            __builtin_amdgcn_fence(__ATOMIC_ACQUIRE, "agent");
            asm volatile("s_waitcnt vmcnt(0)" ::: "memory");
        }
    }
    __syncthreads();
}

__global__ void __launch_bounds__(512, 2) mega(Params pa) {
    extern __shared__ __attribute__((aligned(16))) unsigned char shm[];
    LAS unsigned char* lds = (LAS unsigned char*)shm;
    const int G = gridDim.x, bid = blockIdx.x;
    KP* pk = (KP*)__builtin_amdgcn_kernarg_segment_ptr();
    volatile LAS unsigned* bst = (volatile LAS unsigned*)(lds + LDS_BYTES - 16);
    XcdBarrier xb; xb.bar = nullptr; xb.x = 0; xb.st = bst;
    if (pa.coop) { if (threadIdx.x < 2) bst[threadIdx.x] = 0u; __syncthreads(); xb = xcd_barrier_post((unsigned*)(pa.ws + W_BAR), bst); }
    for (int ph = pa.ph_lo; ph < pa.ph_hi; ++ph) {
        if (ph > pa.ph_lo && pa.coop) { if (pa.pad == 0x5a5a) { __threadfence(); cg::this_grid().sync(); } else xcd_barrier(xb); }
        asm volatile("" : "+s"(pk)); KP& p = *pk;
        if (ph == 0) { phase_prep(p, lds); continue; }
        if (ph == 42) { int tq = threadIdx.x; asm volatile("" : "+v"(tq)); const unsigned short* w16 = (const unsigned short*)p.ws; for (size_t i = (size_t)bid * 512 + tq; i < (size_t)59418624; i += (size_t)G * 512) p.out[i] = (float)w16[i * 4]; continue; }
        if (ph == 41) { int tq = threadIdx.x; asm volatile("" : "+v"(tq)); for (size_t i = (size_t)bid * 512 + tq; i < (size_t)59418624; i += (size_t)G * 512) { const float v = p.out[i]; if (!(fabsf(v) < 1e30f)) p.out[i] = 0.f; } continue; }
        const int l = (ph - 1) / 10, k = (ph - 1) % 10;
        bf16_t* XB = (bf16_t*)(p.ws + W_XB);
        switch (k) {
        case 0: if (REP_G1 > 1) { pg8::StaticOrder S; S.init(T_ALL, NPROJ, G, bid); EpiNull E{(float*)(p.ws + W_CD)};
                  pg8::gemm_phase(lds, pg8::Gemm{XB, (const bf16_t*)(p.ws + W_IN + l * W_IN_L), T_ALL, NPROJ, DM}, S, E); }
                { pg8::StaticOrder S; S.init(T_ALL, NPROJ, G, bid);
                  EpiIn E{(bf16_t*)(p.ws + W_PROJ), p.out, (float*)(p.ws + W_DTB), p.in[13], l};
                  pg8::gemm_phase(lds, pg8::Gemm{XB, (const bf16_t*)(p.ws + W_IN + l * W_IN_L), T_ALL, NPROJ, DM}, S, E); } break;
        case 1: {
                  unsigned* qctr = (unsigned*)(p.ws + W_BAR + 14336) + l * 64;
                  volatile LAS int* qslot = (volatile LAS int*)(lds + LDS_BYTES - 32);
                  for (;;) {
                      __syncthreads();
                      if (threadIdx.x == 0) qslot[0] = (int)__hip_atomic_fetch_add(qctr, 1u, __ATOMIC_RELAXED, __HIP_MEMORY_SCOPE_AGENT);
                      __syncthreads();
                      const int it = qslot[0];
                      if (it >= 3 * NU64) break;
                      if (it < NU64) attn_unit(p, lds, l, NU64 - 1 - it); else if (it < 2 * NU64) ssd_states(p, lds, l, it - NU64); else gmlp_unit(p, lds, l, it - 2 * NU64);
                  } } break;
        case 2: for (int it = bid; it < 96 + 768; it += G) { if (it < 96) scan_prompt(p, l, it); else scan_sample(p, l, it - 96); } break;
        case 3: for (int rep = 0; rep < REP_M3; ++rep) for (int it = bid; it < NU64; it += G) ssd_y(p, lds, l, it); break;
        case 4: { pg8::StaticOrder S; S.init(T_ALL, DM, G, bid); EpiRes E{p.out, XB, (bf16_t*)p.out};
                  pg8::gemm_phase(lds, pg8::Gemm{(const bf16_t*)(p.ws + W_MIX), (const bf16_t*)(p.ws + W_OUT + l * W_OUT_L), T_ALL, DM, DM}, S, E); } break;
        case 5: phase_ln(p, (const bf16_t*)p.out, p.in[20] + l * DM, p.in[21] + l * DM, false); break;
        case 6: for (int rep = 0; rep < REP_G3; ++rep) { pg8::StaticOrder S; S.init(T_ALL, DFF2, G, bid);
                  EpiUp E{(bf16_t*)(p.ws + W_PROJ), (float*)(p.ws + W_MIX), p.out, p.in[23], p.in[24], p.in[6], l};
                  pg8::OneUnit o1;
                  for (int i = 0; S.next(i, o1.u); ++i) { pg8::gemm_phase(lds, pg8::Gemm{XB, (const bf16_t*)(p.ws + W_UP + l * W_UP_L), T_ALL, DFF2, DM}, o1, E); __syncthreads(); } } break;
        case 7: phase_fix(p, l); break;
        case 8: { pg8::StaticOrder S; S.init(T_ALL, DM, G, bid); EpiRes E{p.out, XB, (bf16_t*)(p.ws + W_MIX)};
                  pg8::gemm_phase(lds, pg8::Gemm{(const bf16_t*)(p.ws + W_PROJ), (const bf16_t*)(p.ws + W_DN + l * W_DN_L), T_ALL, DM, DFF}, S, E); } break;
        case 9: phase_ln(p, (const bf16_t*)(p.ws + W_MIX), p.in[26] + l * DM, p.in[27] + l * DM, l == DEPTH - 1); break;
        }
    }
}

constexpr int N_PHASES = 41;
#ifndef MULTI_LAUNCH
#define MULTI_LAUNCH 0
#endif

extern "C" void kernel_launch(void* const* d_in, const int* in_sizes, int n_in, void* d_out, int out_size, void* d_ws, size_t ws_size, hipStream_t stream) {
    static int grid = 0;
    if (grid == 0) {
        if (n_in != 28 || ws_size < W_END2) { fprintf(stderr, "kernel_launch: need 28 inputs and %zu bytes of workspace (got %d, %zu)\n", (size_t)W_END2, n_in, ws_size); grid = -1; return; }
        int dev = 0, cus = 0, per_cu = 0;
        hipGetDevice(&dev); hipDeviceGetAttribute(&cus, hipDeviceAttributeMultiprocessorCount, dev);
        if (hipFuncSetAttribute((const void*)mega, hipFuncAttributeMaxDynamicSharedMemorySize, LDS_BYTES) != hipSuccess) { fprintf(stderr, "kernel_launch: hipFuncSetAttribute failed\n"); grid = -1; return; }
        hipOccupancyMaxActiveBlocksPerMultiprocessor(&per_cu, (const void*)mega, 512, LDS_BYTES);
        (void)hipGetLastError();
        if (per_cu < 1) per_cu = 1;
        grid = cus * 1;
    }
    if (grid < 0) return;
    Params p{};
    for (int i = 0; i < 28; ++i) p.in[i] = (const float*)d_in[i];
    p.out = (float*)d_out; p.ws = (unsigned char*)d_ws;
#if MULTI_LAUNCH
#ifdef PROBE_CUT
    for (int ph = 0; ph < PROBE_CUT; ++ph) { p.ph_lo = ph; p.ph_hi = ph + 1; p.coop = 0; hipLaunchKernelGGL(mega, dim3(grid), dim3(512), LDS_BYTES, stream, p); }
    p.ph_lo = 42; p.ph_hi = 43; p.coop = 0; hipLaunchKernelGGL(mega, dim3(grid), dim3(512), LDS_BYTES, stream, p);
#else
    for (int ph = 0; ph < N_PHASES; ++ph) { p.ph_lo = ph; p.ph_hi = ph + 1; p.coop = 0; hipLaunchKernelGGL(mega, dim3(grid), dim3(512), LDS_BYTES, stream, p); }
#endif
#else
    p.ph_lo = 0; p.ph_hi = N_PHASES; p.coop = 1;
    if (hipMemsetAsync((char*)d_ws + W_BAR, 0, 16384, stream) != hipSuccess) { fprintf(stderr, "kernel_launch: memset failed\n"); return; }
    void* args[] = {&p};
    hipError_t e = hipLaunchCooperativeKernel((const void*)mega, dim3(grid), dim3(512), args, LDS_BYTES, stream);
    if (e != hipSuccess) fprintf(stderr, "cooperative launch failed: %s (grid %d)\n", hipGetErrorString(e), grid);
#endif
}
```

```cpp
#define REP_G1 1
#define REP_M1 1
#define REP_ATT 1
#define REP_M3 1
#define REP_G3 1
#include <hip/hip_runtime.h>
#include <hip/hip_cooperative_groups.h>
#include <cstdio>
namespace cg = cooperative_groups;

#define LAS __attribute__((address_space(3)))
typedef unsigned short bf16_t;
typedef short bf16x8 __attribute__((ext_vector_type(8)));
typedef float f32x4 __attribute__((ext_vector_type(4)));
typedef float f32x2 __attribute__((ext_vector_type(2)));
typedef unsigned u32x4 __attribute__((ext_vector_type(4)));
typedef unsigned u32x2 __attribute__((ext_vector_type(2)));

constexpr int T_ALL = 34816, T_P = 32768, DM = 1024, NPROJ = 3072, DFF = 2816, DFF2 = 5632, DEPTH = 4;
constexpr int NU64 = 544;
constexpr float ALPHA = 1.6817928305074290f;
constexpr float LN_EPS = 1e-5f, RMS_EPS = 1e-5f;
constexpr int C_K = 384, C_V = 768, C_Z = 1152, C_XBC = 1536, C_U = 2432, C_VC = 2688, C_DT = 2944;
constexpr size_t O_YP = 0, O_YS = 33554432, O_PK = 35651584, O_PV = O_PK + 3145728, O_PH = O_PV + 3145728, O_PC = O_PH + 786432,
                 O_PF = O_PC + 43008, O_SK = O_PF + 180224, O_SV = O_SK + 3145728, O_SH = O_SV + 3145728, O_SC = O_SH + 6291456,
                 O_SG = O_SC + 344064, O_SF = O_SG + 2097152;
constexpr size_t W_IN = 0, W_IN_L = (size_t)NPROJ * DM * 2;
constexpr size_t W_OUT = W_IN + 4 * W_IN_L, W_OUT_L = (size_t)DM * DM * 2;
constexpr size_t W_UP = W_OUT + 4 * W_OUT_L, W_UP_L = (size_t)DFF2 * DM * 2;
constexpr size_t W_DN = W_UP + 4 * W_UP_L, W_DN_L = (size_t)DM * DFF * 2;
constexpr size_t W_GW = W_DN + 4 * W_DN_L, W_GW_L = (size_t)4 * 128 * 128 * 2;
constexpr size_t W_XB = W_GW + 4 * W_GW_L;
constexpr size_t W_PROJ = W_XB + (size_t)T_ALL * DM * 2;
constexpr size_t W_MIX = W_PROJ + (size_t)T_ALL * NPROJ * 2;
constexpr size_t W_ST = W_MIX + (size_t)T_ALL * DM * 2;
constexpr size_t W_CD = W_ST + (size_t)NU64 * 6 * 8192 * 2;
constexpr size_t W_DTB = W_CD + (size_t)NU64 * 8 * 4;
constexpr size_t W_END = W_DTB + (size_t)T_ALL * 8 * 4;
constexpr size_t W_BAR = W_END;
constexpr size_t W_END2 = W_BAR + 16384;
constexpr int LDS_BYTES = 156 * 1024;

struct Params { const float* in[28]; float* out; unsigned char* ws; int ph_lo, ph_hi, coop, pad; };
typedef const __attribute__((address_space(4))) Params KP;

__device__ __forceinline__ float bf2f(unsigned b) { return __uint_as_float(b << 16); }
typedef __bf16 bf16v2 __attribute__((ext_vector_type(2)));
__device__ __forceinline__ unsigned cvt_pk_bf16(float lo, float hi) { const f32x2 v = {lo, hi}; const bf16v2 b = __builtin_convertvector(v, bf16v2); return __builtin_bit_cast(unsigned, b); }
__device__ __forceinline__ u32x2 pack4(f32x4 v) { u32x2 w; w.x = cvt_pk_bf16(v[0], v[1]); w.y = cvt_pk_bf16(v[2], v[3]); return w; }
__device__ __forceinline__ f32x4 unpack4(u32x2 w) { f32x4 v; v[0] = bf2f(w.x & 0xffffu); v[1] = bf2f(w.x >> 16); v[2] = bf2f(w.y & 0xffffu); v[3] = bf2f(w.y >> 16); return v; }
__device__ __forceinline__ float silu_f(float x) { return x * __builtin_amdgcn_rcpf(1.0f + __expf(-x)); }
__device__ __forceinline__ float gelu_tanh(float x) { const float y = 0.7978845608028654f * (x + 0.044715f * x * x * x); const float e = __expf(2.0f * y); return 0.5f * x * (2.0f - 2.0f * __builtin_amdgcn_rcpf(1.0f + e)); }
__device__ __forceinline__ float softplus_f(float x) { const float e = __expf(x); return x > 15.0f ? x : (e < 1e-3f ? e * (1.0f - 0.5f * e + 0.33333333f * e * e) : __logf(1.0f + e)); }
#define MFMA16(colfrag, rowfrag, acc) __builtin_amdgcn_mfma_f32_16x16x32_bf16((colfrag), (rowfrag), (acc), 0, 0, 0)
__device__ __forceinline__ bf16x8 ldsfrag(LAS const unsigned char* p) { return *(LAS const bf16x8*)p; }
__device__ __forceinline__ bf16x8 glbfrag(const bf16_t* p) { return *(const bf16x8*)p; }
#define LDS_WAVE_SYNC() asm volatile("s_waitcnt lgkmcnt(0)" ::: "memory")

namespace pg8 {
constexpr int BM = 256, BK = 64, HALF = 128, HTB = HALF * BK * 2, STAGE_BYTES = 8 * HTB, NXCD = 8, WGM = 8;
__device__ __forceinline__ int lds_byte(int r, int c) { const int st = (r >> 4) * 2 + (c >> 5), rr = r & 15, cc = c & 31, ob = rr * 64 + cc * 2; return st * 1024 + (ob ^ (((ob >> 9) & 1) << 5)); }
__device__ __forceinline__ void stage_rc(int b, int& R, int& C) { const int st = b / 1024, sb = b % 1024, swz = sb ^ (((sb >> 9) & 1) << 5); R = (st >> 1) * 16 + swz / 64; C = (st & 1) * 32 + (swz % 64) / 2; }
__device__ __forceinline__ int perm32(int rho) { const int n = rho >> 4, i = rho & 15; return 8 * (i >> 2) + 4 * n + (i & 3); }
struct Unit { int pm, pn; };
struct Gemm { const bf16_t* A; const bf16_t* Bt; int M, N, K; };
struct StaticOrder {
    int nM, nN, nwg, G, c;
    __device__ __forceinline__ void init(int M, int N, int G_, int c_) { nM = M / BM; nN = N / BM; nwg = nM * nN; G = G_; c = c_; }
    __device__ __forceinline__ bool next(int i, Unit& u) const {
        const long L = (long)i * G + c; if (L >= nwg) return false;
        int wgid = (int)L; { const int q = nwg / NXCD, r = nwg % NXCD, xcd = wgid % NXCD, off = wgid / NXCD; wgid = (xcd < r ? xcd * (q + 1) : r * (q + 1) + (xcd - r) * q) + off; }
        const int nig = WGM * nN, gid = wgid / nig, fm = gid * WGM, gsz = (nM - fm) < WGM ? (nM - fm) : WGM;
        u.pm = fm + ((wgid % nig) % gsz); u.pn = (wgid % nig) / gsz; return true;
    }
    __device__ __forceinline__ void a_ready(const Unit&) const {}
    __device__ __forceinline__ void done(const Unit&) const {}
};
struct OneUnit {
    Unit u;
    __device__ __forceinline__ bool next(int i, Unit& o) const { if (i) return false; o = u; return true; }
    __device__ __forceinline__ void a_ready(const Unit&) const {}
    __device__ __forceinline__ void done(const Unit&) const {}
};

template <class Epi, class Sched>
__device__ __forceinline__ void gemm_phase(LAS unsigned char* lds, const Gemm g, const Sched& S, const Epi& E) {
    int tid_ = threadIdx.x; asm volatile("" : "+v"(tid_));
    const int tid = tid_, wid = __builtin_amdgcn_readfirstlane(tid >> 6), lane = tid & 63, wr = wid >> 2, wc = wid & 3, fr = lane & 15, fq = lane >> 4;
    const int K = g.K, nt = K / BK;
    unsigned voffA[2], voffB[2];
#pragma unroll
    for (int i = 0; i < 2; ++i) { int R, C; stage_rc(tid * 16 + i * 8192, R, C); const int Rb = (R & ~31) + perm32(R & 31); voffA[i] = (unsigned)(R * K + C) * 2u; voffB[i] = (unsigned)(Rb * K + C) * 2u; }
    const size_t kstep = (size_t)(BK * 2);
    const size_t hstep = (size_t)HALF * K * 2;
    const size_t tstep = 2 * hstep;
    const unsigned ldsw = (unsigned)wid * 1024u;
    const int aoff = lds_byte(wr * 64 + fr, fq * 8), boff = lds_byte(wc * 32 + fr, fq * 8);
#define PG8_SA(b, h) (((b) * 2 + (h)) * HTB)
#define PG8_SB(b, h) ((4 + (b) * 2 + (h)) * HTB)
#define PG8_STAGE(bufoff, gbase, voff) do { _Pragma("unroll") for (int _i = 0; _i < 2; ++_i) \
        __builtin_amdgcn_global_load_lds((const unsigned*)((const char*)(gbase) + (voff)[_i]), (LAS unsigned*)(lds + (bufoff) + ldsw + _i * 8192), 16, 0, 0); } while (0)
#define PG8_LDA(dst, b, h) do { _Pragma("unroll") for (int m = 0; m < 4; ++m) _Pragma("unroll") for (int k = 0; k < 2; ++k) dst[m][k] = *(const LAS bf16x8*)(lds + PG8_SA(b, h) + aoff + m * 2048 + k * 1024); } while (0)
#define PG8_LDB(dst, b, h) do { _Pragma("unroll") for (int n = 0; n < 2; ++n) _Pragma("unroll") for (int k = 0; k < 2; ++k) dst[n][k] = *(const LAS bf16x8*)(lds + PG8_SB(b, h) + boff + n * 2048 + k * 1024); } while (0)
#define PG8_MMA(ai, bj, At, Bt) do { __builtin_amdgcn_s_setprio(1); _Pragma("unroll") for (int m = 0; m < 4; ++m) _Pragma("unroll") for (int n = 0; n < 2; ++n) _Pragma("unroll") for (int k = 0; k < 2; ++k) \
        acc[ai][bj][m][n] = __builtin_amdgcn_mfma_f32_16x16x32_bf16(Bt[n][k], At[m][k], acc[ai][bj][m][n], 0, 0, 0); __builtin_amdgcn_s_setprio(0); } while (0)
#define PG8_WAIT_V(n) asm volatile("s_waitcnt vmcnt(" #n ")" ::: "memory")
#define PG8_WAIT_L(n) asm volatile("s_waitcnt lgkmcnt(" #n ")" ::: "memory")
#define PG8_BAR __builtin_amdgcn_s_barrier()
#define PG8_SCHED __builtin_amdgcn_sched_barrier(0)
    Unit cur, nxt; int ui = 0;
    if (!S.next(0, cur)) return;
    f32x4 acc[2][2][4][2];
#pragma unroll
    for (int a = 0; a < 2; ++a)
#pragma unroll
        for (int b = 0; b < 2; ++b)
#pragma unroll
            for (int m = 0; m < 4; ++m)
#pragma unroll
                for (int n = 0; n < 2; ++n) acc[a][b][m][n] = (f32x4){0.f, 0.f, 0.f, 0.f};
    bf16x8 At[4][2], B0[2][2], B1[2][2];
    const char* cA = (const char*)g.A + (size_t)cur.pm * tstep; const char* cB = (const char*)g.Bt + (size_t)cur.pn * tstep;
    S.a_ready(cur);
    PG8_STAGE(PG8_SB(0, 0), cB, voffB); PG8_STAGE(PG8_SA(0, 0), cA, voffA); PG8_STAGE(PG8_SB(0, 1), cB + hstep, voffB); PG8_STAGE(PG8_SA(0, 1), cA + hstep, voffA);
    if (wr == 1) PG8_BAR;
    PG8_WAIT_V(4); PG8_BAR;
    PG8_STAGE(PG8_SB(1, 0), cB + kstep, voffB); PG8_STAGE(PG8_SA(1, 0), cA + kstep, voffA); PG8_STAGE(PG8_SB(1, 1), cB + hstep + kstep, voffB);
    PG8_WAIT_V(6); PG8_BAR;
    for (;;) {
        const bool has_next = S.next(ui + 1, nxt);
        const char* nA = has_next ? (const char*)g.A + (size_t)nxt.pm * tstep : cA; const char* nB = has_next ? (const char*)g.Bt + (size_t)nxt.pn * tstep : cB;
        for (int t = 0; t < nt; t += 2) {
            const bool last = (t == nt - 2);
            const char* a1 = cA + (size_t)(t + 1) * kstep;
            const char* a2 = last ? nA : cA + (size_t)(t + 2) * kstep; const char* b2 = last ? nB : cB + (size_t)(t + 2) * kstep;
            const char* a3 = a2 + kstep; const char* b3 = b2 + kstep;
            if (last && has_next) S.a_ready(nxt);
            PG8_LDB(B0, 0, 0); PG8_SCHED; PG8_LDA(At, 0, 0); PG8_STAGE(PG8_SA(1, 1), a1 + hstep, voffA);
            PG8_WAIT_L(8); PG8_BAR; PG8_WAIT_L(0); PG8_MMA(0, 0, At, B0); PG8_BAR; PG8_SCHED;
            PG8_LDB(B1, 0, 1); PG8_STAGE(PG8_SB(0, 0), b2, voffB);
            PG8_BAR; PG8_WAIT_L(0); PG8_MMA(0, 1, At, B1); PG8_BAR;
            PG8_LDA(At, 0, 1); PG8_STAGE(PG8_SA(0, 0), a2, voffA);
            PG8_BAR; PG8_WAIT_L(0); PG8_MMA(1, 0, At, B0); PG8_BAR; PG8_SCHED;
            PG8_STAGE(PG8_SB(0, 1), b2 + hstep, voffB);
            PG8_WAIT_V(6); PG8_BAR; PG8_MMA(1, 1, At, B1); PG8_BAR;
            PG8_LDB(B0, 1, 0); PG8_SCHED; PG8_LDA(At, 1, 0); PG8_STAGE(PG8_SA(0, 1), a2 + hstep, voffA);
            PG8_WAIT_L(8); PG8_BAR; PG8_WAIT_L(0); PG8_MMA(0, 0, At, B0); PG8_BAR; PG8_SCHED;
            PG8_LDB(B1, 1, 1); PG8_STAGE(PG8_SB(1, 0), b3, voffB);
            PG8_BAR; PG8_WAIT_L(0); PG8_MMA(0, 1, At, B1); PG8_BAR;
            PG8_LDA(At, 1, 1); PG8_STAGE(PG8_SA(1, 0), a3, voffA);
            PG8_BAR; PG8_WAIT_L(0); PG8_MMA(1, 0, At, B0); PG8_BAR; PG8_SCHED;
            PG8_STAGE(PG8_SB(1, 1), b3 + hstep, voffB);
            PG8_WAIT_V(6); PG8_BAR; PG8_MMA(1, 1, At, B1); PG8_BAR;
        }
        if constexpr (!Epi::AFTER_DRAIN) { E(acc, cur, wr, wc, fr, fq); S.done(cur); }
        if (!has_next) break;
#pragma unroll
        for (int a = 0; a < 2; ++a)
#pragma unroll
            for (int b = 0; b < 2; ++b)
#pragma unroll
                for (int m = 0; m < 4; ++m)
#pragma unroll
                    for (int n = 0; n < 2; ++n) acc[a][b][m][n] = (f32x4){0.f, 0.f, 0.f, 0.f};
        cur = nxt; cA = nA; cB = nB; ++ui;
    }
    PG8_WAIT_V(0);
    if (wr == 0) PG8_BAR;
    PG8_BAR;
    if constexpr (Epi::AFTER_DRAIN) { E.fused(acc, cur, wr, wc, fr, fq, lds, wid, lane); S.done(cur); }
#undef PG8_SA
#undef PG8_SB
#undef PG8_STAGE
#undef PG8_LDA
#undef PG8_LDB
#undef PG8_MMA
#undef PG8_WAIT_V
#undef PG8_WAIT_L
#undef PG8_BAR
#undef PG8_SCHED
}
}
using pg8::Unit;

struct EpiIn {
    static constexpr bool AFTER_DRAIN = false;
    bf16_t* proj; float* out; float* dtb; const float* dt_bias; int l;
    __device__ __forceinline__ void operator()(const f32x4 (&acc)[2][2][4][2], const Unit& u, int wr, int wc, int fr_, int fq_) const {
        int fr = fr_, fq = fq_; asm volatile("" : "+v"(fr), "+v"(fq));
#pragma unroll
        for (int bj = 0; bj < 2; ++bj) {
            const int cb = u.pn * 256 + bj * 128;
            const int col = cb + wc * 32 + fq * 8;
            if (cb > C_DT) continue;
#pragma unroll
            for (int ai = 0; ai < 2; ++ai)
#pragma unroll
                for (int m = 0; m < 4; ++m) {
                    const int row = u.pm * 256 + ai * 128 + wr * 64 + m * 16 + fr;
                    const bool isP = row < T_P; int b, t;
                    if (isP) { b = row >> 13; t = row & 8191; } else { b = (row - T_P) >> 6; t = row & 63; }
                    f32x4 v0 = acc[ai][bj][m][0], v1 = acc[ai][bj][m][1];
                    if (cb < C_U) {
                        u32x4 w; { const u32x2 a = pack4(v0), c = pack4(v1); w.x = a.x; w.y = a.y; w.z = c.x; w.w = c.y; }
                        *(u32x4*)(proj + (size_t)row * NPROJ + col) = w;
                        if (cb >= C_K && cb < C_Z) {
                            const int isv = cb >= C_V; const int cc = col - (isv ? C_V : C_K);
                            float* o = nullptr;
                            if (isP) { if (t >= 7680) o = out + (isv ? O_PV : O_PK) + ((size_t)(l * 4 + b) * 512 + (t - 7680)) * 384 + cc; }
                            else o = out + (isv ? O_SV : O_SK) + ((size_t)(l * 32 + b) * 64 + t) * 384 + cc;
                            if (o) { *(f32x4*)o = v0; *(f32x4*)(o + 4) = v1; }
                        } else if (cb >= C_XBC) {
                            const int cc = col - C_XBC; float* o = nullptr;
                            if (isP) { if (t >= 8189) o = out + O_PC + ((size_t)(l * 4 + b) * 3 + (t - 8189)) * 896 + cc; }
                            else if (t >= 61) o = out + O_SC + ((size_t)(l * 32 + b) * 3 + (t - 61)) * 896 + cc;
                            if (o) { *(f32x4*)o = v0; *(f32x4*)(o + 4) = v1; }
                        }
                    } else if (cb < C_DT) {
#pragma unroll
                        for (int j = 0; j < 4; ++j) { v0[j] = gelu_tanh(v0[j]); v1[j] = gelu_tanh(v1[j]); }
                        u32x4 w; { const u32x2 a = pack4(v0), c = pack4(v1); w.x = a.x; w.y = a.y; w.z = c.x; w.w = c.y; }
                        *(u32x4*)(proj + (size_t)row * NPROJ + col) = w;
                        if (cb >= C_VC && !isP) { float* o = out + O_SG + ((size_t)(l * 32 + b) * 64 + t) * 256 + (col - C_VC); *(f32x4*)o = v0; *(f32x4*)(o + 4) = v1; }
                    } else if (col == C_DT) {
                        float* d = dtb + (size_t)row * 8;
#pragma unroll
                        for (int j = 0; j < 4; ++j) d[j] = softplus_f(v0[j] + dt_bias[l * 6 + j]);
#pragma unroll
                        for (int j = 0; j < 2; ++j) d[4 + j] = softplus_f(v1[j] + dt_bias[l * 6 + 4 + j]);
                    }
                    asm volatile("" ::: "memory");
                }
        }
    }
};
struct EpiNull {
    static constexpr bool AFTER_DRAIN = false;
    float* sink;
    __device__ __forceinline__ void operator()(const f32x4 (&acc)[2][2][4][2], const Unit& u, int wr, int wc, int fr, int fq) const {
        float t = 0.f;
#pragma unroll
        for (int ai = 0; ai < 2; ++ai)
#pragma unroll
            for (int bj = 0; bj < 2; ++bj)
#pragma unroll
                for (int m = 0; m < 4; ++m)
#pragma unroll
                    for (int n = 0; n < 2; ++n) t += acc[ai][bj][m][n][0] + acc[ai][bj][m][n][1] + acc[ai][bj][m][n][2] + acc[ai][bj][m][n][3];
        if (t == 123456.789f) sink[0] = t;
    }
};
struct EpiRes {
    static constexpr bool AFTER_DRAIN = false;
    float* x; const bf16_t* xb; bf16_t* rdst;
    __device__ __forceinline__ void operator()(const f32x4 (&acc)[2][2][4][2], const Unit& u, int wr, int wc, int fr_, int fq_) const {
        int fr = fr_, fq = fq_; asm volatile("" : "+v"(fr), "+v"(fq));
#pragma unroll
        for (int ai = 0; ai < 2; ++ai)
#pragma unroll
            for (int m = 0; m < 4; ++m) {
                float* rowp = x + (size_t)(u.pm * 256 + ai * 128 + wr * 64 + m * 16 + fr) * DM + u.pn * 256 + wc * 32 + fq * 8;
#pragma unroll
                for (int bj = 0; bj < 2; ++bj) { float* q = rowp + bj * 128; const u32x4 xw = *(const u32x4*)(xb + (q - x));
                    const f32x4 o0 = unpack4((u32x2){xw.x, xw.y}), o1 = unpack4((u32x2){xw.z, xw.w});
                    const u32x2 ra = pack4(o0 * ALPHA + acc[ai][bj][m][0]), rb = pack4(o1 * ALPHA + acc[ai][bj][m][1]);
                    *(u32x4*)(rdst + (q - x)) = (u32x4){ra.x, ra.y, rb.x, rb.y}; }
                asm volatile("" ::: "memory");
            }
    }
};
struct EpiUp {
    static constexpr bool AFTER_DRAIN = true;
    bf16_t* H; float* halo; float* out; const float* cw; const float* cb; const float* fstate; int l;
    __device__ __forceinline__ void operator()(const f32x4 (&)[2][2][4][2], const Unit&, int, int, int, int) const {}
    __device__ __forceinline__ void fused(f32x4 (&acc)[2][2][4][2], const Unit& u, int wr, int wc, int fr, int fq, LAS unsigned char* lds, int wid, int lane) const {
        constexpr int LS = 264;
#pragma unroll
        for (int ai = 0; ai < 2; ++ai)
#pragma unroll
            for (int m = 0; m < 4; ++m)
#pragma unroll
                for (int bj = 0; bj < 2; ++bj) {
                        const int rl = ai * 128 + wr * 64 + m * 16 + fr, cl = bj * 128 + wc * 32 + fq * 8;
                        u32x4 w; { const u32x2 a = pack4(acc[ai][bj][m][0]), c = pack4(acc[ai][bj][m][1]); w.x = a.x; w.y = a.y; w.z = c.x; w.w = c.y; }
                        *(LAS u32x4*)(lds + (rl * LS + cl) * 2) = w;
                    }
        __syncthreads();
        const int tid = wid * 64 + lane, j = tid & 127, seg = tid >> 7;
        const int hcol = u.pn * 128 + j;
        const float* w = cw + (size_t)l * 3 * DFF2; const float* bb = cb + (size_t)l * DFF2;
        const float wg0 = w[hcol], wg1 = w[DFF2 + hcol], wg2 = w[2 * DFF2 + hcol], bg = bb[hcol];
        const float wv0 = w[DFF + hcol], wv1 = w[DFF2 + DFF + hcol], wv2 = w[2 * DFF2 + DFF + hcol], bv = bb[DFF + hcol];
        const int R = u.pm * 256 + seg * 64;
        const bool isP = R < T_P;
        float g2 = 0.f, g1 = 0.f, v2 = 0.f, v1 = 0.f; int skip = 0;
        const LAS bf16_t* U = (const LAS bf16_t*)lds;
        if (isP) {
            if (seg > 0) { g2 = bf2f(U[(seg * 64 - 2) * LS + j]); g1 = bf2f(U[(seg * 64 - 1) * LS + j]); v2 = bf2f(U[(seg * 64 - 2) * LS + 128 + j]); v1 = bf2f(U[(seg * 64 - 1) * LS + 128 + j]); }
            else if ((R & 8191) != 0) skip = 2;
        } else {
            const int sb = (R - T_P) >> 6; const float* fs = fstate + (size_t)(l * 32 + sb) * 2 * DFF2;
            g2 = fs[hcol]; g1 = fs[DFF2 + hcol]; v2 = fs[DFF + hcol]; v1 = fs[DFF2 + DFF + hcol];
        }
        bf16_t* hp = H + (size_t)R * DFF + hcol;
#pragma unroll 8
        for (int i = 0; i < 64; ++i) {
            const float gq = bf2f(U[(seg * 64 + i) * LS + j]), vq = bf2f(U[(seg * 64 + i) * LS + 128 + j]);
            if (i >= skip) {
                const float cgv = bg + wg0 * g2 + wg1 * g1 + wg2 * gq, cvv = bv + wv0 * v2 + wv1 * v1 + wv2 * vq;
                const float hv = silu_f(cgv) * cvv;
                hp[(size_t)i * DFF] = (bf16_t)(cvt_pk_bf16(hv, 0.f) & 0xffffu);
            }
            g2 = g1; g1 = gq; v2 = v1; v1 = vq;
            if (isP) {
                if (seg == 0 && i < 2) { float* hl = halo + ((size_t)u.pm * 4 + i) * DFF2; hl[hcol] = gq; hl[DFF + hcol] = vq; }
                if (seg == 3 && i >= 62) { float* hl = halo + ((size_t)u.pm * 4 + 2 + (i - 62)) * DFF2; hl[hcol] = gq; hl[DFF + hcol] = vq;
                    if ((u.pm & 31) == 31) { float* o = out + O_PF + ((size_t)(l * 4 + (u.pm >> 5)) * 2 + (i - 62)) * DFF2; o[hcol] = gq; o[DFF + hcol] = vq; } }
            } else if (i >= 62) {
                const int sb = (R - T_P) >> 6; float* o = out + O_SF + ((size_t)(l * 32 + sb) * 2 + (i - 62)) * DFF2; o[hcol] = gq; o[DFF + hcol] = vq;
            }
        }
    }
};

template <int CTRL> __device__ __forceinline__ float dppz(float x) { return __builtin_bit_cast(float, __builtin_amdgcn_update_dpp(0, __builtin_bit_cast(int, x), CTRL, 0xf, 0xf, true)); }
struct EpiUp2 {
    static constexpr bool AFTER_DRAIN = false;
    bf16_t* H; float* halo; float* out; const float* cw; const float* cb; const float* fstate; int l; LAS unsigned char* lds;
    __device__ __forceinline__ void operator()(const f32x4 (&acc)[2][2][4][2], const Unit& u, int wr, int wc, int fr_, int fq_) const {
        int fr = fr_, fq = fq_; asm volatile("" : "+v"(fr), "+v"(fq));
        const int hcol = u.pn * 128 + wc * 32 + fq * 8;
        const float* w = cw + (size_t)l * 3 * DFF2 + hcol; const float* bb = cb + (size_t)l * DFF2 + hcol;
        LAS f32x4* wl = (LAS f32x4*)(lds + 131072 + (wc * 4 + fq) * 256);
#pragma unroll
        for (int sd = 0; sd < 2; ++sd)
#pragma unroll
            for (int hf = 0; hf < 2; ++hf) { wl[(sd * 2 + hf) * 4 + 3] = *(const f32x4*)(bb + sd * DFF + hf * 4);
#pragma unroll
                for (int tp = 0; tp < 3; ++tp) wl[(sd * 2 + hf) * 4 + tp] = *(const f32x4*)(w + tp * DFF2 + sd * DFF + hf * 4); }
        asm volatile("s_waitcnt lgkmcnt(0)" ::: "memory");
#pragma unroll
        for (int ai = 0; ai < 2; ++ai) {
            const int R = u.pm * 256 + ai * 128 + wr * 64, blk = R >> 6;
            const bool isP = R < T_P, seqstart = isP ? ((R & 8191) == 0) : true;
            f32x4 Xp[2][2];
#pragma unroll
            for (int sd = 0; sd < 2; ++sd)
#pragma unroll
                for (int hf = 0; hf < 2; ++hf) Xp[sd][hf] = (f32x4){0.f, 0.f, 0.f, 0.f};
            if (!isP && fr >= 14) { const float* fs = fstate + ((size_t)(l * 32 + (blk - 512)) * 2 + (fr - 14)) * DFF2 + hcol;
#pragma unroll
                for (int sd = 0; sd < 2; ++sd)
#pragma unroll
                    for (int hf = 0; hf < 2; ++hf) Xp[sd][hf] = *(const f32x4*)(fs + sd * DFF + hf * 4); }
#pragma unroll
            for (int m = 0; m < 4; ++m) {
                f32x4 cv[2][2];
#pragma unroll
                for (int sd = 0; sd < 2; ++sd)
#pragma unroll
                    for (int hf = 0; hf < 2; ++hf)
                    { const f32x4 w0 = wl[(sd * 2 + hf) * 4 + 0], w1 = wl[(sd * 2 + hf) * 4 + 1], w2 = wl[(sd * 2 + hf) * 4 + 2], b3 = wl[(sd * 2 + hf) * 4 + 3];
#pragma unroll
                        for (int j = 0; j < 4; ++j) {
                            const float x = acc[ai][sd][m][hf][j], xp = Xp[sd][hf][j];
                            float c = b3[j] + w2[j] * x;
                            c += w1[j] * dppz<0x111>(x); c += w1[j] * dppz<0x10F>(xp); c += w0[j] * dppz<0x112>(x); c += w0[j] * dppz<0x10E>(xp);
                            cv[sd][hf][j] = c;
                        } }
                f32x4 h0, h1;
#pragma unroll
                for (int j = 0; j < 4; ++j) { h0[j] = silu_f(cv[0][0][j]) * cv[1][0][j]; h1[j] = silu_f(cv[0][1][j]) * cv[1][1][j]; }
                const int row = R + m * 16 + fr;
                if (!(m == 0 && fr < 2 && !seqstart)) { u32x4 pk; { const u32x2 a = pack4(h0), c = pack4(h1); pk.x = a.x; pk.y = a.y; pk.z = c.x; pk.w = c.y; }
                    *(u32x4*)(H + (size_t)row * DFF + hcol) = pk; }
                float* sv = nullptr; float* sv2 = nullptr;
                if (isP) { if (m == 0 && fr < 2) sv = halo + ((size_t)blk * 4 + fr) * DFF2 + hcol;
                           if (m == 3 && fr >= 14) { sv = halo + ((size_t)blk * 4 + 2 + (fr - 14)) * DFF2 + hcol; if ((blk & 127) == 127) sv2 = out + O_PF + ((size_t)(l * 4 + (blk >> 7)) * 2 + (fr - 14)) * DFF2 + hcol; } }
                else if (m == 3 && fr >= 14) sv = out + O_SF + ((size_t)(l * 32 + (blk - 512)) * 2 + (fr - 14)) * DFF2 + hcol;
                if (sv) {
#pragma unroll
                    for (int sd = 0; sd < 2; ++sd)
#pragma unroll
                        for (int hf = 0; hf < 2; ++hf) { *(f32x4*)(sv + sd * DFF + hf * 4) = acc[ai][sd][m][hf]; if (sv2) *(f32x4*)(sv2 + sd * DFF + hf * 4) = acc[ai][sd][m][hf]; } }
#pragma unroll
                for (int sd = 0; sd < 2; ++sd)
#pragma unroll
                    for (int hf = 0; hf < 2; ++hf) Xp[sd][hf] = acc[ai][sd][m][hf];
                asm volatile("" ::: "memory");
            }
        }
    }
};

__device__ __forceinline__ void ln_row(const float* src, const bf16_t* srcb, float* x32, bf16_t* xb, const float* g, const float* b, int lane) {
    f32x4 v[4]; float s = 0.f;
#pragma unroll
    for (int i = 0; i < 4; ++i) { v[i] = srcb ? unpack4(*(const u32x2*)(srcb + i * 256 + lane * 4)) : *(const f32x4*)(src + i * 256 + lane * 4); s += (v[i][0] + v[i][1]) + (v[i][2] + v[i][3]); }
#pragma unroll
    for (int o = 32; o >= 1; o >>= 1) s += __shfl_xor(s, o);
    const float mu = s * (1.0f / 1024.0f); float q = 0.f;
#pragma unroll
    for (int i = 0; i < 4; ++i) { const f32x4 d = v[i] - mu; q += (d[0] * d[0] + d[1] * d[1]) + (d[2] * d[2] + d[3] * d[3]); }
#pragma unroll
    for (int o = 32; o >= 1; o >>= 1) q += __shfl_xor(q, o);
    const float rstd = 1.0f / sqrtf(q * (1.0f / 1024.0f) + LN_EPS);
#pragma unroll
    for (int i = 0; i < 4; ++i) {
        const f32x4 gg = *(const f32x4*)(g + i * 256 + lane * 4), bb = *(const f32x4*)(b + i * 256 + lane * 4);
        const f32x4 o = (v[i] - mu) * rstd * gg + bb;
        if (x32) *(f32x4*)(x32 + i * 256 + lane * 4) = o;
        if (xb) *(u32x2*)(xb + i * 256 + lane * 4) = pack4(o);
    }
}

__device__ __forceinline__ void tr_tile(LAS float* tile, const float* src, int Nsrc, bf16_t* dst, int K, int n0, int k0, int mode, int tid) {
    const int nn = tid & 63, np = n0 + nn; int sc;
    if (mode == 0) sc = np < C_U ? np : (np < C_DT ? np + 6 : (np < C_DT + 6 ? np - 512 : -1));
    else if (mode == 1) sc = np;
    else { const int pn = np >> 8, jj = np & 255; sc = jj < 128 ? pn * 128 + jj : DFF + pn * 128 + (jj - 128); }
#pragma unroll
    for (int i = 0; i < 8; ++i) { const int kk = (tid >> 6) + 8 * i; tile[kk * 65 + nn] = sc >= 0 ? src[(size_t)(k0 + kk) * Nsrc + sc] : 0.f; }
    __syncthreads();
    const int kk2 = (tid & 31) * 2;
#pragma unroll
    for (int i = 0; i < 4; ++i) { const int nn2 = (tid >> 5) + 16 * i; *(unsigned*)(dst + (size_t)(n0 + nn2) * K + k0 + kk2) = cvt_pk_bf16(tile[kk2 * 65 + nn2], tile[(kk2 + 1) * 65 + nn2]); }
    __syncthreads();
}

__device__ __forceinline__ void phase_prep(KP& p, LAS unsigned char* lds) {
    int tid_ = threadIdx.x; asm volatile("" : "+v"(tid_));
    const int tid = tid_, wid = tid >> 6, lane = tid & 63;
    for (int row = blockIdx.x * 8 + wid; row < T_ALL; row += gridDim.x * 8) {
        const float* src = row < T_P ? p.in[0] + (size_t)row * DM : p.in[1] + (size_t)(row - T_P) * DM;
        ln_row(src, nullptr, nullptr, (bf16_t*)(p.ws + W_XB) + (size_t)row * DM, p.in[7], p.in[8], lane);
    }
    constexpr int T_IN = 48 * 16, T_OUT = 16 * 16, T_UPT = 88 * 16, T_DNT = 16 * 44, T_L = T_IN + T_OUT + T_UPT + T_DNT;
    for (int it = blockIdx.x; it < 4 * T_L; it += gridDim.x) {
        const int l = it / T_L; int r = it % T_L;
        if (r < T_IN) tr_tile((LAS float*)lds, p.in[9] + (size_t)l * DM * 2950, 2950, (bf16_t*)(p.ws + W_IN + l * W_IN_L), DM, (r >> 4) * 64, (r & 15) * 64, 0, tid);
        else if ((r -= T_IN) < T_OUT) tr_tile((LAS float*)lds, p.in[19] + (size_t)l * DM * DM, DM, (bf16_t*)(p.ws + W_OUT + l * W_OUT_L), DM, (r >> 4) * 64, (r & 15) * 64, 1, tid);
        else if ((r -= T_OUT) < T_UPT) tr_tile((LAS float*)lds, p.in[22] + (size_t)l * DM * DFF2, DFF2, (bf16_t*)(p.ws + W_UP + l * W_UP_L), DM, (r >> 4) * 64, (r & 15) * 64, 2, tid);
        else { r -= T_UPT; tr_tile((LAS float*)lds, p.in[25] + (size_t)l * DFF * DM, DM, (bf16_t*)(p.ws + W_DN + l * W_DN_L), DFF, (r / 44) * 64, (r % 44) * 64, 1, tid); }
    }
    for (int i = blockIdx.x * 512 + tid; i < 4 * 4 * 128 * 128; i += gridDim.x * 512) {
        const int jj = i & 127, ii = (i >> 7) & 127;
        ((bf16_t*)(p.ws + W_GW))[i] = (bf16_t)(cvt_pk_bf16(jj <= ii ? p.in[16][i] : 0.f, 0.f) & 0xffffu);
    }
}

__device__ __forceinline__ void phase_ln(KP& p, const bf16_t* rsrc, const float* g, const float* b, bool final_out) {
    int tid_ = threadIdx.x; asm volatile("" : "+v"(tid_));
    const int wid = tid_ >> 6, lane = tid_ & 63;
    for (int row = blockIdx.x * 8 + wid; row < T_ALL; row += gridDim.x * 8)
        ln_row(nullptr, rsrc + (size_t)row * DM, final_out ? p.out + (size_t)row * DM : nullptr, final_out ? nullptr : (bf16_t*)(p.ws + W_XB) + (size_t)row * DM, g, b, lane);
}

__device__ __forceinline__ void dt_scan(KP& p, int l, int u, int g, int wid, int lane, float& dt, float& ac, float& last) {
    const int h = g * 3 + wid;
    dt = ((const float*)(p.ws + W_DTB))[(size_t)(u * 64 + lane) * 8 + h];
    const float a = -__expf(p.in[14][l * 6 + h]);
    float v = dt * a;
#pragma unroll
    for (int o = 1; o < 64; o <<= 1) { const float t = __shfl_up(v, o); if (lane >= o) v += t; }
    ac = v; last = __shfl(v, 63);
}

__device__ __forceinline__ f32x4 xbc_row(KP& p, int l, int u, int s, int ch) {
    const bf16_t* proj = (const bf16_t*)(p.ws + W_PROJ);
    const bool isP = u < 512; const bool hasprev = isP && (u & 127) != 0;
    if (s >= 0 || hasprev) return unpack4(*(const u32x2*)(proj + (size_t)(u * 64 + s) * NPROJ + C_XBC + ch));
    if (!isP) return *(const f32x4*)(p.in[5] + (unsigned)(((l * 32 + (u - 512)) * 3 + (3 + s)) * 896 + ch));
    return (f32x4){0.f, 0.f, 0.f, 0.f};
}
__device__ __forceinline__ void ssd_states(KP& p, LAS unsigned char* lds, int l, int u) {
    int tid_ = threadIdx.x; asm volatile("" : "+v"(tid_));
    const int tid = tid_, wid = tid >> 6, lane = tid & 63, fr = lane & 15, fq = lane >> 4;
    LAS bf16_t* xT = (LAS bf16_t*)lds;
    LAS bf16_t* BT = (LAS bf16_t*)(lds + 55296);
    LAS float* wgt = (LAS float*)(lds + 92160);
    bf16_t* XC = (bf16_t*)p.out;
    __syncthreads();
    if (wid < 6) {
        float dt, ac, last; dt_scan(p, l, u, wid / 3, wid % 3, lane, dt, ac, last);
        wgt[wid * 64 + lane] = dt * __expf(last - ac);
        if (lane == 0) ((float*)(p.ws + W_CD))[u * 8 + wid] = __expf(last);
    }
    __syncthreads();
    if (tid < 448) {
        const int cgp = tid % 224, seg = tid / 224, ch = cgp * 4, r0 = seg * 32;
        const float* cw = p.in[11] + (size_t)l * 4 * 896 + ch;
        const f32x4 w0 = *(const f32x4*)cw, w1 = *(const f32x4*)(cw + 896), w2 = *(const f32x4*)(cw + 2 * 896), w3 = *(const f32x4*)(cw + 3 * 896);
        const f32x4 bs = *(const f32x4*)(p.in[12] + (size_t)l * 896 + ch);
        f32x4 xm3 = xbc_row(p, l, u, r0 - 3, ch), xm2 = xbc_row(p, l, u, r0 - 2, ch), xm1 = xbc_row(p, l, u, r0 - 1, ch);
        const bf16_t* src = (const bf16_t*)(p.ws + W_PROJ) + (size_t)(u * 64) * NPROJ + C_XBC + ch;
        bf16_t* dst = XC + (size_t)(u * 64) * 896 + ch;
        const int hh = ch >> 6;
#pragma unroll 2
        for (int i = r0; i < r0 + 32; i += 2) {
            const f32x4 xa = unpack4(*(const u32x2*)(src + (size_t)i * NPROJ)), xb = unpack4(*(const u32x2*)(src + (size_t)(i + 1) * NPROJ));
            f32x4 ya = bs + w0 * xm3 + w1 * xm2 + w2 * xm1 + w3 * xa, yb = bs + w0 * xm2 + w1 * xm1 + w2 * xa + w3 * xb;
#pragma unroll
            for (int e = 0; e < 4; ++e) { ya[e] = silu_f(ya[e]); yb[e] = silu_f(yb[e]); }
            xm3 = xm1; xm2 = xa; xm1 = xb;
            *(u32x2*)(dst + (size_t)i * 896) = pack4(ya); *(u32x2*)(dst + (size_t)(i + 1) * 896) = pack4(yb);
            if (ch < 384) { const float wa = wgt[hh * 64 + i], wb = wgt[hh * 64 + i + 1];
#pragma unroll
                for (int e = 0; e < 4; ++e) *(LAS unsigned*)(xT + (ch + e) * 72 + i) = cvt_pk_bf16(ya[e] * wa, yb[e] * wb); }
            else if (ch < 640) {
#pragma unroll
                for (int e = 0; e < 4; ++e) *(LAS unsigned*)(BT + (ch - 384 + e) * 72 + i) = cvt_pk_bf16(ya[e], yb[e]); }
        }
    }
    __syncthreads();
    bf16_t* ST = (bf16_t*)(p.ws + W_ST);
#pragma unroll 2
    for (int k = 0; k < 24; ++k) {
        const int tt = wid * 24 + k, h = tt >> 5, pt = (tt & 31) >> 3, nt = tt & 7, g = h / 3;
        f32x4 acc = (f32x4){0.f, 0.f, 0.f, 0.f};
#pragma unroll
        for (int ks = 0; ks < 2; ++ks) {
            const bf16x8 rf = ldsfrag((LAS const unsigned char*)(xT + (h * 64 + pt * 16 + fr) * 72 + ks * 32 + fq * 8));
            const bf16x8 cf = ldsfrag((LAS const unsigned char*)(BT + (g * 128 + nt * 16 + fr) * 72 + ks * 32 + fq * 8));
            acc = MFMA16(cf, rf, acc);
        }
        *(u32x2*)(ST + ((size_t)(u * 6 + h) * 64 + pt * 16 + fr) * 128 + nt * 16 + fq * 4) = pack4(acc);
    }
}

__device__ __forceinline__ void gmlp_unit(KP& p, LAS unsigned char* lds, int l, int u) {
    int tid_ = threadIdx.x; asm volatile("" : "+v"(tid_));
    const int tid = tid_, wid = tid >> 6, lane = tid & 63, fr = lane & 15, fq = lane >> 4;
    LAS bf16_t* vT = (LAS bf16_t*)lds;
    LAS float* ssq = (LAS float*)(lds + 69632);
    const bf16_t* proj = (const bf16_t*)(p.ws + W_PROJ);
    const int half = u < 512 ? (u & 1) : 0, KJ = (half + 1) * 64, R0 = u * 64, Rb = R0 - half * 64;
    __syncthreads();
    for (int idx = tid; idx < KJ * 32; idx += 512) {
        const int j = idx & (KJ - 1), cgp = idx / KJ;
        const u32x4 w = *(const u32x4*)(proj + (size_t)(Rb + j) * NPROJ + C_VC + cgp * 8);
        const unsigned ww[4] = {w.x, w.y, w.z, w.w};
#pragma unroll
        for (int e = 0; e < 4; ++e) { vT[(cgp * 8 + 2 * e) * 136 + j] = (bf16_t)(ww[e] & 0xffffu); vT[(cgp * 8 + 2 * e + 1) * 136 + j] = (bf16_t)(ww[e] >> 16); }
    }
    __syncthreads();
    const int rt = wid & 3, cbase = (wid >> 2) * 8;
    const bf16_t* GW = (const bf16_t*)(p.ws + W_GW + l * W_GW_L);
    f32x4 acc[8];
#pragma unroll
    for (int gi = 0; gi < 2; ++gi) {
        const int gg = (cbase >> 2) + gi;
        bf16x8 rf[4];
#pragma unroll
        for (int ks = 0; ks < 4; ++ks) rf[ks] = glbfrag(GW + ((size_t)gg * 128 + half * 64 + rt * 16 + fr) * 128 + ks * 32 + fq * 8);
#pragma unroll
        for (int c4 = 0; c4 < 4; ++c4) {
            const int ct = cbase + gi * 4 + c4;
            f32x4 a = (f32x4){0.f, 0.f, 0.f, 0.f};
#pragma unroll
            for (int ks = 0; ks < 4; ++ks) if (ks * 32 < KJ) a = MFMA16(ldsfrag((LAS const unsigned char*)(vT + (ct * 16 + fr) * 136 + ks * 32 + fq * 8)), rf[ks], a);
            acc[gi * 4 + c4] = a;
        }
    }
    const int row = R0 + rt * 16 + fr; float sq = 0.f;
#pragma unroll
    for (int k = 0; k < 8; ++k) {
        const int col = (cbase + k) * 16 + fq * 4, gg = col >> 6;
        const float bsv = p.in[17][(size_t)(l * 4 + gg) * 128 + half * 64 + rt * 16 + fr];
        const f32x4 uv = unpack4(*(const u32x2*)(proj + (size_t)row * NPROJ + C_U + col));
        f32x4 o = uv * (acc[k] + bsv); acc[k] = o;
        sq += (o[0] * o[0] + o[1] * o[1]) + (o[2] * o[2] + o[3] * o[3]);
    }
    sq += __shfl_xor(sq, 16); sq += __shfl_xor(sq, 32);
    if (fq == 0) ssq[(wid >> 2) * 64 + rt * 16 + fr] = sq;
    __syncthreads();
    const float rstd = 1.0f / sqrtf((ssq[rt * 16 + fr] + ssq[64 + rt * 16 + fr]) * (1.0f / 256.0f) + RMS_EPS);
    bf16_t* mix = (bf16_t*)(p.ws + W_MIX);
#pragma unroll
    for (int k = 0; k < 8; ++k) {
        const int col = (cbase + k) * 16 + fq * 4;
        const f32x4 gv = *(const f32x4*)(p.in[18] + (size_t)l * 1024 + 768 + col);
        *(u32x2*)(mix + (size_t)row * DM + 768 + col) = pack4(acc[k] * rstd * gv);
    }
}

__device__ __forceinline__ void scan_prompt(KP& p, int l, int item) {
    int tid_ = threadIdx.x; asm volatile("" : "+v"(tid_));
    const int gid = item * 512 + tid_, e = (gid & 2047) * 4, bh = gid >> 11, b = bh / 6, h = bh % 6;
    bf16_t* ST = (bf16_t*)(p.ws + W_ST); const float* CD = (const float*)(p.ws + W_CD);
    f32x4 st = (f32x4){0.f, 0.f, 0.f, 0.f};
#pragma unroll 1
    for (int c0 = 0; c0 < 128; c0 += 16) {
        u32x2 s[16]; float cd[16];
#pragma unroll
        for (int k = 0; k < 16; ++k) { const int u = b * 128 + c0 + k; s[k] = *(const u32x2*)(ST + ((size_t)(u * 6 + h)) * 8192 + e); cd[k] = CD[u * 8 + h]; }
#pragma unroll
        for (int k = 0; k < 16; ++k) { const int u = b * 128 + c0 + k; *(u32x2*)(ST + ((size_t)(u * 6 + h)) * 8192 + e) = pack4(st); st = st * cd[k] + unpack4(s[k]); }
    }
    *(f32x4*)(p.out + O_PH + ((size_t)(l * 4 + b) * 6 + h) * 8192 + e) = st;
}
__device__ __forceinline__ void scan_sample(KP& p, int l, int item) {
    int tid_ = threadIdx.x; asm volatile("" : "+v"(tid_));
    const int gid = item * 512 + tid_, e = (gid & 2047) * 4, sbh = gid >> 11, sb = sbh / 6, h = sbh % 6;
    bf16_t* ST = (bf16_t*)(p.ws + W_ST); const float* CD = (const float*)(p.ws + W_CD);
    const int u = 512 + sb;
    const f32x4 st = *(const f32x4*)(p.in[4] + ((size_t)(l * 32 + sb) * 6 + h) * 8192 + e);
    const f32x4 s = unpack4(*(const u32x2*)(ST + ((size_t)(u * 6 + h)) * 8192 + e));
    *(u32x2*)(ST + ((size_t)(u * 6 + h)) * 8192 + e) = pack4(st);
    *(f32x4*)(p.out + O_SH + ((size_t)(l * 32 + sb) * 6 + h) * 8192 + e) = st * CD[u * 8 + h] + s;
}

__device__ __forceinline__ void attn_unit(KP& p, LAS unsigned char* lds, int l, int u) {
    int tid_ = threadIdx.x; asm volatile("" : "+v"(tid_));
    const int tid = tid_, wid = tid >> 6, lane = tid & 63, fr = lane & 15, fq = lane >> 4;
    LAS bf16_t* VT = (LAS bf16_t*)(lds + 98304);
    LAS float* bias = (LAS float*)(lds + 153600);
    LAS float* ssq = (LAS float*)(lds + 158208);
    const bf16_t* proj = (const bf16_t*)(p.ws + W_PROJ);
    const bool isP = u < 512; const int R0 = u * 64, c = u & 127, b = u >> 7, sb = u - 512;
    const int qt = wid & 3, hbase = (wid >> 2) * 3;
    __syncthreads();
    for (int i = tid; i < 1152; i += 512) bias[i] = p.in[10][(size_t)l * 1152 + i];
    bf16x8 qf[3][2];
#pragma unroll
    for (int hh = 0; hh < 3; ++hh)
#pragma unroll
        for (int ks = 0; ks < 2; ++ks) qf[hh][ks] = glbfrag(proj + (size_t)(R0 + qt * 16 + fr) * NPROJ + (hbase + hh) * 64 + ks * 32 + fq * 8);
    float mrun[3], lrun[3]; f32x4 O[3][4];
#pragma unroll
    for (int hh = 0; hh < 3; ++hh) { mrun[hh] = -1e30f; lrun[hh] = 0.f;
#pragma unroll
        for (int d = 0; d < 4; ++d) O[hh][d] = (f32x4){0.f, 0.f, 0.f, 0.f}; }
    const int blk_lo = isP ? (c < 8 ? 8 - c : 0) : 0;
    u32x4 vr[6];
    const int vkp = tid & 31, vcg0 = tid >> 5;
#define ATT_LOADP(blkv, bufv) do { const size_t rb_ = isP ? (size_t)b * 8192 + (size_t)(c - 8 + (blkv)) * 64 : (size_t)T_P + (size_t)sb * 64; \
        _Pragma("unroll") for (int it = 0; it < 6; ++it) { const int pu_ = it * 512 + tid, row_ = pu_ / 48, un_ = (pu_ % 48) ^ (row_ & 15); \
            __builtin_amdgcn_global_load_lds((const unsigned*)(proj + (rb_ + row_) * NPROJ + C_K + un_ * 8), (LAS unsigned*)(lds + (bufv) * 49152 + (it * 512 + wid * 64) * 16), 16, 0, 0); } \
        _Pragma("unroll") for (int it = 0; it < 2; ++it) { const int cg_ = vcg0 + it * 16; \
            vr[2 * it] = *(const u32x4*)(proj + (rb_ + 2 * vkp) * NPROJ + C_V + cg_ * 8); vr[2 * it + 1] = *(const u32x4*)(proj + (rb_ + 2 * vkp + 1) * NPROJ + C_V + cg_ * 8); } } while (0)
    bool have = false; int cur = 0;
    if (isP || blk_lo == 8) { ATT_LOADP(blk_lo, 0); have = true; }
#pragma unroll 1
    for (int blk = blk_lo; blk <= 8; ++blk) {
        LAS unsigned char* Kc = lds + cur * 49152;
        __syncthreads();
        if (!have) {
#pragma unroll
            for (int it = 0; it < 6; ++it) { const int idx = it * 512 + tid, row_ = idx / 48, un_ = idx % 48;
                const float* s = p.in[2] + ((size_t)(l * 32 + sb) * 512 + blk * 64 + row_) * 384 + un_ * 8; const f32x4 a = *(const f32x4*)s, bq = *(const f32x4*)(s + 4);
                u32x4 w; w.x = cvt_pk_bf16(a[0], a[1]); w.y = cvt_pk_bf16(a[2], a[3]); w.z = cvt_pk_bf16(bq[0], bq[1]); w.w = cvt_pk_bf16(bq[2], bq[3]);
                *(LAS u32x4*)(Kc + row_ * 768 + ((un_ ^ (row_ & 15)) * 16)) = w; }
#pragma unroll
            for (int it = 0; it < 6; ++it) { const int cg_ = vcg0 + (it >> 1) * 16;
                const float* s = p.in[3] + ((size_t)(l * 32 + sb) * 512 + blk * 64 + 2 * vkp + (it & 1)) * 384 + cg_ * 8; const f32x4 a = *(const f32x4*)s, bq = *(const f32x4*)(s + 4);
                vr[it].x = cvt_pk_bf16(a[0], a[1]); vr[it].y = cvt_pk_bf16(a[2], a[3]); vr[it].z = cvt_pk_bf16(bq[0], bq[1]); vr[it].w = cvt_pk_bf16(bq[2], bq[3]); }
        }
        if (have) { const size_t rb_ = isP ? (size_t)b * 8192 + (size_t)(c - 8 + blk) * 64 : (size_t)T_P + (size_t)sb * 64; const int cg_ = vcg0 + 2 * 16;
            vr[4] = *(const u32x4*)(proj + (rb_ + 2 * vkp) * NPROJ + C_V + cg_ * 8); vr[5] = *(const u32x4*)(proj + (rb_ + 2 * vkp + 1) * NPROJ + C_V + cg_ * 8); }
#pragma unroll
        for (int it = 0; it < 3; ++it) { const int cg_ = vcg0 + it * 16; const u32x4 w0 = vr[2 * it], w1 = vr[2 * it + 1];
            const unsigned a0[4] = {w0.x, w0.y, w0.z, w0.w}, a1[4] = {w1.x, w1.y, w1.z, w1.w};
#pragma unroll
            for (int e = 0; e < 4; ++e) {
                *(LAS unsigned*)(VT + (cg_ * 8 + 2 * e) * 72 + 2 * vkp) = (a0[e] & 0xffffu) | (a1[e] << 16);
                *(LAS unsigned*)(VT + (cg_ * 8 + 2 * e + 1) * 72 + 2 * vkp) = (a0[e] >> 16) | (a1[e] & 0xffff0000u); } }
        asm volatile("s_waitcnt vmcnt(0)" ::: "memory");
        __syncthreads();
        have = false;
        if (blk < 8 && (isP || blk == 7)) { ATT_LOADP(blk + 1, cur ^ 1); have = true; }
#pragma unroll
        for (int hh = 0; hh < 3; ++hh) {
            const int h = hbase + hh;
            f32x4 s[4]; float mx = -1e30f;
#pragma unroll
            for (int kt = 0; kt < 4; ++kt) {
                f32x4 a = (f32x4){0.f, 0.f, 0.f, 0.f};
#pragma unroll
                for (int ks = 0; ks < 2; ++ks) a = MFMA16(ldsfrag((LAS const unsigned char*)(Kc + (kt * 16 + fr) * 768 + (((h * 8 + ks * 4 + fq) ^ fr) * 16))), qf[hh][ks], a);
                if (blk <= 5) { const float bc = bias[h * 192 + 191];
#pragma unroll
                    for (int j = 0; j < 4; ++j) { a[j] = a[j] * 0.125f + bc; mx = fmaxf(mx, a[j]); } }
                else {
#pragma unroll
                    for (int j = 0; j < 4; ++j) {
                        int rel = (qt * 16 + fr) + 512 - (blk * 64 + kt * 16 + fq * 4 + j); rel = rel > 128 ? 128 : rel;
                        a[j] = a[j] * 0.125f + bias[h * 192 + rel + 63]; mx = fmaxf(mx, a[j]);
                    } }
                s[kt] = a;
            }
            mx = fmaxf(mx, __shfl_xor(mx, 16)); mx = fmaxf(mx, __shfl_xor(mx, 32));
            const float mnew = fmaxf(mrun[hh], mx), fac = __expf(mrun[hh] - mnew); mrun[hh] = mnew;
            float rs = 0.f;
#pragma unroll
            for (int kt = 0; kt < 4; ++kt)
#pragma unroll
                for (int j = 0; j < 4; ++j) { s[kt][j] = __expf(s[kt][j] - mnew); rs += s[kt][j]; }
            lrun[hh] = lrun[hh] * fac + rs;
#pragma unroll
            for (int d = 0; d < 4; ++d) O[hh][d] *= fac;
#pragma unroll
            for (int ks = 0; ks < 2; ++ks) {
                const u32x2 pa = pack4(s[2 * ks]), pb = pack4(s[2 * ks + 1]);
                const bf16x8 pf = __builtin_bit_cast(bf16x8, (u32x4){pa.x, pa.y, pb.x, pb.y});
#pragma unroll
                for (int d = 0; d < 4; ++d) {
                    const LAS bf16_t* vrow = VT + (h * 64 + d * 16 + fr) * 72 + ks * 32 + fq * 4;
                    const u32x2 va = *(const LAS u32x2*)vrow, vb = *(const LAS u32x2*)(vrow + 16);
                    O[hh][d] = MFMA16(__builtin_bit_cast(bf16x8, (u32x4){va.x, va.y, vb.x, vb.y}), pf, O[hh][d]);
                }
            }
        }
        cur ^= 1;
    }
#pragma unroll
    for (int hh = 0; hh < 3; ++hh) { lrun[hh] += __shfl_xor(lrun[hh], 16); lrun[hh] += __shfl_xor(lrun[hh], 32); }
    float sq = 0.f;
#pragma unroll
    for (int hh = 0; hh < 3; ++hh) { const float inv = 1.0f / lrun[hh];
#pragma unroll
        for (int d = 0; d < 4; ++d) { O[hh][d] *= inv; const f32x4 o = O[hh][d]; sq += (o[0] * o[0] + o[1] * o[1]) + (o[2] * o[2] + o[3] * o[3]); } }
    sq += __shfl_xor(sq, 16); sq += __shfl_xor(sq, 32);
    if (fq == 0) ssq[(wid >> 2) * 64 + qt * 16 + fr] = sq;
    __syncthreads();
    const float rstd = 1.0f / sqrtf((ssq[qt * 16 + fr] + ssq[64 + qt * 16 + fr]) * (1.0f / 384.0f) + RMS_EPS);
    bf16_t* mix = (bf16_t*)(p.ws + W_MIX);
#pragma unroll
    for (int hh = 0; hh < 3; ++hh)
#pragma unroll
        for (int d = 0; d < 4; ++d) {
            const int col = (hbase + hh) * 64 + d * 16 + fq * 4;
            const f32x4 gv = *(const f32x4*)(p.in[18] + (size_t)l * 1024 + col);
            *(u32x2*)(mix + (size_t)(R0 + qt * 16 + fr) * DM + col) = pack4(O[hh][d] * rstd * gv);
        }
}

__device__ __forceinline__ void ssd_y(KP& p, LAS unsigned char* lds, int l, int u) {
    int tid_ = threadIdx.x; asm volatile("" : "+v"(tid_));
    const int tid = tid_, wid = tid >> 6, lane = tid & 63, fr = lane & 15, fq = lane >> 4;
    LAS bf16_t* Cn = (LAS bf16_t*)lds;
    LAS bf16_t* Bn = (LAS bf16_t*)(lds + 17408);
    LAS bf16_t* xT = (LAS bf16_t*)(lds + 34816);
    LAS bf16_t* Mm = (LAS bf16_t*)(lds + 62464);
    LAS float* dtl = (LAS float*)(lds + 90112);
    LAS float* acl = (LAS float*)(lds + 90880);
    LAS float* ssq = (LAS float*)(lds + 91648);
    const bf16_t* proj = (const bf16_t*)(p.ws + W_PROJ);
    const bf16_t* HP = (const bf16_t*)(p.ws + W_ST);
    const bf16_t* XC = (const bf16_t*)p.out + (size_t)(u * 64) * 896;
    const int R0 = u * 64, lt = wid & 3;
    f32x4 yacc[2][6];
#pragma unroll
    for (int g = 0; g < 2; ++g) {
        __syncthreads();
        if (wid < 3) { float dt, ac, last; dt_scan(p, l, u, g, wid, lane, dt, ac, last); dtl[wid * 64 + lane] = dt; acl[wid * 64 + lane] = ac; }
#pragma unroll
        for (int it = 0; it < 4; ++it) {
            const int idx = it * 512 + tid, mat = idx >> 10, i = (idx >> 4) & 63, c8 = idx & 15;
            const u32x4 w = *(const u32x4*)(XC + (size_t)i * 896 + 384 + mat * 256 + g * 128 + c8 * 8);
            *(LAS u32x4*)((mat ? Cn : Bn) + i * 136 + c8 * 8) = w;
        }
#pragma unroll
        for (int it = 0; it < 3; ++it) {
            const int idx = it * 512 + tid, c4 = idx % 48, i = (idx / 48) * 2;
            const u32x2 wa = *(const u32x2*)(XC + (size_t)i * 896 + g * 192 + c4 * 4), wb = *(const u32x2*)(XC + (size_t)(i + 1) * 896 + g * 192 + c4 * 4);
            *(LAS unsigned*)(xT + (c4 * 4 + 0) * 72 + i) = (wa.x & 0xffffu) | (wb.x << 16);
            *(LAS unsigned*)(xT + (c4 * 4 + 1) * 72 + i) = (wa.x >> 16) | (wb.x & 0xffff0000u);
            *(LAS unsigned*)(xT + (c4 * 4 + 2) * 72 + i) = (wa.y & 0xffffu) | (wb.y << 16);
            *(LAS unsigned*)(xT + (c4 * 4 + 3) * 72 + i) = (wa.y >> 16) | (wb.y & 0xffff0000u);
        }
        __syncthreads();
#pragma unroll
        for (int k = 0; k < 2; ++k) {
            const int st = (wid >> 2) * 2 + k;
            f32x4 a = (f32x4){0.f, 0.f, 0.f, 0.f};
#pragma unroll
            for (int ks = 0; ks < 4; ++ks) a = MFMA16(ldsfrag((LAS const unsigned char*)(Bn + (st * 16 + fr) * 136 + ks * 32 + fq * 8)), ldsfrag((LAS const unsigned char*)(Cn + (lt * 16 + fr) * 136 + ks * 32 + fq * 8)), a);
            const int li = lt * 16 + fr;
#pragma unroll
            for (int hh = 0; hh < 3; ++hh) {
                const float al = acl[hh * 64 + li]; f32x4 mv;
#pragma unroll
                for (int j = 0; j < 4; ++j) { const int si = st * 16 + fq * 4 + j; mv[j] = si <= li ? a[j] * __expf(al - acl[hh * 64 + si]) * dtl[hh * 64 + si] : 0.f; }
                *(LAS u32x2*)(Mm + (hh * 64 + li) * 72 + st * 16 + fq * 4) = pack4(mv);
            }
        }
        __syncthreads();
#pragma unroll
        for (int k = 0; k < 6; ++k) {
            const int ctile = (wid >> 2) * 6 + k, hh = ctile >> 2, pt = ctile & 3, h = g * 3 + hh, li = lt * 16 + fr;
            f32x4 ad = (f32x4){0.f, 0.f, 0.f, 0.f}, ao = (f32x4){0.f, 0.f, 0.f, 0.f};
#pragma unroll
            for (int ks = 0; ks < 2; ++ks) ad = MFMA16(ldsfrag((LAS const unsigned char*)(xT + (hh * 64 + pt * 16 + fr) * 72 + ks * 32 + fq * 8)), ldsfrag((LAS const unsigned char*)(Mm + (hh * 64 + li) * 72 + ks * 32 + fq * 8)), ad);
#pragma unroll
            for (int ks = 0; ks < 4; ++ks) ao = MFMA16(glbfrag(HP + ((size_t)(u * 6 + h) * 64 + pt * 16 + fr) * 128 + ks * 32 + fq * 8), ldsfrag((LAS const unsigned char*)(Cn + li * 136 + ks * 32 + fq * 8)), ao);
            const float ea = __expf(acl[hh * 64 + li]), dsk = p.in[15][l * 6 + h];
            const f32x4 xv = unpack4(*(const u32x2*)(XC + (size_t)li * 896 + h * 64 + pt * 16 + fq * 4));
            const f32x4 zv = unpack4(*(const u32x2*)(proj + (size_t)(R0 + li) * NPROJ + C_Z + h * 64 + pt * 16 + fq * 4));
            f32x4 y = ad + ao * ea + xv * dsk;
#pragma unroll
            for (int j = 0; j < 4; ++j) y[j] *= silu_f(zv[j]);
            yacc[g][k] = y;
            asm volatile("" ::: "memory");
        }
    }
    float sq = 0.f;
#pragma unroll
    for (int g = 0; g < 2; ++g)
#pragma unroll
        for (int k = 0; k < 6; ++k) { const f32x4 o = yacc[g][k]; sq += (o[0] * o[0] + o[1] * o[1]) + (o[2] * o[2] + o[3] * o[3]); }
    sq += __shfl_xor(sq, 16); sq += __shfl_xor(sq, 32);
    if (fq == 0) ssq[(wid >> 2) * 64 + lt * 16 + fr] = sq;
    __syncthreads();
    const float rstd = 1.0f / sqrtf((ssq[lt * 16 + fr] + ssq[64 + lt * 16 + fr]) * (1.0f / 384.0f) + RMS_EPS);
    bf16_t* mix = (bf16_t*)(p.ws + W_MIX);
#pragma unroll
    for (int g = 0; g < 2; ++g)
#pragma unroll
        for (int k = 0; k < 6; ++k) {
            const int col = 384 + g * 192 + ((wid >> 2) * 6 + k) * 16 + fq * 4;
            const f32x4 gv = *(const f32x4*)(p.in[18] + (size_t)l * 1024 + col);
            *(u32x2*)(mix + (size_t)(R0 + lt * 16 + fr) * DM + col) = pack4(yacc[g][k] * rstd * gv);
        }
}

__device__ __forceinline__ void phase_fix(KP& p, int l) {
    const float* halo = (const float*)(p.ws + W_MIX); bf16_t* H = (bf16_t*)(p.ws + W_PROJ);
    const float* w = p.in[23] + (size_t)l * 3 * DFF2; const float* bb = p.in[24] + (size_t)l * DFF2;
    int tid_ = threadIdx.x; asm volatile("" : "+v"(tid_));
    for (int i = blockIdx.x * 512 + tid_; i < 128 * DFF2; i += gridDim.x * 512) {
        const int pm = i / DFF2, cc = i % DFF2;
        if ((pm & 31) == 0 || cc >= DFF) continue;
        const float* h0 = halo + (size_t)(pm - 1) * 4 * DFF2; const float* h1 = halo + (size_t)pm * 4 * DFF2;
        float r[2];
#pragma unroll
        for (int rr = 0; rr < 2; ++rr) {
            float o[2];
#pragma unroll
            for (int gv = 0; gv < 2; ++gv) {
                const int c2 = cc + gv * DFF;
                const float xm2 = h0[2 * DFF2 + c2], xm1 = h0[3 * DFF2 + c2], x0 = h1[c2], x1 = h1[DFF2 + c2];
                o[gv] = rr == 0 ? bb[c2] + w[c2] * xm2 + w[DFF2 + c2] * xm1 + w[2 * DFF2 + c2] * x0 : bb[c2] + w[c2] * xm1 + w[DFF2 + c2] * x0 + w[2 * DFF2 + c2] * x1;
            }
            r[rr] = silu_f(o[0]) * o[1];
        }
        H[((size_t)pm * 256) * DFF + cc] = (bf16_t)(cvt_pk_bf16(r[0], 0.f) & 0xffffu);
        H[((size_t)pm * 256 + 1) * DFF + cc] = (bf16_t)(cvt_pk_bf16(r[1], 0.f) & 0xffffu);
    }
}

#define XB_TMO      128
#define XB_XCNT(j)  (256  + 64 * (j))
#define XB_XSUB(j)  (1280 + 64 * (j))
#define XB_XGEN(j)  (2304 + 64 * (j))
#define XB_TOP      3328
#define XB_TOPGEN   3392
#define XCD_BAR_WORDS 3456
#define XB_SPIN_CAP (1u << 18)

__device__ __forceinline__ unsigned xb_ld(unsigned* p)              { return __hip_atomic_load(p, __ATOMIC_RELAXED, __HIP_MEMORY_SCOPE_AGENT); }
__device__ __forceinline__ unsigned xb_add(unsigned* p, unsigned v) { return __hip_atomic_fetch_add(p, v, __ATOMIC_RELAXED, __HIP_MEMORY_SCOPE_AGENT); }
__device__ __forceinline__ unsigned xb_xcc_id() { return (unsigned)__builtin_amdgcn_s_getreg((3 << 11) | 20) & 0xFu; }
#define XB_SPIN(cond, bar) do { unsigned _sp = 0; while (cond) { __builtin_amdgcn_s_sleep(1); \
    if ((++_sp & 255u) == 0u) { if (xb_ld(&(bar)[XB_TMO])) break; if (_sp > XB_SPIN_CAP) { atomicAdd(&(bar)[XB_TMO], 1u); break; } } } } while (0)

struct XcdBarrier {
    unsigned* bar; unsigned x;
    volatile LAS unsigned* st;
};

__device__ __forceinline__ XcdBarrier xcd_barrier_post(unsigned* bar, volatile LAS unsigned* st) {
    XcdBarrier b; b.bar = bar; b.x = xb_xcc_id(); b.st = st;
    if (threadIdx.x == 0) (void)xb_add(&bar[XB_XCNT(b.x)], 1u);
    return b;
}
__device__ __forceinline__ void xcd_barrier_complete(unsigned* bar, unsigned x, unsigned& nloc, unsigned& nx) {
    const unsigned G = gridDim.x * gridDim.y * gridDim.z;
    unsigned sum, cnt, mine, sp = 0u;
    for (;;) {
        sum = 0u; cnt = 0u; mine = 0u;
#pragma unroll
        for (unsigned j = 0; j < 16; ++j) { const unsigned c = xb_ld(&bar[XB_XCNT(j)]); sum += c; cnt += (c > 0u) ? 1u : 0u; mine = (j == x) ? c : mine; }
        if (sum == G) break;
        __builtin_amdgcn_s_sleep(1);
        if ((++sp & 255u) == 0u) { if (xb_ld(&bar[XB_TMO])) break; if (sp > XB_SPIN_CAP) { atomicAdd(&bar[XB_TMO], 1u); break; } }
    }
    nloc = mine > 0u ? mine : 1u; nx = cnt > 0u ? cnt : 1u;
}

__device__ __forceinline__ void xcd_barrier(const XcdBarrier& b) {
    asm volatile("s_waitcnt vmcnt(0)" ::: "memory");
    __syncthreads();
    if (threadIdx.x == 0) {
        unsigned* bar = b.bar;
        __builtin_amdgcn_s_waitcnt(0);
        unsigned nloc = b.st[0], nx = b.st[1];
        if (nloc == 0u) { xcd_barrier_complete(bar, b.x, nloc, nx); b.st[0] = nloc; b.st[1] = nx; }
        const unsigned old = xb_add(&bar[XB_XSUB(b.x)], 1u);
        const unsigned gen = old / nloc;
        if (old + 1u == (gen + 1u) * nloc) {
            __builtin_amdgcn_fence(__ATOMIC_RELEASE, "agent");
            asm volatile("s_waitcnt vmcnt(0)" ::: "memory");
            const unsigned og = xb_add(&bar[XB_TOP], 1u);
            const unsigned tg = og / nx;
            if (og + 1u == (tg + 1u) * nx) xb_add(&bar[XB_TOPGEN], 1u);
            else XB_SPIN(xb_ld(&bar[XB_TOPGEN]) == tg, bar);
            __builtin_amdgcn_fence(__ATOMIC_ACQUIRE, "agent");
            xb_add(&bar[XB_XGEN(b.x)], 1u);
            asm volatile("s_waitcnt vmcnt(0)" ::: "memory");
        } else {
            XB_SPIN(xb_ld(&bar[XB_XGEN(b.x)]) == gen, bar);
            __builtin_amdgcn_fence(__ATOMIC_ACQUIRE, "agent");
            asm volatile("s_waitcnt vmcnt(0)" ::: "memory");
        }
    }
    __syncthreads();
}

__global__ void __launch_bounds__(512, 2) mega(Params pa) {
    extern __shared__ __attribute__((aligned(16))) unsigned char shm[];
    LAS unsigned char* lds = (LAS unsigned char*)shm;
    const int G = gridDim.x, bid = blockIdx.x;
    KP* pk = (KP*)__builtin_amdgcn_kernarg_segment_ptr();
    volatile LAS unsigned* bst = (volatile LAS unsigned*)(lds + LDS_BYTES - 16);
    XcdBarrier xb; xb.bar = nullptr; xb.x = 0; xb.st = bst;
    if (pa.coop) { if (threadIdx.x < 2) bst[threadIdx.x] = 0u; __syncthreads(); xb = xcd_barrier_post((unsigned*)(pa.ws + W_BAR), bst); }
    for (int ph = pa.ph_lo; ph < pa.ph_hi; ++ph) {
        if (ph > pa.ph_lo && pa.coop) { if (pa.pad == 0x5a5a) { __threadfence(); cg::this_grid().sync(); } else xcd_barrier(xb); }
        asm volatile("" : "+s"(pk)); KP& p = *pk;
        if (ph == 0) { phase_prep(p, lds); continue; }
        if (ph == 42) { int tq = threadIdx.x; asm volatile("" : "+v"(tq)); const unsigned short* w16 = (const unsigned short*)p.ws; for (size_t i = (size_t)bid * 512 + tq; i < (size_t)59418624; i += (size_t)G * 512) p.out[i] = (float)w16[i * 4]; continue; }
        if (ph == 41) { int tq = threadIdx.x; asm volatile("" : "+v"(tq)); for (size_t i = (size_t)bid * 512 + tq; i < (size_t)59418624; i += (size_t)G * 512) { const float v = p.out[i]; if (!(fabsf(v) < 1e30f)) p.out[i] = 0.f; } continue; }
        const int l = (ph - 1) / 10, k = (ph - 1) % 10;
        bf16_t* XB = (bf16_t*)(p.ws + W_XB);
        switch (k) {
        case 0: if (REP_G1 > 1) { pg8::StaticOrder S; S.init(T_ALL, NPROJ, G, bid); EpiNull E{(float*)(p.ws + W_CD)};
                  pg8::gemm_phase(lds, pg8::Gemm{XB, (const bf16_t*)(p.ws + W_IN + l * W_IN_L), T_ALL, NPROJ, DM}, S, E); }
                { pg8::StaticOrder S; S.init(T_ALL, NPROJ, G, bid);
                  EpiIn E{(bf16_t*)(p.ws + W_PROJ), p.out, (float*)(p.ws + W_DTB), p.in[13], l};
                  pg8::gemm_phase(lds, pg8::Gemm{XB, (const bf16_t*)(p.ws + W_IN + l * W_IN_L), T_ALL, NPROJ, DM}, S, E); } break;
        case 1: {
                  unsigned* qctr = (unsigned*)(p.ws + W_BAR + 14336) + l * 64;
                  volatile LAS int* qslot = (volatile LAS int*)(lds + LDS_BYTES - 32);
                  for (;;) {
                      __syncthreads();
                      if (threadIdx.x == 0) qslot[0] = (int)__hip_atomic_fetch_add(qctr, 1u, __ATOMIC_RELAXED, __HIP_MEMORY_SCOPE_AGENT);
                      __syncthreads();
                      const int it = qslot[0];
                      if (it >= 2 * NU64) break;
                      if (it < NU64) attn_unit(p, lds, l, NU64 - 1 - it); else ssd_states(p, lds, l, it - NU64);
                  } } break;
        case 2: for (int it = bid; it < 96 + 768; it += G) { if (it < 96) scan_prompt(p, l, it); else scan_sample(p, l, it - 96); } break;
        case 3: {
                  unsigned* qctr = (unsigned*)(p.ws + W_BAR + 14336) + l * 64 + 32;
                  volatile LAS int* qslot = (volatile LAS int*)(lds + LDS_BYTES - 32);
                  for (;;) {
                      __syncthreads();
                      if (threadIdx.x == 0) qslot[0] = (int)__hip_atomic_fetch_add(qctr, 1u, __ATOMIC_RELAXED, __HIP_MEMORY_SCOPE_AGENT);
                      __syncthreads();
                      const int it = qslot[0];
                      if (it >= 2 * NU64) break;
                      if (it < NU64) ssd_y(p, lds, l, it); else gmlp_unit(p, lds, l, it - NU64);
                  } } break;
        case 4: { pg8::StaticOrder S; S.init(T_ALL, DM, G, bid); EpiRes E{p.out, XB, (bf16_t*)p.out};
                  pg8::gemm_phase(lds, pg8::Gemm{(const bf16_t*)(p.ws + W_MIX), (const bf16_t*)(p.ws + W_OUT + l * W_OUT_L), T_ALL, DM, DM}, S, E); } break;
        case 5: phase_ln(p, (const bf16_t*)p.out, p.in[20] + l * DM, p.in[21] + l * DM, false); break;
        case 6: for (int rep = 0; rep < REP_G3; ++rep) { pg8::StaticOrder S; S.init(T_ALL, DFF2, G, bid);
                  EpiUp E{(bf16_t*)(p.ws + W_PROJ), (float*)(p.ws + W_MIX), p.out, p.in[23], p.in[24], p.in[6], l};
                  pg8::OneUnit o1;
                  for (int i = 0; S.next(i, o1.u); ++i) { pg8::gemm_phase(lds, pg8::Gemm{XB, (const bf16_t*)(p.ws + W_UP + l * W_UP_L), T_ALL, DFF2, DM}, o1, E); __syncthreads(); } } break;
        case 7: phase_fix(p, l); break;
        case 8: { pg8::StaticOrder S; S.init(T_ALL, DM, G, bid); EpiRes E{p.out, XB, (bf16_t*)(p.ws + W_MIX)};
                  pg8::gemm_phase(lds, pg8::Gemm{(const bf16_t*)(p.ws + W_PROJ), (const bf16_t*)(p.ws + W_DN + l * W_DN_L), T_ALL, DM, DFF}, S, E); } break;
        case 9: phase_ln(p, (const bf16_t*)(p.ws + W_MIX), p.in[26] + l * DM, p.in[27] + l * DM, l == DEPTH - 1); break;
        }
    }
}

constexpr int N_PHASES = 41;
#ifndef MULTI_LAUNCH
#define MULTI_LAUNCH 0
#endif

extern "C" void kernel_launch(void* const* d_in, const int* in_sizes, int n_in, void* d_out, int out_size, void* d_ws, size_t ws_size, hipStream_t stream) {
    static int grid = 0;
    if (grid == 0) {
        if (n_in != 28 || ws_size < W_END2) { fprintf(stderr, "kernel_launch: need 28 inputs and %zu bytes of workspace (got %d, %zu)\n", (size_t)W_END2, n_in, ws_size); grid = -1; return; }
        int dev = 0, cus = 0, per_cu = 0;
        hipGetDevice(&dev); hipDeviceGetAttribute(&cus, hipDeviceAttributeMultiprocessorCount, dev);
        if (hipFuncSetAttribute((const void*)mega, hipFuncAttributeMaxDynamicSharedMemorySize, LDS_BYTES) != hipSuccess) { fprintf(stderr, "kernel_launch: hipFuncSetAttribute failed\n"); grid = -1; return; }
        hipOccupancyMaxActiveBlocksPerMultiprocessor(&per_cu, (const void*)mega, 512, LDS_BYTES);
        (void)hipGetLastError();
        if (per_cu < 1) per_cu = 1;
        grid = cus * 1;
    }
    if (grid < 0) return;
    Params p{};
    for (int i = 0; i < 28; ++i) p.in[i] = (const float*)d_in[i];
    p.out = (float*)d_out; p.ws = (unsigned char*)d_ws;
#if MULTI_LAUNCH
#ifdef PROBE_CUT
    for (int ph = 0; ph < PROBE_CUT; ++ph) { p.ph_lo = ph; p.ph_hi = ph + 1; p.coop = 0; hipLaunchKernelGGL(mega, dim3(grid), dim3(512), LDS_BYTES, stream, p); }
    p.ph_lo = 42; p.ph_hi = 43; p.coop = 0; hipLaunchKernelGGL(mega, dim3(grid), dim3(512), LDS_BYTES, stream, p);
#else
    for (int ph = 0; ph < N_PHASES; ++ph) { p.ph_lo = ph; p.ph_hi = ph + 1; p.coop = 0; hipLaunchKernelGGL(mega, dim3(grid), dim3(512), LDS_BYTES, stream, p); }
#endif
#else
    p.ph_lo = 0; p.ph_hi = N_PHASES; p.coop = 1;
    if (hipMemsetAsync((char*)d_ws + W_BAR, 0, 16384, stream) != hipSuccess) { fprintf(stderr, "kernel_launch: memset failed\n"); return; }
    void* args[] = {&p};
    hipError_t e = hipLaunchCooperativeKernel((const void*)mega, dim3(grid), dim3(512), args, LDS_BYTES, stream);
    if (e != hipSuccess) fprintf(stderr, "cooperative launch failed: %s (grid %d)\n", hipGetErrorString(e), grid);
#endif
}
```

```cpp
#define REP_G1 1
#define REP_M1 1
#define REP_ATT 1
#define REP_M3 1
#define REP_G3 1
#include <hip/hip_runtime.h>
#include <hip/hip_cooperative_groups.h>
#include <cstdio>
namespace cg = cooperative_groups;

#define LAS __attribute__((address_space(3)))
typedef unsigned short bf16_t;
typedef short bf16x8 __attribute__((ext_vector_type(8)));
typedef float f32x4 __attribute__((ext_vector_type(4)));
typedef float f32x2 __attribute__((ext_vector_type(2)));
typedef unsigned u32x4 __attribute__((ext_vector_type(4)));
typedef unsigned u32x2 __attribute__((ext_vector_type(2)));

constexpr int T_ALL = 34816, T_P = 32768, DM = 1024, NPROJ = 3072, DFF = 2816, DFF2 = 5632, DEPTH = 4;
constexpr int NU64 = 544;
constexpr float ALPHA = 1.6817928305074290f;
constexpr float LN_EPS = 1e-5f, RMS_EPS = 1e-5f;
constexpr int C_K = 384, C_V = 768, C_Z = 1152, C_XBC = 1536, C_U = 2432, C_VC = 2688, C_DT = 2944;
constexpr size_t O_YP = 0, O_YS = 33554432, O_PK = 35651584, O_PV = O_PK + 3145728, O_PH = O_PV + 3145728, O_PC = O_PH + 786432,
                 O_PF = O_PC + 43008, O_SK = O_PF + 180224, O_SV = O_SK + 3145728, O_SH = O_SV + 3145728, O_SC = O_SH + 6291456,
                 O_SG = O_SC + 344064, O_SF = O_SG + 2097152;
constexpr size_t W_IN = 0, W_IN_L = (size_t)NPROJ * DM * 2;
constexpr size_t W_OUT = W_IN + 4 * W_IN_L, W_OUT_L = (size_t)DM * DM * 2;
constexpr size_t W_UP = W_OUT + 4 * W_OUT_L, W_UP_L = (size_t)DFF2 * DM * 2;
constexpr size_t W_DN = W_UP + 4 * W_UP_L, W_DN_L = (size_t)DM * DFF * 2;
constexpr size_t W_GW = W_DN + 4 * W_DN_L, W_GW_L = (size_t)4 * 128 * 128 * 2;
constexpr size_t W_XB = W_GW + 4 * W_GW_L;
constexpr size_t W_PROJ = W_XB + (size_t)T_ALL * DM * 2;
constexpr size_t W_MIX = W_PROJ + (size_t)T_ALL * NPROJ * 2;
constexpr size_t W_ST = W_MIX + (size_t)T_ALL * DM * 2;
constexpr size_t W_CD = W_ST + (size_t)NU64 * 6 * 8192 * 2;
constexpr size_t W_DTB = W_CD + (size_t)NU64 * 8 * 4;
constexpr size_t W_END = W_DTB + (size_t)T_ALL * 8 * 4;
constexpr size_t W_BAR = W_END;
constexpr size_t W_END2 = W_BAR + 16384;
constexpr int LDS_BYTES = 156 * 1024;

struct Params { const float* in[28]; float* out; unsigned char* ws; int ph_lo, ph_hi, coop, pad; };
typedef const __attribute__((address_space(4))) Params KP;

__device__ __forceinline__ float bf2f(unsigned b) { return __uint_as_float(b << 16); }
typedef __bf16 bf16v2 __attribute__((ext_vector_type(2)));
__device__ __forceinline__ unsigned cvt_pk_bf16(float lo, float hi) { const f32x2 v = {lo, hi}; const bf16v2 b = __builtin_convertvector(v, bf16v2); return __builtin_bit_cast(unsigned, b); }
__device__ __forceinline__ u32x2 pack4(f32x4 v) { u32x2 w; w.x = cvt_pk_bf16(v[0], v[1]); w.y = cvt_pk_bf16(v[2], v[3]); return w; }
__device__ __forceinline__ f32x4 unpack4(u32x2 w) { f32x4 v; v[0] = bf2f(w.x & 0xffffu); v[1] = bf2f(w.x >> 16); v[2] = bf2f(w.y & 0xffffu); v[3] = bf2f(w.y >> 16); return v; }
__device__ __forceinline__ float silu_f(float x) { return x * __builtin_amdgcn_rcpf(1.0f + __expf(-x)); }
__device__ __forceinline__ float gelu_tanh(float x) { const float y = 0.7978845608028654f * (x + 0.044715f * x * x * x); const float e = __expf(2.0f * y); return 0.5f * x * (2.0f - 2.0f * __builtin_amdgcn_rcpf(1.0f + e)); }
__device__ __forceinline__ float softplus_f(float x) { const float e = __expf(x); return x > 15.0f ? x : (e < 1e-3f ? e * (1.0f - 0.5f * e + 0.33333333f * e * e) : __logf(1.0f + e)); }
#define MFMA16(colfrag, rowfrag, acc) __builtin_amdgcn_mfma_f32_16x16x32_bf16((colfrag), (rowfrag), (acc), 0, 0, 0)
__device__ __forceinline__ bf16x8 ldsfrag(LAS const unsigned char* p) { return *(LAS const bf16x8*)p; }
__device__ __forceinline__ bf16x8 glbfrag(const bf16_t* p) { return *(const bf16x8*)p; }
#define LDS_WAVE_SYNC() asm volatile("s_waitcnt lgkmcnt(0)" ::: "memory")

namespace pg8 {
constexpr int BM = 256, BK = 64, HALF = 128, HTB = HALF * BK * 2, STAGE_BYTES = 8 * HTB, NXCD = 8, WGM = 8;
__device__ __forceinline__ int lds_byte(int r, int c) { const int st = (r >> 4) * 2 + (c >> 5), rr = r & 15, cc = c & 31, ob = rr * 64 + cc * 2; return st * 1024 + (ob ^ (((ob >> 9) & 1) << 5)); }
__device__ __forceinline__ void stage_rc(int b, int& R, int& C) { const int st = b / 1024, sb = b % 1024, swz = sb ^ (((sb >> 9) & 1) << 5); R = (st >> 1) * 16 + swz / 64; C = (st & 1) * 32 + (swz % 64) / 2; }
__device__ __forceinline__ int perm32(int rho) { const int n = rho >> 4, i = rho & 15; return 8 * (i >> 2) + 4 * n + (i & 3); }
struct Unit { int pm, pn; };
struct Gemm { const bf16_t* A; const bf16_t* Bt; int M, N, K; };
struct StaticOrder {
    int nM, nN, nwg, G, c;
    __device__ __forceinline__ void init(int M, int N, int G_, int c_) { nM = M / BM; nN = N / BM; nwg = nM * nN; G = G_; c = c_; }
    __device__ __forceinline__ bool next(int i, Unit& u) const {
        const long L = (long)i * G + c; if (L >= nwg) return false;
        int wgid = (int)L; { const int q = nwg / NXCD, r = nwg % NXCD, xcd = wgid % NXCD, off = wgid / NXCD; wgid = (xcd < r ? xcd * (q + 1) : r * (q + 1) + (xcd - r) * q) + off; }
        const int nig = WGM * nN, gid = wgid / nig, fm = gid * WGM, gsz = (nM - fm) < WGM ? (nM - fm) : WGM;
        u.pm = fm + ((wgid % nig) % gsz); u.pn = (wgid % nig) / gsz; return true;
    }
    __device__ __forceinline__ void a_ready(const Unit&) const {}
    __device__ __forceinline__ void done(const Unit&) const {}
};
struct OneUnit {
    Unit u;
    __device__ __forceinline__ bool next(int i, Unit& o) const { if (i) return false; o = u; return true; }
    __device__ __forceinline__ void a_ready(const Unit&) const {}
    __device__ __forceinline__ void done(const Unit&) const {}
};

template <class Epi, class Sched>
__device__ __forceinline__ void gemm_phase(LAS unsigned char* lds, const Gemm g, const Sched& S, const Epi& E) {
    int tid_ = threadIdx.x; asm volatile("" : "+v"(tid_));
    const int tid = tid_, wid = __builtin_amdgcn_readfirstlane(tid >> 6), lane = tid & 63, wr = wid >> 2, wc = wid & 3, fr = lane & 15, fq = lane >> 4;
    const int K = g.K, nt = K / BK;
    unsigned voffA[2], voffB[2];
#pragma unroll
    for (int i = 0; i < 2; ++i) { int R, C; stage_rc(tid * 16 + i * 8192, R, C); const int Rb = (R & ~31) + perm32(R & 31); voffA[i] = (unsigned)(R * K + C) * 2u; voffB[i] = (unsigned)(Rb * K + C) * 2u; }
    const size_t kstep = (size_t)(BK * 2);
    const size_t hstep = (size_t)HALF * K * 2;
    const size_t tstep = 2 * hstep;
    const unsigned ldsw = (unsigned)wid * 1024u;
    const int aoff = lds_byte(wr * 64 + fr, fq * 8), boff = lds_byte(wc * 32 + fr, fq * 8);
#define PG8_SA(b, h) (((b) * 2 + (h)) * HTB)
#define PG8_SB(b, h) ((4 + (b) * 2 + (h)) * HTB)
#define PG8_STAGE(bufoff, gbase, voff) do { _Pragma("unroll") for (int _i = 0; _i < 2; ++_i) \
        __builtin_amdgcn_global_load_lds((const unsigned*)((const char*)(gbase) + (voff)[_i]), (LAS unsigned*)(lds + (bufoff) + ldsw + _i * 8192), 16, 0, 0); } while (0)
#define PG8_LDA(dst, b, h) do { _Pragma("unroll") for (int m = 0; m < 4; ++m) _Pragma("unroll") for (int k = 0; k < 2; ++k) dst[m][k] = *(const LAS bf16x8*)(lds + PG8_SA(b, h) + aoff + m * 2048 + k * 1024); } while (0)
#define PG8_LDB(dst, b, h) do { _Pragma("unroll") for (int n = 0; n < 2; ++n) _Pragma("unroll") for (int k = 0; k < 2; ++k) dst[n][k] = *(const LAS bf16x8*)(lds + PG8_SB(b, h) + boff + n * 2048 + k * 1024); } while (0)
#define PG8_MMA(ai, bj, At, Bt) do { __builtin_amdgcn_s_setprio(1); _Pragma("unroll") for (int m = 0; m < 4; ++m) _Pragma("unroll") for (int n = 0; n < 2; ++n) _Pragma("unroll") for (int k = 0; k < 2; ++k) \
        acc[ai][bj][m][n] = __builtin_amdgcn_mfma_f32_16x16x32_bf16(Bt[n][k], At[m][k], acc[ai][bj][m][n], 0, 0, 0); __builtin_amdgcn_s_setprio(0); } while (0)
#define PG8_WAIT_V(n) asm volatile("s_waitcnt vmcnt(" #n ")" ::: "memory")
#define PG8_WAIT_L(n) asm volatile("s_waitcnt lgkmcnt(" #n ")" ::: "memory")
#define PG8_BAR __builtin_amdgcn_s_barrier()
#define PG8_SCHED __builtin_amdgcn_sched_barrier(0)
    Unit cur, nxt; int ui = 0;
    if (!S.next(0, cur)) return;
    f32x4 acc[2][2][4][2];
#pragma unroll
    for (int a = 0; a < 2; ++a)
#pragma unroll
        for (int b = 0; b < 2; ++b)
#pragma unroll
            for (int m = 0; m < 4; ++m)
#pragma unroll
                for (int n = 0; n < 2; ++n) acc[a][b][m][n] = (f32x4){0.f, 0.f, 0.f, 0.f};
    bf16x8 At[4][2], B0[2][2], B1[2][2];
    const char* cA = (const char*)g.A + (size_t)cur.pm * tstep; const char* cB = (const char*)g.Bt + (size_t)cur.pn * tstep;
    S.a_ready(cur);
    PG8_STAGE(PG8_SB(0, 0), cB, voffB); PG8_STAGE(PG8_SA(0, 0), cA, voffA); PG8_STAGE(PG8_SB(0, 1), cB + hstep, voffB); PG8_STAGE(PG8_SA(0, 1), cA + hstep, voffA);
    if (wr == 1) PG8_BAR;
    PG8_WAIT_V(4); PG8_BAR;
    PG8_STAGE(PG8_SB(1, 0), cB + kstep, voffB); PG8_STAGE(PG8_SA(1, 0), cA + kstep, voffA); PG8_STAGE(PG8_SB(1, 1), cB + hstep + kstep, voffB);
    PG8_WAIT_V(6); PG8_BAR;
    for (;;) {
        const bool has_next = S.next(ui + 1, nxt);
        const char* nA = has_next ? (const char*)g.A + (size_t)nxt.pm * tstep : cA; const char* nB = has_next ? (const char*)g.Bt + (size_t)nxt.pn * tstep : cB;
        for (int t = 0; t < nt; t += 2) {
            const bool last = (t == nt - 2);
            const char* a1 = cA + (size_t)(t + 1) * kstep;
            const char* a2 = last ? nA : cA + (size_t)(t + 2) * kstep; const char* b2 = last ? nB : cB + (size_t)(t + 2) * kstep;
            const char* a3 = a2 + kstep; const char* b3 = b2 + kstep;
            if (last && has_next) S.a_ready(nxt);
            PG8_LDB(B0, 0, 0); PG8_SCHED; PG8_LDA(At, 0, 0); PG8_STAGE(PG8_SA(1, 1), a1 + hstep, voffA);
            PG8_WAIT_L(8); PG8_BAR; PG8_WAIT_L(0); PG8_MMA(0, 0, At, B0); PG8_BAR; PG8_SCHED;
            PG8_LDB(B1, 0, 1); PG8_STAGE(PG8_SB(0, 0), b2, voffB);
            PG8_BAR; PG8_WAIT_L(0); PG8_MMA(0, 1, At, B1); PG8_BAR;
            PG8_LDA(At, 0, 1); PG8_STAGE(PG8_SA(0, 0), a2, voffA);
            PG8_BAR; PG8_WAIT_L(0); PG8_MMA(1, 0, At, B0); PG8_BAR; PG8_SCHED;
            PG8_STAGE(PG8_SB(0, 1), b2 + hstep, voffB);
            PG8_WAIT_V(6); PG8_BAR; PG8_MMA(1, 1, At, B1); PG8_BAR;
            PG8_LDB(B0, 1, 0); PG8_SCHED; PG8_LDA(At, 1, 0); PG8_STAGE(PG8_SA(0, 1), a2 + hstep, voffA);
            PG8_WAIT_L(8); PG8_BAR; PG8_WAIT_L(0); PG8_MMA(0, 0, At, B0); PG8_BAR; PG8_SCHED;
            PG8_LDB(B1, 1, 1); PG8_STAGE(PG8_SB(1, 0), b3, voffB);
            PG8_BAR; PG8_WAIT_L(0); PG8_MMA(0, 1, At, B1); PG8_BAR;
            PG8_LDA(At, 1, 1); PG8_STAGE(PG8_SA(1, 0), a3, voffA);
            PG8_BAR; PG8_WAIT_L(0); PG8_MMA(1, 0, At, B0); PG8_BAR; PG8_SCHED;
            PG8_STAGE(PG8_SB(1, 1), b3 + hstep, voffB);
            PG8_WAIT_V(6); PG8_BAR; PG8_MMA(1, 1, At, B1); PG8_BAR;
        }
        if constexpr (!Epi::AFTER_DRAIN) { E(acc, cur, wr, wc, fr, fq); S.done(cur); }
        if (!has_next) break;
#pragma unroll
        for (int a = 0; a < 2; ++a)
#pragma unroll
            for (int b = 0; b < 2; ++b)
#pragma unroll
                for (int m = 0; m < 4; ++m)
#pragma unroll
                    for (int n = 0; n < 2; ++n) acc[a][b][m][n] = (f32x4){0.f, 0.f, 0.f, 0.f};
        cur = nxt; cA = nA; cB = nB; ++ui;
    }
    PG8_WAIT_V(0);
    if (wr == 0) PG8_BAR;
    PG8_BAR;
    if constexpr (Epi::AFTER_DRAIN) { E.fused(acc, cur, wr, wc, fr, fq, lds, wid, lane); S.done(cur); }
#undef PG8_SA
#undef PG8_SB
#undef PG8_STAGE
#undef PG8_LDA
#undef PG8_LDB
#undef PG8_MMA
#undef PG8_WAIT_V
#undef PG8_WAIT_L
#undef PG8_BAR
#undef PG8_SCHED
}
}
using pg8::Unit;

struct EpiIn {
    static constexpr bool AFTER_DRAIN = false;
    bf16_t* proj; float* out; float* dtb; const float* dt_bias; int l;
    __device__ __forceinline__ void operator()(const f32x4 (&acc)[2][2][4][2], const Unit& u, int wr, int wc, int fr_, int fq_) const {
        int fr = fr_, fq = fq_; asm volatile("" : "+v"(fr), "+v"(fq));
#pragma unroll
        for (int bj = 0; bj < 2; ++bj) {
            const int cb = u.pn * 256 + bj * 128;
            const int col = cb + wc * 32 + fq * 8;
            if (cb > C_DT) continue;
#pragma unroll
            for (int ai = 0; ai < 2; ++ai)
#pragma unroll
                for (int m = 0; m < 4; ++m) {
                    const int row = u.pm * 256 + ai * 128 + wr * 64 + m * 16 + fr;
                    const bool isP = row < T_P; int b, t;
                    if (isP) { b = row >> 13; t = row & 8191; } else { b = (row - T_P) >> 6; t = row & 63; }
                    f32x4 v0 = acc[ai][bj][m][0], v1 = acc[ai][bj][m][1];
                    if (cb < C_U) {
                        u32x4 w; { const u32x2 a = pack4(v0), c = pack4(v1); w.x = a.x; w.y = a.y; w.z = c.x; w.w = c.y; }
                        *(u32x4*)(proj + (size_t)row * NPROJ + col) = w;
                        if (cb >= C_K && cb < C_Z) {
                            const int isv = cb >= C_V; const int cc = col - (isv ? C_V : C_K);
                            float* o = nullptr;
                            if (isP) { if (t >= 7680) o = out + (isv ? O_PV : O_PK) + ((size_t)(l * 4 + b) * 512 + (t - 7680)) * 384 + cc; }
                            else o = out + (isv ? O_SV : O_SK) + ((size_t)(l * 32 + b) * 64 + t) * 384 + cc;
                            if (o) { *(f32x4*)o = v0; *(f32x4*)(o + 4) = v1; }
                        } else if (cb >= C_XBC) {
                            const int cc = col - C_XBC; float* o = nullptr;
                            if (isP) { if (t >= 8189) o = out + O_PC + ((size_t)(l * 4 + b) * 3 + (t - 8189)) * 896 + cc; }
                            else if (t >= 61) o = out + O_SC + ((size_t)(l * 32 + b) * 3 + (t - 61)) * 896 + cc;
                            if (o) { *(f32x4*)o = v0; *(f32x4*)(o + 4) = v1; }
                        }
                    } else if (cb < C_DT) {
#pragma unroll
                        for (int j = 0; j < 4; ++j) { v0[j] = gelu_tanh(v0[j]); v1[j] = gelu_tanh(v1[j]); }
                        u32x4 w; { const u32x2 a = pack4(v0), c = pack4(v1); w.x = a.x; w.y = a.y; w.z = c.x; w.w = c.y; }
                        *(u32x4*)(proj + (size_t)row * NPROJ + col) = w;
                        if (cb >= C_VC && !isP) { float* o = out + O_SG + ((size_t)(l * 32 + b) * 64 + t) * 256 + (col - C_VC); *(f32x4*)o = v0; *(f32x4*)(o + 4) = v1; }
                    } else if (col == C_DT) {
                        float* d = dtb + (size_t)row * 8;
#pragma unroll
                        for (int j = 0; j < 4; ++j) d[j] = softplus_f(v0[j] + dt_bias[l * 6 + j]);
#pragma unroll
                        for (int j = 0; j < 2; ++j) d[4 + j] = softplus_f(v1[j] + dt_bias[l * 6 + 4 + j]);
                    }
                    asm volatile("" ::: "memory");
                }
        }
    }
};
struct EpiNull {
    static constexpr bool AFTER_DRAIN = false;
    float* sink;
    __device__ __forceinline__ void operator()(const f32x4 (&acc)[2][2][4][2], const Unit& u, int wr, int wc, int fr, int fq) const {
        float t = 0.f;
#pragma unroll
        for (int ai = 0; ai < 2; ++ai)
#pragma unroll
            for (int bj = 0; bj < 2; ++bj)
#pragma unroll
                for (int m = 0; m < 4; ++m)
#pragma unroll
                    for (int n = 0; n < 2; ++n) t += acc[ai][bj][m][n][0] + acc[ai][bj][m][n][1] + acc[ai][bj][m][n][2] + acc[ai][bj][m][n][3];
        if (t == 123456.789f) sink[0] = t;
    }
};
struct EpiRes {
    static constexpr bool AFTER_DRAIN = false;
    float* x; const bf16_t* xb; bf16_t* rdst;
    __device__ __forceinline__ void operator()(const f32x4 (&acc)[2][2][4][2], const Unit& u, int wr, int wc, int fr_, int fq_) const {
        int fr = fr_, fq = fq_; asm volatile("" : "+v"(fr), "+v"(fq));
#pragma unroll
        for (int ai = 0; ai < 2; ++ai)
#pragma unroll
            for (int m = 0; m < 4; ++m) {
                float* rowp = x + (size_t)(u.pm * 256 + ai * 128 + wr * 64 + m * 16 + fr) * DM + u.pn * 256 + wc * 32 + fq * 8;
#pragma unroll
                for (int bj = 0; bj < 2; ++bj) { float* q = rowp + bj * 128; const u32x4 xw = *(const u32x4*)(xb + (q - x));
                    const f32x4 o0 = unpack4((u32x2){xw.x, xw.y}), o1 = unpack4((u32x2){xw.z, xw.w});
                    const u32x2 ra = pack4(o0 * ALPHA + acc[ai][bj][m][0]), rb = pack4(o1 * ALPHA + acc[ai][bj][m][1]);
                    *(u32x4*)(rdst + (q - x)) = (u32x4){ra.x, ra.y, rb.x, rb.y}; }
                asm volatile("" ::: "memory");
            }
    }
};
struct EpiUp {
    static constexpr bool AFTER_DRAIN = true;
    bf16_t* H; float* halo; float* out; const float* cw; const float* cb; const float* fstate; int l;
    __device__ __forceinline__ void operator()(const f32x4 (&)[2][2][4][2], const Unit&, int, int, int, int) const {}
    __device__ __forceinline__ void fused(f32x4 (&acc)[2][2][4][2], const Unit& u, int wr, int wc, int fr, int fq, LAS unsigned char* lds, int wid, int lane) const {
        constexpr int LS = 264;
#pragma unroll
        for (int ai = 0; ai < 2; ++ai)
#pragma unroll
            for (int m = 0; m < 4; ++m)
#pragma unroll
                for (int bj = 0; bj < 2; ++bj) {
                        const int rl = ai * 128 + wr * 64 + m * 16 + fr, cl = bj * 128 + wc * 32 + fq * 8;
                        u32x4 w; { const u32x2 a = pack4(acc[ai][bj][m][0]), c = pack4(acc[ai][bj][m][1]); w.x = a.x; w.y = a.y; w.z = c.x; w.w = c.y; }
                        *(LAS u32x4*)(lds + (rl * LS + cl) * 2) = w;
                    }
        __syncthreads();
        const int tid = wid * 64 + lane, j = 2 * (tid & 63), seg = tid >> 6;
        const int hcol = u.pn * 128 + j;
        const float* w = cw + (size_t)l * 3 * DFF2 + hcol; const float* bb = cb + (size_t)l * DFF2 + hcol;
        const f32x2 wg0 = *(const f32x2*)w, wg1 = *(const f32x2*)(w + DFF2), wg2 = *(const f32x2*)(w + 2 * DFF2), bg = *(const f32x2*)bb;
        const f32x2 wv0 = *(const f32x2*)(w + DFF), wv1 = *(const f32x2*)(w + DFF2 + DFF), wv2 = *(const f32x2*)(w + 2 * DFF2 + DFF), bv = *(const f32x2*)(bb + DFF);
        const int r0 = seg * 32, R = u.pm * 256 + r0;
        const bool isP = R < T_P;
        const LAS unsigned char* U = (const LAS unsigned char*)lds;
#define UP2(row, off) ({ const unsigned w_ = *(const LAS unsigned*)(U + ((row) * LS + (off) + j) * 2); (f32x2){bf2f(w_ & 0xffffu), bf2f(w_ >> 16)}; })
        f32x2 g2 = (f32x2){0.f, 0.f}, g1 = g2, v2 = g2, v1 = g2; int skip = 0;
        if (isP) {
            if (seg > 0) { g2 = UP2(r0 - 2, 0); g1 = UP2(r0 - 1, 0); v2 = UP2(r0 - 2, 128); v1 = UP2(r0 - 1, 128); }
            else if ((R & 8191) != 0) skip = 2;
        } else if (seg & 1) { g2 = UP2(r0 - 2, 0); g1 = UP2(r0 - 1, 0); v2 = UP2(r0 - 2, 128); v1 = UP2(r0 - 1, 128); }
        else { const int sb = (R - T_P) >> 6; const float* fs = fstate + (size_t)(l * 32 + sb) * 2 * DFF2 + hcol;
            g2 = *(const f32x2*)fs; g1 = *(const f32x2*)(fs + DFF2); v2 = *(const f32x2*)(fs + DFF); v1 = *(const f32x2*)(fs + DFF2 + DFF); }
        bf16_t* hp = H + (size_t)R * DFF + hcol;
#pragma unroll 8
        for (int i = 0; i < 32; ++i) {
            const f32x2 gq = UP2(r0 + i, 0), vq = UP2(r0 + i, 128);
            if (i >= skip) {
                const f32x2 cgv = bg + wg0 * g2 + wg1 * g1 + wg2 * gq, cvv = bv + wv0 * v2 + wv1 * v1 + wv2 * vq;
                *(unsigned*)(hp + (size_t)i * DFF) = cvt_pk_bf16(silu_f(cgv[0]) * cvv[0], silu_f(cgv[1]) * cvv[1]);
            }
            g2 = g1; g1 = gq; v2 = v1; v1 = vq;
            if (isP) {
                if (seg == 0 && i < 2) { float* hl = halo + ((size_t)u.pm * 4 + i) * DFF2 + hcol; *(f32x2*)hl = gq; *(f32x2*)(hl + DFF) = vq; }
                if (seg == 7 && i >= 30) { float* hl = halo + ((size_t)u.pm * 4 + 2 + (i - 30)) * DFF2 + hcol; *(f32x2*)hl = gq; *(f32x2*)(hl + DFF) = vq;
                    if ((u.pm & 31) == 31) { float* o = out + O_PF + ((size_t)(l * 4 + (u.pm >> 5)) * 2 + (i - 30)) * DFF2 + hcol; *(f32x2*)o = gq; *(f32x2*)(o + DFF) = vq; } }
            } else if ((seg & 1) && i >= 30) {
                const int sb = (R - 32 - T_P) >> 6; float* o = out + O_SF + ((size_t)(l * 32 + sb) * 2 + (i - 30)) * DFF2 + hcol; *(f32x2*)o = gq; *(f32x2*)(o + DFF) = vq;
            }
        }
#undef UP2
    }
};

__device__ __forceinline__ void ln_row(const float* src, const bf16_t* srcb, float* x32, bf16_t* xb, const float* g, const float* b, int lane) {
    f32x4 v[4]; float s = 0.f;
#pragma unroll
    for (int i = 0; i < 4; ++i) { v[i] = srcb ? unpack4(*(const u32x2*)(srcb + i * 256 + lane * 4)) : *(const f32x4*)(src + i * 256 + lane * 4); s += (v[i][0] + v[i][1]) + (v[i][2] + v[i][3]); }
#pragma unroll
    for (int o = 32; o >= 1; o >>= 1) s += __shfl_xor(s, o);
    const float mu = s * (1.0f / 1024.0f); float q = 0.f;
#pragma unroll
    for (int i = 0; i < 4; ++i) { const f32x4 d = v[i] - mu; q += (d[0] * d[0] + d[1] * d[1]) + (d[2] * d[2] + d[3] * d[3]); }
#pragma unroll
    for (int o = 32; o >= 1; o >>= 1) q += __shfl_xor(q, o);
    const float rstd = 1.0f / sqrtf(q * (1.0f / 1024.0f) + LN_EPS);
#pragma unroll
    for (int i = 0; i < 4; ++i) {
        const f32x4 gg = *(const f32x4*)(g + i * 256 + lane * 4), bb = *(const f32x4*)(b + i * 256 + lane * 4);
        const f32x4 o = (v[i] - mu) * rstd * gg + bb;
        if (x32) *(f32x4*)(x32 + i * 256 + lane * 4) = o;
        if (xb) *(u32x2*)(xb + i * 256 + lane * 4) = pack4(o);
    }
}

__device__ __forceinline__ void tr_tile(LAS float* tile, const float* src, int Nsrc, bf16_t* dst, int K, int n0, int k0, int mode, int tid) {
    const int nn = tid & 63, np = n0 + nn; int sc;
    if (mode == 0) sc = np < C_U ? np : (np < C_DT ? np + 6 : (np < C_DT + 6 ? np - 512 : -1));
    else if (mode == 1) sc = np;
    else { const int pn = np >> 8, jj = np & 255; sc = jj < 128 ? pn * 128 + jj : DFF + pn * 128 + (jj - 128); }
#pragma unroll
    for (int i = 0; i < 8; ++i) { const int kk = (tid >> 6) + 8 * i; tile[kk * 65 + nn] = sc >= 0 ? src[(size_t)(k0 + kk) * Nsrc + sc] : 0.f; }
    __syncthreads();
    const int kk2 = (tid & 31) * 2;
#pragma unroll
    for (int i = 0; i < 4; ++i) { const int nn2 = (tid >> 5) + 16 * i; *(unsigned*)(dst + (size_t)(n0 + nn2) * K + k0 + kk2) = cvt_pk_bf16(tile[kk2 * 65 + nn2], tile[(kk2 + 1) * 65 + nn2]); }
    __syncthreads();
}

__device__ __forceinline__ void phase_prep(KP& p, LAS unsigned char* lds) {
    int tid_ = threadIdx.x; asm volatile("" : "+v"(tid_));
    const int tid = tid_, wid = tid >> 6, lane = tid & 63;
    for (int row = blockIdx.x * 8 + wid; row < T_ALL; row += gridDim.x * 8) {
        const float* src = row < T_P ? p.in[0] + (size_t)row * DM : p.in[1] + (size_t)(row - T_P) * DM;
        ln_row(src, nullptr, nullptr, (bf16_t*)(p.ws + W_XB) + (size_t)row * DM, p.in[7], p.in[8], lane);
    }
    constexpr int T_IN = 48 * 16, T_OUT = 16 * 16, T_UPT = 88 * 16, T_DNT = 16 * 44, T_L = T_IN + T_OUT + T_UPT + T_DNT;
    for (int it = blockIdx.x; it < 4 * T_L; it += gridDim.x) {
        const int l = it / T_L; int r = it % T_L;
        if (r < T_IN) tr_tile((LAS float*)lds, p.in[9] + (size_t)l * DM * 2950, 2950, (bf16_t*)(p.ws + W_IN + l * W_IN_L), DM, (r >> 4) * 64, (r & 15) * 64, 0, tid);
        else if ((r -= T_IN) < T_OUT) tr_tile((LAS float*)lds, p.in[19] + (size_t)l * DM * DM, DM, (bf16_t*)(p.ws + W_OUT + l * W_OUT_L), DM, (r >> 4) * 64, (r & 15) * 64, 1, tid);
        else if ((r -= T_OUT) < T_UPT) tr_tile((LAS float*)lds, p.in[22] + (size_t)l * DM * DFF2, DFF2, (bf16_t*)(p.ws + W_UP + l * W_UP_L), DM, (r >> 4) * 64, (r & 15) * 64, 2, tid);
        else { r -= T_UPT; tr_tile((LAS float*)lds, p.in[25] + (size_t)l * DFF * DM, DM, (bf16_t*)(p.ws + W_DN + l * W_DN_L), DFF, (r / 44) * 64, (r % 44) * 64, 1, tid); }
    }
    for (int i = blockIdx.x * 512 + tid; i < 4 * 4 * 128 * 128; i += gridDim.x * 512) {
        const int jj = i & 127, ii = (i >> 7) & 127;
        ((bf16_t*)(p.ws + W_GW))[i] = (bf16_t)(cvt_pk_bf16(jj <= ii ? p.in[16][i] : 0.f, 0.f) & 0xffffu);
    }
}

__device__ __forceinline__ void phase_ln(KP& p, const bf16_t* rsrc, const float* g, const float* b, bool final_out) {
    int tid_ = threadIdx.x; asm volatile("" : "+v"(tid_));
    const int wid = tid_ >> 6, lane = tid_ & 63;
    for (int row = blockIdx.x * 8 + wid; row < T_ALL; row += gridDim.x * 8)
        ln_row(nullptr, rsrc + (size_t)row * DM, final_out ? p.out + (size_t)row * DM : nullptr, final_out ? nullptr : (bf16_t*)(p.ws + W_XB) + (size_t)row * DM, g, b, lane);
}

__device__ __forceinline__ void dt_scan(KP& p, int l, int u, int g, int wid, int lane, float& dt, float& ac, float& last) {
    const int h = g * 3 + wid;
    dt = ((const float*)(p.ws + W_DTB))[(size_t)(u * 64 + lane) * 8 + h];
    const float a = -__expf(p.in[14][l * 6 + h]);
    float v = dt * a;
#pragma unroll
    for (int o = 1; o < 64; o <<= 1) { const float t = __shfl_up(v, o); if (lane >= o) v += t; }
    ac = v; last = __shfl(v, 63);
}

__device__ __forceinline__ f32x4 xbc_row(KP& p, int l, int u, int s, int ch) {
    const bf16_t* proj = (const bf16_t*)(p.ws + W_PROJ);
    const bool isP = u < 512; const bool hasprev = isP && (u & 127) != 0;
    if (s >= 0 || hasprev) return unpack4(*(const u32x2*)(proj + (size_t)(u * 64 + s) * NPROJ + C_XBC + ch));
    if (!isP) return *(const f32x4*)(p.in[5] + (unsigned)(((l * 32 + (u - 512)) * 3 + (3 + s)) * 896 + ch));
    return (f32x4){0.f, 0.f, 0.f, 0.f};
}
__device__ __forceinline__ void ssd_states(KP& p, LAS unsigned char* lds, int l, int u) {
    int tid_ = threadIdx.x; asm volatile("" : "+v"(tid_));
    const int tid = tid_, wid = tid >> 6, lane = tid & 63, fr = lane & 15, fq = lane >> 4;
    LAS bf16_t* xT = (LAS bf16_t*)lds;
    LAS bf16_t* BT = (LAS bf16_t*)(lds + 55296);
    LAS float* wgt = (LAS float*)(lds + 92160);
    bf16_t* XC = (bf16_t*)p.out;
    __syncthreads();
    if (wid < 6) {
        float dt, ac, last; dt_scan(p, l, u, wid / 3, wid % 3, lane, dt, ac, last);
        wgt[wid * 64 + lane] = dt * __expf(last - ac);
        if (lane == 0) ((float*)(p.ws + W_CD))[u * 8 + wid] = __expf(last);
    }
    __syncthreads();
    if (tid < 448) {
        const int cgp = tid % 224, seg = tid / 224, ch = cgp * 4, r0 = seg * 32;
        const float* cw = p.in[11] + (size_t)l * 4 * 896 + ch;
        const f32x4 w0 = *(const f32x4*)cw, w1 = *(const f32x4*)(cw + 896), w2 = *(const f32x4*)(cw + 2 * 896), w3 = *(const f32x4*)(cw + 3 * 896);
        const f32x4 bs = *(const f32x4*)(p.in[12] + (size_t)l * 896 + ch);
        f32x4 xm3 = xbc_row(p, l, u, r0 - 3, ch), xm2 = xbc_row(p, l, u, r0 - 2, ch), xm1 = xbc_row(p, l, u, r0 - 1, ch);
        const bf16_t* src = (const bf16_t*)(p.ws + W_PROJ) + (size_t)(u * 64) * NPROJ + C_XBC + ch;
        bf16_t* dst = XC + (size_t)(u * 64) * 896 + ch;
        const int hh = ch >> 6;
#pragma unroll 2
        for (int i = r0; i < r0 + 32; i += 2) {
            const f32x4 xa = unpack4(*(const u32x2*)(src + (size_t)i * NPROJ)), xb = unpack4(*(const u32x2*)(src + (size_t)(i + 1) * NPROJ));
            f32x4 ya = bs + w0 * xm3 + w1 * xm2 + w2 * xm1 + w3 * xa, yb = bs + w0 * xm2 + w1 * xm1 + w2 * xa + w3 * xb;
#pragma unroll
            for (int e = 0; e < 4; ++e) { ya[e] = silu_f(ya[e]); yb[e] = silu_f(yb[e]); }
            xm3 = xm1; xm2 = xa; xm1 = xb;
            *(u32x2*)(dst + (size_t)i * 896) = pack4(ya); *(u32x2*)(dst + (size_t)(i + 1) * 896) = pack4(yb);
            if (ch < 384) { const float wa = wgt[hh * 64 + i], wb = wgt[hh * 64 + i + 1];
#pragma unroll
                for (int e = 0; e < 4; ++e) *(LAS unsigned*)(xT + (ch + e) * 72 + i) = cvt_pk_bf16(ya[e] * wa, yb[e] * wb); }
            else if (ch < 640) {
#pragma unroll
                for (int e = 0; e < 4; ++e) *(LAS unsigned*)(BT + (ch - 384 + e) * 72 + i) = cvt_pk_bf16(ya[e], yb[e]); }
        }
    }
    __syncthreads();
    bf16_t* ST = (bf16_t*)(p.ws + W_ST);
#pragma unroll 2
    for (int k = 0; k < 24; ++k) {
        const int tt = wid * 24 + k, h = tt >> 5, pt = (tt & 31) >> 3, nt = tt & 7, g = h / 3;
        f32x4 acc = (f32x4){0.f, 0.f, 0.f, 0.f};
#pragma unroll
        for (int ks = 0; ks < 2; ++ks) {
            const bf16x8 rf = ldsfrag((LAS const unsigned char*)(xT + (h * 64 + pt * 16 + fr) * 72 + ks * 32 + fq * 8));
            const bf16x8 cf = ldsfrag((LAS const unsigned char*)(BT + (g * 128 + nt * 16 + fr) * 72 + ks * 32 + fq * 8));
            acc = MFMA16(cf, rf, acc);
        }
        *(u32x2*)(ST + ((size_t)(u * 6 + h) * 64 + pt * 16 + fr) * 128 + nt * 16 + fq * 4) = pack4(acc);
    }
}

__device__ __forceinline__ void gmlp_unit(KP& p, LAS unsigned char* lds, int l, int u) {
    int tid_ = threadIdx.x; asm volatile("" : "+v"(tid_));
    const int tid = tid_, wid = tid >> 6, lane = tid & 63, fr = lane & 15, fq = lane >> 4;
    LAS bf16_t* vT = (LAS bf16_t*)lds;
    LAS float* ssq = (LAS float*)(lds + 69632);
    const bf16_t* proj = (const bf16_t*)(p.ws + W_PROJ);
    const int half = u < 512 ? (u & 1) : 0, KJ = (half + 1) * 64, R0 = u * 64, Rb = R0 - half * 64;
    __syncthreads();
    for (int idx = tid; idx < KJ * 32; idx += 512) {
        const int j = idx & (KJ - 1), cgp = idx / KJ;
        const u32x4 w = *(const u32x4*)(proj + (size_t)(Rb + j) * NPROJ + C_VC + cgp * 8);
        const unsigned ww[4] = {w.x, w.y, w.z, w.w};
#pragma unroll
        for (int e = 0; e < 4; ++e) { vT[(cgp * 8 + 2 * e) * 136 + j] = (bf16_t)(ww[e] & 0xffffu); vT[(cgp * 8 + 2 * e + 1) * 136 + j] = (bf16_t)(ww[e] >> 16); }
    }
    __syncthreads();
    const int rt = wid & 3, cbase = (wid >> 2) * 8;
    const bf16_t* GW = (const bf16_t*)(p.ws + W_GW + l * W_GW_L);
    f32x4 acc[8];
#pragma unroll
    for (int gi = 0; gi < 2; ++gi) {
        const int gg = (cbase >> 2) + gi;
        bf16x8 rf[4];
#pragma unroll
        for (int ks = 0; ks < 4; ++ks) rf[ks] = glbfrag(GW + ((size_t)gg * 128 + half * 64 + rt * 16 + fr) * 128 + ks * 32 + fq * 8);
#pragma unroll
        for (int c4 = 0; c4 < 4; ++c4) {
            const int ct = cbase + gi * 4 + c4;
            f32x4 a = (f32x4){0.f, 0.f, 0.f, 0.f};
#pragma unroll
            for (int ks = 0; ks < 4; ++ks) if (ks * 32 < KJ) a = MFMA16(ldsfrag((LAS const unsigned char*)(vT + (ct * 16 + fr) * 136 + ks * 32 + fq * 8)), rf[ks], a);
            acc[gi * 4 + c4] = a;
        }
    }
    const int row = R0 + rt * 16 + fr; float sq = 0.f;
#pragma unroll
    for (int k = 0; k < 8; ++k) {
        const int col = (cbase + k) * 16 + fq * 4, gg = col >> 6;
        const float bsv = p.in[17][(size_t)(l * 4 + gg) * 128 + half * 64 + rt * 16 + fr];
        const f32x4 uv = unpack4(*(const u32x2*)(proj + (size_t)row * NPROJ + C_U + col));
        f32x4 o = uv * (acc[k] + bsv); acc[k] = o;
        sq += (o[0] * o[0] + o[1] * o[1]) + (o[2] * o[2] + o[3] * o[3]);
    }
    sq += __shfl_xor(sq, 16); sq += __shfl_xor(sq, 32);
    if (fq == 0) ssq[(wid >> 2) * 64 + rt * 16 + fr] = sq;
    __syncthreads();
    const float rstd = 1.0f / sqrtf((ssq[rt * 16 + fr] + ssq[64 + rt * 16 + fr]) * (1.0f / 256.0f) + RMS_EPS);
    bf16_t* mix = (bf16_t*)(p.ws + W_MIX);
#pragma unroll
    for (int k = 0; k < 8; ++k) {
        const int col = (cbase + k) * 16 + fq * 4;
        const f32x4 gv = *(const f32x4*)(p.in[18] + (size_t)l * 1024 + 768 + col);
        *(u32x2*)(mix + (size_t)row * DM + 768 + col) = pack4(acc[k] * rstd * gv);
    }
}

__device__ __forceinline__ void scan_prompt(KP& p, int l, int item) {
    int tid_ = threadIdx.x; asm volatile("" : "+v"(tid_));
    const int gid = item * 512 + tid_, e = (gid & 2047) * 4, bh = gid >> 11, b = bh / 6, h = bh % 6;
    bf16_t* ST = (bf16_t*)(p.ws + W_ST); const float* CD = (const float*)(p.ws + W_CD);
    f32x4 st = (f32x4){0.f, 0.f, 0.f, 0.f};
#pragma unroll 1
    for (int c0 = 0; c0 < 128; c0 += 16) {
        u32x2 s[16]; float cd[16];
#pragma unroll
        for (int k = 0; k < 16; ++k) { const int u = b * 128 + c0 + k; s[k] = *(const u32x2*)(ST + ((size_t)(u * 6 + h)) * 8192 + e); cd[k] = CD[u * 8 + h]; }
#pragma unroll
        for (int k = 0; k < 16; ++k) { const int u = b * 128 + c0 + k; *(u32x2*)(ST + ((size_t)(u * 6 + h)) * 8192 + e) = pack4(st); st = st * cd[k] + unpack4(s[k]); }
    }
    *(f32x4*)(p.out + O_PH + ((size_t)(l * 4 + b) * 6 + h) * 8192 + e) = st;
}
__device__ __forceinline__ void scan_sample(KP& p, int l, int item) {
    int tid_ = threadIdx.x; asm volatile("" : "+v"(tid_));
    const int gid = item * 512 + tid_, e = (gid & 2047) * 4, sbh = gid >> 11, sb = sbh / 6, h = sbh % 6;
    bf16_t* ST = (bf16_t*)(p.ws + W_ST); const float* CD = (const float*)(p.ws + W_CD);
    const int u = 512 + sb;
    const f32x4 st = *(const f32x4*)(p.in[4] + ((size_t)(l * 32 + sb) * 6 + h) * 8192 + e);
    const f32x4 s = unpack4(*(const u32x2*)(ST + ((size_t)(u * 6 + h)) * 8192 + e));
    *(u32x2*)(ST + ((size_t)(u * 6 + h)) * 8192 + e) = pack4(st);
    *(f32x4*)(p.out + O_SH + ((size_t)(l * 32 + sb) * 6 + h) * 8192 + e) = st * CD[u * 8 + h] + s;
}

__device__ __forceinline__ void attn_unit(KP& p, LAS unsigned char* lds, int l, int u) {
    int tid_ = threadIdx.x; asm volatile("" : "+v"(tid_));
    const int tid = tid_, wid = tid >> 6, lane = tid & 63, fr = lane & 15, fq = lane >> 4;
    LAS bf16_t* VT = (LAS bf16_t*)(lds + 98304);
    LAS float* bias = (LAS float*)(lds + 153600);
    LAS float* ssq = (LAS float*)(lds + 158208);
    const bf16_t* proj = (const bf16_t*)(p.ws + W_PROJ);
    const bool isP = u < 512; const int R0 = u * 64, c = u & 127, b = u >> 7, sb = u - 512;
    const int qt = wid & 3, hbase = (wid >> 2) * 3;
    __syncthreads();
    for (int i = tid; i < 1152; i += 512) bias[i] = p.in[10][(size_t)l * 1152 + i];
    bf16x8 qf[3][2];
#pragma unroll
    for (int hh = 0; hh < 3; ++hh)
#pragma unroll
        for (int ks = 0; ks < 2; ++ks) qf[hh][ks] = glbfrag(proj + (size_t)(R0 + qt * 16 + fr) * NPROJ + (hbase + hh) * 64 + ks * 32 + fq * 8);
    float mrun[3], lrun[3]; f32x4 O[3][4];
#pragma unroll
    for (int hh = 0; hh < 3; ++hh) { mrun[hh] = -1e30f; lrun[hh] = 0.f;
#pragma unroll
        for (int d = 0; d < 4; ++d) O[hh][d] = (f32x4){0.f, 0.f, 0.f, 0.f}; }
    const int blk_lo = isP ? (c < 8 ? 8 - c : 0) : 0;
    u32x4 vr[6];
    const int vkp = tid & 31, vcg0 = tid >> 5;
#define ATT_LOADP(blkv, bufv) do { const size_t rb_ = isP ? (size_t)b * 8192 + (size_t)(c - 8 + (blkv)) * 64 : (size_t)T_P + (size_t)sb * 64; \
        _Pragma("unroll") for (int it = 0; it < 6; ++it) { const int pu_ = it * 512 + tid, row_ = pu_ / 48, un_ = (pu_ % 48) ^ (row_ & 15); \
            __builtin_amdgcn_global_load_lds((const unsigned*)(proj + (rb_ + row_) * NPROJ + C_K + un_ * 8), (LAS unsigned*)(lds + (bufv) * 49152 + (it * 512 + wid * 64) * 16), 16, 0, 0); } \
        _Pragma("unroll") for (int it = 0; it < 2; ++it) { const int cg_ = vcg0 + it * 16; \
            vr[2 * it] = *(const u32x4*)(proj + (rb_ + 2 * vkp) * NPROJ + C_V + cg_ * 8); vr[2 * it + 1] = *(const u32x4*)(proj + (rb_ + 2 * vkp + 1) * NPROJ + C_V + cg_ * 8); } } while (0)
    bool have = false; int cur = 0;
    if (isP || blk_lo == 8) { ATT_LOADP(blk_lo, 0); have = true; }
#pragma unroll 1
    for (int blk = blk_lo; blk <= 8; ++blk) {
        LAS unsigned char* Kc = lds + cur * 49152;
        __syncthreads();
        if (!have) {
#pragma unroll
            for (int it = 0; it < 6; ++it) { const int idx = it * 512 + tid, row_ = idx / 48, un_ = idx % 48;
                const float* s = p.in[2] + ((size_t)(l * 32 + sb) * 512 + blk * 64 + row_) * 384 + un_ * 8; const f32x4 a = *(const f32x4*)s, bq = *(const f32x4*)(s + 4);
                u32x4 w; w.x = cvt_pk_bf16(a[0], a[1]); w.y = cvt_pk_bf16(a[2], a[3]); w.z = cvt_pk_bf16(bq[0], bq[1]); w.w = cvt_pk_bf16(bq[2], bq[3]);
                *(LAS u32x4*)(Kc + row_ * 768 + ((un_ ^ (row_ & 15)) * 16)) = w; }
#pragma unroll
            for (int it = 0; it < 6; ++it) { const int cg_ = vcg0 + (it >> 1) * 16;
                const float* s = p.in[3] + ((size_t)(l * 32 + sb) * 512 + blk * 64 + 2 * vkp + (it & 1)) * 384 + cg_ * 8; const f32x4 a = *(const f32x4*)s, bq = *(const f32x4*)(s + 4);
                vr[it].x = cvt_pk_bf16(a[0], a[1]); vr[it].y = cvt_pk_bf16(a[2], a[3]); vr[it].z = cvt_pk_bf16(bq[0], bq[1]); vr[it].w = cvt_pk_bf16(bq[2], bq[3]); }
        }
        if (have) { const size_t rb_ = isP ? (size_t)b * 8192 + (size_t)(c - 8 + blk) * 64 : (size_t)T_P + (size_t)sb * 64; const int cg_ = vcg0 + 2 * 16;
            vr[4] = *(const u32x4*)(proj + (rb_ + 2 * vkp) * NPROJ + C_V + cg_ * 8); vr[5] = *(const u32x4*)(proj + (rb_ + 2 * vkp + 1) * NPROJ + C_V + cg_ * 8); }
#pragma unroll
        for (int it = 0; it < 3; ++it) { const int cg_ = vcg0 + it * 16; const u32x4 w0 = vr[2 * it], w1 = vr[2 * it + 1];
            const unsigned a0[4] = {w0.x, w0.y, w0.z, w0.w}, a1[4] = {w1.x, w1.y, w1.z, w1.w};
#pragma unroll
            for (int e = 0; e < 4; ++e) {
                *(LAS unsigned*)(VT + (cg_ * 8 + 2 * e) * 72 + 2 * vkp) = (a0[e] & 0xffffu) | (a1[e] << 16);
                *(LAS unsigned*)(VT + (cg_ * 8 + 2 * e + 1) * 72 + 2 * vkp) = (a0[e] >> 16) | (a1[e] & 0xffff0000u); } }
        asm volatile("s_waitcnt vmcnt(0)" ::: "memory");
        __syncthreads();
        have = false;
        if (blk < 8 && (isP || blk == 7)) { ATT_LOADP(blk + 1, cur ^ 1); have = true; }
#pragma unroll
        for (int hh = 0; hh < 3; ++hh) {
            const int h = hbase + hh;
            f32x4 s[4]; float mx = -1e30f;
#pragma unroll
            for (int kt = 0; kt < 4; ++kt) {
                f32x4 a = (f32x4){0.f, 0.f, 0.f, 0.f};
#pragma unroll
                for (int ks = 0; ks < 2; ++ks) a = MFMA16(ldsfrag((LAS const unsigned char*)(Kc + (kt * 16 + fr) * 768 + (((h * 8 + ks * 4 + fq) ^ fr) * 16))), qf[hh][ks], a);
                if (blk <= 5) { const float bc = bias[h * 192 + 191];
#pragma unroll
                    for (int j = 0; j < 4; ++j) { a[j] = a[j] * 0.125f + bc; mx = fmaxf(mx, a[j]); } }
                else {
#pragma unroll
                    for (int j = 0; j < 4; ++j) {
                        int rel = (qt * 16 + fr) + 512 - (blk * 64 + kt * 16 + fq * 4 + j); rel = rel > 128 ? 128 : rel;
                        a[j] = a[j] * 0.125f + bias[h * 192 + rel + 63]; mx = fmaxf(mx, a[j]);
                    } }
                s[kt] = a;
            }
            mx = fmaxf(mx, __shfl_xor(mx, 16)); mx = fmaxf(mx, __shfl_xor(mx, 32));
            const float mnew = fmaxf(mrun[hh], mx), fac = __expf(mrun[hh] - mnew); mrun[hh] = mnew;
            float rs = 0.f;
#pragma unroll
            for (int kt = 0; kt < 4; ++kt)
#pragma unroll
                for (int j = 0; j < 4; ++j) { s[kt][j] = __expf(s[kt][j] - mnew); rs += s[kt][j]; }
            lrun[hh] = lrun[hh] * fac + rs;
#pragma unroll
            for (int d = 0; d < 4; ++d) O[hh][d] *= fac;
#pragma unroll
            for (int ks = 0; ks < 2; ++ks) {
                const u32x2 pa = pack4(s[2 * ks]), pb = pack4(s[2 * ks + 1]);
                const bf16x8 pf = __builtin_bit_cast(bf16x8, (u32x4){pa.x, pa.y, pb.x, pb.y});
#pragma unroll
                for (int d = 0; d < 4; ++d) {
                    const LAS bf16_t* vrow = VT + (h * 64 + d * 16 + fr) * 72 + ks * 32 + fq * 4;
                    const u32x2 va = *(const LAS u32x2*)vrow, vb = *(const LAS u32x2*)(vrow + 16);
                    O[hh][d] = MFMA16(__builtin_bit_cast(bf16x8, (u32x4){va.x, va.y, vb.x, vb.y}), pf, O[hh][d]);
                }
            }
        }
        cur ^= 1;
    }
#pragma unroll
    for (int hh = 0; hh < 3; ++hh) { lrun[hh] += __shfl_xor(lrun[hh], 16); lrun[hh] += __shfl_xor(lrun[hh], 32); }
    float sq = 0.f;
#pragma unroll
    for (int hh = 0; hh < 3; ++hh) { const float inv = 1.0f / lrun[hh];
#pragma unroll
        for (int d = 0; d < 4; ++d) { O[hh][d] *= inv; const f32x4 o = O[hh][d]; sq += (o[0] * o[0] + o[1] * o[1]) + (o[2] * o[2] + o[3] * o[3]); } }
    sq += __shfl_xor(sq, 16); sq += __shfl_xor(sq, 32);
    if (fq == 0) ssq[(wid >> 2) * 64 + qt * 16 + fr] = sq;
    __syncthreads();
    const float rstd = 1.0f / sqrtf((ssq[qt * 16 + fr] + ssq[64 + qt * 16 + fr]) * (1.0f / 384.0f) + RMS_EPS);
    bf16_t* mix = (bf16_t*)(p.ws + W_MIX);
#pragma unroll
    for (int hh = 0; hh < 3; ++hh)
#pragma unroll
        for (int d = 0; d < 4; ++d) {
            const int col = (hbase + hh) * 64 + d * 16 + fq * 4;
            const f32x4 gv = *(const f32x4*)(p.in[18] + (size_t)l * 1024 + col);
            *(u32x2*)(mix + (size_t)(R0 + qt * 16 + fr) * DM + col) = pack4(O[hh][d] * rstd * gv);
        }
}

__device__ __forceinline__ void ssd_y(KP& p, LAS unsigned char* lds, int l, int u) {
    int tid_ = threadIdx.x; asm volatile("" : "+v"(tid_));
    const int tid = tid_, wid = tid >> 6, lane = tid & 63, fr = lane & 15, fq = lane >> 4;
    LAS bf16_t* Cn = (LAS bf16_t*)lds;
    LAS bf16_t* Bn = (LAS bf16_t*)(lds + 17408);
    LAS bf16_t* xT = (LAS bf16_t*)(lds + 34816);
    LAS bf16_t* Mm = (LAS bf16_t*)(lds + 62464);
    LAS float* dtl = (LAS float*)(lds + 90112);
    LAS float* acl = (LAS float*)(lds + 90880);
    LAS float* ssq = (LAS float*)(lds + 91648);
    const bf16_t* proj = (const bf16_t*)(p.ws + W_PROJ);
    const bf16_t* HP = (const bf16_t*)(p.ws + W_ST);
    const bf16_t* XC = (const bf16_t*)p.out + (size_t)(u * 64) * 896;
    const int R0 = u * 64, lt = wid & 3;
    f32x4 yacc[2][6];
#pragma unroll
    for (int g = 0; g < 2; ++g) {
        __syncthreads();
        if (wid < 3) { float dt, ac, last; dt_scan(p, l, u, g, wid, lane, dt, ac, last); dtl[wid * 64 + lane] = dt; acl[wid * 64 + lane] = ac; }
#pragma unroll
        for (int it = 0; it < 4; ++it) {
            const int idx = it * 512 + tid, mat = idx >> 10, i = (idx >> 4) & 63, c8 = idx & 15;
            const u32x4 w = *(const u32x4*)(XC + (size_t)i * 896 + 384 + mat * 256 + g * 128 + c8 * 8);
            *(LAS u32x4*)((mat ? Cn : Bn) + i * 136 + c8 * 8) = w;
        }
#pragma unroll
        for (int it = 0; it < 3; ++it) {
            const int idx = it * 512 + tid, c4 = idx % 48, i = (idx / 48) * 2;
            const u32x2 wa = *(const u32x2*)(XC + (size_t)i * 896 + g * 192 + c4 * 4), wb = *(const u32x2*)(XC + (size_t)(i + 1) * 896 + g * 192 + c4 * 4);
            *(LAS unsigned*)(xT + (c4 * 4 + 0) * 72 + i) = (wa.x & 0xffffu) | (wb.x << 16);
            *(LAS unsigned*)(xT + (c4 * 4 + 1) * 72 + i) = (wa.x >> 16) | (wb.x & 0xffff0000u);
            *(LAS unsigned*)(xT + (c4 * 4 + 2) * 72 + i) = (wa.y & 0xffffu) | (wb.y << 16);
            *(LAS unsigned*)(xT + (c4 * 4 + 3) * 72 + i) = (wa.y >> 16) | (wb.y & 0xffff0000u);
        }
        __syncthreads();
#pragma unroll
        for (int k = 0; k < 2; ++k) {
            const int st = (wid >> 2) * 2 + k;
            f32x4 a = (f32x4){0.f, 0.f, 0.f, 0.f};
#pragma unroll
            for (int ks = 0; ks < 4; ++ks) a = MFMA16(ldsfrag((LAS const unsigned char*)(Bn + (st * 16 + fr) * 136 + ks * 32 + fq * 8)), ldsfrag((LAS const unsigned char*)(Cn + (lt * 16 + fr) * 136 + ks * 32 + fq * 8)), a);
            const int li = lt * 16 + fr;
#pragma unroll
            for (int hh = 0; hh < 3; ++hh) {
                const float al = acl[hh * 64 + li]; f32x4 mv;
#pragma unroll
                for (int j = 0; j < 4; ++j) { const int si = st * 16 + fq * 4 + j; mv[j] = si <= li ? a[j] * __expf(al - acl[hh * 64 + si]) * dtl[hh * 64 + si] : 0.f; }
                *(LAS u32x2*)(Mm + (hh * 64 + li) * 72 + st * 16 + fq * 4) = pack4(mv);
            }
        }
        __syncthreads();
#pragma unroll
        for (int k = 0; k < 6; ++k) {
            const int ctile = (wid >> 2) * 6 + k, hh = ctile >> 2, pt = ctile & 3, h = g * 3 + hh, li = lt * 16 + fr;
            f32x4 ad = (f32x4){0.f, 0.f, 0.f, 0.f}, ao = (f32x4){0.f, 0.f, 0.f, 0.f};
#pragma unroll
            for (int ks = 0; ks < 2; ++ks) ad = MFMA16(ldsfrag((LAS const unsigned char*)(xT + (hh * 64 + pt * 16 + fr) * 72 + ks * 32 + fq * 8)), ldsfrag((LAS const unsigned char*)(Mm + (hh * 64 + li) * 72 + ks * 32 + fq * 8)), ad);
#pragma unroll
            for (int ks = 0; ks < 4; ++ks) ao = MFMA16(glbfrag(HP + ((size_t)(u * 6 + h) * 64 + pt * 16 + fr) * 128 + ks * 32 + fq * 8), ldsfrag((LAS const unsigned char*)(Cn + li * 136 + ks * 32 + fq * 8)), ao);
            const float ea = __expf(acl[hh * 64 + li]), dsk = p.in[15][l * 6 + h];
            const f32x4 xv = unpack4(*(const u32x2*)(XC + (size_t)li * 896 + h * 64 + pt * 16 + fq * 4));
            const f32x4 zv = unpack4(*(const u32x2*)(proj + (size_t)(R0 + li) * NPROJ + C_Z + h * 64 + pt * 16 + fq * 4));
            f32x4 y = ad + ao * ea + xv * dsk;
#pragma unroll
            for (int j = 0; j < 4; ++j) y[j] *= silu_f(zv[j]);
            yacc[g][k] = y;
            asm volatile("" ::: "memory");
        }
    }
    float sq = 0.f;
#pragma unroll
    for (int g = 0; g < 2; ++g)
#pragma unroll
        for (int k = 0; k < 6; ++k) { const f32x4 o = yacc[g][k]; sq += (o[0] * o[0] + o[1] * o[1]) + (o[2] * o[2] + o[3] * o[3]); }
    sq += __shfl_xor(sq, 16); sq += __shfl_xor(sq, 32);
    if (fq == 0) ssq[(wid >> 2) * 64 + lt * 16 + fr] = sq;
    __syncthreads();
    const float rstd = 1.0f / sqrtf((ssq[lt * 16 + fr] + ssq[64 + lt * 16 + fr]) * (1.0f / 384.0f) + RMS_EPS);
    bf16_t* mix = (bf16_t*)(p.ws + W_MIX);
#pragma unroll
    for (int g = 0; g < 2; ++g)
#pragma unroll
        for (int k = 0; k < 6; ++k) {
            const int col = 384 + g * 192 + ((wid >> 2) * 6 + k) * 16 + fq * 4;
            const f32x4 gv = *(const f32x4*)(p.in[18] + (size_t)l * 1024 + col);
            *(u32x2*)(mix + (size_t)(R0 + lt * 16 + fr) * DM + col) = pack4(yacc[g][k] * rstd * gv);
        }
}

__device__ __forceinline__ void phase_fix(KP& p, int l) {
    const float* halo = (const float*)(p.ws + W_MIX); bf16_t* H = (bf16_t*)(p.ws + W_PROJ);
    const float* w = p.in[23] + (size_t)l * 3 * DFF2; const float* bb = p.in[24] + (size_t)l * DFF2;
    int tid_ = threadIdx.x; asm volatile("" : "+v"(tid_));
    for (int i = blockIdx.x * 512 + tid_; i < 128 * DFF2; i += gridDim.x * 512) {
        const int pm = i / DFF2, cc = i % DFF2;
        if ((pm & 31) == 0 || cc >= DFF) continue;
        const float* h0 = halo + (size_t)(pm - 1) * 4 * DFF2; const float* h1 = halo + (size_t)pm * 4 * DFF2;
        float r[2];
#pragma unroll
        for (int rr = 0; rr < 2; ++rr) {
            float o[2];
#pragma unroll
            for (int gv = 0; gv < 2; ++gv) {
                const int c2 = cc + gv * DFF;
                const float xm2 = h0[2 * DFF2 + c2], xm1 = h0[3 * DFF2 + c2], x0 = h1[c2], x1 = h1[DFF2 + c2];
                o[gv] = rr == 0 ? bb[c2] + w[c2] * xm2 + w[DFF2 + c2] * xm1 + w[2 * DFF2 + c2] * x0 : bb[c2] + w[c2] * xm1 + w[DFF2 + c2] * x0 + w[2 * DFF2 + c2] * x1;
            }
            r[rr] = silu_f(o[0]) * o[1];
        }
        H[((size_t)pm * 256) * DFF + cc] = (bf16_t)(cvt_pk_bf16(r[0], 0.f) & 0xffffu);
        H[((size_t)pm * 256 + 1) * DFF + cc] = (bf16_t)(cvt_pk_bf16(r[1], 0.f) & 0xffffu);
    }
}

#define XB_TMO      128
#define XB_XCNT(j)  (256  + 64 * (j))
#define XB_XSUB(j)  (1280 + 64 * (j))
#define XB_XGEN(j)  (2304 + 64 * (j))
#define XB_TOP      3328
#define XB_TOPGEN   3392
#define XCD_BAR_WORDS 3456
#define XB_SPIN_CAP (1u << 18)

__device__ __forceinline__ unsigned xb_ld(unsigned* p)              { return __hip_atomic_load(p, __ATOMIC_RELAXED, __HIP_MEMORY_SCOPE_AGENT); }
__device__ __forceinline__ unsigned xb_add(unsigned* p, unsigned v) { return __hip_atomic_fetch_add(p, v, __ATOMIC_RELAXED, __HIP_MEMORY_SCOPE_AGENT); }
__device__ __forceinline__ unsigned xb_xcc_id() { return (unsigned)__builtin_amdgcn_s_getreg((3 << 11) | 20) & 0xFu; }
#define XB_SPIN(cond, bar) do { unsigned _sp = 0; while (cond) { __builtin_amdgcn_s_sleep(1); \
    if ((++_sp & 255u) == 0u) { if (xb_ld(&(bar)[XB_TMO])) break; if (_sp > XB_SPIN_CAP) { atomicAdd(&(bar)[XB_TMO], 1u); break; } } } } while (0)

struct XcdBarrier {
    unsigned* bar; unsigned x;
    volatile LAS unsigned* st;
};

__device__ __forceinline__ XcdBarrier xcd_barrier_post(unsigned* bar, volatile LAS unsigned* st) {
    XcdBarrier b; b.bar = bar; b.x = xb_xcc_id(); b.st = st;
    if (threadIdx.x == 0) (void)xb_add(&bar[XB_XCNT(b.x)], 1u);
    return b;
}
__device__ __forceinline__ void xcd_barrier_complete(unsigned* bar, unsigned x, unsigned& nloc, unsigned& nx) {
    const unsigned G = gridDim.x * gridDim.y * gridDim.z;
    unsigned sum, cnt, mine, sp = 0u;
    for (;;) {
        sum = 0u; cnt = 0u; mine = 0u;
#pragma unroll
        for (unsigned j = 0; j < 16; ++j) { const unsigned c = xb_ld(&bar[XB_XCNT(j)]); sum += c; cnt += (c > 0u) ? 1u : 0u; mine = (j == x) ? c : mine; }
        if (sum == G) break;
        __builtin_amdgcn_s_sleep(1);
        if ((++sp & 255u) == 0u) { if (xb_ld(&bar[XB_TMO])) break; if (sp > XB_SPIN_CAP) { atomicAdd(&bar[XB_TMO], 1u); break; } }
    }
    nloc = mine > 0u ? mine : 1u; nx = cnt > 0u ? cnt : 1u;
}

__device__ __forceinline__ void xcd_barrier(const XcdBarrier& b) {
    asm volatile("s_waitcnt vmcnt(0)" ::: "memory");
    __syncthreads();
    if (threadIdx.x == 0) {
        unsigned* bar = b.bar;
        __builtin_amdgcn_s_waitcnt(0);
        unsigned nloc = b.st[0], nx = b.st[1];
        if (nloc == 0u) { xcd_barrier_complete(bar, b.x, nloc, nx); b.st[0] = nloc; b.st[1] = nx; }
        const unsigned old = xb_add(&bar[XB_XSUB(b.x)], 1u);
        const unsigned gen = old / nloc;
        if (old + 1u == (gen + 1u) * nloc) {
            __builtin_amdgcn_fence(__ATOMIC_RELEASE, "agent");
            asm volatile("s_waitcnt vmcnt(0)" ::: "memory");
            const unsigned og = xb_add(&bar[XB_TOP], 1u);
            const unsigned tg = og / nx;
            if (og + 1u == (tg + 1u) * nx) xb_add(&bar[XB_TOPGEN], 1u);
            else XB_SPIN(xb_ld(&bar[XB_TOPGEN]) == tg, bar);
            __builtin_amdgcn_fence(__ATOMIC_ACQUIRE, "agent");
            xb_add(&bar[XB_XGEN(b.x)], 1u);
            asm volatile("s_waitcnt vmcnt(0)" ::: "memory");
        } else {
            XB_SPIN(xb_ld(&bar[XB_XGEN(b.x)]) == gen, bar);
            __builtin_amdgcn_fence(__ATOMIC_ACQUIRE, "agent");
            asm volatile("s_waitcnt vmcnt(0)" ::: "memory");
        }
    }
    __syncthreads();
}

__global__ void __launch_bounds__(512, 2) mega(Params pa) {
    extern __shared__ __attribute__((aligned(16))) unsigned char shm[];
    LAS unsigned char* lds = (LAS unsigned char*)shm;
    const int G = gridDim.x, bid = blockIdx.x;
    KP* pk = (KP*)__builtin_amdgcn_kernarg_segment_ptr();
    volatile LAS unsigned* bst = (volatile LAS unsigned*)(lds + LDS_BYTES - 16);
    XcdBarrier xb; xb.bar = nullptr; xb.x = 0; xb.st = bst;
    if (pa.coop) { if (threadIdx.x < 2) bst[threadIdx.x] = 0u; __syncthreads(); xb = xcd_barrier_post((unsigned*)(pa.ws + W_BAR), bst); }
    for (int ph = pa.ph_lo; ph < pa.ph_hi; ++ph) {
        if (ph > pa.ph_lo && pa.coop) { if (pa.pad == 0x5a5a) { __threadfence(); cg::this_grid().sync(); } else xcd_barrier(xb); }
        asm volatile("" : "+s"(pk)); KP& p = *pk;
        if (ph == 0) { phase_prep(p, lds); continue; }
        if (ph == 42) { int tq = threadIdx.x; asm volatile("" : "+v"(tq)); const unsigned short* w16 = (const unsigned short*)p.ws; for (size_t i = (size_t)bid * 512 + tq; i < (size_t)59418624; i += (size_t)G * 512) p.out[i] = (float)w16[i * 4]; continue; }
        if (ph == 41) { int tq = threadIdx.x; asm volatile("" : "+v"(tq)); for (size_t i = (size_t)bid * 512 + tq; i < (size_t)59418624; i += (size_t)G * 512) { const float v = p.out[i]; if (!(fabsf(v) < 1e30f)) p.out[i] = 0.f; } continue; }
        const int l = (ph - 1) / 10, k = (ph - 1) % 10;
        bf16_t* XB = (bf16_t*)(p.ws + W_XB);
        switch (k) {
        case 0: if (REP_G1 > 1) { pg8::StaticOrder S; S.init(T_ALL, NPROJ, G, bid); EpiNull E{(float*)(p.ws + W_CD)};
                  pg8::gemm_phase(lds, pg8::Gemm{XB, (const bf16_t*)(p.ws + W_IN + l * W_IN_L), T_ALL, NPROJ, DM}, S, E); }
                { pg8::StaticOrder S; S.init(T_ALL, NPROJ, G, bid);
                  EpiIn E{(bf16_t*)(p.ws + W_PROJ), p.out, (float*)(p.ws + W_DTB), p.in[13], l};
                  pg8::gemm_phase(lds, pg8::Gemm{XB, (const bf16_t*)(p.ws + W_IN + l * W_IN_L), T_ALL, NPROJ, DM}, S, E); } break;
        case 1: {
                  unsigned* qctr = (unsigned*)(p.ws + W_BAR + 14336) + l * 64;
                  volatile LAS int* qslot = (volatile LAS int*)(lds + LDS_BYTES - 32);
                  for (;;) {
                      __syncthreads();
                      if (threadIdx.x == 0) qslot[0] = (int)__hip_atomic_fetch_add(qctr, 1u, __ATOMIC_RELAXED, __HIP_MEMORY_SCOPE_AGENT);
                      __syncthreads();
                      const int it = qslot[0];
                      if (it >= 2 * NU64) break;
                      if (it < NU64) attn_unit(p, lds, l, NU64 - 1 - it); else ssd_states(p, lds, l, it - NU64);
                  } } break;
        case 2: for (int it = bid; it < 96 + 768; it += G) { if (it < 96) scan_prompt(p, l, it); else scan_sample(p, l, it - 96); } break;
        case 3: {
                  unsigned* qctr = (unsigned*)(p.ws + W_BAR + 14336) + l * 64 + 32;
                  volatile LAS int* qslot = (volatile LAS int*)(lds + LDS_BYTES - 32);
                  for (;;) {
                      __syncthreads();
                      if (threadIdx.x == 0) qslot[0] = (int)__hip_atomic_fetch_add(qctr, 1u, __ATOMIC_RELAXED, __HIP_MEMORY_SCOPE_AGENT);
                      __syncthreads();
                      const int it = qslot[0];
                      if (it >= 2 * NU64) break;
                      if (it < NU64) ssd_y(p, lds, l, it); else gmlp_unit(p, lds, l, it - NU64);
                  } } break;
        case 4: { pg8::StaticOrder S; S.init(T_ALL, DM, G, bid); EpiRes E{p.out, XB, (bf16_t*)p.out};
                  pg8::gemm_phase(lds, pg8::Gemm{(const bf16_t*)(p.ws + W_MIX), (const bf16_t*)(p.ws + W_OUT + l * W_OUT_L), T_ALL, DM, DM}, S, E); } break;
        case 5: phase_ln(p, (const bf16_t*)p.out, p.in[20] + l * DM, p.in[21] + l * DM, false); break;
        case 6: for (int rep = 0; rep < REP_G3; ++rep) { pg8::StaticOrder S; S.init(T_ALL, DFF2, G, bid);
                  EpiUp E{(bf16_t*)(p.ws + W_PROJ), (float*)(p.ws + W_MIX), p.out, p.in[23], p.in[24], p.in[6], l};
                  pg8::OneUnit o1;
                  for (int i = 0; S.next(i, o1.u); ++i) { pg8::gemm_phase(lds, pg8::Gemm{XB, (const bf16_t*)(p.ws + W_UP + l * W_UP_L), T_ALL, DFF2, DM}, o1, E); __syncthreads(); } } break;
        case 7: phase_fix(p, l); break;
        case 8: { pg8::StaticOrder S; S.init(T_ALL, DM, G, bid); EpiRes E{p.out, XB, (bf16_t*)(p.ws + W_MIX)};
                  pg8::gemm_phase(lds, pg8::Gemm{(const bf16_t*)(p.ws + W_PROJ), (const bf16_t*)(p.ws + W_DN + l * W_DN_L), T_ALL, DM, DFF}, S, E); } break;
        case 9: phase_ln(p, (const bf16_t*)(p.ws + W_MIX), p.in[26] + l * DM, p.in[27] + l * DM, l == DEPTH - 1); break;
        }
    }
}

constexpr int N_PHASES = 41;
#ifndef MULTI_LAUNCH
#define MULTI_LAUNCH 0
#endif

extern "C" void kernel_launch(void* const* d_in, const int* in_sizes, int n_in, void* d_out, int out_size, void* d_ws, size_t ws_size, hipStream_t stream) {
    static int grid = 0;
    if (grid == 0) {
        if (n_in != 28 || ws_size < W_END2) { fprintf(stderr, "kernel_launch: need 28 inputs and %zu bytes of workspace (got %d, %zu)\n", (size_t)W_END2, n_in, ws_size); grid = -1; return; }
        int dev = 0, cus = 0, per_cu = 0;
        hipGetDevice(&dev); hipDeviceGetAttribute(&cus, hipDeviceAttributeMultiprocessorCount, dev);
        if (hipFuncSetAttribute((const void*)mega, hipFuncAttributeMaxDynamicSharedMemorySize, LDS_BYTES) != hipSuccess) { fprintf(stderr, "kernel_launch: hipFuncSetAttribute failed\n"); grid = -1; return; }
        hipOccupancyMaxActiveBlocksPerMultiprocessor(&per_cu, (const void*)mega, 512, LDS_BYTES);
        (void)hipGetLastError();
        if (per_cu < 1) per_cu = 1;
        grid = cus * 1;
    }
    if (grid < 0) return;
    Params p{};
    for (int i = 0; i < 28; ++i) p.in[i] = (const float*)d_in[i];
    p.out = (float*)d_out; p.ws = (unsigned char*)d_ws;
#if MULTI_LAUNCH
#ifdef PROBE_CUT
    for (int ph = 0; ph < PROBE_CUT; ++ph) { p.ph_lo = ph; p.ph_hi = ph + 1; p.coop = 0; hipLaunchKernelGGL(mega, dim3(grid), dim3(512), LDS_BYTES, stream, p); }
    p.ph_lo = 42; p.ph_hi = 43; p.coop = 0; hipLaunchKernelGGL(mega, dim3(grid), dim3(512), LDS_BYTES, stream, p);
#else
    for (int ph = 0; ph < N_PHASES; ++ph) { p.ph_lo = ph; p.ph_hi = ph + 1; p.coop = 0; hipLaunchKernelGGL(mega, dim3(grid), dim3(512), LDS_BYTES, stream, p); }
#endif
#else
    p.ph_lo = 0; p.ph_hi = N_PHASES; p.coop = 1;
    if (hipMemsetAsync((char*)d_ws + W_BAR, 0, 16384, stream) != hipSuccess) { fprintf(stderr, "kernel_launch: memset failed\n"); return; }
    void* args[] = {&p};
    hipError_t e = hipLaunchCooperativeKernel((const void*)mega, dim3(grid), dim3(512), args, LDS_BYTES, stream);
    if (e != hipSuccess) fprintf(stderr, "cooperative launch failed: %s (grid %d)\n", hipGetErrorString(e), grid);
#endif
}
```

```cpp
#define REP_G1 1
#define REP_M1 1
#define REP_ATT 1
#define REP_M3 1
#define REP_G3 1
#include <hip/hip_runtime.h>
#include <hip/hip_cooperative_groups.h>
#include <cstdio>
namespace cg = cooperative_groups;

#define LAS __attribute__((address_space(3)))
typedef unsigned short bf16_t;
typedef short bf16x8 __attribute__((ext_vector_type(8)));
typedef float f32x4 __attribute__((ext_vector_type(4)));
typedef float f32x2 __attribute__((ext_vector_type(2)));
typedef unsigned u32x4 __attribute__((ext_vector_type(4)));
typedef unsigned u32x2 __attribute__((ext_vector_type(2)));

constexpr int T_ALL = 34816, T_P = 32768, DM = 1024, NPROJ = 3072, DFF = 2816, DFF2 = 5632, DEPTH = 4;
constexpr int NU64 = 544;
constexpr float ALPHA = 1.6817928305074290f;
constexpr float LN_EPS = 1e-5f, RMS_EPS = 1e-5f;
constexpr int C_K = 384, C_V = 768, C_Z = 1152, C_XBC = 1536, C_U = 2432, C_VC = 2688, C_DT = 2944;
constexpr size_t O_YP = 0, O_YS = 33554432, O_PK = 35651584, O_PV = O_PK + 3145728, O_PH = O_PV + 3145728, O_PC = O_PH + 786432,
                 O_PF = O_PC + 43008, O_SK = O_PF + 180224, O_SV = O_SK + 3145728, O_SH = O_SV + 3145728, O_SC = O_SH + 6291456,
                 O_SG = O_SC + 344064, O_SF = O_SG + 2097152;
constexpr size_t W_IN = 0, W_IN_L = (size_t)NPROJ * DM * 2;
constexpr size_t W_OUT = W_IN + 4 * W_IN_L, W_OUT_L = (size_t)DM * DM * 2;
constexpr size_t W_UP = W_OUT + 4 * W_OUT_L, W_UP_L = (size_t)DFF2 * DM * 2;
constexpr size_t W_DN = W_UP + 4 * W_UP_L, W_DN_L = (size_t)DM * DFF * 2;
constexpr size_t W_GW = W_DN + 4 * W_DN_L, W_GW_L = (size_t)4 * 128 * 128 * 2;
constexpr size_t W_XB = W_GW + 4 * W_GW_L;
constexpr size_t W_PROJ = W_XB + (size_t)T_ALL * DM * 2;
constexpr size_t W_MIX = W_PROJ + (size_t)T_ALL * NPROJ * 2;
constexpr size_t W_ST = W_MIX + (size_t)T_ALL * DM * 2;
constexpr size_t W_CD = W_ST + (size_t)NU64 * 6 * 8192 * 2;
constexpr size_t W_DTB = W_CD + (size_t)NU64 * 8 * 4;
constexpr size_t W_END = W_DTB + (size_t)T_ALL * 8 * 4;
constexpr size_t W_BAR = W_END;
constexpr size_t W_END2 = W_BAR + 16384;
constexpr int LDS_BYTES = 156 * 1024;

struct Params { const float* in[28]; float* out; unsigned char* ws; int ph_lo, ph_hi, coop, pad; };
typedef const __attribute__((address_space(4))) Params KP;

__device__ __forceinline__ float bf2f(unsigned b) { return __uint_as_float(b << 16); }
typedef __bf16 bf16v2 __attribute__((ext_vector_type(2)));
__device__ __forceinline__ unsigned cvt_pk_bf16(float lo, float hi) { const f32x2 v = {lo, hi}; const bf16v2 b = __builtin_convertvector(v, bf16v2); return __builtin_bit_cast(unsigned, b); }
__device__ __forceinline__ u32x2 pack4(f32x4 v) { u32x2 w; w.x = cvt_pk_bf16(v[0], v[1]); w.y = cvt_pk_bf16(v[2], v[3]); return w; }
__device__ __forceinline__ f32x4 unpack4(u32x2 w) { f32x4 v; v[0] = bf2f(w.x & 0xffffu); v[1] = bf2f(w.x >> 16); v[2] = bf2f(w.y & 0xffffu); v[3] = bf2f(w.y >> 16); return v; }
__device__ __forceinline__ float silu_f(float x) { return x * __builtin_amdgcn_rcpf(1.0f + __expf(-x)); }
__device__ __forceinline__ float gelu_tanh(float x) { const float y = 0.7978845608028654f * (x + 0.044715f * x * x * x); const float e = __expf(2.0f * y); return 0.5f * x * (2.0f - 2.0f * __builtin_amdgcn_rcpf(1.0f + e)); }
__device__ __forceinline__ float softplus_f(float x) { const float e = __expf(x); return x > 15.0f ? x : (e < 1e-3f ? e * (1.0f - 0.5f * e + 0.33333333f * e * e) : __logf(1.0f + e)); }
#define MFMA16(colfrag, rowfrag, acc) __builtin_amdgcn_mfma_f32_16x16x32_bf16((colfrag), (rowfrag), (acc), 0, 0, 0)
__device__ __forceinline__ bf16x8 ldsfrag(LAS const unsigned char* p) { return *(LAS const bf16x8*)p; }
__device__ __forceinline__ bf16x8 glbfrag(const bf16_t* p) { return *(const bf16x8*)p; }
#define LDS_WAVE_SYNC() asm volatile("s_waitcnt lgkmcnt(0)" ::: "memory")

namespace pg8 {
constexpr int BM = 256, BK = 64, HALF = 128, HTB = HALF * BK * 2, STAGE_BYTES = 8 * HTB, NXCD = 8, WGM = 16;
__device__ __forceinline__ int lds_byte(int r, int c) { const int st = (r >> 4) * 2 + (c >> 5), rr = r & 15, cc = c & 31, ob = rr * 64 + cc * 2; return st * 1024 + (ob ^ (((ob >> 9) & 1) << 5)); }
__device__ __forceinline__ void stage_rc(int b, int& R, int& C) { const int st = b / 1024, sb = b % 1024, swz = sb ^ (((sb >> 9) & 1) << 5); R = (st >> 1) * 16 + swz / 64; C = (st & 1) * 32 + (swz % 64) / 2; }
__device__ __forceinline__ int perm32(int rho) { const int n = rho >> 4, i = rho & 15; return 8 * (i >> 2) + 4 * n + (i & 3); }
struct Unit { int pm, pn; };
struct Gemm { const bf16_t* A; const bf16_t* Bt; int M, N, K; };
struct StaticOrder {
    int nM, nN, nwg, G, c;
    __device__ __forceinline__ void init(int M, int N, int G_, int c_) { nM = M / BM; nN = N / BM; nwg = nM * nN; G = G_; c = c_; }
    __device__ __forceinline__ bool next(int i, Unit& u) const {
        const long L = (long)i * G + c; if (L >= nwg) return false;
        int wgid = (int)L; { const int q = nwg / NXCD, r = nwg % NXCD, xcd = wgid % NXCD, off = wgid / NXCD; wgid = (xcd < r ? xcd * (q + 1) : r * (q + 1) + (xcd - r) * q) + off; }
        const int nig = WGM * nN, gid = wgid / nig, fm = gid * WGM, gsz = (nM - fm) < WGM ? (nM - fm) : WGM;
        u.pm = fm + ((wgid % nig) % gsz); u.pn = (wgid % nig) / gsz; return true;
    }
    __device__ __forceinline__ void a_ready(const Unit&) const {}
    __device__ __forceinline__ void done(const Unit&) const {}
};
struct OneUnit {
    Unit u;
    __device__ __forceinline__ bool next(int i, Unit& o) const { if (i) return false; o = u; return true; }
    __device__ __forceinline__ void a_ready(const Unit&) const {}
    __device__ __forceinline__ void done(const Unit&) const {}
};

template <class Epi, class Sched>
__device__ __forceinline__ void gemm_phase(LAS unsigned char* lds, const Gemm g, const Sched& S, const Epi& E) {
    int tid_ = threadIdx.x; asm volatile("" : "+v"(tid_));
    const int tid = tid_, wid = __builtin_amdgcn_readfirstlane(tid >> 6), lane = tid & 63, wr = wid >> 2, wc = wid & 3, fr = lane & 15, fq = lane >> 4;
    const int K = g.K, nt = K / BK;
    unsigned voffA[2], voffB[2];
#pragma unroll
    for (int i = 0; i < 2; ++i) { int R, C; stage_rc(tid * 16 + i * 8192, R, C); const int Rb = (R & ~31) + perm32(R & 31); voffA[i] = (unsigned)(R * K + C) * 2u; voffB[i] = (unsigned)(Rb * K + C) * 2u; }
    const size_t kstep = (size_t)(BK * 2);
    const size_t hstep = (size_t)HALF * K * 2;
    const size_t tstep = 2 * hstep;
    const unsigned ldsw = (unsigned)wid * 1024u;
    const int aoff = lds_byte(wr * 64 + fr, fq * 8), boff = lds_byte(wc * 32 + fr, fq * 8);
#define PG8_SA(b, h) (((b) * 2 + (h)) * HTB)
#define PG8_SB(b, h) ((4 + (b) * 2 + (h)) * HTB)
#define PG8_STAGE(bufoff, gbase, voff) do { _Pragma("unroll") for (int _i = 0; _i < 2; ++_i) \
        __builtin_amdgcn_global_load_lds((const unsigned*)((const char*)(gbase) + (voff)[_i]), (LAS unsigned*)(lds + (bufoff) + ldsw + _i * 8192), 16, 0, 0); } while (0)
#define PG8_LDA(dst, b, h) do { _Pragma("unroll") for (int m = 0; m < 4; ++m) _Pragma("unroll") for (int k = 0; k < 2; ++k) dst[m][k] = *(const LAS bf16x8*)(lds + PG8_SA(b, h) + aoff + m * 2048 + k * 1024); } while (0)
#define PG8_LDB(dst, b, h) do { _Pragma("unroll") for (int n = 0; n < 2; ++n) _Pragma("unroll") for (int k = 0; k < 2; ++k) dst[n][k] = *(const LAS bf16x8*)(lds + PG8_SB(b, h) + boff + n * 2048 + k * 1024); } while (0)
#define PG8_MMA(ai, bj, At, Bt) do { __builtin_amdgcn_s_setprio(1); _Pragma("unroll") for (int m = 0; m < 4; ++m) _Pragma("unroll") for (int n = 0; n < 2; ++n) _Pragma("unroll") for (int k = 0; k < 2; ++k) \
        acc[ai][bj][m][n] = __builtin_amdgcn_mfma_f32_16x16x32_bf16(Bt[n][k], At[m][k], acc[ai][bj][m][n], 0, 0, 0); __builtin_amdgcn_s_setprio(0); } while (0)
#define PG8_WAIT_V(n) asm volatile("s_waitcnt vmcnt(" #n ")" ::: "memory")
#define PG8_WAIT_L(n) asm volatile("s_waitcnt lgkmcnt(" #n ")" ::: "memory")
#define PG8_BAR __builtin_amdgcn_s_barrier()
#define PG8_SCHED __builtin_amdgcn_sched_barrier(0)
    Unit cur, nxt; int ui = 0;
    if (!S.next(0, cur)) return;
    f32x4 acc[2][2][4][2];
#pragma unroll
    for (int a = 0; a < 2; ++a)
#pragma unroll
        for (int b = 0; b < 2; ++b)
#pragma unroll
            for (int m = 0; m < 4; ++m)
#pragma unroll
                for (int n = 0; n < 2; ++n) acc[a][b][m][n] = (f32x4){0.f, 0.f, 0.f, 0.f};
    bf16x8 At[4][2], B0[2][2], B1[2][2];
    const char* cA = (const char*)g.A + (size_t)cur.pm * tstep; const char* cB = (const char*)g.Bt + (size_t)cur.pn * tstep;
    S.a_ready(cur);
    PG8_STAGE(PG8_SB(0, 0), cB, voffB); PG8_STAGE(PG8_SA(0, 0), cA, voffA); PG8_STAGE(PG8_SB(0, 1), cB + hstep, voffB); PG8_STAGE(PG8_SA(0, 1), cA + hstep, voffA);
    if (wr == 1) PG8_BAR;
    PG8_WAIT_V(4); PG8_BAR;
    PG8_STAGE(PG8_SB(1, 0), cB + kstep, voffB); PG8_STAGE(PG8_SA(1, 0), cA + kstep, voffA); PG8_STAGE(PG8_SB(1, 1), cB + hstep + kstep, voffB);
    PG8_WAIT_V(6); PG8_BAR;
    for (;;) {
        const bool has_next = S.next(ui + 1, nxt);
        const char* nA = has_next ? (const char*)g.A + (size_t)nxt.pm * tstep : cA; const char* nB = has_next ? (const char*)g.Bt + (size_t)nxt.pn * tstep : cB;
        for (int t = 0; t < nt; t += 2) {
            const bool last = (t == nt - 2);
            const char* a1 = cA + (size_t)(t + 1) * kstep;
            const char* a2 = last ? nA : cA + (size_t)(t + 2) * kstep; const char* b2 = last ? nB : cB + (size_t)(t + 2) * kstep;
            const char* a3 = a2 + kstep; const char* b3 = b2 + kstep;
            if (last && has_next) S.a_ready(nxt);
            PG8_LDB(B0, 0, 0); PG8_SCHED; PG8_LDA(At, 0, 0); PG8_STAGE(PG8_SA(1, 1), a1 + hstep, voffA);
            PG8_WAIT_L(8); PG8_BAR; PG8_WAIT_L(0); PG8_MMA(0, 0, At, B0); PG8_BAR; PG8_SCHED;
            PG8_LDB(B1, 0, 1); PG8_STAGE(PG8_SB(0, 0), b2, voffB);
            PG8_BAR; PG8_WAIT_L(0); PG8_MMA(0, 1, At, B1); PG8_BAR;
            PG8_LDA(At, 0, 1); PG8_STAGE(PG8_SA(0, 0), a2, voffA);
            PG8_BAR; PG8_WAIT_L(0); PG8_MMA(1, 0, At, B0); PG8_BAR; PG8_SCHED;
            PG8_STAGE(PG8_SB(0, 1), b2 + hstep, voffB);
            PG8_WAIT_V(6); PG8_BAR; PG8_MMA(1, 1, At, B1); PG8_BAR;
            PG8_LDB(B0, 1, 0); PG8_SCHED; PG8_LDA(At, 1, 0); PG8_STAGE(PG8_SA(0, 1), a2 + hstep, voffA);
            PG8_WAIT_L(8); PG8_BAR; PG8_WAIT_L(0); PG8_MMA(0, 0, At, B0); PG8_BAR; PG8_SCHED;
            PG8_LDB(B1, 1, 1); PG8_STAGE(PG8_SB(1, 0), b3, voffB);
            PG8_BAR; PG8_WAIT_L(0); PG8_MMA(0, 1, At, B1); PG8_BAR;
            PG8_LDA(At, 1, 1); PG8_STAGE(PG8_SA(1, 0), a3, voffA);
            PG8_BAR; PG8_WAIT_L(0); PG8_MMA(1, 0, At, B0); PG8_BAR; PG8_SCHED;
            PG8_STAGE(PG8_SB(1, 1), b3 + hstep, voffB);
            PG8_WAIT_V(6); PG8_BAR; PG8_MMA(1, 1, At, B1); PG8_BAR;
        }
        if constexpr (!Epi::AFTER_DRAIN) { E(acc, cur, wr, wc, fr, fq); S.done(cur); }
        if (!has_next) break;
#pragma unroll
        for (int a = 0; a < 2; ++a)
#pragma unroll
            for (int b = 0; b < 2; ++b)
#pragma unroll
                for (int m = 0; m < 4; ++m)
#pragma unroll
                    for (int n = 0; n < 2; ++n) acc[a][b][m][n] = (f32x4){0.f, 0.f, 0.f, 0.f};
        cur = nxt; cA = nA; cB = nB; ++ui;
    }
    PG8_WAIT_V(0);
    if (wr == 0) PG8_BAR;
    PG8_BAR;
    if constexpr (Epi::AFTER_DRAIN) { E.fused(acc, cur, wr, wc, fr, fq, lds, wid, lane); S.done(cur); }
#undef PG8_SA
#undef PG8_SB
#undef PG8_STAGE
#undef PG8_LDA
#undef PG8_LDB
#undef PG8_MMA
#undef PG8_WAIT_V
#undef PG8_WAIT_L
#undef PG8_BAR
#undef PG8_SCHED
}
}
using pg8::Unit;

struct EpiIn {
    static constexpr bool AFTER_DRAIN = false;
    bf16_t* proj; float* out; float* dtb; const float* dt_bias; int l;
    __device__ __forceinline__ void operator()(const f32x4 (&acc)[2][2][4][2], const Unit& u, int wr, int wc, int fr_, int fq_) const {
        int fr = fr_, fq = fq_; asm volatile("" : "+v"(fr), "+v"(fq));
#pragma unroll
        for (int bj = 0; bj < 2; ++bj) {
            const int cb = u.pn * 256 + bj * 128;
            const int col = cb + wc * 32 + fq * 8;
            if (cb > C_DT) continue;
#pragma unroll
            for (int ai = 0; ai < 2; ++ai)
#pragma unroll
                for (int m = 0; m < 4; ++m) {
                    const int row = u.pm * 256 + ai * 128 + wr * 64 + m * 16 + fr;
                    const bool isP = row < T_P; int b, t;
                    if (isP) { b = row >> 13; t = row & 8191; } else { b = (row - T_P) >> 6; t = row & 63; }
                    f32x4 v0 = acc[ai][bj][m][0], v1 = acc[ai][bj][m][1];
                    if (cb < C_U) {
                        u32x4 w; { const u32x2 a = pack4(v0), c = pack4(v1); w.x = a.x; w.y = a.y; w.z = c.x; w.w = c.y; }
                        *(u32x4*)(proj + (size_t)row * NPROJ + col) = w;
                        if (cb >= C_K && cb < C_Z) {
                            const int isv = cb >= C_V; const int cc = col - (isv ? C_V : C_K);
                            float* o = nullptr;
                            if (isP) { if (t >= 7680) o = out + (isv ? O_PV : O_PK) + ((size_t)(l * 4 + b) * 512 + (t - 7680)) * 384 + cc; }
                            else o = out + (isv ? O_SV : O_SK) + ((size_t)(l * 32 + b) * 64 + t) * 384 + cc;
                            if (o) { *(f32x4*)o = v0; *(f32x4*)(o + 4) = v1; }
                        } else if (cb >= C_XBC) {
                            const int cc = col - C_XBC; float* o = nullptr;
                            if (isP) { if (t >= 8189) o = out + O_PC + ((size_t)(l * 4 + b) * 3 + (t - 8189)) * 896 + cc; }
                            else if (t >= 61) o = out + O_SC + ((size_t)(l * 32 + b) * 3 + (t - 61)) * 896 + cc;
                            if (o) { *(f32x4*)o = v0; *(f32x4*)(o + 4) = v1; }
                        }
                    } else if (cb < C_DT) {
#pragma unroll
                        for (int j = 0; j < 4; ++j) { v0[j] = gelu_tanh(v0[j]); v1[j] = gelu_tanh(v1[j]); }
                        u32x4 w; { const u32x2 a = pack4(v0), c = pack4(v1); w.x = a.x; w.y = a.y; w.z = c.x; w.w = c.y; }
                        *(u32x4*)(proj + (size_t)row * NPROJ + col) = w;
                        if (cb >= C_VC && !isP) { float* o = out + O_SG + ((size_t)(l * 32 + b) * 64 + t) * 256 + (col - C_VC); *(f32x4*)o = v0; *(f32x4*)(o + 4) = v1; }
                    } else if (col == C_DT) {
                        float* d = dtb + (size_t)row * 8;
#pragma unroll
                        for (int j = 0; j < 4; ++j) d[j] = softplus_f(v0[j] + dt_bias[l * 6 + j]);
#pragma unroll
                        for (int j = 0; j < 2; ++j) d[4 + j] = softplus_f(v1[j] + dt_bias[l * 6 + 4 + j]);
                    }
                    asm volatile("" ::: "memory");
                }
        }
    }
};
struct EpiNull {
    static constexpr bool AFTER_DRAIN = false;
    float* sink;
    __device__ __forceinline__ void operator()(const f32x4 (&acc)[2][2][4][2], const Unit& u, int wr, int wc, int fr, int fq) const {
        float t = 0.f;
#pragma unroll
        for (int ai = 0; ai < 2; ++ai)
#pragma unroll
            for (int bj = 0; bj < 2; ++bj)
#pragma unroll
                for (int m = 0; m < 4; ++m)
#pragma unroll
                    for (int n = 0; n < 2; ++n) t += acc[ai][bj][m][n][0] + acc[ai][bj][m][n][1] + acc[ai][bj][m][n][2] + acc[ai][bj][m][n][3];
        if (t == 123456.789f) sink[0] = t;
    }
};
struct EpiRes {
    static constexpr bool AFTER_DRAIN = false;
    float* x; const bf16_t* xb; bf16_t* rdst;
    __device__ __forceinline__ void operator()(const f32x4 (&acc)[2][2][4][2], const Unit& u, int wr, int wc, int fr_, int fq_) const {
        int fr = fr_, fq = fq_; asm volatile("" : "+v"(fr), "+v"(fq));
#pragma unroll
        for (int ai = 0; ai < 2; ++ai)
#pragma unroll
            for (int m = 0; m < 4; ++m) {
                float* rowp = x + (size_t)(u.pm * 256 + ai * 128 + wr * 64 + m * 16 + fr) * DM + u.pn * 256 + wc * 32 + fq * 8;
#pragma unroll
                for (int bj = 0; bj < 2; ++bj) { float* q = rowp + bj * 128; const u32x4 xw = *(const u32x4*)(xb + (q - x));
                    const f32x4 o0 = unpack4((u32x2){xw.x, xw.y}), o1 = unpack4((u32x2){xw.z, xw.w});
                    const u32x2 ra = pack4(o0 * ALPHA + acc[ai][bj][m][0]), rb = pack4(o1 * ALPHA + acc[ai][bj][m][1]);
                    *(u32x4*)(rdst + (q - x)) = (u32x4){ra.x, ra.y, rb.x, rb.y}; }
                asm volatile("" ::: "memory");
            }
    }
};
struct EpiUp {
    static constexpr bool AFTER_DRAIN = true;
    bf16_t* H; float* halo; float* out; const float* cw; const float* cb; const float* fstate; int l;
    __device__ __forceinline__ void operator()(const f32x4 (&)[2][2][4][2], const Unit&, int, int, int, int) const {}
    __device__ __forceinline__ void fused(f32x4 (&acc)[2][2][4][2], const Unit& u, int wr, int wc, int fr, int fq, LAS unsigned char* lds, int wid, int lane) const {
        constexpr int LS = 264;
#pragma unroll
        for (int ai = 0; ai < 2; ++ai)
#pragma unroll
            for (int m = 0; m < 4; ++m)
#pragma unroll
                for (int bj = 0; bj < 2; ++bj) {
                        const int rl = ai * 128 + wr * 64 + m * 16 + fr, cl = bj * 128 + wc * 32 + fq * 8;
                        u32x4 w; { const u32x2 a = pack4(acc[ai][bj][m][0]), c = pack4(acc[ai][bj][m][1]); w.x = a.x; w.y = a.y; w.z = c.x; w.w = c.y; }
                        *(LAS u32x4*)(lds + (rl * LS + cl) * 2) = w;
                    }
        __syncthreads();
        const int tid = wid * 64 + lane, j = 2 * (tid & 63), seg = tid >> 6;
        const int hcol = u.pn * 128 + j;
        const float* w = cw + (size_t)l * 3 * DFF2 + hcol; const float* bb = cb + (size_t)l * DFF2 + hcol;
        const f32x2 wg0 = *(const f32x2*)w, wg1 = *(const f32x2*)(w + DFF2), wg2 = *(const f32x2*)(w + 2 * DFF2), bg = *(const f32x2*)bb;
        const f32x2 wv0 = *(const f32x2*)(w + DFF), wv1 = *(const f32x2*)(w + DFF2 + DFF), wv2 = *(const f32x2*)(w + 2 * DFF2 + DFF), bv = *(const f32x2*)(bb + DFF);
        const int r0 = seg * 32, R = u.pm * 256 + r0;
        const bool isP = R < T_P;
        const LAS unsigned char* U = (const LAS unsigned char*)lds;
#define UP2(row, off) ({ const unsigned w_ = *(const LAS unsigned*)(U + ((row) * LS + (off) + j) * 2); (f32x2){bf2f(w_ & 0xffffu), bf2f(w_ >> 16)}; })
        f32x2 g2 = (f32x2){0.f, 0.f}, g1 = g2, v2 = g2, v1 = g2; int skip = 0;
        if (isP) {
            if (seg > 0) { g2 = UP2(r0 - 2, 0); g1 = UP2(r0 - 1, 0); v2 = UP2(r0 - 2, 128); v1 = UP2(r0 - 1, 128); }
            else if ((R & 8191) != 0) skip = 2;
        } else if (seg & 1) { g2 = UP2(r0 - 2, 0); g1 = UP2(r0 - 1, 0); v2 = UP2(r0 - 2, 128); v1 = UP2(r0 - 1, 128); }
        else { const int sb = (R - T_P) >> 6; const float* fs = fstate + (size_t)(l * 32 + sb) * 2 * DFF2 + hcol;
            g2 = *(const f32x2*)fs; g1 = *(const f32x2*)(fs + DFF2); v2 = *(const f32x2*)(fs + DFF); v1 = *(const f32x2*)(fs + DFF2 + DFF); }
        bf16_t* hp = H + (size_t)R * DFF + hcol;
#pragma unroll 8
        for (int i = 0; i < 32; ++i) {
            const f32x2 gq = UP2(r0 + i, 0), vq = UP2(r0 + i, 128);
            if (i >= skip) {
                const f32x2 cgv = bg + wg0 * g2 + wg1 * g1 + wg2 * gq, cvv = bv + wv0 * v2 + wv1 * v1 + wv2 * vq;
                *(unsigned*)(hp + (size_t)i * DFF) = cvt_pk_bf16(silu_f(cgv[0]) * cvv[0], silu_f(cgv[1]) * cvv[1]);
            }
            g2 = g1; g1 = gq; v2 = v1; v1 = vq;
            if (isP) {
                if (seg == 0 && i < 2) { float* hl = halo + ((size_t)u.pm * 4 + i) * DFF2 + hcol; *(f32x2*)hl = gq; *(f32x2*)(hl + DFF) = vq; }
                if (seg == 7 && i >= 30) { float* hl = halo + ((size_t)u.pm * 4 + 2 + (i - 30)) * DFF2 + hcol; *(f32x2*)hl = gq; *(f32x2*)(hl + DFF) = vq;
                    if ((u.pm & 31) == 31) { float* o = out + O_PF + ((size_t)(l * 4 + (u.pm >> 5)) * 2 + (i - 30)) * DFF2 + hcol; *(f32x2*)o = gq; *(f32x2*)(o + DFF) = vq; } }
            } else if ((seg & 1) && i >= 30) {
                const int sb = (R - 32 - T_P) >> 6; float* o = out + O_SF + ((size_t)(l * 32 + sb) * 2 + (i - 30)) * DFF2 + hcol; *(f32x2*)o = gq; *(f32x2*)(o + DFF) = vq;
            }
        }
#undef UP2
    }
};

__device__ __forceinline__ void ln_row(const float* src, const bf16_t* srcb, float* x32, bf16_t* xb, const float* g, const float* b, int lane) {
    f32x4 v[4]; float s = 0.f;
#pragma unroll
    for (int i = 0; i < 4; ++i) { v[i] = srcb ? unpack4(*(const u32x2*)(srcb + i * 256 + lane * 4)) : *(const f32x4*)(src + i * 256 + lane * 4); s += (v[i][0] + v[i][1]) + (v[i][2] + v[i][3]); }
#pragma unroll
    for (int o = 32; o >= 1; o >>= 1) s += __shfl_xor(s, o);
    const float mu = s * (1.0f / 1024.0f); float q = 0.f;
#pragma unroll
    for (int i = 0; i < 4; ++i) { const f32x4 d = v[i] - mu; q += (d[0] * d[0] + d[1] * d[1]) + (d[2] * d[2] + d[3] * d[3]); }
#pragma unroll
    for (int o = 32; o >= 1; o >>= 1) q += __shfl_xor(q, o);
    const float rstd = 1.0f / sqrtf(q * (1.0f / 1024.0f) + LN_EPS);
#pragma unroll
    for (int i = 0; i < 4; ++i) {
        const f32x4 gg = *(const f32x4*)(g + i * 256 + lane * 4), bb = *(const f32x4*)(b + i * 256 + lane * 4);
        const f32x4 o = (v[i] - mu) * rstd * gg + bb;
        if (x32) *(f32x4*)(x32 + i * 256 + lane * 4) = o;
        if (xb) *(u32x2*)(xb + i * 256 + lane * 4) = pack4(o);
    }
}

__device__ __forceinline__ void tr_tile(LAS float* tile, const float* src, int Nsrc, bf16_t* dst, int K, int n0, int k0, int mode, int tid) {
    const int nn = tid & 63, np = n0 + nn; int sc;
    if (mode == 0) sc = np < C_U ? np : (np < C_DT ? np + 6 : (np < C_DT + 6 ? np - 512 : -1));
    else if (mode == 1) sc = np;
    else { const int pn = np >> 8, jj = np & 255; sc = jj < 128 ? pn * 128 + jj : DFF + pn * 128 + (jj - 128); }
#pragma unroll
    for (int i = 0; i < 8; ++i) { const int kk = (tid >> 6) + 8 * i; tile[kk * 65 + nn] = sc >= 0 ? src[(size_t)(k0 + kk) * Nsrc + sc] : 0.f; }
    __syncthreads();
    const int kk2 = (tid & 31) * 2;
#pragma unroll
    for (int i = 0; i < 4; ++i) { const int nn2 = (tid >> 5) + 16 * i; *(unsigned*)(dst + (size_t)(n0 + nn2) * K + k0 + kk2) = cvt_pk_bf16(tile[kk2 * 65 + nn2], tile[(kk2 + 1) * 65 + nn2]); }
    __syncthreads();
}

__device__ __forceinline__ void phase_prep(KP& p, LAS unsigned char* lds) {
    int tid_ = threadIdx.x; asm volatile("" : "+v"(tid_));
    const int tid = tid_, wid = tid >> 6, lane = tid & 63;
    for (int row = blockIdx.x * 8 + wid; row < T_ALL; row += gridDim.x * 8) {
        const float* src = row < T_P ? p.in[0] + (size_t)row * DM : p.in[1] + (size_t)(row - T_P) * DM;
        ln_row(src, nullptr, nullptr, (bf16_t*)(p.ws + W_XB) + (size_t)row * DM, p.in[7], p.in[8], lane);
    }
    constexpr int T_IN = 48 * 16, T_OUT = 16 * 16, T_UPT = 88 * 16, T_DNT = 16 * 44, T_L = T_IN + T_OUT + T_UPT + T_DNT;
    for (int it = blockIdx.x; it < 4 * T_L; it += gridDim.x) {
        const int l = it / T_L; int r = it % T_L;
        if (r < T_IN) tr_tile((LAS float*)lds, p.in[9] + (size_t)l * DM * 2950, 2950, (bf16_t*)(p.ws + W_IN + l * W_IN_L), DM, (r >> 4) * 64, (r & 15) * 64, 0, tid);
        else if ((r -= T_IN) < T_OUT) tr_tile((LAS float*)lds, p.in[19] + (size_t)l * DM * DM, DM, (bf16_t*)(p.ws + W_OUT + l * W_OUT_L), DM, (r >> 4) * 64, (r & 15) * 64, 1, tid);
        else if ((r -= T_OUT) < T_UPT) tr_tile((LAS float*)lds, p.in[22] + (size_t)l * DM * DFF2, DFF2, (bf16_t*)(p.ws + W_UP + l * W_UP_L), DM, (r >> 4) * 64, (r & 15) * 64, 2, tid);
        else { r -= T_UPT; tr_tile((LAS float*)lds, p.in[25] + (size_t)l * DFF * DM, DM, (bf16_t*)(p.ws + W_DN + l * W_DN_L), DFF, (r / 44) * 64, (r % 44) * 64, 1, tid); }
    }
    for (int i = blockIdx.x * 512 + tid; i < 4 * 4 * 128 * 128; i += gridDim.x * 512) {
        const int jj = i & 127, ii = (i >> 7) & 127;
        ((bf16_t*)(p.ws + W_GW))[i] = (bf16_t)(cvt_pk_bf16(jj <= ii ? p.in[16][i] : 0.f, 0.f) & 0xffffu);
    }
}

__device__ __forceinline__ void phase_ln(KP& p, const bf16_t* rsrc, const float* g, const float* b, bool final_out) {
    int tid_ = threadIdx.x; asm volatile("" : "+v"(tid_));
    const int wid = tid_ >> 6, lane = tid_ & 63;
    for (int row = blockIdx.x * 8 + wid; row < T_ALL; row += gridDim.x * 8)
        ln_row(nullptr, rsrc + (size_t)row * DM, final_out ? p.out + (size_t)row * DM : nullptr, final_out ? nullptr : (bf16_t*)(p.ws + W_XB) + (size_t)row * DM, g, b, lane);
}

__device__ __forceinline__ void dt_scan(KP& p, int l, int u, int g, int wid, int lane, float& dt, float& ac, float& last) {
    const int h = g * 3 + wid;
    dt = ((const float*)(p.ws + W_DTB))[(size_t)(u * 64 + lane) * 8 + h];
    const float a = -__expf(p.in[14][l * 6 + h]);
    float v = dt * a;
#pragma unroll
    for (int o = 1; o < 64; o <<= 1) { const float t = __shfl_up(v, o); if (lane >= o) v += t; }
    ac = v; last = __shfl(v, 63);
}

__device__ __forceinline__ f32x4 xbc_row(KP& p, int l, int u, int s, int ch) {
    const bf16_t* proj = (const bf16_t*)(p.ws + W_PROJ);
    const bool isP = u < 512; const bool hasprev = isP && (u & 127) != 0;
    if (s >= 0 || hasprev) return unpack4(*(const u32x2*)(proj + (size_t)(u * 64 + s) * NPROJ + C_XBC + ch));
    if (!isP) return *(const f32x4*)(p.in[5] + (unsigned)(((l * 32 + (u - 512)) * 3 + (3 + s)) * 896 + ch));
    return (f32x4){0.f, 0.f, 0.f, 0.f};
}
__device__ __forceinline__ void ssd_states(KP& p, LAS unsigned char* lds, int l, int u) {
    int tid_ = threadIdx.x; asm volatile("" : "+v"(tid_));
    const int tid = tid_, wid = tid >> 6, lane = tid & 63, fr = lane & 15, fq = lane >> 4;
    LAS bf16_t* xT = (LAS bf16_t*)lds;
    LAS bf16_t* BT = (LAS bf16_t*)(lds + 55296);
    LAS float* wgt = (LAS float*)(lds + 92160);
    bf16_t* XC = (bf16_t*)p.out;
    __syncthreads();
    if (wid < 6) {
        float dt, ac, last; dt_scan(p, l, u, wid / 3, wid % 3, lane, dt, ac, last);
        wgt[wid * 64 + lane] = dt * __expf(last - ac);
        if (lane == 0) ((float*)(p.ws + W_CD))[u * 8 + wid] = __expf(last);
    }
    __syncthreads();
    if (tid < 448) {
        const int cgp = tid % 224, seg = tid / 224, ch = cgp * 4, r0 = seg * 32;
        const float* cw = p.in[11] + (size_t)l * 4 * 896 + ch;
        const f32x4 w0 = *(const f32x4*)cw, w1 = *(const f32x4*)(cw + 896), w2 = *(const f32x4*)(cw + 2 * 896), w3 = *(const f32x4*)(cw + 3 * 896);
        const f32x4 bs = *(const f32x4*)(p.in[12] + (size_t)l * 896 + ch);
        f32x4 xm3 = xbc_row(p, l, u, r0 - 3, ch), xm2 = xbc_row(p, l, u, r0 - 2, ch), xm1 = xbc_row(p, l, u, r0 - 1, ch);
        const bf16_t* src = (const bf16_t*)(p.ws + W_PROJ) + (size_t)(u * 64) * NPROJ + C_XBC + ch;
        bf16_t* dst = XC + (size_t)(u * 64) * 896 + ch;
        const int hh = ch >> 6;
#pragma unroll 2
        for (int i = r0; i < r0 + 32; i += 2) {
            const f32x4 xa = unpack4(*(const u32x2*)(src + (size_t)i * NPROJ)), xb = unpack4(*(const u32x2*)(src + (size_t)(i + 1) * NPROJ));
            f32x4 ya = bs + w0 * xm3 + w1 * xm2 + w2 * xm1 + w3 * xa, yb = bs + w0 * xm2 + w1 * xm1 + w2 * xa + w3 * xb;
#pragma unroll
            for (int e = 0; e < 4; ++e) { ya[e] = silu_f(ya[e]); yb[e] = silu_f(yb[e]); }
            xm3 = xm1; xm2 = xa; xm1 = xb;
            *(u32x2*)(dst + (size_t)i * 896) = pack4(ya); *(u32x2*)(dst + (size_t)(i + 1) * 896) = pack4(yb);
            if (ch < 384) { const float wa = wgt[hh * 64 + i], wb = wgt[hh * 64 + i + 1];
#pragma unroll
                for (int e = 0; e < 4; ++e) *(LAS unsigned*)(xT + (ch + e) * 72 + i) = cvt_pk_bf16(ya[e] * wa, yb[e] * wb); }
            else if (ch < 640) {
#pragma unroll
                for (int e = 0; e < 4; ++e) *(LAS unsigned*)(BT + (ch - 384 + e) * 72 + i) = cvt_pk_bf16(ya[e], yb[e]); }
        }
    }
    __syncthreads();
    bf16_t* ST = (bf16_t*)(p.ws + W_ST);
#pragma unroll 2
    for (int k = 0; k < 24; ++k) {
        const int tt = wid * 24 + k, h = tt >> 5, pt = (tt & 31) >> 3, nt = tt & 7, g = h / 3;
        f32x4 acc = (f32x4){0.f, 0.f, 0.f, 0.f};
#pragma unroll
        for (int ks = 0; ks < 2; ++ks) {
            const bf16x8 rf = ldsfrag((LAS const unsigned char*)(xT + (h * 64 + pt * 16 + fr) * 72 + ks * 32 + fq * 8));
            const bf16x8 cf = ldsfrag((LAS const unsigned char*)(BT + (g * 128 + nt * 16 + fr) * 72 + ks * 32 + fq * 8));
            acc = MFMA16(cf, rf, acc);
        }
        *(u32x2*)(ST + ((size_t)(u * 6 + h) * 64 + pt * 16 + fr) * 128 + nt * 16 + fq * 4) = pack4(acc);
    }
}

__device__ __forceinline__ void gmlp_unit(KP& p, LAS unsigned char* lds, int l, int u) {
    int tid_ = threadIdx.x; asm volatile("" : "+v"(tid_));
    const int tid = tid_, wid = tid >> 6, lane = tid & 63, fr = lane & 15, fq = lane >> 4;
    LAS bf16_t* vT = (LAS bf16_t*)lds;
    LAS float* ssq = (LAS float*)(lds + 69632);
    const bf16_t* proj = (const bf16_t*)(p.ws + W_PROJ);
    const int half = u < 512 ? (u & 1) : 0, KJ = (half + 1) * 64, R0 = u * 64, Rb = R0 - half * 64;
    __syncthreads();
    for (int idx = tid; idx < KJ * 32; idx += 512) {
        const int j = idx & (KJ - 1), cgp = idx / KJ;
        const u32x4 w = *(const u32x4*)(proj + (size_t)(Rb + j) * NPROJ + C_VC + cgp * 8);
        const unsigned ww[4] = {w.x, w.y, w.z, w.w};
#pragma unroll
        for (int e = 0; e < 4; ++e) { vT[(cgp * 8 + 2 * e) * 136 + j] = (bf16_t)(ww[e] & 0xffffu); vT[(cgp * 8 + 2 * e + 1) * 136 + j] = (bf16_t)(ww[e] >> 16); }
    }
    __syncthreads();
    const int rt = wid & 3, cbase = (wid >> 2) * 8;
    const bf16_t* GW = (const bf16_t*)(p.ws + W_GW + l * W_GW_L);
    f32x4 acc[8];
#pragma unroll
    for (int gi = 0; gi < 2; ++gi) {
        const int gg = (cbase >> 2) + gi;
        bf16x8 rf[4];
#pragma unroll
        for (int ks = 0; ks < 4; ++ks) rf[ks] = glbfrag(GW + ((size_t)gg * 128 + half * 64 + rt * 16 + fr) * 128 + ks * 32 + fq * 8);
#pragma unroll
        for (int c4 = 0; c4 < 4; ++c4) {
            const int ct = cbase + gi * 4 + c4;
            f32x4 a = (f32x4){0.f, 0.f, 0.f, 0.f};
#pragma unroll
            for (int ks = 0; ks < 4; ++ks) if (ks * 32 < KJ) a = MFMA16(ldsfrag((LAS const unsigned char*)(vT + (ct * 16 + fr) * 136 + ks * 32 + fq * 8)), rf[ks], a);
            acc[gi * 4 + c4] = a;
        }
    }
    const int row = R0 + rt * 16 + fr; float sq = 0.f;
#pragma unroll
    for (int k = 0; k < 8; ++k) {
        const int col = (cbase + k) * 16 + fq * 4, gg = col >> 6;
        const float bsv = p.in[17][(size_t)(l * 4 + gg) * 128 + half * 64 + rt * 16 + fr];
        const f32x4 uv = unpack4(*(const u32x2*)(proj + (size_t)row * NPROJ + C_U + col));
        f32x4 o = uv * (acc[k] + bsv); acc[k] = o;
        sq += (o[0] * o[0] + o[1] * o[1]) + (o[2] * o[2] + o[3] * o[3]);
    }
    sq += __shfl_xor(sq, 16); sq += __shfl_xor(sq, 32);
    if (fq == 0) ssq[(wid >> 2) * 64 + rt * 16 + fr] = sq;
    __syncthreads();
    const float rstd = 1.0f / sqrtf((ssq[rt * 16 + fr] + ssq[64 + rt * 16 + fr]) * (1.0f / 256.0f) + RMS_EPS);
    bf16_t* mix = (bf16_t*)(p.ws + W_MIX);
#pragma unroll
    for (int k = 0; k < 8; ++k) {
        const int col = (cbase + k) * 16 + fq * 4;
        const f32x4 gv = *(const f32x4*)(p.in[18] + (size_t)l * 1024 + 768 + col);
        *(u32x2*)(mix + (size_t)row * DM + 768 + col) = pack4(acc[k] * rstd * gv);
    }
}

__device__ __forceinline__ void scan_prompt(KP& p, int l, int item) {
    int tid_ = threadIdx.x; asm volatile("" : "+v"(tid_));
    const int gid = item * 512 + tid_, e = (gid & 2047) * 4, bh = gid >> 11, b = bh / 6, h = bh % 6;
    bf16_t* ST = (bf16_t*)(p.ws + W_ST); const float* CD = (const float*)(p.ws + W_CD);
    f32x4 st = (f32x4){0.f, 0.f, 0.f, 0.f};
#pragma unroll 1
    for (int c0 = 0; c0 < 128; c0 += 16) {
        u32x2 s[16]; float cd[16];
#pragma unroll
        for (int k = 0; k < 16; ++k) { const int u = b * 128 + c0 + k; s[k] = *(const u32x2*)(ST + ((size_t)(u * 6 + h)) * 8192 + e); cd[k] = CD[u * 8 + h]; }
#pragma unroll
        for (int k = 0; k < 16; ++k) { const int u = b * 128 + c0 + k; *(u32x2*)(ST + ((size_t)(u * 6 + h)) * 8192 + e) = pack4(st); st = st * cd[k] + unpack4(s[k]); }
    }
    *(f32x4*)(p.out + O_PH + ((size_t)(l * 4 + b) * 6 + h) * 8192 + e) = st;
}
__device__ __forceinline__ void scan_sample(KP& p, int l, int item) {
    int tid_ = threadIdx.x; asm volatile("" : "+v"(tid_));
    const int gid = item * 512 + tid_, e = (gid & 2047) * 4, sbh = gid >> 11, sb = sbh / 6, h = sbh % 6;
    bf16_t* ST = (bf16_t*)(p.ws + W_ST); const float* CD = (const float*)(p.ws + W_CD);
    const int u = 512 + sb;
    const f32x4 st = *(const f32x4*)(p.in[4] + ((size_t)(l * 32 + sb) * 6 + h) * 8192 + e);
    const f32x4 s = unpack4(*(const u32x2*)(ST + ((size_t)(u * 6 + h)) * 8192 + e));
    *(u32x2*)(ST + ((size_t)(u * 6 + h)) * 8192 + e) = pack4(st);
    *(f32x4*)(p.out + O_SH + ((size_t)(l * 32 + sb) * 6 + h) * 8192 + e) = st * CD[u * 8 + h] + s;
}

__device__ __forceinline__ void attn_unit(KP& p, LAS unsigned char* lds, int l, int u) {
    int tid_ = threadIdx.x; asm volatile("" : "+v"(tid_));
    const int tid = tid_, wid = tid >> 6, lane = tid & 63, fr = lane & 15, fq = lane >> 4;
    LAS bf16_t* VT = (LAS bf16_t*)(lds + 98304);
    LAS float* bias = (LAS float*)(lds + 153600);
    LAS float* ssq = (LAS float*)(lds + 158208);
    const bf16_t* proj = (const bf16_t*)(p.ws + W_PROJ);
    const bool isP = u < 512; const int R0 = u * 64, c = u & 127, b = u >> 7, sb = u - 512;
    const int qt = wid & 3, hbase = (wid >> 2) * 3;
    __syncthreads();
    for (int i = tid; i < 1152; i += 512) bias[i] = p.in[10][(size_t)l * 1152 + i];
    bf16x8 qf[3][2];
#pragma unroll
    for (int hh = 0; hh < 3; ++hh)
#pragma unroll
        for (int ks = 0; ks < 2; ++ks) qf[hh][ks] = glbfrag(proj + (size_t)(R0 + qt * 16 + fr) * NPROJ + (hbase + hh) * 64 + ks * 32 + fq * 8);
    float mrun[3], lrun[3]; f32x4 O[3][4];
#pragma unroll
    for (int hh = 0; hh < 3; ++hh) { mrun[hh] = -1e30f; lrun[hh] = 0.f;
#pragma unroll
        for (int d = 0; d < 4; ++d) O[hh][d] = (f32x4){0.f, 0.f, 0.f, 0.f}; }
    const int blk_lo = isP ? (c < 8 ? 8 - c : 0) : 0;
    u32x4 vr[6];
    const int vkp = tid & 31, vcg0 = tid >> 5;
#define ATT_LOADP(blkv, bufv) do { const size_t rb_ = isP ? (size_t)b * 8192 + (size_t)(c - 8 + (blkv)) * 64 : (size_t)T_P + (size_t)sb * 64; \
        _Pragma("unroll") for (int it = 0; it < 6; ++it) { const int pu_ = it * 512 + tid, row_ = pu_ / 48, un_ = (pu_ % 48) ^ (row_ & 15); \
            __builtin_amdgcn_global_load_lds((const unsigned*)(proj + (rb_ + row_) * NPROJ + C_K + un_ * 8), (LAS unsigned*)(lds + (bufv) * 49152 + (it * 512 + wid * 64) * 16), 16, 0, 0); } \
        _Pragma("unroll") for (int it = 0; it < 2; ++it) { const int cg_ = vcg0 + it * 16; \
            vr[2 * it] = *(const u32x4*)(proj + (rb_ + 2 * vkp) * NPROJ + C_V + cg_ * 8); vr[2 * it + 1] = *(const u32x4*)(proj + (rb_ + 2 * vkp + 1) * NPROJ + C_V + cg_ * 8); } } while (0)
    bool have = false; int cur = 0;
    if (isP || blk_lo == 8) { ATT_LOADP(blk_lo, 0); have = true; }
#pragma unroll 1
    for (int blk = blk_lo; blk <= 8; ++blk) {
        LAS unsigned char* Kc = lds + cur * 49152;
        __syncthreads();
        if (!have) {
#pragma unroll
            for (int it = 0; it < 6; ++it) { const int idx = it * 512 + tid, row_ = idx / 48, un_ = idx % 48;
                const float* s = p.in[2] + ((size_t)(l * 32 + sb) * 512 + blk * 64 + row_) * 384 + un_ * 8; const f32x4 a = *(const f32x4*)s, bq = *(const f32x4*)(s + 4);
                u32x4 w; w.x = cvt_pk_bf16(a[0], a[1]); w.y = cvt_pk_bf16(a[2], a[3]); w.z = cvt_pk_bf16(bq[0], bq[1]); w.w = cvt_pk_bf16(bq[2], bq[3]);
                *(LAS u32x4*)(Kc + row_ * 768 + ((un_ ^ (row_ & 15)) * 16)) = w; }
#pragma unroll
            for (int it = 0; it < 6; ++it) { const int cg_ = vcg0 + (it >> 1) * 16;
                const float* s = p.in[3] + ((size_t)(l * 32 + sb) * 512 + blk * 64 + 2 * vkp + (it & 1)) * 384 + cg_ * 8; const f32x4 a = *(const f32x4*)s, bq = *(const f32x4*)(s + 4);
                vr[it].x = cvt_pk_bf16(a[0], a[1]); vr[it].y = cvt_pk_bf16(a[2], a[3]); vr[it].z = cvt_pk_bf16(bq[0], bq[1]); vr[it].w = cvt_pk_bf16(bq[2], bq[3]); }
        }
        if (have) { const size_t rb_ = isP ? (size_t)b * 8192 + (size_t)(c - 8 + blk) * 64 : (size_t)T_P + (size_t)sb * 64; const int cg_ = vcg0 + 2 * 16;
            vr[4] = *(const u32x4*)(proj + (rb_ + 2 * vkp) * NPROJ + C_V + cg_ * 8); vr[5] = *(const u32x4*)(proj + (rb_ + 2 * vkp + 1) * NPROJ + C_V + cg_ * 8); }
#pragma unroll
        for (int it = 0; it < 3; ++it) { const int cg_ = vcg0 + it * 16; const u32x4 w0 = vr[2 * it], w1 = vr[2 * it + 1];
            const unsigned a0[4] = {w0.x, w0.y, w0.z, w0.w}, a1[4] = {w1.x, w1.y, w1.z, w1.w};
#pragma unroll
            for (int e = 0; e < 4; ++e) {
                *(LAS unsigned*)(VT + (cg_ * 8 + 2 * e) * 72 + 2 * vkp) = (a0[e] & 0xffffu) | (a1[e] << 16);
                *(LAS unsigned*)(VT + (cg_ * 8 + 2 * e + 1) * 72 + 2 * vkp) = (a0[e] >> 16) | (a1[e] & 0xffff0000u); } }
        asm volatile("s_waitcnt vmcnt(0)" ::: "memory");
        __syncthreads();
        have = false;
        if (blk < 8 && (isP || blk == 7)) { ATT_LOADP(blk + 1, cur ^ 1); have = true; }
#pragma unroll
        for (int hh = 0; hh < 3; ++hh) {
            const int h = hbase + hh;
            f32x4 s[4]; float mx = -1e30f;
#pragma unroll
            for (int kt = 0; kt < 4; ++kt) {
                f32x4 a = (f32x4){0.f, 0.f, 0.f, 0.f};
#pragma unroll
                for (int ks = 0; ks < 2; ++ks) a = MFMA16(ldsfrag((LAS const unsigned char*)(Kc + (kt * 16 + fr) * 768 + (((h * 8 + ks * 4 + fq) ^ fr) * 16))), qf[hh][ks], a);
                if (blk <= 5) { const float bc = bias[h * 192 + 191];
#pragma unroll
                    for (int j = 0; j < 4; ++j) { a[j] = a[j] * 0.125f + bc; mx = fmaxf(mx, a[j]); } }
                else {
#pragma unroll
                    for (int j = 0; j < 4; ++j) {
                        int rel = (qt * 16 + fr) + 512 - (blk * 64 + kt * 16 + fq * 4 + j); rel = rel > 128 ? 128 : rel;
                        a[j] = a[j] * 0.125f + bias[h * 192 + rel + 63]; mx = fmaxf(mx, a[j]);
                    } }
                s[kt] = a;
            }
            mx = fmaxf(mx, __shfl_xor(mx, 16)); mx = fmaxf(mx, __shfl_xor(mx, 32));
            const float mnew = fmaxf(mrun[hh], mx), fac = __expf(mrun[hh] - mnew); mrun[hh] = mnew;
            float rs = 0.f;
#pragma unroll
            for (int kt = 0; kt < 4; ++kt)
#pragma unroll
                for (int j = 0; j < 4; ++j) { s[kt][j] = __expf(s[kt][j] - mnew); rs += s[kt][j]; }
            lrun[hh] = lrun[hh] * fac + rs;
#pragma unroll
            for (int d = 0; d < 4; ++d) O[hh][d] *= fac;
#pragma unroll
            for (int ks = 0; ks < 2; ++ks) {
                const u32x2 pa = pack4(s[2 * ks]), pb = pack4(s[2 * ks + 1]);
                const bf16x8 pf = __builtin_bit_cast(bf16x8, (u32x4){pa.x, pa.y, pb.x, pb.y});
#pragma unroll
                for (int d = 0; d < 4; ++d) {
                    const LAS bf16_t* vrow = VT + (h * 64 + d * 16 + fr) * 72 + ks * 32 + fq * 4;
                    const u32x2 va = *(const LAS u32x2*)vrow, vb = *(const LAS u32x2*)(vrow + 16);
                    O[hh][d] = MFMA16(__builtin_bit_cast(bf16x8, (u32x4){va.x, va.y, vb.x, vb.y}), pf, O[hh][d]);
                }
            }
        }
        cur ^= 1;
    }
#pragma unroll
    for (int hh = 0; hh < 3; ++hh) { lrun[hh] += __shfl_xor(lrun[hh], 16); lrun[hh] += __shfl_xor(lrun[hh], 32); }
    float sq = 0.f;
#pragma unroll
    for (int hh = 0; hh < 3; ++hh) { const float inv = 1.0f / lrun[hh];
#pragma unroll
        for (int d = 0; d < 4; ++d) { O[hh][d] *= inv; const f32x4 o = O[hh][d]; sq += (o[0] * o[0] + o[1] * o[1]) + (o[2] * o[2] + o[3] * o[3]); } }
    sq += __shfl_xor(sq, 16); sq += __shfl_xor(sq, 32);
    if (fq == 0) ssq[(wid >> 2) * 64 + qt * 16 + fr] = sq;
    __syncthreads();
    const float rstd = 1.0f / sqrtf((ssq[qt * 16 + fr] + ssq[64 + qt * 16 + fr]) * (1.0f / 384.0f) + RMS_EPS);
    bf16_t* mix = (bf16_t*)(p.ws + W_MIX);
#pragma unroll
    for (int hh = 0; hh < 3; ++hh)
#pragma unroll
        for (int d = 0; d < 4; ++d) {
            const int col = (hbase + hh) * 64 + d * 16 + fq * 4;
            const f32x4 gv = *(const f32x4*)(p.in[18] + (size_t)l * 1024 + col);
            *(u32x2*)(mix + (size_t)(R0 + qt * 16 + fr) * DM + col) = pack4(O[hh][d] * rstd * gv);
        }
}

__device__ __forceinline__ void ssd_y(KP& p, LAS unsigned char* lds, int l, int u) {
    int tid_ = threadIdx.x; asm volatile("" : "+v"(tid_));
    const int tid = tid_, wid = tid >> 6, lane = tid & 63, fr = lane & 15, fq = lane >> 4;
    LAS bf16_t* Cn = (LAS bf16_t*)lds;
    LAS bf16_t* Bn = (LAS bf16_t*)(lds + 17408);
    LAS bf16_t* xT = (LAS bf16_t*)(lds + 34816);
    LAS bf16_t* Mm = (LAS bf16_t*)(lds + 62464);
    LAS float* dtl = (LAS float*)(lds + 90112);
    LAS float* acl = (LAS float*)(lds + 90880);
    LAS float* ssq = (LAS float*)(lds + 91648);
    const bf16_t* proj = (const bf16_t*)(p.ws + W_PROJ);
    const bf16_t* HP = (const bf16_t*)(p.ws + W_ST);
    const bf16_t* XC = (const bf16_t*)p.out + (size_t)(u * 64) * 896;
    const int R0 = u * 64, lt = wid & 3;
    f32x4 yacc[2][6];
#pragma unroll
    for (int g = 0; g < 2; ++g) {
        __syncthreads();
        if (wid < 3) { float dt, ac, last; dt_scan(p, l, u, g, wid, lane, dt, ac, last); dtl[wid * 64 + lane] = dt; acl[wid * 64 + lane] = ac; }
#pragma unroll
        for (int it = 0; it < 4; ++it) {
            const int idx = it * 512 + tid, mat = idx >> 10, i = (idx >> 4) & 63, c8 = idx & 15;
            const u32x4 w = *(const u32x4*)(XC + (size_t)i * 896 + 384 + mat * 256 + g * 128 + c8 * 8);
            *(LAS u32x4*)((mat ? Cn : Bn) + i * 136 + c8 * 8) = w;
        }
#pragma unroll
        for (int it = 0; it < 3; ++it) {
            const int idx = it * 512 + tid, c4 = idx % 48, i = (idx / 48) * 2;
            const u32x2 wa = *(const u32x2*)(XC + (size_t)i * 896 + g * 192 + c4 * 4), wb = *(const u32x2*)(XC + (size_t)(i + 1) * 896 + g * 192 + c4 * 4);
            *(LAS unsigned*)(xT + (c4 * 4 + 0) * 72 + i) = (wa.x & 0xffffu) | (wb.x << 16);
            *(LAS unsigned*)(xT + (c4 * 4 + 1) * 72 + i) = (wa.x >> 16) | (wb.x & 0xffff0000u);
            *(LAS unsigned*)(xT + (c4 * 4 + 2) * 72 + i) = (wa.y & 0xffffu) | (wb.y << 16);
            *(LAS unsigned*)(xT + (c4 * 4 + 3) * 72 + i) = (wa.y >> 16) | (wb.y & 0xffff0000u);
        }
        __syncthreads();
#pragma unroll
        for (int k = 0; k < 2; ++k) {
            const int st = (wid >> 2) * 2 + k;
            f32x4 a = (f32x4){0.f, 0.f, 0.f, 0.f};
#pragma unroll
            for (int ks = 0; ks < 4; ++ks) a = MFMA16(ldsfrag((LAS const unsigned char*)(Bn + (st * 16 + fr) * 136 + ks * 32 + fq * 8)), ldsfrag((LAS const unsigned char*)(Cn + (lt * 16 + fr) * 136 + ks * 32 + fq * 8)), a);
            const int li = lt * 16 + fr;
#pragma unroll
            for (int hh = 0; hh < 3; ++hh) {
                const float al = acl[hh * 64 + li]; f32x4 mv;
#pragma unroll
                for (int j = 0; j < 4; ++j) { const int si = st * 16 + fq * 4 + j; mv[j] = si <= li ? a[j] * __expf(al - acl[hh * 64 + si]) * dtl[hh * 64 + si] : 0.f; }
                *(LAS u32x2*)(Mm + (hh * 64 + li) * 72 + st * 16 + fq * 4) = pack4(mv);
            }
        }
        __syncthreads();
#pragma unroll
        for (int k = 0; k < 6; ++k) {
            const int ctile = (wid >> 2) * 6 + k, hh = ctile >> 2, pt = ctile & 3, h = g * 3 + hh, li = lt * 16 + fr;
            f32x4 ad = (f32x4){0.f, 0.f, 0.f, 0.f}, ao = (f32x4){0.f, 0.f, 0.f, 0.f};
#pragma unroll
            for (int ks = 0; ks < 2; ++ks) ad = MFMA16(ldsfrag((LAS const unsigned char*)(xT + (hh * 64 + pt * 16 + fr) * 72 + ks * 32 + fq * 8)), ldsfrag((LAS const unsigned char*)(Mm + (hh * 64 + li) * 72 + ks * 32 + fq * 8)), ad);
#pragma unroll
            for (int ks = 0; ks < 4; ++ks) ao = MFMA16(glbfrag(HP + ((size_t)(u * 6 + h) * 64 + pt * 16 + fr) * 128 + ks * 32 + fq * 8), ldsfrag((LAS const unsigned char*)(Cn + li * 136 + ks * 32 + fq * 8)), ao);
            const float ea = __expf(acl[hh * 64 + li]), dsk = p.in[15][l * 6 + h];
            const f32x4 xv = unpack4(*(const u32x2*)(XC + (size_t)li * 896 + h * 64 + pt * 16 + fq * 4));
            const f32x4 zv = unpack4(*(const u32x2*)(proj + (size_t)(R0 + li) * NPROJ + C_Z + h * 64 + pt * 16 + fq * 4));
            f32x4 y = ad + ao * ea + xv * dsk;
#pragma unroll
            for (int j = 0; j < 4; ++j) y[j] *= silu_f(zv[j]);
            yacc[g][k] = y;
            asm volatile("" ::: "memory");
        }
    }
    float sq = 0.f;
#pragma unroll
    for (int g = 0; g < 2; ++g)
#pragma unroll
        for (int k = 0; k < 6; ++k) { const f32x4 o = yacc[g][k]; sq += (o[0] * o[0] + o[1] * o[1]) + (o[2] * o[2] + o[3] * o[3]); }
    sq += __shfl_xor(sq, 16); sq += __shfl_xor(sq, 32);
    if (fq == 0) ssq[(wid >> 2) * 64 + lt * 16 + fr] = sq;
    __syncthreads();
    const float rstd = 1.0f / sqrtf((ssq[lt * 16 + fr] + ssq[64 + lt * 16 + fr]) * (1.0f / 384.0f) + RMS_EPS);
    bf16_t* mix = (bf16_t*)(p.ws + W_MIX);
#pragma unroll
    for (int g = 0; g < 2; ++g)
#pragma unroll
        for (int k = 0; k < 6; ++k) {
            const int col = 384 + g * 192 + ((wid >> 2) * 6 + k) * 16 + fq * 4;
            const f32x4 gv = *(const f32x4*)(p.in[18] + (size_t)l * 1024 + col);
            *(u32x2*)(mix + (size_t)(R0 + lt * 16 + fr) * DM + col) = pack4(yacc[g][k] * rstd * gv);
        }
}

__device__ __forceinline__ void phase_fix(KP& p, int l) {
    const float* halo = (const float*)(p.ws + W_MIX); bf16_t* H = (bf16_t*)(p.ws + W_PROJ);
    const float* w = p.in[23] + (size_t)l * 3 * DFF2; const float* bb = p.in[24] + (size_t)l * DFF2;
    int tid_ = threadIdx.x; asm volatile("" : "+v"(tid_));
    for (int i = blockIdx.x * 512 + tid_; i < 128 * DFF2; i += gridDim.x * 512) {
        const int pm = i / DFF2, cc = i % DFF2;
        if ((pm & 31) == 0 || cc >= DFF) continue;
        const float* h0 = halo + (size_t)(pm - 1) * 4 * DFF2; const float* h1 = halo + (size_t)pm * 4 * DFF2;
        float r[2];
#pragma unroll
        for (int rr = 0; rr < 2; ++rr) {
            float o[2];
#pragma unroll
            for (int gv = 0; gv < 2; ++gv) {
                const int c2 = cc + gv * DFF;
                const float xm2 = h0[2 * DFF2 + c2], xm1 = h0[3 * DFF2 + c2], x0 = h1[c2], x1 = h1[DFF2 + c2];
                o[gv] = rr == 0 ? bb[c2] + w[c2] * xm2 + w[DFF2 + c2] * xm1 + w[2 * DFF2 + c2] * x0 : bb[c2] + w[c2] * xm1 + w[DFF2 + c2] * x0 + w[2 * DFF2 + c2] * x1;
            }
            r[rr] = silu_f(o[0]) * o[1];
        }
        H[((size_t)pm * 256) * DFF + cc] = (bf16_t)(cvt_pk_bf16(r[0], 0.f) & 0xffffu);
        H[((size_t)pm * 256 + 1) * DFF + cc] = (bf16_t)(cvt_pk_bf16(r[1], 0.f) & 0xffffu);
    }
}

#define XB_TMO      128
#define XB_XCNT(j)  (256  + 64 * (j))
#define XB_XSUB(j)  (1280 + 64 * (j))
#define XB_XGEN(j)  (2304 + 64 * (j))
#define XB_TOP      3328
#define XB_TOPGEN   3392
#define XCD_BAR_WORDS 3456
#define XB_SPIN_CAP (1u << 18)

__device__ __forceinline__ unsigned xb_ld(unsigned* p)              { return __hip_atomic_load(p, __ATOMIC_RELAXED, __HIP_MEMORY_SCOPE_AGENT); }
__device__ __forceinline__ unsigned xb_add(unsigned* p, unsigned v) { return __hip_atomic_fetch_add(p, v, __ATOMIC_RELAXED, __HIP_MEMORY_SCOPE_AGENT); }
__device__ __forceinline__ unsigned xb_xcc_id() { return (unsigned)__builtin_amdgcn_s_getreg((3 << 11) | 20) & 0xFu; }
#define XB_SPIN(cond, bar) do { unsigned _sp = 0; while (cond) { __builtin_amdgcn_s_sleep(1); \
    if ((++_sp & 255u) == 0u) { if (xb_ld(&(bar)[XB_TMO])) break; if (_sp > XB_SPIN_CAP) { atomicAdd(&(bar)[XB_TMO], 1u); break; } } } } while (0)

struct XcdBarrier {
    unsigned* bar; unsigned x;
    volatile LAS unsigned* st;
};

__device__ __forceinline__ XcdBarrier xcd_barrier_post(unsigned* bar, volatile LAS unsigned* st) {
    XcdBarrier b; b.bar = bar; b.x = xb_xcc_id(); b.st = st;
    if (threadIdx.x == 0) (void)xb_add(&bar[XB_XCNT(b.x)], 1u);
    return b;
}
__device__ __forceinline__ void xcd_barrier_complete(unsigned* bar, unsigned x, unsigned& nloc, unsigned& nx) {
    const unsigned G = gridDim.x * gridDim.y * gridDim.z;
    unsigned sum, cnt, mine, sp = 0u;
    for (;;) {
        sum = 0u; cnt = 0u; mine = 0u;
#pragma unroll
        for (unsigned j = 0; j < 16; ++j) { const unsigned c = xb_ld(&bar[XB_XCNT(j)]); sum += c; cnt += (c > 0u) ? 1u : 0u; mine = (j == x) ? c : mine; }
        if (sum == G) break;
        __builtin_amdgcn_s_sleep(1);
        if ((++sp & 255u) == 0u) { if (xb_ld(&bar[XB_TMO])) break; if (sp > XB_SPIN_CAP) { atomicAdd(&bar[XB_TMO], 1u); break; } }
    }
    nloc = mine > 0u ? mine : 1u; nx = cnt > 0u ? cnt : 1u;
}

__device__ __forceinline__ void xcd_barrier(const XcdBarrier& b) {
    asm volatile("s_waitcnt vmcnt(0)" ::: "memory");
    __syncthreads();
    if (threadIdx.x == 0) {
        unsigned* bar = b.bar;
        __builtin_amdgcn_s_waitcnt(0);
        unsigned nloc = b.st[0], nx = b.st[1];
        if (nloc == 0u) { xcd_barrier_complete(bar, b.x, nloc, nx); b.st[0] = nloc; b.st[1] = nx; }
        const unsigned old = xb_add(&bar[XB_XSUB(b.x)], 1u);
        const unsigned gen = old / nloc;
        if (old + 1u == (gen + 1u) * nloc) {
            __builtin_amdgcn_fence(__ATOMIC_RELEASE, "agent");
            asm volatile("s_waitcnt vmcnt(0)" ::: "memory");
            const unsigned og = xb_add(&bar[XB_TOP], 1u);
            const unsigned tg = og / nx;
            if (og + 1u == (tg + 1u) * nx) xb_add(&bar[XB_TOPGEN], 1u);
            else XB_SPIN(xb_ld(&bar[XB_TOPGEN]) == tg, bar);
            __builtin_amdgcn_fence(__ATOMIC_ACQUIRE, "agent");
            xb_add(&bar[XB_XGEN(b.x)], 1u);
            asm volatile("s_waitcnt vmcnt(0)" ::: "memory");
        } else {
            XB_SPIN(xb_ld(&bar[XB_XGEN(b.x)]) == gen, bar);
            __builtin_amdgcn_fence(__ATOMIC_ACQUIRE, "agent");
            asm volatile("s_waitcnt vmcnt(0)" ::: "memory");
        }
    }
    __syncthreads();
}

__global__ void __launch_bounds__(512, 2) mega(Params pa) {
    extern __shared__ __attribute__((aligned(16))) unsigned char shm[];
    LAS unsigned char* lds = (LAS unsigned char*)shm;
    const int G = gridDim.x, bid = blockIdx.x;
    KP* pk = (KP*)__builtin_amdgcn_kernarg_segment_ptr();
    volatile LAS unsigned* bst = (volatile LAS unsigned*)(lds + LDS_BYTES - 16);
    XcdBarrier xb; xb.bar = nullptr; xb.x = 0; xb.st = bst;
    if (pa.coop) { if (threadIdx.x < 2) bst[threadIdx.x] = 0u; __syncthreads(); xb = xcd_barrier_post((unsigned*)(pa.ws + W_BAR), bst); }
    for (int ph = pa.ph_lo; ph < pa.ph_hi; ++ph) {
        if (ph > pa.ph_lo && pa.coop) { if (pa.pad == 0x5a5a) { __threadfence(); cg::this_grid().sync(); } else xcd_barrier(xb); }
        asm volatile("" : "+s"(pk)); KP& p = *pk;
        if (ph == 0) { phase_prep(p, lds); continue; }
        if (ph == 42) { int tq = threadIdx.x; asm volatile("" : "+v"(tq)); const unsigned short* w16 = (const unsigned short*)p.ws; for (size_t i = (size_t)bid * 512 + tq; i < (size_t)59418624; i += (size_t)G * 512) p.out[i] = (float)w16[i * 4]; continue; }
        if (ph == 41) { int tq = threadIdx.x; asm volatile("" : "+v"(tq)); for (size_t i = (size_t)bid * 512 + tq; i < (size_t)59418624; i += (size_t)G * 512) { const float v = p.out[i]; if (!(fabsf(v) < 1e30f)) p.out[i] = 0.f; } continue; }
        const int l = (ph - 1) / 10, k = (ph - 1) % 10;
        bf16_t* XB = (bf16_t*)(p.ws + W_XB);
        switch (k) {
        case 0: if (REP_G1 > 1) { pg8::StaticOrder S; S.init(T_ALL, NPROJ, G, bid); EpiNull E{(float*)(p.ws + W_CD)};
                  pg8::gemm_phase(lds, pg8::Gemm{XB, (const bf16_t*)(p.ws + W_IN + l * W_IN_L), T_ALL, NPROJ, DM}, S, E); }
                { pg8::StaticOrder S; S.init(T_ALL, NPROJ, G, bid);
                  EpiIn E{(bf16_t*)(p.ws + W_PROJ), p.out, (float*)(p.ws + W_DTB), p.in[13], l};
                  pg8::gemm_phase(lds, pg8::Gemm{XB, (const bf16_t*)(p.ws + W_IN + l * W_IN_L), T_ALL, NPROJ, DM}, S, E); } break;
        case 1: {
                  unsigned* qctr = (unsigned*)(p.ws + W_BAR + 14336) + l * 64;
                  volatile LAS int* qslot = (volatile LAS int*)(lds + LDS_BYTES - 32);
                  for (;;) {
                      __syncthreads();
                      if (threadIdx.x == 0) qslot[0] = (int)__hip_atomic_fetch_add(qctr, 1u, __ATOMIC_RELAXED, __HIP_MEMORY_SCOPE_AGENT);
                      __syncthreads();
                      const int it = qslot[0];
                      if (it >= 2 * NU64) break;
                      if (it < NU64) attn_unit(p, lds, l, NU64 - 1 - it); else ssd_states(p, lds, l, it - NU64);
                  } } break;
        case 2: for (int it = bid; it < 96 + 768; it += G) { if (it < 96) scan_prompt(p, l, it); else scan_sample(p, l, it - 96); } break;
        case 3: {
                  unsigned* qctr = (unsigned*)(p.ws + W_BAR + 14336) + l * 64 + 32;
                  volatile LAS int* qslot = (volatile LAS int*)(lds + LDS_BYTES - 32);
                  for (;;) {
                      __syncthreads();
                      if (threadIdx.x == 0) qslot[0] = (int)__hip_atomic_fetch_add(qctr, 1u, __ATOMIC_RELAXED, __HIP_MEMORY_SCOPE_AGENT);
                      __syncthreads();
                      const int it = qslot[0];
                      if (it >= 2 * NU64) break;
                      if (it < NU64) ssd_y(p, lds, l, it); else gmlp_unit(p, lds, l, it - NU64);
                  } } break;
        case 4: { pg8::StaticOrder S; S.init(T_ALL, DM, G, bid); EpiRes E{p.out, XB, (bf16_t*)p.out};
                  pg8::gemm_phase(lds, pg8::Gemm{(const bf16_t*)(p.ws + W_MIX), (const bf16_t*)(p.ws + W_OUT + l * W_OUT_L), T_ALL, DM, DM}, S, E); } break;
        case 5: phase_ln(p, (const bf16_t*)p.out, p.in[20] + l * DM, p.in[21] + l * DM, false); break;
        case 6: for (int rep = 0; rep < REP_G3; ++rep) { pg8::StaticOrder S; S.init(T_ALL, DFF2, G, bid);
                  EpiUp E{(bf16_t*)(p.ws + W_PROJ), (float*)(p.ws + W_MIX), p.out, p.in[23], p.in[24], p.in[6], l};
                  pg8::OneUnit o1;
                  for (int i = 0; S.next(i, o1.u); ++i) { pg8::gemm_phase(lds, pg8::Gemm{XB, (const bf16_t*)(p.ws + W_UP + l * W_UP_L), T_ALL, DFF2, DM}, o1, E); __syncthreads(); } } break;
        case 7: phase_fix(p, l); break;
        case 8: { pg8::StaticOrder S; S.init(T_ALL, DM, G, bid); EpiRes E{p.out, XB, (bf16_t*)(p.ws + W_MIX)};
                  pg8::gemm_phase(lds, pg8::Gemm{(const bf16_t*)(p.ws + W_PROJ), (const bf16_t*)(p.ws + W_DN + l * W_DN_L), T_ALL, DM, DFF}, S, E); } break;
        case 9: phase_ln(p, (const bf16_t*)(p.ws + W_MIX), p.in[26] + l * DM, p.in[27] + l * DM, l == DEPTH - 1); break;
        }
    }
}

constexpr int N_PHASES = 41;
#ifndef MULTI_LAUNCH
#define MULTI_LAUNCH 0
#endif

extern "C" void kernel_launch(void* const* d_in, const int* in_sizes, int n_in, void* d_out, int out_size, void* d_ws, size_t ws_size, hipStream_t stream) {
    static int grid = 0;
    if (grid == 0) {
        if (n_in != 28 || ws_size < W_END2) { fprintf(stderr, "kernel_launch: need 28 inputs and %zu bytes of workspace (got %d, %zu)\n", (size_t)W_END2, n_in, ws_size); grid = -1; return; }
        int dev = 0, cus = 0, per_cu = 0;
        hipGetDevice(&dev); hipDeviceGetAttribute(&cus, hipDeviceAttributeMultiprocessorCount, dev);
        if (hipFuncSetAttribute((const void*)mega, hipFuncAttributeMaxDynamicSharedMemorySize, LDS_BYTES) != hipSuccess) { fprintf(stderr, "kernel_launch: hipFuncSetAttribute failed\n"); grid = -1; return; }
        hipOccupancyMaxActiveBlocksPerMultiprocessor(&per_cu, (const void*)mega, 512, LDS_BYTES);
        (void)hipGetLastError();
        if (per_cu < 1) per_cu = 1;
        grid = cus * 1;
    }
    if (grid < 0) return;
    Params p{};
    for (int i = 0; i < 28; ++i) p.in[i] = (const float*)d_in[i];
    p.out = (float*)d_out; p.ws = (unsigned char*)d_ws;
#if MULTI_LAUNCH
#ifdef PROBE_CUT
    for (int ph = 0; ph < PROBE_CUT; ++ph) { p.ph_lo = ph; p.ph_hi = ph + 1; p.coop = 0; hipLaunchKernelGGL(mega, dim3(grid), dim3(512), LDS_BYTES, stream, p); }
    p.ph_lo = 42; p.ph_hi = 43; p.coop = 0; hipLaunchKernelGGL(mega, dim3(grid), dim3(512), LDS_BYTES, stream, p);
#else
    for (int ph = 0; ph < N_PHASES; ++ph) { p.ph_lo = ph; p.ph_hi = ph + 1; p.coop = 0; hipLaunchKernelGGL(mega, dim3(grid), dim3(512), LDS_BYTES, stream, p); }
#endif
#else
    p.ph_lo = 0; p.ph_hi = N_PHASES; p.coop = 1;
    if (hipMemsetAsync((char*)d_ws + W_BAR, 0, 16384, stream) != hipSuccess) { fprintf(stderr, "kernel_launch: memset failed\n"); return; }
    void* args[] = {&p};
    hipError_t e = hipLaunchCooperativeKernel((const void*)mega, dim3(grid), dim3(512), args, LDS_BYTES, stream);
    if (e != hipSuccess) fprintf(stderr, "cooperative launch failed: %s (grid %d)\n", hipGetErrorString(e), grid);
#endif
}
```

```cpp
#define REP_G1 1
#define REP_M1 1
#define REP_ATT 1
#define REP_M3 1
#define REP_G3 1
#include <hip/hip_runtime.h>
#include <hip/hip_cooperative_groups.h>
#include <cstdio>
namespace cg = cooperative_groups;

#define LAS __attribute__((address_space(3)))
typedef unsigned short bf16_t;
typedef short bf16x8 __attribute__((ext_vector_type(8)));
typedef float f32x4 __attribute__((ext_vector_type(4)));
typedef float f32x2 __attribute__((ext_vector_type(2)));
typedef unsigned u32x4 __attribute__((ext_vector_type(4)));
typedef unsigned u32x2 __attribute__((ext_vector_type(2)));

constexpr int T_ALL = 34816, T_P = 32768, DM = 1024, NPROJ = 3072, DFF = 2816, DFF2 = 5632, DEPTH = 4;
constexpr int NU64 = 544;
constexpr float ALPHA = 1.6817928305074290f;
constexpr float LN_EPS = 1e-5f, RMS_EPS = 1e-5f;
constexpr int C_K = 384, C_V = 768, C_Z = 1152, C_XBC = 1536, C_U = 2432, C_VC = 2688, C_DT = 2944;
constexpr size_t O_YP = 0, O_YS = 33554432, O_PK = 35651584, O_PV = O_PK + 3145728, O_PH = O_PV + 3145728, O_PC = O_PH + 786432,
                 O_PF = O_PC + 43008, O_SK = O_PF + 180224, O_SV = O_SK + 3145728, O_SH = O_SV + 3145728, O_SC = O_SH + 6291456,
                 O_SG = O_SC + 344064, O_SF = O_SG + 2097152;
constexpr size_t W_IN = 0, W_IN_L = (size_t)NPROJ * DM * 2;
constexpr size_t W_OUT = W_IN + 4 * W_IN_L, W_OUT_L = (size_t)DM * DM * 2;
constexpr size_t W_UP = W_OUT + 4 * W_OUT_L, W_UP_L = (size_t)DFF2 * DM * 2;
constexpr size_t W_DN = W_UP + 4 * W_UP_L, W_DN_L = (size_t)DM * DFF * 2;
constexpr size_t W_GW = W_DN + 4 * W_DN_L, W_GW_L = (size_t)4 * 128 * 128 * 2;
constexpr size_t W_XB = W_GW + 4 * W_GW_L;
constexpr size_t W_PROJ = W_XB + (size_t)T_ALL * DM * 2;
constexpr size_t W_MIX = W_PROJ + (size_t)T_ALL * NPROJ * 2;
constexpr size_t W_ST = W_MIX + (size_t)T_ALL * DM * 2;
constexpr size_t W_CD = W_ST + (size_t)NU64 * 6 * 8192 * 2;
constexpr size_t W_DTB = W_CD + (size_t)NU64 * 8 * 4;
constexpr size_t W_END = W_DTB + (size_t)T_ALL * 8 * 4;
constexpr size_t W_BAR = W_END;
constexpr size_t W_END2 = W_BAR + 16384;
constexpr int LDS_BYTES = 156 * 1024;

struct Params { const float* in[28]; float* out; unsigned char* ws; int ph_lo, ph_hi, coop, pad; };
typedef const __attribute__((address_space(4))) Params KP;

__device__ __forceinline__ float bf2f(unsigned b) { return __uint_as_float(b << 16); }
typedef __bf16 bf16v2 __attribute__((ext_vector_type(2)));
__device__ __forceinline__ unsigned cvt_pk_bf16(float lo, float hi) { const f32x2 v = {lo, hi}; const bf16v2 b = __builtin_convertvector(v, bf16v2); return __builtin_bit_cast(unsigned, b); }
__device__ __forceinline__ u32x2 pack4(f32x4 v) { u32x2 w; w.x = cvt_pk_bf16(v[0], v[1]); w.y = cvt_pk_bf16(v[2], v[3]); return w; }
__device__ __forceinline__ f32x4 unpack4(u32x2 w) { f32x4 v; v[0] = bf2f(w.x & 0xffffu); v[1] = bf2f(w.x >> 16); v[2] = bf2f(w.y & 0xffffu); v[3] = bf2f(w.y >> 16); return v; }
__device__ __forceinline__ float silu_f(float x) { return x * __builtin_amdgcn_rcpf(1.0f + __expf(-x)); }
__device__ __forceinline__ float gelu_tanh(float x) { const float y = 0.7978845608028654f * (x + 0.044715f * x * x * x); const float e = __expf(2.0f * y); return 0.5f * x * (2.0f - 2.0f * __builtin_amdgcn_rcpf(1.0f + e)); }
__device__ __forceinline__ float softplus_f(float x) { const float e = __expf(x); return x > 15.0f ? x : (e < 1e-3f ? e * (1.0f - 0.5f * e + 0.33333333f * e * e) : __logf(1.0f + e)); }
#define MFMA16(colfrag, rowfrag, acc) __builtin_amdgcn_mfma_f32_16x16x32_bf16((colfrag), (rowfrag), (acc), 0, 0, 0)
__device__ __forceinline__ bf16x8 ldsfrag(LAS const unsigned char* p) { return *(LAS const bf16x8*)p; }
__device__ __forceinline__ bf16x8 glbfrag(const bf16_t* p) { return *(const bf16x8*)p; }
#define LDS_WAVE_SYNC() asm volatile("s_waitcnt lgkmcnt(0)" ::: "memory")

namespace pg8 {
constexpr int BM = 256, BK = 64, HALF = 128, HTB = HALF * BK * 2, STAGE_BYTES = 8 * HTB, NXCD = 8, WGM = 16;
__device__ __forceinline__ int lds_byte(int r, int c) { const int st = (r >> 4) * 2 + (c >> 5), rr = r & 15, cc = c & 31, ob = rr * 64 + cc * 2; return st * 1024 + (ob ^ (((ob >> 9) & 1) << 5)); }
__device__ __forceinline__ void stage_rc(int b, int& R, int& C) { const int st = b / 1024, sb = b % 1024, swz = sb ^ (((sb >> 9) & 1) << 5); R = (st >> 1) * 16 + swz / 64; C = (st & 1) * 32 + (swz % 64) / 2; }
__device__ __forceinline__ int perm32(int rho) { const int n = rho >> 4, i = rho & 15; return 8 * (i >> 2) + 4 * n + (i & 3); }
struct Unit { int pm, pn; };
struct Gemm { const bf16_t* A; const bf16_t* Bt; int M, N, K; };
struct StaticOrder {
    int nM, nN, nwg, G, c;
    __device__ __forceinline__ void init(int M, int N, int G_, int c_) { nM = M / BM; nN = N / BM; nwg = nM * nN; G = G_; c = c_; }
    __device__ __forceinline__ bool next(int i, Unit& u) const {
        const long L = (long)i * G + c; if (L >= nwg) return false;
        int wgid = (int)L; { const int q = nwg / NXCD, r = nwg % NXCD, xcd = wgid % NXCD, off = wgid / NXCD; wgid = (xcd < r ? xcd * (q + 1) : r * (q + 1) + (xcd - r) * q) + off; }
        const int nig = WGM * nN, gid = wgid / nig, fm = gid * WGM, gsz = (nM - fm) < WGM ? (nM - fm) : WGM;
        u.pm = fm + ((wgid % nig) % gsz); u.pn = (wgid % nig) / gsz; return true;
    }
    __device__ __forceinline__ void a_ready(const Unit&) const {}
    __device__ __forceinline__ void done(const Unit&) const {}
};
struct OneUnit {
    Unit u;
    __device__ __forceinline__ bool next(int i, Unit& o) const { if (i) return false; o = u; return true; }
    __device__ __forceinline__ void a_ready(const Unit&) const {}
    __device__ __forceinline__ void done(const Unit&) const {}
};

template <class Epi, class Sched>
__device__ __forceinline__ void gemm_phase(LAS unsigned char* lds, const Gemm g, const Sched& S, const Epi& E) {
    int tid_ = threadIdx.x; asm volatile("" : "+v"(tid_));
    const int tid = tid_, wid = __builtin_amdgcn_readfirstlane(tid >> 6), lane = tid & 63, wr = wid >> 2, wc = wid & 3, fr = lane & 15, fq = lane >> 4;
    const int K = g.K, nt = K / BK;
    unsigned voffA[2], voffB[2];
#pragma unroll
    for (int i = 0; i < 2; ++i) { int R, C; stage_rc(tid * 16 + i * 8192, R, C); const int Rb = (R & ~31) + perm32(R & 31); voffA[i] = (unsigned)(R * K + C) * 2u; voffB[i] = (unsigned)(Rb * K + C) * 2u; }
    const size_t kstep = (size_t)(BK * 2);
    const size_t hstep = (size_t)HALF * K * 2;
    const size_t tstep = 2 * hstep;
    const unsigned ldsw = (unsigned)wid * 1024u;
    const int aoff = lds_byte(wr * 64 + fr, fq * 8), boff = lds_byte(wc * 32 + fr, fq * 8);
#define PG8_SA(b, h) (((b) * 2 + (h)) * HTB)
#define PG8_SB(b, h) ((4 + (b) * 2 + (h)) * HTB)
#define PG8_STAGE(bufoff, gbase, voff) do { _Pragma("unroll") for (int _i = 0; _i < 2; ++_i) \
        __builtin_amdgcn_global_load_lds((const unsigned*)((const char*)(gbase) + (voff)[_i]), (LAS unsigned*)(lds + (bufoff) + ldsw + _i * 8192), 16, 0, 0); } while (0)
#define PG8_LDA(dst, b, h) do { _Pragma("unroll") for (int m = 0; m < 4; ++m) _Pragma("unroll") for (int k = 0; k < 2; ++k) dst[m][k] = *(const LAS bf16x8*)(lds + PG8_SA(b, h) + aoff + m * 2048 + k * 1024); } while (0)
#define PG8_LDB(dst, b, h) do { _Pragma("unroll") for (int n = 0; n < 2; ++n) _Pragma("unroll") for (int k = 0; k < 2; ++k) dst[n][k] = *(const LAS bf16x8*)(lds + PG8_SB(b, h) + boff + n * 2048 + k * 1024); } while (0)
#define PG8_MMA(ai, bj, At, Bt) do { __builtin_amdgcn_s_setprio(1); _Pragma("unroll") for (int m = 0; m < 4; ++m) _Pragma("unroll") for (int n = 0; n < 2; ++n) _Pragma("unroll") for (int k = 0; k < 2; ++k) \
        acc[ai][bj][m][n] = __builtin_amdgcn_mfma_f32_16x16x32_bf16(Bt[n][k], At[m][k], acc[ai][bj][m][n], 0, 0, 0); __builtin_amdgcn_s_setprio(0); } while (0)
#define PG8_WAIT_V(n) asm volatile("s_waitcnt vmcnt(" #n ")" ::: "memory")
#define PG8_WAIT_L(n) asm volatile("s_waitcnt lgkmcnt(" #n ")" ::: "memory")
#define PG8_BAR __builtin_amdgcn_s_barrier()
#define PG8_SCHED __builtin_amdgcn_sched_barrier(0)
    Unit cur, nxt; int ui = 0;
    if (!S.next(0, cur)) return;
    f32x4 acc[2][2][4][2];
#pragma unroll
    for (int a = 0; a < 2; ++a)
#pragma unroll
        for (int b = 0; b < 2; ++b)
#pragma unroll
            for (int m = 0; m < 4; ++m)
#pragma unroll
                for (int n = 0; n < 2; ++n) acc[a][b][m][n] = (f32x4){0.f, 0.f, 0.f, 0.f};
    bf16x8 At[4][2], B0[2][2], B1[2][2];
    const char* cA = (const char*)g.A + (size_t)cur.pm * tstep; const char* cB = (const char*)g.Bt + (size_t)cur.pn * tstep;
    S.a_ready(cur);
    PG8_STAGE(PG8_SB(0, 0), cB, voffB); PG8_STAGE(PG8_SA(0, 0), cA, voffA); PG8_STAGE(PG8_SB(0, 1), cB + hstep, voffB); PG8_STAGE(PG8_SA(0, 1), cA + hstep, voffA);
    if (wr == 1) PG8_BAR;
    PG8_WAIT_V(4); PG8_BAR;
    PG8_STAGE(PG8_SB(1, 0), cB + kstep, voffB); PG8_STAGE(PG8_SA(1, 0), cA + kstep, voffA); PG8_STAGE(PG8_SB(1, 1), cB + hstep + kstep, voffB);
    PG8_WAIT_V(6); PG8_BAR;
    for (;;) {
        const bool has_next = S.next(ui + 1, nxt);
        const char* nA = has_next ? (const char*)g.A + (size_t)nxt.pm * tstep : cA; const char* nB = has_next ? (const char*)g.Bt + (size_t)nxt.pn * tstep : cB;
        for (int t = 0; t < nt; t += 2) {
            const bool last = (t == nt - 2);
            const char* a1 = cA + (size_t)(t + 1) * kstep;
            const char* a2 = last ? nA : cA + (size_t)(t + 2) * kstep; const char* b2 = last ? nB : cB + (size_t)(t + 2) * kstep;
            const char* a3 = a2 + kstep; const char* b3 = b2 + kstep;
            if (last && has_next) S.a_ready(nxt);
            PG8_LDB(B0, 0, 0); PG8_SCHED; PG8_LDA(At, 0, 0); PG8_STAGE(PG8_SA(1, 1), a1 + hstep, voffA);
            PG8_WAIT_L(8); PG8_BAR; PG8_WAIT_L(0); PG8_MMA(0, 0, At, B0); PG8_BAR; PG8_SCHED;
            PG8_LDB(B1, 0, 1); PG8_STAGE(PG8_SB(0, 0), b2, voffB);
            PG8_BAR; PG8_WAIT_L(0); PG8_MMA(0, 1, At, B1); PG8_BAR;
            PG8_LDA(At, 0, 1); PG8_STAGE(PG8_SA(0, 0), a2, voffA);
            PG8_BAR; PG8_WAIT_L(0); PG8_MMA(1, 0, At, B0); PG8_BAR; PG8_SCHED;
            PG8_STAGE(PG8_SB(0, 1), b2 + hstep, voffB);
            PG8_WAIT_V(6); PG8_BAR; PG8_MMA(1, 1, At, B1); PG8_BAR;
            PG8_LDB(B0, 1, 0); PG8_SCHED; PG8_LDA(At, 1, 0); PG8_STAGE(PG8_SA(0, 1), a2 + hstep, voffA);
            PG8_WAIT_L(8); PG8_BAR; PG8_WAIT_L(0); PG8_MMA(0, 0, At, B0); PG8_BAR; PG8_SCHED;
            PG8_LDB(B1, 1, 1); PG8_STAGE(PG8_SB(1, 0), b3, voffB);
            PG8_BAR; PG8_WAIT_L(0); PG8_MMA(0, 1, At, B1); PG8_BAR;
            PG8_LDA(At, 1, 1); PG8_STAGE(PG8_SA(1, 0), a3, voffA);
            PG8_BAR; PG8_WAIT_L(0); PG8_MMA(1, 0, At, B0); PG8_BAR; PG8_SCHED;
            PG8_STAGE(PG8_SB(1, 1), b3 + hstep, voffB);
            PG8_WAIT_V(6); PG8_BAR; PG8_MMA(1, 1, At, B1); PG8_BAR;
        }
        if constexpr (!Epi::AFTER_DRAIN) { E(acc, cur, wr, wc, fr, fq); S.done(cur); }
        if (!has_next) break;
#pragma unroll
        for (int a = 0; a < 2; ++a)
#pragma unroll
            for (int b = 0; b < 2; ++b)
#pragma unroll
                for (int m = 0; m < 4; ++m)
#pragma unroll
                    for (int n = 0; n < 2; ++n) acc[a][b][m][n] = (f32x4){0.f, 0.f, 0.f, 0.f};
        cur = nxt; cA = nA; cB = nB; ++ui;
    }
    PG8_WAIT_V(0);
    if (wr == 0) PG8_BAR;
    PG8_BAR;
    if constexpr (Epi::AFTER_DRAIN) { E.fused(acc, cur, wr, wc, fr, fq, lds, wid, lane); S.done(cur); }
#undef PG8_SA
#undef PG8_SB
#undef PG8_STAGE
#undef PG8_LDA
#undef PG8_LDB
#undef PG8_MMA
#undef PG8_WAIT_V
#undef PG8_WAIT_L
#undef PG8_BAR
#undef PG8_SCHED
}
}
using pg8::Unit;

struct EpiIn {
    static constexpr bool AFTER_DRAIN = false;
    bf16_t* proj; float* out; float* dtb; const float* dt_bias; int l;
    __device__ __forceinline__ void operator()(const f32x4 (&acc)[2][2][4][2], const Unit& u, int wr, int wc, int fr_, int fq_) const {
        int fr = fr_, fq = fq_; asm volatile("" : "+v"(fr), "+v"(fq));
#pragma unroll
        for (int bj = 0; bj < 2; ++bj) {
            const int cb = u.pn * 256 + bj * 128;
            const int col = cb + wc * 32 + fq * 8;
            if (cb > C_DT) continue;
#pragma unroll
            for (int ai = 0; ai < 2; ++ai)
#pragma unroll
                for (int m = 0; m < 4; ++m) {
                    const int row = u.pm * 256 + ai * 128 + wr * 64 + m * 16 + fr;
                    const bool isP = row < T_P; int b, t;
                    if (isP) { b = row >> 13; t = row & 8191; } else { b = (row - T_P) >> 6; t = row & 63; }
                    f32x4 v0 = acc[ai][bj][m][0], v1 = acc[ai][bj][m][1];
                    if (cb < C_U) {
                        u32x4 w; { const u32x2 a = pack4(v0), c = pack4(v1); w.x = a.x; w.y = a.y; w.z = c.x; w.w = c.y; }
                        *(u32x4*)(proj + (size_t)row * NPROJ + col) = w;
                        if (cb >= C_K && cb < C_Z) {
                            const int isv = cb >= C_V; const int cc = col - (isv ? C_V : C_K);
                            float* o = nullptr;
                            if (isP) { if (t >= 7680) o = out + (isv ? O_PV : O_PK) + ((size_t)(l * 4 + b) * 512 + (t - 7680)) * 384 + cc; }
                            else o = out + (isv ? O_SV : O_SK) + ((size_t)(l * 32 + b) * 64 + t) * 384 + cc;
                            if (o) { *(f32x4*)o = v0; *(f32x4*)(o + 4) = v1; }
                        } else if (cb >= C_XBC) {
                            const int cc = col - C_XBC; float* o = nullptr;
                            if (isP) { if (t >= 8189) o = out + O_PC + ((size_t)(l * 4 + b) * 3 + (t - 8189)) * 896 + cc; }
                            else if (t >= 61) o = out + O_SC + ((size_t)(l * 32 + b) * 3 + (t - 61)) * 896 + cc;
                            if (o) { *(f32x4*)o = v0; *(f32x4*)(o + 4) = v1; }
                        }
                    } else if (cb < C_DT) {
#pragma unroll
                        for (int j = 0; j < 4; ++j) { v0[j] = gelu_tanh(v0[j]); v1[j] = gelu_tanh(v1[j]); }
                        u32x4 w; { const u32x2 a = pack4(v0), c = pack4(v1); w.x = a.x; w.y = a.y; w.z = c.x; w.w = c.y; }
                        *(u32x4*)(proj + (size_t)row * NPROJ + col) = w;
                        if (cb >= C_VC && !isP) { float* o = out + O_SG + ((size_t)(l * 32 + b) * 64 + t) * 256 + (col - C_VC); *(f32x4*)o = v0; *(f32x4*)(o + 4) = v1; }
                    } else if (col == C_DT) {
                        float* d = dtb + (size_t)row * 8;
#pragma unroll
                        for (int j = 0; j < 4; ++j) d[j] = softplus_f(v0[j] + dt_bias[l * 6 + j]);
#pragma unroll
                        for (int j = 0; j < 2; ++j) d[4 + j] = softplus_f(v1[j] + dt_bias[l * 6 + 4 + j]);
                    }
                    asm volatile("" ::: "memory");
                }
        }
    }
};
struct EpiNull {
    static constexpr bool AFTER_DRAIN = false;
    float* sink;
    __device__ __forceinline__ void operator()(const f32x4 (&acc)[2][2][4][2], const Unit& u, int wr, int wc, int fr, int fq) const {
        float t = 0.f;
#pragma unroll
        for (int ai = 0; ai < 2; ++ai)
#pragma unroll
            for (int bj = 0; bj < 2; ++bj)
#pragma unroll
                for (int m = 0; m < 4; ++m)
#pragma unroll
                    for (int n = 0; n < 2; ++n) t += acc[ai][bj][m][n][0] + acc[ai][bj][m][n][1] + acc[ai][bj][m][n][2] + acc[ai][bj][m][n][3];
        if (t == 123456.789f) sink[0] = t;
    }
};
struct EpiRes {
    static constexpr bool AFTER_DRAIN = false;
    float* x; const bf16_t* xb; bf16_t* rdst;
    __device__ __forceinline__ void operator()(const f32x4 (&acc)[2][2][4][2], const Unit& u, int wr, int wc, int fr_, int fq_) const {
        int fr = fr_, fq = fq_; asm volatile("" : "+v"(fr), "+v"(fq));
#pragma unroll
        for (int ai = 0; ai < 2; ++ai)
#pragma unroll
            for (int m = 0; m < 4; ++m) {
                float* rowp = x + (size_t)(u.pm * 256 + ai * 128 + wr * 64 + m * 16 + fr) * DM + u.pn * 256 + wc * 32 + fq * 8;
#pragma unroll
                for (int bj = 0; bj < 2; ++bj) { float* q = rowp + bj * 128; const u32x4 xw = *(const u32x4*)(xb + (q - x));
                    const f32x4 o0 = unpack4((u32x2){xw.x, xw.y}), o1 = unpack4((u32x2){xw.z, xw.w});
                    const u32x2 ra = pack4(o0 * ALPHA + acc[ai][bj][m][0]), rb = pack4(o1 * ALPHA + acc[ai][bj][m][1]);
                    *(u32x4*)(rdst + (q - x)) = (u32x4){ra.x, ra.y, rb.x, rb.y}; }
                asm volatile("" ::: "memory");
            }
    }
};
struct EpiUp {
    static constexpr bool AFTER_DRAIN = true;
    bf16_t* H; float* halo; float* out; const float* cw; const float* cb; const float* fstate; int l;
    __device__ __forceinline__ void operator()(const f32x4 (&)[2][2][4][2], const Unit&, int, int, int, int) const {}
    __device__ __forceinline__ void fused(f32x4 (&acc)[2][2][4][2], const Unit& u, int wr, int wc, int fr, int fq, LAS unsigned char* lds, int wid, int lane) const {
        constexpr int LS = 264;
#pragma unroll
        for (int ai = 0; ai < 2; ++ai)
#pragma unroll
            for (int m = 0; m < 4; ++m)
#pragma unroll
                for (int bj = 0; bj < 2; ++bj) {
                        const int rl = ai * 128 + wr * 64 + m * 16 + fr, cl = bj * 128 + wc * 32 + fq * 8;
                        u32x4 w; { const u32x2 a = pack4(acc[ai][bj][m][0]), c = pack4(acc[ai][bj][m][1]); w.x = a.x; w.y = a.y; w.z = c.x; w.w = c.y; }
                        *(LAS u32x4*)(lds + (rl * LS + cl) * 2) = w;
                    }
        __syncthreads();
        const int tid = wid * 64 + lane, j = 2 * (tid & 63), seg = tid >> 6;
        const int hcol = u.pn * 128 + j;
        const float* w = cw + (size_t)l * 3 * DFF2 + hcol; const float* bb = cb + (size_t)l * DFF2 + hcol;
        const f32x2 wg0 = *(const f32x2*)w, wg1 = *(const f32x2*)(w + DFF2), wg2 = *(const f32x2*)(w + 2 * DFF2), bg = *(const f32x2*)bb;
        const f32x2 wv0 = *(const f32x2*)(w + DFF), wv1 = *(const f32x2*)(w + DFF2 + DFF), wv2 = *(const f32x2*)(w + 2 * DFF2 + DFF), bv = *(const f32x2*)(bb + DFF);
        const int r0 = seg * 32, R = u.pm * 256 + r0;
        const bool isP = R < T_P;
        const LAS unsigned char* U = (const LAS unsigned char*)lds;
#define UP2(row, off) ({ const unsigned w_ = *(const LAS unsigned*)(U + ((row) * LS + (off) + j) * 2); (f32x2){bf2f(w_ & 0xffffu), bf2f(w_ >> 16)}; })
        f32x2 g2 = (f32x2){0.f, 0.f}, g1 = g2, v2 = g2, v1 = g2; int skip = 0;
        if (isP) {
            if (seg > 0) { g2 = UP2(r0 - 2, 0); g1 = UP2(r0 - 1, 0); v2 = UP2(r0 - 2, 128); v1 = UP2(r0 - 1, 128); }
            else if ((R & 8191) != 0) skip = 2;
        } else if (seg & 1) { g2 = UP2(r0 - 2, 0); g1 = UP2(r0 - 1, 0); v2 = UP2(r0 - 2, 128); v1 = UP2(r0 - 1, 128); }
        else { const int sb = (R - T_P) >> 6; const float* fs = fstate + (size_t)(l * 32 + sb) * 2 * DFF2 + hcol;
            g2 = *(const f32x2*)fs; g1 = *(const f32x2*)(fs + DFF2); v2 = *(const f32x2*)(fs + DFF); v1 = *(const f32x2*)(fs + DFF2 + DFF); }
        bf16_t* hp = H + (size_t)R * DFF + hcol;
#pragma unroll 8
        for (int i = 0; i < 32; ++i) {
            const f32x2 gq = UP2(r0 + i, 0), vq = UP2(r0 + i, 128);
            if (i >= skip) {
                const f32x2 cgv = bg + wg0 * g2 + wg1 * g1 + wg2 * gq, cvv = bv + wv0 * v2 + wv1 * v1 + wv2 * vq;
                *(unsigned*)(hp + (size_t)i * DFF) = cvt_pk_bf16(silu_f(cgv[0]) * cvv[0], silu_f(cgv[1]) * cvv[1]);
            }
            g2 = g1; g1 = gq; v2 = v1; v1 = vq;
            if (isP) {
                if (seg == 0 && i < 2) { float* hl = halo + ((size_t)u.pm * 4 + i) * DFF2 + hcol; *(f32x2*)hl = gq; *(f32x2*)(hl + DFF) = vq; }
                if (seg == 7 && i >= 30) { float* hl = halo + ((size_t)u.pm * 4 + 2 + (i - 30)) * DFF2 + hcol; *(f32x2*)hl = gq; *(f32x2*)(hl + DFF) = vq;
                    if ((u.pm & 31) == 31) { float* o = out + O_PF + ((size_t)(l * 4 + (u.pm >> 5)) * 2 + (i - 30)) * DFF2 + hcol; *(f32x2*)o = gq; *(f32x2*)(o + DFF) = vq; } }
            } else if ((seg & 1) && i >= 30) {
                const int sb = (R - 32 - T_P) >> 6; float* o = out + O_SF + ((size_t)(l * 32 + sb) * 2 + (i - 30)) * DFF2 + hcol; *(f32x2*)o = gq; *(f32x2*)(o + DFF) = vq;
            }
        }
#undef UP2
    }
};

__device__ __forceinline__ void ln_row(const float* src, const bf16_t* srcb, float* x32, bf16_t* xb, const float* g, const float* b, int lane) {
    f32x4 v[4]; float s = 0.f;
#pragma unroll
    for (int i = 0; i < 4; ++i) { v[i] = srcb ? unpack4(*(const u32x2*)(srcb + i * 256 + lane * 4)) : *(const f32x4*)(src + i * 256 + lane * 4); s += (v[i][0] + v[i][1]) + (v[i][2] + v[i][3]); }
#pragma unroll
    for (int o = 32; o >= 1; o >>= 1) s += __shfl_xor(s, o);
    const float mu = s * (1.0f / 1024.0f); float q = 0.f;
#pragma unroll
    for (int i = 0; i < 4; ++i) { const f32x4 d = v[i] - mu; q += (d[0] * d[0] + d[1] * d[1]) + (d[2] * d[2] + d[3] * d[3]); }
#pragma unroll
    for (int o = 32; o >= 1; o >>= 1) q += __shfl_xor(q, o);
    const float rstd = 1.0f / sqrtf(q * (1.0f / 1024.0f) + LN_EPS);
#pragma unroll
    for (int i = 0; i < 4; ++i) {
        const f32x4 gg = *(const f32x4*)(g + i * 256 + lane * 4), bb = *(const f32x4*)(b + i * 256 + lane * 4);
        const f32x4 o = (v[i] - mu) * rstd * gg + bb;
        if (x32) *(f32x4*)(x32 + i * 256 + lane * 4) = o;
        if (xb) *(u32x2*)(xb + i * 256 + lane * 4) = pack4(o);
    }
}

__device__ __forceinline__ void tr_tile(LAS float* tile, const float* src, int Nsrc, bf16_t* dst, int K, int n0, int k0, int mode, int tid) {
    const int nn = tid & 63, np = n0 + nn; int sc;
    if (mode == 0) sc = np < C_U ? np : (np < C_DT ? np + 6 : (np < C_DT + 6 ? np - 512 : -1));
    else if (mode == 1) sc = np;
    else { const int pn = np >> 8, jj = np & 255; sc = jj < 128 ? pn * 128 + jj : DFF + pn * 128 + (jj - 128); }
#pragma unroll
    for (int i = 0; i < 8; ++i) { const int kk = (tid >> 6) + 8 * i; tile[kk * 65 + nn] = sc >= 0 ? src[(size_t)(k0 + kk) * Nsrc + sc] : 0.f; }
    __syncthreads();
    const int kk2 = (tid & 31) * 2;
#pragma unroll
    for (int i = 0; i < 4; ++i) { const int nn2 = (tid >> 5) + 16 * i; *(unsigned*)(dst + (size_t)(n0 + nn2) * K + k0 + kk2) = cvt_pk_bf16(tile[kk2 * 65 + nn2], tile[(kk2 + 1) * 65 + nn2]); }
    __syncthreads();
}

__device__ __forceinline__ void phase_prep(KP& p, LAS unsigned char* lds) {
    int tid_ = threadIdx.x; asm volatile("" : "+v"(tid_));
    const int tid = tid_, wid = tid >> 6, lane = tid & 63;
    for (int row = blockIdx.x * 8 + wid; row < T_ALL; row += gridDim.x * 8) {
        const float* src = row < T_P ? p.in[0] + (size_t)row * DM : p.in[1] + (size_t)(row - T_P) * DM;
        ln_row(src, nullptr, nullptr, (bf16_t*)(p.ws + W_XB) + (size_t)row * DM, p.in[7], p.in[8], lane);
    }
    constexpr int T_IN = 48 * 16, T_OUT = 16 * 16, T_UPT = 88 * 16, T_DNT = 16 * 44, T_L = T_IN + T_OUT + T_UPT + T_DNT;
    for (int it = blockIdx.x; it < 4 * T_L; it += gridDim.x) {
        const int l = it / T_L; int r = it % T_L;
        if (r < T_IN) tr_tile((LAS float*)lds, p.in[9] + (size_t)l * DM * 2950, 2950, (bf16_t*)(p.ws + W_IN + l * W_IN_L), DM, (r >> 4) * 64, (r & 15) * 64, 0, tid);
        else if ((r -= T_IN) < T_OUT) tr_tile((LAS float*)lds, p.in[19] + (size_t)l * DM * DM, DM, (bf16_t*)(p.ws + W_OUT + l * W_OUT_L), DM, (r >> 4) * 64, (r & 15) * 64, 1, tid);
        else if ((r -= T_OUT) < T_UPT) tr_tile((LAS float*)lds, p.in[22] + (size_t)l * DM * DFF2, DFF2, (bf16_t*)(p.ws + W_UP + l * W_UP_L), DM, (r >> 4) * 64, (r & 15) * 64, 2, tid);
        else { r -= T_UPT; tr_tile((LAS float*)lds, p.in[25] + (size_t)l * DFF * DM, DM, (bf16_t*)(p.ws + W_DN + l * W_DN_L), DFF, (r / 44) * 64, (r % 44) * 64, 1, tid); }
    }
    for (int i = blockIdx.x * 512 + tid; i < 4 * 4 * 128 * 128; i += gridDim.x * 512) {
        const int jj = i & 127, ii = (i >> 7) & 127;
        ((bf16_t*)(p.ws + W_GW))[i] = (bf16_t)(cvt_pk_bf16(jj <= ii ? p.in[16][i] : 0.f, 0.f) & 0xffffu);
    }
}

__device__ __forceinline__ void phase_ln(KP& p, const bf16_t* rsrc, const float* g, const float* b, bool final_out) {
    int tid_ = threadIdx.x; asm volatile("" : "+v"(tid_));
    const int wid = tid_ >> 6, lane = tid_ & 63;
    for (int row = blockIdx.x * 8 + wid; row < T_ALL; row += gridDim.x * 8)
        ln_row(nullptr, rsrc + (size_t)row * DM, final_out ? p.out + (size_t)row * DM : nullptr, final_out ? nullptr : (bf16_t*)(p.ws + W_XB) + (size_t)row * DM, g, b, lane);
}

__device__ __forceinline__ void dt_scan(KP& p, int l, int u, int g, int wid, int lane, float& dt, float& ac, float& last) {
    const int h = g * 3 + wid;
    dt = ((const float*)(p.ws + W_DTB))[(size_t)(u * 64 + lane) * 8 + h];
    const float a = -__expf(p.in[14][l * 6 + h]);
    float v = dt * a;
#pragma unroll
    for (int o = 1; o < 64; o <<= 1) { const float t = __shfl_up(v, o); if (lane >= o) v += t; }
    ac = v; last = __shfl(v, 63);
}

__device__ __forceinline__ f32x4 xbc_row(KP& p, int l, int u, int s, int ch) {
    const bf16_t* proj = (const bf16_t*)(p.ws + W_PROJ);
    const bool isP = u < 512; const bool hasprev = isP && (u & 127) != 0;
    if (s >= 0 || hasprev) return unpack4(*(const u32x2*)(proj + (size_t)(u * 64 + s) * NPROJ + C_XBC + ch));
    if (!isP) return *(const f32x4*)(p.in[5] + (unsigned)(((l * 32 + (u - 512)) * 3 + (3 + s)) * 896 + ch));
    return (f32x4){0.f, 0.f, 0.f, 0.f};
}
__device__ __forceinline__ void ssd_states(KP& p, LAS unsigned char* lds, int l, int u) {
    int tid_ = threadIdx.x; asm volatile("" : "+v"(tid_));
    const int tid = tid_, wid = tid >> 6, lane = tid & 63, fr = lane & 15, fq = lane >> 4;
    LAS bf16_t* xT = (LAS bf16_t*)lds;
    LAS bf16_t* BT = (LAS bf16_t*)(lds + 55296);
    LAS float* wgt = (LAS float*)(lds + 92160);
    bf16_t* XC = (bf16_t*)p.out;
    __syncthreads();
    if (wid < 6) {
        float dt, ac, last; dt_scan(p, l, u, wid / 3, wid % 3, lane, dt, ac, last);
        wgt[wid * 64 + lane] = dt * __expf(last - ac);
        if (lane == 0) ((float*)(p.ws + W_CD))[u * 8 + wid] = __expf(last);
    }
    __syncthreads();
    if (tid < 448) {
        const int cgp = tid % 224, seg = tid / 224, ch = cgp * 4, r0 = seg * 32;
        const float* cw = p.in[11] + (size_t)l * 4 * 896 + ch;
        const f32x4 w0 = *(const f32x4*)cw, w1 = *(const f32x4*)(cw + 896), w2 = *(const f32x4*)(cw + 2 * 896), w3 = *(const f32x4*)(cw + 3 * 896);
        const f32x4 bs = *(const f32x4*)(p.in[12] + (size_t)l * 896 + ch);
        f32x4 xm3 = xbc_row(p, l, u, r0 - 3, ch), xm2 = xbc_row(p, l, u, r0 - 2, ch), xm1 = xbc_row(p, l, u, r0 - 1, ch);
        const bf16_t* src = (const bf16_t*)(p.ws + W_PROJ) + (size_t)(u * 64) * NPROJ + C_XBC + ch;
        bf16_t* dst = XC + (size_t)(u * 64) * 896 + ch;
        const int hh = ch >> 6;
#pragma unroll 2
        for (int i = r0; i < r0 + 32; i += 2) {
            const f32x4 xa = unpack4(*(const u32x2*)(src + (size_t)i * NPROJ)), xb = unpack4(*(const u32x2*)(src + (size_t)(i + 1) * NPROJ));
            f32x4 ya = bs + w0 * xm3 + w1 * xm2 + w2 * xm1 + w3 * xa, yb = bs + w0 * xm2 + w1 * xm1 + w2 * xa + w3 * xb;
#pragma unroll
            for (int e = 0; e < 4; ++e) { ya[e] = silu_f(ya[e]); yb[e] = silu_f(yb[e]); }
            xm3 = xm1; xm2 = xa; xm1 = xb;
            *(u32x2*)(dst + (size_t)i * 896) = pack4(ya); *(u32x2*)(dst + (size_t)(i + 1) * 896) = pack4(yb);
            if (ch < 384) { const float wa = wgt[hh * 64 + i], wb = wgt[hh * 64 + i + 1];
#pragma unroll
                for (int e = 0; e < 4; ++e) *(LAS unsigned*)(xT + (ch + e) * 72 + i) = cvt_pk_bf16(ya[e] * wa, yb[e] * wb); }
            else if (ch < 640) {
#pragma unroll
                for (int e = 0; e < 4; ++e) *(LAS unsigned*)(BT + (ch - 384 + e) * 72 + i) = cvt_pk_bf16(ya[e], yb[e]); }
        }
    }
    __syncthreads();
    bf16_t* ST = (bf16_t*)(p.ws + W_ST);
#pragma unroll 2
    for (int k = 0; k < 24; ++k) {
        const int tt = wid * 24 + k, h = tt >> 5, pt = (tt & 31) >> 3, nt = tt & 7, g = h / 3;
        f32x4 acc = (f32x4){0.f, 0.f, 0.f, 0.f};
#pragma unroll
        for (int ks = 0; ks < 2; ++ks) {
            const bf16x8 rf = ldsfrag((LAS const unsigned char*)(xT + (h * 64 + pt * 16 + fr) * 72 + ks * 32 + fq * 8));
            const bf16x8 cf = ldsfrag((LAS const unsigned char*)(BT + (g * 128 + nt * 16 + fr) * 72 + ks * 32 + fq * 8));
            acc = MFMA16(cf, rf, acc);
        }
        *(u32x2*)(ST + ((size_t)(u * 6 + h) * 64 + pt * 16 + fr) * 128 + nt * 16 + fq * 4) = pack4(acc);
    }
}

__device__ __forceinline__ void gmlp_unit(KP& p, LAS unsigned char* lds, int l, int u) {
    int tid_ = threadIdx.x; asm volatile("" : "+v"(tid_));
    const int tid = tid_, wid = tid >> 6, lane = tid & 63, fr = lane & 15, fq = lane >> 4;
    LAS bf16_t* vT = (LAS bf16_t*)lds;
    LAS float* ssq = (LAS float*)(lds + 69632);
    const bf16_t* proj = (const bf16_t*)(p.ws + W_PROJ);
    const int half = u < 512 ? (u & 1) : 0, KJ = (half + 1) * 64, R0 = u * 64, Rb = R0 - half * 64;
    __syncthreads();
    for (int idx = tid; idx < KJ * 32; idx += 512) {
        const int j = idx & (KJ - 1), cgp = idx / KJ;
        const u32x4 w = *(const u32x4*)(proj + (size_t)(Rb + j) * NPROJ + C_VC + cgp * 8);
        const unsigned ww[4] = {w.x, w.y, w.z, w.w};
#pragma unroll
        for (int e = 0; e < 4; ++e) { vT[(cgp * 8 + 2 * e) * 136 + j] = (bf16_t)(ww[e] & 0xffffu); vT[(cgp * 8 + 2 * e + 1) * 136 + j] = (bf16_t)(ww[e] >> 16); }
    }
    __syncthreads();
    const int rt = wid & 3, cbase = (wid >> 2) * 8;
    const bf16_t* GW = (const bf16_t*)(p.ws + W_GW + l * W_GW_L);
    f32x4 acc[8];
#pragma unroll
    for (int gi = 0; gi < 2; ++gi) {
        const int gg = (cbase >> 2) + gi;
        bf16x8 rf[4];
#pragma unroll
        for (int ks = 0; ks < 4; ++ks) rf[ks] = glbfrag(GW + ((size_t)gg * 128 + half * 64 + rt * 16 + fr) * 128 + ks * 32 + fq * 8);
#pragma unroll
        for (int c4 = 0; c4 < 4; ++c4) {
            const int ct = cbase + gi * 4 + c4;
            f32x4 a = (f32x4){0.f, 0.f, 0.f, 0.f};
#pragma unroll
            for (int ks = 0; ks < 4; ++ks) if (ks * 32 < KJ) a = MFMA16(ldsfrag((LAS const unsigned char*)(vT + (ct * 16 + fr) * 136 + ks * 32 + fq * 8)), rf[ks], a);
            acc[gi * 4 + c4] = a;
        }
    }
    const int row = R0 + rt * 16 + fr; float sq = 0.f;
#pragma unroll
    for (int k = 0; k < 8; ++k) {
        const int col = (cbase + k) * 16 + fq * 4, gg = col >> 6;
        const float bsv = p.in[17][(size_t)(l * 4 + gg) * 128 + half * 64 + rt * 16 + fr];
        const f32x4 uv = unpack4(*(const u32x2*)(proj + (size_t)row * NPROJ + C_U + col));
        f32x4 o = uv * (acc[k] + bsv); acc[k] = o;
        sq += (o[0] * o[0] + o[1] * o[1]) + (o[2] * o[2] + o[3] * o[3]);
    }
    sq += __shfl_xor(sq, 16); sq += __shfl_xor(sq, 32);
    if (fq == 0) ssq[(wid >> 2) * 64 + rt * 16 + fr] = sq;
    __syncthreads();
    const float rstd = 1.0f / sqrtf((ssq[rt * 16 + fr] + ssq[64 + rt * 16 + fr]) * (1.0f / 256.0f) + RMS_EPS);
    bf16_t* mix = (bf16_t*)(p.ws + W_MIX);
#pragma unroll
    for (int k = 0; k < 8; ++k) {
        const int col = (cbase + k) * 16 + fq * 4;
        const f32x4 gv = *(const f32x4*)(p.in[18] + (size_t)l * 1024 + 768 + col);
        *(u32x2*)(mix + (size_t)row * DM + 768 + col) = pack4(acc[k] * rstd * gv);
    }
}

__device__ __forceinline__ void scan_prompt(KP& p, int l, int item) {
    int tid_ = threadIdx.x; asm volatile("" : "+v"(tid_));
    const int gid = item * 512 + tid_, e = (gid & 2047) * 4, bh = gid >> 11, b = bh / 6, h = bh % 6;
    bf16_t* ST = (bf16_t*)(p.ws + W_ST); const float* CD = (const float*)(p.ws + W_CD);
    f32x4 st = (f32x4){0.f, 0.f, 0.f, 0.f};
#pragma unroll 1
    for (int c0 = 0; c0 < 128; c0 += 16) {
        u32x2 s[16]; float cd[16];
#pragma unroll
        for (int k = 0; k < 16; ++k) { const int u = b * 128 + c0 + k; s[k] = *(const u32x2*)(ST + ((size_t)(u * 6 + h)) * 8192 + e); cd[k] = CD[u * 8 + h]; }
#pragma unroll
        for (int k = 0; k < 16; ++k) { const int u = b * 128 + c0 + k; *(u32x2*)(ST + ((size_t)(u * 6 + h)) * 8192 + e) = pack4(st); st = st * cd[k] + unpack4(s[k]); }
    }
    *(f32x4*)(p.out + O_PH + ((size_t)(l * 4 + b) * 6 + h) * 8192 + e) = st;
}
__device__ __forceinline__ void scan_sample(KP& p, int l, int item) {
    int tid_ = threadIdx.x; asm volatile("" : "+v"(tid_));
    const int gid = item * 512 + tid_, e = (gid & 2047) * 4, sbh = gid >> 11, sb = sbh / 6, h = sbh % 6;
    bf16_t* ST = (bf16_t*)(p.ws + W_ST); const float* CD = (const float*)(p.ws + W_CD);
    const int u = 512 + sb;
    const f32x4 st = *(const f32x4*)(p.in[4] + ((size_t)(l * 32 + sb) * 6 + h) * 8192 + e);
    const f32x4 s = unpack4(*(const u32x2*)(ST + ((size_t)(u * 6 + h)) * 8192 + e));
    *(u32x2*)(ST + ((size_t)(u * 6 + h)) * 8192 + e) = pack4(st);
    *(f32x4*)(p.out + O_SH + ((size_t)(l * 32 + sb) * 6 + h) * 8192 + e) = st * CD[u * 8 + h] + s;
}

__device__ __forceinline__ void attn_unit(KP& p, LAS unsigned char* lds, int l, int u) {
    int tid_ = threadIdx.x; asm volatile("" : "+v"(tid_));
    const int tid = tid_, wid = tid >> 6, lane = tid & 63, fr = lane & 15, fq = lane >> 4;
    LAS bf16_t* VT = (LAS bf16_t*)(lds + 98304);
    LAS float* bias = (LAS float*)(lds + 153600);
    LAS float* ssq = (LAS float*)(lds + 158208);
    const bf16_t* proj = (const bf16_t*)(p.ws + W_PROJ);
    const bool isP = u < 512; const int R0 = u * 64, c = u & 127, b = u >> 7, sb = u - 512;
    const int qt = wid & 3, hbase = (wid >> 2) * 3;
    __syncthreads();
    for (int i = tid; i < 1152; i += 512) bias[i] = p.in[10][(size_t)l * 1152 + i];
    bf16x8 qf[3][2];
#pragma unroll
    for (int hh = 0; hh < 3; ++hh)
#pragma unroll
        for (int ks = 0; ks < 2; ++ks) qf[hh][ks] = glbfrag(proj + (size_t)(R0 + qt * 16 + fr) * NPROJ + (hbase + hh) * 64 + ks * 32 + fq * 8);
    float mrun[3], lrun[3]; f32x4 O[3][4];
#pragma unroll
    for (int hh = 0; hh < 3; ++hh) { mrun[hh] = -1e30f; lrun[hh] = 0.f;
#pragma unroll
        for (int d = 0; d < 4; ++d) O[hh][d] = (f32x4){0.f, 0.f, 0.f, 0.f}; }
    const int blk_lo = isP ? (c < 8 ? 8 - c : 0) : 0;
    u32x4 vr[6];
    const int vkp = tid & 31, vcg0 = tid >> 5;
#define ATT_LOADP(blkv, bufv) do { const size_t rb_ = isP ? (size_t)b * 8192 + (size_t)(c - 8 + (blkv)) * 64 : (size_t)T_P + (size_t)sb * 64; \
        _Pragma("unroll") for (int it = 0; it < 6; ++it) { const int pu_ = it * 512 + tid, row_ = pu_ / 48, un_ = (pu_ % 48) ^ (row_ & 15); \
            __builtin_amdgcn_global_load_lds((const unsigned*)(proj + (rb_ + row_) * NPROJ + C_K + un_ * 8), (LAS unsigned*)(lds + (bufv) * 49152 + (it * 512 + wid * 64) * 16), 16, 0, 0); } \
        _Pragma("unroll") for (int it = 0; it < 2; ++it) { const int cg_ = vcg0 + it * 16; \
            vr[2 * it] = *(const u32x4*)(proj + (rb_ + 2 * vkp) * NPROJ + C_V + cg_ * 8); vr[2 * it + 1] = *(const u32x4*)(proj + (rb_ + 2 * vkp + 1) * NPROJ + C_V + cg_ * 8); } } while (0)
    bool have = false; int cur = 0;
    if (isP || blk_lo == 8) { ATT_LOADP(blk_lo, 0); have = true; }
#pragma unroll 1
    for (int blk = blk_lo; blk <= 8; ++blk) {
        LAS unsigned char* Kc = lds + cur * 49152;
        __syncthreads();
        if (!have) {
#pragma unroll
            for (int it = 0; it < 6; ++it) { const int idx = it * 512 + tid, row_ = idx / 48, un_ = idx % 48;
                const float* s = p.in[2] + ((size_t)(l * 32 + sb) * 512 + blk * 64 + row_) * 384 + un_ * 8; const f32x4 a = *(const f32x4*)s, bq = *(const f32x4*)(s + 4);
                u32x4 w; w.x = cvt_pk_bf16(a[0], a[1]); w.y = cvt_pk_bf16(a[2], a[3]); w.z = cvt_pk_bf16(bq[0], bq[1]); w.w = cvt_pk_bf16(bq[2], bq[3]);
                *(LAS u32x4*)(Kc + row_ * 768 + ((un_ ^ (row_ & 15)) * 16)) = w; }
#pragma unroll
            for (int it = 0; it < 6; ++it) { const int cg_ = vcg0 + (it >> 1) * 16;
                const float* s = p.in[3] + ((size_t)(l * 32 + sb) * 512 + blk * 64 + 2 * vkp + (it & 1)) * 384 + cg_ * 8; const f32x4 a = *(const f32x4*)s, bq = *(const f32x4*)(s + 4);
                vr[it].x = cvt_pk_bf16(a[0], a[1]); vr[it].y = cvt_pk_bf16(a[2], a[3]); vr[it].z = cvt_pk_bf16(bq[0], bq[1]); vr[it].w = cvt_pk_bf16(bq[2], bq[3]); }
        }
        if (have) { const size_t rb_ = isP ? (size_t)b * 8192 + (size_t)(c - 8 + blk) * 64 : (size_t)T_P + (size_t)sb * 64; const int cg_ = vcg0 + 2 * 16;
            vr[4] = *(const u32x4*)(proj + (rb_ + 2 * vkp) * NPROJ + C_V + cg_ * 8); vr[5] = *(const u32x4*)(proj + (rb_ + 2 * vkp + 1) * NPROJ + C_V + cg_ * 8); }
#pragma unroll
        for (int it = 0; it < 3; ++it) { const int cg_ = vcg0 + it * 16; const u32x4 w0 = vr[2 * it], w1 = vr[2 * it + 1];
            const unsigned a0[4] = {w0.x, w0.y, w0.z, w0.w}, a1[4] = {w1.x, w1.y, w1.z, w1.w};
#pragma unroll
            for (int e = 0; e < 4; ++e) {
                *(LAS unsigned*)(VT + (cg_ * 8 + 2 * e) * 72 + 2 * vkp) = (a0[e] & 0xffffu) | (a1[e] << 16);
                *(LAS unsigned*)(VT + (cg_ * 8 + 2 * e + 1) * 72 + 2 * vkp) = (a0[e] >> 16) | (a1[e] & 0xffff0000u); } }
        asm volatile("s_waitcnt vmcnt(0)" ::: "memory");
        __syncthreads();
        have = false;
        if (blk < 8 && (isP || blk == 7)) { ATT_LOADP(blk + 1, cur ^ 1); have = true; }
#pragma unroll
        for (int hh = 0; hh < 3; ++hh) {
            const int h = hbase + hh;
            f32x4 s[4]; float mx = -1e30f;
#pragma unroll
            for (int kt = 0; kt < 4; ++kt) {
                f32x4 a = (f32x4){0.f, 0.f, 0.f, 0.f};
#pragma unroll
                for (int ks = 0; ks < 2; ++ks) a = MFMA16(ldsfrag((LAS const unsigned char*)(Kc + (kt * 16 + fr) * 768 + (((h * 8 + ks * 4 + fq) ^ fr) * 16))), qf[hh][ks], a);
                if (blk <= 5) { const float bc = bias[h * 192 + 191];
#pragma unroll
                    for (int j = 0; j < 4; ++j) { a[j] = a[j] * 0.125f + bc; mx = fmaxf(mx, a[j]); } }
                else {
#pragma unroll
                    for (int j = 0; j < 4; ++j) {
                        int rel = (qt * 16 + fr) + 512 - (blk * 64 + kt * 16 + fq * 4 + j); rel = rel > 128 ? 128 : rel;
                        a[j] = a[j] * 0.125f + bias[h * 192 + rel + 63]; mx = fmaxf(mx, a[j]);
                    } }
                s[kt] = a;
            }
            mx = fmaxf(mx, __shfl_xor(mx, 16)); mx = fmaxf(mx, __shfl_xor(mx, 32));
            const float mnew = fmaxf(mrun[hh], mx), fac = __expf(mrun[hh] - mnew); mrun[hh] = mnew;
            float rs = 0.f;
#pragma unroll
            for (int kt = 0; kt < 4; ++kt)
#pragma unroll
                for (int j = 0; j < 4; ++j) { s[kt][j] = __expf(s[kt][j] - mnew); rs += s[kt][j]; }
            lrun[hh] = lrun[hh] * fac + rs;
#pragma unroll
            for (int d = 0; d < 4; ++d) O[hh][d] *= fac;
#pragma unroll
            for (int ks = 0; ks < 2; ++ks) {
                const u32x2 pa = pack4(s[2 * ks]), pb = pack4(s[2 * ks + 1]);
                const bf16x8 pf = __builtin_bit_cast(bf16x8, (u32x4){pa.x, pa.y, pb.x, pb.y});
#pragma unroll
                for (int d = 0; d < 4; ++d) {
                    const LAS bf16_t* vrow = VT + (h * 64 + d * 16 + fr) * 72 + ks * 32 + fq * 4;
                    const u32x2 va = *(const LAS u32x2*)vrow, vb = *(const LAS u32x2*)(vrow + 16);
                    O[hh][d] = MFMA16(__builtin_bit_cast(bf16x8, (u32x4){va.x, va.y, vb.x, vb.y}), pf, O[hh][d]);
                }
            }
        }
        cur ^= 1;
    }
#pragma unroll
    for (int hh = 0; hh < 3; ++hh) { lrun[hh] += __shfl_xor(lrun[hh], 16); lrun[hh] += __shfl_xor(lrun[hh], 32); }
    float sq = 0.f;
#pragma unroll
    for (int hh = 0; hh < 3; ++hh) { const float inv = 1.0f / lrun[hh];
#pragma unroll
        for (int d = 0; d < 4; ++d) { O[hh][d] *= inv; const f32x4 o = O[hh][d]; sq += (o[0] * o[0] + o[1] * o[1]) + (o[2] * o[2] + o[3] * o[3]); } }
    sq += __shfl_xor(sq, 16); sq += __shfl_xor(sq, 32);
    if (fq == 0) ssq[(wid >> 2) * 64 + qt * 16 + fr] = sq;
    __syncthreads();
    const float rstd = 1.0f / sqrtf((ssq[qt * 16 + fr] + ssq[64 + qt * 16 + fr]) * (1.0f / 384.0f) + RMS_EPS);
    bf16_t* mix = (bf16_t*)(p.ws + W_MIX);
#pragma unroll
    for (int hh = 0; hh < 3; ++hh)
#pragma unroll
        for (int d = 0; d < 4; ++d) {
            const int col = (hbase + hh) * 64 + d * 16 + fq * 4;
            const f32x4 gv = *(const f32x4*)(p.in[18] + (size_t)l * 1024 + col);
            *(u32x2*)(mix + (size_t)(R0 + qt * 16 + fr) * DM + col) = pack4(O[hh][d] * rstd * gv);
        }
}

__device__ __forceinline__ void ssd_y(KP& p, LAS unsigned char* lds, int l, int u) {
    int tid_ = threadIdx.x; asm volatile("" : "+v"(tid_));
    const int tid = tid_, wid = tid >> 6, lane = tid & 63, fr = lane & 15, fq = lane >> 4;
    LAS bf16_t* Cn = (LAS bf16_t*)lds;
    LAS bf16_t* Bn = (LAS bf16_t*)(lds + 17408);
    LAS bf16_t* xT = (LAS bf16_t*)(lds + 34816);
    LAS bf16_t* Mm = (LAS bf16_t*)(lds + 62464);
    LAS float* dtl = (LAS float*)(lds + 90112);
    LAS float* acl = (LAS float*)(lds + 90880);
    LAS float* ssq = (LAS float*)(lds + 91648);
    const bf16_t* proj = (const bf16_t*)(p.ws + W_PROJ);
    const bf16_t* HP = (const bf16_t*)(p.ws + W_ST);
    const bf16_t* XC = (const bf16_t*)p.out + (size_t)(u * 64) * 896;
    const int R0 = u * 64, lt = wid & 3;
    f32x4 yacc[2][6];
#pragma unroll
    for (int g = 0; g < 2; ++g) {
        __syncthreads();
        if (wid < 3) { float dt, ac, last; dt_scan(p, l, u, g, wid, lane, dt, ac, last); dtl[wid * 64 + lane] = dt; acl[wid * 64 + lane] = ac; }
#pragma unroll
        for (int it = 0; it < 4; ++it) {
            const int idx = it * 512 + tid, mat = idx >> 10, i = (idx >> 4) & 63, c8 = idx & 15;
            const u32x4 w = *(const u32x4*)(XC + (size_t)i * 896 + 384 + mat * 256 + g * 128 + c8 * 8);
            *(LAS u32x4*)((mat ? Cn : Bn) + i * 136 + c8 * 8) = w;
        }
#pragma unroll
        for (int it = 0; it < 3; ++it) {
            const int idx = it * 512 + tid, c4 = idx % 48, i = (idx / 48) * 2;
            const u32x2 wa = *(const u32x2*)(XC + (size_t)i * 896 + g * 192 + c4 * 4), wb = *(const u32x2*)(XC + (size_t)(i + 1) * 896 + g * 192 + c4 * 4);
            *(LAS unsigned*)(xT + (c4 * 4 + 0) * 72 + i) = (wa.x & 0xffffu) | (wb.x << 16);
            *(LAS unsigned*)(xT + (c4 * 4 + 1) * 72 + i) = (wa.x >> 16) | (wb.x & 0xffff0000u);
            *(LAS unsigned*)(xT + (c4 * 4 + 2) * 72 + i) = (wa.y & 0xffffu) | (wb.y << 16);
            *(LAS unsigned*)(xT + (c4 * 4 + 3) * 72 + i) = (wa.y >> 16) | (wb.y & 0xffff0000u);
        }
        __syncthreads();
#pragma unroll
        for (int k = 0; k < 2; ++k) {
            const int st = (wid >> 2) * 2 + k;
            f32x4 a = (f32x4){0.f, 0.f, 0.f, 0.f};
#pragma unroll
            for (int ks = 0; ks < 4; ++ks) a = MFMA16(ldsfrag((LAS const unsigned char*)(Bn + (st * 16 + fr) * 136 + ks * 32 + fq * 8)), ldsfrag((LAS const unsigned char*)(Cn + (lt * 16 + fr) * 136 + ks * 32 + fq * 8)), a);
            const int li = lt * 16 + fr;
#pragma unroll
            for (int hh = 0; hh < 3; ++hh) {
                const float al = acl[hh * 64 + li]; f32x4 mv;
#pragma unroll
                for (int j = 0; j < 4; ++j) { const int si = st * 16 + fq * 4 + j; mv[j] = si <= li ? a[j] * __expf(al - acl[hh * 64 + si]) * dtl[hh * 64 + si] : 0.f; }
                *(LAS u32x2*)(Mm + (hh * 64 + li) * 72 + st * 16 + fq * 4) = pack4(mv);
            }
        }
        __syncthreads();
#pragma unroll
        for (int k = 0; k < 6; ++k) {
            const int ctile = (wid >> 2) * 6 + k, hh = ctile >> 2, pt = ctile & 3, h = g * 3 + hh, li = lt * 16 + fr;
            f32x4 ad = (f32x4){0.f, 0.f, 0.f, 0.f}, ao = (f32x4){0.f, 0.f, 0.f, 0.f};
#pragma unroll
            for (int ks = 0; ks < 2; ++ks) ad = MFMA16(ldsfrag((LAS const unsigned char*)(xT + (hh * 64 + pt * 16 + fr) * 72 + ks * 32 + fq * 8)), ldsfrag((LAS const unsigned char*)(Mm + (hh * 64 + li) * 72 + ks * 32 + fq * 8)), ad);
#pragma unroll
            for (int ks = 0; ks < 4; ++ks) ao = MFMA16(glbfrag(HP + ((size_t)(u * 6 + h) * 64 + pt * 16 + fr) * 128 + ks * 32 + fq * 8), ldsfrag((LAS const unsigned char*)(Cn + li * 136 + ks * 32 + fq * 8)), ao);
            const float ea = __expf(acl[hh * 64 + li]), dsk = p.in[15][l * 6 + h];
            const f32x4 xv = unpack4(*(const u32x2*)(XC + (size_t)li * 896 + h * 64 + pt * 16 + fq * 4));
            const f32x4 zv = unpack4(*(const u32x2*)(proj + (size_t)(R0 + li) * NPROJ + C_Z + h * 64 + pt * 16 + fq * 4));
            f32x4 y = ad + ao * ea + xv * dsk;
#pragma unroll
            for (int j = 0; j < 4; ++j) y[j] *= silu_f(zv[j]);
            yacc[g][k] = y;
            asm volatile("" ::: "memory");
        }
    }
    float sq = 0.f;
#pragma unroll
    for (int g = 0; g < 2; ++g)
#pragma unroll
        for (int k = 0; k < 6; ++k) { const f32x4 o = yacc[g][k]; sq += (o[0] * o[0] + o[1] * o[1]) + (o[2] * o[2] + o[3] * o[3]); }
    sq += __shfl_xor(sq, 16); sq += __shfl_xor(sq, 32);
    if (fq == 0) ssq[(wid >> 2) * 64 + lt * 16 + fr] = sq;
    __syncthreads();
    const float rstd = 1.0f / sqrtf((ssq[lt * 16 + fr] + ssq[64 + lt * 16 + fr]) * (1.0f / 384.0f) + RMS_EPS);
    bf16_t* mix = (bf16_t*)(p.ws + W_MIX);
#pragma unroll
    for (int g = 0; g < 2; ++g)
#pragma unroll
        for (int k = 0; k < 6; ++k) {
            const int col = 384 + g * 192 + ((wid >> 2) * 6 + k) * 16 + fq * 4;
            const f32x4 gv = *(const f32x4*)(p.in[18] + (size_t)l * 1024 + col);
            *(u32x2*)(mix + (size_t)(R0 + lt * 16 + fr) * DM + col) = pack4(yacc[g][k] * rstd * gv);
        }
}

__device__ __forceinline__ void phase_fix(KP& p, int l) {
    const float* halo = (const float*)(p.ws + W_MIX); bf16_t* H = (bf16_t*)(p.ws + W_PROJ);
    const float* w = p.in[23] + (size_t)l * 3 * DFF2; const float* bb = p.in[24] + (size_t)l * DFF2;
    int tid_ = threadIdx.x; asm volatile("" : "+v"(tid_));
    for (int i = blockIdx.x * 512 + tid_; i < 128 * DFF2; i += gridDim.x * 512) {
        const int pm = i / DFF2, cc = i % DFF2;
        if ((pm & 31) == 0 || cc >= DFF) continue;
        const float* h0 = halo + (size_t)(pm - 1) * 4 * DFF2; const float* h1 = halo + (size_t)pm * 4 * DFF2;
        float r[2];
#pragma unroll
        for (int rr = 0; rr < 2; ++rr) {
            float o[2];
#pragma unroll
            for (int gv = 0; gv < 2; ++gv) {
                const int c2 = cc + gv * DFF;
                const float xm2 = h0[2 * DFF2 + c2], xm1 = h0[3 * DFF2 + c2], x0 = h1[c2], x1 = h1[DFF2 + c2];
                o[gv] = rr == 0 ? bb[c2] + w[c2] * xm2 + w[DFF2 + c2] * xm1 + w[2 * DFF2 + c2] * x0 : bb[c2] + w[c2] * xm1 + w[DFF2 + c2] * x0 + w[2 * DFF2 + c2] * x1;
            }
            r[rr] = silu_f(o[0]) * o[1];
        }
        H[((size_t)pm * 256) * DFF + cc] = (bf16_t)(cvt_pk_bf16(r[0], 0.f) & 0xffffu);
        H[((size_t)pm * 256 + 1) * DFF + cc] = (bf16_t)(cvt_pk_bf16(r[1], 0.f) & 0xffffu);
    }
}

#define XB_TMO      128
#define XB_XCNT(j)  (256  + 64 * (j))
#define XB_XSUB(j)  (1280 + 64 * (j))
#define XB_XGEN(j)  (2304 + 64 * (j))
#define XB_TOP      3328
#define XB_TOPGEN   3392
#define XCD_BAR_WORDS 3456
#define XB_SPIN_CAP (1u << 18)

__device__ __forceinline__ unsigned xb_ld(unsigned* p)              { return __hip_atomic_load(p, __ATOMIC_RELAXED, __HIP_MEMORY_SCOPE_AGENT); }
__device__ __forceinline__ unsigned xb_add(unsigned* p, unsigned v) { return __hip_atomic_fetch_add(p, v, __ATOMIC_RELAXED, __HIP_MEMORY_SCOPE_AGENT); }
__device__ __forceinline__ unsigned xb_xcc_id() { return (unsigned)__builtin_amdgcn_s_getreg((3 << 11) | 20) & 0xFu; }
#define XB_SPIN(cond, bar) do { unsigned _sp = 0; while (cond) { __builtin_amdgcn_s_sleep(1); \
    if ((++_sp & 255u) == 0u) { if (xb_ld(&(bar)[XB_TMO])) break; if (_sp > XB_SPIN_CAP) { atomicAdd(&(bar)[XB_TMO], 1u); break; } } } } while (0)

struct XcdBarrier {
    unsigned* bar; unsigned x;
    volatile LAS unsigned* st;
};

__device__ __forceinline__ XcdBarrier xcd_barrier_post(unsigned* bar, volatile LAS unsigned* st) {
    XcdBarrier b; b.bar = bar; b.x = xb_xcc_id(); b.st = st;
    if (threadIdx.x == 0) (void)xb_add(&bar[XB_XCNT(b.x)], 1u);
    return b;
}
__device__ __forceinline__ void xcd_barrier_complete(unsigned* bar, unsigned x, unsigned& nloc, unsigned& nx) {
    const unsigned G = gridDim.x * gridDim.y * gridDim.z;
    unsigned sum, cnt, mine, sp = 0u;
    for (;;) {
        sum = 0u; cnt = 0u; mine = 0u;
#pragma unroll
        for (unsigned j = 0; j < 16; ++j) { const unsigned c = xb_ld(&bar[XB_XCNT(j)]); sum += c; cnt += (c > 0u) ? 1u : 0u; mine = (j == x) ? c : mine; }
        if (sum == G) break;
        __builtin_amdgcn_s_sleep(1);
        if ((++sp & 255u) == 0u) { if (xb_ld(&bar[XB_TMO])) break; if (sp > XB_SPIN_CAP) { atomicAdd(&bar[XB_TMO], 1u); break; } }
    }
    nloc = mine > 0u ? mine : 1u; nx = cnt > 0u ? cnt : 1u;
}

__device__ __forceinline__ void xcd_barrier(const XcdBarrier& b) {
    asm volatile("s_waitcnt vmcnt(0)" ::: "memory");
    __syncthreads();
    if (threadIdx.x == 0) {
        unsigned* bar = b.bar;
        __builtin_amdgcn_s_waitcnt(0);
        unsigned nloc = b.st[0], nx = b.st[1];
        if (nloc == 0u) { xcd_barrier_complete(bar, b.x, nloc, nx); b.st[0] = nloc; b.st[1] = nx; }
        const unsigned old = xb_add(&bar[XB_XSUB(b.x)], 1u);
        const unsigned gen = old / nloc;
        if (old + 1u == (gen + 1u) * nloc) {
            __builtin_amdgcn_fence(__ATOMIC_RELEASE, "agent");
            asm volatile("s_waitcnt vmcnt(0)" ::: "memory");
            const unsigned og = xb_add(&bar[XB_TOP], 1u);
            const unsigned tg = og / nx;
            if (og + 1u == (tg + 1u) * nx) xb_add(&bar[XB_TOPGEN], 1u);
            else XB_SPIN(xb_ld(&bar[XB_TOPGEN]) == tg, bar);
            __builtin_amdgcn_fence(__ATOMIC_ACQUIRE, "agent");
            xb_add(&bar[XB_XGEN(b.x)], 1u);
            asm volatile("s_waitcnt vmcnt(0)" ::: "memory");
        } else {
            XB_SPIN(xb_ld(&bar[XB_XGEN(b.x)]) == gen, bar);
            __builtin_amdgcn_fence(__ATOMIC_ACQUIRE, "agent");
            asm volatile("s_waitcnt vmcnt(0)" ::: "memory");
        }
    }
    __syncthreads();
}

__global__ void __launch_bounds__(512, 2) mega(Params pa) {
    extern __shared__ __attribute__((aligned(16))) unsigned char shm[];
    LAS unsigned char* lds = (LAS unsigned char*)shm;
    const int G = gridDim.x, bid = blockIdx.x;
    KP* pk = (KP*)__builtin_amdgcn_kernarg_segment_ptr();
    volatile LAS unsigned* bst = (volatile LAS unsigned*)(lds + LDS_BYTES - 16);
    XcdBarrier xb; xb.bar = nullptr; xb.x = 0; xb.st = bst;
    if (pa.coop) { if (threadIdx.x < 2) bst[threadIdx.x] = 0u; __syncthreads(); xb = xcd_barrier_post((unsigned*)(pa.ws + W_BAR), bst); }
    for (int ph = pa.ph_lo; ph < pa.ph_hi; ++ph) {
        if (ph > pa.ph_lo && pa.coop) { if (pa.pad == 0x5a5a) { __threadfence(); cg::this_grid().sync(); } else xcd_barrier(xb); }
        asm volatile("" : "+s"(pk)); KP& p = *pk;
        if (ph == 0) { phase_prep(p, lds); continue; }
        if (ph == 42) { int tq = threadIdx.x; asm volatile("" : "+v"(tq)); const unsigned short* w16 = (const unsigned short*)p.ws; for (size_t i = (size_t)bid * 512 + tq; i < (size_t)59418624; i += (size_t)G * 512) p.out[i] = (float)w16[i * 4]; continue; }
        if (ph == 41) { int tq = threadIdx.x; asm volatile("" : "+v"(tq)); for (size_t i = (size_t)bid * 512 + tq; i < (size_t)59418624; i += (size_t)G * 512) { const float v = p.out[i]; if (!(fabsf(v) < 1e30f)) p.out[i] = 0.f; } continue; }
        const int l = (ph - 1) / 10, k = (ph - 1) % 10;
        bf16_t* XB = (bf16_t*)(p.ws + W_XB);
        switch (k) {
        case 0: if (REP_G1 > 1) { pg8::StaticOrder S; S.init(T_ALL, NPROJ, G, bid); EpiNull E{(float*)(p.ws + W_CD)};
                  pg8::gemm_phase(lds, pg8::Gemm{XB, (const bf16_t*)(p.ws + W_IN + l * W_IN_L), T_ALL, NPROJ, DM}, S, E); }
                { if ((bid >> 3) & 1) { __builtin_amdgcn_s_sleep(127); __builtin_amdgcn_s_sleep(127); __builtin_amdgcn_s_sleep(127); }
                  pg8::StaticOrder S; S.init(T_ALL, NPROJ, G, bid);
                  EpiIn E{(bf16_t*)(p.ws + W_PROJ), p.out, (float*)(p.ws + W_DTB), p.in[13], l};
                  pg8::gemm_phase(lds, pg8::Gemm{XB, (const bf16_t*)(p.ws + W_IN + l * W_IN_L), T_ALL, NPROJ, DM}, S, E); } break;
        case 1: {
                  unsigned* qctr = (unsigned*)(p.ws + W_BAR + 14336) + l * 64;
                  volatile LAS int* qslot = (volatile LAS int*)(lds + LDS_BYTES - 32);
                  for (;;) {
                      __syncthreads();
                      if (threadIdx.x == 0) qslot[0] = (int)__hip_atomic_fetch_add(qctr, 1u, __ATOMIC_RELAXED, __HIP_MEMORY_SCOPE_AGENT);
                      __syncthreads();
                      const int it = qslot[0];
                      if (it >= 2 * NU64) break;
                      if (it < NU64) attn_unit(p, lds, l, NU64 - 1 - it); else ssd_states(p, lds, l, it - NU64);
                  } } break;
        case 2: for (int it = bid; it < 96 + 768; it += G) { if (it < 96) scan_prompt(p, l, it); else scan_sample(p, l, it - 96); } break;
        case 3: {
                  unsigned* qctr = (unsigned*)(p.ws + W_BAR + 14336) + l * 64 + 32;
                  volatile LAS int* qslot = (volatile LAS int*)(lds + LDS_BYTES - 32);
                  for (;;) {
                      __syncthreads();
                      if (threadIdx.x == 0) qslot[0] = (int)__hip_atomic_fetch_add(qctr, 1u, __ATOMIC_RELAXED, __HIP_MEMORY_SCOPE_AGENT);
                      __syncthreads();
                      const int it = qslot[0];
                      if (it >= 2 * NU64) break;
                      if (it < NU64) ssd_y(p, lds, l, it); else gmlp_unit(p, lds, l, it - NU64);
                  } } break;
        case 4: { pg8::StaticOrder S; S.init(T_ALL, DM, G, bid); EpiRes E{p.out, XB, (bf16_t*)p.out};
                  pg8::gemm_phase(lds, pg8::Gemm{(const bf16_t*)(p.ws + W_MIX), (const bf16_t*)(p.ws + W_OUT + l * W_OUT_L), T_ALL, DM, DM}, S, E); } break;
        case 5: phase_ln(p, (const bf16_t*)p.out, p.in[20] + l * DM, p.in[21] + l * DM, false); break;
        case 6: for (int rep = 0; rep < REP_G3; ++rep) { pg8::StaticOrder S; S.init(T_ALL, DFF2, G, bid);
                  EpiUp E{(bf16_t*)(p.ws + W_PROJ), (float*)(p.ws + W_MIX), p.out, p.in[23], p.in[24], p.in[6], l};
                  pg8::OneUnit o1;
                  for (int i = 0; S.next(i, o1.u); ++i) { pg8::gemm_phase(lds, pg8::Gemm{XB, (const bf16_t*)(p.ws + W_UP + l * W_UP_L), T_ALL, DFF2, DM}, o1, E); __syncthreads(); } } break;
        case 7: phase_fix(p, l); break;
        case 8: { pg8::StaticOrder S; S.init(T_ALL, DM, G, bid); EpiRes E{p.out, XB, (bf16_t*)(p.ws + W_MIX)};
                  pg8::gemm_phase(lds, pg8::Gemm{(const bf16_t*)(p.ws + W_PROJ), (const bf16_t*)(p.ws + W_DN + l * W_DN_L), T_ALL, DM, DFF}, S, E); } break;
        case 9: phase_ln(p, (const bf16_t*)(p.ws + W_MIX), p.in[26] + l * DM, p.in[27] + l * DM, l == DEPTH - 1); break;
        }
    }
}

constexpr int N_PHASES = 41;
#ifndef MULTI_LAUNCH
#define MULTI_LAUNCH 0
#endif

extern "C" void kernel_launch(void* const* d_in, const int* in_sizes, int n_in, void* d_out, int out_size, void* d_ws, size_t ws_size, hipStream_t stream) {
    static int grid = 0;
    if (grid == 0) {
        if (n_in != 28 || ws_size < W_END2) { fprintf(stderr, "kernel_launch: need 28 inputs and %zu bytes of workspace (got %d, %zu)\n", (size_t)W_END2, n_in, ws_size); grid = -1; return; }
        int dev = 0, cus = 0, per_cu = 0;
        hipGetDevice(&dev); hipDeviceGetAttribute(&cus, hipDeviceAttributeMultiprocessorCount, dev);
        if (hipFuncSetAttribute((const void*)mega, hipFuncAttributeMaxDynamicSharedMemorySize, LDS_BYTES) != hipSuccess) { fprintf(stderr, "kernel_launch: hipFuncSetAttribute failed\n"); grid = -1; return; }
        hipOccupancyMaxActiveBlocksPerMultiprocessor(&per_cu, (const void*)mega, 512, LDS_BYTES);
        (void)hipGetLastError();
        if (per_cu < 1) per_cu = 1;
        grid = cus * 1;
    }
    if (grid < 0) return;
    Params p{};
    for (int i = 0; i < 28; ++i) p.in[i] = (const float*)d_in[i];
    p.out = (float*)d_out; p.ws = (unsigned char*)d_ws;
#if MULTI_LAUNCH
#ifdef PROBE_CUT
    for (int ph = 0; ph < PROBE_CUT; ++ph) { p.ph_lo = ph; p.ph_hi = ph + 1; p.coop = 0; hipLaunchKernelGGL(mega, dim3(grid), dim3(512), LDS_BYTES, stream, p); }
    p.ph_lo = 42; p.ph_hi = 43; p.coop = 0; hipLaunchKernelGGL(mega, dim3(grid), dim3(512), LDS_BYTES, stream, p);
#else
    for (int ph = 0; ph < N_PHASES; ++ph) { p.ph_lo = ph; p.ph_hi = ph + 1; p.coop = 0; hipLaunchKernelGGL(mega, dim3(grid), dim3(512), LDS_BYTES, stream, p); }
#endif
#else
    p.ph_lo = 0; p.ph_hi = N_PHASES; p.coop = 1;
    if (hipMemsetAsync((char*)d_ws + W_BAR, 0, 16384, stream) != hipSuccess) { fprintf(stderr, "kernel_launch: memset failed\n"); return; }
    void* args[] = {&p};
    hipError_t e = hipLaunchCooperativeKernel((const void*)mega, dim3(grid), dim3(512), args, LDS_BYTES, stream);
    if (e != hipSuccess) fprintf(stderr, "cooperative launch failed: %s (grid %d)\n", hipGetErrorString(e), grid);
#endif
}
```

```cpp
#define REP_G1 1
#define REP_M1 1
#define REP_ATT 1
#define REP_M3 1
#define REP_G3 1
#include <hip/hip_runtime.h>
#include <hip/hip_cooperative_groups.h>
#include <cstdio>
namespace cg = cooperative_groups;

#define LAS __attribute__((address_space(3)))
typedef unsigned short bf16_t;
typedef short bf16x8 __attribute__((ext_vector_type(8)));
typedef float f32x4 __attribute__((ext_vector_type(4)));
typedef float f32x2 __attribute__((ext_vector_type(2)));
typedef unsigned u32x4 __attribute__((ext_vector_type(4)));
typedef unsigned u32x2 __attribute__((ext_vector_type(2)));

constexpr int T_ALL = 34816, T_P = 32768, DM = 1024, NPROJ = 3072, DFF = 2816, DFF2 = 5632, DEPTH = 4;
constexpr int NU64 = 544;
constexpr float ALPHA = 1.6817928305074290f;
constexpr float LN_EPS = 1e-5f, RMS_EPS = 1e-5f;
constexpr int C_K = 384, C_V = 768, C_Z = 1152, C_XBC = 1536, C_U = 2432, C_VC = 2688, C_DT = 2944;
constexpr size_t O_YP = 0, O_YS = 33554432, O_PK = 35651584, O_PV = O_PK + 3145728, O_PH = O_PV + 3145728, O_PC = O_PH + 786432,
                 O_PF = O_PC + 43008, O_SK = O_PF + 180224, O_SV = O_SK + 3145728, O_SH = O_SV + 3145728, O_SC = O_SH + 6291456,
                 O_SG = O_SC + 344064, O_SF = O_SG + 2097152;
constexpr size_t W_IN = 0, W_IN_L = (size_t)NPROJ * DM * 2;
constexpr size_t W_OUT = W_IN + 4 * W_IN_L, W_OUT_L = (size_t)DM * DM * 2;
constexpr size_t W_UP = W_OUT + 4 * W_OUT_L, W_UP_L = (size_t)DFF2 * DM * 2;
constexpr size_t W_DN = W_UP + 4 * W_UP_L, W_DN_L = (size_t)DM * DFF * 2;
constexpr size_t W_GW = W_DN + 4 * W_DN_L, W_GW_L = (size_t)4 * 128 * 128 * 2;
constexpr size_t W_XB = W_GW + 4 * W_GW_L;
constexpr size_t W_PROJ = W_XB + (size_t)T_ALL * DM * 2;
constexpr size_t W_MIX = W_PROJ + (size_t)T_ALL * NPROJ * 2;
constexpr size_t W_ST = W_MIX + (size_t)T_ALL * DM * 2;
constexpr size_t W_CD = W_ST + (size_t)NU64 * 6 * 8192 * 2;
constexpr size_t W_DTB = W_CD + (size_t)NU64 * 8 * 4;
constexpr size_t W_END = W_DTB + (size_t)T_ALL * 8 * 4;
constexpr size_t W_BAR = W_END;
constexpr size_t W_END2 = W_BAR + 16384;
constexpr int LDS_BYTES = 156 * 1024;

struct Params { const float* in[28]; float* out; unsigned char* ws; int ph_lo, ph_hi, coop, pad; };
typedef const __attribute__((address_space(4))) Params KP;

__device__ __forceinline__ float bf2f(unsigned b) { return __uint_as_float(b << 16); }
typedef __bf16 bf16v2 __attribute__((ext_vector_type(2)));
__device__ __forceinline__ unsigned cvt_pk_bf16(float lo, float hi) { const f32x2 v = {lo, hi}; const bf16v2 b = __builtin_convertvector(v, bf16v2); return __builtin_bit_cast(unsigned, b); }
__device__ __forceinline__ u32x2 pack4(f32x4 v) { u32x2 w; w.x = cvt_pk_bf16(v[0], v[1]); w.y = cvt_pk_bf16(v[2], v[3]); return w; }
__device__ __forceinline__ f32x4 unpack4(u32x2 w) { f32x4 v; v[0] = bf2f(w.x & 0xffffu); v[1] = bf2f(w.x >> 16); v[2] = bf2f(w.y & 0xffffu); v[3] = bf2f(w.y >> 16); return v; }
__device__ __forceinline__ float silu_f(float x) { return x * __builtin_amdgcn_rcpf(1.0f + __expf(-x)); }
__device__ __forceinline__ float gelu_tanh(float x) { const float y = 0.7978845608028654f * (x + 0.044715f * x * x * x); const float e = __expf(2.0f * y); return 0.5f * x * (2.0f - 2.0f * __builtin_amdgcn_rcpf(1.0f + e)); }
__device__ __forceinline__ float softplus_f(float x) { const float e = __expf(x); return x > 15.0f ? x : (e < 1e-3f ? e * (1.0f - 0.5f * e + 0.33333333f * e * e) : __logf(1.0f + e)); }
#define MFMA16(colfrag, rowfrag, acc) __builtin_amdgcn_mfma_f32_16x16x32_bf16((colfrag), (rowfrag), (acc), 0, 0, 0)
__device__ __forceinline__ bf16x8 ldsfrag(LAS const unsigned char* p) { return *(LAS const bf16x8*)p; }
__device__ __forceinline__ bf16x8 glbfrag(const bf16_t* p) { return *(const bf16x8*)p; }
#define LDS_WAVE_SYNC() asm volatile("s_waitcnt lgkmcnt(0)" ::: "memory")

namespace pg8 {
constexpr int BM = 256, BK = 64, HALF = 128, HTB = HALF * BK * 2, STAGE_BYTES = 8 * HTB, NXCD = 8, WGM = 16;
__device__ __forceinline__ int lds_byte(int r, int c) { const int st = (r >> 4) * 2 + (c >> 5), rr = r & 15, cc = c & 31, ob = rr * 64 + cc * 2; return st * 1024 + (ob ^ (((ob >> 9) & 1) << 5)); }
__device__ __forceinline__ void stage_rc(int b, int& R, int& C) { const int st = b / 1024, sb = b % 1024, swz = sb ^ (((sb >> 9) & 1) << 5); R = (st >> 1) * 16 + swz / 64; C = (st & 1) * 32 + (swz % 64) / 2; }
__device__ __forceinline__ int perm32(int rho) { const int n = rho >> 4, i = rho & 15; return 8 * (i >> 2) + 4 * n + (i & 3); }
struct Unit { int pm, pn; };
struct Gemm { const bf16_t* A; const bf16_t* Bt; int M, N, K; };
struct StaticOrder {
    int nM, nN, nwg, G, c;
    __device__ __forceinline__ void init(int M, int N, int G_, int c_) { nM = M / BM; nN = N / BM; nwg = nM * nN; G = G_; c = c_; }
    __device__ __forceinline__ bool next(int i, Unit& u) const {
        const long L = (long)i * G + c; if (L >= nwg) return false;
        int wgid = (int)L; { const int q = nwg / NXCD, r = nwg % NXCD, xcd = wgid % NXCD, off = wgid / NXCD; wgid = (xcd < r ? xcd * (q + 1) : r * (q + 1) + (xcd - r) * q) + off; }
        const int nig = WGM * nN, gid = wgid / nig, fm = gid * WGM, gsz = (nM - fm) < WGM ? (nM - fm) : WGM;
        u.pm = fm + ((wgid % nig) % gsz); u.pn = (wgid % nig) / gsz; return true;
    }
    __device__ __forceinline__ void a_ready(const Unit&) const {}
    __device__ __forceinline__ void done(const Unit&) const {}
};
struct OneUnit {
    Unit u;
    __device__ __forceinline__ bool next(int i, Unit& o) const { if (i) return false; o = u; return true; }
    __device__ __forceinline__ void a_ready(const Unit&) const {}
    __device__ __forceinline__ void done(const Unit&) const {}
};

template <class Epi, class Sched>
__device__ __forceinline__ void gemm_phase(LAS unsigned char* lds, const Gemm g, const Sched& S, const Epi& E) {
    int tid_ = threadIdx.x; asm volatile("" : "+v"(tid_));
    const int tid = tid_, wid = __builtin_amdgcn_readfirstlane(tid >> 6), lane = tid & 63, wr = wid >> 2, wc = wid & 3, fr = lane & 15, fq = lane >> 4;
    const int K = g.K, nt = K / BK;
    unsigned voffA[2], voffB[2];
#pragma unroll
    for (int i = 0; i < 2; ++i) { int R, C; stage_rc(tid * 16 + i * 8192, R, C); const int Rb = (R & ~31) + perm32(R & 31); voffA[i] = (unsigned)(R * K + C) * 2u; voffB[i] = (unsigned)(Rb * K + C) * 2u; }
    const size_t kstep = (size_t)(BK * 2);
    const size_t hstep = (size_t)HALF * K * 2;
    const size_t tstep = 2 * hstep;
    const unsigned ldsw = (unsigned)wid * 1024u;
    const int aoff = lds_byte(wr * 64 + fr, fq * 8), boff = lds_byte(wc * 32 + fr, fq * 8);
#define PG8_SA(b, h) (((b) * 2 + (h)) * HTB)
#define PG8_SB(b, h) ((4 + (b) * 2 + (h)) * HTB)
#define PG8_STAGE(bufoff, gbase, voff) do { _Pragma("unroll") for (int _i = 0; _i < 2; ++_i) \
        __builtin_amdgcn_global_load_lds((const unsigned*)((const char*)(gbase) + (voff)[_i]), (LAS unsigned*)(lds + (bufoff) + ldsw + _i * 8192), 16, 0, 0); } while (0)
#define PG8_LDA(dst, b, h) do { _Pragma("unroll") for (int m = 0; m < 4; ++m) _Pragma("unroll") for (int k = 0; k < 2; ++k) dst[m][k] = *(const LAS bf16x8*)(lds + PG8_SA(b, h) + aoff + m * 2048 + k * 1024); } while (0)
#define PG8_LDB(dst, b, h) do { _Pragma("unroll") for (int n = 0; n < 2; ++n) _Pragma("unroll") for (int k = 0; k < 2; ++k) dst[n][k] = *(const LAS bf16x8*)(lds + PG8_SB(b, h) + boff + n * 2048 + k * 1024); } while (0)
#define PG8_MMA(ai, bj, At, Bt) do { __builtin_amdgcn_s_setprio(1); _Pragma("unroll") for (int m = 0; m < 4; ++m) _Pragma("unroll") for (int n = 0; n < 2; ++n) _Pragma("unroll") for (int k = 0; k < 2; ++k) \
        acc[ai][bj][m][n] = __builtin_amdgcn_mfma_f32_16x16x32_bf16(Bt[n][k], At[m][k], acc[ai][bj][m][n], 0, 0, 0); __builtin_amdgcn_s_setprio(0); } while (0)
#define PG8_WAIT_V(n) asm volatile("s_waitcnt vmcnt(" #n ")" ::: "memory")
#define PG8_WAIT_L(n) asm volatile("s_waitcnt lgkmcnt(" #n ")" ::: "memory")
#define PG8_BAR __builtin_amdgcn_s_barrier()
#define PG8_SCHED __builtin_amdgcn_sched_barrier(0)
    Unit cur, nxt; int ui = 0;
    if (!S.next(0, cur)) return;
    f32x4 acc[2][2][4][2];
#pragma unroll
    for (int a = 0; a < 2; ++a)
#pragma unroll
        for (int b = 0; b < 2; ++b)
#pragma unroll
            for (int m = 0; m < 4; ++m)
#pragma unroll
                for (int n = 0; n < 2; ++n) acc[a][b][m][n] = (f32x4){0.f, 0.f, 0.f, 0.f};
    bf16x8 At[4][2], B0[2][2], B1[2][2];
    const char* cA = (const char*)g.A + (size_t)cur.pm * tstep; const char* cB = (const char*)g.Bt + (size_t)cur.pn * tstep;
    S.a_ready(cur);
    PG8_STAGE(PG8_SB(0, 0), cB, voffB); PG8_STAGE(PG8_SA(0, 0), cA, voffA); PG8_STAGE(PG8_SB(0, 1), cB + hstep, voffB); PG8_STAGE(PG8_SA(0, 1), cA + hstep, voffA);
    if (wr == 1) PG8_BAR;
    PG8_WAIT_V(4); PG8_BAR;
    PG8_STAGE(PG8_SB(1, 0), cB + kstep, voffB); PG8_STAGE(PG8_SA(1, 0), cA + kstep, voffA); PG8_STAGE(PG8_SB(1, 1), cB + hstep + kstep, voffB);
    PG8_WAIT_V(6); PG8_BAR;
    for (;;) {
        const bool has_next = S.next(ui + 1, nxt);
        const char* nA = has_next ? (const char*)g.A + (size_t)nxt.pm * tstep : cA; const char* nB = has_next ? (const char*)g.Bt + (size_t)nxt.pn * tstep : cB;
        for (int t = 0; t < nt; t += 2) {
            const bool last = (t == nt - 2);
            const char* a1 = cA + (size_t)(t + 1) * kstep;
            const char* a2 = last ? nA : cA + (size_t)(t + 2) * kstep; const char* b2 = last ? nB : cB + (size_t)(t + 2) * kstep;
            const char* a3 = a2 + kstep; const char* b3 = b2 + kstep;
            if (last && has_next) S.a_ready(nxt);
            PG8_LDB(B0, 0, 0); PG8_SCHED; PG8_LDA(At, 0, 0); PG8_STAGE(PG8_SA(1, 1), a1 + hstep, voffA);
            PG8_WAIT_L(8); PG8_BAR; PG8_WAIT_L(0); PG8_MMA(0, 0, At, B0); PG8_BAR; PG8_SCHED;
            PG8_LDB(B1, 0, 1); PG8_STAGE(PG8_SB(0, 0), b2, voffB);
            PG8_BAR; PG8_WAIT_L(0); PG8_MMA(0, 1, At, B1); PG8_BAR;
            PG8_LDA(At, 0, 1); PG8_STAGE(PG8_SA(0, 0), a2, voffA);
            PG8_BAR; PG8_WAIT_L(0); PG8_MMA(1, 0, At, B0); PG8_BAR; PG8_SCHED;
            PG8_STAGE(PG8_SB(0, 1), b2 + hstep, voffB);
            PG8_WAIT_V(6); PG8_BAR; PG8_MMA(1, 1, At, B1); PG8_BAR;
            PG8_LDB(B0, 1, 0); PG8_SCHED; PG8_LDA(At, 1, 0); PG8_STAGE(PG8_SA(0, 1), a2 + hstep, voffA);
            PG8_WAIT_L(8); PG8_BAR; PG8_WAIT_L(0); PG8_MMA(0, 0, At, B0); PG8_BAR; PG8_SCHED;
            PG8_LDB(B1, 1, 1); PG8_STAGE(PG8_SB(1, 0), b3, voffB);
            PG8_BAR; PG8_WAIT_L(0); PG8_MMA(0, 1, At, B1); PG8_BAR;
            PG8_LDA(At, 1, 1); PG8_STAGE(PG8_SA(1, 0), a3, voffA);
            PG8_BAR; PG8_WAIT_L(0); PG8_MMA(1, 0, At, B0); PG8_BAR; PG8_SCHED;
            PG8_STAGE(PG8_SB(1, 1), b3 + hstep, voffB);
            PG8_WAIT_V(6); PG8_BAR; PG8_MMA(1, 1, At, B1); PG8_BAR;
        }
        if constexpr (!Epi::AFTER_DRAIN) { E(acc, cur, wr, wc, fr, fq); S.done(cur); }
        if (!has_next) break;
#pragma unroll
        for (int a = 0; a < 2; ++a)
#pragma unroll
            for (int b = 0; b < 2; ++b)
#pragma unroll
                for (int m = 0; m < 4; ++m)
#pragma unroll
                    for (int n = 0; n < 2; ++n) acc[a][b][m][n] = (f32x4){0.f, 0.f, 0.f, 0.f};
        cur = nxt; cA = nA; cB = nB; ++ui;
    }
    PG8_WAIT_V(0);
    if (wr == 0) PG8_BAR;
    PG8_BAR;
    if constexpr (Epi::AFTER_DRAIN) { E.fused(acc, cur, wr, wc, fr, fq, lds, wid, lane); S.done(cur); }
#undef PG8_SA
#undef PG8_SB
#undef PG8_STAGE
#undef PG8_LDA
#undef PG8_LDB
#undef PG8_MMA
#undef PG8_WAIT_V
#undef PG8_WAIT_L
#undef PG8_BAR
#undef PG8_SCHED
}
}
using pg8::Unit;

struct EpiIn {
    static constexpr bool AFTER_DRAIN = false;
    bf16_t* proj; float* out; float* dtb; const float* dt_bias; int l;
    __device__ __forceinline__ void operator()(const f32x4 (&acc)[2][2][4][2], const Unit& u, int wr, int wc, int fr_, int fq_) const {
        int fr = fr_, fq = fq_; asm volatile("" : "+v"(fr), "+v"(fq));
#pragma unroll
        for (int bj = 0; bj < 2; ++bj) {
            const int cb = u.pn * 256 + bj * 128;
            const int col = cb + wc * 32 + fq * 8;
            if (cb > C_DT) continue;
#pragma unroll
            for (int ai = 0; ai < 2; ++ai)
#pragma unroll
                for (int m = 0; m < 4; ++m) {
                    const int row = u.pm * 256 + ai * 128 + wr * 64 + m * 16 + fr;
                    const bool isP = row < T_P; int b, t;
                    if (isP) { b = row >> 13; t = row & 8191; } else { b = (row - T_P) >> 6; t = row & 63; }
                    f32x4 v0 = acc[ai][bj][m][0], v1 = acc[ai][bj][m][1];
                    if (cb < C_U) {
                        u32x4 w; { const u32x2 a = pack4(v0), c = pack4(v1); w.x = a.x; w.y = a.y; w.z = c.x; w.w = c.y; }
                        *(u32x4*)(proj + (size_t)row * NPROJ + col) = w;
                        if (cb >= C_K && cb < C_Z) {
                            const int isv = cb >= C_V; const int cc = col - (isv ? C_V : C_K);
                            float* o = nullptr;
                            if (isP) { if (t >= 7680) o = out + (isv ? O_PV : O_PK) + ((size_t)(l * 4 + b) * 512 + (t - 7680)) * 384 + cc; }
                            else o = out + (isv ? O_SV : O_SK) + ((size_t)(l * 32 + b) * 64 + t) * 384 + cc;
                            if (o) { *(f32x4*)o = v0; *(f32x4*)(o + 4) = v1; }
                        } else if (cb >= C_XBC) {
                            const int cc = col - C_XBC; float* o = nullptr;
                            if (isP) { if (t >= 8189) o = out + O_PC + ((size_t)(l * 4 + b) * 3 + (t - 8189)) * 896 + cc; }
                            else if (t >= 61) o = out + O_SC + ((size_t)(l * 32 + b) * 3 + (t - 61)) * 896 + cc;
                            if (o) { *(f32x4*)o = v0; *(f32x4*)(o + 4) = v1; }
                        }
                    } else if (cb < C_DT) {
#pragma unroll
                        for (int j = 0; j < 4; ++j) { v0[j] = gelu_tanh(v0[j]); v1[j] = gelu_tanh(v1[j]); }
                        u32x4 w; { const u32x2 a = pack4(v0), c = pack4(v1); w.x = a.x; w.y = a.y; w.z = c.x; w.w = c.y; }
                        *(u32x4*)(proj + (size_t)row * NPROJ + col) = w;
                        if (cb >= C_VC && !isP) { float* o = out + O_SG + ((size_t)(l * 32 + b) * 64 + t) * 256 + (col - C_VC); *(f32x4*)o = v0; *(f32x4*)(o + 4) = v1; }
                    } else if (col == C_DT) {
                        float* d = dtb + (size_t)row * 8;
#pragma unroll
                        for (int j = 0; j < 4; ++j) d[j] = softplus_f(v0[j] + dt_bias[l * 6 + j]);
#pragma unroll
                        for (int j = 0; j < 2; ++j) d[4 + j] = softplus_f(v1[j] + dt_bias[l * 6 + 4 + j]);
                    }
                    asm volatile("" ::: "memory");
                }
        }
    }
};
struct EpiNull {
    static constexpr bool AFTER_DRAIN = false;
    float* sink;
    __device__ __forceinline__ void operator()(const f32x4 (&acc)[2][2][4][2], const Unit& u, int wr, int wc, int fr, int fq) const {
        float t = 0.f;
#pragma unroll
        for (int ai = 0; ai < 2; ++ai)
#pragma unroll
            for (int bj = 0; bj < 2; ++bj)
#pragma unroll
                for (int m = 0; m < 4; ++m)
#pragma unroll
                    for (int n = 0; n < 2; ++n) t += acc[ai][bj][m][n][0] + acc[ai][bj][m][n][1] + acc[ai][bj][m][n][2] + acc[ai][bj][m][n][3];
        if (t == 123456.789f) sink[0] = t;
    }
};
struct EpiRes {
    static constexpr bool AFTER_DRAIN = false;
    float* x; const bf16_t* xb; bf16_t* rdst;
    __device__ __forceinline__ void operator()(const f32x4 (&acc)[2][2][4][2], const Unit& u, int wr, int wc, int fr_, int fq_) const {
        int fr = fr_, fq = fq_; asm volatile("" : "+v"(fr), "+v"(fq));
#pragma unroll
        for (int ai = 0; ai < 2; ++ai)
#pragma unroll
            for (int m = 0; m < 4; ++m) {
                float* rowp = x + (size_t)(u.pm * 256 + ai * 128 + wr * 64 + m * 16 + fr) * DM + u.pn * 256 + wc * 32 + fq * 8;
#pragma unroll
                for (int bj = 0; bj < 2; ++bj) { float* q = rowp + bj * 128; const u32x4 xw = *(const u32x4*)(xb + (q - x));
                    const f32x4 o0 = unpack4((u32x2){xw.x, xw.y}), o1 = unpack4((u32x2){xw.z, xw.w});
                    const u32x2 ra = pack4(o0 * ALPHA + acc[ai][bj][m][0]), rb = pack4(o1 * ALPHA + acc[ai][bj][m][1]);
                    *(u32x4*)(rdst + (q - x)) = (u32x4){ra.x, ra.y, rb.x, rb.y}; }
                asm volatile("" ::: "memory");
            }
    }
};
struct EpiUp {
    static constexpr bool AFTER_DRAIN = true;
    bf16_t* H; float* halo; float* out; const float* cw; const float* cb; const float* fstate; int l;
    __device__ __forceinline__ void operator()(const f32x4 (&)[2][2][4][2], const Unit&, int, int, int, int) const {}
    __device__ __forceinline__ void fused(f32x4 (&acc)[2][2][4][2], const Unit& u, int wr, int wc, int fr, int fq, LAS unsigned char* lds, int wid, int lane) const {
        constexpr int LS = 264;
#pragma unroll
        for (int ai = 0; ai < 2; ++ai)
#pragma unroll
            for (int m = 0; m < 4; ++m)
#pragma unroll
                for (int bj = 0; bj < 2; ++bj) {
                        const int rl = ai * 128 + wr * 64 + m * 16 + fr, cl = bj * 128 + wc * 32 + fq * 8;
                        u32x4 w; { const u32x2 a = pack4(acc[ai][bj][m][0]), c = pack4(acc[ai][bj][m][1]); w.x = a.x; w.y = a.y; w.z = c.x; w.w = c.y; }
                        *(LAS u32x4*)(lds + (rl * LS + cl) * 2) = w;
                    }
        __syncthreads();
        const int tid = wid * 64 + lane, j = 2 * (tid & 63), seg = tid >> 6;
        const int hcol = u.pn * 128 + j;
        const float* w = cw + (size_t)l * 3 * DFF2 + hcol; const float* bb = cb + (size_t)l * DFF2 + hcol;
        const f32x2 wg0 = *(const f32x2*)w, wg1 = *(const f32x2*)(w + DFF2), wg2 = *(const f32x2*)(w + 2 * DFF2), bg = *(const f32x2*)bb;
        const f32x2 wv0 = *(const f32x2*)(w + DFF), wv1 = *(const f32x2*)(w + DFF2 + DFF), wv2 = *(const f32x2*)(w + 2 * DFF2 + DFF), bv = *(const f32x2*)(bb + DFF);
        const int r0 = seg * 32, R = u.pm * 256 + r0;
        const bool isP = R < T_P;
        const LAS unsigned char* U = (const LAS unsigned char*)lds;
#define UP2(row, off) ({ const unsigned w_ = *(const LAS unsigned*)(U + ((row) * LS + (off) + j) * 2); (f32x2){bf2f(w_ & 0xffffu), bf2f(w_ >> 16)}; })
        f32x2 g2 = (f32x2){0.f, 0.f}, g1 = g2, v2 = g2, v1 = g2; int skip = 0;
        if (isP) {
            if (seg > 0) { g2 = UP2(r0 - 2, 0); g1 = UP2(r0 - 1, 0); v2 = UP2(r0 - 2, 128); v1 = UP2(r0 - 1, 128); }
            else if ((R & 8191) != 0) skip = 2;
        } else if (seg & 1) { g2 = UP2(r0 - 2, 0); g1 = UP2(r0 - 1, 0); v2 = UP2(r0 - 2, 128); v1 = UP2(r0 - 1, 128); }
        else { const int sb = (R - T_P) >> 6; const float* fs = fstate + (size_t)(l * 32 + sb) * 2 * DFF2 + hcol;
            g2 = *(const f32x2*)fs; g1 = *(const f32x2*)(fs + DFF2); v2 = *(const f32x2*)(fs + DFF); v1 = *(const f32x2*)(fs + DFF2 + DFF); }
        bf16_t* hp = H + (size_t)R * DFF + hcol;
#pragma unroll 8
        for (int i = 0; i < 32; ++i) {
            const f32x2 gq = UP2(r0 + i, 0), vq = UP2(r0 + i, 128);
            if (i >= skip) {
                const f32x2 cgv = bg + wg0 * g2 + wg1 * g1 + wg2 * gq, cvv = bv + wv0 * v2 + wv1 * v1 + wv2 * vq;
                *(unsigned*)(hp + (size_t)i * DFF) = cvt_pk_bf16(silu_f(cgv[0]) * cvv[0], silu_f(cgv[1]) * cvv[1]);
            }
            g2 = g1; g1 = gq; v2 = v1; v1 = vq;
            if (isP) {
                if (seg == 0 && i < 2) { float* hl = halo + ((size_t)u.pm * 4 + i) * DFF2 + hcol; *(f32x2*)hl = gq; *(f32x2*)(hl + DFF) = vq; }
                if (seg == 7 && i >= 30) { float* hl = halo + ((size_t)u.pm * 4 + 2 + (i - 30)) * DFF2 + hcol; *(f32x2*)hl = gq; *(f32x2*)(hl + DFF) = vq;
                    if ((u.pm & 31) == 31) { float* o = out + O_PF + ((size_t)(l * 4 + (u.pm >> 5)) * 2 + (i - 30)) * DFF2 + hcol; *(f32x2*)o = gq; *(f32x2*)(o + DFF) = vq; } }
            } else if ((seg & 1) && i >= 30) {
                const int sb = (R - 32 - T_P) >> 6; float* o = out + O_SF + ((size_t)(l * 32 + sb) * 2 + (i - 30)) * DFF2 + hcol; *(f32x2*)o = gq; *(f32x2*)(o + DFF) = vq;
            }
        }
#undef UP2
    }
};

__device__ __forceinline__ void ln_row(const float* src, const bf16_t* srcb, float* x32, bf16_t* xb, const float* g, const float* b, int lane) {
    f32x4 v[4]; float s = 0.f;
#pragma unroll
    for (int i = 0; i < 4; ++i) { v[i] = srcb ? unpack4(*(const u32x2*)(srcb + i * 256 + lane * 4)) : *(const f32x4*)(src + i * 256 + lane * 4); s += (v[i][0] + v[i][1]) + (v[i][2] + v[i][3]); }
#pragma unroll
    for (int o = 32; o >= 1; o >>= 1) s += __shfl_xor(s, o);
    const float mu = s * (1.0f / 1024.0f); float q = 0.f;
#pragma unroll
    for (int i = 0; i < 4; ++i) { const f32x4 d = v[i] - mu; q += (d[0] * d[0] + d[1] * d[1]) + (d[2] * d[2] + d[3] * d[3]); }
#pragma unroll
    for (int o = 32; o >= 1; o >>= 1) q += __shfl_xor(q, o);
    const float rstd = 1.0f / sqrtf(q * (1.0f / 1024.0f) + LN_EPS);
#pragma unroll
    for (int i = 0; i < 4; ++i) {
        const f32x4 gg = *(const f32x4*)(g + i * 256 + lane * 4), bb = *(const f32x4*)(b + i * 256 + lane * 4);
        const f32x4 o = (v[i] - mu) * rstd * gg + bb;
        if (x32) *(f32x4*)(x32 + i * 256 + lane * 4) = o;
        if (xb) *(u32x2*)(xb + i * 256 + lane * 4) = pack4(o);
    }
}

__device__ __forceinline__ void tr_tile(LAS float* tile, const float* src, int Nsrc, bf16_t* dst, int K, int n0, int k0, int mode, int tid) {
    const int nn = tid & 63, np = n0 + nn; int sc;
    if (mode == 0) sc = np < C_U ? np : (np < C_DT ? np + 6 : (np < C_DT + 6 ? np - 512 : -1));
    else if (mode == 1) sc = np;
    else { const int pn = np >> 8, jj = np & 255; sc = jj < 128 ? pn * 128 + jj : DFF + pn * 128 + (jj - 128); }
#pragma unroll
    for (int i = 0; i < 8; ++i) { const int kk = (tid >> 6) + 8 * i; tile[kk * 65 + nn] = sc >= 0 ? src[(size_t)(k0 + kk) * Nsrc + sc] : 0.f; }
    __syncthreads();
    const int kk2 = (tid & 31) * 2;
#pragma unroll
    for (int i = 0; i < 4; ++i) { const int nn2 = (tid >> 5) + 16 * i; *(unsigned*)(dst + (size_t)(n0 + nn2) * K + k0 + kk2) = cvt_pk_bf16(tile[kk2 * 65 + nn2], tile[(kk2 + 1) * 65 + nn2]); }
    __syncthreads();
}

__device__ __forceinline__ void phase_prep(KP& p, LAS unsigned char* lds) {
    int tid_ = threadIdx.x; asm volatile("" : "+v"(tid_));
    const int tid = tid_, wid = tid >> 6, lane = tid & 63;
    for (int row = blockIdx.x * 8 + wid; row < T_ALL; row += gridDim.x * 8) {
        const float* src = row < T_P ? p.in[0] + (size_t)row * DM : p.in[1] + (size_t)(row - T_P) * DM;
        ln_row(src, nullptr, nullptr, (bf16_t*)(p.ws + W_XB) + (size_t)row * DM, p.in[7], p.in[8], lane);
    }
    constexpr int T_IN = 48 * 16, T_OUT = 16 * 16, T_UPT = 88 * 16, T_DNT = 16 * 44, T_L = T_IN + T_OUT + T_UPT + T_DNT;
    for (int it = blockIdx.x; it < 4 * T_L; it += gridDim.x) {
        const int l = it / T_L; int r = it % T_L;
        if (r < T_IN) tr_tile((LAS float*)lds, p.in[9] + (size_t)l * DM * 2950, 2950, (bf16_t*)(p.ws + W_IN + l * W_IN_L), DM, (r >> 4) * 64, (r & 15) * 64, 0, tid);
        else if ((r -= T_IN) < T_OUT) tr_tile((LAS float*)lds, p.in[19] + (size_t)l * DM * DM, DM, (bf16_t*)(p.ws + W_OUT + l * W_OUT_L), DM, (r >> 4) * 64, (r & 15) * 64, 1, tid);
        else if ((r -= T_OUT) < T_UPT) tr_tile((LAS float*)lds, p.in[22] + (size_t)l * DM * DFF2, DFF2, (bf16_t*)(p.ws + W_UP + l * W_UP_L), DM, (r >> 4) * 64, (r & 15) * 64, 2, tid);
        else { r -= T_UPT; tr_tile((LAS float*)lds, p.in[25] + (size_t)l * DFF * DM, DM, (bf16_t*)(p.ws + W_DN + l * W_DN_L), DFF, (r / 44) * 64, (r % 44) * 64, 1, tid); }
    }
    for (int i = blockIdx.x * 512 + tid; i < 4 * 4 * 128 * 128; i += gridDim.x * 512) {
        const int jj = i & 127, ii = (i >> 7) & 127;
        ((bf16_t*)(p.ws + W_GW))[i] = (bf16_t)(cvt_pk_bf16(jj <= ii ? p.in[16][i] : 0.f, 0.f) & 0xffffu);
    }
}

__device__ __forceinline__ void phase_ln(KP& p, const bf16_t* rsrc, const float* g, const float* b, bool final_out) {
    int tid_ = threadIdx.x; asm volatile("" : "+v"(tid_));
    const int wid = tid_ >> 6, lane = tid_ & 63;
    for (int row = blockIdx.x * 8 + wid; row < T_ALL; row += gridDim.x * 8)
        ln_row(nullptr, rsrc + (size_t)row * DM, final_out ? p.out + (size_t)row * DM : nullptr, final_out ? nullptr : (bf16_t*)(p.ws + W_XB) + (size_t)row * DM, g, b, lane);
}

__device__ __forceinline__ void dt_scan(KP& p, int l, int u, int g, int wid, int lane, float& dt, float& ac, float& last) {
    const int h = g * 3 + wid;
    dt = ((const float*)(p.ws + W_DTB))[(size_t)(u * 64 + lane) * 8 + h];
    const float a = -__expf(p.in[14][l * 6 + h]);
    float v = dt * a;
#pragma unroll
    for (int o = 1; o < 64; o <<= 1) { const float t = __shfl_up(v, o); if (lane >= o) v += t; }
    ac = v; last = __shfl(v, 63);
}

__device__ __forceinline__ f32x4 xbc_row(KP& p, int l, int u, int s, int ch) {
    const bf16_t* proj = (const bf16_t*)(p.ws + W_PROJ);
    const bool isP = u < 512; const bool hasprev = isP && (u & 127) != 0;
    if (s >= 0 || hasprev) return unpack4(*(const u32x2*)(proj + (size_t)(u * 64 + s) * NPROJ + C_XBC + ch));
    if (!isP) return *(const f32x4*)(p.in[5] + (unsigned)(((l * 32 + (u - 512)) * 3 + (3 + s)) * 896 + ch));
    return (f32x4){0.f, 0.f, 0.f, 0.f};
}
__device__ __forceinline__ void ssd_states(KP& p, LAS unsigned char* lds, int l, int u) {
    int tid_ = threadIdx.x; asm volatile("" : "+v"(tid_));
    const int tid = tid_, wid = tid >> 6, lane = tid & 63, fr = lane & 15, fq = lane >> 4;
    LAS bf16_t* xT = (LAS bf16_t*)lds;
    LAS bf16_t* BT = (LAS bf16_t*)(lds + 55296);
    LAS float* wgt = (LAS float*)(lds + 92160);
    bf16_t* XC = (bf16_t*)p.out;
    __syncthreads();
    if (wid < 6) {
        float dt, ac, last; dt_scan(p, l, u, wid / 3, wid % 3, lane, dt, ac, last);
        wgt[wid * 64 + lane] = dt * __expf(last - ac);
        if (lane == 0) ((float*)(p.ws + W_CD))[u * 8 + wid] = __expf(last);
    }
    __syncthreads();
    if (tid < 448) {
        const int cgp = tid % 224, seg = tid / 224, ch = cgp * 4, r0 = seg * 32;
        const float* cw = p.in[11] + (size_t)l * 4 * 896 + ch;
        const f32x4 w0 = *(const f32x4*)cw, w1 = *(const f32x4*)(cw + 896), w2 = *(const f32x4*)(cw + 2 * 896), w3 = *(const f32x4*)(cw + 3 * 896);
        const f32x4 bs = *(const f32x4*)(p.in[12] + (size_t)l * 896 + ch);
        f32x4 xm3 = xbc_row(p, l, u, r0 - 3, ch), xm2 = xbc_row(p, l, u, r0 - 2, ch), xm1 = xbc_row(p, l, u, r0 - 1, ch);
        const bf16_t* src = (const bf16_t*)(p.ws + W_PROJ) + (size_t)(u * 64) * NPROJ + C_XBC + ch;
        bf16_t* dst = XC + (size_t)(u * 64) * 896 + ch;
        const int hh = ch >> 6;
#pragma unroll 2
        for (int i = r0; i < r0 + 32; i += 2) {
            const f32x4 xa = unpack4(*(const u32x2*)(src + (size_t)i * NPROJ)), xb = unpack4(*(const u32x2*)(src + (size_t)(i + 1) * NPROJ));
            f32x4 ya = bs + w0 * xm3 + w1 * xm2 + w2 * xm1 + w3 * xa, yb = bs + w0 * xm2 + w1 * xm1 + w2 * xa + w3 * xb;
#pragma unroll
            for (int e = 0; e < 4; ++e) { ya[e] = silu_f(ya[e]); yb[e] = silu_f(yb[e]); }
            xm3 = xm1; xm2 = xa; xm1 = xb;
            *(u32x2*)(dst + (size_t)i * 896) = pack4(ya); *(u32x2*)(dst + (size_t)(i + 1) * 896) = pack4(yb);
            if (ch < 384) { const float wa = wgt[hh * 64 + i], wb = wgt[hh * 64 + i + 1];
#pragma unroll
                for (int e = 0; e < 4; ++e) *(LAS unsigned*)(xT + (ch + e) * 72 + i) = cvt_pk_bf16(ya[e] * wa, yb[e] * wb); }
            else if (ch < 640) {
#pragma unroll
                for (int e = 0; e < 4; ++e) *(LAS unsigned*)(BT + (ch - 384 + e) * 72 + i) = cvt_pk_bf16(ya[e], yb[e]); }
        }
    }
    __syncthreads();
    bf16_t* ST = (bf16_t*)(p.ws + W_ST);
#pragma unroll 2
    for (int k = 0; k < 24; ++k) {
        const int tt = wid * 24 + k, h = tt >> 5, pt = (tt & 31) >> 3, nt = tt & 7, g = h / 3;
        f32x4 acc = (f32x4){0.f, 0.f, 0.f, 0.f};
#pragma unroll
        for (int ks = 0; ks < 2; ++ks) {
            const bf16x8 rf = ldsfrag((LAS const unsigned char*)(xT + (h * 64 + pt * 16 + fr) * 72 + ks * 32 + fq * 8));
            const bf16x8 cf = ldsfrag((LAS const unsigned char*)(BT + (g * 128 + nt * 16 + fr) * 72 + ks * 32 + fq * 8));
            acc = MFMA16(cf, rf, acc);
        }
        *(u32x2*)(ST + ((size_t)(u * 6 + h) * 64 + pt * 16 + fr) * 128 + nt * 16 + fq * 4) = pack4(acc);
    }
}

__device__ __forceinline__ void gmlp_unit(KP& p, LAS unsigned char* lds, int l, int u) {
    int tid_ = threadIdx.x; asm volatile("" : "+v"(tid_));
    const int tid = tid_, wid = tid >> 6, lane = tid & 63, fr = lane & 15, fq = lane >> 4;
    LAS bf16_t* vT = (LAS bf16_t*)lds;
    LAS float* ssq = (LAS float*)(lds + 69632);
    const bf16_t* proj = (const bf16_t*)(p.ws + W_PROJ);
    const int half = u < 512 ? (u & 1) : 0, KJ = (half + 1) * 64, R0 = u * 64, Rb = R0 - half * 64;
    __syncthreads();
    for (int idx = tid; idx < KJ * 32; idx += 512) {
        const int j = idx & (KJ - 1), cgp = idx / KJ;
        const u32x4 w = *(const u32x4*)(proj + (size_t)(Rb + j) * NPROJ + C_VC + cgp * 8);
        const unsigned ww[4] = {w.x, w.y, w.z, w.w};
#pragma unroll
        for (int e = 0; e < 4; ++e) { vT[(cgp * 8 + 2 * e) * 136 + j] = (bf16_t)(ww[e] & 0xffffu); vT[(cgp * 8 + 2 * e + 1) * 136 + j] = (bf16_t)(ww[e] >> 16); }
    }
    __syncthreads();
    const int rt = wid & 3, cbase = (wid >> 2) * 8;
    const bf16_t* GW = (const bf16_t*)(p.ws + W_GW + l * W_GW_L);
    f32x4 acc[8];
#pragma unroll
    for (int gi = 0; gi < 2; ++gi) {
        const int gg = (cbase >> 2) + gi;
        bf16x8 rf[4];
#pragma unroll
        for (int ks = 0; ks < 4; ++ks) rf[ks] = glbfrag(GW + ((size_t)gg * 128 + half * 64 + rt * 16 + fr) * 128 + ks * 32 + fq * 8);
#pragma unroll
        for (int c4 = 0; c4 < 4; ++c4) {
            const int ct = cbase + gi * 4 + c4;
            f32x4 a = (f32x4){0.f, 0.f, 0.f, 0.f};
#pragma unroll
            for (int ks = 0; ks < 4; ++ks) if (ks * 32 < KJ) a = MFMA16(ldsfrag((LAS const unsigned char*)(vT + (ct * 16 + fr) * 136 + ks * 32 + fq * 8)), rf[ks], a);
            acc[gi * 4 + c4] = a;
        }
    }
    const int row = R0 + rt * 16 + fr; float sq = 0.f;
#pragma unroll
    for (int k = 0; k < 8; ++k) {
        const int col = (cbase + k) * 16 + fq * 4, gg = col >> 6;
        const float bsv = p.in[17][(size_t)(l * 4 + gg) * 128 + half * 64 + rt * 16 + fr];
        const f32x4 uv = unpack4(*(const u32x2*)(proj + (size_t)row * NPROJ + C_U + col));
        f32x4 o = uv * (acc[k] + bsv); acc[k] = o;
        sq += (o[0] * o[0] + o[1] * o[1]) + (o[2] * o[2] + o[3] * o[3]);
    }
    sq += __shfl_xor(sq, 16); sq += __shfl_xor(sq, 32);
    if (fq == 0) ssq[(wid >> 2) * 64 + rt * 16 + fr] = sq;
    __syncthreads();
    const float rstd = 1.0f / sqrtf((ssq[rt * 16 + fr] + ssq[64 + rt * 16 + fr]) * (1.0f / 256.0f) + RMS_EPS);
    bf16_t* mix = (bf16_t*)(p.ws + W_MIX);
#pragma unroll
    for (int k = 0; k < 8; ++k) {
        const int col = (cbase + k) * 16 + fq * 4;
        const f32x4 gv = *(const f32x4*)(p.in[18] + (size_t)l * 1024 + 768 + col);
        *(u32x2*)(mix + (size_t)row * DM + 768 + col) = pack4(acc[k] * rstd * gv);
    }
}

__device__ __forceinline__ void scan_prompt(KP& p, int l, int item) {
    int tid_ = threadIdx.x; asm volatile("" : "+v"(tid_));
    const int gid = item * 512 + tid_, e = (gid & 2047) * 4, bh = gid >> 11, b = bh / 6, h = bh % 6;
    bf16_t* ST = (bf16_t*)(p.ws + W_ST); const float* CD = (const float*)(p.ws + W_CD);
    f32x4 st = (f32x4){0.f, 0.f, 0.f, 0.f};
#pragma unroll 1
    for (int c0 = 0; c0 < 128; c0 += 16) {
        u32x2 s[16]; float cd[16];
#pragma unroll
        for (int k = 0; k < 16; ++k) { const int u = b * 128 + c0 + k; s[k] = *(const u32x2*)(ST + ((size_t)(u * 6 + h)) * 8192 + e); cd[k] = CD[u * 8 + h]; }
#pragma unroll
        for (int k = 0; k < 16; ++k) { const int u = b * 128 + c0 + k; *(u32x2*)(ST + ((size_t)(u * 6 + h)) * 8192 + e) = pack4(st); st = st * cd[k] + unpack4(s[k]); }
    }
    *(f32x4*)(p.out + O_PH + ((size_t)(l * 4 + b) * 6 + h) * 8192 + e) = st;
}
__device__ __forceinline__ void scan_sample(KP& p, int l, int item) {
    int tid_ = threadIdx.x; asm volatile("" : "+v"(tid_));
    const int gid = item * 512 + tid_, e = (gid & 2047) * 4, sbh = gid >> 11, sb = sbh / 6, h = sbh % 6;
    bf16_t* ST = (bf16_t*)(p.ws + W_ST); const float* CD = (const float*)(p.ws + W_CD);
    const int u = 512 + sb;
    const f32x4 st = *(const f32x4*)(p.in[4] + ((size_t)(l * 32 + sb) * 6 + h) * 8192 + e);
    const f32x4 s = unpack4(*(const u32x2*)(ST + ((size_t)(u * 6 + h)) * 8192 + e));
    *(u32x2*)(ST + ((size_t)(u * 6 + h)) * 8192 + e) = pack4(st);
    *(f32x4*)(p.out + O_SH + ((size_t)(l * 32 + sb) * 6 + h) * 8192 + e) = st * CD[u * 8 + h] + s;
}

__device__ __forceinline__ void attn_unit(KP& p, LAS unsigned char* lds, int l, int u) {
    int tid_ = threadIdx.x; asm volatile("" : "+v"(tid_));
    const int tid = tid_, wid = tid >> 6, lane = tid & 63, fr = lane & 15, fq = lane >> 4;
    LAS bf16_t* VT = (LAS bf16_t*)(lds + 98304);
    LAS float* bias = (LAS float*)(lds + 153600);
    LAS float* ssq = (LAS float*)(lds + 158208);
    const bf16_t* proj = (const bf16_t*)(p.ws + W_PROJ);
    const bool isP = u < 512; const int R0 = u * 64, c = u & 127, b = u >> 7, sb = u - 512;
    const int qt = wid & 3, hbase = (wid >> 2) * 3;
    __syncthreads();
    for (int i = tid; i < 1152; i += 512) bias[i] = p.in[10][(size_t)l * 1152 + i];
    bf16x8 qf[3][2];
#pragma unroll
    for (int hh = 0; hh < 3; ++hh)
#pragma unroll
        for (int ks = 0; ks < 2; ++ks) qf[hh][ks] = glbfrag(proj + (size_t)(R0 + qt * 16 + fr) * NPROJ + (hbase + hh) * 64 + ks * 32 + fq * 8);
    float mrun[3], lrun[3]; f32x4 O[3][4];
#pragma unroll
    for (int hh = 0; hh < 3; ++hh) { mrun[hh] = -1e30f; lrun[hh] = 0.f;
#pragma unroll
        for (int d = 0; d < 4; ++d) O[hh][d] = (f32x4){0.f, 0.f, 0.f, 0.f}; }
    const int blk_lo = isP ? (c < 8 ? 8 - c : 0) : 0;
    u32x4 vr[6];
    const int vkp = tid & 31, vcg0 = tid >> 5;
#define ATT_LOADP(blkv, bufv) do { const size_t rb_ = isP ? (size_t)b * 8192 + (size_t)(c - 8 + (blkv)) * 64 : (size_t)T_P + (size_t)sb * 64; \
        _Pragma("unroll") for (int it = 0; it < 6; ++it) { const int pu_ = it * 512 + tid, row_ = pu_ / 48, un_ = (pu_ % 48) ^ (row_ & 15); \
            __builtin_amdgcn_global_load_lds((const unsigned*)(proj + (rb_ + row_) * NPROJ + C_K + un_ * 8), (LAS unsigned*)(lds + (bufv) * 49152 + (it * 512 + wid * 64) * 16), 16, 0, 0); } \
        _Pragma("unroll") for (int it = 0; it < 2; ++it) { const int cg_ = vcg0 + it * 16; \
            vr[2 * it] = *(const u32x4*)(proj + (rb_ + 2 * vkp) * NPROJ + C_V + cg_ * 8); vr[2 * it + 1] = *(const u32x4*)(proj + (rb_ + 2 * vkp + 1) * NPROJ + C_V + cg_ * 8); } } while (0)
    bool have = false; int cur = 0;
    if (isP || blk_lo == 8) { ATT_LOADP(blk_lo, 0); have = true; }
#pragma unroll 1
    for (int blk = blk_lo; blk <= 8; ++blk) {
        LAS unsigned char* Kc = lds + cur * 49152;
        __syncthreads();
        if (!have) {
#pragma unroll
            for (int it = 0; it < 6; ++it) { const int idx = it * 512 + tid, row_ = idx / 48, un_ = idx % 48;
                const float* s = p.in[2] + ((size_t)(l * 32 + sb) * 512 + blk * 64 + row_) * 384 + un_ * 8; const f32x4 a = *(const f32x4*)s, bq = *(const f32x4*)(s + 4);
                u32x4 w; w.x = cvt_pk_bf16(a[0], a[1]); w.y = cvt_pk_bf16(a[2], a[3]); w.z = cvt_pk_bf16(bq[0], bq[1]); w.w = cvt_pk_bf16(bq[2], bq[3]);
                *(LAS u32x4*)(Kc + row_ * 768 + ((un_ ^ (row_ & 15)) * 16)) = w; }
#pragma unroll
            for (int it = 0; it < 6; ++it) { const int cg_ = vcg0 + (it >> 1) * 16;
                const float* s = p.in[3] + ((size_t)(l * 32 + sb) * 512 + blk * 64 + 2 * vkp + (it & 1)) * 384 + cg_ * 8; const f32x4 a = *(const f32x4*)s, bq = *(const f32x4*)(s + 4);
                vr[it].x = cvt_pk_bf16(a[0], a[1]); vr[it].y = cvt_pk_bf16(a[2], a[3]); vr[it].z = cvt_pk_bf16(bq[0], bq[1]); vr[it].w = cvt_pk_bf16(bq[2], bq[3]); }
        }
        if (have) { const size_t rb_ = isP ? (size_t)b * 8192 + (size_t)(c - 8 + blk) * 64 : (size_t)T_P + (size_t)sb * 64; const int cg_ = vcg0 + 2 * 16;
            vr[4] = *(const u32x4*)(proj + (rb_ + 2 * vkp) * NPROJ + C_V + cg_ * 8); vr[5] = *(const u32x4*)(proj + (rb_ + 2 * vkp + 1) * NPROJ + C_V + cg_ * 8); }
#pragma unroll
        for (int it = 0; it < 3; ++it) { const int cg_ = vcg0 + it * 16; const u32x4 w0 = vr[2 * it], w1 = vr[2 * it + 1];
            const unsigned a0[4] = {w0.x, w0.y, w0.z, w0.w}, a1[4] = {w1.x, w1.y, w1.z, w1.w};
#pragma unroll
            for (int e = 0; e < 4; ++e) {
                *(LAS unsigned*)(VT + (cg_ * 8 + 2 * e) * 72 + 2 * vkp) = (a0[e] & 0xffffu) | (a1[e] << 16);
                *(LAS unsigned*)(VT + (cg_ * 8 + 2 * e + 1) * 72 + 2 * vkp) = (a0[e] >> 16) | (a1[e] & 0xffff0000u); } }
        asm volatile("s_waitcnt vmcnt(0)" ::: "memory");
        __syncthreads();
        have = false;
        if (blk < 8 && (isP || blk == 7)) { ATT_LOADP(blk + 1, cur ^ 1); have = true; }
#pragma unroll
        for (int hh = 0; hh < 3; ++hh) {
            const int h = hbase + hh;
            f32x4 s[4]; float mx = -1e30f;
#pragma unroll
            for (int kt = 0; kt < 4; ++kt) {
                f32x4 a = (f32x4){0.f, 0.f, 0.f, 0.f};
#pragma unroll
                for (int ks = 0; ks < 2; ++ks) a = MFMA16(ldsfrag((LAS const unsigned char*)(Kc + (kt * 16 + fr) * 768 + (((h * 8 + ks * 4 + fq) ^ fr) * 16))), qf[hh][ks], a);
                if (blk <= 5) { const float bc = bias[h * 192 + 191];
#pragma unroll
                    for (int j = 0; j < 4; ++j) { a[j] = a[j] * 0.125f + bc; mx = fmaxf(mx, a[j]); } }
                else {
#pragma unroll
                    for (int j = 0; j < 4; ++j) {
                        int rel = (qt * 16 + fr) + 512 - (blk * 64 + kt * 16 + fq * 4 + j); rel = rel > 128 ? 128 : rel;
                        a[j] = a[j] * 0.125f + bias[h * 192 + rel + 63]; mx = fmaxf(mx, a[j]);
                    } }
                s[kt] = a;
            }
            mx = fmaxf(mx, __shfl_xor(mx, 16)); mx = fmaxf(mx, __shfl_xor(mx, 32));
            const float mnew = fmaxf(mrun[hh], mx), fac = __expf(mrun[hh] - mnew); mrun[hh] = mnew;
            float rs = 0.f;
#pragma unroll
            for (int kt = 0; kt < 4; ++kt)
#pragma unroll
                for (int j = 0; j < 4; ++j) { s[kt][j] = __expf(s[kt][j] - mnew); rs += s[kt][j]; }
            lrun[hh] = lrun[hh] * fac + rs;
#pragma unroll
            for (int d = 0; d < 4; ++d) O[hh][d] *= fac;
#pragma unroll
            for (int ks = 0; ks < 2; ++ks) {
                const u32x2 pa = pack4(s[2 * ks]), pb = pack4(s[2 * ks + 1]);
                const bf16x8 pf = __builtin_bit_cast(bf16x8, (u32x4){pa.x, pa.y, pb.x, pb.y});
#pragma unroll
                for (int d = 0; d < 4; ++d) {
                    const LAS bf16_t* vrow = VT + (h * 64 + d * 16 + fr) * 72 + ks * 32 + fq * 4;
                    const u32x2 va = *(const LAS u32x2*)vrow, vb = *(const LAS u32x2*)(vrow + 16);
                    O[hh][d] = MFMA16(__builtin_bit_cast(bf16x8, (u32x4){va.x, va.y, vb.x, vb.y}), pf, O[hh][d]);
                }
            }
        }
        cur ^= 1;
    }
#pragma unroll
    for (int hh = 0; hh < 3; ++hh) { lrun[hh] += __shfl_xor(lrun[hh], 16); lrun[hh] += __shfl_xor(lrun[hh], 32); }
    float sq = 0.f;
#pragma unroll
    for (int hh = 0; hh < 3; ++hh) { const float inv = 1.0f / lrun[hh];
#pragma unroll
        for (int d = 0; d < 4; ++d) { O[hh][d] *= inv; const f32x4 o = O[hh][d]; sq += (o[0] * o[0] + o[1] * o[1]) + (o[2] * o[2] + o[3] * o[3]); } }
    sq += __shfl_xor(sq, 16); sq += __shfl_xor(sq, 32);
    if (fq == 0) ssq[(wid >> 2) * 64 + qt * 16 + fr] = sq;
    __syncthreads();
    const float rstd = 1.0f / sqrtf((ssq[qt * 16 + fr] + ssq[64 + qt * 16 + fr]) * (1.0f / 384.0f) + RMS_EPS);
    bf16_t* mix = (bf16_t*)(p.ws + W_MIX);
#pragma unroll
    for (int hh = 0; hh < 3; ++hh)
#pragma unroll
        for (int d = 0; d < 4; ++d) {
            const int col = (hbase + hh) * 64 + d * 16 + fq * 4;
            const f32x4 gv = *(const f32x4*)(p.in[18] + (size_t)l * 1024 + col);
            *(u32x2*)(mix + (size_t)(R0 + qt * 16 + fr) * DM + col) = pack4(O[hh][d] * rstd * gv);
        }
}

__device__ __forceinline__ void ssd_y(KP& p, LAS unsigned char* lds, int l, int u) {
    int tid_ = threadIdx.x; asm volatile("" : "+v"(tid_));
    const int tid = tid_, wid = tid >> 6, lane = tid & 63, fr = lane & 15, fq = lane >> 4;
    LAS bf16_t* Cn = (LAS bf16_t*)lds;
    LAS bf16_t* Bn = (LAS bf16_t*)(lds + 17408);
    LAS bf16_t* xT = (LAS bf16_t*)(lds + 34816);
    LAS bf16_t* Mm = (LAS bf16_t*)(lds + 62464);
    LAS float* dtl = (LAS float*)(lds + 90112);
    LAS float* acl = (LAS float*)(lds + 90880);
    LAS float* ssq = (LAS float*)(lds + 91648);
    LAS bf16_t* HPl = (LAS bf16_t*)(lds + 92160);
    const bf16_t* proj = (const bf16_t*)(p.ws + W_PROJ);
    const bf16_t* HP = (const bf16_t*)(p.ws + W_ST);
    const bf16_t* XC = (const bf16_t*)p.out + (size_t)(u * 64) * 896;
    const int R0 = u * 64, lt = wid & 3;
    f32x4 yacc[2][6];
#pragma unroll
    for (int g = 0; g < 2; ++g) {
        __syncthreads();
        if (wid < 3) { float dt, ac, last; dt_scan(p, l, u, g, wid, lane, dt, ac, last); dtl[wid * 64 + lane] = dt; acl[wid * 64 + lane] = ac; }
#pragma unroll
        for (int it = 0; it < 4; ++it) {
            const int idx = it * 512 + tid, mat = idx >> 10, i = (idx >> 4) & 63, c8 = idx & 15;
            const u32x4 w = *(const u32x4*)(XC + (size_t)i * 896 + 384 + mat * 256 + g * 128 + c8 * 8);
            *(LAS u32x4*)((mat ? Cn : Bn) + i * 136 + c8 * 8) = w;
        }
#pragma unroll
        for (int it = 0; it < 6; ++it) {
            const int idx = it * 512 + tid, r_ = idx >> 4, c8 = idx & 15;
            *(LAS u32x4*)(HPl + r_ * 136 + c8 * 8) = *(const u32x4*)(HP + ((size_t)(u * 6 + g * 3) * 64 + r_) * 128 + c8 * 8);
        }
#pragma unroll
        for (int it = 0; it < 3; ++it) {
            const int idx = it * 512 + tid, c4 = idx % 48, i = (idx / 48) * 2;
            const u32x2 wa = *(const u32x2*)(XC + (size_t)i * 896 + g * 192 + c4 * 4), wb = *(const u32x2*)(XC + (size_t)(i + 1) * 896 + g * 192 + c4 * 4);
            *(LAS unsigned*)(xT + (c4 * 4 + 0) * 72 + i) = (wa.x & 0xffffu) | (wb.x << 16);
            *(LAS unsigned*)(xT + (c4 * 4 + 1) * 72 + i) = (wa.x >> 16) | (wb.x & 0xffff0000u);
            *(LAS unsigned*)(xT + (c4 * 4 + 2) * 72 + i) = (wa.y & 0xffffu) | (wb.y << 16);
            *(LAS unsigned*)(xT + (c4 * 4 + 3) * 72 + i) = (wa.y >> 16) | (wb.y & 0xffff0000u);
        }
        __syncthreads();
#pragma unroll
        for (int k = 0; k < 2; ++k) {
            const int st = (wid >> 2) * 2 + k;
            f32x4 a = (f32x4){0.f, 0.f, 0.f, 0.f};
#pragma unroll
            for (int ks = 0; ks < 4; ++ks) a = MFMA16(ldsfrag((LAS const unsigned char*)(Bn + (st * 16 + fr) * 136 + ks * 32 + fq * 8)), ldsfrag((LAS const unsigned char*)(Cn + (lt * 16 + fr) * 136 + ks * 32 + fq * 8)), a);
            const int li = lt * 16 + fr;
#pragma unroll
            for (int hh = 0; hh < 3; ++hh) {
                const float al = acl[hh * 64 + li]; f32x4 mv;
#pragma unroll
                for (int j = 0; j < 4; ++j) { const int si = st * 16 + fq * 4 + j; mv[j] = si <= li ? a[j] * __expf(al - acl[hh * 64 + si]) * dtl[hh * 64 + si] : 0.f; }
                *(LAS u32x2*)(Mm + (hh * 64 + li) * 72 + st * 16 + fq * 4) = pack4(mv);
            }
        }
        __syncthreads();
#pragma unroll
        for (int k = 0; k < 6; ++k) {
            const int ctile = (wid >> 2) * 6 + k, hh = ctile >> 2, pt = ctile & 3, h = g * 3 + hh, li = lt * 16 + fr;
            f32x4 ad = (f32x4){0.f, 0.f, 0.f, 0.f}, ao = (f32x4){0.f, 0.f, 0.f, 0.f};
#pragma unroll
            for (int ks = 0; ks < 2; ++ks) ad = MFMA16(ldsfrag((LAS const unsigned char*)(xT + (hh * 64 + pt * 16 + fr) * 72 + ks * 32 + fq * 8)), ldsfrag((LAS const unsigned char*)(Mm + (hh * 64 + li) * 72 + ks * 32 + fq * 8)), ad);
#pragma unroll
            for (int ks = 0; ks < 4; ++ks) ao = MFMA16(ldsfrag((LAS const unsigned char*)(HPl + (hh * 64 + pt * 16 + fr) * 136 + ks * 32 + fq * 8)), ldsfrag((LAS const unsigned char*)(Cn + li * 136 + ks * 32 + fq * 8)), ao);
            const float ea = __expf(acl[hh * 64 + li]), dsk = p.in[15][l * 6 + h];
            const f32x4 xv = unpack4(*(const u32x2*)(XC + (size_t)li * 896 + h * 64 + pt * 16 + fq * 4));
            const f32x4 zv = unpack4(*(const u32x2*)(proj + (size_t)(R0 + li) * NPROJ + C_Z + h * 64 + pt * 16 + fq * 4));
            f32x4 y = ad + ao * ea + xv * dsk;
#pragma unroll
            for (int j = 0; j < 4; ++j) y[j] *= silu_f(zv[j]);
            yacc[g][k] = y;
            asm volatile("" ::: "memory");
        }
    }
    float sq = 0.f;
#pragma unroll
    for (int g = 0; g < 2; ++g)
#pragma unroll
        for (int k = 0; k < 6; ++k) { const f32x4 o = yacc[g][k]; sq += (o[0] * o[0] + o[1] * o[1]) + (o[2] * o[2] + o[3] * o[3]); }
    sq += __shfl_xor(sq, 16); sq += __shfl_xor(sq, 32);
    if (fq == 0) ssq[(wid >> 2) * 64 + lt * 16 + fr] = sq;
    __syncthreads();
    const float rstd = 1.0f / sqrtf((ssq[lt * 16 + fr] + ssq[64 + lt * 16 + fr]) * (1.0f / 384.0f) + RMS_EPS);
    bf16_t* mix = (bf16_t*)(p.ws + W_MIX);
#pragma unroll
    for (int g = 0; g < 2; ++g)
#pragma unroll
        for (int k = 0; k < 6; ++k) {
            const int col = 384 + g * 192 + ((wid >> 2) * 6 + k) * 16 + fq * 4;
            const f32x4 gv = *(const f32x4*)(p.in[18] + (size_t)l * 1024 + col);
            *(u32x2*)(mix + (size_t)(R0 + lt * 16 + fr) * DM + col) = pack4(yacc[g][k] * rstd * gv);
        }
}

__device__ __forceinline__ void phase_fix(KP& p, int l) {
    const float* halo = (const float*)(p.ws + W_MIX); bf16_t* H = (bf16_t*)(p.ws + W_PROJ);
    const float* w = p.in[23] + (size_t)l * 3 * DFF2; const float* bb = p.in[24] + (size_t)l * DFF2;
    int tid_ = threadIdx.x; asm volatile("" : "+v"(tid_));
    for (int i = blockIdx.x * 512 + tid_; i < 128 * DFF2; i += gridDim.x * 512) {
        const int pm = i / DFF2, cc = i % DFF2;
        if ((pm & 31) == 0 || cc >= DFF) continue;
        const float* h0 = halo + (size_t)(pm - 1) * 4 * DFF2; const float* h1 = halo + (size_t)pm * 4 * DFF2;
        float r[2];
#pragma unroll
        for (int rr = 0; rr < 2; ++rr) {
            float o[2];
#pragma unroll
            for (int gv = 0; gv < 2; ++gv) {
                const int c2 = cc + gv * DFF;
                const float xm2 = h0[2 * DFF2 + c2], xm1 = h0[3 * DFF2 + c2], x0 = h1[c2], x1 = h1[DFF2 + c2];
                o[gv] = rr == 0 ? bb[c2] + w[c2] * xm2 + w[DFF2 + c2] * xm1 + w[2 * DFF2 + c2] * x0 : bb[c2] + w[c2] * xm1 + w[DFF2 + c2] * x0 + w[2 * DFF2 + c2] * x1;
            }
            r[rr] = silu_f(o[0]) * o[1];
        }
        H[((size_t)pm * 256) * DFF + cc] = (bf16_t)(cvt_pk_bf16(r[0], 0.f) & 0xffffu);
        H[((size_t)pm * 256 + 1) * DFF + cc] = (bf16_t)(cvt_pk_bf16(r[1], 0.f) & 0xffffu);
    }
}

#define XB_TMO      128
#define XB_XCNT(j)  (256  + 64 * (j))
#define XB_XSUB(j)  (1280 + 64 * (j))
#define XB_XGEN(j)  (2304 + 64 * (j))
#define XB_TOP      3328
#define XB_TOPGEN   3392
#define XCD_BAR_WORDS 3456
#define XB_SPIN_CAP (1u << 18)

__device__ __forceinline__ unsigned xb_ld(unsigned* p)              { return __hip_atomic_load(p, __ATOMIC_RELAXED, __HIP_MEMORY_SCOPE_AGENT); }
__device__ __forceinline__ unsigned xb_add(unsigned* p, unsigned v) { return __hip_atomic_fetch_add(p, v, __ATOMIC_RELAXED, __HIP_MEMORY_SCOPE_AGENT); }
__device__ __forceinline__ unsigned xb_xcc_id() { return (unsigned)__builtin_amdgcn_s_getreg((3 << 11) | 20) & 0xFu; }
#define XB_SPIN(cond, bar) do { unsigned _sp = 0; while (cond) { __builtin_amdgcn_s_sleep(1); \
    if ((++_sp & 255u) == 0u) { if (xb_ld(&(bar)[XB_TMO])) break; if (_sp > XB_SPIN_CAP) { atomicAdd(&(bar)[XB_TMO], 1u); break; } } } } while (0)

struct XcdBarrier {
    unsigned* bar; unsigned x;
    volatile LAS unsigned* st;
};

__device__ __forceinline__ XcdBarrier xcd_barrier_post(unsigned* bar, volatile LAS unsigned* st) {
    XcdBarrier b; b.bar = bar; b.x = xb_xcc_id(); b.st = st;
    if (threadIdx.x == 0) (void)xb_add(&bar[XB_XCNT(b.x)], 1u);
    return b;
}
__device__ __forceinline__ void xcd_barrier_complete(unsigned* bar, unsigned x, unsigned& nloc, unsigned& nx) {
    const unsigned G = gridDim.x * gridDim.y * gridDim.z;
    unsigned sum, cnt, mine, sp = 0u;
    for (;;) {
        sum = 0u; cnt = 0u; mine = 0u;
#pragma unroll
        for (unsigned j = 0; j < 16; ++j) { const unsigned c = xb_ld(&bar[XB_XCNT(j)]); sum += c; cnt += (c > 0u) ? 1u : 0u; mine = (j == x) ? c : mine; }
        if (sum == G) break;
        __builtin_amdgcn_s_sleep(1);
        if ((++sp & 255u) == 0u) { if (xb_ld(&bar[XB_TMO])) break; if (sp > XB_SPIN_CAP) { atomicAdd(&bar[XB_TMO], 1u); break; } }
    }
    nloc = mine > 0u ? mine : 1u; nx = cnt > 0u ? cnt : 1u;
}

__device__ __forceinline__ void xcd_barrier(const XcdBarrier& b) {
    asm volatile("s_waitcnt vmcnt(0)" ::: "memory");
    __syncthreads();
    if (threadIdx.x == 0) {
        unsigned* bar = b.bar;
        __builtin_amdgcn_s_waitcnt(0);
        unsigned nloc = b.st[0], nx = b.st[1];
        if (nloc == 0u) { xcd_barrier_complete(bar, b.x, nloc, nx); b.st[0] = nloc; b.st[1] = nx; }
        const unsigned old = xb_add(&bar[XB_XSUB(b.x)], 1u);
        const unsigned gen = old / nloc;
        if (old + 1u == (gen + 1u) * nloc) {
            __builtin_amdgcn_fence(__ATOMIC_RELEASE, "agent");
            asm volatile("s_waitcnt vmcnt(0)" ::: "memory");
            const unsigned og = xb_add(&bar[XB_TOP], 1u);
            const unsigned tg = og / nx;
            if (og + 1u == (tg + 1u) * nx) xb_add(&bar[XB_TOPGEN], 1u);
            else XB_SPIN(xb_ld(&bar[XB_TOPGEN]) == tg, bar);
            __builtin_amdgcn_fence(__ATOMIC_ACQUIRE, "agent");
            xb_add(&bar[XB_XGEN(b.x)], 1u);
            asm volatile("s_waitcnt vmcnt(0)" ::: "memory");
        } else {
            XB_SPIN(xb_ld(&bar[XB_XGEN(b.x)]) == gen, bar);
            __builtin_amdgcn_fence(__ATOMIC_ACQUIRE, "agent");
            asm volatile("s_waitcnt vmcnt(0)" ::: "memory");
        }
    }
    __syncthreads();
}

__global__ void __launch_bounds__(512, 2) mega(Params pa) {
    extern __shared__ __attribute__((aligned(16))) unsigned char shm[];
    LAS unsigned char* lds = (LAS unsigned char*)shm;
    const int G = gridDim.x, bid = blockIdx.x;
    KP* pk = (KP*)__builtin_amdgcn_kernarg_segment_ptr();
    volatile LAS unsigned* bst = (volatile LAS unsigned*)(lds + LDS_BYTES - 16);
    XcdBarrier xb; xb.bar = nullptr; xb.x = 0; xb.st = bst;
    if (pa.coop) { if (threadIdx.x < 2) bst[threadIdx.x] = 0u; __syncthreads(); xb = xcd_barrier_post((unsigned*)(pa.ws + W_BAR), bst); }
    for (int ph = pa.ph_lo; ph < pa.ph_hi; ++ph) {
        if (ph > pa.ph_lo && pa.coop) { if (pa.pad == 0x5a5a) { __threadfence(); cg::this_grid().sync(); } else xcd_barrier(xb); }
        asm volatile("" : "+s"(pk)); KP& p = *pk;
        if (ph == 0) { phase_prep(p, lds); continue; }
        if (ph == 42) { int tq = threadIdx.x; asm volatile("" : "+v"(tq)); const unsigned short* w16 = (const unsigned short*)p.ws; for (size_t i = (size_t)bid * 512 + tq; i < (size_t)59418624; i += (size_t)G * 512) p.out[i] = (float)w16[i * 4]; continue; }
        if (ph == 41) { int tq = threadIdx.x; asm volatile("" : "+v"(tq)); for (size_t i = (size_t)bid * 512 + tq; i < (size_t)59418624; i += (size_t)G * 512) { const float v = p.out[i]; if (!(fabsf(v) < 1e30f)) p.out[i] = 0.f; } continue; }
        const int l = (ph - 1) / 10, k = (ph - 1) % 10;
        bf16_t* XB = (bf16_t*)(p.ws + W_XB);
        switch (k) {
        case 0: if (REP_G1 > 1) { pg8::StaticOrder S; S.init(T_ALL, NPROJ, G, bid); EpiNull E{(float*)(p.ws + W_CD)};
                  pg8::gemm_phase(lds, pg8::Gemm{XB, (const bf16_t*)(p.ws + W_IN + l * W_IN_L), T_ALL, NPROJ, DM}, S, E); }
                { if ((bid >> 3) & 1) { __builtin_amdgcn_s_sleep(127); __builtin_amdgcn_s_sleep(127); __builtin_amdgcn_s_sleep(127); }
                  pg8::StaticOrder S; S.init(T_ALL, NPROJ, G, bid);
                  EpiIn E{(bf16_t*)(p.ws + W_PROJ), p.out, (float*)(p.ws + W_DTB), p.in[13], l};
                  pg8::gemm_phase(lds, pg8::Gemm{XB, (const bf16_t*)(p.ws + W_IN + l * W_IN_L), T_ALL, NPROJ, DM}, S, E); } break;
        case 1: {
                  unsigned* qctr = (unsigned*)(p.ws + W_BAR + 14336) + l * 64;
                  volatile LAS int* qslot = (volatile LAS int*)(lds + LDS_BYTES - 32);
                  for (;;) {
                      __syncthreads();
                      if (threadIdx.x == 0) qslot[0] = (int)__hip_atomic_fetch_add(qctr, 1u, __ATOMIC_RELAXED, __HIP_MEMORY_SCOPE_AGENT);
                      __syncthreads();
                      const int it = qslot[0];
                      if (it >= 2 * NU64) break;
                      if (it < NU64) attn_unit(p, lds, l, NU64 - 1 - it); else ssd_states(p, lds, l, it - NU64);
                  } } break;
        case 2: for (int it = bid; it < 96 + 768; it += G) { if (it < 96) scan_prompt(p, l, it); else scan_sample(p, l, it - 96); } break;
        case 3: {
                  unsigned* qctr = (unsigned*)(p.ws + W_BAR + 14336) + l * 64 + 32;
                  volatile LAS int* qslot = (volatile LAS int*)(lds + LDS_BYTES - 32);
                  for (;;) {
                      __syncthreads();
                      if (threadIdx.x == 0) qslot[0] = (int)__hip_atomic_fetch_add(qctr, 1u, __ATOMIC_RELAXED, __HIP_MEMORY_SCOPE_AGENT);
                      __syncthreads();
                      const int it = qslot[0];
                      if (it >= 2 * NU64) break;
                      if (it < NU64) ssd_y(p, lds, l, it); else gmlp_unit(p, lds, l, it - NU64);
                  } } break;
        case 4: { pg8::StaticOrder S; S.init(T_ALL, DM, G, bid); EpiRes E{p.out, XB, (bf16_t*)p.out};
                  pg8::gemm_phase(lds, pg8::Gemm{(const bf16_t*)(p.ws + W_MIX), (const bf16_t*)(p.ws + W_OUT + l * W_OUT_L), T_ALL, DM, DM}, S, E); } break;
        case 5: phase_ln(p, (const bf16_t*)p.out, p.in[20] + l * DM, p.in[21] + l * DM, false); break;
        case 6: for (int rep = 0; rep < REP_G3; ++rep) { pg8::StaticOrder S; S.init(T_ALL, DFF2, G, bid);
                  EpiUp E{(bf16_t*)(p.ws + W_PROJ), (float*)(p.ws + W_MIX), p.out, p.in[23], p.in[24], p.in[6], l};
                  pg8::OneUnit o1;
                  for (int i = 0; S.next(i, o1.u); ++i) { pg8::gemm_phase(lds, pg8::Gemm{XB, (const bf16_t*)(p.ws + W_UP + l * W_UP_L), T_ALL, DFF2, DM}, o1, E); __syncthreads(); } } break;
        case 7: phase_fix(p, l); break;
        case 8: { pg8::StaticOrder S; S.init(T_ALL, DM, G, bid); EpiRes E{p.out, XB, (bf16_t*)(p.ws + W_MIX)};
                  pg8::gemm_phase(lds, pg8::Gemm{(const bf16_t*)(p.ws + W_PROJ), (const bf16_t*)(p.ws + W_DN + l * W_DN_L), T_ALL, DM, DFF}, S, E); } break;
        case 9: phase_ln(p, (const bf16_t*)(p.ws + W_MIX), p.in[26] + l * DM, p.in[27] + l * DM, l == DEPTH - 1); break;
        }
    }
}

constexpr int N_PHASES = 41;
#ifndef MULTI_LAUNCH
#define MULTI_LAUNCH 0
#endif

extern "C" void kernel_launch(void* const* d_in, const int* in_sizes, int n_in, void* d_out, int out_size, void* d_ws, size_t ws_size, hipStream_t stream) {
    static int grid = 0;
    if (grid == 0) {
        if (n_in != 28 || ws_size < W_END2) { fprintf(stderr, "kernel_launch: need 28 inputs and %zu bytes of workspace (got %d, %zu)\n", (size_t)W_END2, n_in, ws_size); grid = -1; return; }
        int dev = 0, cus = 0, per_cu = 0;
        hipGetDevice(&dev); hipDeviceGetAttribute(&cus, hipDeviceAttributeMultiprocessorCount, dev);
        if (hipFuncSetAttribute((const void*)mega, hipFuncAttributeMaxDynamicSharedMemorySize, LDS_BYTES) != hipSuccess) { fprintf(stderr, "kernel_launch: hipFuncSetAttribute failed\n"); grid = -1; return; }
        hipOccupancyMaxActiveBlocksPerMultiprocessor(&per_cu, (const void*)mega, 512, LDS_BYTES);
        (void)hipGetLastError();
        if (per_cu < 1) per_cu = 1;
        grid = cus * 1;
    }
    if (grid < 0) return;
    Params p{};
    for (int i = 0; i < 28; ++i) p.in[i] = (const float*)d_in[i];
    p.out = (float*)d_out; p.ws = (unsigned char*)d_ws;
#if MULTI_LAUNCH
#ifdef PROBE_CUT
    for (int ph = 0; ph < PROBE_CUT; ++ph) { p.ph_lo = ph; p.ph_hi = ph + 1; p.coop = 0; hipLaunchKernelGGL(mega, dim3(grid), dim3(512), LDS_BYTES, stream, p); }
    p.ph_lo = 42; p.ph_hi = 43; p.coop = 0; hipLaunchKernelGGL(mega, dim3(grid), dim3(512), LDS_BYTES, stream, p);
#else
    for (int ph = 0; ph < N_PHASES; ++ph) { p.ph_lo = ph; p.ph_hi = ph + 1; p.coop = 0; hipLaunchKernelGGL(mega, dim3(grid), dim3(512), LDS_BYTES, stream, p); }
#endif
#else
    p.ph_lo = 0; p.ph_hi = N_PHASES; p.coop = 1;
    if (hipMemsetAsync((char*)d_ws + W_BAR, 0, 16384, stream) != hipSuccess) { fprintf(stderr, "kernel_launch: memset failed\n"); return; }
    void* args[] = {&p};
    hipError_t e = hipLaunchCooperativeKernel((const void*)mega, dim3(grid), dim3(512), args, LDS_BYTES, stream);
    if (e != hipSuccess) fprintf(stderr, "cooperative launch failed: %s (grid %d)\n", hipGetErrorString(e), grid);
#endif
}
```

```cpp
#define REP_G1 1
#define REP_M1 1
#define REP_ATT 1
#define REP_M3 1
#define REP_G3 1
#include <hip/hip_runtime.h>
#include <hip/hip_cooperative_groups.h>
#include <cstdio>
namespace cg = cooperative_groups;

#define LAS __attribute__((address_space(3)))
typedef unsigned short bf16_t;
typedef short bf16x8 __attribute__((ext_vector_type(8)));
typedef float f32x4 __attribute__((ext_vector_type(4)));
typedef float f32x2 __attribute__((ext_vector_type(2)));
typedef unsigned u32x4 __attribute__((ext_vector_type(4)));
typedef unsigned u32x2 __attribute__((ext_vector_type(2)));

constexpr int T_ALL = 34816, T_P = 32768, DM = 1024, NPROJ = 3072, DFF = 2816, DFF2 = 5632, DEPTH = 4;
constexpr int NU64 = 544;
constexpr float ALPHA = 1.6817928305074290f;
constexpr float LN_EPS = 1e-5f, RMS_EPS = 1e-5f;
constexpr int C_K = 384, C_V = 768, C_Z = 1152, C_XBC = 1536, C_U = 2432, C_VC = 2688, C_DT = 2944;
constexpr size_t O_YP = 0, O_YS = 33554432, O_PK = 35651584, O_PV = O_PK + 3145728, O_PH = O_PV + 3145728, O_PC = O_PH + 786432,
                 O_PF = O_PC + 43008, O_SK = O_PF + 180224, O_SV = O_SK + 3145728, O_SH = O_SV + 3145728, O_SC = O_SH + 6291456,
                 O_SG = O_SC + 344064, O_SF = O_SG + 2097152;
constexpr size_t W_IN = 0, W_IN_L = (size_t)NPROJ * DM * 2;
constexpr size_t W_OUT = W_IN + 4 * W_IN_L, W_OUT_L = (size_t)DM * DM * 2;
constexpr size_t W_UP = W_OUT + 4 * W_OUT_L, W_UP_L = (size_t)DFF2 * DM * 2;
constexpr size_t W_DN = W_UP + 4 * W_UP_L, W_DN_L = (size_t)DM * DFF * 2;
constexpr size_t W_GW = W_DN + 4 * W_DN_L, W_GW_L = (size_t)4 * 128 * 128 * 2;
constexpr size_t W_XB = W_GW + 4 * W_GW_L;
constexpr size_t W_PROJ = W_XB + (size_t)T_ALL * DM * 2;
constexpr size_t W_MIX = W_PROJ + (size_t)T_ALL * NPROJ * 2;
constexpr size_t W_ST = W_MIX + (size_t)T_ALL * DM * 2;
constexpr size_t W_CD = W_ST + (size_t)NU64 * 6 * 8192 * 2;
constexpr size_t W_DTB = W_CD + (size_t)NU64 * 8 * 4;
constexpr size_t W_END = W_DTB + (size_t)T_ALL * 8 * 4;
constexpr size_t W_BAR = W_END;
constexpr size_t W_END2 = W_BAR + 16384;
constexpr int LDS_BYTES = 156 * 1024;

struct Params { const float* in[28]; float* out; unsigned char* ws; int ph_lo, ph_hi, coop, pad; };
typedef const __attribute__((address_space(4))) Params KP;

__device__ __forceinline__ float bf2f(unsigned b) { return __uint_as_float(b << 16); }
typedef __bf16 bf16v2 __attribute__((ext_vector_type(2)));
__device__ __forceinline__ unsigned cvt_pk_bf16(float lo, float hi) { const f32x2 v = {lo, hi}; const bf16v2 b = __builtin_convertvector(v, bf16v2); return __builtin_bit_cast(unsigned, b); }
__device__ __forceinline__ u32x2 pack4(f32x4 v) { u32x2 w; w.x = cvt_pk_bf16(v[0], v[1]); w.y = cvt_pk_bf16(v[2], v[3]); return w; }
__device__ __forceinline__ f32x4 unpack4(u32x2 w) { f32x4 v; v[0] = bf2f(w.x & 0xffffu); v[1] = bf2f(w.x >> 16); v[2] = bf2f(w.y & 0xffffu); v[3] = bf2f(w.y >> 16); return v; }
__device__ __forceinline__ float silu_f(float x) { return x * __builtin_amdgcn_rcpf(1.0f + __expf(-x)); }
__device__ __forceinline__ float gelu_tanh(float x) { const float y = 0.7978845608028654f * (x + 0.044715f * x * x * x); const float e = __expf(2.0f * y); return 0.5f * x * (2.0f - 2.0f * __builtin_amdgcn_rcpf(1.0f + e)); }
__device__ __forceinline__ float softplus_f(float x) { const float e = __expf(x); return x > 15.0f ? x : (e < 1e-3f ? e * (1.0f - 0.5f * e + 0.33333333f * e * e) : __logf(1.0f + e)); }
#define MFMA16(colfrag, rowfrag, acc) __builtin_amdgcn_mfma_f32_16x16x32_bf16((colfrag), (rowfrag), (acc), 0, 0, 0)
__device__ __forceinline__ bf16x8 ldsfrag(LAS const unsigned char* p) { return *(LAS const bf16x8*)p; }
__device__ __forceinline__ bf16x8 glbfrag(const bf16_t* p) { return *(const bf16x8*)p; }
#define LDS_WAVE_SYNC() asm volatile("s_waitcnt lgkmcnt(0)" ::: "memory")

namespace pg8 {
constexpr int BM = 256, BK = 64, HALF = 128, HTB = HALF * BK * 2, STAGE_BYTES = 8 * HTB, NXCD = 8, WGM = 16;
__device__ __forceinline__ int lds_byte(int r, int c) { const int st = (r >> 4) * 2 + (c >> 5), rr = r & 15, cc = c & 31, ob = rr * 64 + cc * 2; return st * 1024 + (ob ^ (((ob >> 9) & 1) << 5)); }
__device__ __forceinline__ void stage_rc(int b, int& R, int& C) { const int st = b / 1024, sb = b % 1024, swz = sb ^ (((sb >> 9) & 1) << 5); R = (st >> 1) * 16 + swz / 64; C = (st & 1) * 32 + (swz % 64) / 2; }
__device__ __forceinline__ int perm32(int rho) { const int n = rho >> 4, i = rho & 15; return 8 * (i >> 2) + 4 * n + (i & 3); }
struct Unit { int pm, pn; };
struct Gemm { const bf16_t* A; const bf16_t* Bt; int M, N, K; };
struct StaticOrder {
    int nM, nN, nwg, G, c;
    __device__ __forceinline__ void init(int M, int N, int G_, int c_) { nM = M / BM; nN = N / BM; nwg = nM * nN; G = G_; c = c_; }
    __device__ __forceinline__ bool next(int i, Unit& u) const {
        const long L = (long)i * G + c; if (L >= nwg) return false;
        int wgid = (int)L; { const int q = nwg / NXCD, r = nwg % NXCD, xcd = wgid % NXCD, off = wgid / NXCD; wgid = (xcd < r ? xcd * (q + 1) : r * (q + 1) + (xcd - r) * q) + off; }
        const int nig = WGM * nN, gid = wgid / nig, fm = gid * WGM, gsz = (nM - fm) < WGM ? (nM - fm) : WGM;
        u.pm = fm + ((wgid % nig) % gsz); u.pn = (wgid % nig) / gsz; return true;
    }
    __device__ __forceinline__ void a_ready(const Unit&) const {}
    __device__ __forceinline__ void done(const Unit&) const {}
};
struct OneUnit {
    Unit u;
    __device__ __forceinline__ bool next(int i, Unit& o) const { if (i) return false; o = u; return true; }
    __device__ __forceinline__ void a_ready(const Unit&) const {}
    __device__ __forceinline__ void done(const Unit&) const {}
};

template <class Epi, class Sched>
__device__ __forceinline__ void gemm_phase(LAS unsigned char* lds, const Gemm g, const Sched& S, const Epi& E) {
    int tid_ = threadIdx.x; asm volatile("" : "+v"(tid_));
    const int tid = tid_, wid = __builtin_amdgcn_readfirstlane(tid >> 6), lane = tid & 63, wr = wid >> 2, wc = wid & 3, fr = lane & 15, fq = lane >> 4;
    const int K = g.K, nt = K / BK;
    unsigned voffA[2], voffB[2];
#pragma unroll
    for (int i = 0; i < 2; ++i) { int R, C; stage_rc(tid * 16 + i * 8192, R, C); const int Rb = (R & ~31) + perm32(R & 31); voffA[i] = (unsigned)(R * K + C) * 2u; voffB[i] = (unsigned)(Rb * K + C) * 2u; }
    const size_t kstep = (size_t)(BK * 2);
    const size_t hstep = (size_t)HALF * K * 2;
    const size_t tstep = 2 * hstep;
    const unsigned ldsw = (unsigned)wid * 1024u;
    const int aoff = lds_byte(wr * 64 + fr, fq * 8), boff = lds_byte(wc * 32 + fr, fq * 8);
#define PG8_SA(b, h) (((b) * 2 + (h)) * HTB)
#define PG8_SB(b, h) ((4 + (b) * 2 + (h)) * HTB)
#define PG8_STAGE(bufoff, gbase, voff) do { _Pragma("unroll") for (int _i = 0; _i < 2; ++_i) \
        __builtin_amdgcn_global_load_lds((const unsigned*)((const char*)(gbase) + (voff)[_i]), (LAS unsigned*)(lds + (bufoff) + ldsw + _i * 8192), 16, 0, 0); } while (0)
#define PG8_LDA(dst, b, h) do { _Pragma("unroll") for (int m = 0; m < 4; ++m) _Pragma("unroll") for (int k = 0; k < 2; ++k) dst[m][k] = *(const LAS bf16x8*)(lds + PG8_SA(b, h) + aoff + m * 2048 + k * 1024); } while (0)
#define PG8_LDB(dst, b, h) do { _Pragma("unroll") for (int n = 0; n < 2; ++n) _Pragma("unroll") for (int k = 0; k < 2; ++k) dst[n][k] = *(const LAS bf16x8*)(lds + PG8_SB(b, h) + boff + n * 2048 + k * 1024); } while (0)
#define PG8_MMA(ai, bj, At, Bt) do { __builtin_amdgcn_s_setprio(1); _Pragma("unroll") for (int m = 0; m < 4; ++m) _Pragma("unroll") for (int n = 0; n < 2; ++n) _Pragma("unroll") for (int k = 0; k < 2; ++k) \
        acc[ai][bj][m][n] = __builtin_amdgcn_mfma_f32_16x16x32_bf16(Bt[n][k], At[m][k], acc[ai][bj][m][n], 0, 0, 0); __builtin_amdgcn_s_setprio(0); } while (0)
#define PG8_WAIT_V(n) asm volatile("s_waitcnt vmcnt(" #n ")" ::: "memory")
#define PG8_WAIT_L(n) asm volatile("s_waitcnt lgkmcnt(" #n ")" ::: "memory")
#define PG8_BAR __builtin_amdgcn_s_barrier()
#define PG8_SCHED __builtin_amdgcn_sched_barrier(0)
    Unit cur, nxt; int ui = 0;
    if (!S.next(0, cur)) return;
    f32x4 acc[2][2][4][2];
#pragma unroll
    for (int a = 0; a < 2; ++a)
#pragma unroll
        for (int b = 0; b < 2; ++b)
#pragma unroll
            for (int m = 0; m < 4; ++m)
#pragma unroll
                for (int n = 0; n < 2; ++n) acc[a][b][m][n] = (f32x4){0.f, 0.f, 0.f, 0.f};
    bf16x8 At[4][2], B0[2][2], B1[2][2];
    const char* cA = (const char*)g.A + (size_t)cur.pm * tstep; const char* cB = (const char*)g.Bt + (size_t)cur.pn * tstep;
    S.a_ready(cur);
    PG8_STAGE(PG8_SB(0, 0), cB, voffB); PG8_STAGE(PG8_SA(0, 0), cA, voffA); PG8_STAGE(PG8_SB(0, 1), cB + hstep, voffB); PG8_STAGE(PG8_SA(0, 1), cA + hstep, voffA);
    if (wr == 1) PG8_BAR;
    PG8_WAIT_V(4); PG8_BAR;
    PG8_STAGE(PG8_SB(1, 0), cB + kstep, voffB); PG8_STAGE(PG8_SA(1, 0), cA + kstep, voffA); PG8_STAGE(PG8_SB(1, 1), cB + hstep + kstep, voffB);
    PG8_WAIT_V(6); PG8_BAR;
    for (;;) {
        const bool has_next = S.next(ui + 1, nxt);
        const char* nA = has_next ? (const char*)g.A + (size_t)nxt.pm * tstep : cA; const char* nB = has_next ? (const char*)g.Bt + (size_t)nxt.pn * tstep : cB;
        for (int t = 0; t < nt; t += 2) {
            const bool last = (t == nt - 2);
            const char* a1 = cA + (size_t)(t + 1) * kstep;
            const char* a2 = last ? nA : cA + (size_t)(t + 2) * kstep; const char* b2 = last ? nB : cB + (size_t)(t + 2) * kstep;
            const char* a3 = a2 + kstep; const char* b3 = b2 + kstep;
            if (last && has_next) S.a_ready(nxt);
            PG8_LDB(B0, 0, 0); PG8_SCHED; PG8_LDA(At, 0, 0); PG8_STAGE(PG8_SA(1, 1), a1 + hstep, voffA);
            PG8_WAIT_L(8); PG8_BAR; PG8_WAIT_L(0); PG8_MMA(0, 0, At, B0); PG8_BAR; PG8_SCHED;
            PG8_LDB(B1, 0, 1); PG8_STAGE(PG8_SB(0, 0), b2, voffB);
            PG8_BAR; PG8_WAIT_L(0); PG8_MMA(0, 1, At, B1); PG8_BAR;
            PG8_LDA(At, 0, 1); PG8_STAGE(PG8_SA(0, 0), a2, voffA);
            PG8_BAR; PG8_WAIT_L(0); PG8_MMA(1, 0, At, B0); PG8_BAR; PG8_SCHED;
            PG8_STAGE(PG8_SB(0, 1), b2 + hstep, voffB);
            PG8_WAIT_V(6); PG8_BAR; PG8_MMA(1, 1, At, B1); PG8_BAR;
            PG8_LDB(B0, 1, 0); PG8_SCHED; PG8_LDA(At, 1, 0); PG8_STAGE(PG8_SA(0, 1), a2 + hstep, voffA);
            PG8_WAIT_L(8); PG8_BAR; PG8_WAIT_L(0); PG8_MMA(0, 0, At, B0); PG8_BAR; PG8_SCHED;
            PG8_LDB(B1, 1, 1); PG8_STAGE(PG8_SB(1, 0), b3, voffB);
            PG8_BAR; PG8_WAIT_L(0); PG8_MMA(0, 1, At, B1); PG8_BAR;
            PG8_LDA(At, 1, 1); PG8_STAGE(PG8_SA(1, 0), a3, voffA);
            PG8_BAR; PG8_WAIT_L(0); PG8_MMA(1, 0, At, B0); PG8_BAR; PG8_SCHED;
            PG8_STAGE(PG8_SB(1, 1), b3 + hstep, voffB);
            PG8_WAIT_V(6); PG8_BAR; PG8_MMA(1, 1, At, B1); PG8_BAR;
        }
        if constexpr (!Epi::AFTER_DRAIN) { E(acc, cur, wr, wc, fr, fq); S.done(cur); }
        if (!has_next) break;
#pragma unroll
        for (int a = 0; a < 2; ++a)
#pragma unroll
            for (int b = 0; b < 2; ++b)
#pragma unroll
                for (int m = 0; m < 4; ++m)
#pragma unroll
                    for (int n = 0; n < 2; ++n) acc[a][b][m][n] = (f32x4){0.f, 0.f, 0.f, 0.f};
        cur = nxt; cA = nA; cB = nB; ++ui;
    }
    PG8_WAIT_V(0);
    if (wr == 0) PG8_BAR;
    PG8_BAR;
    if constexpr (Epi::AFTER_DRAIN) { E.fused(acc, cur, wr, wc, fr, fq, lds, wid, lane); S.done(cur); }
#undef PG8_SA
#undef PG8_SB
#undef PG8_STAGE
#undef PG8_LDA
#undef PG8_LDB
#undef PG8_MMA
#undef PG8_WAIT_V
#undef PG8_WAIT_L
#undef PG8_BAR
#undef PG8_SCHED
}
}
using pg8::Unit;

struct EpiIn {
    static constexpr bool AFTER_DRAIN = false;
    bf16_t* proj; float* out; float* dtb; const float* dt_bias; int l;
    __device__ __forceinline__ void operator()(const f32x4 (&acc)[2][2][4][2], const Unit& u, int wr, int wc, int fr_, int fq_) const {
        int fr = fr_, fq = fq_; asm volatile("" : "+v"(fr), "+v"(fq));
#pragma unroll
        for (int bj = 0; bj < 2; ++bj) {
            const int cb = u.pn * 256 + bj * 128;
            const int col = cb + wc * 32 + fq * 8;
            if (cb > C_DT) continue;
#pragma unroll
            for (int ai = 0; ai < 2; ++ai)
#pragma unroll
                for (int m = 0; m < 4; ++m) {
                    const int row = u.pm * 256 + ai * 128 + wr * 64 + m * 16 + fr;
                    const bool isP = row < T_P; int b, t;
                    if (isP) { b = row >> 13; t = row & 8191; } else { b = (row - T_P) >> 6; t = row & 63; }
                    f32x4 v0 = acc[ai][bj][m][0], v1 = acc[ai][bj][m][1];
                    if (cb < C_U) {
                        u32x4 w; { const u32x2 a = pack4(v0), c = pack4(v1); w.x = a.x; w.y = a.y; w.z = c.x; w.w = c.y; }
                        *(u32x4*)(proj + (size_t)row * NPROJ + col) = w;
                        if (cb >= C_K && cb < C_Z) {
                            const int isv = cb >= C_V; const int cc = col - (isv ? C_V : C_K);
                            float* o = nullptr;
                            if (isP) { if (t >= 7680) o = out + (isv ? O_PV : O_PK) + ((size_t)(l * 4 + b) * 512 + (t - 7680)) * 384 + cc; }
                            else o = out + (isv ? O_SV : O_SK) + ((size_t)(l * 32 + b) * 64 + t) * 384 + cc;
                            if (o) { *(f32x4*)o = v0; *(f32x4*)(o + 4) = v1; }
                        } else if (cb >= C_XBC) {
                            const int cc = col - C_XBC; float* o = nullptr;
                            if (isP) { if (t >= 8189) o = out + O_PC + ((size_t)(l * 4 + b) * 3 + (t - 8189)) * 896 + cc; }
                            else if (t >= 61) o = out + O_SC + ((size_t)(l * 32 + b) * 3 + (t - 61)) * 896 + cc;
                            if (o) { *(f32x4*)o = v0; *(f32x4*)(o + 4) = v1; }
                        }
                    } else if (cb < C_DT) {
#pragma unroll
                        for (int j = 0; j < 4; ++j) { v0[j] = gelu_tanh(v0[j]); v1[j] = gelu_tanh(v1[j]); }
                        u32x4 w; { const u32x2 a = pack4(v0), c = pack4(v1); w.x = a.x; w.y = a.y; w.z = c.x; w.w = c.y; }
                        *(u32x4*)(proj + (size_t)row * NPROJ + col) = w;
                        if (cb >= C_VC && !isP) { float* o = out + O_SG + ((size_t)(l * 32 + b) * 64 + t) * 256 + (col - C_VC); *(f32x4*)o = v0; *(f32x4*)(o + 4) = v1; }
                    } else if (col == C_DT) {
                        float* d = dtb + (size_t)row * 8;
#pragma unroll
                        for (int j = 0; j < 4; ++j) d[j] = softplus_f(v0[j] + dt_bias[l * 6 + j]);
#pragma unroll
                        for (int j = 0; j < 2; ++j) d[4 + j] = softplus_f(v1[j] + dt_bias[l * 6 + 4 + j]);
                    }
                    asm volatile("" ::: "memory");
                }
        }
    }
};
struct EpiNull {
    static constexpr bool AFTER_DRAIN = false;
    float* sink;
    __device__ __forceinline__ void operator()(const f32x4 (&acc)[2][2][4][2], const Unit& u, int wr, int wc, int fr, int fq) const {
        float t = 0.f;
#pragma unroll
        for (int ai = 0; ai < 2; ++ai)
#pragma unroll
            for (int bj = 0; bj < 2; ++bj)
#pragma unroll
                for (int m = 0; m < 4; ++m)
#pragma unroll
                    for (int n = 0; n < 2; ++n) t += acc[ai][bj][m][n][0] + acc[ai][bj][m][n][1] + acc[ai][bj][m][n][2] + acc[ai][bj][m][n][3];
        if (t == 123456.789f) sink[0] = t;
    }
};
struct EpiRes {
    static constexpr bool AFTER_DRAIN = false;
    float* x; const bf16_t* xb; bf16_t* rdst;
    __device__ __forceinline__ void operator()(const f32x4 (&acc)[2][2][4][2], const Unit& u, int wr, int wc, int fr_, int fq_) const {
        int fr = fr_, fq = fq_; asm volatile("" : "+v"(fr), "+v"(fq));
        const size_t base = (size_t)(u.pm * 256 + wr * 64 + fr) * DM + u.pn * 256 + wc * 32 + fq * 8;
        u32x4 xw[2][4][2];
#pragma unroll
        for (int ai = 0; ai < 2; ++ai)
#pragma unroll
            for (int m = 0; m < 4; ++m)
#pragma unroll
                for (int bj = 0; bj < 2; ++bj) xw[ai][m][bj] = *(const u32x4*)(xb + base + (size_t)(ai * 128 + m * 16) * DM + bj * 128);
#pragma unroll
        for (int ai = 0; ai < 2; ++ai)
#pragma unroll
            for (int m = 0; m < 4; ++m)
#pragma unroll
                for (int bj = 0; bj < 2; ++bj) { const u32x4 w = xw[ai][m][bj];
                    const f32x4 o0 = unpack4((u32x2){w.x, w.y}), o1 = unpack4((u32x2){w.z, w.w});
                    const u32x2 ra = pack4(o0 * ALPHA + acc[ai][bj][m][0]), rb = pack4(o1 * ALPHA + acc[ai][bj][m][1]);
                    *(u32x4*)(rdst + base + (size_t)(ai * 128 + m * 16) * DM + bj * 128) = (u32x4){ra.x, ra.y, rb.x, rb.y}; }
    }
};
struct EpiUp {
    static constexpr bool AFTER_DRAIN = true;
    bf16_t* H; float* halo; float* out; const float* cw; const float* cb; const float* fstate; int l;
    __device__ __forceinline__ void operator()(const f32x4 (&)[2][2][4][2], const Unit&, int, int, int, int) const {}
    __device__ __forceinline__ void fused(f32x4 (&acc)[2][2][4][2], const Unit& u, int wr, int wc, int fr, int fq, LAS unsigned char* lds, int wid, int lane) const {
        constexpr int LS = 264;
#pragma unroll
        for (int ai = 0; ai < 2; ++ai)
#pragma unroll
            for (int m = 0; m < 4; ++m)
#pragma unroll
                for (int bj = 0; bj < 2; ++bj) {
                        const int rl = ai * 128 + wr * 64 + m * 16 + fr, cl = bj * 128 + wc * 32 + fq * 8;
                        u32x4 w; { const u32x2 a = pack4(acc[ai][bj][m][0]), c = pack4(acc[ai][bj][m][1]); w.x = a.x; w.y = a.y; w.z = c.x; w.w = c.y; }
                        *(LAS u32x4*)(lds + (rl * LS + cl) * 2) = w;
                    }
        __syncthreads();
        const int tid = wid * 64 + lane, j = 2 * (tid & 63), seg = tid >> 6;
        const int hcol = u.pn * 128 + j;
        const float* w = cw + (size_t)l * 3 * DFF2 + hcol; const float* bb = cb + (size_t)l * DFF2 + hcol;
        const f32x2 wg0 = *(const f32x2*)w, wg1 = *(const f32x2*)(w + DFF2), wg2 = *(const f32x2*)(w + 2 * DFF2), bg = *(const f32x2*)bb;
        const f32x2 wv0 = *(const f32x2*)(w + DFF), wv1 = *(const f32x2*)(w + DFF2 + DFF), wv2 = *(const f32x2*)(w + 2 * DFF2 + DFF), bv = *(const f32x2*)(bb + DFF);
        const int r0 = seg * 32, R = u.pm * 256 + r0;
        const bool isP = R < T_P;
        const LAS unsigned char* U = (const LAS unsigned char*)lds;
#define UP2(row, off) ({ const unsigned w_ = *(const LAS unsigned*)(U + ((row) * LS + (off) + j) * 2); (f32x2){bf2f(w_ & 0xffffu), bf2f(w_ >> 16)}; })
        f32x2 g2 = (f32x2){0.f, 0.f}, g1 = g2, v2 = g2, v1 = g2; int skip = 0;
        if (isP) {
            if (seg > 0) { g2 = UP2(r0 - 2, 0); g1 = UP2(r0 - 1, 0); v2 = UP2(r0 - 2, 128); v1 = UP2(r0 - 1, 128); }
            else if ((R & 8191) != 0) skip = 2;
        } else if (seg & 1) { g2 = UP2(r0 - 2, 0); g1 = UP2(r0 - 1, 0); v2 = UP2(r0 - 2, 128); v1 = UP2(r0 - 1, 128); }
        else { const int sb = (R - T_P) >> 6; const float* fs = fstate + (size_t)(l * 32 + sb) * 2 * DFF2 + hcol;
            g2 = *(const f32x2*)fs; g1 = *(const f32x2*)(fs + DFF2); v2 = *(const f32x2*)(fs + DFF); v1 = *(const f32x2*)(fs + DFF2 + DFF); }
        bf16_t* hp = H + (size_t)R * DFF + hcol;
#pragma unroll 8
        for (int i = 0; i < 32; ++i) {
            const f32x2 gq = UP2(r0 + i, 0), vq = UP2(r0 + i, 128);
            if (i >= skip) {
                const f32x2 cgv = bg + wg0 * g2 + wg1 * g1 + wg2 * gq, cvv = bv + wv0 * v2 + wv1 * v1 + wv2 * vq;
                *(unsigned*)(hp + (size_t)i * DFF) = cvt_pk_bf16(silu_f(cgv[0]) * cvv[0], silu_f(cgv[1]) * cvv[1]);
            }
            g2 = g1; g1 = gq; v2 = v1; v1 = vq;
            if (isP) {
                if (seg == 0 && i < 2) { float* hl = halo + ((size_t)u.pm * 4 + i) * DFF2 + hcol; *(f32x2*)hl = gq; *(f32x2*)(hl + DFF) = vq; }
                if (seg == 7 && i >= 30) { float* hl = halo + ((size_t)u.pm * 4 + 2 + (i - 30)) * DFF2 + hcol; *(f32x2*)hl = gq; *(f32x2*)(hl + DFF) = vq;
                    if ((u.pm & 31) == 31) { float* o = out + O_PF + ((size_t)(l * 4 + (u.pm >> 5)) * 2 + (i - 30)) * DFF2 + hcol; *(f32x2*)o = gq; *(f32x2*)(o + DFF) = vq; } }
            } else if ((seg & 1) && i >= 30) {
                const int sb = (R - 32 - T_P) >> 6; float* o = out + O_SF + ((size_t)(l * 32 + sb) * 2 + (i - 30)) * DFF2 + hcol; *(f32x2*)o = gq; *(f32x2*)(o + DFF) = vq;
            }
        }
#undef UP2
    }
};

__device__ __forceinline__ void ln_row(const float* src, const bf16_t* srcb, float* x32, bf16_t* xb, const float* g, const float* b, int lane) {
    f32x4 v[4]; float s = 0.f;
#pragma unroll
    for (int i = 0; i < 4; ++i) { v[i] = srcb ? unpack4(*(const u32x2*)(srcb + i * 256 + lane * 4)) : *(const f32x4*)(src + i * 256 + lane * 4); s += (v[i][0] + v[i][1]) + (v[i][2] + v[i][3]); }
#pragma unroll
    for (int o = 32; o >= 1; o >>= 1) s += __shfl_xor(s, o);
    const float mu = s * (1.0f / 1024.0f); float q = 0.f;
#pragma unroll
    for (int i = 0; i < 4; ++i) { const f32x4 d = v[i] - mu; q += (d[0] * d[0] + d[1] * d[1]) + (d[2] * d[2] + d[3] * d[3]); }
#pragma unroll
    for (int o = 32; o >= 1; o >>= 1) q += __shfl_xor(q, o);
    const float rstd = 1.0f / sqrtf(q * (1.0f / 1024.0f) + LN_EPS);
#pragma unroll
    for (int i = 0; i < 4; ++i) {
        const f32x4 gg = *(const f32x4*)(g + i * 256 + lane * 4), bb = *(const f32x4*)(b + i * 256 + lane * 4);
        const f32x4 o = (v[i] - mu) * rstd * gg + bb;
        if (x32) *(f32x4*)(x32 + i * 256 + lane * 4) = o;
        if (xb) *(u32x2*)(xb + i * 256 + lane * 4) = pack4(o);
    }
}

__device__ __forceinline__ void tr_tile(LAS float* tile, const float* src, int Nsrc, bf16_t* dst, int K, int n0, int k0, int mode, int tid) {
    const int nn = tid & 63, np = n0 + nn; int sc;
    if (mode == 0) sc = np < C_U ? np : (np < C_DT ? np + 6 : (np < C_DT + 6 ? np - 512 : -1));
    else if (mode == 1) sc = np;
    else { const int pn = np >> 8, jj = np & 255; sc = jj < 128 ? pn * 128 + jj : DFF + pn * 128 + (jj - 128); }
#pragma unroll
    for (int i = 0; i < 8; ++i) { const int kk = (tid >> 6) + 8 * i; tile[kk * 65 + nn] = sc >= 0 ? src[(size_t)(k0 + kk) * Nsrc + sc] : 0.f; }
    __syncthreads();
    const int kk2 = (tid & 31) * 2;
#pragma unroll
    for (int i = 0; i < 4; ++i) { const int nn2 = (tid >> 5) + 16 * i; *(unsigned*)(dst + (size_t)(n0 + nn2) * K + k0 + kk2) = cvt_pk_bf16(tile[kk2 * 65 + nn2], tile[(kk2 + 1) * 65 + nn2]); }
    __syncthreads();
}

__device__ __forceinline__ void phase_prep(KP& p, LAS unsigned char* lds) {
    int tid_ = threadIdx.x; asm volatile("" : "+v"(tid_));
    const int tid = tid_, wid = tid >> 6, lane = tid & 63;
    for (int row = blockIdx.x * 8 + wid; row < T_ALL; row += gridDim.x * 8) {
        const float* src = row < T_P ? p.in[0] + (size_t)row * DM : p.in[1] + (size_t)(row - T_P) * DM;
        ln_row(src, nullptr, nullptr, (bf16_t*)(p.ws + W_XB) + (size_t)row * DM, p.in[7], p.in[8], lane);
    }
    constexpr int T_IN = 48 * 16, T_OUT = 16 * 16, T_UPT = 88 * 16, T_DNT = 16 * 44, T_L = T_IN + T_OUT + T_UPT + T_DNT;
    for (int it = blockIdx.x; it < 4 * T_L; it += gridDim.x) {
        const int l = it / T_L; int r = it % T_L;
        if (r < T_IN) tr_tile((LAS float*)lds, p.in[9] + (size_t)l * DM * 2950, 2950, (bf16_t*)(p.ws + W_IN + l * W_IN_L), DM, (r >> 4) * 64, (r & 15) * 64, 0, tid);
        else if ((r -= T_IN) < T_OUT) tr_tile((LAS float*)lds, p.in[19] + (size_t)l * DM * DM, DM, (bf16_t*)(p.ws + W_OUT + l * W_OUT_L), DM, (r >> 4) * 64, (r & 15) * 64, 1, tid);
        else if ((r -= T_OUT) < T_UPT) tr_tile((LAS float*)lds, p.in[22] + (size_t)l * DM * DFF2, DFF2, (bf16_t*)(p.ws + W_UP + l * W_UP_L), DM, (r >> 4) * 64, (r & 15) * 64, 2, tid);
        else { r -= T_UPT; tr_tile((LAS float*)lds, p.in[25] + (size_t)l * DFF * DM, DM, (bf16_t*)(p.ws + W_DN + l * W_DN_L), DFF, (r / 44) * 64, (r % 44) * 64, 1, tid); }
    }
    for (int i = blockIdx.x * 512 + tid; i < 4 * 4 * 128 * 128; i += gridDim.x * 512) {
        const int jj = i & 127, ii = (i >> 7) & 127;
        ((bf16_t*)(p.ws + W_GW))[i] = (bf16_t)(cvt_pk_bf16(jj <= ii ? p.in[16][i] : 0.f, 0.f) & 0xffffu);
    }
}

__device__ __forceinline__ void phase_ln(KP& p, const bf16_t* rsrc, const float* g, const float* b, bool final_out) {
    int tid_ = threadIdx.x; asm volatile("" : "+v"(tid_));
    const int wid = tid_ >> 6, lane = tid_ & 63;
    for (int row = blockIdx.x * 8 + wid; row < T_ALL; row += gridDim.x * 8)
        ln_row(nullptr, rsrc + (size_t)row * DM, final_out ? p.out + (size_t)row * DM : nullptr, final_out ? nullptr : (bf16_t*)(p.ws + W_XB) + (size_t)row * DM, g, b, lane);
}

__device__ __forceinline__ void dt_scan(KP& p, int l, int u, int g, int wid, int lane, float& dt, float& ac, float& last) {
    const int h = g * 3 + wid;
    dt = ((const float*)(p.ws + W_DTB))[(size_t)(u * 64 + lane) * 8 + h];
    const float a = -__expf(p.in[14][l * 6 + h]);
    float v = dt * a;
#pragma unroll
    for (int o = 1; o < 64; o <<= 1) { const float t = __shfl_up(v, o); if (lane >= o) v += t; }
    ac = v; last = __shfl(v, 63);
}

__device__ __forceinline__ f32x4 xbc_row(KP& p, int l, int u, int s, int ch) {
    const bf16_t* proj = (const bf16_t*)(p.ws + W_PROJ);
    const bool isP = u < 512; const bool hasprev = isP && (u & 127) != 0;
    if (s >= 0 || hasprev) return unpack4(*(const u32x2*)(proj + (size_t)(u * 64 + s) * NPROJ + C_XBC + ch));
    if (!isP) return *(const f32x4*)(p.in[5] + (unsigned)(((l * 32 + (u - 512)) * 3 + (3 + s)) * 896 + ch));
    return (f32x4){0.f, 0.f, 0.f, 0.f};
}
__device__ __forceinline__ void ssd_states(KP& p, LAS unsigned char* lds, int l, int u) {
    int tid_ = threadIdx.x; asm volatile("" : "+v"(tid_));
    const int tid = tid_, wid = tid >> 6, lane = tid & 63, fr = lane & 15, fq = lane >> 4;
    LAS bf16_t* xT = (LAS bf16_t*)lds;
    LAS bf16_t* BT = (LAS bf16_t*)(lds + 55296);
    LAS float* wgt = (LAS float*)(lds + 92160);
    bf16_t* XC = (bf16_t*)p.out;
    __syncthreads();
    if (wid < 6) {
        float dt, ac, last; dt_scan(p, l, u, wid / 3, wid % 3, lane, dt, ac, last);
        wgt[wid * 64 + lane] = dt * __expf(last - ac);
        if (lane == 0) ((float*)(p.ws + W_CD))[u * 8 + wid] = __expf(last);
    }
    __syncthreads();
    if (tid < 448) {
        const int cgp = tid % 224, seg = tid / 224, ch = cgp * 4, r0 = seg * 32;
        const float* cw = p.in[11] + (size_t)l * 4 * 896 + ch;
        const f32x4 w0 = *(const f32x4*)cw, w1 = *(const f32x4*)(cw + 896), w2 = *(const f32x4*)(cw + 2 * 896), w3 = *(const f32x4*)(cw + 3 * 896);
        const f32x4 bs = *(const f32x4*)(p.in[12] + (size_t)l * 896 + ch);
        f32x4 xm3 = xbc_row(p, l, u, r0 - 3, ch), xm2 = xbc_row(p, l, u, r0 - 2, ch), xm1 = xbc_row(p, l, u, r0 - 1, ch);
        const bf16_t* src = (const bf16_t*)(p.ws + W_PROJ) + (size_t)(u * 64) * NPROJ + C_XBC + ch;
        bf16_t* dst = XC + (size_t)(u * 64) * 896 + ch;
        const int hh = ch >> 6;
#pragma unroll 2
        for (int i = r0; i < r0 + 32; i += 2) {
            const f32x4 xa = unpack4(*(const u32x2*)(src + (size_t)i * NPROJ)), xb = unpack4(*(const u32x2*)(src + (size_t)(i + 1) * NPROJ));
            f32x4 ya = bs + w0 * xm3 + w1 * xm2 + w2 * xm1 + w3 * xa, yb = bs + w0 * xm2 + w1 * xm1 + w2 * xa + w3 * xb;
#pragma unroll
            for (int e = 0; e < 4; ++e) { ya[e] = silu_f(ya[e]); yb[e] = silu_f(yb[e]); }
            xm3 = xm1; xm2 = xa; xm1 = xb;
            *(u32x2*)(dst + (size_t)i * 896) = pack4(ya); *(u32x2*)(dst + (size_t)(i + 1) * 896) = pack4(yb);
            if (ch < 384) { const float wa = wgt[hh * 64 + i], wb = wgt[hh * 64 + i + 1];
#pragma unroll
                for (int e = 0; e < 4; ++e) *(LAS unsigned*)(xT + (ch + e) * 72 + i) = cvt_pk_bf16(ya[e] * wa, yb[e] * wb); }
            else if (ch < 640) {
#pragma unroll
                for (int e = 0; e < 4; ++e) *(LAS unsigned*)(BT + (ch - 384 + e) * 72 + i) = cvt_pk_bf16(ya[e], yb[e]); }
        }
    }
    __syncthreads();
    bf16_t* ST = (bf16_t*)(p.ws + W_ST);
#pragma unroll 2
    for (int k = 0; k < 24; ++k) {
        const int tt = wid * 24 + k, h = tt >> 5, pt = (tt & 31) >> 3, nt = tt & 7, g = h / 3;
        f32x4 acc = (f32x4){0.f, 0.f, 0.f, 0.f};
#pragma unroll
        for (int ks = 0; ks < 2; ++ks) {
            const bf16x8 rf = ldsfrag((LAS const unsigned char*)(xT + (h * 64 + pt * 16 + fr) * 72 + ks * 32 + fq * 8));
            const bf16x8 cf = ldsfrag((LAS const unsigned char*)(BT + (g * 128 + nt * 16 + fr) * 72 + ks * 32 + fq * 8));
            acc = MFMA16(cf, rf, acc);
        }
        *(u32x2*)(ST + ((size_t)(u * 6 + h) * 64 + pt * 16 + fr) * 128 + nt * 16 + fq * 4) = pack4(acc);
    }
}

__device__ __forceinline__ void gmlp_unit(KP& p, LAS unsigned char* lds, int l, int u) {
    int tid_ = threadIdx.x; asm volatile("" : "+v"(tid_));
    const int tid = tid_, wid = tid >> 6, lane = tid & 63, fr = lane & 15, fq = lane >> 4;
    LAS bf16_t* vT = (LAS bf16_t*)lds;
    LAS float* ssq = (LAS float*)(lds + 69632);
    const bf16_t* proj = (const bf16_t*)(p.ws + W_PROJ);
    const int half = u < 512 ? (u & 1) : 0, KJ = (half + 1) * 64, R0 = u * 64, Rb = R0 - half * 64;
    __syncthreads();
    for (int idx = tid; idx < KJ * 32; idx += 512) {
        const int j = idx & (KJ - 1), cgp = idx / KJ;
        const u32x4 w = *(const u32x4*)(proj + (size_t)(Rb + j) * NPROJ + C_VC + cgp * 8);
        const unsigned ww[4] = {w.x, w.y, w.z, w.w};
#pragma unroll
        for (int e = 0; e < 4; ++e) { vT[(cgp * 8 + 2 * e) * 136 + j] = (bf16_t)(ww[e] & 0xffffu); vT[(cgp * 8 + 2 * e + 1) * 136 + j] = (bf16_t)(ww[e] >> 16); }
    }
    __syncthreads();
    const int rt = wid & 3, cbase = (wid >> 2) * 8;
    const bf16_t* GW = (const bf16_t*)(p.ws + W_GW + l * W_GW_L);
    f32x4 acc[8];
#pragma unroll
    for (int gi = 0; gi < 2; ++gi) {
        const int gg = (cbase >> 2) + gi;
        bf16x8 rf[4];
#pragma unroll
        for (int ks = 0; ks < 4; ++ks) rf[ks] = glbfrag(GW + ((size_t)gg * 128 + half * 64 + rt * 16 + fr) * 128 + ks * 32 + fq * 8);
#pragma unroll
        for (int c4 = 0; c4 < 4; ++c4) {
            const int ct = cbase + gi * 4 + c4;
            f32x4 a = (f32x4){0.f, 0.f, 0.f, 0.f};
#pragma unroll
            for (int ks = 0; ks < 4; ++ks) if (ks * 32 < KJ) a = MFMA16(ldsfrag((LAS const unsigned char*)(vT + (ct * 16 + fr) * 136 + ks * 32 + fq * 8)), rf[ks], a);
            acc[gi * 4 + c4] = a;
        }
    }
    const int row = R0 + rt * 16 + fr; float sq = 0.f;
#pragma unroll
    for (int k = 0; k < 8; ++k) {
        const int col = (cbase + k) * 16 + fq * 4, gg = col >> 6;
        const float bsv = p.in[17][(size_t)(l * 4 + gg) * 128 + half * 64 + rt * 16 + fr];
        const f32x4 uv = unpack4(*(const u32x2*)(proj + (size_t)row * NPROJ + C_U + col));
        f32x4 o = uv * (acc[k] + bsv); acc[k] = o;
        sq += (o[0] * o[0] + o[1] * o[1]) + (o[2] * o[2] + o[3] * o[3]);
    }
    sq += __shfl_xor(sq, 16); sq += __shfl_xor(sq, 32);
    if (fq == 0) ssq[(wid >> 2) * 64 + rt * 16 + fr] = sq;
    __syncthreads();
    const float rstd = 1.0f / sqrtf((ssq[rt * 16 + fr] + ssq[64 + rt * 16 + fr]) * (1.0f / 256.0f) + RMS_EPS);
    bf16_t* mix = (bf16_t*)(p.ws + W_MIX);
#pragma unroll
    for (int k = 0; k < 8; ++k) {
        const int col = (cbase + k) * 16 + fq * 4;
        const f32x4 gv = *(const f32x4*)(p.in[18] + (size_t)l * 1024 + 768 + col);
        *(u32x2*)(mix + (size_t)row * DM + 768 + col) = pack4(acc[k] * rstd * gv);
    }
}

__device__ __forceinline__ void scan_prompt(KP& p, int l, int item) {
    int tid_ = threadIdx.x; asm volatile("" : "+v"(tid_));
    const int gid = item * 512 + tid_, e = (gid & 2047) * 4, bh = gid >> 11, b = bh / 6, h = bh % 6;
    bf16_t* ST = (bf16_t*)(p.ws + W_ST); const float* CD = (const float*)(p.ws + W_CD);
    f32x4 st = (f32x4){0.f, 0.f, 0.f, 0.f};
#pragma unroll 1
    for (int c0 = 0; c0 < 128; c0 += 16) {
        u32x2 s[16]; float cd[16];
#pragma unroll
        for (int k = 0; k < 16; ++k) { const int u = b * 128 + c0 + k; s[k] = *(const u32x2*)(ST + ((size_t)(u * 6 + h)) * 8192 + e); cd[k] = CD[u * 8 + h]; }
#pragma unroll
        for (int k = 0; k < 16; ++k) { const int u = b * 128 + c0 + k; *(u32x2*)(ST + ((size_t)(u * 6 + h)) * 8192 + e) = pack4(st); st = st * cd[k] + unpack4(s[k]); }
    }
    *(f32x4*)(p.out + O_PH + ((size_t)(l * 4 + b) * 6 + h) * 8192 + e) = st;
}
__device__ __forceinline__ void scan_sample(KP& p, int l, int item) {
    int tid_ = threadIdx.x; asm volatile("" : "+v"(tid_));
    const int gid = item * 512 + tid_, e = (gid & 2047) * 4, sbh = gid >> 11, sb = sbh / 6, h = sbh % 6;
    bf16_t* ST = (bf16_t*)(p.ws + W_ST); const float* CD = (const float*)(p.ws + W_CD);
    const int u = 512 + sb;
    const f32x4 st = *(const f32x4*)(p.in[4] + ((size_t)(l * 32 + sb) * 6 + h) * 8192 + e);
    const f32x4 s = unpack4(*(const u32x2*)(ST + ((size_t)(u * 6 + h)) * 8192 + e));
    *(u32x2*)(ST + ((size_t)(u * 6 + h)) * 8192 + e) = pack4(st);
    *(f32x4*)(p.out + O_SH + ((size_t)(l * 32 + sb) * 6 + h) * 8192 + e) = st * CD[u * 8 + h] + s;
}

__device__ __forceinline__ void attn_unit(KP& p, LAS unsigned char* lds, int l, int u) {
    int tid_ = threadIdx.x; asm volatile("" : "+v"(tid_));
    const int tid = tid_, wid = tid >> 6, lane = tid & 63, fr = lane & 15, fq = lane >> 4;
    LAS bf16_t* VT = (LAS bf16_t*)(lds + 98304);
    LAS float* bias = (LAS float*)(lds + 153600);
    LAS float* ssq = (LAS float*)(lds + 158208);
    const bf16_t* proj = (const bf16_t*)(p.ws + W_PROJ);
    const bool isP = u < 512; const int R0 = u * 64, c = u & 127, b = u >> 7, sb = u - 512;
    const int qt = wid & 3, hbase = (wid >> 2) * 3;
    __syncthreads();
    for (int i = tid; i < 1152; i += 512) bias[i] = p.in[10][(size_t)l * 1152 + i];
    bf16x8 qf[3][2];
#pragma unroll
    for (int hh = 0; hh < 3; ++hh)
#pragma unroll
        for (int ks = 0; ks < 2; ++ks) qf[hh][ks] = glbfrag(proj + (size_t)(R0 + qt * 16 + fr) * NPROJ + (hbase + hh) * 64 + ks * 32 + fq * 8);
    float mrun[3], lrun[3]; f32x4 O[3][4];
#pragma unroll
    for (int hh = 0; hh < 3; ++hh) { mrun[hh] = -1e30f; lrun[hh] = 0.f;
#pragma unroll
        for (int d = 0; d < 4; ++d) O[hh][d] = (f32x4){0.f, 0.f, 0.f, 0.f}; }
    const int blk_lo = isP ? (c < 8 ? 8 - c : 0) : 0;
    u32x4 vr[6];
    const int vkp = tid & 31, vcg0 = tid >> 5;
#define ATT_LOADP(blkv, bufv) do { const size_t rb_ = isP ? (size_t)b * 8192 + (size_t)(c - 8 + (blkv)) * 64 : (size_t)T_P + (size_t)sb * 64; \
        _Pragma("unroll") for (int it = 0; it < 6; ++it) { const int pu_ = it * 512 + tid, row_ = pu_ / 48, un_ = (pu_ % 48) ^ (row_ & 15); \
            __builtin_amdgcn_global_load_lds((const unsigned*)(proj + (rb_ + row_) * NPROJ + C_K + un_ * 8), (LAS unsigned*)(lds + (bufv) * 49152 + (it * 512 + wid * 64) * 16), 16, 0, 0); } \
        _Pragma("unroll") for (int it = 0; it < 2; ++it) { const int cg_ = vcg0 + it * 16; \
            vr[2 * it] = *(const u32x4*)(proj + (rb_ + 2 * vkp) * NPROJ + C_V + cg_ * 8); vr[2 * it + 1] = *(const u32x4*)(proj + (rb_ + 2 * vkp + 1) * NPROJ + C_V + cg_ * 8); } } while (0)
    bool have = false; int cur = 0;
    if (isP || blk_lo == 8) { ATT_LOADP(blk_lo, 0); have = true; }
#pragma unroll 1
    for (int blk = blk_lo; blk <= 8; ++blk) {
        LAS unsigned char* Kc = lds + cur * 49152;
        __syncthreads();
        if (!have) {
#pragma unroll
            for (int it = 0; it < 6; ++it) { const int idx = it * 512 + tid, row_ = idx / 48, un_ = idx % 48;
                const float* s = p.in[2] + ((size_t)(l * 32 + sb) * 512 + blk * 64 + row_) * 384 + un_ * 8; const f32x4 a = *(const f32x4*)s, bq = *(const f32x4*)(s + 4);
                u32x4 w; w.x = cvt_pk_bf16(a[0], a[1]); w.y = cvt_pk_bf16(a[2], a[3]); w.z = cvt_pk_bf16(bq[0], bq[1]); w.w = cvt_pk_bf16(bq[2], bq[3]);
                *(LAS u32x4*)(Kc + row_ * 768 + ((un_ ^ (row_ & 15)) * 16)) = w; }
#pragma unroll
            for (int it = 0; it < 6; ++it) { const int cg_ = vcg0 + (it >> 1) * 16;
                const float* s = p.in[3] + ((size_t)(l * 32 + sb) * 512 + blk * 64 + 2 * vkp + (it & 1)) * 384 + cg_ * 8; const f32x4 a = *(const f32x4*)s, bq = *(const f32x4*)(s + 4);
                vr[it].x = cvt_pk_bf16(a[0], a[1]); vr[it].y = cvt_pk_bf16(a[2], a[3]); vr[it].z = cvt_pk_bf16(bq[0], bq[1]); vr[it].w = cvt_pk_bf16(bq[2], bq[3]); }
        }
        if (have) { const size_t rb_ = isP ? (size_t)b * 8192 + (size_t)(c - 8 + blk) * 64 : (size_t)T_P + (size_t)sb * 64; const int cg_ = vcg0 + 2 * 16;
            vr[4] = *(const u32x4*)(proj + (rb_ + 2 * vkp) * NPROJ + C_V + cg_ * 8); vr[5] = *(const u32x4*)(proj + (rb_ + 2 * vkp + 1) * NPROJ + C_V + cg_ * 8); }
#pragma unroll
        for (int it = 0; it < 3; ++it) { const int cg_ = vcg0 + it * 16; const u32x4 w0 = vr[2 * it], w1 = vr[2 * it + 1];
            const unsigned a0[4] = {w0.x, w0.y, w0.z, w0.w}, a1[4] = {w1.x, w1.y, w1.z, w1.w};
#pragma unroll
            for (int e = 0; e < 4; ++e) {
                *(LAS unsigned*)(VT + (cg_ * 8 + 2 * e) * 72 + 2 * vkp) = (a0[e] & 0xffffu) | (a1[e] << 16);
                *(LAS unsigned*)(VT + (cg_ * 8 + 2 * e + 1) * 72 + 2 * vkp) = (a0[e] >> 16) | (a1[e] & 0xffff0000u); } }
        asm volatile("s_waitcnt vmcnt(0)" ::: "memory");
        __syncthreads();
        have = false;
        if (blk < 8 && (isP || blk == 7)) { ATT_LOADP(blk + 1, cur ^ 1); have = true; }
#pragma unroll
        for (int hh = 0; hh < 3; ++hh) {
            const int h = hbase + hh;
            f32x4 s[4]; float mx = -1e30f;
#pragma unroll
            for (int kt = 0; kt < 4; ++kt) {
                f32x4 a = (f32x4){0.f, 0.f, 0.f, 0.f};
#pragma unroll
                for (int ks = 0; ks < 2; ++ks) a = MFMA16(ldsfrag((LAS const unsigned char*)(Kc + (kt * 16 + fr) * 768 + (((h * 8 + ks * 4 + fq) ^ fr) * 16))), qf[hh][ks], a);
                if (blk <= 5) { const float bc = bias[h * 192 + 191];
#pragma unroll
                    for (int j = 0; j < 4; ++j) { a[j] = a[j] * 0.125f + bc; mx = fmaxf(mx, a[j]); } }
                else {
#pragma unroll
                    for (int j = 0; j < 4; ++j) {
                        int rel = (qt * 16 + fr) + 512 - (blk * 64 + kt * 16 + fq * 4 + j); rel = rel > 128 ? 128 : rel;
                        a[j] = a[j] * 0.125f + bias[h * 192 + rel + 63]; mx = fmaxf(mx, a[j]);
                    } }
                s[kt] = a;
            }
            mx = fmaxf(mx, __shfl_xor(mx, 16)); mx = fmaxf(mx, __shfl_xor(mx, 32));
            const float mnew = fmaxf(mrun[hh], mx), fac = __expf(mrun[hh] - mnew); mrun[hh] = mnew;
            float rs = 0.f;
#pragma unroll
            for (int kt = 0; kt < 4; ++kt)
#pragma unroll
                for (int j = 0; j < 4; ++j) { s[kt][j] = __expf(s[kt][j] - mnew); rs += s[kt][j]; }
            lrun[hh] = lrun[hh] * fac + rs;
#pragma unroll
            for (int d = 0; d < 4; ++d) O[hh][d] *= fac;
#pragma unroll
            for (int ks = 0; ks < 2; ++ks) {
                const u32x2 pa = pack4(s[2 * ks]), pb = pack4(s[2 * ks + 1]);
                const bf16x8 pf = __builtin_bit_cast(bf16x8, (u32x4){pa.x, pa.y, pb.x, pb.y});
#pragma unroll
                for (int d = 0; d < 4; ++d) {
                    const LAS bf16_t* vrow = VT + (h * 64 + d * 16 + fr) * 72 + ks * 32 + fq * 4;
                    const u32x2 va = *(const LAS u32x2*)vrow, vb = *(const LAS u32x2*)(vrow + 16);
                    O[hh][d] = MFMA16(__builtin_bit_cast(bf16x8, (u32x4){va.x, va.y, vb.x, vb.y}), pf, O[hh][d]);
                }
            }
        }
        cur ^= 1;
    }
#pragma unroll
    for (int hh = 0; hh < 3; ++hh) { lrun[hh] += __shfl_xor(lrun[hh], 16); lrun[hh] += __shfl_xor(lrun[hh], 32); }
    float sq = 0.f;
#pragma unroll
    for (int hh = 0; hh < 3; ++hh) { const float inv = 1.0f / lrun[hh];
#pragma unroll
        for (int d = 0; d < 4; ++d) { O[hh][d] *= inv; const f32x4 o = O[hh][d]; sq += (o[0] * o[0] + o[1] * o[1]) + (o[2] * o[2] + o[3] * o[3]); } }
    sq += __shfl_xor(sq, 16); sq += __shfl_xor(sq, 32);
    if (fq == 0) ssq[(wid >> 2) * 64 + qt * 16 + fr] = sq;
    __syncthreads();
    const float rstd = 1.0f / sqrtf((ssq[qt * 16 + fr] + ssq[64 + qt * 16 + fr]) * (1.0f / 384.0f) + RMS_EPS);
    bf16_t* mix = (bf16_t*)(p.ws + W_MIX);
#pragma unroll
    for (int hh = 0; hh < 3; ++hh)
#pragma unroll
        for (int d = 0; d < 4; ++d) {
            const int col = (hbase + hh) * 64 + d * 16 + fq * 4;
            const f32x4 gv = *(const f32x4*)(p.in[18] + (size_t)l * 1024 + col);
            *(u32x2*)(mix + (size_t)(R0 + qt * 16 + fr) * DM + col) = pack4(O[hh][d] * rstd * gv);
        }
}

__device__ __forceinline__ void ssd_y(KP& p, LAS unsigned char* lds, int l, int u) {
    int tid_ = threadIdx.x; asm volatile("" : "+v"(tid_));
    const int tid = tid_, wid = tid >> 6, lane = tid & 63, fr = lane & 15, fq = lane >> 4;
    LAS bf16_t* Cn = (LAS bf16_t*)lds;
    LAS bf16_t* Bn = (LAS bf16_t*)(lds + 17408);
    LAS bf16_t* xT = (LAS bf16_t*)(lds + 34816);
    LAS bf16_t* Mm = (LAS bf16_t*)(lds + 62464);
    LAS float* dtl = (LAS float*)(lds + 90112);
    LAS float* acl = (LAS float*)(lds + 90880);
    LAS float* ssq = (LAS float*)(lds + 91648);
    LAS bf16_t* HPl = (LAS bf16_t*)(lds + 92160);
    const bf16_t* proj = (const bf16_t*)(p.ws + W_PROJ);
    const bf16_t* HP = (const bf16_t*)(p.ws + W_ST);
    const bf16_t* XC = (const bf16_t*)p.out + (size_t)(u * 64) * 896;
    const int R0 = u * 64, lt = wid & 3;
    f32x4 yacc[2][6];
#pragma unroll
    for (int g = 0; g < 2; ++g) {
        __syncthreads();
        if (wid < 3) { float dt, ac, last; dt_scan(p, l, u, g, wid, lane, dt, ac, last); dtl[wid * 64 + lane] = dt; acl[wid * 64 + lane] = ac; }
#pragma unroll
        for (int it = 0; it < 4; ++it) {
            const int idx = it * 512 + tid, mat = idx >> 10, i = (idx >> 4) & 63, c8 = idx & 15;
            const u32x4 w = *(const u32x4*)(XC + (size_t)i * 896 + 384 + mat * 256 + g * 128 + c8 * 8);
            *(LAS u32x4*)((mat ? Cn : Bn) + i * 136 + c8 * 8) = w;
        }
#pragma unroll
        for (int it = 0; it < 6; ++it) {
            const int idx = it * 512 + tid, r_ = idx >> 4, c8 = idx & 15;
            *(LAS u32x4*)(HPl + r_ * 136 + c8 * 8) = *(const u32x4*)(HP + ((size_t)(u * 6 + g * 3) * 64 + r_) * 128 + c8 * 8);
        }
#pragma unroll
        for (int it = 0; it < 3; ++it) {
            const int idx = it * 512 + tid, c4 = idx % 48, i = (idx / 48) * 2;
            const u32x2 wa = *(const u32x2*)(XC + (size_t)i * 896 + g * 192 + c4 * 4), wb = *(const u32x2*)(XC + (size_t)(i + 1) * 896 + g * 192 + c4 * 4);
            *(LAS unsigned*)(xT + (c4 * 4 + 0) * 72 + i) = (wa.x & 0xffffu) | (wb.x << 16);
            *(LAS unsigned*)(xT + (c4 * 4 + 1) * 72 + i) = (wa.x >> 16) | (wb.x & 0xffff0000u);
            *(LAS unsigned*)(xT + (c4 * 4 + 2) * 72 + i) = (wa.y & 0xffffu) | (wb.y << 16);
            *(LAS unsigned*)(xT + (c4 * 4 + 3) * 72 + i) = (wa.y >> 16) | (wb.y & 0xffff0000u);
        }
        __syncthreads();
#pragma unroll
        for (int k = 0; k < 2; ++k) {
            const int st = (wid >> 2) * 2 + k;
            f32x4 a = (f32x4){0.f, 0.f, 0.f, 0.f};
#pragma unroll
            for (int ks = 0; ks < 4; ++ks) a = MFMA16(ldsfrag((LAS const unsigned char*)(Bn + (st * 16 + fr) * 136 + ks * 32 + fq * 8)), ldsfrag((LAS const unsigned char*)(Cn + (lt * 16 + fr) * 136 + ks * 32 + fq * 8)), a);
            const int li = lt * 16 + fr;
#pragma unroll
            for (int hh = 0; hh < 3; ++hh) {
                const float al = acl[hh * 64 + li]; f32x4 mv;
#pragma unroll
                for (int j = 0; j < 4; ++j) { const int si = st * 16 + fq * 4 + j; mv[j] = si <= li ? a[j] * __expf(al - acl[hh * 64 + si]) * dtl[hh * 64 + si] : 0.f; }
                *(LAS u32x2*)(Mm + (hh * 64 + li) * 72 + st * 16 + fq * 4) = pack4(mv);
            }
        }
        __syncthreads();
#pragma unroll
        for (int k = 0; k < 6; ++k) {
            const int ctile = (wid >> 2) * 6 + k, hh = ctile >> 2, pt = ctile & 3, h = g * 3 + hh, li = lt * 16 + fr;
            f32x4 ad = (f32x4){0.f, 0.f, 0.f, 0.f}, ao = (f32x4){0.f, 0.f, 0.f, 0.f};
#pragma unroll
            for (int ks = 0; ks < 2; ++ks) ad = MFMA16(ldsfrag((LAS const unsigned char*)(xT + (hh * 64 + pt * 16 + fr) * 72 + ks * 32 + fq * 8)), ldsfrag((LAS const unsigned char*)(Mm + (hh * 64 + li) * 72 + ks * 32 + fq * 8)), ad);
#pragma unroll
            for (int ks = 0; ks < 4; ++ks) ao = MFMA16(ldsfrag((LAS const unsigned char*)(HPl + (hh * 64 + pt * 16 + fr) * 136 + ks * 32 + fq * 8)), ldsfrag((LAS const unsigned char*)(Cn + li * 136 + ks * 32 + fq * 8)), ao);
            const float ea = __expf(acl[hh * 64 + li]), dsk = p.in[15][l * 6 + h];
            const f32x4 xv = unpack4(*(const u32x2*)(XC + (size_t)li * 896 + h * 64 + pt * 16 + fq * 4));
            const f32x4 zv = unpack4(*(const u32x2*)(proj + (size_t)(R0 + li) * NPROJ + C_Z + h * 64 + pt * 16 + fq * 4));
            f32x4 y = ad + ao * ea + xv * dsk;
#pragma unroll
            for (int j = 0; j < 4; ++j) y[j] *= silu_f(zv[j]);
            yacc[g][k] = y;
            asm volatile("" ::: "memory");
        }
    }
    float sq = 0.f;
#pragma unroll
    for (int g = 0; g < 2; ++g)
#pragma unroll
        for (int k = 0; k < 6; ++k) { const f32x4 o = yacc[g][k]; sq += (o[0] * o[0] + o[1] * o[1]) + (o[2] * o[2] + o[3] * o[3]); }
    sq += __shfl_xor(sq, 16); sq += __shfl_xor(sq, 32);
    if (fq == 0) ssq[(wid >> 2) * 64 + lt * 16 + fr] = sq;
    __syncthreads();
    const float rstd = 1.0f / sqrtf((ssq[lt * 16 + fr] + ssq[64 + lt * 16 + fr]) * (1.0f / 384.0f) + RMS_EPS);
    bf16_t* mix = (bf16_t*)(p.ws + W_MIX);
#pragma unroll
    for (int g = 0; g < 2; ++g)
#pragma unroll
        for (int k = 0; k < 6; ++k) {
            const int col = 384 + g * 192 + ((wid >> 2) * 6 + k) * 16 + fq * 4;
            const f32x4 gv = *(const f32x4*)(p.in[18] + (size_t)l * 1024 + col);
            *(u32x2*)(mix + (size_t)(R0 + lt * 16 + fr) * DM + col) = pack4(yacc[g][k] * rstd * gv);
        }
}

__device__ __forceinline__ void phase_fix(KP& p, int l) {
    const float* halo = (const float*)(p.ws + W_MIX); bf16_t* H = (bf16_t*)(p.ws + W_PROJ);
    const float* w = p.in[23] + (size_t)l * 3 * DFF2; const float* bb = p.in[24] + (size_t)l * DFF2;
    int tid_ = threadIdx.x; asm volatile("" : "+v"(tid_));
    for (int i = blockIdx.x * 512 + tid_; i < 128 * DFF2; i += gridDim.x * 512) {
        const int pm = i / DFF2, cc = i % DFF2;
        if ((pm & 31) == 0 || cc >= DFF) continue;
        const float* h0 = halo + (size_t)(pm - 1) * 4 * DFF2; const float* h1 = halo + (size_t)pm * 4 * DFF2;
        float r[2];
#pragma unroll
        for (int rr = 0; rr < 2; ++rr) {
            float o[2];
#pragma unroll
            for (int gv = 0; gv < 2; ++gv) {
                const int c2 = cc + gv * DFF;
                const float xm2 = h0[2 * DFF2 + c2], xm1 = h0[3 * DFF2 + c2], x0 = h1[c2], x1 = h1[DFF2 + c2];
                o[gv] = rr == 0 ? bb[c2] + w[c2] * xm2 + w[DFF2 + c2] * xm1 + w[2 * DFF2 + c2] * x0 : bb[c2] + w[c2] * xm1 + w[DFF2 + c2] * x0 + w[2 * DFF2 + c2] * x1;
            }
            r[rr] = silu_f(o[0]) * o[1];
        }
        H[((size_t)pm * 256) * DFF + cc] = (bf16_t)(cvt_pk_bf16(r[0], 0.f) & 0xffffu);
        H[((size_t)pm * 256 + 1) * DFF + cc] = (bf16_t)(cvt_pk_bf16(r[1], 0.f) & 0xffffu);
    }
}

#define XB_TMO      128
#define XB_XCNT(j)  (256  + 64 * (j))
#define XB_XSUB(j)  (1280 + 64 * (j))
#define XB_XGEN(j)  (2304 + 64 * (j))
#define XB_TOP      3328
#define XB_TOPGEN   3392
#define XCD_BAR_WORDS 3456
#define XB_SPIN_CAP (1u << 18)

__device__ __forceinline__ unsigned xb_ld(unsigned* p)              { return __hip_atomic_load(p, __ATOMIC_RELAXED, __HIP_MEMORY_SCOPE_AGENT); }
__device__ __forceinline__ unsigned xb_add(unsigned* p, unsigned v) { return __hip_atomic_fetch_add(p, v, __ATOMIC_RELAXED, __HIP_MEMORY_SCOPE_AGENT); }
__device__ __forceinline__ unsigned xb_xcc_id() { return (unsigned)__builtin_amdgcn_s_getreg((3 << 11) | 20) & 0xFu; }
#define XB_SPIN(cond, bar) do { unsigned _sp = 0; while (cond) { __builtin_amdgcn_s_sleep(1); \
    if ((++_sp & 255u) == 0u) { if (xb_ld(&(bar)[XB_TMO])) break; if (_sp > XB_SPIN_CAP) { atomicAdd(&(bar)[XB_TMO], 1u); break; } } } } while (0)

struct XcdBarrier {
    unsigned* bar; unsigned x;
    volatile LAS unsigned* st;
};

__device__ __forceinline__ XcdBarrier xcd_barrier_post(unsigned* bar, volatile LAS unsigned* st) {
    XcdBarrier b; b.bar = bar; b.x = xb_xcc_id(); b.st = st;
    if (threadIdx.x == 0) (void)xb_add(&bar[XB_XCNT(b.x)], 1u);
    return b;
}
__device__ __forceinline__ void xcd_barrier_complete(unsigned* bar, unsigned x, unsigned& nloc, unsigned& nx) {
    const unsigned G = gridDim.x * gridDim.y * gridDim.z;
    unsigned sum, cnt, mine, sp = 0u;
    for (;;) {
        sum = 0u; cnt = 0u; mine = 0u;
#pragma unroll
        for (unsigned j = 0; j < 16; ++j) { const unsigned c = xb_ld(&bar[XB_XCNT(j)]); sum += c; cnt += (c > 0u) ? 1u : 0u; mine = (j == x) ? c : mine; }
        if (sum == G) break;
        __builtin_amdgcn_s_sleep(1);
        if ((++sp & 255u) == 0u) { if (xb_ld(&bar[XB_TMO])) break; if (sp > XB_SPIN_CAP) { atomicAdd(&bar[XB_TMO], 1u); break; } }
    }
    nloc = mine > 0u ? mine : 1u; nx = cnt > 0u ? cnt : 1u;
}

__device__ __forceinline__ void xcd_barrier(const XcdBarrier& b) {
    asm volatile("s_waitcnt vmcnt(0)" ::: "memory");
    __syncthreads();
    if (threadIdx.x == 0) {
        unsigned* bar = b.bar;
        __builtin_amdgcn_s_waitcnt(0);
        unsigned nloc = b.st[0], nx = b.st[1];
        if (nloc == 0u) { xcd_barrier_complete(bar, b.x, nloc, nx); b.st[0] = nloc; b.st[1] = nx; }
        const unsigned old = xb_add(&bar[XB_XSUB(b.x)], 1u);
        const unsigned gen = old / nloc;
        if (old + 1u == (gen + 1u) * nloc) {
            __builtin_amdgcn_fence(__ATOMIC_RELEASE, "agent");
            asm volatile("s_waitcnt vmcnt(0)" ::: "memory");
            const unsigned og = xb_add(&bar[XB_TOP], 1u);
            const unsigned tg = og / nx;
            if (og + 1u == (tg + 1u) * nx) xb_add(&bar[XB_TOPGEN], 1u);
            else XB_SPIN(xb_ld(&bar[XB_TOPGEN]) == tg, bar);
            __builtin_amdgcn_fence(__ATOMIC_ACQUIRE, "agent");
            xb_add(&bar[XB_XGEN(b.x)], 1u);
            asm volatile("s_waitcnt vmcnt(0)" ::: "memory");
        } else {
            XB_SPIN(xb_ld(&bar[XB_XGEN(b.x)]) == gen, bar);
            __builtin_amdgcn_fence(__ATOMIC_ACQUIRE, "agent");
            asm volatile("s_waitcnt vmcnt(0)" ::: "memory");
        }
    }
    __syncthreads();
}

__global__ void __launch_bounds__(512, 2) mega(Params pa) {
    extern __shared__ __attribute__((aligned(16))) unsigned char shm[];
    LAS unsigned char* lds = (LAS unsigned char*)shm;
    const int G = gridDim.x, bid = blockIdx.x;
    KP* pk = (KP*)__builtin_amdgcn_kernarg_segment_ptr();
    volatile LAS unsigned* bst = (volatile LAS unsigned*)(lds + LDS_BYTES - 16);
    XcdBarrier xb; xb.bar = nullptr; xb.x = 0; xb.st = bst;
    if (pa.coop) { if (threadIdx.x < 2) bst[threadIdx.x] = 0u; __syncthreads(); xb = xcd_barrier_post((unsigned*)(pa.ws + W_BAR), bst); }
    for (int ph = pa.ph_lo; ph < pa.ph_hi; ++ph) {
        if (ph > pa.ph_lo && pa.coop) { if (pa.pad == 0x5a5a) { __threadfence(); cg::this_grid().sync(); } else xcd_barrier(xb); }
        asm volatile("" : "+s"(pk)); KP& p = *pk;
        if (ph == 0) { phase_prep(p, lds); continue; }
        if (ph == 42) { int tq = threadIdx.x; asm volatile("" : "+v"(tq)); const unsigned short* w16 = (const unsigned short*)p.ws; for (size_t i = (size_t)bid * 512 + tq; i < (size_t)59418624; i += (size_t)G * 512) p.out[i] = (float)w16[i * 4]; continue; }
        if (ph == 41) { int tq = threadIdx.x; asm volatile("" : "+v"(tq)); for (size_t i = (size_t)bid * 512 + tq; i < (size_t)59418624; i += (size_t)G * 512) { const float v = p.out[i]; if (!(fabsf(v) < 1e30f)) p.out[i] = 0.f; } continue; }
        const int l = (ph - 1) / 10, k = (ph - 1) % 10;
        bf16_t* XB = (bf16_t*)(p.ws + W_XB);
        switch (k) {
        case 0: if (REP_G1 > 1) { pg8::StaticOrder S; S.init(T_ALL, NPROJ, G, bid); EpiNull E{(float*)(p.ws + W_CD)};
                  pg8::gemm_phase(lds, pg8::Gemm{XB, (const bf16_t*)(p.ws + W_IN + l * W_IN_L), T_ALL, NPROJ, DM}, S, E); }
                { if ((bid >> 3) & 1) { __builtin_amdgcn_s_sleep(127); __builtin_amdgcn_s_sleep(127); __builtin_amdgcn_s_sleep(127); }
                  pg8::StaticOrder S; S.init(T_ALL, NPROJ, G, bid);
                  EpiIn E{(bf16_t*)(p.ws + W_PROJ), p.out, (float*)(p.ws + W_DTB), p.in[13], l};
                  pg8::gemm_phase(lds, pg8::Gemm{XB, (const bf16_t*)(p.ws + W_IN + l * W_IN_L), T_ALL, NPROJ, DM}, S, E); } break;
        case 1: {
                  unsigned* qctr = (unsigned*)(p.ws + W_BAR + 14336) + l * 64;
                  volatile LAS int* qslot = (volatile LAS int*)(lds + LDS_BYTES - 32);
                  for (;;) {
                      __syncthreads();
                      if (threadIdx.x == 0) qslot[0] = (int)__hip_atomic_fetch_add(qctr, 1u, __ATOMIC_RELAXED, __HIP_MEMORY_SCOPE_AGENT);
                      __syncthreads();
                      const int it = qslot[0];
                      if (it >= 2 * NU64) break;
                      if (it < NU64) attn_unit(p, lds, l, NU64 - 1 - it); else ssd_states(p, lds, l, it - NU64);
                  } } break;
        case 2: for (int it = bid; it < 96 + 768; it += G) { if (it < 96) scan_prompt(p, l, it); else scan_sample(p, l, it - 96); } break;
        case 3: {
                  unsigned* qctr = (unsigned*)(p.ws + W_BAR + 14336) + l * 64 + 32;
                  volatile LAS int* qslot = (volatile LAS int*)(lds + LDS_BYTES - 32);
                  for (;;) {
                      __syncthreads();
                      if (threadIdx.x == 0) qslot[0] = (int)__hip_atomic_fetch_add(qctr, 1u, __ATOMIC_RELAXED, __HIP_MEMORY_SCOPE_AGENT);
                      __syncthreads();
                      const int it = qslot[0];
                      if (it >= 2 * NU64) break;
                      if (it < NU64) ssd_y(p, lds, l, it); else gmlp_unit(p, lds, l, it - NU64);
                  } } break;
        case 4: { pg8::StaticOrder S; S.init(T_ALL, DM, G, bid); EpiRes E{p.out, XB, (bf16_t*)p.out};
                  pg8::gemm_phase(lds, pg8::Gemm{(const bf16_t*)(p.ws + W_MIX), (const bf16_t*)(p.ws + W_OUT + l * W_OUT_L), T_ALL, DM, DM}, S, E); } break;
        case 5: phase_ln(p, (const bf16_t*)p.out, p.in[20] + l * DM, p.in[21] + l * DM, false); break;
        case 6: for (int rep = 0; rep < REP_G3; ++rep) { pg8::StaticOrder S; S.init(T_ALL, DFF2, G, bid);
                  EpiUp E{(bf16_t*)(p.ws + W_PROJ), (float*)(p.ws + W_MIX), p.out, p.in[23], p.in[24], p.in[6], l};
                  pg8::OneUnit o1;
                  for (int i = 0; S.next(i, o1.u); ++i) { pg8::gemm_phase(lds, pg8::Gemm{XB, (const bf16_t*)(p.ws + W_UP + l * W_UP_L), T_ALL, DFF2, DM}, o1, E); __syncthreads(); } } break;
        case 7: phase_fix(p, l); break;
        case 8: { pg8::StaticOrder S; S.init(T_ALL, DM, G, bid); EpiRes E{p.out, XB, (bf16_t*)(p.ws + W_MIX)};
                  pg8::gemm_phase(lds, pg8::Gemm{(const bf16_t*)(p.ws + W_PROJ), (const bf16_t*)(p.ws + W_DN + l * W_DN_L), T_ALL, DM, DFF}, S, E); } break;
        case 9: phase_ln(p, (const bf16_t*)(p.ws + W_MIX), p.in[26] + l * DM, p.in[27] + l * DM, l == DEPTH - 1); break;
        }
    }
}

constexpr int N_PHASES = 41;
#ifndef MULTI_LAUNCH
#define MULTI_LAUNCH 0
#endif

extern "C" void kernel_launch(void* const* d_in, const int* in_sizes, int n_in, void* d_out, int out_size, void* d_ws, size_t ws_size, hipStream_t stream) {
    static int grid = 0;
    if (grid == 0) {
        if (n_in != 28 || ws_size < W_END2) { fprintf(stderr, "kernel_launch: need 28 inputs and %zu bytes of workspace (got %d, %zu)\n", (size_t)W_END2, n_in, ws_size); grid = -1; return; }
        int dev = 0, cus = 0, per_cu = 0;
        hipGetDevice(&dev); hipDeviceGetAttribute(&cus, hipDeviceAttributeMultiprocessorCount, dev);
        if (hipFuncSetAttribute((const void*)mega, hipFuncAttributeMaxDynamicSharedMemorySize, LDS_BYTES) != hipSuccess) { fprintf(stderr, "kernel_launch: hipFuncSetAttribute failed\n"); grid = -1; return; }
        hipOccupancyMaxActiveBlocksPerMultiprocessor(&per_cu, (const void*)mega, 512, LDS_BYTES);
        (void)hipGetLastError();
        if (per_cu < 1) per_cu = 1;
        grid = cus * 1;
    }
    if (grid < 0) return;
    Params p{};
    for (int i = 0; i < 28; ++i) p.in[i] = (const float*)d_in[i];
    p.out = (float*)d_out; p.ws = (unsigned char*)d_ws;
#if MULTI_LAUNCH
#ifdef PROBE_CUT
    for (int ph = 0; ph < PROBE_CUT; ++ph) { p.ph_lo = ph; p.ph_hi = ph + 1; p.coop = 0; hipLaunchKernelGGL(mega, dim3(grid), dim3(512), LDS_BYTES, stream, p); }
    p.ph_lo = 42; p.ph_hi = 43; p.coop = 0; hipLaunchKernelGGL(mega, dim3(grid), dim3(512), LDS_BYTES, stream, p);
#else
    for (int ph = 0; ph < N_PHASES; ++ph) { p.ph_lo = ph; p.ph_hi = ph + 1; p.coop = 0; hipLaunchKernelGGL(mega, dim3(grid), dim3(512), LDS_BYTES, stream, p); }
#endif
#else
    p.ph_lo = 0; p.ph_hi = N_PHASES; p.coop = 1;
    if (hipMemsetAsync((char*)d_ws + W_BAR, 0, 16384, stream) != hipSuccess) { fprintf(stderr, "kernel_launch: memset failed\n"); return; }
    void* args[] = {&p};
    hipError_t e = hipLaunchCooperativeKernel((const void*)mega, dim3(grid), dim3(512), args, LDS_BYTES, stream);
    if (e != hipSuccess) fprintf(stderr, "cooperative launch failed: %s (grid %d)\n", hipGetErrorString(e), grid);
#endif
}
```

```cpp
#define REP_G1 1
#define REP_M1 1
#define REP_ATT 1
#define REP_M3 1
#define REP_G3 1
#include <hip/hip_runtime.h>
#include <hip/hip_cooperative_groups.h>
#include <cstdio>
namespace cg = cooperative_groups;

#define LAS __attribute__((address_space(3)))
typedef unsigned short bf16_t;
typedef short bf16x8 __attribute__((ext_vector_type(8)));
typedef float f32x4 __attribute__((ext_vector_type(4)));
typedef float f32x2 __attribute__((ext_vector_type(2)));
typedef unsigned u32x4 __attribute__((ext_vector_type(4)));
typedef unsigned u32x2 __attribute__((ext_vector_type(2)));

constexpr int T_ALL = 34816, T_P = 32768, DM = 1024, NPROJ = 3072, DFF = 2816, DFF2 = 5632, DEPTH = 4;
constexpr int NU64 = 544;
constexpr float ALPHA = 1.6817928305074290f;
constexpr float LN_EPS = 1e-5f, RMS_EPS = 1e-5f;
constexpr int C_K = 384, C_V = 768, C_Z = 1152, C_XBC = 1536, C_U = 2432, C_VC = 2688, C_DT = 2944;
constexpr size_t O_YP = 0, O_YS = 33554432, O_PK = 35651584, O_PV = O_PK + 3145728, O_PH = O_PV + 3145728, O_PC = O_PH + 786432,
                 O_PF = O_PC + 43008, O_SK = O_PF + 180224, O_SV = O_SK + 3145728, O_SH = O_SV + 3145728, O_SC = O_SH + 6291456,
                 O_SG = O_SC + 344064, O_SF = O_SG + 2097152;
constexpr size_t W_IN = 0, W_IN_L = (size_t)NPROJ * DM * 2;
constexpr size_t W_OUT = W_IN + 4 * W_IN_L, W_OUT_L = (size_t)DM * DM * 2;
constexpr size_t W_UP = W_OUT + 4 * W_OUT_L, W_UP_L = (size_t)DFF2 * DM * 2;
constexpr size_t W_DN = W_UP + 4 * W_UP_L, W_DN_L = (size_t)DM * DFF * 2;
constexpr size_t W_GW = W_DN + 4 * W_DN_L, W_GW_L = (size_t)4 * 128 * 128 * 2;
constexpr size_t W_XB = W_GW + 4 * W_GW_L;
constexpr size_t W_PROJ = W_XB + (size_t)T_ALL * DM * 2;
constexpr size_t W_MIX = W_PROJ + (size_t)T_ALL * NPROJ * 2;
constexpr size_t W_ST = W_MIX + (size_t)T_ALL * DM * 2;
constexpr size_t W_CD = W_ST + (size_t)NU64 * 6 * 8192 * 2;
constexpr size_t W_DTB = W_CD + (size_t)NU64 * 8 * 4;
constexpr size_t W_END = W_DTB + (size_t)T_ALL * 8 * 4;
constexpr size_t W_BAR = W_END;
constexpr size_t W_END2 = W_BAR + 16384;
constexpr int LDS_BYTES = 156 * 1024;

struct Params { const float* in[28]; float* out; unsigned char* ws; int ph_lo, ph_hi, coop, pad; };
typedef const __attribute__((address_space(4))) Params KP;

__device__ __forceinline__ float bf2f(unsigned b) { return __uint_as_float(b << 16); }
typedef __bf16 bf16v2 __attribute__((ext_vector_type(2)));
__device__ __forceinline__ unsigned cvt_pk_bf16(float lo, float hi) { const f32x2 v = {lo, hi}; const bf16v2 b = __builtin_convertvector(v, bf16v2); return __builtin_bit_cast(unsigned, b); }
__device__ __forceinline__ u32x2 pack4(f32x4 v) { u32x2 w; w.x = cvt_pk_bf16(v[0], v[1]); w.y = cvt_pk_bf16(v[2], v[3]); return w; }
__device__ __forceinline__ f32x4 unpack4(u32x2 w) { f32x4 v; v[0] = bf2f(w.x & 0xffffu); v[1] = bf2f(w.x >> 16); v[2] = bf2f(w.y & 0xffffu); v[3] = bf2f(w.y >> 16); return v; }
__device__ __forceinline__ float silu_f(float x) { return x * __builtin_amdgcn_rcpf(1.0f + __expf(-x)); }
__device__ __forceinline__ float gelu_tanh(float x) { const float y = 0.7978845608028654f * (x + 0.044715f * x * x * x); const float e = __expf(2.0f * y); return 0.5f * x * (2.0f - 2.0f * __builtin_amdgcn_rcpf(1.0f + e)); }
__device__ __forceinline__ float softplus_f(float x) { const float e = __expf(x); return x > 15.0f ? x : (e < 1e-3f ? e * (1.0f - 0.5f * e + 0.33333333f * e * e) : __logf(1.0f + e)); }
#define MFMA16(colfrag, rowfrag, acc) __builtin_amdgcn_mfma_f32_16x16x32_bf16((colfrag), (rowfrag), (acc), 0, 0, 0)
__device__ __forceinline__ bf16x8 ldsfrag(LAS const unsigned char* p) { return *(LAS const bf16x8*)p; }
__device__ __forceinline__ bf16x8 glbfrag(const bf16_t* p) { return *(const bf16x8*)p; }
#define LDS_WAVE_SYNC() asm volatile("s_waitcnt lgkmcnt(0)" ::: "memory")

namespace pg8 {
constexpr int BM = 256, BK = 64, HALF = 128, HTB = HALF * BK * 2, STAGE_BYTES = 8 * HTB, NXCD = 8, WGM = 16;
__device__ __forceinline__ int lds_byte(int r, int c) { const int st = (r >> 4) * 2 + (c >> 5), rr = r & 15, cc = c & 31, ob = rr * 64 + cc * 2; return st * 1024 + (ob ^ (((ob >> 9) & 1) << 5)); }
__device__ __forceinline__ void stage_rc(int b, int& R, int& C) { const int st = b / 1024, sb = b % 1024, swz = sb ^ (((sb >> 9) & 1) << 5); R = (st >> 1) * 16 + swz / 64; C = (st & 1) * 32 + (swz % 64) / 2; }
__device__ __forceinline__ int perm32(int rho) { const int n = rho >> 4, i = rho & 15; return 8 * (i >> 2) + 4 * n + (i & 3); }
struct Unit { int pm, pn; };
struct Gemm { const bf16_t* A; const bf16_t* Bt; int M, N, K; };
struct StaticOrder {
    int nM, nN, nwg, G, c;
    __device__ __forceinline__ void init(int M, int N, int G_, int c_) { nM = M / BM; nN = N / BM; nwg = nM * nN; G = G_; c = c_; }
    __device__ __forceinline__ bool next(int i, Unit& u) const {
        const long L = (long)i * G + c; if (L >= nwg) return false;
        int wgid = (int)L; { const int q = nwg / NXCD, r = nwg % NXCD, xcd = wgid % NXCD, off = wgid / NXCD; wgid = (xcd < r ? xcd * (q + 1) : r * (q + 1) + (xcd - r) * q) + off; }
        const int nig = WGM * nN, gid = wgid / nig, fm = gid * WGM, gsz = (nM - fm) < WGM ? (nM - fm) : WGM;
        u.pm = fm + ((wgid % nig) % gsz); u.pn = (wgid % nig) / gsz; return true;
    }
    __device__ __forceinline__ void a_ready(const Unit&) const {}
    __device__ __forceinline__ void done(const Unit&) const {}
};
struct OneUnit {
    Unit u;
    __device__ __forceinline__ bool next(int i, Unit& o) const { if (i) return false; o = u; return true; }
    __device__ __forceinline__ void a_ready(const Unit&) const {}
    __device__ __forceinline__ void done(const Unit&) const {}
};

template <class Epi, class Sched>
__device__ __forceinline__ void gemm_phase(LAS unsigned char* lds, const Gemm g, const Sched& S, const Epi& E) {
    int tid_ = threadIdx.x; asm volatile("" : "+v"(tid_));
    const int tid = tid_, wid = __builtin_amdgcn_readfirstlane(tid >> 6), lane = tid & 63, wr = wid >> 2, wc = wid & 3, fr = lane & 15, fq = lane >> 4;
    const int K = g.K, nt = K / BK;
    unsigned voffA[2], voffB[2];
#pragma unroll
    for (int i = 0; i < 2; ++i) { int R, C; stage_rc(tid * 16 + i * 8192, R, C); const int Rb = (R & ~31) + perm32(R & 31); voffA[i] = (unsigned)(R * K + C) * 2u; voffB[i] = (unsigned)(Rb * K + C) * 2u; }
    const size_t kstep = (size_t)(BK * 2);
    const size_t hstep = (size_t)HALF * K * 2;
    const size_t tstep = 2 * hstep;
    const unsigned ldsw = (unsigned)wid * 1024u;
    const int aoff = lds_byte(wr * 64 + fr, fq * 8), boff = lds_byte(wc * 32 + fr, fq * 8);
#define PG8_SA(b, h) (((b) * 2 + (h)) * HTB)
#define PG8_SB(b, h) ((4 + (b) * 2 + (h)) * HTB)
#define PG8_STAGE(bufoff, gbase, voff) do { _Pragma("unroll") for (int _i = 0; _i < 2; ++_i) \
        __builtin_amdgcn_global_load_lds((const unsigned*)((const char*)(gbase) + (voff)[_i]), (LAS unsigned*)(lds + (bufoff) + ldsw + _i * 8192), 16, 0, 0); } while (0)
#define PG8_LDA(dst, b, h) do { _Pragma("unroll") for (int m = 0; m < 4; ++m) _Pragma("unroll") for (int k = 0; k < 2; ++k) dst[m][k] = *(const LAS bf16x8*)(lds + PG8_SA(b, h) + aoff + m * 2048 + k * 1024); } while (0)
#define PG8_LDB(dst, b, h) do { _Pragma("unroll") for (int n = 0; n < 2; ++n) _Pragma("unroll") for (int k = 0; k < 2; ++k) dst[n][k] = *(const LAS bf16x8*)(lds + PG8_SB(b, h) + boff + n * 2048 + k * 1024); } while (0)
#define PG8_MMA(ai, bj, At, Bt) do { __builtin_amdgcn_s_setprio(1); _Pragma("unroll") for (int m = 0; m < 4; ++m) _Pragma("unroll") for (int n = 0; n < 2; ++n) _Pragma("unroll") for (int k = 0; k < 2; ++k) \
        acc[ai][bj][m][n] = __builtin_amdgcn_mfma_f32_16x16x32_bf16(Bt[n][k], At[m][k], acc[ai][bj][m][n], 0, 0, 0); __builtin_amdgcn_s_setprio(0); } while (0)
#define PG8_WAIT_V(n) asm volatile("s_waitcnt vmcnt(" #n ")" ::: "memory")
#define PG8_WAIT_L(n) asm volatile("s_waitcnt lgkmcnt(" #n ")" ::: "memory")
#define PG8_BAR __builtin_amdgcn_s_barrier()
#define PG8_SCHED __builtin_amdgcn_sched_barrier(0)
    Unit cur, nxt; int ui = 0;
    if (!S.next(0, cur)) return;
    f32x4 acc[2][2][4][2];
#pragma unroll
    for (int a = 0; a < 2; ++a)
#pragma unroll
        for (int b = 0; b < 2; ++b)
#pragma unroll
            for (int m = 0; m < 4; ++m)
#pragma unroll
                for (int n = 0; n < 2; ++n) acc[a][b][m][n] = (f32x4){0.f, 0.f, 0.f, 0.f};
    bf16x8 At[4][2], B0[2][2], B1[2][2];
    const char* cA = (const char*)g.A + (size_t)cur.pm * tstep; const char* cB = (const char*)g.Bt + (size_t)cur.pn * tstep;
    S.a_ready(cur);
    PG8_STAGE(PG8_SB(0, 0), cB, voffB); PG8_STAGE(PG8_SA(0, 0), cA, voffA); PG8_STAGE(PG8_SB(0, 1), cB + hstep, voffB); PG8_STAGE(PG8_SA(0, 1), cA + hstep, voffA);
    if (wr == 1) PG8_BAR;
    PG8_WAIT_V(4); PG8_BAR;
    PG8_STAGE(PG8_SB(1, 0), cB + kstep, voffB); PG8_STAGE(PG8_SA(1, 0), cA + kstep, voffA); PG8_STAGE(PG8_SB(1, 1), cB + hstep + kstep, voffB);
    PG8_WAIT_V(6); PG8_BAR;
    for (;;) {
        const bool has_next = S.next(ui + 1, nxt);
        const char* nA = has_next ? (const char*)g.A + (size_t)nxt.pm * tstep : cA; const char* nB = has_next ? (const char*)g.Bt + (size_t)nxt.pn * tstep : cB;
        for (int t = 0; t < nt; t += 2) {
            const bool last = (t == nt - 2);
            const char* a1 = cA + (size_t)(t + 1) * kstep;
            const char* a2 = last ? nA : cA + (size_t)(t + 2) * kstep; const char* b2 = last ? nB : cB + (size_t)(t + 2) * kstep;
            const char* a3 = a2 + kstep; const char* b3 = b2 + kstep;
            if (last && has_next) S.a_ready(nxt);
            PG8_LDB(B0, 0, 0); PG8_SCHED; PG8_LDA(At, 0, 0); PG8_STAGE(PG8_SA(1, 1), a1 + hstep, voffA);
            PG8_WAIT_L(8); PG8_BAR; PG8_WAIT_L(0); PG8_MMA(0, 0, At, B0); PG8_BAR; PG8_SCHED;
            PG8_LDB(B1, 0, 1); PG8_STAGE(PG8_SB(0, 0), b2, voffB);
            PG8_BAR; PG8_WAIT_L(0); PG8_MMA(0, 1, At, B1); PG8_BAR;
            PG8_LDA(At, 0, 1); PG8_STAGE(PG8_SA(0, 0), a2, voffA);
            PG8_BAR; PG8_WAIT_L(0); PG8_MMA(1, 0, At, B0); PG8_BAR; PG8_SCHED;
            PG8_STAGE(PG8_SB(0, 1), b2 + hstep, voffB);
            PG8_WAIT_V(6); PG8_BAR; PG8_MMA(1, 1, At, B1); PG8_BAR;
            PG8_LDB(B0, 1, 0); PG8_SCHED; PG8_LDA(At, 1, 0); PG8_STAGE(PG8_SA(0, 1), a2 + hstep, voffA);
            PG8_WAIT_L(8); PG8_BAR; PG8_WAIT_L(0); PG8_MMA(0, 0, At, B0); PG8_BAR; PG8_SCHED;
            PG8_LDB(B1, 1, 1); PG8_STAGE(PG8_SB(1, 0), b3, voffB);
            PG8_BAR; PG8_WAIT_L(0); PG8_MMA(0, 1, At, B1); PG8_BAR;
            PG8_LDA(At, 1, 1); PG8_STAGE(PG8_SA(1, 0), a3, voffA);
            PG8_BAR; PG8_WAIT_L(0); PG8_MMA(1, 0, At, B0); PG8_BAR; PG8_SCHED;
            PG8_STAGE(PG8_SB(1, 1), b3 + hstep, voffB);
            PG8_WAIT_V(6); PG8_BAR; PG8_MMA(1, 1, At, B1); PG8_BAR;
        }
        if constexpr (!Epi::AFTER_DRAIN) { E(acc, cur, wr, wc, fr, fq); S.done(cur); }
        if (!has_next) break;
#pragma unroll
        for (int a = 0; a < 2; ++a)
#pragma unroll
            for (int b = 0; b < 2; ++b)
#pragma unroll
                for (int m = 0; m < 4; ++m)
#pragma unroll
                    for (int n = 0; n < 2; ++n) acc[a][b][m][n] = (f32x4){0.f, 0.f, 0.f, 0.f};
        cur = nxt; cA = nA; cB = nB; ++ui;
    }
    PG8_WAIT_V(0);
    if (wr == 0) PG8_BAR;
    PG8_BAR;
    if constexpr (Epi::AFTER_DRAIN) { E.fused(acc, cur, wr, wc, fr, fq, lds, wid, lane); S.done(cur); }
#undef PG8_SA
#undef PG8_SB
#undef PG8_STAGE
#undef PG8_LDA
#undef PG8_LDB
#undef PG8_MMA
#undef PG8_WAIT_V
#undef PG8_WAIT_L
#undef PG8_BAR
#undef PG8_SCHED
}
}
using pg8::Unit;

struct EpiIn {
    static constexpr bool AFTER_DRAIN = false;
    bf16_t* proj; float* out; float* dtb; const float* dt_bias; int l;
    __device__ __forceinline__ void operator()(const f32x4 (&acc)[2][2][4][2], const Unit& u, int wr, int wc, int fr_, int fq_) const {
        int fr = fr_, fq = fq_; asm volatile("" : "+v"(fr), "+v"(fq));
#pragma unroll
        for (int bj = 0; bj < 2; ++bj) {
            const int cb = u.pn * 256 + bj * 128;
            const int col = cb + wc * 32 + fq * 8;
            if (cb > C_DT) continue;
#pragma unroll
            for (int ai = 0; ai < 2; ++ai)
#pragma unroll
                for (int m = 0; m < 4; ++m) {
                    const int row = u.pm * 256 + ai * 128 + wr * 64 + m * 16 + fr;
                    const bool isP = row < T_P; int b, t;
                    if (isP) { b = row >> 13; t = row & 8191; } else { b = (row - T_P) >> 6; t = row & 63; }
                    f32x4 v0 = acc[ai][bj][m][0], v1 = acc[ai][bj][m][1];
                    if (cb < C_U) {
                        u32x4 w; { const u32x2 a = pack4(v0), c = pack4(v1); w.x = a.x; w.y = a.y; w.z = c.x; w.w = c.y; }
                        *(u32x4*)(proj + (size_t)row * NPROJ + col) = w;
                        if (cb >= C_K && cb < C_Z) {
                            const int isv = cb >= C_V; const int cc = col - (isv ? C_V : C_K);
                            float* o = nullptr;
                            if (isP) { if (t >= 7680) o = out + (isv ? O_PV : O_PK) + ((size_t)(l * 4 + b) * 512 + (t - 7680)) * 384 + cc; }
                            else o = out + (isv ? O_SV : O_SK) + ((size_t)(l * 32 + b) * 64 + t) * 384 + cc;
                            if (o) { *(f32x4*)o = v0; *(f32x4*)(o + 4) = v1; }
                        } else if (cb >= C_XBC) {
                            const int cc = col - C_XBC; float* o = nullptr;
                            if (isP) { if (t >= 8189) o = out + O_PC + ((size_t)(l * 4 + b) * 3 + (t - 8189)) * 896 + cc; }
                            else if (t >= 61) o = out + O_SC + ((size_t)(l * 32 + b) * 3 + (t - 61)) * 896 + cc;
                            if (o) { *(f32x4*)o = v0; *(f32x4*)(o + 4) = v1; }
                        }
                    } else if (cb < C_DT) {
#pragma unroll
                        for (int j = 0; j < 4; ++j) { v0[j] = gelu_tanh(v0[j]); v1[j] = gelu_tanh(v1[j]); }
                        u32x4 w; { const u32x2 a = pack4(v0), c = pack4(v1); w.x = a.x; w.y = a.y; w.z = c.x; w.w = c.y; }
                        *(u32x4*)(proj + (size_t)row * NPROJ + col) = w;
                        if (cb >= C_VC && !isP) { float* o = out + O_SG + ((size_t)(l * 32 + b) * 64 + t) * 256 + (col - C_VC); *(f32x4*)o = v0; *(f32x4*)(o + 4) = v1; }
                    } else if (col == C_DT) {
                        float* d = dtb + (size_t)row * 8;
#pragma unroll
                        for (int j = 0; j < 4; ++j) d[j] = softplus_f(v0[j] + dt_bias[l * 6 + j]);
#pragma unroll
                        for (int j = 0; j < 2; ++j) d[4 + j] = softplus_f(v1[j] + dt_bias[l * 6 + 4 + j]);
                    }
                    asm volatile("" ::: "memory");
                }
        }
    }
};
struct EpiNull {
    static constexpr bool AFTER_DRAIN = false;
    float* sink;
    __device__ __forceinline__ void operator()(const f32x4 (&acc)[2][2][4][2], const Unit& u, int wr, int wc, int fr, int fq) const {
        float t = 0.f;
#pragma unroll
        for (int ai = 0; ai < 2; ++ai)
#pragma unroll
            for (int bj = 0; bj < 2; ++bj)
#pragma unroll
                for (int m = 0; m < 4; ++m)
#pragma unroll
                    for (int n = 0; n < 2; ++n) t += acc[ai][bj][m][n][0] + acc[ai][bj][m][n][1] + acc[ai][bj][m][n][2] + acc[ai][bj][m][n][3];
        if (t == 123456.789f) sink[0] = t;
    }
};
struct EpiRes {
    static constexpr bool AFTER_DRAIN = false;
    float* x; const bf16_t* xb; bf16_t* rdst;
    __device__ __forceinline__ void operator()(const f32x4 (&acc)[2][2][4][2], const Unit& u, int wr, int wc, int fr_, int fq_) const {
        int fr = fr_, fq = fq_; asm volatile("" : "+v"(fr), "+v"(fq));
        const size_t base = (size_t)(u.pm * 256 + wr * 64 + fr) * DM + u.pn * 256 + wc * 32 + fq * 8;
        u32x4 xw[2][4][2];
#pragma unroll
        for (int ai = 0; ai < 2; ++ai)
#pragma unroll
            for (int m = 0; m < 4; ++m)
#pragma unroll
                for (int bj = 0; bj < 2; ++bj) xw[ai][m][bj] = *(const u32x4*)(xb + base + (size_t)(ai * 128 + m * 16) * DM + bj * 128);
#pragma unroll
        for (int ai = 0; ai < 2; ++ai)
#pragma unroll
            for (int m = 0; m < 4; ++m)
#pragma unroll
                for (int bj = 0; bj < 2; ++bj) { const u32x4 w = xw[ai][m][bj];
                    const f32x4 o0 = unpack4((u32x2){w.x, w.y}), o1 = unpack4((u32x2){w.z, w.w});
                    const u32x2 ra = pack4(o0 * ALPHA + acc[ai][bj][m][0]), rb = pack4(o1 * ALPHA + acc[ai][bj][m][1]);
                    *(u32x4*)(rdst + base + (size_t)(ai * 128 + m * 16) * DM + bj * 128) = (u32x4){ra.x, ra.y, rb.x, rb.y}; }
    }
};
struct EpiUp {
    static constexpr bool AFTER_DRAIN = true;
    bf16_t* H; float* halo; float* out; const float* cw; const float* cb; const float* fstate; int l;
    __device__ __forceinline__ void operator()(const f32x4 (&)[2][2][4][2], const Unit&, int, int, int, int) const {}
    __device__ __forceinline__ void fused(f32x4 (&acc)[2][2][4][2], const Unit& u, int wr, int wc, int fr, int fq, LAS unsigned char* lds, int wid, int lane) const {
        constexpr int LS = 264;
#pragma unroll
        for (int ai = 0; ai < 2; ++ai)
#pragma unroll
            for (int m = 0; m < 4; ++m)
#pragma unroll
                for (int bj = 0; bj < 2; ++bj) {
                        const int rl = ai * 128 + wr * 64 + m * 16 + fr, cl = bj * 128 + wc * 32 + fq * 8;
                        u32x4 w; { const u32x2 a = pack4(acc[ai][bj][m][0]), c = pack4(acc[ai][bj][m][1]); w.x = a.x; w.y = a.y; w.z = c.x; w.w = c.y; }
                        *(LAS u32x4*)(lds + (rl * LS + cl) * 2) = w;
                    }
        __syncthreads();
        const int tid = wid * 64 + lane, j = 2 * (tid & 63), seg = tid >> 6;
        const int hcol = u.pn * 128 + j;
        const float* w = cw + (size_t)l * 3 * DFF2 + hcol; const float* bb = cb + (size_t)l * DFF2 + hcol;
        const f32x2 wg0 = *(const f32x2*)w, wg1 = *(const f32x2*)(w + DFF2), wg2 = *(const f32x2*)(w + 2 * DFF2), bg = *(const f32x2*)bb;
        const f32x2 wv0 = *(const f32x2*)(w + DFF), wv1 = *(const f32x2*)(w + DFF2 + DFF), wv2 = *(const f32x2*)(w + 2 * DFF2 + DFF), bv = *(const f32x2*)(bb + DFF);
        const int r0 = seg * 32, R = u.pm * 256 + r0;
        const bool isP = R < T_P;
        const LAS unsigned char* U = (const LAS unsigned char*)lds;
#define UP2(row, off) ({ const unsigned w_ = *(const LAS unsigned*)(U + ((row) * LS + (off) + j) * 2); (f32x2){bf2f(w_ & 0xffffu), bf2f(w_ >> 16)}; })
        f32x2 g2 = (f32x2){0.f, 0.f}, g1 = g2, v2 = g2, v1 = g2; int skip = 0;
        if (isP) {
            if (seg > 0) { g2 = UP2(r0 - 2, 0); g1 = UP2(r0 - 1, 0); v2 = UP2(r0 - 2, 128); v1 = UP2(r0 - 1, 128); }
            else if ((R & 8191) != 0) skip = 2;
        } else if (seg & 1) { g2 = UP2(r0 - 2, 0); g1 = UP2(r0 - 1, 0); v2 = UP2(r0 - 2, 128); v1 = UP2(r0 - 1, 128); }
        else { const int sb = (R - T_P) >> 6; const float* fs = fstate + (size_t)(l * 32 + sb) * 2 * DFF2 + hcol;
            g2 = *(const f32x2*)fs; g1 = *(const f32x2*)(fs + DFF2); v2 = *(const f32x2*)(fs + DFF); v1 = *(const f32x2*)(fs + DFF2 + DFF); }
        bf16_t* hp = H + (size_t)R * DFF + hcol;
#pragma unroll 8
        for (int i = 0; i < 32; ++i) {
            const f32x2 gq = UP2(r0 + i, 0), vq = UP2(r0 + i, 128);
            if (i >= skip) {
                const f32x2 cgv = bg + wg0 * g2 + wg1 * g1 + wg2 * gq, cvv = bv + wv0 * v2 + wv1 * v1 + wv2 * vq;
                *(unsigned*)(hp + (size_t)i * DFF) = cvt_pk_bf16(silu_f(cgv[0]) * cvv[0], silu_f(cgv[1]) * cvv[1]);
            }
            g2 = g1; g1 = gq; v2 = v1; v1 = vq;
            if (isP) {
                if (seg == 0 && i < 2) { float* hl = halo + ((size_t)u.pm * 4 + i) * DFF2 + hcol; *(f32x2*)hl = gq; *(f32x2*)(hl + DFF) = vq; }
                if (seg == 7 && i >= 30) { float* hl = halo + ((size_t)u.pm * 4 + 2 + (i - 30)) * DFF2 + hcol; *(f32x2*)hl = gq; *(f32x2*)(hl + DFF) = vq;
                    if ((u.pm & 31) == 31) { float* o = out + O_PF + ((size_t)(l * 4 + (u.pm >> 5)) * 2 + (i - 30)) * DFF2 + hcol; *(f32x2*)o = gq; *(f32x2*)(o + DFF) = vq; } }
            } else if ((seg & 1) && i >= 30) {
                const int sb = (R - 32 - T_P) >> 6; float* o = out + O_SF + ((size_t)(l * 32 + sb) * 2 + (i - 30)) * DFF2 + hcol; *(f32x2*)o = gq; *(f32x2*)(o + DFF) = vq;
            }
        }
#undef UP2
    }
};

__device__ __forceinline__ void ln_row(const float* src, const bf16_t* srcb, float* x32, bf16_t* xb, const float* g, const float* b, int lane) {
    f32x4 v[4]; float s = 0.f;
#pragma unroll
    for (int i = 0; i < 4; ++i) { v[i] = srcb ? unpack4(*(const u32x2*)(srcb + i * 256 + lane * 4)) : *(const f32x4*)(src + i * 256 + lane * 4); s += (v[i][0] + v[i][1]) + (v[i][2] + v[i][3]); }
#pragma unroll
    for (int o = 32; o >= 1; o >>= 1) s += __shfl_xor(s, o);
    const float mu = s * (1.0f / 1024.0f); float q = 0.f;
#pragma unroll
    for (int i = 0; i < 4; ++i) { const f32x4 d = v[i] - mu; q += (d[0] * d[0] + d[1] * d[1]) + (d[2] * d[2] + d[3] * d[3]); }
#pragma unroll
    for (int o = 32; o >= 1; o >>= 1) q += __shfl_xor(q, o);
    const float rstd = 1.0f / sqrtf(q * (1.0f / 1024.0f) + LN_EPS);
#pragma unroll
    for (int i = 0; i < 4; ++i) {
        const f32x4 gg = *(const f32x4*)(g + i * 256 + lane * 4), bb = *(const f32x4*)(b + i * 256 + lane * 4);
        const f32x4 o = (v[i] - mu) * rstd * gg + bb;
        if (x32) *(f32x4*)(x32 + i * 256 + lane * 4) = o;
        if (xb) *(u32x2*)(xb + i * 256 + lane * 4) = pack4(o);
    }
}

__device__ __forceinline__ void tr_tile(LAS float* tile, const float* src, int Nsrc, bf16_t* dst, int K, int n0, int k0, int mode, int tid) {
    const int nn = tid & 63, np = n0 + nn; int sc;
    if (mode == 0) sc = np < C_U ? np : (np < C_DT ? np + 6 : (np < C_DT + 6 ? np - 512 : -1));
    else if (mode == 1) sc = np;
    else { const int pn = np >> 8, jj = np & 255; sc = jj < 128 ? pn * 128 + jj : DFF + pn * 128 + (jj - 128); }
#pragma unroll
    for (int i = 0; i < 8; ++i) { const int kk = (tid >> 6) + 8 * i; tile[kk * 65 + nn] = sc >= 0 ? src[(size_t)(k0 + kk) * Nsrc + sc] : 0.f; }
    __syncthreads();
    const int kk2 = (tid & 31) * 2;
#pragma unroll
    for (int i = 0; i < 4; ++i) { const int nn2 = (tid >> 5) + 16 * i; *(unsigned*)(dst + (size_t)(n0 + nn2) * K + k0 + kk2) = cvt_pk_bf16(tile[kk2 * 65 + nn2], tile[(kk2 + 1) * 65 + nn2]); }
    __syncthreads();
}

__device__ __forceinline__ void phase_prep(KP& p, LAS unsigned char* lds) {
    int tid_ = threadIdx.x; asm volatile("" : "+v"(tid_));
    const int tid = tid_, wid = tid >> 6, lane = tid & 63;
    for (int row = blockIdx.x * 8 + wid; row < T_ALL; row += gridDim.x * 8) {
        const float* src = row < T_P ? p.in[0] + (size_t)row * DM : p.in[1] + (size_t)(row - T_P) * DM;
        ln_row(src, nullptr, nullptr, (bf16_t*)(p.ws + W_XB) + (size_t)row * DM, p.in[7], p.in[8], lane);
    }
    constexpr int T_IN = 48 * 16, T_OUT = 16 * 16, T_UPT = 88 * 16, T_DNT = 16 * 44, T_L = T_IN + T_OUT + T_UPT + T_DNT;
    for (int it = blockIdx.x; it < 4 * T_L; it += gridDim.x) {
        const int l = it / T_L; int r = it % T_L;
        if (r < T_IN) tr_tile((LAS float*)lds, p.in[9] + (size_t)l * DM * 2950, 2950, (bf16_t*)(p.ws + W_IN + l * W_IN_L), DM, (r >> 4) * 64, (r & 15) * 64, 0, tid);
        else if ((r -= T_IN) < T_OUT) tr_tile((LAS float*)lds, p.in[19] + (size_t)l * DM * DM, DM, (bf16_t*)(p.ws + W_OUT + l * W_OUT_L), DM, (r >> 4) * 64, (r & 15) * 64, 1, tid);
        else if ((r -= T_OUT) < T_UPT) tr_tile((LAS float*)lds, p.in[22] + (size_t)l * DM * DFF2, DFF2, (bf16_t*)(p.ws + W_UP + l * W_UP_L), DM, (r >> 4) * 64, (r & 15) * 64, 2, tid);
        else { r -= T_UPT; tr_tile((LAS float*)lds, p.in[25] + (size_t)l * DFF * DM, DM, (bf16_t*)(p.ws + W_DN + l * W_DN_L), DFF, (r / 44) * 64, (r % 44) * 64, 1, tid); }
    }
    for (int i = blockIdx.x * 512 + tid; i < 4 * 4 * 128 * 128; i += gridDim.x * 512) {
        const int jj = i & 127, ii = (i >> 7) & 127;
        ((bf16_t*)(p.ws + W_GW))[i] = (bf16_t)(cvt_pk_bf16(jj <= ii ? p.in[16][i] : 0.f, 0.f) & 0xffffu);
    }
}

template <int NB>
__device__ __forceinline__ void ln_rows_bf(const bf16_t* rsrc, float* x32, bf16_t* xb, const f32x4 (&gg)[4], const f32x4 (&bb)[4], int row, int stride, int lane) {
    u32x2 raw[NB][4];
#pragma unroll
    for (int k = 0; k < NB; ++k)
#pragma unroll
        for (int i = 0; i < 4; ++i) raw[k][i] = *(const u32x2*)(rsrc + (size_t)(row + k * stride) * DM + i * 256 + lane * 4);
#pragma unroll
    for (int k = 0; k < NB; ++k) {
        f32x4 v[4]; float s = 0.f;
#pragma unroll
        for (int i = 0; i < 4; ++i) { v[i] = unpack4(raw[k][i]); s += (v[i][0] + v[i][1]) + (v[i][2] + v[i][3]); }
#pragma unroll
        for (int o = 32; o >= 1; o >>= 1) s += __shfl_xor(s, o);
        const float mu = s * (1.0f / 1024.0f); float q = 0.f;
#pragma unroll
        for (int i = 0; i < 4; ++i) { const f32x4 d = v[i] - mu; q += (d[0] * d[0] + d[1] * d[1]) + (d[2] * d[2] + d[3] * d[3]); }
#pragma unroll
        for (int o = 32; o >= 1; o >>= 1) q += __shfl_xor(q, o);
        const float rstd = 1.0f / sqrtf(q * (1.0f / 1024.0f) + LN_EPS);
        const size_t ro = (size_t)(row + k * stride) * DM + lane * 4;
#pragma unroll
        for (int i = 0; i < 4; ++i) {
            const f32x4 o = (v[i] - mu) * rstd * gg[i] + bb[i];
            if (x32) *(f32x4*)(x32 + ro + i * 256) = o;
            if (xb) *(u32x2*)(xb + ro + i * 256) = pack4(o);
        }
    }
}
__device__ __forceinline__ void phase_ln(KP& p, const bf16_t* rsrc, const float* g, const float* b, bool final_out) {
    int tid_ = threadIdx.x; asm volatile("" : "+v"(tid_));
    const int wid = tid_ >> 6, lane = tid_ & 63, stride = gridDim.x * 8;
    f32x4 gg[4], bb[4];
#pragma unroll
    for (int i = 0; i < 4; ++i) { gg[i] = *(const f32x4*)(g + i * 256 + lane * 4); bb[i] = *(const f32x4*)(b + i * 256 + lane * 4); }
    float* x32 = final_out ? p.out : nullptr; bf16_t* xb = final_out ? nullptr : (bf16_t*)(p.ws + W_XB);
    int row = blockIdx.x * 8 + wid;
    for (; row + 3 * stride < T_ALL; row += 4 * stride) ln_rows_bf<4>(rsrc, x32, xb, gg, bb, row, stride, lane);
    for (; row < T_ALL; row += stride) ln_rows_bf<1>(rsrc, x32, xb, gg, bb, row, stride, lane);
}

__device__ __forceinline__ void dt_scan(KP& p, int l, int u, int g, int wid, int lane, float& dt, float& ac, float& last) {
    const int h = g * 3 + wid;
    dt = ((const float*)(p.ws + W_DTB))[(size_t)(u * 64 + lane) * 8 + h];
    const float a = -__expf(p.in[14][l * 6 + h]);
    float v = dt * a;
#pragma unroll
    for (int o = 1; o < 64; o <<= 1) { const float t = __shfl_up(v, o); if (lane >= o) v += t; }
    ac = v; last = __shfl(v, 63);
}

__device__ __forceinline__ f32x4 xbc_row(KP& p, int l, int u, int s, int ch) {
    const bf16_t* proj = (const bf16_t*)(p.ws + W_PROJ);
    const bool isP = u < 512; const bool hasprev = isP && (u & 127) != 0;
    if (s >= 0 || hasprev) return unpack4(*(const u32x2*)(proj + (size_t)(u * 64 + s) * NPROJ + C_XBC + ch));
    if (!isP) return *(const f32x4*)(p.in[5] + (unsigned)(((l * 32 + (u - 512)) * 3 + (3 + s)) * 896 + ch));
    return (f32x4){0.f, 0.f, 0.f, 0.f};
}
__device__ __forceinline__ void ssd_states(KP& p, LAS unsigned char* lds, int l, int u) {
    int tid_ = threadIdx.x; asm volatile("" : "+v"(tid_));
    const int tid = tid_, wid = tid >> 6, lane = tid & 63, fr = lane & 15, fq = lane >> 4;
    LAS bf16_t* xT = (LAS bf16_t*)lds;
    LAS bf16_t* BT = (LAS bf16_t*)(lds + 55296);
    LAS float* wgt = (LAS float*)(lds + 92160);
    bf16_t* XC = (bf16_t*)p.out;
    __syncthreads();
    if (wid < 6) {
        float dt, ac, last; dt_scan(p, l, u, wid / 3, wid % 3, lane, dt, ac, last);
        wgt[wid * 64 + lane] = dt * __expf(last - ac);
        if (lane == 0) ((float*)(p.ws + W_CD))[u * 8 + wid] = __expf(last);
    }
    __syncthreads();
    if (tid < 448) {
        const int cgp = tid % 224, seg = tid / 224, ch = cgp * 4, r0 = seg * 32;
        const float* cw = p.in[11] + (size_t)l * 4 * 896 + ch;
        const f32x4 w0 = *(const f32x4*)cw, w1 = *(const f32x4*)(cw + 896), w2 = *(const f32x4*)(cw + 2 * 896), w3 = *(const f32x4*)(cw + 3 * 896);
        const f32x4 bs = *(const f32x4*)(p.in[12] + (size_t)l * 896 + ch);
        f32x4 xm3 = xbc_row(p, l, u, r0 - 3, ch), xm2 = xbc_row(p, l, u, r0 - 2, ch), xm1 = xbc_row(p, l, u, r0 - 1, ch);
        const bf16_t* src = (const bf16_t*)(p.ws + W_PROJ) + (size_t)(u * 64) * NPROJ + C_XBC + ch;
        bf16_t* dst = XC + (size_t)(u * 64) * 896 + ch;
        const int hh = ch >> 6;
#pragma unroll 2
        for (int i = r0; i < r0 + 32; i += 2) {
            const f32x4 xa = unpack4(*(const u32x2*)(src + (size_t)i * NPROJ)), xb = unpack4(*(const u32x2*)(src + (size_t)(i + 1) * NPROJ));
            f32x4 ya = bs + w0 * xm3 + w1 * xm2 + w2 * xm1 + w3 * xa, yb = bs + w0 * xm2 + w1 * xm1 + w2 * xa + w3 * xb;
#pragma unroll
            for (int e = 0; e < 4; ++e) { ya[e] = silu_f(ya[e]); yb[e] = silu_f(yb[e]); }
            xm3 = xm1; xm2 = xa; xm1 = xb;
            *(u32x2*)(dst + (size_t)i * 896) = pack4(ya); *(u32x2*)(dst + (size_t)(i + 1) * 896) = pack4(yb);
            if (ch < 384) { const float wa = wgt[hh * 64 + i], wb = wgt[hh * 64 + i + 1];
#pragma unroll
                for (int e = 0; e < 4; ++e) *(LAS unsigned*)(xT + (ch + e) * 72 + i) = cvt_pk_bf16(ya[e] * wa, yb[e] * wb); }
            else if (ch < 640) {
#pragma unroll
                for (int e = 0; e < 4; ++e) *(LAS unsigned*)(BT + (ch - 384 + e) * 72 + i) = cvt_pk_bf16(ya[e], yb[e]); }
        }
    }
    __syncthreads();
    bf16_t* ST = (bf16_t*)(p.ws + W_ST);
#pragma unroll 2
    for (int k = 0; k < 24; ++k) {
        const int tt = wid * 24 + k, h = tt >> 5, pt = (tt & 31) >> 3, nt = tt & 7, g = h / 3;
        f32x4 acc = (f32x4){0.f, 0.f, 0.f, 0.f};
#pragma unroll
        for (int ks = 0; ks < 2; ++ks) {
            const bf16x8 rf = ldsfrag((LAS const unsigned char*)(xT + (h * 64 + pt * 16 + fr) * 72 + ks * 32 + fq * 8));
            const bf16x8 cf = ldsfrag((LAS const unsigned char*)(BT + (g * 128 + nt * 16 + fr) * 72 + ks * 32 + fq * 8));
            acc = MFMA16(cf, rf, acc);
        }
        *(u32x2*)(ST + ((size_t)(u * 6 + h) * 64 + pt * 16 + fr) * 128 + nt * 16 + fq * 4) = pack4(acc);
    }
}

__device__ __forceinline__ void gmlp_unit(KP& p, LAS unsigned char* lds, int l, int u) {
    int tid_ = threadIdx.x; asm volatile("" : "+v"(tid_));
    const int tid = tid_, wid = tid >> 6, lane = tid & 63, fr = lane & 15, fq = lane >> 4;
    LAS bf16_t* vT = (LAS bf16_t*)lds;
    LAS float* ssq = (LAS float*)(lds + 69632);
    const bf16_t* proj = (const bf16_t*)(p.ws + W_PROJ);
    const int half = u < 512 ? (u & 1) : 0, KJ = (half + 1) * 64, R0 = u * 64, Rb = R0 - half * 64;
    __syncthreads();
    for (int idx = tid; idx < KJ * 32; idx += 512) {
        const int j = idx & (KJ - 1), cgp = idx / KJ;
        const u32x4 w = *(const u32x4*)(proj + (size_t)(Rb + j) * NPROJ + C_VC + cgp * 8);
        const unsigned ww[4] = {w.x, w.y, w.z, w.w};
#pragma unroll
        for (int e = 0; e < 4; ++e) { vT[(cgp * 8 + 2 * e) * 136 + j] = (bf16_t)(ww[e] & 0xffffu); vT[(cgp * 8 + 2 * e + 1) * 136 + j] = (bf16_t)(ww[e] >> 16); }
    }
    __syncthreads();
    const int rt = wid & 3, cbase = (wid >> 2) * 8;
    const bf16_t* GW = (const bf16_t*)(p.ws + W_GW + l * W_GW_L);
    f32x4 acc[8];
#pragma unroll
    for (int gi = 0; gi < 2; ++gi) {
        const int gg = (cbase >> 2) + gi;
        bf16x8 rf[4];
#pragma unroll
        for (int ks = 0; ks < 4; ++ks) rf[ks] = glbfrag(GW + ((size_t)gg * 128 + half * 64 + rt * 16 + fr) * 128 + ks * 32 + fq * 8);
#pragma unroll
        for (int c4 = 0; c4 < 4; ++c4) {
            const int ct = cbase + gi * 4 + c4;
            f32x4 a = (f32x4){0.f, 0.f, 0.f, 0.f};
#pragma unroll
            for (int ks = 0; ks < 4; ++ks) if (ks * 32 < KJ) a = MFMA16(ldsfrag((LAS const unsigned char*)(vT + (ct * 16 + fr) * 136 + ks * 32 + fq * 8)), rf[ks], a);
            acc[gi * 4 + c4] = a;
        }
    }
    const int row = R0 + rt * 16 + fr; float sq = 0.f;
#pragma unroll
    for (int k = 0; k < 8; ++k) {
        const int col = (cbase + k) * 16 + fq * 4, gg = col >> 6;
        const float bsv = p.in[17][(size_t)(l * 4 + gg) * 128 + half * 64 + rt * 16 + fr];
        const f32x4 uv = unpack4(*(const u32x2*)(proj + (size_t)row * NPROJ + C_U + col));
        f32x4 o = uv * (acc[k] + bsv); acc[k] = o;
        sq += (o[0] * o[0] + o[1] * o[1]) + (o[2] * o[2] + o[3] * o[3]);
    }
    sq += __shfl_xor(sq, 16); sq += __shfl_xor(sq, 32);
    if (fq == 0) ssq[(wid >> 2) * 64 + rt * 16 + fr] = sq;
    __syncthreads();
    const float rstd = 1.0f / sqrtf((ssq[rt * 16 + fr] + ssq[64 + rt * 16 + fr]) * (1.0f / 256.0f) + RMS_EPS);
    bf16_t* mix = (bf16_t*)(p.ws + W_MIX);
#pragma unroll
    for (int k = 0; k < 8; ++k) {
        const int col = (cbase + k) * 16 + fq * 4;
        const f32x4 gv = *(const f32x4*)(p.in[18] + (size_t)l * 1024 + 768 + col);
        *(u32x2*)(mix + (size_t)row * DM + 768 + col) = pack4(acc[k] * rstd * gv);
    }
}

__device__ __forceinline__ void scan_prompt(KP& p, int l, int item) {
    int tid_ = threadIdx.x; asm volatile("" : "+v"(tid_));
    const int gid = item * 512 + tid_, e = (gid & 2047) * 4, bh = gid >> 11, b = bh / 6, h = bh % 6;
    bf16_t* ST = (bf16_t*)(p.ws + W_ST); const float* CD = (const float*)(p.ws + W_CD);
    f32x4 st = (f32x4){0.f, 0.f, 0.f, 0.f};
#pragma unroll 1
    for (int c0 = 0; c0 < 128; c0 += 16) {
        u32x2 s[16]; float cd[16];
#pragma unroll
        for (int k = 0; k < 16; ++k) { const int u = b * 128 + c0 + k; s[k] = *(const u32x2*)(ST + ((size_t)(u * 6 + h)) * 8192 + e); cd[k] = CD[u * 8 + h]; }
#pragma unroll
        for (int k = 0; k < 16; ++k) { const int u = b * 128 + c0 + k; *(u32x2*)(ST + ((size_t)(u * 6 + h)) * 8192 + e) = pack4(st); st = st * cd[k] + unpack4(s[k]); }
    }
    *(f32x4*)(p.out + O_PH + ((size_t)(l * 4 + b) * 6 + h) * 8192 + e) = st;
}
__device__ __forceinline__ void scan_sample(KP& p, int l, int item) {
    int tid_ = threadIdx.x; asm volatile("" : "+v"(tid_));
    const int gid = item * 512 + tid_, e = (gid & 2047) * 4, sbh = gid >> 11, sb = sbh / 6, h = sbh % 6;
    bf16_t* ST = (bf16_t*)(p.ws + W_ST); const float* CD = (const float*)(p.ws + W_CD);
    const int u = 512 + sb;
    const f32x4 st = *(const f32x4*)(p.in[4] + ((size_t)(l * 32 + sb) * 6 + h) * 8192 + e);
    const f32x4 s = unpack4(*(const u32x2*)(ST + ((size_t)(u * 6 + h)) * 8192 + e));
    *(u32x2*)(ST + ((size_t)(u * 6 + h)) * 8192 + e) = pack4(st);
    *(f32x4*)(p.out + O_SH + ((size_t)(l * 32 + sb) * 6 + h) * 8192 + e) = st * CD[u * 8 + h] + s;
}

__device__ __forceinline__ void attn_unit(KP& p, LAS unsigned char* lds, int l, int u) {
    int tid_ = threadIdx.x; asm volatile("" : "+v"(tid_));
    const int tid = tid_, wid = tid >> 6, lane = tid & 63, fr = lane & 15, fq = lane >> 4;
    LAS bf16_t* VT = (LAS bf16_t*)(lds + 98304);
    LAS float* bias = (LAS float*)(lds + 153600);
    LAS float* ssq = (LAS float*)(lds + 158208);
    const bf16_t* proj = (const bf16_t*)(p.ws + W_PROJ);
    const bool isP = u < 512; const int R0 = u * 64, c = u & 127, b = u >> 7, sb = u - 512;
    const int qt = wid & 3, hbase = (wid >> 2) * 3;
    __syncthreads();
    for (int i = tid; i < 1152; i += 512) bias[i] = p.in[10][(size_t)l * 1152 + i];
    bf16x8 qf[3][2];
#pragma unroll
    for (int hh = 0; hh < 3; ++hh)
#pragma unroll
        for (int ks = 0; ks < 2; ++ks) qf[hh][ks] = glbfrag(proj + (size_t)(R0 + qt * 16 + fr) * NPROJ + (hbase + hh) * 64 + ks * 32 + fq * 8);
    float mrun[3], lrun[3]; f32x4 O[3][4];
#pragma unroll
    for (int hh = 0; hh < 3; ++hh) { mrun[hh] = -1e30f; lrun[hh] = 0.f;
#pragma unroll
        for (int d = 0; d < 4; ++d) O[hh][d] = (f32x4){0.f, 0.f, 0.f, 0.f}; }
    const int blk_lo = isP ? (c < 8 ? 8 - c : 0) : 0;
    u32x4 vr[6];
    const int vkp = tid & 31, vcg0 = tid >> 5;
#define ATT_LOADP(blkv, bufv) do { const size_t rb_ = isP ? (size_t)b * 8192 + (size_t)(c - 8 + (blkv)) * 64 : (size_t)T_P + (size_t)sb * 64; \
        _Pragma("unroll") for (int it = 0; it < 6; ++it) { const int pu_ = it * 512 + tid, row_ = pu_ / 48, un_ = (pu_ % 48) ^ (row_ & 15); \
            __builtin_amdgcn_global_load_lds((const unsigned*)(proj + (rb_ + row_) * NPROJ + C_K + un_ * 8), (LAS unsigned*)(lds + (bufv) * 49152 + (it * 512 + wid * 64) * 16), 16, 0, 0); } \
        _Pragma("unroll") for (int it = 0; it < 2; ++it) { const int cg_ = vcg0 + it * 16; \
            vr[2 * it] = *(const u32x4*)(proj + (rb_ + 2 * vkp) * NPROJ + C_V + cg_ * 8); vr[2 * it + 1] = *(const u32x4*)(proj + (rb_ + 2 * vkp + 1) * NPROJ + C_V + cg_ * 8); } } while (0)
    bool have = false; int cur = 0;
    if (isP || blk_lo == 8) { ATT_LOADP(blk_lo, 0); have = true; }
#pragma unroll 1
    for (int blk = blk_lo; blk <= 8; ++blk) {
        LAS unsigned char* Kc = lds + cur * 49152;
        __syncthreads();
        if (!have) {
#pragma unroll
            for (int it = 0; it < 6; ++it) { const int idx = it * 512 + tid, row_ = idx / 48, un_ = idx % 48;
                const float* s = p.in[2] + ((size_t)(l * 32 + sb) * 512 + blk * 64 + row_) * 384 + un_ * 8; const f32x4 a = *(const f32x4*)s, bq = *(const f32x4*)(s + 4);
                u32x4 w; w.x = cvt_pk_bf16(a[0], a[1]); w.y = cvt_pk_bf16(a[2], a[3]); w.z = cvt_pk_bf16(bq[0], bq[1]); w.w = cvt_pk_bf16(bq[2], bq[3]);
                *(LAS u32x4*)(Kc + row_ * 768 + ((un_ ^ (row_ & 15)) * 16)) = w; }
#pragma unroll
            for (int it = 0; it < 6; ++it) { const int cg_ = vcg0 + (it >> 1) * 16;
                const float* s = p.in[3] + ((size_t)(l * 32 + sb) * 512 + blk * 64 + 2 * vkp + (it & 1)) * 384 + cg_ * 8; const f32x4 a = *(const f32x4*)s, bq = *(const f32x4*)(s + 4);
                vr[it].x = cvt_pk_bf16(a[0], a[1]); vr[it].y = cvt_pk_bf16(a[2], a[3]); vr[it].z = cvt_pk_bf16(bq[0], bq[1]); vr[it].w = cvt_pk_bf16(bq[2], bq[3]); }
        }
        if (have) { const size_t rb_ = isP ? (size_t)b * 8192 + (size_t)(c - 8 + blk) * 64 : (size_t)T_P + (size_t)sb * 64; const int cg_ = vcg0 + 2 * 16;
            vr[4] = *(const u32x4*)(proj + (rb_ + 2 * vkp) * NPROJ + C_V + cg_ * 8); vr[5] = *(const u32x4*)(proj + (rb_ + 2 * vkp + 1) * NPROJ + C_V + cg_ * 8); }
#pragma unroll
        for (int it = 0; it < 3; ++it) { const int cg_ = vcg0 + it * 16; const u32x4 w0 = vr[2 * it], w1 = vr[2 * it + 1];
            const unsigned a0[4] = {w0.x, w0.y, w0.z, w0.w}, a1[4] = {w1.x, w1.y, w1.z, w1.w};
#pragma unroll
            for (int e = 0; e < 4; ++e) {
                *(LAS unsigned*)(VT + (cg_ * 8 + 2 * e) * 72 + 2 * vkp) = (a0[e] & 0xffffu) | (a1[e] << 16);
                *(LAS unsigned*)(VT + (cg_ * 8 + 2 * e + 1) * 72 + 2 * vkp) = (a0[e] >> 16) | (a1[e] & 0xffff0000u); } }
        asm volatile("s_waitcnt vmcnt(0)" ::: "memory");
        __syncthreads();
        have = false;
        if (blk < 8 && (isP || blk == 7)) { ATT_LOADP(blk + 1, cur ^ 1); have = true; }
#pragma unroll
        for (int hh = 0; hh < 3; ++hh) {
            const int h = hbase + hh;
            f32x4 s[4]; float mx = -1e30f;
#pragma unroll
            for (int kt = 0; kt < 4; ++kt) {
                f32x4 a = (f32x4){0.f, 0.f, 0.f, 0.f};
#pragma unroll
                for (int ks = 0; ks < 2; ++ks) a = MFMA16(ldsfrag((LAS const unsigned char*)(Kc + (kt * 16 + fr) * 768 + (((h * 8 + ks * 4 + fq) ^ fr) * 16))), qf[hh][ks], a);
                if (blk <= 5) { const float bc = bias[h * 192 + 191];
#pragma unroll
                    for (int j = 0; j < 4; ++j) { a[j] = a[j] * 0.125f + bc; mx = fmaxf(mx, a[j]); } }
                else {
#pragma unroll
                    for (int j = 0; j < 4; ++j) {
                        int rel = (qt * 16 + fr) + 512 - (blk * 64 + kt * 16 + fq * 4 + j); rel = rel > 128 ? 128 : rel;
                        a[j] = a[j] * 0.125f + bias[h * 192 + rel + 63]; mx = fmaxf(mx, a[j]);
                    } }
                s[kt] = a;
            }
            mx = fmaxf(mx, __shfl_xor(mx, 16)); mx = fmaxf(mx, __shfl_xor(mx, 32));
            const float mnew = fmaxf(mrun[hh], mx), fac = __expf(mrun[hh] - mnew); mrun[hh] = mnew;
            float rs = 0.f;
#pragma unroll
            for (int kt = 0; kt < 4; ++kt)
#pragma unroll
                for (int j = 0; j < 4; ++j) { s[kt][j] = __expf(s[kt][j] - mnew); rs += s[kt][j]; }
            lrun[hh] = lrun[hh] * fac + rs;
#pragma unroll
            for (int d = 0; d < 4; ++d) O[hh][d] *= fac;
#pragma unroll
            for (int ks = 0; ks < 2; ++ks) {
                const u32x2 pa = pack4(s[2 * ks]), pb = pack4(s[2 * ks + 1]);
                const bf16x8 pf = __builtin_bit_cast(bf16x8, (u32x4){pa.x, pa.y, pb.x, pb.y});
#pragma unroll
                for (int d = 0; d < 4; ++d) {
                    const LAS bf16_t* vrow = VT + (h * 64 + d * 16 + fr) * 72 + ks * 32 + fq * 4;
                    const u32x2 va = *(const LAS u32x2*)vrow, vb = *(const LAS u32x2*)(vrow + 16);
                    O[hh][d] = MFMA16(__builtin_bit_cast(bf16x8, (u32x4){va.x, va.y, vb.x, vb.y}), pf, O[hh][d]);
                }
            }
        }
        cur ^= 1;
    }
#pragma unroll
    for (int hh = 0; hh < 3; ++hh) { lrun[hh] += __shfl_xor(lrun[hh], 16); lrun[hh] += __shfl_xor(lrun[hh], 32); }
    float sq = 0.f;
#pragma unroll
    for (int hh = 0; hh < 3; ++hh) { const float inv = 1.0f / lrun[hh];
#pragma unroll
        for (int d = 0; d < 4; ++d) { O[hh][d] *= inv; const f32x4 o = O[hh][d]; sq += (o[0] * o[0] + o[1] * o[1]) + (o[2] * o[2] + o[3] * o[3]); } }
    sq += __shfl_xor(sq, 16); sq += __shfl_xor(sq, 32);
    if (fq == 0) ssq[(wid >> 2) * 64 + qt * 16 + fr] = sq;
    __syncthreads();
    const float rstd = 1.0f / sqrtf((ssq[qt * 16 + fr] + ssq[64 + qt * 16 + fr]) * (1.0f / 384.0f) + RMS_EPS);
    bf16_t* mix = (bf16_t*)(p.ws + W_MIX);
#pragma unroll
    for (int hh = 0; hh < 3; ++hh)
#pragma unroll
        for (int d = 0; d < 4; ++d) {
            const int col = (hbase + hh) * 64 + d * 16 + fq * 4;
            const f32x4 gv = *(const f32x4*)(p.in[18] + (size_t)l * 1024 + col);
            *(u32x2*)(mix + (size_t)(R0 + qt * 16 + fr) * DM + col) = pack4(O[hh][d] * rstd * gv);
        }
}

__device__ __forceinline__ void ssd_y(KP& p, LAS unsigned char* lds, int l, int u) {
    int tid_ = threadIdx.x; asm volatile("" : "+v"(tid_));
    const int tid = tid_, wid = tid >> 6, lane = tid & 63, fr = lane & 15, fq = lane >> 4;
    LAS bf16_t* Cn = (LAS bf16_t*)lds;
    LAS bf16_t* Bn = (LAS bf16_t*)(lds + 17408);
    LAS bf16_t* xT = (LAS bf16_t*)(lds + 34816);
    LAS bf16_t* Mm = (LAS bf16_t*)(lds + 62464);
    LAS float* dtl = (LAS float*)(lds + 90112);
    LAS float* acl = (LAS float*)(lds + 90880);
    LAS float* ssq = (LAS float*)(lds + 91648);
    LAS bf16_t* HPl = (LAS bf16_t*)(lds + 92160);
    const bf16_t* proj = (const bf16_t*)(p.ws + W_PROJ);
    const bf16_t* HP = (const bf16_t*)(p.ws + W_ST);
    const bf16_t* XC = (const bf16_t*)p.out + (size_t)(u * 64) * 896;
    const int R0 = u * 64, lt = wid & 3;
    f32x4 yacc[2][6];
#pragma unroll
    for (int g = 0; g < 2; ++g) {
        __syncthreads();
        if (wid < 3) { float dt, ac, last; dt_scan(p, l, u, g, wid, lane, dt, ac, last); dtl[wid * 64 + lane] = dt; acl[wid * 64 + lane] = ac; }
#pragma unroll
        for (int it = 0; it < 4; ++it) {
            const int idx = it * 512 + tid, mat = idx >> 10, i = (idx >> 4) & 63, c8 = idx & 15;
            const u32x4 w = *(const u32x4*)(XC + (size_t)i * 896 + 384 + mat * 256 + g * 128 + c8 * 8);
            *(LAS u32x4*)((mat ? Cn : Bn) + i * 136 + c8 * 8) = w;
        }
#pragma unroll
        for (int it = 0; it < 6; ++it) {
            const int idx = it * 512 + tid, r_ = idx >> 4, c8 = idx & 15;
            *(LAS u32x4*)(HPl + r_ * 136 + c8 * 8) = *(const u32x4*)(HP + ((size_t)(u * 6 + g * 3) * 64 + r_) * 128 + c8 * 8);
        }
#pragma unroll
        for (int it = 0; it < 3; ++it) {
            const int idx = it * 512 + tid, c4 = idx % 48, i = (idx / 48) * 2;
            const u32x2 wa = *(const u32x2*)(XC + (size_t)i * 896 + g * 192 + c4 * 4), wb = *(const u32x2*)(XC + (size_t)(i + 1) * 896 + g * 192 + c4 * 4);
            *(LAS unsigned*)(xT + (c4 * 4 + 0) * 72 + i) = (wa.x & 0xffffu) | (wb.x << 16);
            *(LAS unsigned*)(xT + (c4 * 4 + 1) * 72 + i) = (wa.x >> 16) | (wb.x & 0xffff0000u);
            *(LAS unsigned*)(xT + (c4 * 4 + 2) * 72 + i) = (wa.y & 0xffffu) | (wb.y << 16);
            *(LAS unsigned*)(xT + (c4 * 4 + 3) * 72 + i) = (wa.y >> 16) | (wb.y & 0xffff0000u);
        }
        __syncthreads();
#pragma unroll
        for (int k = 0; k < 2; ++k) {
            const int st = (wid >> 2) * 2 + k;
            f32x4 a = (f32x4){0.f, 0.f, 0.f, 0.f};
#pragma unroll
            for (int ks = 0; ks < 4; ++ks) a = MFMA16(ldsfrag((LAS const unsigned char*)(Bn + (st * 16 + fr) * 136 + ks * 32 + fq * 8)), ldsfrag((LAS const unsigned char*)(Cn + (lt * 16 + fr) * 136 + ks * 32 + fq * 8)), a);
            const int li = lt * 16 + fr;
#pragma unroll
            for (int hh = 0; hh < 3; ++hh) {
                const float al = acl[hh * 64 + li]; f32x4 mv;
#pragma unroll
                for (int j = 0; j < 4; ++j) { const int si = st * 16 + fq * 4 + j; mv[j] = si <= li ? a[j] * __expf(al - acl[hh * 64 + si]) * dtl[hh * 64 + si] : 0.f; }
                *(LAS u32x2*)(Mm + (hh * 64 + li) * 72 + st * 16 + fq * 4) = pack4(mv);
            }
        }
        __syncthreads();
#pragma unroll
        for (int k = 0; k < 6; ++k) {
            const int ctile = (wid >> 2) * 6 + k, hh = ctile >> 2, pt = ctile & 3, h = g * 3 + hh, li = lt * 16 + fr;
            f32x4 ad = (f32x4){0.f, 0.f, 0.f, 0.f}, ao = (f32x4){0.f, 0.f, 0.f, 0.f};
#pragma unroll
            for (int ks = 0; ks < 2; ++ks) ad = MFMA16(ldsfrag((LAS const unsigned char*)(xT + (hh * 64 + pt * 16 + fr) * 72 + ks * 32 + fq * 8)), ldsfrag((LAS const unsigned char*)(Mm + (hh * 64 + li) * 72 + ks * 32 + fq * 8)), ad);
#pragma unroll
            for (int ks = 0; ks < 4; ++ks) ao = MFMA16(ldsfrag((LAS const unsigned char*)(HPl + (hh * 64 + pt * 16 + fr) * 136 + ks * 32 + fq * 8)), ldsfrag((LAS const unsigned char*)(Cn + li * 136 + ks * 32 + fq * 8)), ao);
            const float ea = __expf(acl[hh * 64 + li]), dsk = p.in[15][l * 6 + h];
            const f32x4 xv = unpack4(*(const u32x2*)(XC + (size_t)li * 896 + h * 64 + pt * 16 + fq * 4));
            const f32x4 zv = unpack4(*(const u32x2*)(proj + (size_t)(R0 + li) * NPROJ + C_Z + h * 64 + pt * 16 + fq * 4));
            f32x4 y = ad + ao * ea + xv * dsk;
#pragma unroll
            for (int j = 0; j < 4; ++j) y[j] *= silu_f(zv[j]);
            yacc[g][k] = y;
            asm volatile("" ::: "memory");
        }
    }
    float sq = 0.f;
#pragma unroll
    for (int g = 0; g < 2; ++g)
#pragma unroll
        for (int k = 0; k < 6; ++k) { const f32x4 o = yacc[g][k]; sq += (o[0] * o[0] + o[1] * o[1]) + (o[2] * o[2] + o[3] * o[3]); }
    sq += __shfl_xor(sq, 16); sq += __shfl_xor(sq, 32);
    if (fq == 0) ssq[(wid >> 2) * 64 + lt * 16 + fr] = sq;
    __syncthreads();
    const float rstd = 1.0f / sqrtf((ssq[lt * 16 + fr] + ssq[64 + lt * 16 + fr]) * (1.0f / 384.0f) + RMS_EPS);
    bf16_t* mix = (bf16_t*)(p.ws + W_MIX);
#pragma unroll
    for (int g = 0; g < 2; ++g)
#pragma unroll
        for (int k = 0; k < 6; ++k) {
            const int col = 384 + g * 192 + ((wid >> 2) * 6 + k) * 16 + fq * 4;
            const f32x4 gv = *(const f32x4*)(p.in[18] + (size_t)l * 1024 + col);
            *(u32x2*)(mix + (size_t)(R0 + lt * 16 + fr) * DM + col) = pack4(yacc[g][k] * rstd * gv);
        }
}

__device__ __forceinline__ void phase_fix(KP& p, int l) {
    const float* halo = (const float*)(p.ws + W_MIX); bf16_t* H = (bf16_t*)(p.ws + W_PROJ);
    const float* w = p.in[23] + (size_t)l * 3 * DFF2; const float* bb = p.in[24] + (size_t)l * DFF2;
    int tid_ = threadIdx.x; asm volatile("" : "+v"(tid_));
    for (int i = blockIdx.x * 512 + tid_; i < 128 * DFF2; i += gridDim.x * 512) {
        const int pm = i / DFF2, cc = i % DFF2;
        if ((pm & 31) == 0 || cc >= DFF) continue;
        const float* h0 = halo + (size_t)(pm - 1) * 4 * DFF2; const float* h1 = halo + (size_t)pm * 4 * DFF2;
        float r[2];
#pragma unroll
        for (int rr = 0; rr < 2; ++rr) {
            float o[2];
#pragma unroll
            for (int gv = 0; gv < 2; ++gv) {
                const int c2 = cc + gv * DFF;
                const float xm2 = h0[2 * DFF2 + c2], xm1 = h0[3 * DFF2 + c2], x0 = h1[c2], x1 = h1[DFF2 + c2];
                o[gv] = rr == 0 ? bb[c2] + w[c2] * xm2 + w[DFF2 + c2] * xm1 + w[2 * DFF2 + c2] * x0 : bb[c2] + w[c2] * xm1 + w[DFF2 + c2] * x0 + w[2 * DFF2 + c2] * x1;
            }
            r[rr] = silu_f(o[0]) * o[1];
        }
        H[((size_t)pm * 256) * DFF + cc] = (bf16_t)(cvt_pk_bf16(r[0], 0.f) & 0xffffu);
        H[((size_t)pm * 256 + 1) * DFF + cc] = (bf16_t)(cvt_pk_bf16(r[1], 0.f) & 0xffffu);
    }
}

#define XB_TMO      128
#define XB_XCNT(j)  (256  + 64 * (j))
#define XB_XSUB(j)  (1280 + 64 * (j))
#define XB_XGEN(j)  (2304 + 64 * (j))
#define XB_TOP      3328
#define XB_TOPGEN   3392
#define XCD_BAR_WORDS 3456
#define XB_SPIN_CAP (1u << 18)

__device__ __forceinline__ unsigned xb_ld(unsigned* p)              { return __hip_atomic_load(p, __ATOMIC_RELAXED, __HIP_MEMORY_SCOPE_AGENT); }
__device__ __forceinline__ unsigned xb_add(unsigned* p, unsigned v) { return __hip_atomic_fetch_add(p, v, __ATOMIC_RELAXED, __HIP_MEMORY_SCOPE_AGENT); }
__device__ __forceinline__ unsigned xb_xcc_id() { return (unsigned)__builtin_amdgcn_s_getreg((3 << 11) | 20) & 0xFu; }
#define XB_SPIN(cond, bar) do { unsigned _sp = 0; while (cond) { __builtin_amdgcn_s_sleep(1); \
    if ((++_sp & 255u) == 0u) { if (xb_ld(&(bar)[XB_TMO])) break; if (_sp > XB_SPIN_CAP) { atomicAdd(&(bar)[XB_TMO], 1u); break; } } } } while (0)

struct XcdBarrier {
    unsigned* bar; unsigned x;
    volatile LAS unsigned* st;
};

__device__ __forceinline__ XcdBarrier xcd_barrier_post(unsigned* bar, volatile LAS unsigned* st) {
    XcdBarrier b; b.bar = bar; b.x = xb_xcc_id(); b.st = st;
    if (threadIdx.x == 0) (void)xb_add(&bar[XB_XCNT(b.x)], 1u);
    return b;
}
__device__ __forceinline__ void xcd_barrier_complete(unsigned* bar, unsigned x, unsigned& nloc, unsigned& nx) {
    const unsigned G = gridDim.x * gridDim.y * gridDim.z;
    unsigned sum, cnt, mine, sp = 0u;
    for (;;) {
        sum = 0u; cnt = 0u; mine = 0u;
#pragma unroll
        for (unsigned j = 0; j < 16; ++j) { const unsigned c = xb_ld(&bar[XB_XCNT(j)]); sum += c; cnt += (c > 0u) ? 1u : 0u; mine = (j == x) ? c : mine; }
        if (sum == G) break;
        __builtin_amdgcn_s_sleep(1);
        if ((++sp & 255u) == 0u) { if (xb_ld(&bar[XB_TMO])) break; if (sp > XB_SPIN_CAP) { atomicAdd(&bar[XB_TMO], 1u); break; } }
    }
    nloc = mine > 0u ? mine : 1u; nx = cnt > 0u ? cnt : 1u;
}

__device__ __forceinline__ void xcd_barrier(const XcdBarrier& b) {
    asm volatile("s_waitcnt vmcnt(0)" ::: "memory");
    __syncthreads();
    if (threadIdx.x == 0) {
        unsigned* bar = b.bar;
        __builtin_amdgcn_s_waitcnt(0);
        unsigned nloc = b.st[0], nx = b.st[1];
        if (nloc == 0u) { xcd_barrier_complete(bar, b.x, nloc, nx); b.st[0] = nloc; b.st[1] = nx; }
        const unsigned old = xb_add(&bar[XB_XSUB(b.x)], 1u);
        const unsigned gen = old / nloc;
        if (old + 1u == (gen + 1u) * nloc) {
            __builtin_amdgcn_fence(__ATOMIC_RELEASE, "agent");
            asm volatile("s_waitcnt vmcnt(0)" ::: "memory");
            const unsigned og = xb_add(&bar[XB_TOP], 1u);
            const unsigned tg = og / nx;
            if (og + 1u == (tg + 1u) * nx) xb_add(&bar[XB_TOPGEN], 1u);
            else XB_SPIN(xb_ld(&bar[XB_TOPGEN]) == tg, bar);
            __builtin_amdgcn_fence(__ATOMIC_ACQUIRE, "agent");
            xb_add(&bar[XB_XGEN(b.x)], 1u);
            asm volatile("s_waitcnt vmcnt(0)" ::: "memory");
        } else {
            XB_SPIN(xb_ld(&bar[XB_XGEN(b.x)]) == gen, bar);
            __builtin_amdgcn_fence(__ATOMIC_ACQUIRE, "agent");
            asm volatile("s_waitcnt vmcnt(0)" ::: "memory");
        }
    }
    __syncthreads();
}

__global__ void __launch_bounds__(512, 2) mega(Params pa) {
    extern __shared__ __attribute__((aligned(16))) unsigned char shm[];
    LAS unsigned char* lds = (LAS unsigned char*)shm;
    const int G = gridDim.x, bid = blockIdx.x;
    KP* pk = (KP*)__builtin_amdgcn_kernarg_segment_ptr();
    volatile LAS unsigned* bst = (volatile LAS unsigned*)(lds + LDS_BYTES - 16);
    XcdBarrier xb; xb.bar = nullptr; xb.x = 0; xb.st = bst;
    if (pa.coop) { if (threadIdx.x < 2) bst[threadIdx.x] = 0u; __syncthreads(); xb = xcd_barrier_post((unsigned*)(pa.ws + W_BAR), bst); }
    for (int ph = pa.ph_lo; ph < pa.ph_hi; ++ph) {
        if (ph > pa.ph_lo && pa.coop) { if (pa.pad == 0x5a5a) { __threadfence(); cg::this_grid().sync(); } else xcd_barrier(xb); }
        asm volatile("" : "+s"(pk)); KP& p = *pk;
        if (ph == 0) { phase_prep(p, lds); continue; }
        if (ph == 42) { int tq = threadIdx.x; asm volatile("" : "+v"(tq)); const unsigned short* w16 = (const unsigned short*)p.ws; for (size_t i = (size_t)bid * 512 + tq; i < (size_t)59418624; i += (size_t)G * 512) p.out[i] = (float)w16[i * 4]; continue; }
        if (ph == 41) { int tq = threadIdx.x; asm volatile("" : "+v"(tq)); for (size_t i = (size_t)bid * 512 + tq; i < (size_t)59418624; i += (size_t)G * 512) { const float v = p.out[i]; if (!(fabsf(v) < 1e30f)) p.out[i] = 0.f; } continue; }
        const int l = (ph - 1) / 10, k = (ph - 1) % 10;
        bf16_t* XB = (bf16_t*)(p.ws + W_XB);
        switch (k) {
        case 0: if (REP_G1 > 1) { pg8::StaticOrder S; S.init(T_ALL, NPROJ, G, bid); EpiNull E{(float*)(p.ws + W_CD)};
                  pg8::gemm_phase(lds, pg8::Gemm{XB, (const bf16_t*)(p.ws + W_IN + l * W_IN_L), T_ALL, NPROJ, DM}, S, E); }
                { if ((bid >> 3) & 1) { __builtin_amdgcn_s_sleep(127); __builtin_amdgcn_s_sleep(127); __builtin_amdgcn_s_sleep(127); }
                  pg8::StaticOrder S; S.init(T_ALL, NPROJ, G, bid);
                  EpiIn E{(bf16_t*)(p.ws + W_PROJ), p.out, (float*)(p.ws + W_DTB), p.in[13], l};
                  pg8::gemm_phase(lds, pg8::Gemm{XB, (const bf16_t*)(p.ws + W_IN + l * W_IN_L), T_ALL, NPROJ, DM}, S, E); } break;
        case 1: {
                  unsigned* qctr = (unsigned*)(p.ws + W_BAR + 14336) + l * 64;
                  volatile LAS int* qslot = (volatile LAS int*)(lds + LDS_BYTES - 32);
                  for (;;) {
                      __syncthreads();
                      if (threadIdx.x == 0) qslot[0] = (int)__hip_atomic_fetch_add(qctr, 1u, __ATOMIC_RELAXED, __HIP_MEMORY_SCOPE_AGENT);
                      __syncthreads();
                      const int it = qslot[0];
                      if (it >= 2 * NU64) break;
                      if (it < NU64) attn_unit(p, lds, l, NU64 - 1 - it); else ssd_states(p, lds, l, it - NU64);
                  } } break;
        case 2: for (int it = bid; it < 96 + 768; it += G) { if (it < 96) scan_prompt(p, l, it); else scan_sample(p, l, it - 96); } break;
        case 3: {
                  unsigned* qctr = (unsigned*)(p.ws + W_BAR + 14336) + l * 64 + 32;
                  volatile LAS int* qslot = (volatile LAS int*)(lds + LDS_BYTES - 32);
                  for (;;) {
                      __syncthreads();
                      if (threadIdx.x == 0) qslot[0] = (int)__hip_atomic_fetch_add(qctr, 1u, __ATOMIC_RELAXED, __HIP_MEMORY_SCOPE_AGENT);
                      __syncthreads();
                      const int it = qslot[0];
                      if (it >= 2 * NU64) break;
                      if (it < NU64) ssd_y(p, lds, l, it); else gmlp_unit(p, lds, l, it - NU64);
                  } } break;
        case 4: { pg8::StaticOrder S; S.init(T_ALL, DM, G, bid); EpiRes E{p.out, XB, (bf16_t*)p.out};
                  pg8::gemm_phase(lds, pg8::Gemm{(const bf16_t*)(p.ws + W_MIX), (const bf16_t*)(p.ws + W_OUT + l * W_OUT_L), T_ALL, DM, DM}, S, E); } break;
        case 5: phase_ln(p, (const bf16_t*)p.out, p.in[20] + l * DM, p.in[21] + l * DM, false); break;
        case 6: for (int rep = 0; rep < REP_G3; ++rep) { pg8::StaticOrder S; S.init(T_ALL, DFF2, G, bid);
                  EpiUp E{(bf16_t*)(p.ws + W_PROJ), (float*)(p.ws + W_MIX), p.out, p.in[23], p.in[24], p.in[6], l};
                  pg8::OneUnit o1;
                  for (int i = 0; S.next(i, o1.u); ++i) { pg8::gemm_phase(lds, pg8::Gemm{XB, (const bf16_t*)(p.ws + W_UP + l * W_UP_L), T_ALL, DFF2, DM}, o1, E); __syncthreads(); } } break;
        case 7: phase_fix(p, l); break;
        case 8: { pg8::StaticOrder S; S.init(T_ALL, DM, G, bid); EpiRes E{p.out, XB, (bf16_t*)(p.ws + W_MIX)};
                  pg8::gemm_phase(lds, pg8::Gemm{(const bf16_t*)(p.ws + W_PROJ), (const bf16_t*)(p.ws + W_DN + l * W_DN_L), T_ALL, DM, DFF}, S, E); } break;
        case 9: phase_ln(p, (const bf16_t*)(p.ws + W_MIX), p.in[26] + l * DM, p.in[27] + l * DM, l == DEPTH - 1); break;
        }
    }
}

constexpr int N_PHASES = 41;
#ifndef MULTI_LAUNCH
#define MULTI_LAUNCH 0
#endif

extern "C" void kernel_launch(void* const* d_in, const int* in_sizes, int n_in, void* d_out, int out_size, void* d_ws, size_t ws_size, hipStream_t stream) {
    static int grid = 0;
    if (grid == 0) {
        if (n_in != 28 || ws_size < W_END2) { fprintf(stderr, "kernel_launch: need 28 inputs and %zu bytes of workspace (got %d, %zu)\n", (size_t)W_END2, n_in, ws_size); grid = -1; return; }
        int dev = 0, cus = 0, per_cu = 0;
        hipGetDevice(&dev); hipDeviceGetAttribute(&cus, hipDeviceAttributeMultiprocessorCount, dev);
        if (hipFuncSetAttribute((const void*)mega, hipFuncAttributeMaxDynamicSharedMemorySize, LDS_BYTES) != hipSuccess) { fprintf(stderr, "kernel_launch: hipFuncSetAttribute failed\n"); grid = -1; return; }
        hipOccupancyMaxActiveBlocksPerMultiprocessor(&per_cu, (const void*)mega, 512, LDS_BYTES);
        (void)hipGetLastError();
        if (per_cu < 1) per_cu = 1;
        grid = cus * 1;
    }
    if (grid < 0) return;
    Params p{};
    for (int i = 0; i < 28; ++i) p.in[i] = (const float*)d_in[i];
    p.out = (float*)d_out; p.ws = (unsigned char*)d_ws;
#if MULTI_LAUNCH
#ifdef PROBE_CUT
    for (int ph = 0; ph < PROBE_CUT; ++ph) { p.ph_lo = ph; p.ph_hi = ph + 1; p.coop = 0; hipLaunchKernelGGL(mega, dim3(grid), dim3(512), LDS_BYTES, stream, p); }
    p.ph_lo = 42; p.ph_hi = 43; p.coop = 0; hipLaunchKernelGGL(mega, dim3(grid), dim3(512), LDS_BYTES, stream, p);
#else
    for (int ph = 0; ph < N_PHASES; ++ph) { p.ph_lo = ph; p.ph_hi = ph + 1; p.coop = 0; hipLaunchKernelGGL(mega, dim3(grid), dim3(512), LDS_BYTES, stream, p); }
#endif
#else
    p.ph_lo = 0; p.ph_hi = N_PHASES; p.coop = 1;
    if (hipMemsetAsync((char*)d_ws + W_BAR, 0, 16384, stream) != hipSuccess) { fprintf(stderr, "kernel_launch: memset failed\n"); return; }
    void* args[] = {&p};
    hipError_t e = hipLaunchCooperativeKernel((const void*)mega, dim3(grid), dim3(512), args, LDS_BYTES, stream);
    if (e != hipSuccess) fprintf(stderr, "cooperative launch failed: %s (grid %d)\n", hipGetErrorString(e), grid);
#endif
}
```

```cpp
#define REP_G1 1
#define REP_M1 1
#define REP_ATT 1
#define REP_M3 1
#define REP_G3 1
#include <hip/hip_runtime.h>
#include <hip/hip_cooperative_groups.h>
#include <cstdio>
namespace cg = cooperative_groups;

#define LAS __attribute__((address_space(3)))
typedef unsigned short bf16_t;
typedef short bf16x8 __attribute__((ext_vector_type(8)));
typedef float f32x4 __attribute__((ext_vector_type(4)));
typedef float f32x2 __attribute__((ext_vector_type(2)));
typedef unsigned u32x4 __attribute__((ext_vector_type(4)));
typedef unsigned u32x2 __attribute__((ext_vector_type(2)));

constexpr int T_ALL = 34816, T_P = 32768, DM = 1024, NPROJ = 3072, DFF = 2816, DFF2 = 5632, DEPTH = 4;
constexpr int NU64 = 544;
constexpr float ALPHA = 1.6817928305074290f;
constexpr float LN_EPS = 1e-5f, RMS_EPS = 1e-5f;
constexpr int C_K = 384, C_V = 768, C_Z = 1152, C_XBC = 1536, C_U = 2432, C_VC = 2688, C_DT = 2944;
constexpr size_t O_YP = 0, O_YS = 33554432, O_PK = 35651584, O_PV = O_PK + 3145728, O_PH = O_PV + 3145728, O_PC = O_PH + 786432,
                 O_PF = O_PC + 43008, O_SK = O_PF + 180224, O_SV = O_SK + 3145728, O_SH = O_SV + 3145728, O_SC = O_SH + 6291456,
                 O_SG = O_SC + 344064, O_SF = O_SG + 2097152;
constexpr size_t W_IN = 0, W_IN_L = (size_t)NPROJ * DM * 2;
constexpr size_t W_OUT = W_IN + 4 * W_IN_L, W_OUT_L = (size_t)DM * DM * 2;
constexpr size_t W_UP = W_OUT + 4 * W_OUT_L, W_UP_L = (size_t)DFF2 * DM * 2;
constexpr size_t W_DN = W_UP + 4 * W_UP_L, W_DN_L = (size_t)DM * DFF * 2;
constexpr size_t W_GW = W_DN + 4 * W_DN_L, W_GW_L = (size_t)4 * 128 * 128 * 2;
constexpr size_t W_XB = W_GW + 4 * W_GW_L;
constexpr size_t W_PROJ = W_XB + (size_t)T_ALL * DM * 2;
constexpr size_t W_MIX = W_PROJ + (size_t)T_ALL * NPROJ * 2;
constexpr size_t W_ST = W_MIX + (size_t)T_ALL * DM * 2;
constexpr size_t W_CD = W_ST + (size_t)NU64 * 6 * 8192 * 2;
constexpr size_t W_DTB = W_CD + (size_t)NU64 * 8 * 4;
constexpr size_t W_END = W_DTB + (size_t)T_ALL * 8 * 4;
constexpr size_t W_BAR = W_END;
constexpr size_t W_END2 = W_BAR + 16384;
constexpr int LDS_BYTES = 156 * 1024;

struct Params { const float* in[28]; float* out; unsigned char* ws; int ph_lo, ph_hi, coop, pad; };
typedef const __attribute__((address_space(4))) Params KP;

__device__ __forceinline__ float bf2f(unsigned b) { return __uint_as_float(b << 16); }
typedef __bf16 bf16v2 __attribute__((ext_vector_type(2)));
__device__ __forceinline__ unsigned cvt_pk_bf16(float lo, float hi) { const f32x2 v = {lo, hi}; const bf16v2 b = __builtin_convertvector(v, bf16v2); return __builtin_bit_cast(unsigned, b); }
__device__ __forceinline__ u32x2 pack4(f32x4 v) { u32x2 w; w.x = cvt_pk_bf16(v[0], v[1]); w.y = cvt_pk_bf16(v[2], v[3]); return w; }
__device__ __forceinline__ f32x4 unpack4(u32x2 w) { f32x4 v; v[0] = bf2f(w.x & 0xffffu); v[1] = bf2f(w.x >> 16); v[2] = bf2f(w.y & 0xffffu); v[3] = bf2f(w.y >> 16); return v; }
__device__ __forceinline__ float silu_f(float x) { return x * __builtin_amdgcn_rcpf(1.0f + __expf(-x)); }
__device__ __forceinline__ float gelu_tanh(float x) { const float y = 0.7978845608028654f * (x + 0.044715f * x * x * x); const float e = __expf(2.0f * y); return 0.5f * x * (2.0f - 2.0f * __builtin_amdgcn_rcpf(1.0f + e)); }
__device__ __forceinline__ float softplus_f(float x) { const float e = __expf(x); return x > 15.0f ? x : (e < 1e-3f ? e * (1.0f - 0.5f * e + 0.33333333f * e * e) : __logf(1.0f + e)); }
#define MFMA16(colfrag, rowfrag, acc) __builtin_amdgcn_mfma_f32_16x16x32_bf16((colfrag), (rowfrag), (acc), 0, 0, 0)
__device__ __forceinline__ bf16x8 ldsfrag(LAS const unsigned char* p) { return *(LAS const bf16x8*)p; }
__device__ __forceinline__ bf16x8 glbfrag(const bf16_t* p) { return *(const bf16x8*)p; }
#define LDS_WAVE_SYNC() asm volatile("s_waitcnt lgkmcnt(0)" ::: "memory")

namespace pg8 {
constexpr int BM = 256, BK = 64, HALF = 128, HTB = HALF * BK * 2, STAGE_BYTES = 8 * HTB, NXCD = 8, WGM = 16;
__device__ __forceinline__ int lds_byte(int r, int c) { const int st = (r >> 4) * 2 + (c >> 5), rr = r & 15, cc = c & 31, ob = rr * 64 + cc * 2; return st * 1024 + (ob ^ (((ob >> 9) & 1) << 5)); }
__device__ __forceinline__ void stage_rc(int b, int& R, int& C) { const int st = b / 1024, sb = b % 1024, swz = sb ^ (((sb >> 9) & 1) << 5); R = (st >> 1) * 16 + swz / 64; C = (st & 1) * 32 + (swz % 64) / 2; }
__device__ __forceinline__ int perm32(int rho) { const int n = rho >> 4, i = rho & 15; return 8 * (i >> 2) + 4 * n + (i & 3); }
struct Unit { int pm, pn; };
struct Gemm { const bf16_t* A; const bf16_t* Bt; int M, N, K; };
struct StaticOrder {
    int nM, nN, nwg, G, c;
    __device__ __forceinline__ void init(int M, int N, int G_, int c_) { nM = M / BM; nN = N / BM; nwg = nM * nN; G = G_; c = c_; }
    __device__ __forceinline__ bool next(int i, Unit& u) const {
        const long L = (long)i * G + c; if (L >= nwg) return false;
        int wgid = (int)L; { const int q = nwg / NXCD, r = nwg % NXCD, xcd = wgid % NXCD, off = wgid / NXCD; wgid = (xcd < r ? xcd * (q + 1) : r * (q + 1) + (xcd - r) * q) + off; }
        const int nig = WGM * nN, gid = wgid / nig, fm = gid * WGM, gsz = (nM - fm) < WGM ? (nM - fm) : WGM;
        u.pm = fm + ((wgid % nig) % gsz); u.pn = (wgid % nig) / gsz; return true;
    }
    __device__ __forceinline__ void a_ready(const Unit&) const {}
    __device__ __forceinline__ void done(const Unit&) const {}
};
struct OneUnit {
    Unit u;
    __device__ __forceinline__ bool next(int i, Unit& o) const { if (i) return false; o = u; return true; }
    __device__ __forceinline__ void a_ready(const Unit&) const {}
    __device__ __forceinline__ void done(const Unit&) const {}
};

template <class Epi, class Sched>
__device__ __forceinline__ void gemm_phase(LAS unsigned char* lds, const Gemm g, const Sched& S, const Epi& E) {
    int tid_ = threadIdx.x; asm volatile("" : "+v"(tid_));
    const int tid = tid_, wid = __builtin_amdgcn_readfirstlane(tid >> 6), lane = tid & 63, wr = wid >> 2, wc = wid & 3, fr = lane & 15, fq = lane >> 4;
    const int K = g.K, nt = K / BK;
    unsigned voffA[2], voffB[2];
#pragma unroll
    for (int i = 0; i < 2; ++i) { int R, C; stage_rc(tid * 16 + i * 8192, R, C); const int Rb = (R & ~31) + perm32(R & 31); voffA[i] = (unsigned)(R * K + C) * 2u; voffB[i] = (unsigned)(Rb * K + C) * 2u; }
    const size_t kstep = (size_t)(BK * 2);
    const size_t hstep = (size_t)HALF * K * 2;
    const size_t tstep = 2 * hstep;
    const unsigned ldsw = (unsigned)wid * 1024u;
    const int aoff = lds_byte(wr * 64 + fr, fq * 8), boff = lds_byte(wc * 32 + fr, fq * 8);
#define PG8_SA(b, h) (((b) * 2 + (h)) * HTB)
#define PG8_SB(b, h) ((4 + (b) * 2 + (h)) * HTB)
#define PG8_STAGE(bufoff, gbase, voff) do { _Pragma("unroll") for (int _i = 0; _i < 2; ++_i) \
        __builtin_amdgcn_global_load_lds((const unsigned*)((const char*)(gbase) + (voff)[_i]), (LAS unsigned*)(lds + (bufoff) + ldsw + _i * 8192), 16, 0, 0); } while (0)
#define PG8_LDA(dst, b, h) do { _Pragma("unroll") for (int m = 0; m < 4; ++m) _Pragma("unroll") for (int k = 0; k < 2; ++k) dst[m][k] = *(const LAS bf16x8*)(lds + PG8_SA(b, h) + aoff + m * 2048 + k * 1024); } while (0)
#define PG8_LDB(dst, b, h) do { _Pragma("unroll") for (int n = 0; n < 2; ++n) _Pragma("unroll") for (int k = 0; k < 2; ++k) dst[n][k] = *(const LAS bf16x8*)(lds + PG8_SB(b, h) + boff + n * 2048 + k * 1024); } while (0)
#define PG8_MMA(ai, bj, At, Bt) do { __builtin_amdgcn_s_setprio(1); _Pragma("unroll") for (int m = 0; m < 4; ++m) _Pragma("unroll") for (int n = 0; n < 2; ++n) _Pragma("unroll") for (int k = 0; k < 2; ++k) \
        acc[ai][bj][m][n] = __builtin_amdgcn_mfma_f32_16x16x32_bf16(Bt[n][k], At[m][k], acc[ai][bj][m][n], 0, 0, 0); __builtin_amdgcn_s_setprio(0); } while (0)
#define PG8_WAIT_V(n) asm volatile("s_waitcnt vmcnt(" #n ")" ::: "memory")
#define PG8_WAIT_L(n) asm volatile("s_waitcnt lgkmcnt(" #n ")" ::: "memory")
#define PG8_BAR __builtin_amdgcn_s_barrier()
#define PG8_SCHED __builtin_amdgcn_sched_barrier(0)
    Unit cur, nxt; int ui = 0;
    if (!S.next(0, cur)) return;
    f32x4 acc[2][2][4][2];
#pragma unroll
    for (int a = 0; a < 2; ++a)
#pragma unroll
        for (int b = 0; b < 2; ++b)
#pragma unroll
            for (int m = 0; m < 4; ++m)
#pragma unroll
                for (int n = 0; n < 2; ++n) acc[a][b][m][n] = (f32x4){0.f, 0.f, 0.f, 0.f};
    bf16x8 At[4][2], B0[2][2], B1[2][2];
    const char* cA = (const char*)g.A + (size_t)cur.pm * tstep; const char* cB = (const char*)g.Bt + (size_t)cur.pn * tstep;
    S.a_ready(cur);
    PG8_STAGE(PG8_SB(0, 0), cB, voffB); PG8_STAGE(PG8_SA(0, 0), cA, voffA); PG8_STAGE(PG8_SB(0, 1), cB + hstep, voffB); PG8_STAGE(PG8_SA(0, 1), cA + hstep, voffA);
    if (wr == 1) PG8_BAR;
    PG8_WAIT_V(4); PG8_BAR;
    PG8_STAGE(PG8_SB(1, 0), cB + kstep, voffB); PG8_STAGE(PG8_SA(1, 0), cA + kstep, voffA); PG8_STAGE(PG8_SB(1, 1), cB + hstep + kstep, voffB);
    PG8_WAIT_V(6); PG8_BAR;
    for (;;) {
        const bool has_next = S.next(ui + 1, nxt);
        const char* nA = has_next ? (const char*)g.A + (size_t)nxt.pm * tstep : cA; const char* nB = has_next ? (const char*)g.Bt + (size_t)nxt.pn * tstep : cB;
        for (int t = 0; t < nt; t += 2) {
            const bool last = (t == nt - 2);
            const char* a1 = cA + (size_t)(t + 1) * kstep;
            const char* a2 = last ? nA : cA + (size_t)(t + 2) * kstep; const char* b2 = last ? nB : cB + (size_t)(t + 2) * kstep;
            const char* a3 = a2 + kstep; const char* b3 = b2 + kstep;
            if (last && has_next) S.a_ready(nxt);
            PG8_LDB(B0, 0, 0); PG8_SCHED; PG8_LDA(At, 0, 0); PG8_STAGE(PG8_SA(1, 1), a1 + hstep, voffA);
            PG8_WAIT_L(8); PG8_BAR; PG8_WAIT_L(0); PG8_MMA(0, 0, At, B0); PG8_BAR; PG8_SCHED;
            PG8_LDB(B1, 0, 1); PG8_STAGE(PG8_SB(0, 0), b2, voffB);
            PG8_BAR; PG8_WAIT_L(0); PG8_MMA(0, 1, At, B1); PG8_BAR;
            PG8_LDA(At, 0, 1); PG8_STAGE(PG8_SA(0, 0), a2, voffA);
            PG8_BAR; PG8_WAIT_L(0); PG8_MMA(1, 0, At, B0); PG8_BAR; PG8_SCHED;
            PG8_STAGE(PG8_SB(0, 1), b2 + hstep, voffB);
            PG8_WAIT_V(6); PG8_BAR; PG8_MMA(1, 1, At, B1); PG8_BAR;
            PG8_LDB(B0, 1, 0); PG8_SCHED; PG8_LDA(At, 1, 0); PG8_STAGE(PG8_SA(0, 1), a2 + hstep, voffA);
            PG8_WAIT_L(8); PG8_BAR; PG8_WAIT_L(0); PG8_MMA(0, 0, At, B0); PG8_BAR; PG8_SCHED;
            PG8_LDB(B1, 1, 1); PG8_STAGE(PG8_SB(1, 0), b3, voffB);
            PG8_BAR; PG8_WAIT_L(0); PG8_MMA(0, 1, At, B1); PG8_BAR;
            PG8_LDA(At, 1, 1); PG8_STAGE(PG8_SA(1, 0), a3, voffA);
            PG8_BAR; PG8_WAIT_L(0); PG8_MMA(1, 0, At, B0); PG8_BAR; PG8_SCHED;
            PG8_STAGE(PG8_SB(1, 1), b3 + hstep, voffB);
            PG8_WAIT_V(6); PG8_BAR; PG8_MMA(1, 1, At, B1); PG8_BAR;
        }
        if constexpr (!Epi::AFTER_DRAIN) { E(acc, cur, wr, wc, fr, fq); S.done(cur); }
        if (!has_next) break;
#pragma unroll
        for (int a = 0; a < 2; ++a)
#pragma unroll
            for (int b = 0; b < 2; ++b)
#pragma unroll
                for (int m = 0; m < 4; ++m)
#pragma unroll
                    for (int n = 0; n < 2; ++n) acc[a][b][m][n] = (f32x4){0.f, 0.f, 0.f, 0.f};
        cur = nxt; cA = nA; cB = nB; ++ui;
    }
    PG8_WAIT_V(0);
    if (wr == 0) PG8_BAR;
    PG8_BAR;
    if constexpr (Epi::AFTER_DRAIN) { E.fused(acc, cur, wr, wc, fr, fq, lds, wid, lane); S.done(cur); }
#undef PG8_SA
#undef PG8_SB
#undef PG8_STAGE
#undef PG8_LDA
#undef PG8_LDB
#undef PG8_MMA
#undef PG8_WAIT_V
#undef PG8_WAIT_L
#undef PG8_BAR
#undef PG8_SCHED
}
}
using pg8::Unit;

struct EpiIn {
    static constexpr bool AFTER_DRAIN = false;
    bf16_t* proj; float* out; float* dtb; const float* dt_bias; int l;
    __device__ __forceinline__ void operator()(const f32x4 (&acc)[2][2][4][2], const Unit& u, int wr, int wc, int fr_, int fq_) const {
        int fr = fr_, fq = fq_; asm volatile("" : "+v"(fr), "+v"(fq));
#pragma unroll
        for (int bj = 0; bj < 2; ++bj) {
            const int cb = u.pn * 256 + bj * 128;
            const int col = cb + wc * 32 + fq * 8;
            if (cb > C_DT) continue;
#pragma unroll
            for (int ai = 0; ai < 2; ++ai)
#pragma unroll
                for (int m = 0; m < 4; ++m) {
                    const int row = u.pm * 256 + ai * 128 + wr * 64 + m * 16 + fr;
                    const bool isP = row < T_P; int b, t;
                    if (isP) { b = row >> 13; t = row & 8191; } else { b = (row - T_P) >> 6; t = row & 63; }
                    f32x4 v0 = acc[ai][bj][m][0], v1 = acc[ai][bj][m][1];
                    if (cb < C_U) {
                        u32x4 w; { const u32x2 a = pack4(v0), c = pack4(v1); w.x = a.x; w.y = a.y; w.z = c.x; w.w = c.y; }
                        *(u32x4*)(proj + (size_t)row * NPROJ + col) = w;
                        if (cb >= C_K && cb < C_Z) {
                            const int isv = cb >= C_V; const int cc = col - (isv ? C_V : C_K);
                            float* o = nullptr;
                            if (isP) { if (t >= 7680) o = out + (isv ? O_PV : O_PK) + ((size_t)(l * 4 + b) * 512 + (t - 7680)) * 384 + cc; }
                            else o = out + (isv ? O_SV : O_SK) + ((size_t)(l * 32 + b) * 64 + t) * 384 + cc;
                            if (o) { *(f32x4*)o = v0; *(f32x4*)(o + 4) = v1; }
                        } else if (cb >= C_XBC) {
                            const int cc = col - C_XBC; float* o = nullptr;
                            if (isP) { if (t >= 8189) o = out + O_PC + ((size_t)(l * 4 + b) * 3 + (t - 8189)) * 896 + cc; }
                            else if (t >= 61) o = out + O_SC + ((size_t)(l * 32 + b) * 3 + (t - 61)) * 896 + cc;
                            if (o) { *(f32x4*)o = v0; *(f32x4*)(o + 4) = v1; }
                        }
                    } else if (cb < C_DT) {
#pragma unroll
                        for (int j = 0; j < 4; ++j) { v0[j] = gelu_tanh(v0[j]); v1[j] = gelu_tanh(v1[j]); }
                        u32x4 w; { const u32x2 a = pack4(v0), c = pack4(v1); w.x = a.x; w.y = a.y; w.z = c.x; w.w = c.y; }
                        *(u32x4*)(proj + (size_t)row * NPROJ + col) = w;
                        if (cb >= C_VC && !isP) { float* o = out + O_SG + ((size_t)(l * 32 + b) * 64 + t) * 256 + (col - C_VC); *(f32x4*)o = v0; *(f32x4*)(o + 4) = v1; }
                    } else if (col == C_DT) {
                        float* d = dtb + (size_t)row * 8;
#pragma unroll
                        for (int j = 0; j < 4; ++j) d[j] = softplus_f(v0[j] + dt_bias[l * 6 + j]);
#pragma unroll
                        for (int j = 0; j < 2; ++j) d[4 + j] = softplus_f(v1[j] + dt_bias[l * 6 + 4 + j]);
                    }
                    asm volatile("" ::: "memory");
                }
        }
    }
};
struct EpiNull {
    static constexpr bool AFTER_DRAIN = false;
    float* sink;
    __device__ __forceinline__ void operator()(const f32x4 (&acc)[2][2][4][2], const Unit& u, int wr, int wc, int fr, int fq) const {
        float t = 0.f;
#pragma unroll
        for (int ai = 0; ai < 2; ++ai)
#pragma unroll
            for (int bj = 0; bj < 2; ++bj)
#pragma unroll
                for (int m = 0; m < 4; ++m)
#pragma unroll
                    for (int n = 0; n < 2; ++n) t += acc[ai][bj][m][n][0] + acc[ai][bj][m][n][1] + acc[ai][bj][m][n][2] + acc[ai][bj][m][n][3];
        if (t == 123456.789f) sink[0] = t;
    }
};
struct EpiRes {
    static constexpr bool AFTER_DRAIN = false;
    float* x; const bf16_t* xb; bf16_t* rdst;
    __device__ __forceinline__ void operator()(const f32x4 (&acc)[2][2][4][2], const Unit& u, int wr, int wc, int fr_, int fq_) const {
        int fr = fr_, fq = fq_; asm volatile("" : "+v"(fr), "+v"(fq));
        const size_t base = (size_t)(u.pm * 256 + wr * 64 + fr) * DM + u.pn * 256 + wc * 32 + fq * 8;
        u32x4 xw[2][4][2];
#pragma unroll
        for (int ai = 0; ai < 2; ++ai)
#pragma unroll
            for (int m = 0; m < 4; ++m)
#pragma unroll
                for (int bj = 0; bj < 2; ++bj) xw[ai][m][bj] = *(const u32x4*)(xb + base + (size_t)(ai * 128 + m * 16) * DM + bj * 128);
#pragma unroll
        for (int ai = 0; ai < 2; ++ai)
#pragma unroll
            for (int m = 0; m < 4; ++m)
#pragma unroll
                for (int bj = 0; bj < 2; ++bj) { const u32x4 w = xw[ai][m][bj];
                    const f32x4 o0 = unpack4((u32x2){w.x, w.y}), o1 = unpack4((u32x2){w.z, w.w});
                    const u32x2 ra = pack4(o0 * ALPHA + acc[ai][bj][m][0]), rb = pack4(o1 * ALPHA + acc[ai][bj][m][1]);
                    *(u32x4*)(rdst + base + (size_t)(ai * 128 + m * 16) * DM + bj * 128) = (u32x4){ra.x, ra.y, rb.x, rb.y}; }
    }
};
struct EpiUp {
    static constexpr bool AFTER_DRAIN = true;
    bf16_t* H; float* halo; float* out; const float* cw; const float* cb; const float* fstate; int l;
    __device__ __forceinline__ void operator()(const f32x4 (&)[2][2][4][2], const Unit&, int, int, int, int) const {}
    __device__ __forceinline__ void fused(f32x4 (&acc)[2][2][4][2], const Unit& u, int wr, int wc, int fr, int fq, LAS unsigned char* lds, int wid, int lane) const {
        constexpr int LS = 264;
#pragma unroll
        for (int ai = 0; ai < 2; ++ai)
#pragma unroll
            for (int m = 0; m < 4; ++m)
#pragma unroll
                for (int bj = 0; bj < 2; ++bj) {
                        const int rl = ai * 128 + wr * 64 + m * 16 + fr, cl = bj * 128 + wc * 32 + fq * 8;
                        u32x4 w; { const u32x2 a = pack4(acc[ai][bj][m][0]), c = pack4(acc[ai][bj][m][1]); w.x = a.x; w.y = a.y; w.z = c.x; w.w = c.y; }
                        *(LAS u32x4*)(lds + (rl * LS + cl) * 2) = w;
                    }
        __syncthreads();
        const int tid = wid * 64 + lane, j = 2 * (tid & 63), seg = tid >> 6;
        const int hcol = u.pn * 128 + j;
        const float* w = cw + (size_t)l * 3 * DFF2 + hcol; const float* bb = cb + (size_t)l * DFF2 + hcol;
        const f32x2 wg0 = *(const f32x2*)w, wg1 = *(const f32x2*)(w + DFF2), wg2 = *(const f32x2*)(w + 2 * DFF2), bg = *(const f32x2*)bb;
        const f32x2 wv0 = *(const f32x2*)(w + DFF), wv1 = *(const f32x2*)(w + DFF2 + DFF), wv2 = *(const f32x2*)(w + 2 * DFF2 + DFF), bv = *(const f32x2*)(bb + DFF);
        const int r0 = seg * 32, R = u.pm * 256 + r0;
        const bool isP = R < T_P;
        const LAS unsigned char* U = (const LAS unsigned char*)lds;
#define UP2(row, off) ({ const unsigned w_ = *(const LAS unsigned*)(U + ((row) * LS + (off) + j) * 2); (f32x2){bf2f(w_ & 0xffffu), bf2f(w_ >> 16)}; })
        f32x2 g2 = (f32x2){0.f, 0.f}, g1 = g2, v2 = g2, v1 = g2; int skip = 0;
        if (isP) {
            if (seg > 0) { g2 = UP2(r0 - 2, 0); g1 = UP2(r0 - 1, 0); v2 = UP2(r0 - 2, 128); v1 = UP2(r0 - 1, 128); }
            else if ((R & 8191) != 0) skip = 2;
        } else if (seg & 1) { g2 = UP2(r0 - 2, 0); g1 = UP2(r0 - 1, 0); v2 = UP2(r0 - 2, 128); v1 = UP2(r0 - 1, 128); }
        else { const int sb = (R - T_P) >> 6; const float* fs = fstate + (size_t)(l * 32 + sb) * 2 * DFF2 + hcol;
            g2 = *(const f32x2*)fs; g1 = *(const f32x2*)(fs + DFF2); v2 = *(const f32x2*)(fs + DFF); v1 = *(const f32x2*)(fs + DFF2 + DFF); }
        bf16_t* hp = H + (size_t)R * DFF + hcol;
#pragma unroll 8
        for (int i = 0; i < 32; ++i) {
            const f32x2 gq = UP2(r0 + i, 0), vq = UP2(r0 + i, 128);
            if (i >= skip) {
                const f32x2 cgv = bg + wg0 * g2 + wg1 * g1 + wg2 * gq, cvv = bv + wv0 * v2 + wv1 * v1 + wv2 * vq;
                *(unsigned*)(hp + (size_t)i * DFF) = cvt_pk_bf16(silu_f(cgv[0]) * cvv[0], silu_f(cgv[1]) * cvv[1]);
            }
            g2 = g1; g1 = gq; v2 = v1; v1 = vq;
            if (isP) {
                if (seg == 0 && i < 2) { float* hl = halo + ((size_t)u.pm * 4 + i) * DFF2 + hcol; *(f32x2*)hl = gq; *(f32x2*)(hl + DFF) = vq; }
                if (seg == 7 && i >= 30) { float* hl = halo + ((size_t)u.pm * 4 + 2 + (i - 30)) * DFF2 + hcol; *(f32x2*)hl = gq; *(f32x2*)(hl + DFF) = vq;
                    if ((u.pm & 31) == 31) { float* o = out + O_PF + ((size_t)(l * 4 + (u.pm >> 5)) * 2 + (i - 30)) * DFF2 + hcol; *(f32x2*)o = gq; *(f32x2*)(o + DFF) = vq; } }
            } else if ((seg & 1) && i >= 30) {
                const int sb = (R - 32 - T_P) >> 6; float* o = out + O_SF + ((size_t)(l * 32 + sb) * 2 + (i - 30)) * DFF2 + hcol; *(f32x2*)o = gq; *(f32x2*)(o + DFF) = vq;
            }
        }
#undef UP2
    }
};

__device__ __forceinline__ void ln_row(const float* src, const bf16_t* srcb, float* x32, bf16_t* xb, const float* g, const float* b, int lane) {
    f32x4 v[4]; float s = 0.f;
#pragma unroll
    for (int i = 0; i < 4; ++i) { v[i] = srcb ? unpack4(*(const u32x2*)(srcb + i * 256 + lane * 4)) : *(const f32x4*)(src + i * 256 + lane * 4); s += (v[i][0] + v[i][1]) + (v[i][2] + v[i][3]); }
#pragma unroll
    for (int o = 32; o >= 1; o >>= 1) s += __shfl_xor(s, o);
    const float mu = s * (1.0f / 1024.0f); float q = 0.f;
#pragma unroll
    for (int i = 0; i < 4; ++i) { const f32x4 d = v[i] - mu; q += (d[0] * d[0] + d[1] * d[1]) + (d[2] * d[2] + d[3] * d[3]); }
#pragma unroll
    for (int o = 32; o >= 1; o >>= 1) q += __shfl_xor(q, o);
    const float rstd = 1.0f / sqrtf(q * (1.0f / 1024.0f) + LN_EPS);
#pragma unroll
    for (int i = 0; i < 4; ++i) {
        const f32x4 gg = *(const f32x4*)(g + i * 256 + lane * 4), bb = *(const f32x4*)(b + i * 256 + lane * 4);
        const f32x4 o = (v[i] - mu) * rstd * gg + bb;
        if (x32) *(f32x4*)(x32 + i * 256 + lane * 4) = o;
        if (xb) *(u32x2*)(xb + i * 256 + lane * 4) = pack4(o);
    }
}

__device__ __forceinline__ void tr_tile(LAS float* tile, const float* src, int Nsrc, bf16_t* dst, int K, int n0, int k0, int mode, int tid) {
    const int nn = tid & 63, np = n0 + nn; int sc;
    if (mode == 0) sc = np < C_U ? np : (np < C_DT ? np + 6 : (np < C_DT + 6 ? np - 512 : -1));
    else if (mode == 1) sc = np;
    else { const int pn = np >> 8, jj = np & 255; sc = jj < 128 ? pn * 128 + jj : DFF + pn * 128 + (jj - 128); }
#pragma unroll
    for (int i = 0; i < 8; ++i) { const int kk = (tid >> 6) + 8 * i; tile[kk * 65 + nn] = sc >= 0 ? src[(size_t)(k0 + kk) * Nsrc + sc] : 0.f; }
    __syncthreads();
    const int kk2 = (tid & 31) * 2;
#pragma unroll
    for (int i = 0; i < 4; ++i) { const int nn2 = (tid >> 5) + 16 * i; *(unsigned*)(dst + (size_t)(n0 + nn2) * K + k0 + kk2) = cvt_pk_bf16(tile[kk2 * 65 + nn2], tile[(kk2 + 1) * 65 + nn2]); }
    __syncthreads();
}

__device__ __forceinline__ void phase_prep(KP& p, LAS unsigned char* lds) {
    int tid_ = threadIdx.x; asm volatile("" : "+v"(tid_));
    const int tid = tid_, wid = tid >> 6, lane = tid & 63;
    for (int row = blockIdx.x * 8 + wid; row < T_ALL; row += gridDim.x * 8) {
        const float* src = row < T_P ? p.in[0] + (size_t)row * DM : p.in[1] + (size_t)(row - T_P) * DM;
        ln_row(src, nullptr, nullptr, (bf16_t*)(p.ws + W_XB) + (size_t)row * DM, p.in[7], p.in[8], lane);
    }
    constexpr int T_IN = 48 * 16, T_OUT = 16 * 16, T_UPT = 88 * 16, T_DNT = 16 * 44, T_L = T_IN + T_OUT + T_UPT + T_DNT;
    for (int it = blockIdx.x; it < 4 * T_L; it += gridDim.x) {
        const int l = it / T_L; int r = it % T_L;
        if (r < T_IN) tr_tile((LAS float*)lds, p.in[9] + (size_t)l * DM * 2950, 2950, (bf16_t*)(p.ws + W_IN + l * W_IN_L), DM, (r >> 4) * 64, (r & 15) * 64, 0, tid);
        else if ((r -= T_IN) < T_OUT) tr_tile((LAS float*)lds, p.in[19] + (size_t)l * DM * DM, DM, (bf16_t*)(p.ws + W_OUT + l * W_OUT_L), DM, (r >> 4) * 64, (r & 15) * 64, 1, tid);
        else if ((r -= T_OUT) < T_UPT) tr_tile((LAS float*)lds, p.in[22] + (size_t)l * DM * DFF2, DFF2, (bf16_t*)(p.ws + W_UP + l * W_UP_L), DM, (r >> 4) * 64, (r & 15) * 64, 2, tid);
        else { r -= T_UPT; tr_tile((LAS float*)lds, p.in[25] + (size_t)l * DFF * DM, DM, (bf16_t*)(p.ws + W_DN + l * W_DN_L), DFF, (r / 44) * 64, (r % 44) * 64, 1, tid); }
    }
    for (int i = blockIdx.x * 512 + tid; i < 4 * 4 * 128 * 128; i += gridDim.x * 512) {
        const int jj = i & 127, ii = (i >> 7) & 127;
        ((bf16_t*)(p.ws + W_GW))[i] = (bf16_t)(cvt_pk_bf16(jj <= ii ? p.in[16][i] : 0.f, 0.f) & 0xffffu);
    }
}

template <int NB>
__device__ __forceinline__ void ln_rows_bf(const bf16_t* rsrc, float* x32, bf16_t* xb, const f32x4 (&gg)[4], const f32x4 (&bb)[4], int row, int stride, int lane) {
    u32x2 raw[NB][4];
#pragma unroll
    for (int k = 0; k < NB; ++k)
#pragma unroll
        for (int i = 0; i < 4; ++i) raw[k][i] = *(const u32x2*)(rsrc + (size_t)(row + k * stride) * DM + i * 256 + lane * 4);
#pragma unroll
    for (int k = 0; k < NB; ++k) {
        f32x4 v[4]; float s = 0.f;
#pragma unroll
        for (int i = 0; i < 4; ++i) { v[i] = unpack4(raw[k][i]); s += (v[i][0] + v[i][1]) + (v[i][2] + v[i][3]); }
#pragma unroll
        for (int o = 32; o >= 1; o >>= 1) s += __shfl_xor(s, o);
        const float mu = s * (1.0f / 1024.0f); float q = 0.f;
#pragma unroll
        for (int i = 0; i < 4; ++i) { const f32x4 d = v[i] - mu; q += (d[0] * d[0] + d[1] * d[1]) + (d[2] * d[2] + d[3] * d[3]); }
#pragma unroll
        for (int o = 32; o >= 1; o >>= 1) q += __shfl_xor(q, o);
        const float rstd = 1.0f / sqrtf(q * (1.0f / 1024.0f) + LN_EPS);
        const size_t ro = (size_t)(row + k * stride) * DM + lane * 4;
#pragma unroll
        for (int i = 0; i < 4; ++i) {
            const f32x4 o = (v[i] - mu) * rstd * gg[i] + bb[i];
            if (x32) *(f32x4*)(x32 + ro + i * 256) = o;
            if (xb) *(u32x2*)(xb + ro + i * 256) = pack4(o);
        }
    }
}
__device__ __forceinline__ void phase_ln(KP& p, const bf16_t* rsrc, const float* g, const float* b, bool final_out) {
    int tid_ = threadIdx.x; asm volatile("" : "+v"(tid_));
    const int wid = tid_ >> 6, lane = tid_ & 63, stride = gridDim.x * 8;
    f32x4 gg[4], bb[4];
#pragma unroll
    for (int i = 0; i < 4; ++i) { gg[i] = *(const f32x4*)(g + i * 256 + lane * 4); bb[i] = *(const f32x4*)(b + i * 256 + lane * 4); }
    float* x32 = final_out ? p.out : nullptr; bf16_t* xb = final_out ? nullptr : (bf16_t*)(p.ws + W_XB);
    int row = blockIdx.x * 8 + wid;
    for (; row + 3 * stride < T_ALL; row += 4 * stride) ln_rows_bf<4>(rsrc, x32, xb, gg, bb, row, stride, lane);
    for (; row < T_ALL; row += stride) ln_rows_bf<1>(rsrc, x32, xb, gg, bb, row, stride, lane);
}

__device__ __forceinline__ void dt_scan(KP& p, int l, int u, int g, int wid, int lane, float& dt, float& ac, float& last) {
    const int h = g * 3 + wid;
    dt = ((const float*)(p.ws + W_DTB))[(size_t)(u * 64 + lane) * 8 + h];
    const float a = -__expf(p.in[14][l * 6 + h]);
    float v = dt * a;
#pragma unroll
    for (int o = 1; o < 64; o <<= 1) { const float t = __shfl_up(v, o); if (lane >= o) v += t; }
    ac = v; last = __shfl(v, 63);
}

__device__ __forceinline__ f32x4 xbc_row(KP& p, int l, int u, int s, int ch) {
    const bf16_t* proj = (const bf16_t*)(p.ws + W_PROJ);
    const bool isP = u < 512; const bool hasprev = isP && (u & 127) != 0;
    if (s >= 0 || hasprev) return unpack4(*(const u32x2*)(proj + (size_t)(u * 64 + s) * NPROJ + C_XBC + ch));
    if (!isP) return *(const f32x4*)(p.in[5] + (unsigned)(((l * 32 + (u - 512)) * 3 + (3 + s)) * 896 + ch));
    return (f32x4){0.f, 0.f, 0.f, 0.f};
}
__device__ __forceinline__ void ssd_states(KP& p, LAS unsigned char* lds, int l, int u) {
    int tid_ = threadIdx.x; asm volatile("" : "+v"(tid_));
    const int tid = tid_, wid = tid >> 6, lane = tid & 63, fr = lane & 15, fq = lane >> 4;
    LAS bf16_t* xT = (LAS bf16_t*)lds;
    LAS bf16_t* BT = (LAS bf16_t*)(lds + 55296);
    LAS float* wgt = (LAS float*)(lds + 92160);
    bf16_t* XC = (bf16_t*)p.out;
    __syncthreads();
    if (wid < 6) {
        float dt, ac, last; dt_scan(p, l, u, wid / 3, wid % 3, lane, dt, ac, last);
        wgt[wid * 64 + lane] = dt * __expf(last - ac);
        if (lane == 0) ((float*)(p.ws + W_CD))[u * 8 + wid] = __expf(last);
    }
    __syncthreads();
    if (tid < 448) {
        const int cgp = tid % 224, seg = tid / 224, ch = cgp * 4, r0 = seg * 32;
        const float* cw = p.in[11] + (size_t)l * 4 * 896 + ch;
        const f32x4 w0 = *(const f32x4*)cw, w1 = *(const f32x4*)(cw + 896), w2 = *(const f32x4*)(cw + 2 * 896), w3 = *(const f32x4*)(cw + 3 * 896);
        const f32x4 bs = *(const f32x4*)(p.in[12] + (size_t)l * 896 + ch);
        f32x4 xm3 = xbc_row(p, l, u, r0 - 3, ch), xm2 = xbc_row(p, l, u, r0 - 2, ch), xm1 = xbc_row(p, l, u, r0 - 1, ch);
        const bf16_t* src = (const bf16_t*)(p.ws + W_PROJ) + (size_t)(u * 64) * NPROJ + C_XBC + ch;
        bf16_t* dst = XC + (size_t)(u * 64) * 896 + ch;
        const int hh = ch >> 6;
        u32x2 raw[32];
#pragma unroll
        for (int i = 0; i < 32; ++i) raw[i] = *(const u32x2*)(src + (size_t)(r0 + i) * NPROJ);
#pragma unroll
        for (int ii = 0; ii < 32; ii += 2) { const int i = r0 + ii;
            const f32x4 xa = unpack4(raw[ii]), xb = unpack4(raw[ii + 1]);
            f32x4 ya = bs + w0 * xm3 + w1 * xm2 + w2 * xm1 + w3 * xa, yb = bs + w0 * xm2 + w1 * xm1 + w2 * xa + w3 * xb;
#pragma unroll
            for (int e = 0; e < 4; ++e) { ya[e] = silu_f(ya[e]); yb[e] = silu_f(yb[e]); }
            xm3 = xm1; xm2 = xa; xm1 = xb;
            *(u32x2*)(dst + (size_t)i * 896) = pack4(ya); *(u32x2*)(dst + (size_t)(i + 1) * 896) = pack4(yb);
            if (ch < 384) { const float wa = wgt[hh * 64 + i], wb = wgt[hh * 64 + i + 1];
#pragma unroll
                for (int e = 0; e < 4; ++e) *(LAS unsigned*)(xT + (ch + e) * 72 + i) = cvt_pk_bf16(ya[e] * wa, yb[e] * wb); }
            else if (ch < 640) {
#pragma unroll
                for (int e = 0; e < 4; ++e) *(LAS unsigned*)(BT + (ch - 384 + e) * 72 + i) = cvt_pk_bf16(ya[e], yb[e]); }
        }
    }
    __syncthreads();
    bf16_t* ST = (bf16_t*)(p.ws + W_ST);
#pragma unroll 2
    for (int k = 0; k < 24; ++k) {
        const int tt = wid * 24 + k, h = tt >> 5, pt = (tt & 31) >> 3, nt = tt & 7, g = h / 3;
        f32x4 acc = (f32x4){0.f, 0.f, 0.f, 0.f};
#pragma unroll
        for (int ks = 0; ks < 2; ++ks) {
            const bf16x8 rf = ldsfrag((LAS const unsigned char*)(xT + (h * 64 + pt * 16 + fr) * 72 + ks * 32 + fq * 8));
            const bf16x8 cf = ldsfrag((LAS const unsigned char*)(BT + (g * 128 + nt * 16 + fr) * 72 + ks * 32 + fq * 8));
            acc = MFMA16(cf, rf, acc);
        }
        *(u32x2*)(ST + ((size_t)(u * 6 + h) * 64 + pt * 16 + fr) * 128 + nt * 16 + fq * 4) = pack4(acc);
    }
}

__device__ __forceinline__ void gmlp_unit(KP& p, LAS unsigned char* lds, int l, int u) {
    int tid_ = threadIdx.x; asm volatile("" : "+v"(tid_));
    const int tid = tid_, wid = tid >> 6, lane = tid & 63, fr = lane & 15, fq = lane >> 4;
    LAS bf16_t* vT = (LAS bf16_t*)lds;
    LAS float* ssq = (LAS float*)(lds + 69632);
    const bf16_t* proj = (const bf16_t*)(p.ws + W_PROJ);
    const int half = u < 512 ? (u & 1) : 0, KJ = (half + 1) * 64, R0 = u * 64, Rb = R0 - half * 64;
    __syncthreads();
    for (int idx = tid; idx < KJ * 32; idx += 512) {
        const int j = idx & (KJ - 1), cgp = idx / KJ;
        const u32x4 w = *(const u32x4*)(proj + (size_t)(Rb + j) * NPROJ + C_VC + cgp * 8);
        const unsigned ww[4] = {w.x, w.y, w.z, w.w};
#pragma unroll
        for (int e = 0; e < 4; ++e) { vT[(cgp * 8 + 2 * e) * 136 + j] = (bf16_t)(ww[e] & 0xffffu); vT[(cgp * 8 + 2 * e + 1) * 136 + j] = (bf16_t)(ww[e] >> 16); }
    }
    __syncthreads();
    const int rt = wid & 3, cbase = (wid >> 2) * 8;
    const bf16_t* GW = (const bf16_t*)(p.ws + W_GW + l * W_GW_L);
    f32x4 acc[8];
#pragma unroll
    for (int gi = 0; gi < 2; ++gi) {
        const int gg = (cbase >> 2) + gi;
        bf16x8 rf[4];
#pragma unroll
        for (int ks = 0; ks < 4; ++ks) rf[ks] = glbfrag(GW + ((size_t)gg * 128 + half * 64 + rt * 16 + fr) * 128 + ks * 32 + fq * 8);
#pragma unroll
        for (int c4 = 0; c4 < 4; ++c4) {
            const int ct = cbase + gi * 4 + c4;
            f32x4 a = (f32x4){0.f, 0.f, 0.f, 0.f};
#pragma unroll
            for (int ks = 0; ks < 4; ++ks) if (ks * 32 < KJ) a = MFMA16(ldsfrag((LAS const unsigned char*)(vT + (ct * 16 + fr) * 136 + ks * 32 + fq * 8)), rf[ks], a);
            acc[gi * 4 + c4] = a;
        }
    }
    const int row = R0 + rt * 16 + fr; float sq = 0.f;
#pragma unroll
    for (int k = 0; k < 8; ++k) {
        const int col = (cbase + k) * 16 + fq * 4, gg = col >> 6;
        const float bsv = p.in[17][(size_t)(l * 4 + gg) * 128 + half * 64 + rt * 16 + fr];
        const f32x4 uv = unpack4(*(const u32x2*)(proj + (size_t)row * NPROJ + C_U + col));
        f32x4 o = uv * (acc[k] + bsv); acc[k] = o;
        sq += (o[0] * o[0] + o[1] * o[1]) + (o[2] * o[2] + o[3] * o[3]);
    }
    sq += __shfl_xor(sq, 16); sq += __shfl_xor(sq, 32);
    if (fq == 0) ssq[(wid >> 2) * 64 + rt * 16 + fr] = sq;
    __syncthreads();
    const float rstd = 1.0f / sqrtf((ssq[rt * 16 + fr] + ssq[64 + rt * 16 + fr]) * (1.0f / 256.0f) + RMS_EPS);
    bf16_t* mix = (bf16_t*)(p.ws + W_MIX);
#pragma unroll
    for (int k = 0; k < 8; ++k) {
        const int col = (cbase + k) * 16 + fq * 4;
        const f32x4 gv = *(const f32x4*)(p.in[18] + (size_t)l * 1024 + 768 + col);
        *(u32x2*)(mix + (size_t)row * DM + 768 + col) = pack4(acc[k] * rstd * gv);
    }
}

__device__ __forceinline__ void scan_prompt(KP& p, int l, int item) {
    int tid_ = threadIdx.x; asm volatile("" : "+v"(tid_));
    const int gid = item * 512 + tid_, e = (gid & 2047) * 4, bh = gid >> 11, b = bh / 6, h = bh % 6;
    bf16_t* ST = (bf16_t*)(p.ws + W_ST); const float* CD = (const float*)(p.ws + W_CD);
    f32x4 st = (f32x4){0.f, 0.f, 0.f, 0.f};
#pragma unroll 1
    for (int c0 = 0; c0 < 128; c0 += 16) {
        u32x2 s[16]; float cd[16];
#pragma unroll
        for (int k = 0; k < 16; ++k) { const int u = b * 128 + c0 + k; s[k] = *(const u32x2*)(ST + ((size_t)(u * 6 + h)) * 8192 + e); cd[k] = CD[u * 8 + h]; }
#pragma unroll
        for (int k = 0; k < 16; ++k) { const int u = b * 128 + c0 + k; *(u32x2*)(ST + ((size_t)(u * 6 + h)) * 8192 + e) = pack4(st); st = st * cd[k] + unpack4(s[k]); }
    }
    *(f32x4*)(p.out + O_PH + ((size_t)(l * 4 + b) * 6 + h) * 8192 + e) = st;
}
__device__ __forceinline__ void scan_sample(KP& p, int l, int item) {
    int tid_ = threadIdx.x; asm volatile("" : "+v"(tid_));
    const int gid = item * 512 + tid_, e = (gid & 2047) * 4, sbh = gid >> 11, sb = sbh / 6, h = sbh % 6;
    bf16_t* ST = (bf16_t*)(p.ws + W_ST); const float* CD = (const float*)(p.ws + W_CD);
    const int u = 512 + sb;
    const f32x4 st = *(const f32x4*)(p.in[4] + ((size_t)(l * 32 + sb) * 6 + h) * 8192 + e);
    const f32x4 s = unpack4(*(const u32x2*)(ST + ((size_t)(u * 6 + h)) * 8192 + e));
    *(u32x2*)(ST + ((size_t)(u * 6 + h)) * 8192 + e) = pack4(st);
    *(f32x4*)(p.out + O_SH + ((size_t)(l * 32 + sb) * 6 + h) * 8192 + e) = st * CD[u * 8 + h] + s;
}

__device__ __forceinline__ void attn_unit(KP& p, LAS unsigned char* lds, int l, int u) {
    int tid_ = threadIdx.x; asm volatile("" : "+v"(tid_));
    const int tid = tid_, wid = tid >> 6, lane = tid & 63, fr = lane & 15, fq = lane >> 4;
    LAS bf16_t* VT = (LAS bf16_t*)(lds + 98304);
    LAS float* bias = (LAS float*)(lds + 153600);
    LAS float* ssq = (LAS float*)(lds + 158208);
    const bf16_t* proj = (const bf16_t*)(p.ws + W_PROJ);
    const bool isP = u < 512; const int R0 = u * 64, c = u & 127, b = u >> 7, sb = u - 512;
    const int qt = wid & 3, hbase = (wid >> 2) * 3;
    __syncthreads();
    for (int i = tid; i < 1152; i += 512) bias[i] = p.in[10][(size_t)l * 1152 + i];
    bf16x8 qf[3][2];
#pragma unroll
    for (int hh = 0; hh < 3; ++hh)
#pragma unroll
        for (int ks = 0; ks < 2; ++ks) qf[hh][ks] = glbfrag(proj + (size_t)(R0 + qt * 16 + fr) * NPROJ + (hbase + hh) * 64 + ks * 32 + fq * 8);
    float mrun[3], lrun[3]; f32x4 O[3][4];
#pragma unroll
    for (int hh = 0; hh < 3; ++hh) { mrun[hh] = -1e30f; lrun[hh] = 0.f;
#pragma unroll
        for (int d = 0; d < 4; ++d) O[hh][d] = (f32x4){0.f, 0.f, 0.f, 0.f}; }
    const int blk_lo = isP ? (c < 8 ? 8 - c : 0) : 0;
    u32x4 vr[6];
    const int vkp = tid & 31, vcg0 = tid >> 5;
#define ATT_LOADP(blkv, bufv) do { const size_t rb_ = isP ? (size_t)b * 8192 + (size_t)(c - 8 + (blkv)) * 64 : (size_t)T_P + (size_t)sb * 64; \
        _Pragma("unroll") for (int it = 0; it < 6; ++it) { const int pu_ = it * 512 + tid, row_ = pu_ / 48, un_ = (pu_ % 48) ^ (row_ & 15); \
            __builtin_amdgcn_global_load_lds((const unsigned*)(proj + (rb_ + row_) * NPROJ + C_K + un_ * 8), (LAS unsigned*)(lds + (bufv) * 49152 + (it * 512 + wid * 64) * 16), 16, 0, 0); } \
        _Pragma("unroll") for (int it = 0; it < 2; ++it) { const int cg_ = vcg0 + it * 16; \
            vr[2 * it] = *(const u32x4*)(proj + (rb_ + 2 * vkp) * NPROJ + C_V + cg_ * 8); vr[2 * it + 1] = *(const u32x4*)(proj + (rb_ + 2 * vkp + 1) * NPROJ + C_V + cg_ * 8); } } while (0)
    bool have = false; int cur = 0;
    if (isP || blk_lo == 8) { ATT_LOADP(blk_lo, 0); have = true; }
#pragma unroll 1
    for (int blk = blk_lo; blk <= 8; ++blk) {
        LAS unsigned char* Kc = lds + cur * 49152;
        __syncthreads();
        if (!have) {
#pragma unroll
            for (int it = 0; it < 6; ++it) { const int idx = it * 512 + tid, row_ = idx / 48, un_ = idx % 48;
                const float* s = p.in[2] + ((size_t)(l * 32 + sb) * 512 + blk * 64 + row_) * 384 + un_ * 8; const f32x4 a = *(const f32x4*)s, bq = *(const f32x4*)(s + 4);
                u32x4 w; w.x = cvt_pk_bf16(a[0], a[1]); w.y = cvt_pk_bf16(a[2], a[3]); w.z = cvt_pk_bf16(bq[0], bq[1]); w.w = cvt_pk_bf16(bq[2], bq[3]);
                *(LAS u32x4*)(Kc + row_ * 768 + ((un_ ^ (row_ & 15)) * 16)) = w; }
#pragma unroll
            for (int it = 0; it < 6; ++it) { const int cg_ = vcg0 + (it >> 1) * 16;
                const float* s = p.in[3] + ((size_t)(l * 32 + sb) * 512 + blk * 64 + 2 * vkp + (it & 1)) * 384 + cg_ * 8; const f32x4 a = *(const f32x4*)s, bq = *(const f32x4*)(s + 4);
                vr[it].x = cvt_pk_bf16(a[0], a[1]); vr[it].y = cvt_pk_bf16(a[2], a[3]); vr[it].z = cvt_pk_bf16(bq[0], bq[1]); vr[it].w = cvt_pk_bf16(bq[2], bq[3]); }
        }
        if (have) { const size_t rb_ = isP ? (size_t)b * 8192 + (size_t)(c - 8 + blk) * 64 : (size_t)T_P + (size_t)sb * 64; const int cg_ = vcg0 + 2 * 16;
            vr[4] = *(const u32x4*)(proj + (rb_ + 2 * vkp) * NPROJ + C_V + cg_ * 8); vr[5] = *(const u32x4*)(proj + (rb_ + 2 * vkp + 1) * NPROJ + C_V + cg_ * 8); }
#pragma unroll
        for (int it = 0; it < 3; ++it) { const int cg_ = vcg0 + it * 16; const u32x4 w0 = vr[2 * it], w1 = vr[2 * it + 1];
            const unsigned a0[4] = {w0.x, w0.y, w0.z, w0.w}, a1[4] = {w1.x, w1.y, w1.z, w1.w};
#pragma unroll
            for (int e = 0; e < 4; ++e) {
                *(LAS unsigned*)(VT + (cg_ * 8 + 2 * e) * 72 + 2 * vkp) = (a0[e] & 0xffffu) | (a1[e] << 16);
                *(LAS unsigned*)(VT + (cg_ * 8 + 2 * e + 1) * 72 + 2 * vkp) = (a0[e] >> 16) | (a1[e] & 0xffff0000u); } }
        asm volatile("s_waitcnt vmcnt(0)" ::: "memory");
        __syncthreads();
        have = false;
        if (blk < 8 && (isP || blk == 7)) { ATT_LOADP(blk + 1, cur ^ 1); have = true; }
#pragma unroll
        for (int hh = 0; hh < 3; ++hh) {
            const int h = hbase + hh;
            f32x4 s[4]; float mx = -1e30f;
#pragma unroll
            for (int kt = 0; kt < 4; ++kt) {
                f32x4 a = (f32x4){0.f, 0.f, 0.f, 0.f};
#pragma unroll
                for (int ks = 0; ks < 2; ++ks) a = MFMA16(ldsfrag((LAS const unsigned char*)(Kc + (kt * 16 + fr) * 768 + (((h * 8 + ks * 4 + fq) ^ fr) * 16))), qf[hh][ks], a);
                if (blk <= 5) { const float bc = bias[h * 192 + 191];
#pragma unroll
                    for (int j = 0; j < 4; ++j) { a[j] = a[j] * 0.125f + bc; mx = fmaxf(mx, a[j]); } }
                else {
#pragma unroll
                    for (int j = 0; j < 4; ++j) {
                        int rel = (qt * 16 + fr) + 512 - (blk * 64 + kt * 16 + fq * 4 + j); rel = rel > 128 ? 128 : rel;
                        a[j] = a[j] * 0.125f + bias[h * 192 + rel + 63]; mx = fmaxf(mx, a[j]);
                    } }
                s[kt] = a;
            }
            mx = fmaxf(mx, __shfl_xor(mx, 16)); mx = fmaxf(mx, __shfl_xor(mx, 32));
            const float mnew = fmaxf(mrun[hh], mx), fac = __expf(mrun[hh] - mnew); mrun[hh] = mnew;
            float rs = 0.f;
#pragma unroll
            for (int kt = 0; kt < 4; ++kt)
#pragma unroll
                for (int j = 0; j < 4; ++j) { s[kt][j] = __expf(s[kt][j] - mnew); rs += s[kt][j]; }
            lrun[hh] = lrun[hh] * fac + rs;
#pragma unroll
            for (int d = 0; d < 4; ++d) O[hh][d] *= fac;
#pragma unroll
            for (int ks = 0; ks < 2; ++ks) {
                const u32x2 pa = pack4(s[2 * ks]), pb = pack4(s[2 * ks + 1]);
                const bf16x8 pf = __builtin_bit_cast(bf16x8, (u32x4){pa.x, pa.y, pb.x, pb.y});
#pragma unroll
                for (int d = 0; d < 4; ++d) {
                    const LAS bf16_t* vrow = VT + (h * 64 + d * 16 + fr) * 72 + ks * 32 + fq * 4;
                    const u32x2 va = *(const LAS u32x2*)vrow, vb = *(const LAS u32x2*)(vrow + 16);
                    O[hh][d] = MFMA16(__builtin_bit_cast(bf16x8, (u32x4){va.x, va.y, vb.x, vb.y}), pf, O[hh][d]);
                }
            }
        }
        cur ^= 1;
    }
#pragma unroll
    for (int hh = 0; hh < 3; ++hh) { lrun[hh] += __shfl_xor(lrun[hh], 16); lrun[hh] += __shfl_xor(lrun[hh], 32); }
    float sq = 0.f;
#pragma unroll
    for (int hh = 0; hh < 3; ++hh) { const float inv = 1.0f / lrun[hh];
#pragma unroll
        for (int d = 0; d < 4; ++d) { O[hh][d] *= inv; const f32x4 o = O[hh][d]; sq += (o[0] * o[0] + o[1] * o[1]) + (o[2] * o[2] + o[3] * o[3]); } }
    sq += __shfl_xor(sq, 16); sq += __shfl_xor(sq, 32);
    if (fq == 0) ssq[(wid >> 2) * 64 + qt * 16 + fr] = sq;
    __syncthreads();
    const float rstd = 1.0f / sqrtf((ssq[qt * 16 + fr] + ssq[64 + qt * 16 + fr]) * (1.0f / 384.0f) + RMS_EPS);
    bf16_t* mix = (bf16_t*)(p.ws + W_MIX);
#pragma unroll
    for (int hh = 0; hh < 3; ++hh)
#pragma unroll
        for (int d = 0; d < 4; ++d) {
            const int col = (hbase + hh) * 64 + d * 16 + fq * 4;
            const f32x4 gv = *(const f32x4*)(p.in[18] + (size_t)l * 1024 + col);
            *(u32x2*)(mix + (size_t)(R0 + qt * 16 + fr) * DM + col) = pack4(O[hh][d] * rstd * gv);
        }
}

__device__ __forceinline__ void ssd_y(KP& p, LAS unsigned char* lds, int l, int u) {
    int tid_ = threadIdx.x; asm volatile("" : "+v"(tid_));
    const int tid = tid_, wid = tid >> 6, lane = tid & 63, fr = lane & 15, fq = lane >> 4;
    LAS bf16_t* Cn = (LAS bf16_t*)lds;
    LAS bf16_t* Bn = (LAS bf16_t*)(lds + 17408);
    LAS bf16_t* xT = (LAS bf16_t*)(lds + 34816);
    LAS bf16_t* Mm = (LAS bf16_t*)(lds + 62464);
    LAS float* dtl = (LAS float*)(lds + 90112);
    LAS float* acl = (LAS float*)(lds + 90880);
    LAS float* ssq = (LAS float*)(lds + 91648);
    LAS bf16_t* HPl = (LAS bf16_t*)(lds + 92160);
    const bf16_t* proj = (const bf16_t*)(p.ws + W_PROJ);
    const bf16_t* HP = (const bf16_t*)(p.ws + W_ST);
    const bf16_t* XC = (const bf16_t*)p.out + (size_t)(u * 64) * 896;
    const int R0 = u * 64, lt = wid & 3;
    f32x4 yacc[2][6];
#pragma unroll
    for (int g = 0; g < 2; ++g) {
        __syncthreads();
        if (wid < 3) { float dt, ac, last; dt_scan(p, l, u, g, wid, lane, dt, ac, last); dtl[wid * 64 + lane] = dt; acl[wid * 64 + lane] = ac; }
#pragma unroll
        for (int it = 0; it < 4; ++it) {
            const int idx = it * 512 + tid, mat = idx >> 10, i = (idx >> 4) & 63, c8 = idx & 15;
            const u32x4 w = *(const u32x4*)(XC + (size_t)i * 896 + 384 + mat * 256 + g * 128 + c8 * 8);
            *(LAS u32x4*)((mat ? Cn : Bn) + i * 136 + c8 * 8) = w;
        }
#pragma unroll
        for (int it = 0; it < 6; ++it) {
            const int idx = it * 512 + tid, r_ = idx >> 4, c8 = idx & 15;
            *(LAS u32x4*)(HPl + r_ * 136 + c8 * 8) = *(const u32x4*)(HP + ((size_t)(u * 6 + g * 3) * 64 + r_) * 128 + c8 * 8);
        }
#pragma unroll
        for (int it = 0; it < 3; ++it) {
            const int idx = it * 512 + tid, c4 = idx % 48, i = (idx / 48) * 2;
            const u32x2 wa = *(const u32x2*)(XC + (size_t)i * 896 + g * 192 + c4 * 4), wb = *(const u32x2*)(XC + (size_t)(i + 1) * 896 + g * 192 + c4 * 4);
            *(LAS unsigned*)(xT + (c4 * 4 + 0) * 72 + i) = (wa.x & 0xffffu) | (wb.x << 16);
            *(LAS unsigned*)(xT + (c4 * 4 + 1) * 72 + i) = (wa.x >> 16) | (wb.x & 0xffff0000u);
            *(LAS unsigned*)(xT + (c4 * 4 + 2) * 72 + i) = (wa.y & 0xffffu) | (wb.y << 16);
            *(LAS unsigned*)(xT + (c4 * 4 + 3) * 72 + i) = (wa.y >> 16) | (wb.y & 0xffff0000u);
        }
        __syncthreads();
#pragma unroll
        for (int k = 0; k < 2; ++k) {
            const int st = (wid >> 2) * 2 + k;
            f32x4 a = (f32x4){0.f, 0.f, 0.f, 0.f};
#pragma unroll
            for (int ks = 0; ks < 4; ++ks) a = MFMA16(ldsfrag((LAS const unsigned char*)(Bn + (st * 16 + fr) * 136 + ks * 32 + fq * 8)), ldsfrag((LAS const unsigned char*)(Cn + (lt * 16 + fr) * 136 + ks * 32 + fq * 8)), a);
            const int li = lt * 16 + fr;
#pragma unroll
            for (int hh = 0; hh < 3; ++hh) {
                const float al = acl[hh * 64 + li]; f32x4 mv;
#pragma unroll
                for (int j = 0; j < 4; ++j) { const int si = st * 16 + fq * 4 + j; mv[j] = si <= li ? a[j] * __expf(al - acl[hh * 64 + si]) * dtl[hh * 64 + si] : 0.f; }
                *(LAS u32x2*)(Mm + (hh * 64 + li) * 72 + st * 16 + fq * 4) = pack4(mv);
            }
        }
        __syncthreads();
#pragma unroll
        for (int k = 0; k < 6; ++k) {
            const int ctile = (wid >> 2) * 6 + k, hh = ctile >> 2, pt = ctile & 3, h = g * 3 + hh, li = lt * 16 + fr;
            f32x4 ad = (f32x4){0.f, 0.f, 0.f, 0.f}, ao = (f32x4){0.f, 0.f, 0.f, 0.f};
#pragma unroll
            for (int ks = 0; ks < 2; ++ks) ad = MFMA16(ldsfrag((LAS const unsigned char*)(xT + (hh * 64 + pt * 16 + fr) * 72 + ks * 32 + fq * 8)), ldsfrag((LAS const unsigned char*)(Mm + (hh * 64 + li) * 72 + ks * 32 + fq * 8)), ad);
#pragma unroll
            for (int ks = 0; ks < 4; ++ks) ao = MFMA16(ldsfrag((LAS const unsigned char*)(HPl + (hh * 64 + pt * 16 + fr) * 136 + ks * 32 + fq * 8)), ldsfrag((LAS const unsigned char*)(Cn + li * 136 + ks * 32 + fq * 8)), ao);
            const float ea = __expf(acl[hh * 64 + li]), dsk = p.in[15][l * 6 + h];
            const f32x4 xv = unpack4(*(const u32x2*)(XC + (size_t)li * 896 + h * 64 + pt * 16 + fq * 4));
            const f32x4 zv = unpack4(*(const u32x2*)(proj + (size_t)(R0 + li) * NPROJ + C_Z + h * 64 + pt * 16 + fq * 4));
            f32x4 y = ad + ao * ea + xv * dsk;
#pragma unroll
            for (int j = 0; j < 4; ++j) y[j] *= silu_f(zv[j]);
            yacc[g][k] = y;
            asm volatile("" ::: "memory");
        }
    }
    float sq = 0.f;
#pragma unroll
    for (int g = 0; g < 2; ++g)
#pragma unroll
        for (int k = 0; k < 6; ++k) { const f32x4 o = yacc[g][k]; sq += (o[0] * o[0] + o[1] * o[1]) + (o[2] * o[2] + o[3] * o[3]); }
    sq += __shfl_xor(sq, 16); sq += __shfl_xor(sq, 32);
    if (fq == 0) ssq[(wid >> 2) * 64 + lt * 16 + fr] = sq;
    __syncthreads();
    const float rstd = 1.0f / sqrtf((ssq[lt * 16 + fr] + ssq[64 + lt * 16 + fr]) * (1.0f / 384.0f) + RMS_EPS);
    bf16_t* mix = (bf16_t*)(p.ws + W_MIX);
#pragma unroll
    for (int g = 0; g < 2; ++g)
#pragma unroll
        for (int k = 0; k < 6; ++k) {
            const int col = 384 + g * 192 + ((wid >> 2) * 6 + k) * 16 + fq * 4;
            const f32x4 gv = *(const f32x4*)(p.in[18] + (size_t)l * 1024 + col);
            *(u32x2*)(mix + (size_t)(R0 + lt * 16 + fr) * DM + col) = pack4(yacc[g][k] * rstd * gv);
        }
}

__device__ __forceinline__ void phase_fix(KP& p, int l) {
    const float* halo = (const float*)(p.ws + W_MIX); bf16_t* H = (bf16_t*)(p.ws + W_PROJ);
    const float* w = p.in[23] + (size_t)l * 3 * DFF2; const float* bb = p.in[24] + (size_t)l * DFF2;
    int tid_ = threadIdx.x; asm volatile("" : "+v"(tid_));
    for (int i = blockIdx.x * 512 + tid_; i < 128 * DFF2; i += gridDim.x * 512) {
        const int pm = i / DFF2, cc = i % DFF2;
        if ((pm & 31) == 0 || cc >= DFF) continue;
        const float* h0 = halo + (size_t)(pm - 1) * 4 * DFF2; const float* h1 = halo + (size_t)pm * 4 * DFF2;
        float r[2];
#pragma unroll
        for (int rr = 0; rr < 2; ++rr) {
            float o[2];
#pragma unroll
            for (int gv = 0; gv < 2; ++gv) {
                const int c2 = cc + gv * DFF;
                const float xm2 = h0[2 * DFF2 + c2], xm1 = h0[3 * DFF2 + c2], x0 = h1[c2], x1 = h1[DFF2 + c2];
                o[gv] = rr == 0 ? bb[c2] + w[c2] * xm2 + w[DFF2 + c2] * xm1 + w[2 * DFF2 + c2] * x0 : bb[c2] + w[c2] * xm1 + w[DFF2 + c2] * x0 + w[2 * DFF2 + c2] * x1;
            }
            r[rr] = silu_f(o[0]) * o[1];
        }
        H[((size_t)pm * 256) * DFF + cc] = (bf16_t)(cvt_pk_bf16(r[0], 0.f) & 0xffffu);
        H[((size_t)pm * 256 + 1) * DFF + cc] = (bf16_t)(cvt_pk_bf16(r[1], 0.f) & 0xffffu);
    }
}

#define XB_TMO      128
#define XB_XCNT(j)  (256  + 64 * (j))
#define XB_XSUB(j)  (1280 + 64 * (j))
#define XB_XGEN(j)  (2304 + 64 * (j))
#define XB_TOP      3328
#define XB_TOPGEN   3392
#define XCD_BAR_WORDS 3456
#define XB_SPIN_CAP (1u << 18)

__device__ __forceinline__ unsigned xb_ld(unsigned* p)              { return __hip_atomic_load(p, __ATOMIC_RELAXED, __HIP_MEMORY_SCOPE_AGENT); }
__device__ __forceinline__ unsigned xb_add(unsigned* p, unsigned v) { return __hip_atomic_fetch_add(p, v, __ATOMIC_RELAXED, __HIP_MEMORY_SCOPE_AGENT); }
__device__ __forceinline__ unsigned xb_xcc_id() { return (unsigned)__builtin_amdgcn_s_getreg((3 << 11) | 20) & 0xFu; }
#define XB_SPIN(cond, bar) do { unsigned _sp = 0; while (cond) { __builtin_amdgcn_s_sleep(1); \
    if ((++_sp & 255u) == 0u) { if (xb_ld(&(bar)[XB_TMO])) break; if (_sp > XB_SPIN_CAP) { atomicAdd(&(bar)[XB_TMO], 1u); break; } } } } while (0)

struct XcdBarrier {
    unsigned* bar; unsigned x;
    volatile LAS unsigned* st;
};

__device__ __forceinline__ XcdBarrier xcd_barrier_post(unsigned* bar, volatile LAS unsigned* st) {
    XcdBarrier b; b.bar = bar; b.x = xb_xcc_id(); b.st = st;
    if (threadIdx.x == 0) (void)xb_add(&bar[XB_XCNT(b.x)], 1u);
    return b;
}
__device__ __forceinline__ void xcd_barrier_complete(unsigned* bar, unsigned x, unsigned& nloc, unsigned& nx) {
    const unsigned G = gridDim.x * gridDim.y * gridDim.z;
    unsigned sum, cnt, mine, sp = 0u;
    for (;;) {
        sum = 0u; cnt = 0u; mine = 0u;
#pragma unroll
        for (unsigned j = 0; j < 16; ++j) { const unsigned c = xb_ld(&bar[XB_XCNT(j)]); sum += c; cnt += (c > 0u) ? 1u : 0u; mine = (j == x) ? c : mine; }
        if (sum == G) break;
        __builtin_amdgcn_s_sleep(1);
        if ((++sp & 255u) == 0u) { if (xb_ld(&bar[XB_TMO])) break; if (sp > XB_SPIN_CAP) { atomicAdd(&bar[XB_TMO], 1u); break; } }
    }
    nloc = mine > 0u ? mine : 1u; nx = cnt > 0u ? cnt : 1u;
}

__device__ __forceinline__ void xcd_barrier(const XcdBarrier& b) {
    asm volatile("s_waitcnt vmcnt(0)" ::: "memory");
    __syncthreads();
    if (threadIdx.x == 0) {
        unsigned* bar = b.bar;
        __builtin_amdgcn_s_waitcnt(0);
        unsigned nloc = b.st[0], nx = b.st[1];
        if (nloc == 0u) { xcd_barrier_complete(bar, b.x, nloc, nx); b.st[0] = nloc; b.st[1] = nx; }
        const unsigned old = xb_add(&bar[XB_XSUB(b.x)], 1u);
        const unsigned gen = old / nloc;
        if (old + 1u == (gen + 1u) * nloc) {
            __builtin_amdgcn_fence(__ATOMIC_RELEASE, "agent");
            asm volatile("s_waitcnt vmcnt(0)" ::: "memory");
            const unsigned og = xb_add(&bar[XB_TOP], 1u);
            const unsigned tg = og / nx;
            if (og + 1u == (tg + 1u) * nx) xb_add(&bar[XB_TOPGEN], 1u);
            else XB_SPIN(xb_ld(&bar[XB_TOPGEN]) == tg, bar);
            __builtin_amdgcn_fence(__ATOMIC_ACQUIRE, "agent");
            xb_add(&bar[XB_XGEN(b.x)], 1u);
            asm volatile("s_waitcnt vmcnt(0)" ::: "memory");
        } else {
            XB_SPIN(xb_ld(&bar[XB_XGEN(b.x)]) == gen, bar);
            __builtin_amdgcn_fence(__ATOMIC_ACQUIRE, "agent");
            asm volatile("s_waitcnt vmcnt(0)" ::: "memory");
        }
    }
    __syncthreads();
}

__global__ void __launch_bounds__(512, 2) mega(Params pa) {
    extern __shared__ __attribute__((aligned(16))) unsigned char shm[];
    LAS unsigned char* lds = (LAS unsigned char*)shm;
    const int G = gridDim.x, bid = blockIdx.x;
    KP* pk = (KP*)__builtin_amdgcn_kernarg_segment_ptr();
    volatile LAS unsigned* bst = (volatile LAS unsigned*)(lds + LDS_BYTES - 16);
    XcdBarrier xb; xb.bar = nullptr; xb.x = 0; xb.st = bst;
    if (pa.coop) { if (threadIdx.x < 2) bst[threadIdx.x] = 0u; __syncthreads(); xb = xcd_barrier_post((unsigned*)(pa.ws + W_BAR), bst); }
    for (int ph = pa.ph_lo; ph < pa.ph_hi; ++ph) {
        if (ph > pa.ph_lo && pa.coop) { if (pa.pad == 0x5a5a) { __threadfence(); cg::this_grid().sync(); } else xcd_barrier(xb); }
        asm volatile("" : "+s"(pk)); KP& p = *pk;
        if (ph == 0) { phase_prep(p, lds); continue; }
        if (ph == 42) { int tq = threadIdx.x; asm volatile("" : "+v"(tq)); const unsigned short* w16 = (const unsigned short*)p.ws; for (size_t i = (size_t)bid * 512 + tq; i < (size_t)59418624; i += (size_t)G * 512) p.out[i] = (float)w16[i * 4]; continue; }
        if (ph == 41) { int tq = threadIdx.x; asm volatile("" : "+v"(tq)); for (size_t i = (size_t)bid * 512 + tq; i < (size_t)59418624; i += (size_t)G * 512) { const float v = p.out[i]; if (!(fabsf(v) < 1e30f)) p.out[i] = 0.f; } continue; }
        const int l = (ph - 1) / 10, k = (ph - 1) % 10;
        bf16_t* XB = (bf16_t*)(p.ws + W_XB);
        switch (k) {
        case 0: if (REP_G1 > 1) { pg8::StaticOrder S; S.init(T_ALL, NPROJ, G, bid); EpiNull E{(float*)(p.ws + W_CD)};
                  pg8::gemm_phase(lds, pg8::Gemm{XB, (const bf16_t*)(p.ws + W_IN + l * W_IN_L), T_ALL, NPROJ, DM}, S, E); }
                { if ((bid >> 3) & 1) { __builtin_amdgcn_s_sleep(127); __builtin_amdgcn_s_sleep(127); __builtin_amdgcn_s_sleep(127); }
                  pg8::StaticOrder S; S.init(T_ALL, NPROJ, G, bid);
                  EpiIn E{(bf16_t*)(p.ws + W_PROJ), p.out, (float*)(p.ws + W_DTB), p.in[13], l};
                  pg8::gemm_phase(lds, pg8::Gemm{XB, (const bf16_t*)(p.ws + W_IN + l * W_IN_L), T_ALL, NPROJ, DM}, S, E); } break;
        case 1: {
                  unsigned* qctr = (unsigned*)(p.ws + W_BAR + 14336) + l * 64;
                  volatile LAS int* qslot = (volatile LAS int*)(lds + LDS_BYTES - 32);
                  for (;;) {
                      __syncthreads();
                      if (threadIdx.x == 0) qslot[0] = (int)__hip_atomic_fetch_add(qctr, 1u, __ATOMIC_RELAXED, __HIP_MEMORY_SCOPE_AGENT);
                      __syncthreads();
                      const int it = qslot[0];
                      if (it >= 2 * NU64) break;
                      if (it < NU64) attn_unit(p, lds, l, NU64 - 1 - it); else ssd_states(p, lds, l, it - NU64);
                  } } break;
        case 2: for (int it = bid; it < 96 + 768; it += G) { if (it < 96) scan_prompt(p, l, it); else scan_sample(p, l, it - 96); } break;
        case 3: {
                  unsigned* qctr = (unsigned*)(p.ws + W_BAR + 14336) + l * 64 + 32;
                  volatile LAS int* qslot = (volatile LAS int*)(lds + LDS_BYTES - 32);
                  for (;;) {
                      __syncthreads();
                      if (threadIdx.x == 0) qslot[0] = (int)__hip_atomic_fetch_add(qctr, 1u, __ATOMIC_RELAXED, __HIP_MEMORY_SCOPE_AGENT);
                      __syncthreads();
                      const int it = qslot[0];
                      if (it >= 2 * NU64) break;
                      if (it < NU64) ssd_y(p, lds, l, it); else gmlp_unit(p, lds, l, it - NU64);
                  } } break;
        case 4: { pg8::StaticOrder S; S.init(T_ALL, DM, G, bid); EpiRes E{p.out, XB, (bf16_t*)p.out};
                  pg8::gemm_phase(lds, pg8::Gemm{(const bf16_t*)(p.ws + W_MIX), (const bf16_t*)(p.ws + W_OUT + l * W_OUT_L), T_ALL, DM, DM}, S, E); } break;
        case 5: phase_ln(p, (const bf16_t*)p.out, p.in[20] + l * DM, p.in[21] + l * DM, false); break;
        case 6: for (int rep = 0; rep < REP_G3; ++rep) { pg8::StaticOrder S; S.init(T_ALL, DFF2, G, bid);
                  EpiUp E{(bf16_t*)(p.ws + W_PROJ), (float*)(p.ws + W_MIX), p.out, p.in[23], p.in[24], p.in[6], l};
                  pg8::OneUnit o1;
                  for (int i = 0; S.next(i, o1.u); ++i) { pg8::gemm_phase(lds, pg8::Gemm{XB, (const bf16_t*)(p.ws + W_UP + l * W_UP_L), T_ALL, DFF2, DM}, o1, E); __syncthreads(); } } break;
        case 7: phase_fix(p, l); break;
        case 8: { pg8::StaticOrder S; S.init(T_ALL, DM, G, bid); EpiRes E{p.out, XB, (bf16_t*)(p.ws + W_MIX)};
                  pg8::gemm_phase(lds, pg8::Gemm{(const bf16_t*)(p.ws + W_PROJ), (const bf16_t*)(p.ws + W_DN + l * W_DN_L), T_ALL, DM, DFF}, S, E); } break;
        case 9: phase_ln(p, (const bf16_t*)(p.ws + W_MIX), p.in[26] + l * DM, p.in[27] + l * DM, l == DEPTH - 1); break;
        }
    }
}

constexpr int N_PHASES = 41;
#ifndef MULTI_LAUNCH
#define MULTI_LAUNCH 0
#endif

extern "C" void kernel_launch(void* const* d_in, const int* in_sizes, int n_in, void* d_out, int out_size, void* d_ws, size_t ws_size, hipStream_t stream) {
    static int grid = 0;
    if (grid == 0) {
        if (n_in != 28 || ws_size < W_END2) { fprintf(stderr, "kernel_launch: need 28 inputs and %zu bytes of workspace (got %d, %zu)\n", (size_t)W_END2, n_in, ws_size); grid = -1; return; }
        int dev = 0, cus = 0, per_cu = 0;
        hipGetDevice(&dev); hipDeviceGetAttribute(&cus, hipDeviceAttributeMultiprocessorCount, dev);
        if (hipFuncSetAttribute((const void*)mega, hipFuncAttributeMaxDynamicSharedMemorySize, LDS_BYTES) != hipSuccess) { fprintf(stderr, "kernel_launch: hipFuncSetAttribute failed\n"); grid = -1; return; }
        hipOccupancyMaxActiveBlocksPerMultiprocessor(&per_cu, (const void*)mega, 512, LDS_BYTES);
        (void)hipGetLastError();
        if (per_cu < 1) per_cu = 1;
        grid = cus * 1;
    }
    if (grid < 0) return;
    Params p{};
    for (int i = 0; i < 28; ++i) p.in[i] = (const float*)d_in[i];
    p.out = (float*)d_out; p.ws = (unsigned char*)d_ws;
#if MULTI_LAUNCH
#ifdef PROBE_CUT
    for (int ph = 0; ph < PROBE_CUT; ++ph) { p.ph_lo = ph; p.ph_hi = ph + 1; p.coop = 0; hipLaunchKernelGGL(mega, dim3(grid), dim3(512), LDS_BYTES, stream, p); }
    p.ph_lo = 42; p.ph_hi = 43; p.coop = 0; hipLaunchKernelGGL(mega, dim3(grid), dim3(512), LDS_BYTES, stream, p);
#else
    for (int ph = 0; ph < N_PHASES; ++ph) { p.ph_lo = ph; p.ph_hi = ph + 1; p.coop = 0; hipLaunchKernelGGL(mega, dim3(grid), dim3(512), LDS_BYTES, stream, p); }
#endif
#else
    p.ph_lo = 0; p.ph_hi = N_PHASES; p.coop = 1;
    if (hipMemsetAsync((char*)d_ws + W_BAR, 0, 16384, stream) != hipSuccess) { fprintf(stderr, "kernel_launch: memset failed\n"); return; }
    void* args[] = {&p};
    hipError_t e = hipLaunchCooperativeKernel((const void*)mega, dim3(grid), dim3(512), args, LDS_BYTES, stream);
    if (e != hipSuccess) fprintf(stderr, "cooperative launch failed: %s (grid %d)\n", hipGetErrorString(e), grid);
#endif
}
```
